# Optimizing an MI355X kernel written in HIP

```python
import math
import jax, jax.numpy as jnp
from jax import lax
import numpy as np

D_MODEL = 1024
BATCH = 4
SEQ = 8192
DEPTH = 4

CONV_CH = D_MODEL // 2
CONV_K = 3
SSM_WIDTH = D_MODEL // 2
SSM_GROUP = 16
SSM_GROUPS = SSM_WIDTH // SSM_GROUP
SSM_STATE = 64
DT_MIN = 1e-3
DT_MAX = 1e-1
N_HEADS = 16
HEAD_DIM = D_MODEL // N_HEADS
ROPE_THETA = 10000.0
DILATED_PATTERNS = ((128, 1), (512, 4), (2048, 16))
ATT_BLOCK = 128
N_EXPERTS = 32
TOP_K = 4
D_EXPERT = D_MODEL
SWIGLU_LIMIT = 7.0
SWIGLU_ALPHA = 1.702
MOE_BLOCK = 256
DN_ALPHA = (2 * DEPTH) ** 0.25
DN_BETA = (8 * DEPTH) ** -0.25
LN_EPS = 1e-5
N_EVEN = (DEPTH + 1) // 2
N_ODD = DEPTH // 2

kernel_name = "hybrid_conv_s5_dilated_moe_deepnorm"


def layer_norm(x, g, b):
    xf = x.astype(jnp.float32)
    mu = jnp.mean(xf, axis=-1, keepdims=True)
    xc = xf - mu
    var = jnp.mean(xc * xc, axis=-1, keepdims=True)
    return (xc * lax.rsqrt(var + LN_EPS) * g.astype(jnp.float32) + b.astype(jnp.float32)).astype(x.dtype)


def causal_depthwise_conv(v, w):
    c = v.shape[-1]
    return lax.conv_general_dilated(v, w[:, None, :].astype(v.dtype), window_strides=(1,),
                                    padding=[(CONV_K - 1, 0)],
                                    dimension_numbers=("NWC", "WIO", "NWC"),
                                    feature_group_count=c)


def s5_layer(u, a_re, a_im, log_dt, b_re, b_im, c_re, c_im, d_skip, w_glu, b_glu):
    bsz, L, _ = u.shape
    f32 = jnp.float32
    uf = u.astype(f32).reshape(bsz, L, SSM_GROUPS, SSM_GROUP)
    lam_re = jnp.minimum(a_re.astype(f32), -1e-4)
    lam_im = a_im.astype(f32)
    dt = jnp.exp(log_dt.astype(f32))[:, None]
    mag = jnp.exp(lam_re * dt)
    ab_re = mag * jnp.cos(lam_im * dt)
    ab_im = mag * jnp.sin(lam_im * dt)
    nr, ni = ab_re - 1.0, ab_im
    den = lam_re * lam_re + lam_im * lam_im
    coef_re = ((nr * lam_re + ni * lam_im) / den)[..., None]
    coef_im = ((ni * lam_re - nr * lam_im) / den)[..., None]
    br, bi = b_re.astype(f32), b_im.astype(f32)
    bb_re = coef_re * br - coef_im * bi
    bb_im = coef_re * bi + coef_im * br
    bu_re = jnp.einsum("blgh,gph->blgp", uf, bb_re)
    bu_im = jnp.einsum("blgh,gph->blgp", uf, bb_im)
    a_re_t = jnp.broadcast_to(ab_re, bu_re.shape)
    a_im_t = jnp.broadcast_to(ab_im, bu_re.shape)

    def combine(e1, e2):
        a1r, a1i, b1r, b1i = e1
        a2r, a2i, b2r, b2i = e2
        return (a2r * a1r - a2i * a1i, a2r * a1i + a2i * a1r,
                a2r * b1r - a2i * b1i + b2r, a2r * b1i + a2i * b1r + b2i)

    _, _, xr, xi = lax.associative_scan(combine, (a_re_t, a_im_t, bu_re, bu_im), axis=1)
    y = (jnp.einsum("blgp,ghp->blgh", xr, c_re.astype(f32))
         - jnp.einsum("blgp,ghp->blgh", xi, c_im.astype(f32))
         + d_skip.astype(f32) * uf)
    y = y.reshape(bsz, L, SSM_WIDTH)
    z = jax.nn.gelu(y)
    z = z * jax.nn.sigmoid(z @ w_glu.astype(f32) + b_glu.astype(f32))
    return z.astype(u.dtype)


def conv_ssm_mixer(x, w_in, conv_w, a_re, a_im, log_dt, b_re, b_im, c_re, c_im, d_skip,
                   w_glu, b_glu, w_out):
    proj = x @ w_in
    gate_b = proj[..., :CONV_CH]
    gate_c = proj[..., CONV_CH:2 * CONV_CH]
    h = proj[..., 2 * CONV_CH:3 * CONV_CH]
    u = proj[..., 3 * CONV_CH:]
    y_conv = gate_b * causal_depthwise_conv(gate_c * h, conv_w)
    y_ssm = s5_layer(u, a_re, a_im, log_dt, b_re, b_im, c_re, c_im, d_skip, w_glu, b_glu)
    return jnp.concatenate([y_conv, y_ssm], axis=-1) @ w_out


def rope(x):
    L = x.shape[1]
    half = HEAD_DIM // 2
    inv = ROPE_THETA ** (-jnp.arange(half, dtype=jnp.float32) / half)
    ang = jnp.arange(L, dtype=jnp.float32)[:, None] * inv[None, :]
    cos = jnp.cos(ang)[None, :, None, :]
    sin = jnp.sin(ang)[None, :, None, :]
    xf = x.astype(jnp.float32)
    x1, x2 = xf[..., :half], xf[..., half:]
    return jnp.concatenate([x1 * cos - x2 * sin, x2 * cos + x1 * sin], axis=-1).astype(x.dtype)


def dilated_window_attention(q, k, v, window, dilation):
    bsz, L, H, Dh = q.shape
    span = dilation * ATT_BLOCK
    Lp = -(-L // span) * span
    M = Lp // dilation
    nb = M // ATT_BLOCK
    reach = window // dilation

    def to_blocks(a):
        a = jnp.pad(a, ((0, 0), (0, Lp - L), (0, 0), (0, 0)))
        a = a.reshape(bsz, M, dilation, H, Dh).transpose(0, 2, 1, 3, 4)
        return a.reshape(bsz, dilation, nb, ATT_BLOCK, H, Dh)

    def with_prev(a):
        prev = jnp.pad(a, ((0, 0), (0, 0), (1, 0), (0, 0), (0, 0), (0, 0)))[:, :, :-1]
        return jnp.concatenate([prev, a], axis=3)

    qb = to_blocks(q)
    kk = with_prev(to_blocks(k))
    vv = with_prev(to_blocks(v))
    s = jnp.einsum("brnqhe,brnkhe->brnhqk", qb, kk, preferred_element_type=jnp.float32)
    qi = jnp.arange(ATT_BLOCK)[:, None]
    kj = jnp.arange(2 * ATT_BLOCK)[None, :]
    dist = ATT_BLOCK + qi - kj
    band = (dist >= 0) & (dist <= reach)
    first = (jnp.arange(nb) == 0)[:, None, None]
    valid = band[None] & ~(first & (kj < ATT_BLOCK)[None])
    s = jnp.where(valid[:, None], s, -jnp.inf)
    m = jnp.max(s, axis=-1, keepdims=True)
    p = jnp.exp(s - m)
    den = jnp.sum(p, axis=-1, keepdims=True)
    o = jnp.einsum("brnhqk,brnkhe->brnhqe", p, vv.astype(jnp.float32)) / den
    lse = (m + jnp.log(den))[..., 0]
    o = o.transpose(0, 1, 2, 4, 3, 5).reshape(bsz, dilation, M, H, Dh)
    o = o.transpose(0, 2, 1, 3, 4).reshape(bsz, Lp, H, Dh)[:, :L]
    lse = lse.transpose(0, 1, 2, 4, 3).reshape(bsz, dilation, M, H)
    lse = lse.transpose(0, 2, 1, 3).reshape(bsz, Lp, H)[:, :L]
    return o, lse


def dilated_attention_mixer(x, w_qkv, w_o):
    bsz, L, _ = x.shape
    qkv = (x @ w_qkv).reshape(bsz, L, 3, N_HEADS, HEAD_DIM)
    q = rope(qkv[:, :, 0]) * (HEAD_DIM ** -0.5)
    k = rope(qkv[:, :, 1])
    v = qkv[:, :, 2]
    outs, lses = [], []
    for window, dilation in DILATED_PATTERNS:
        o, lse = dilated_window_attention(q, k, v, window, dilation)
        outs.append(o)
        lses.append(lse)
    wts = jax.nn.softmax(jnp.stack(lses, axis=0), axis=0)
    o = jnp.einsum("pblh,pblhe->blhe", wts, jnp.stack(outs, axis=0))
    return o.reshape(bsz, L, D_MODEL).astype(x.dtype) @ w_o


def moe_ffn(x, router_w, router_b, w_gu, b_gu, w_down, b_down):
    bsz, L, D = x.shape
    T = bsz * L
    xt = x.reshape(T, D)
    logits = (xt @ router_w).astype(jnp.float32) + router_b.astype(jnp.float32)
    top_val, top_idx = lax.top_k(logits, TOP_K)
    gates = jax.nn.softmax(top_val, axis=-1)
    n_assign = T * TOP_K
    flat_e = top_idx.reshape(-1)
    flat_tok = jnp.arange(n_assign, dtype=jnp.int32) // TOP_K
    flat_gate = gates.reshape(-1)
    order = jnp.argsort(flat_e)
    se = flat_e[order]
    counts = jnp.bincount(flat_e, length=N_EXPERTS)
    padded = (counts + MOE_BLOCK - 1) // MOE_BLOCK * MOE_BLOCK
    pad_end = jnp.cumsum(padded)
    pad_start = pad_end - padded
    start = jnp.cumsum(counts) - counts
    rank = jnp.arange(n_assign, dtype=jnp.int32) - start[se]
    dest = pad_start[se] + rank
    n_blocks = -(-n_assign // MOE_BLOCK) + N_EXPERTS
    n_rows = n_blocks * MOE_BLOCK
    row_tok = jnp.full((n_rows,), T, jnp.int32).at[dest].set(flat_tok[order])
    row_gate = jnp.zeros((n_rows,), jnp.float32).at[dest].set(flat_gate[order])
    block_start = jnp.arange(n_blocks, dtype=pad_end.dtype) * MOE_BLOCK
    block_e = jnp.minimum(jnp.searchsorted(pad_end, block_start, side="right"), N_EXPERTS - 1)
    x_pad = jnp.concatenate([xt, jnp.zeros((1, D), xt.dtype)], axis=0)

    def expert_block(args):
        tok, gate, e = args
        h = x_pad[tok] @ w_gu[e] + b_gu[e]
        g = jnp.minimum(h[:, :D_EXPERT], SWIGLU_LIMIT)
        lin = jnp.clip(h[:, D_EXPERT:], -SWIGLU_LIMIT, SWIGLU_LIMIT)
        act = (lin + 1.0) * (g * jax.nn.sigmoid(SWIGLU_ALPHA * g))
        y = act @ w_down[e] + b_down[e]
        return y * gate[:, None].astype(y.dtype)

    ys = lax.map(expert_block, (row_tok.reshape(n_blocks, MOE_BLOCK),
                                row_gate.reshape(n_blocks, MOE_BLOCK), block_e))
    out = jnp.zeros((T + 1, D), ys.dtype).at[row_tok].add(ys.reshape(n_rows, D))[:T]
    return out.reshape(bsz, L, D).astype(x.dtype)


def setup_inputs(seed: int = 0) -> dict:
    key = jax.random.key(seed)
    ks = jax.random.split(key, 32)
    f32 = jnp.float32

    def nrm(k, shape, scale):
        return jax.random.normal(k, shape, f32) * scale

    NE, NO = N_EVEN, N_ODD
    G, P, H = SSM_GROUPS, SSM_STATE, SSM_GROUP
    mix_in = 3 * CONV_CH + SSM_WIDTH
    mix_out = CONV_CH + SSM_WIDTH
    return {
        "x": nrm(ks[0], (BATCH, SEQ, D_MODEL), 1.0),
        "hy_w_in": nrm(ks[1], (NE, D_MODEL, mix_in), D_MODEL ** -0.5),
        "conv_w": nrm(ks[2], (NE, CONV_K, CONV_CH), CONV_K ** -0.5),
        "ssm_a_re": -0.5 + nrm(ks[3], (NE, G, P), 0.01),
        "ssm_a_im": jnp.pi * jnp.arange(P, dtype=f32) + nrm(ks[4], (NE, G, P), 0.01),
        "ssm_log_dt": jax.random.uniform(ks[5], (NE, G), f32, math.log(DT_MIN), math.log(DT_MAX)),
        "ssm_b_re": nrm(ks[6], (NE, G, P, H), (2 * H) ** -0.5),
        "ssm_b_im": nrm(ks[7], (NE, G, P, H), (2 * H) ** -0.5),
        "ssm_c_re": nrm(ks[8], (NE, G, H, P), (2 * P) ** -0.5),
        "ssm_c_im": nrm(ks[9], (NE, G, H, P), (2 * P) ** -0.5),
        "ssm_d": nrm(ks[10], (NE, G, H), 1.0),
        "ssm_w_glu": nrm(ks[11], (NE, SSM_WIDTH, SSM_WIDTH), SSM_WIDTH ** -0.5),
        "ssm_b_glu": nrm(ks[12], (NE, SSM_WIDTH), 0.01),
        "hy_w_out": nrm(ks[13], (NE, mix_out, D_MODEL), DN_BETA * mix_out ** -0.5),
        "att_w_qkv": nrm(ks[14], (NO, D_MODEL, 3 * D_MODEL), D_MODEL ** -0.5),
        "att_w_o": nrm(ks[15], (NO, D_MODEL, D_MODEL), DN_BETA * D_MODEL ** -0.5),
        "ln_mix_g": 1.0 + nrm(ks[16], (DEPTH, D_MODEL), 0.01),
        "ln_mix_b": nrm(ks[17], (DEPTH, D_MODEL), 0.01),
        "ln_ffn_g": 1.0 + nrm(ks[18], (DEPTH, D_MODEL), 0.01),
        "ln_ffn_b": nrm(ks[19], (DEPTH, D_MODEL), 0.01),
        "router_w": nrm(ks[20], (DEPTH, D_MODEL, N_EXPERTS), D_MODEL ** -0.5),
        "router_b": nrm(ks[21], (DEPTH, N_EXPERTS), 0.01),
        "expert_w_gu": nrm(ks[22], (DEPTH, N_EXPERTS, D_MODEL, 2 * D_EXPERT), D_MODEL ** -0.5),
        "expert_b_gu": nrm(ks[23], (DEPTH, N_EXPERTS, 2 * D_EXPERT), 0.01),
        "expert_w_down": nrm(ks[24], (DEPTH, N_EXPERTS, D_EXPERT, D_MODEL), DN_BETA * D_EXPERT ** -0.5),
        "expert_b_down": nrm(ks[25], (DEPTH, N_EXPERTS, D_MODEL), 0.01),
    }


def reference(x, hy_w_in, conv_w, ssm_a_re, ssm_a_im, ssm_log_dt, ssm_b_re, ssm_b_im,
              ssm_c_re, ssm_c_im, ssm_d, ssm_w_glu, ssm_b_glu, hy_w_out, att_w_qkv, att_w_o,
              ln_mix_g, ln_mix_b, ln_ffn_g, ln_ffn_b, router_w, router_b, expert_w_gu,
              expert_b_gu, expert_w_down, expert_b_down):
    h = x
    for layer in range(DEPTH):
        i = layer // 2
        if layer % 2 == 0:
            mix = conv_ssm_mixer(h, hy_w_in[i], conv_w[i], ssm_a_re[i], ssm_a_im[i], ssm_log_dt[i],
                                 ssm_b_re[i], ssm_b_im[i], ssm_c_re[i], ssm_c_im[i], ssm_d[i],
                                 ssm_w_glu[i], ssm_b_glu[i], hy_w_out[i])
        else:
            mix = dilated_attention_mixer(h, att_w_qkv[i], att_w_o[i])
        h = layer_norm(DN_ALPHA * h + mix, ln_mix_g[layer], ln_mix_b[layer])
        ffn = moe_ffn(h, router_w[layer], router_b[layer], expert_w_gu[layer], expert_b_gu[layer],
                      expert_w_down[layer], expert_b_down[layer])
        h = layer_norm(DN_ALPHA * h + ffn, ln_ffn_g[layer], ln_ffn_b[layer])
    return h
```

```cpp
#include <hip/hip_runtime.h>
#include <cstdio>
#include <cstdint>

#ifndef MK_ONE_LAUNCH
#define MK_ONE_LAUNCH 1
#endif

#define GAS __attribute__((address_space(1)))
#define LAS __attribute__((address_space(3)))
#define RLX_AGENT __ATOMIC_RELAXED, __HIP_MEMORY_SCOPE_AGENT
#define WAVE_SYNC() asm volatile("s_waitcnt lgkmcnt(0)" ::: "memory")
typedef float f32x4 __attribute__((ext_vector_type(4)));
typedef float f32x2 __attribute__((ext_vector_type(2)));

constexpr int BATCH = 4, SEQ = 8192, D = 1024, T = BATCH * SEQ, DEPTH = 4;
constexpr int CONV_CH = 512, SSM_W = 512, SSM_G = 32, SSM_H = 16, SSM_P = 64;
constexpr int NH = 16, HD = 64;
constexpr int NE = 32, TOPK = 4, NA = T * TOPK;
constexpr float SW_LIMIT = 7.0f, SW_ALPHA = 1.702f;
constexpr float LN_EPS = 1e-5f;
constexpr float DN_ALPHA = 1.6817928305074290860622509524664f;
constexpr int NWAVES = 8, NTHR = 512;

constexpr size_t MiB = 1u << 20;
constexpr size_t WS_CTL = 0, CTL_ZERO_BYTES = 1 * MiB;
constexpr size_t WS_S5A = 1 * MiB;
constexpr size_t WS_S5B = 1 * MiB + 65536;
constexpr size_t WS_ROPE = 2 * MiB;
constexpr size_t WS_TOKE = 4 * MiB;
constexpr size_t WS_TOKG = 4 * MiB + 524288;
constexpr size_t WS_TOKR = 5 * MiB;
constexpr size_t WS_LIST = 8 * MiB;
constexpr size_t WS_H0 = 16 * MiB;
constexpr size_t WS_H1 = 144 * MiB;
constexpr size_t WS_PROJ = 272 * MiB;
constexpr size_t WS_MIX = 656 * MiB;
constexpr size_t WS_MIXO = 784 * MiB;
constexpr size_t WS_Z = 912 * MiB;
constexpr size_t WS_ACT = 976 * MiB;
constexpr size_t WS_Y = 1488 * MiB;
constexpr size_t WS_END = 2000 * MiB;
constexpr int CW_BAR = 4096;
constexpr int CW_CNT = 16384;

constexpr int LDS_BYTES = 147456;
constexpr int MISC_OFF = 131072 + 320;

#define XB_TMO      128
#define XB_XCNT(j)  (256  + 64 * (j))
#define XB_XSUB(j)  (1280 + 64 * (j))
#define XB_XGEN(j)  (2304 + 64 * (j))
#define XB_TOP      3328
#define XB_TOPGEN   3392
#define XCD_BAR_WORDS 3456
#define XB_SPIN_CAP (1u << 22)

__device__ __forceinline__ unsigned xb_ld(unsigned* p)              { return __hip_atomic_load(p, __ATOMIC_RELAXED, __HIP_MEMORY_SCOPE_AGENT); }
__device__ __forceinline__ unsigned xb_add(unsigned* p, unsigned v) { return __hip_atomic_fetch_add(p, v, __ATOMIC_RELAXED, __HIP_MEMORY_SCOPE_AGENT); }
__device__ __forceinline__ unsigned xb_xcc_id() { return (unsigned)__builtin_amdgcn_s_getreg((3 << 11) | 20) & 0xFu; }
#define XB_SPIN(cond, bar) do { unsigned _sp = 0; while (cond) { __builtin_amdgcn_s_sleep(1); \
    if ((++_sp & 255u) == 0u) { if (xb_ld(&(bar)[XB_TMO])) break; if (_sp > XB_SPIN_CAP) { atomicAdd(&(bar)[XB_TMO], 1u); break; } } } } while (0)

struct XcdBarrier { unsigned* bar; unsigned x; volatile LAS unsigned* st; };

__device__ __forceinline__ XcdBarrier xcd_barrier_post(unsigned* bar, volatile LAS unsigned* st) {
    XcdBarrier b; b.bar = bar; b.x = xb_xcc_id(); b.st = st;
    if (threadIdx.x == 0) (void)xb_add(&bar[XB_XCNT(b.x)], 1u);
    return b;
}
__device__ __forceinline__ void xcd_barrier_complete(unsigned* bar, unsigned x, unsigned& nloc, unsigned& nx) {
    const unsigned G = gridDim.x * gridDim.y * gridDim.z;
    unsigned sum, cnt, mine, sp = 0u;
    for (;;) {
        sum = 0u; cnt = 0u; mine = 0u;
#pragma unroll
        for (unsigned j = 0; j < 16; ++j) { const unsigned c = xb_ld(&bar[XB_XCNT(j)]); sum += c; cnt += (c > 0u) ? 1u : 0u; mine = (j == x) ? c : mine; }
        if (sum == G) break;
        __builtin_amdgcn_s_sleep(1);
        if ((++sp & 255u) == 0u) { if (xb_ld(&bar[XB_TMO])) break; if (sp > XB_SPIN_CAP) { atomicAdd(&bar[XB_TMO], 1u); break; } }
    }
    nloc = mine > 0u ? mine : 1u; nx = cnt > 0u ? cnt : 1u;
}
__device__ __forceinline__ void xcd_barrier(const XcdBarrier& b) {
    asm volatile("s_waitcnt vmcnt(0)" ::: "memory");
    __syncthreads();
    if (threadIdx.x == 0) {
        unsigned* bar = b.bar;
        __builtin_amdgcn_s_waitcnt(0);
        unsigned nloc = b.st[0], nx = b.st[1];
        if (nloc == 0u) { xcd_barrier_complete(bar, b.x, nloc, nx); b.st[0] = nloc; b.st[1] = nx; }
        const unsigned old = xb_add(&bar[XB_XSUB(b.x)], 1u);
        const unsigned gen = old / nloc;
        if (old + 1u == (gen + 1u) * nloc) {
            __builtin_amdgcn_fence(__ATOMIC_RELEASE, "agent");
            asm volatile("s_waitcnt vmcnt(0)" ::: "memory");
            const unsigned og = xb_add(&bar[XB_TOP], 1u);
            const unsigned tg = og / nx;
            if (og + 1u == (tg + 1u) * nx) xb_add(&bar[XB_TOPGEN], 1u);
            else XB_SPIN(xb_ld(&bar[XB_TOPGEN]) == tg, bar);
            __builtin_amdgcn_fence(__ATOMIC_ACQUIRE, "agent");
            xb_add(&bar[XB_XGEN(b.x)], 1u);
            asm volatile("s_waitcnt vmcnt(0)" ::: "memory");
        } else {
            XB_SPIN(xb_ld(&bar[XB_XGEN(b.x)]) == gen, bar);
            __builtin_amdgcn_fence(__ATOMIC_ACQUIRE, "agent");
            asm volatile("s_waitcnt vmcnt(0)" ::: "memory");
        }
    }
    __syncthreads();
}

__device__ __forceinline__ float wave_sum(float v) {
#pragma unroll
    for (int o = 1; o < 64; o <<= 1) v += __shfl_xor(v, o);
    return v;
}
__device__ __forceinline__ float wave_max(float v) {
#pragma unroll
    for (int o = 1; o < 64; o <<= 1) v = fmaxf(v, __shfl_xor(v, o));
    return v;
}
__device__ __forceinline__ float sigmoidf_(float x) { return 1.0f / (1.0f + __expf(-x)); }
__device__ __forceinline__ float gelu_tanh(float y) { return 0.5f * y * (1.0f + tanhf(0.7978845608028654f * (y + 0.044715f * y * y * y))); }

struct Ctx {
    LAS unsigned char* lds;
    int tid, lane, wave, G, bid;
    unsigned* ctl;
    unsigned char* ws;
};

template <bool DUAL, class RowPtr, class Epi>
__device__ __forceinline__ void sgemm_tile(const Ctx& X, RowPtr rowptr, int mvalid, const float* __restrict__ B, int ldb, int n0, int n1off, int K, Epi epi) {
    LAS float* As = (LAS float*)X.lds;
    LAS float* Bs = As + 16 * 132;
    LAS float* Bs2 = Bs + 16 * 64;
    const int tid = X.tid, ty = tid >> 4, tx = tid & 15;
    float acc[4][4], acc2[4][4];
#pragma unroll
    for (int i = 0; i < 4; ++i)
#pragma unroll
        for (int j = 0; j < 4; ++j) { acc[i][j] = 0.f; acc2[i][j] = 0.f; }
    const int ar = tid >> 2, ak = (tid & 3) * 4;
    const float* arow = (ar < mvalid) ? rowptr(ar) : nullptr;
    const int bk = (tid >> 4) & 15, bn = (tid & 15) * 4;
    const float* bptr = B + (size_t)bk * ldb + n0 + bn + ((tid >= 256) ? n1off : 0);
    __syncthreads();
    for (int k0 = 0; k0 < K; k0 += 16) {
        float4 av = make_float4(0.f, 0.f, 0.f, 0.f);
        if (arow) av = *(const float4*)(arow + k0 + ak);
        As[(ak + 0) * 132 + ar] = av.x; As[(ak + 1) * 132 + ar] = av.y; As[(ak + 2) * 132 + ar] = av.z; As[(ak + 3) * 132 + ar] = av.w;
        if (tid < 256) { const f32x4 bv = *(const f32x4*)(bptr + (size_t)k0 * ldb); *(LAS f32x4*)(Bs + bk * 64 + bn) = bv; }
        else if (DUAL) { const f32x4 bv = *(const f32x4*)(bptr + (size_t)k0 * ldb); *(LAS f32x4*)(Bs2 + bk * 64 + bn) = bv; }
        __syncthreads();
#pragma unroll 2
        for (int kk = 0; kk < 16; ++kk) {
            const f32x4 a = *(const LAS f32x4*)(As + kk * 132 + ty * 4);
            const f32x4 b = *(const LAS f32x4*)(Bs + kk * 64 + tx * 4);
            const float aa[4] = {a.x, a.y, a.z, a.w}, bb[4] = {b.x, b.y, b.z, b.w};
#pragma unroll
            for (int i = 0; i < 4; ++i)
#pragma unroll
                for (int j = 0; j < 4; ++j) acc[i][j] = fmaf(aa[i], bb[j], acc[i][j]);
            if (DUAL) {
                const f32x4 b2 = *(const LAS f32x4*)(Bs2 + kk * 64 + tx * 4);
                const float bb2[4] = {b2.x, b2.y, b2.z, b2.w};
#pragma unroll
                for (int i = 0; i < 4; ++i)
#pragma unroll
                    for (int j = 0; j < 4; ++j) acc2[i][j] = fmaf(aa[i], bb2[j], acc2[i][j]);
            }
        }
        __syncthreads();
    }
#pragma unroll
    for (int i = 0; i < 4; ++i) {
        const int r = ty * 4 + i;
        if (r < mvalid) {
#pragma unroll
            for (int j = 0; j < 4; ++j) epi(r, n0 + tx * 4 + j, acc[i][j], acc2[i][j]);
        }
    }
}

template <class Epi>
__device__ __forceinline__ void dense_gemm_phase(const Ctx& X, const float* A, int lda, int M, const float* B, int N, int K, Epi epi) {
    const int nMt = M / 128, nNt = N / 64, nun = nMt * nNt;
    for (int u = X.bid; u < nun; u += X.G) {
        const int mt = u / nNt, nt = u % nNt;
        const float* Ab = A + (size_t)mt * 128 * lda;
        auto rp = [=](int r) { return Ab + (size_t)r * lda; };
        const int m0 = mt * 128;
        auto e2 = [=](int r, int c, float v, float v2) { epi(m0 + r, c, v); };
        sgemm_tile<false>(X, rp, 128, B, N, nt * 64, 0, K, e2);
    }
}

__device__ __forceinline__ void phase_prologue(const Ctx& X, const float* a_re, const float* a_im, const float* log_dt, const float* b_re, const float* b_im) {
    float2* Abar = (float2*)(X.ws + WS_S5A); float2* Bbar = (float2*)(X.ws + WS_S5B); float2* rope = (float2*)(X.ws + WS_ROPE);
    const int gt = X.bid * NTHR + X.tid, NT = X.G * NTHR;
    for (int it = gt; it < 2 * SSM_G * SSM_P; it += NT) {
        const int ig = it >> 6;
        const double lam_re = fmin((double)a_re[it], -1e-4), lam_im = (double)a_im[it];
        const double dt = exp((double)log_dt[ig]);
        const double mag = exp(lam_re * dt), ang = lam_im * dt;
        const double abr = mag * cos(ang), abi = mag * sin(ang);
        const double nr = abr - 1.0, ni = abi, den = lam_re * lam_re + lam_im * lam_im;
        const double cr = (nr * lam_re + ni * lam_im) / den, ci = (ni * lam_re - nr * lam_im) / den;
        Abar[it] = make_float2((float)abr, (float)abi);
        for (int h = 0; h < SSM_H; ++h) {
            const double br = (double)b_re[it * 16 + h], bi = (double)b_im[it * 16 + h];
            Bbar[it * 16 + h] = make_float2((float)(cr * br - ci * bi), (float)(cr * bi + ci * br));
        }
    }
    for (int it = gt; it < SEQ * 32; it += NT) {
        const int pos = it >> 5, i = it & 31;
        const float inv = powf(10000.0f, -(float)i / 32.0f);
        const float ang = (float)pos * inv;
        rope[it] = make_float2((float)cos((double)ang), (float)sin((double)ang));
    }
}

__device__ __forceinline__ void phase_conv_s5(const Ctx& X, int i, const float* proj, const float* conv_w, const float* c_re, const float* c_im, const float* d_skip, float* mix, float* Z) {
    {
        const float* w = conv_w + (size_t)i * 3 * CONV_CH;
        const size_t n = (size_t)T * CONV_CH;
        for (size_t idx = (size_t)X.bid * NTHR + X.tid; idx < n; idx += (size_t)X.G * NTHR) {
            const int bt = (int)(idx >> 9), c = (int)(idx & 511), pos = bt & (SEQ - 1);
            const float* pr = proj + (size_t)bt * 2048;
            float s = w[2 * CONV_CH + c] * (pr[512 + c] * pr[1024 + c]);
            if (pos >= 1) s += w[1 * CONV_CH + c] * (pr[512 + c - 2048] * pr[1024 + c - 2048]);
            if (pos >= 2) s += w[0 * CONV_CH + c] * (pr[512 + c - 4096] * pr[1024 + c - 4096]);
            mix[(size_t)bt * D + c] = pr[c] * s;
        }
    }
    if (X.wave == 0) {
        LAS float* ublk = (LAS float*)(X.lds + 32768);
        LAS f32x2* xs = (LAS f32x2*)(X.lds + 32768 + 1024);
        LAS f32x2* Cs = xs + 16 * 65;
        const float2* Abar = (const float2*)(X.ws + WS_S5A); const float2* Bbar = (const float2*)(X.ws + WS_S5B);
        const int lane = X.lane;
        for (int cid = X.bid; cid < BATCH * SSM_G; cid += X.G) {
            const int b = cid >> 5, g = cid & 31, ig = i * 32 + g;
            const float2 A = Abar[ig * 64 + lane];
            float2 bb[16];
#pragma unroll
            for (int h = 0; h < 16; ++h) bb[h] = Bbar[(ig * 64 + lane) * 16 + h];
            WAVE_SYNC();
            for (int h = 0; h < 16; ++h) Cs[h * 65 + lane] = (f32x2){c_re[(ig * 16 + h) * 64 + lane], c_im[(ig * 16 + h) * 64 + lane]};
            const int tt = lane & 15, hq = lane >> 4;
            float dsk[4];
#pragma unroll
            for (int j = 0; j < 4; ++j) dsk[j] = d_skip[ig * 16 + hq * 4 + j];
            float xr = 0.f, xi = 0.f;
            const float* ub = proj + (size_t)b * SEQ * 2048 + 1536 + g * 16;
            for (int t0 = 0; t0 < SEQ; t0 += 16) {
                { const f32x4 uv = *(const f32x4*)(ub + (size_t)(t0 + (lane >> 2)) * 2048 + (lane & 3) * 4); *(LAS f32x4*)(ublk + (lane >> 2) * 16 + (lane & 3) * 4) = uv; }
                WAVE_SYNC();
#pragma unroll 4
                for (int s = 0; s < 16; ++s) {
                    float bur = 0.f, bui = 0.f;
#pragma unroll
                    for (int h4 = 0; h4 < 4; ++h4) {
                        const f32x4 u = *(const LAS f32x4*)(ublk + s * 16 + h4 * 4);
                        bur = fmaf(bb[h4 * 4 + 0].x, u.x, bur); bui = fmaf(bb[h4 * 4 + 0].y, u.x, bui);
                        bur = fmaf(bb[h4 * 4 + 1].x, u.y, bur); bui = fmaf(bb[h4 * 4 + 1].y, u.y, bui);
                        bur = fmaf(bb[h4 * 4 + 2].x, u.z, bur); bui = fmaf(bb[h4 * 4 + 2].y, u.z, bui);
                        bur = fmaf(bb[h4 * 4 + 3].x, u.w, bur); bui = fmaf(bb[h4 * 4 + 3].y, u.w, bui);
                    }
                    const float nr = A.x * xr - A.y * xi + bur, ni = A.x * xi + A.y * xr + bui;
                    xr = nr; xi = ni;
                    xs[s * 65 + lane] = (f32x2){xr, xi};
                }
                WAVE_SYNC();
                float y[4] = {0.f, 0.f, 0.f, 0.f};
                for (int p = 0; p < 64; ++p) {
                    const f32x2 xv = xs[tt * 65 + p];
#pragma unroll
                    for (int j = 0; j < 4; ++j) { const f32x2 cv = Cs[(hq * 4 + j) * 65 + p]; y[j] = fmaf(cv.x, xv.x, y[j]); y[j] = fmaf(-cv.y, xv.y, y[j]); }
                }
                float4 zo;
                { const f32x4 uu = *(const LAS f32x4*)(ublk + tt * 16 + hq * 4);
                  zo.x = gelu_tanh(y[0] + dsk[0] * uu.x); zo.y = gelu_tanh(y[1] + dsk[1] * uu.y); zo.z = gelu_tanh(y[2] + dsk[2] * uu.z); zo.w = gelu_tanh(y[3] + dsk[3] * uu.w); }
                *(float4*)(Z + (size_t)(b * SEQ + t0 + tt) * SSM_W + g * 16 + hq * 4) = zo;
                WAVE_SYNC();
            }
        }
    }
}

__device__ __forceinline__ void phase_rope(const Ctx& X, float* proj) {
    const float2* rope = (const float2*)(X.ws + WS_ROPE);
    const size_t n = (size_t)T * 2 * NH * 32;
    for (size_t idx = (size_t)X.bid * NTHR + X.tid; idx < n; idx += (size_t)X.G * NTHR) {
        const int i = (int)(idx & 31), hh = (int)((idx >> 5) & 15), qk = (int)((idx >> 9) & 1), bt = (int)(idx >> 10), pos = bt & (SEQ - 1);
        float* p = proj + (size_t)bt * 3072 + qk * 1024 + hh * 64 + i;
        const float2 cs = rope[pos * 32 + i];
        const float x1 = p[0], x2 = p[32];
        const float sc = qk == 0 ? 0.125f : 1.0f;
        p[0] = (x1 * cs.x - x2 * cs.y) * sc; p[32] = (x2 * cs.x + x1 * cs.y) * sc;
    }
}

__device__ __forceinline__ void phase_attn(const Ctx& X, const float* proj, float* att) {
    LAS float* pw = (LAS float*)(X.lds + X.wave * 2048);
    const int lane = X.lane;
    const int gw = X.bid * NWAVES + X.wave, NGW = X.G * NWAVES;
    for (int task = gw; task < T * NH; task += NGW) {
        const int bt = task >> 4, hh = task & 15, pos = bt & (SEQ - 1);
        const float* qp = proj + (size_t)bt * 3072 + hh * 64;
        float sc[7]; float mx = -INFINITY;
#pragma unroll
        for (int r = 0; r < 7; ++r) {
            const int n = r * 64 + lane;
            float s = -INFINITY;
            if (n < 387) {
                const int pat = n / 129, j = n - pat * 129, dil = pat == 0 ? 1 : (pat == 1 ? 4 : 16);
                const int sp = pos - j * dil;
                if (sp >= 0) {
                    const float* kp = proj + (size_t)(bt - j * dil) * 3072 + 1024 + hh * 64;
                    float a = 0.f;
#pragma unroll
                    for (int d4 = 0; d4 < 16; ++d4) { const float4 kv = *(const float4*)(kp + d4 * 4); const float4 qv = *(const float4*)(qp + d4 * 4);
                        a = fmaf(qv.x, kv.x, a); a = fmaf(qv.y, kv.y, a); a = fmaf(qv.z, kv.z, a); a = fmaf(qv.w, kv.w, a); }
                    s = a;
                }
            }
            sc[r] = s; mx = fmaxf(mx, s);
        }
        mx = wave_max(mx);
        float den = 0.f;
#pragma unroll
        for (int r = 0; r < 7; ++r) { const float p = (sc[r] == -INFINITY) ? 0.f : __expf(sc[r] - mx); den += p; pw[r * 64 + lane] = p; }
        den = wave_sum(den);
        WAVE_SYNC();
        float o = 0.f;
        for (int n = 0; n < 387; ++n) {
            const int pat = n / 129, j = n - pat * 129, dil = pat == 0 ? 1 : (pat == 1 ? 4 : 16);
            if (pos - j * dil >= 0) o = fmaf(pw[n], proj[(size_t)(bt - j * dil) * 3072 + 2048 + hh * 64 + lane], o);
        }
        att[(size_t)bt * D + hh * 64 + lane] = o / den;
        WAVE_SYNC();
    }
}

__device__ __forceinline__ void phase_ln_router(const Ctx& X, int layer, const float* hin, const float* mixo, const float* g, const float* bta, const float* rw, const float* rb, float* h1) {
    LAS float* hrow = (LAS float*)(X.lds + X.wave * 4096);
    const int lane = X.lane;
    const int gw = X.bid * NWAVES + X.wave, NGW = X.G * NWAVES;
    int* tok_e = (int*)(X.ws + WS_TOKE); float* tok_g = (float*)(X.ws + WS_TOKG); int* tok_r = (int*)(X.ws + WS_TOKR); int* list = (int*)(X.ws + WS_LIST);
    unsigned* cnt = X.ctl + CW_CNT + layer * 32 * 64;
    for (int bt = gw; bt < T; bt += NGW) {
        float4 v[4]; float s = 0.f;
#pragma unroll
        for (int j = 0; j < 4; ++j) {
            const float4 a = *(const float4*)(hin + (size_t)bt * D + j * 256 + lane * 4), m = *(const float4*)(mixo + (size_t)bt * D + j * 256 + lane * 4);
            v[j] = make_float4(DN_ALPHA * a.x + m.x, DN_ALPHA * a.y + m.y, DN_ALPHA * a.z + m.z, DN_ALPHA * a.w + m.w);
            s += (v[j].x + v[j].y) + (v[j].z + v[j].w);
        }
        const float mean = wave_sum(s) * (1.f / D); float s2 = 0.f;
#pragma unroll
        for (int j = 0; j < 4; ++j) { v[j].x -= mean; v[j].y -= mean; v[j].z -= mean; v[j].w -= mean; s2 += (v[j].x * v[j].x + v[j].y * v[j].y) + (v[j].z * v[j].z + v[j].w * v[j].w); }
        const float rstd = rsqrtf(wave_sum(s2) * (1.f / D) + LN_EPS);
#pragma unroll
        for (int j = 0; j < 4; ++j) {
            const float4 gg = *(const float4*)(g + j * 256 + lane * 4), bb = *(const float4*)(bta + j * 256 + lane * 4);
            float4 o = make_float4(v[j].x * rstd * gg.x + bb.x, v[j].y * rstd * gg.y + bb.y, v[j].z * rstd * gg.z + bb.z, v[j].w * rstd * gg.w + bb.w);
            *(float4*)(h1 + (size_t)bt * D + j * 256 + lane * 4) = o;
            *(LAS f32x4*)(hrow + j * 256 + lane * 4) = (f32x4){o.x, o.y, o.z, o.w};
        }
        WAVE_SYNC();
        const int e = lane & 31, half = lane >> 5;
        float acc = 0.f;
        for (int d = 0; d < 512; ++d) acc = fmaf(hrow[half * 512 + d], rw[(size_t)(half * 512 + d) * NE + e], acc);
        acc += __shfl_xor(acc, 32);
        float logit = acc + rb[e];
        float cur = logit;
        float sv0 = 0.f, sv1 = 0.f, sv2 = 0.f, sv3 = 0.f; int si0 = 0, si1 = 0, si2 = 0, si3 = 0;
#pragma unroll
        for (int k = 0; k < 4; ++k) {
            float bv = cur; int bi = e;
#pragma unroll
            for (int o = 1; o < 32; o <<= 1) { const float ov = __shfl_xor(bv, o); const int oi = __shfl_xor(bi, o); if (ov > bv || (ov == bv && oi < bi)) { bv = ov; bi = oi; } }
            if (k == 0) { sv0 = bv; si0 = bi; } else if (k == 1) { sv1 = bv; si1 = bi; } else if (k == 2) { sv2 = bv; si2 = bi; } else { sv3 = bv; si3 = bi; }
            if (e == bi) cur = -INFINITY;
        }
        const float e0 = 1.f, e1 = __expf(sv1 - sv0), e2 = __expf(sv2 - sv0), e3 = __expf(sv3 - sv0), inv = 1.f / (e0 + e1 + e2 + e3);
        if (lane < 4) {
            const int ee = lane == 0 ? si0 : lane == 1 ? si1 : lane == 2 ? si2 : si3;
            const float gg = (lane == 0 ? e0 : lane == 1 ? e1 : lane == 2 ? e2 : e3) * inv;
            const unsigned r = atomicAdd(cnt + ee * 64, 1u);
            tok_e[bt * 4 + lane] = ee; tok_g[bt * 4 + lane] = gg; tok_r[bt * 4 + lane] = (int)r;
            list[(size_t)ee * T + r] = bt * 4 + lane;
        }
        WAVE_SYNC();
    }
}

__device__ __forceinline__ void load_expert_tables(const Ctx& X, int layer, LAS int* tab) {
    __syncthreads();
    if (X.tid < 32) tab[X.tid] = (int)__hip_atomic_load(X.ctl + CW_CNT + (layer * 32 + X.tid) * 64, RLX_AGENT);
    __syncthreads();
    if (X.tid == 0) { int b = 0, tb = 0; for (int e = 0; e < 32; ++e) { tab[32 + e] = b; tab[80 + e] = tb; b += tab[e]; tb += (tab[e] + 127) >> 7; } tab[64] = b; tab[112] = tb; }
    __syncthreads();
}

__device__ __forceinline__ void phase_moe_gu(const Ctx& X, int layer, const float* h1, const float* wgu, const float* bgu, float* act) {
    LAS int* tab = (LAS int*)(X.lds + 65536);
    load_expert_tables(X, layer, tab);
    const int* list = (const int*)(X.ws + WS_LIST);
    const int ntile = tab[112], nun = ntile * 16;
    for (int u = X.bid; u < nun; u += X.G) {
        const int mtg = u >> 4, nt = u & 15;
        int e = 0; for (int q = 1; q < 32; ++q) if (tab[80 + q] <= mtg) e = q;
        const int mt = mtg - tab[80 + e], cnt = tab[e], base = tab[32 + e];
        const int mvalid = min(128, cnt - mt * 128);
        const int* le = list + (size_t)e * T + mt * 128;
        auto rp = [=](int r) { return h1 + (size_t)(le[r] >> 2) * D; };
        const float* B = wgu + ((size_t)layer * NE + e) * D * 2048;
        const float* bias = bgu + ((size_t)layer * NE + e) * 2048;
        float* out = act + (size_t)(base + mt * 128) * D;
        auto epi = [=](int r, int c, float v, float v2) {
            const float gg = fminf(v + bias[c], SW_LIMIT), lin = fminf(fmaxf(v2 + bias[1024 + c], -SW_LIMIT), SW_LIMIT);
            out[(size_t)r * D + c] = (lin + 1.0f) * (gg * sigmoidf_(SW_ALPHA * gg));
        };
        sgemm_tile<true>(X, rp, mvalid, B, 2048, nt * 64, 1024, D, epi);
    }
}
__device__ __forceinline__ void phase_moe_down(const Ctx& X, int layer, const float* act, const float* wd, const float* bd, float* Y) {
    LAS int* tab = (LAS int*)(X.lds + 65536);
    load_expert_tables(X, layer, tab);
    const int* list = (const int*)(X.ws + WS_LIST); const float* tok_g = (const float*)(X.ws + WS_TOKG);
    const int ntile = tab[112], nun = ntile * 16;
    for (int u = X.bid; u < nun; u += X.G) {
        const int mtg = u >> 4, nt = u & 15;
        int e = 0; for (int q = 1; q < 32; ++q) if (tab[80 + q] <= mtg) e = q;
        const int mt = mtg - tab[80 + e], cnt = tab[e], base = tab[32 + e];
        const int mvalid = min(128, cnt - mt * 128);
        const int* le = list + (size_t)e * T + mt * 128;
        const float* Ab = act + (size_t)(base + mt * 128) * D;
        auto rp = [=](int r) { return Ab + (size_t)r * D; };
        const float* B = wd + ((size_t)layer * NE + e) * D * D;
        const float* bias = bd + ((size_t)layer * NE + e) * D;
        float* out = Y + (size_t)(base + mt * 128) * D;
        auto epi = [=](int r, int c, float v, float v2) { out[(size_t)r * D + c] = (v + bias[c]) * tok_g[le[r]]; };
        sgemm_tile<false>(X, rp, mvalid, B, D, nt * 64, 0, D, epi);
    }
}
__device__ __forceinline__ void phase_combine_ln(const Ctx& X, int layer, const float* h1, const float* Y, const float* g, const float* bta, float* out) {
    const int lane = X.lane;
    const int gw = X.bid * NWAVES + X.wave, NGW = X.G * NWAVES;
    const int* tok_e = (const int*)(X.ws + WS_TOKE); const int* tok_r = (const int*)(X.ws + WS_TOKR);
    int basev = 0;
    { const int c = lane < 32 ? (int)__hip_atomic_load(X.ctl + CW_CNT + (layer * 32 + lane) * 64, RLX_AGENT) : 0; int incl = c;
#pragma unroll
      for (int o = 1; o < 32; o <<= 1) { const int t = __shfl_up(incl, o); if ((lane & 31) >= o) incl += t; }
      basev = incl - c; }
    for (int bt = gw; bt < T; bt += NGW) {
        int myslot = 0;
        if (lane < 4) myslot = tok_r[bt * 4 + lane];
        const int mye = lane < 4 ? tok_e[bt * 4 + lane] : 0;
        myslot += __shfl(basev, mye);
        const int s0 = __shfl(myslot, 0), s1 = __shfl(myslot, 1), s2 = __shfl(myslot, 2), s3 = __shfl(myslot, 3);
        float4 v[4]; float s = 0.f;
#pragma unroll
        for (int j = 0; j < 4; ++j) {
            const int off = j * 256 + lane * 4;
            const float4 a = *(const float4*)(h1 + (size_t)bt * D + off);
            const float4 y0 = *(const float4*)(Y + (size_t)s0 * D + off), y1 = *(const float4*)(Y + (size_t)s1 * D + off), y2 = *(const float4*)(Y + (size_t)s2 * D + off), y3 = *(const float4*)(Y + (size_t)s3 * D + off);
            v[j] = make_float4(DN_ALPHA * a.x + (((y0.x + y1.x) + y2.x) + y3.x), DN_ALPHA * a.y + (((y0.y + y1.y) + y2.y) + y3.y), DN_ALPHA * a.z + (((y0.z + y1.z) + y2.z) + y3.z), DN_ALPHA * a.w + (((y0.w + y1.w) + y2.w) + y3.w));
            s += (v[j].x + v[j].y) + (v[j].z + v[j].w);
        }
        const float mean = wave_sum(s) * (1.f / D); float s2q = 0.f;
#pragma unroll
        for (int j = 0; j < 4; ++j) { v[j].x -= mean; v[j].y -= mean; v[j].z -= mean; v[j].w -= mean; s2q += (v[j].x * v[j].x + v[j].y * v[j].y) + (v[j].z * v[j].z + v[j].w * v[j].w); }
        const float rstd = rsqrtf(wave_sum(s2q) * (1.f / D) + LN_EPS);
#pragma unroll
        for (int j = 0; j < 4; ++j) {
            const float4 gg = *(const float4*)(g + j * 256 + lane * 4), bb = *(const float4*)(bta + j * 256 + lane * 4);
            *(float4*)(out + (size_t)bt * D + j * 256 + lane * 4) = make_float4(v[j].x * rstd * gg.x + bb.x, v[j].y * rstd * gg.y + bb.y, v[j].z * rstd * gg.z + bb.z, v[j].w * rstd * gg.w + bb.w);
        }
    }
}

struct Args { const float* in[26]; float* out; unsigned char* ws; int ph_lo, ph_hi; };
constexpr int N_PHASES = 1 + DEPTH * 8;

__global__ void __launch_bounds__(NTHR, 2) mk_fwd(Args args) {
    extern __shared__ __attribute__((aligned(16))) unsigned char lds_raw[];
    Ctx X;
    X.lds = (LAS unsigned char*)lds_raw;
    X.tid = threadIdx.x; X.lane = X.tid & 63; X.wave = __builtin_amdgcn_readfirstlane(X.tid >> 6);
    X.G = gridDim.x; X.bid = blockIdx.x;
    X.ws = args.ws; X.ctl = (unsigned*)(args.ws + WS_CTL);
    volatile LAS unsigned* MISC = (volatile LAS unsigned*)(X.lds + MISC_OFF);
    if (X.tid < 32) MISC[X.tid] = 0u;
    __syncthreads();
    XcdBarrier bar; bar.bar = X.ctl + CW_BAR; bar.x = 0; bar.st = nullptr;
    if (MK_ONE_LAUNCH) bar = xcd_barrier_post(X.ctl + CW_BAR, MISC + 8);
    const int lo = args.ph_lo, hi = args.ph_hi;
#define IN(k) (lo <= (k) && (k) < hi)
#define SEAM(k) do { if (MK_ONE_LAUNCH && IN(k) && IN((k) + 1)) xcd_barrier(bar); } while (0)

    const float* x_in = args.in[0];
    float* H0 = (float*)(X.ws + WS_H0); float* H1 = (float*)(X.ws + WS_H1); float* PROJ = (float*)(X.ws + WS_PROJ);
    float* MIX = (float*)(X.ws + WS_MIX); float* MIXO = (float*)(X.ws + WS_MIXO); float* Z = (float*)(X.ws + WS_Z);
    float* ACT = (float*)(X.ws + WS_ACT); float* Y = (float*)(X.ws + WS_Y);

    if (IN(0)) { phase_prologue(X, args.in[3], args.in[4], args.in[5], args.in[6], args.in[7]); }
    SEAM(0);

    for (int layer = 0; layer < DEPTH; ++layer) {
        const int pb = 1 + layer * 8, i = layer >> 1;
        const float* hin = layer == 0 ? x_in : H0;
        float* hout = layer == DEPTH - 1 ? args.out : H0;
        if ((layer & 1) == 0) {
            if (IN(pb + 0)) { const float* W = args.in[1] + (size_t)i * D * 2048;
                auto epi = [=](int r, int c, float v) { PROJ[(size_t)r * 2048 + c] = v; };
                dense_gemm_phase(X, hin, D, T, W, 2048, D, epi); }
            SEAM(pb + 0);
            if (IN(pb + 1)) { phase_conv_s5(X, i, PROJ, args.in[2], args.in[8], args.in[9], args.in[10], MIX, Z); }
            SEAM(pb + 1);
            if (IN(pb + 2)) { const float* W = args.in[11] + (size_t)i * SSM_W * SSM_W; const float* bg = args.in[12] + (size_t)i * SSM_W;
                auto epi = [=](int r, int c, float v) { const float z = Z[(size_t)r * SSM_W + c]; MIX[(size_t)r * D + 512 + c] = z * sigmoidf_(v + bg[c]); };
                dense_gemm_phase(X, Z, SSM_W, T, W, SSM_W, SSM_W, epi); }
            SEAM(pb + 2);
            if (IN(pb + 3)) { const float* W = args.in[13] + (size_t)i * D * D;
                auto epi = [=](int r, int c, float v) { MIXO[(size_t)r * D + c] = v; };
                dense_gemm_phase(X, MIX, D, T, W, D, D, epi); }
            SEAM(pb + 3);
        } else {
            if (IN(pb + 0)) { const float* W = args.in[14] + (size_t)i * D * 3072;
                auto epi = [=](int r, int c, float v) { PROJ[(size_t)r * 3072 + c] = v; };
                dense_gemm_phase(X, hin, D, T, W, 3072, D, epi); }
            SEAM(pb + 0);
            if (IN(pb + 1)) { phase_rope(X, PROJ); }
            SEAM(pb + 1);
            if (IN(pb + 2)) { phase_attn(X, PROJ, MIX); }
            SEAM(pb + 2);
            if (IN(pb + 3)) { const float* W = args.in[15] + (size_t)i * D * D;
                auto epi = [=](int r, int c, float v) { MIXO[(size_t)r * D + c] = v; };
                dense_gemm_phase(X, MIX, D, T, W, D, D, epi); }
            SEAM(pb + 3);
        }
        if (IN(pb + 4)) { phase_ln_router(X, layer, hin, MIXO, args.in[16] + layer * D, args.in[17] + layer * D, args.in[20] + (size_t)layer * D * NE, args.in[21] + layer * NE, H1); }
        SEAM(pb + 4);
        if (IN(pb + 5)) { phase_moe_gu(X, layer, H1, args.in[22], args.in[23], ACT); }
        SEAM(pb + 5);
        if (IN(pb + 6)) { phase_moe_down(X, layer, ACT, args.in[24], args.in[25], Y); }
        SEAM(pb + 6);
        if (IN(pb + 7)) { phase_combine_ln(X, layer, H1, Y, args.in[18] + layer * D, args.in[19] + layer * D, hout); }
        SEAM(pb + 7);
    }
#undef IN
#undef SEAM
}

extern "C" void kernel_launch(void* const* d_in, const int* in_sizes, int n_in, void* d_out, int out_size, void* d_ws, size_t ws_size, hipStream_t stream) {
    static int grid = 0;
    if (grid == 0) {
        if (n_in != 26 || out_size != T * D || ws_size < WS_END) { fprintf(stderr, "kernel_launch: unexpected shapes n_in %d out %d ws %zu\n", n_in, out_size, ws_size); grid = -1; return; }
        int dev = 0, cus = 0, per_cu = 0;
        if (hipGetDevice(&dev) != hipSuccess || hipDeviceGetAttribute(&cus, hipDeviceAttributeMultiprocessorCount, dev) != hipSuccess) { grid = -1; return; }
        if (hipFuncSetAttribute((const void*)mk_fwd, hipFuncAttributeMaxDynamicSharedMemorySize, LDS_BYTES) != hipSuccess) { fprintf(stderr, "kernel_launch: hipFuncSetAttribute failed\n"); grid = -1; return; }
        if (hipOccupancyMaxActiveBlocksPerMultiprocessor(&per_cu, (const void*)mk_fwd, NTHR, LDS_BYTES) != hipSuccess || per_cu < 1) fprintf(stderr, "kernel_launch: occupancy query says %d\n", per_cu);
        (void)hipGetLastError();
        grid = cus;
    }
    if (grid < 0) return;
    if (hipMemsetAsync((char*)d_ws + WS_CTL, 0, CTL_ZERO_BYTES, stream) != hipSuccess) return;
    Args a{};
    for (int i = 0; i < 26; ++i) a.in[i] = (const float*)d_in[i];
    a.out = (float*)d_out; a.ws = (unsigned char*)d_ws;
#if MK_ONE_LAUNCH
    a.ph_lo = 0; a.ph_hi = N_PHASES;
    hipLaunchKernelGGL(mk_fwd, dim3(grid), dim3(NTHR), LDS_BYTES, stream, a);
#else
    for (int p = 0; p < N_PHASES; ++p) { a.ph_lo = p; a.ph_hi = p + 1; hipLaunchKernelGGL(mk_fwd, dim3(grid), dim3(NTHR), LDS_BYTES, stream, a); }
#endif
}
```

```cpp
#include <hip/hip_runtime.h>
#include <cstdio>
#include <cstdint>

#ifndef MK_ONE_LAUNCH
#define MK_ONE_LAUNCH 1
#endif

#define GAS __attribute__((address_space(1)))
#define LAS __attribute__((address_space(3)))
#define RLX_AGENT __ATOMIC_RELAXED, __HIP_MEMORY_SCOPE_AGENT
#define WAVE_SYNC() asm volatile("s_waitcnt lgkmcnt(0)" ::: "memory")
typedef float f32x4 __attribute__((ext_vector_type(4)));
typedef float f32x2 __attribute__((ext_vector_type(2)));
typedef unsigned u32x4 __attribute__((ext_vector_type(4)));
typedef unsigned u32x2 __attribute__((ext_vector_type(2)));
typedef unsigned short bf16_t;

constexpr int BATCH = 4, SEQ = 8192, D = 1024, T = BATCH * SEQ, DEPTH = 4;
constexpr int CONV_CH = 512, SSM_W = 512, SSM_G = 32, SSM_H = 16, SSM_P = 64;
constexpr int NH = 16, HD = 64;
constexpr int NE = 32, TOPK = 4, NA = T * TOPK;
constexpr float SW_LIMIT = 7.0f, SW_ALPHA = 1.702f;
constexpr float LN_EPS = 1e-5f;
constexpr float DN_ALPHA = 1.6817928305074290860622509524664f;
constexpr int NWAVES = 8, NTHR = 512;

constexpr size_t MiB = 1u << 20;
constexpr size_t WS_CTL = 0, CTL_ZERO_BYTES = 1 * MiB;
constexpr size_t WS_S5A = 1 * MiB;
constexpr size_t WS_S5B = 1 * MiB + 65536;
constexpr size_t WS_ROPE = 2 * MiB;
constexpr size_t WS_S5X = 48 * MiB;
constexpr size_t WS_TOKE = 4 * MiB;
constexpr size_t WS_TOKR = 4 * MiB + 524288;
constexpr size_t WS_GLIST = 8 * MiB;
constexpr size_t WS_S5S = 12 * MiB;
constexpr size_t WS_WIN = 16 * MiB;
constexpr size_t WS_WGLU = 24 * MiB;
constexpr size_t WS_WOUT = 26 * MiB;
constexpr size_t WS_WQKV = 32 * MiB;
constexpr size_t WS_WO = 44 * MiB;
constexpr size_t WS_WGU = 64 * MiB;
constexpr size_t WS_WDN = 576 * MiB;
constexpr size_t WS_H0 = 832 * MiB;
constexpr size_t WS_H1 = 896 * MiB;
constexpr size_t WS_PROJ = 960 * MiB;
constexpr size_t WS_MIX = 1152 * MiB;
constexpr size_t WS_MIXO = 1216 * MiB;
constexpr size_t WS_Z = 1280 * MiB;
constexpr size_t WS_ACT = 1312 * MiB;
constexpr size_t WS_Y = 1584 * MiB;
constexpr size_t WS_XG = 1856 * MiB;
constexpr size_t WS_END = 3904 * MiB;
constexpr int CW_BAR = 4096;
constexpr int CW_CNT = 16384;

constexpr int LDS_BYTES = 147456;
constexpr int MISC_OFF = 131072 + 320;
constexpr int TAB_OFF = 131072 + 1024;

#define XB_TMO      128
#define XB_XCNT(j)  (256  + 64 * (j))
#define XB_XSUB(j)  (1280 + 64 * (j))
#define XB_XGEN(j)  (2304 + 64 * (j))
#define XB_TOP      3328
#define XB_TOPGEN   3392
#define XCD_BAR_WORDS 3456
#define XB_SPIN_CAP (1u << 22)

__device__ __forceinline__ unsigned xb_ld(unsigned* p)              { return __hip_atomic_load(p, __ATOMIC_RELAXED, __HIP_MEMORY_SCOPE_AGENT); }
__device__ __forceinline__ unsigned xb_add(unsigned* p, unsigned v) { return __hip_atomic_fetch_add(p, v, __ATOMIC_RELAXED, __HIP_MEMORY_SCOPE_AGENT); }
__device__ __forceinline__ unsigned xb_xcc_id() { return (unsigned)__builtin_amdgcn_s_getreg((3 << 11) | 20) & 0xFu; }
#define XB_SPIN(cond, bar) do { unsigned _sp = 0; while (cond) { __builtin_amdgcn_s_sleep(1); \
    if ((++_sp & 255u) == 0u) { if (xb_ld(&(bar)[XB_TMO])) break; if (_sp > XB_SPIN_CAP) { atomicAdd(&(bar)[XB_TMO], 1u); break; } } } } while (0)

struct XcdBarrier { unsigned* bar; unsigned x; volatile LAS unsigned* st; };

__device__ __forceinline__ XcdBarrier xcd_barrier_post(unsigned* bar, volatile LAS unsigned* st) {
    XcdBarrier b; b.bar = bar; b.x = xb_xcc_id(); b.st = st;
    if (threadIdx.x == 0) (void)xb_add(&bar[XB_XCNT(b.x)], 1u);
    return b;
}
__device__ __forceinline__ void xcd_barrier_complete(unsigned* bar, unsigned x, unsigned& nloc, unsigned& nx) {
    const unsigned G = gridDim.x * gridDim.y * gridDim.z;
    unsigned sum, cnt, mine, sp = 0u;
    for (;;) {
        sum = 0u; cnt = 0u; mine = 0u;
#pragma unroll
        for (unsigned j = 0; j < 16; ++j) { const unsigned c = xb_ld(&bar[XB_XCNT(j)]); sum += c; cnt += (c > 0u) ? 1u : 0u; mine = (j == x) ? c : mine; }
        if (sum == G) break;
        __builtin_amdgcn_s_sleep(1);
        if ((++sp & 255u) == 0u) { if (xb_ld(&bar[XB_TMO])) break; if (sp > XB_SPIN_CAP) { atomicAdd(&bar[XB_TMO], 1u); break; } }
    }
    nloc = mine > 0u ? mine : 1u; nx = cnt > 0u ? cnt : 1u;
}
__device__ __forceinline__ void xcd_barrier(const XcdBarrier& b) {
    asm volatile("s_waitcnt vmcnt(0)" ::: "memory");
    __syncthreads();
    if (threadIdx.x == 0) {
        unsigned* bar = b.bar;
        __builtin_amdgcn_s_waitcnt(0);
        unsigned nloc = b.st[0], nx = b.st[1];
        if (nloc == 0u) { xcd_barrier_complete(bar, b.x, nloc, nx); b.st[0] = nloc; b.st[1] = nx; }
        const unsigned old = xb_add(&bar[XB_XSUB(b.x)], 1u);
        const unsigned gen = old / nloc;
        if (old + 1u == (gen + 1u) * nloc) {
            __builtin_amdgcn_fence(__ATOMIC_RELEASE, "agent");
            asm volatile("s_waitcnt vmcnt(0)" ::: "memory");
            const unsigned og = xb_add(&bar[XB_TOP], 1u);
            const unsigned tg = og / nx;
            if (og + 1u == (tg + 1u) * nx) xb_add(&bar[XB_TOPGEN], 1u);
            else XB_SPIN(xb_ld(&bar[XB_TOPGEN]) == tg, bar);
            __builtin_amdgcn_fence(__ATOMIC_ACQUIRE, "agent");
            xb_add(&bar[XB_XGEN(b.x)], 1u);
            asm volatile("s_waitcnt vmcnt(0)" ::: "memory");
        } else {
            XB_SPIN(xb_ld(&bar[XB_XGEN(b.x)]) == gen, bar);
            __builtin_amdgcn_fence(__ATOMIC_ACQUIRE, "agent");
            asm volatile("s_waitcnt vmcnt(0)" ::: "memory");
        }
    }
    __syncthreads();
}

__device__ __forceinline__ float wave_sum(float v) {
#pragma unroll
    for (int o = 1; o < 64; o <<= 1) v += __shfl_xor(v, o);
    return v;
}
__device__ __forceinline__ float wave_max(float v) {
#pragma unroll
    for (int o = 1; o < 64; o <<= 1) v = fmaxf(v, __shfl_xor(v, o));
    return v;
}
__device__ __forceinline__ float sigmoidf_(float x) { return __builtin_amdgcn_rcpf(1.0f + __builtin_amdgcn_exp2f(-1.4426950408889634f * x)); }
__device__ __forceinline__ float gelu_tanh(float y) { return 0.5f * y * (1.0f + tanhf(0.7978845608028654f * (y + 0.044715f * y * y * y))); }
__device__ __forceinline__ unsigned f2bf(float f) { unsigned u = __builtin_bit_cast(unsigned, f); return (u + 0x7fffu + ((u >> 16) & 1u)) >> 16; }
__device__ __forceinline__ unsigned pk2(float lo, float hi) { return f2bf(lo) | (f2bf(hi) << 16); }
typedef float f32x2_t_ __attribute__((ext_vector_type(2))); typedef __bf16 bf16x2_t_ __attribute__((ext_vector_type(2)));
__device__ __forceinline__ unsigned cvt_pk_bf16(float lo, float hi) { const f32x2_t_ v = {lo, hi}; const bf16x2_t_ b = __builtin_convertvector(v, bf16x2_t_); return __builtin_bit_cast(unsigned, b); }
__device__ __forceinline__ float bf_lo(unsigned w) { return __builtin_bit_cast(float, w << 16); }
__device__ __forceinline__ float bf_hi(unsigned w) { return __builtin_bit_cast(float, w & 0xffff0000u); }
__device__ __forceinline__ float bf2f(bf16_t b) { return __builtin_bit_cast(float, ((unsigned)b) << 16); }
__device__ __forceinline__ void unpack8(const u32x4 w, float (&f)[8]) { f[0] = bf_lo(w.x); f[1] = bf_hi(w.x); f[2] = bf_lo(w.y); f[3] = bf_hi(w.y); f[4] = bf_lo(w.z); f[5] = bf_hi(w.z); f[6] = bf_lo(w.w); f[7] = bf_hi(w.w); }
__device__ __forceinline__ u32x4 pack8(const float (&f)[8]) { u32x4 w; w.x = cvt_pk_bf16(f[0], f[1]); w.y = cvt_pk_bf16(f[2], f[3]); w.z = cvt_pk_bf16(f[4], f[5]); w.w = cvt_pk_bf16(f[6], f[7]); return w; }

struct Ctx {
    LAS unsigned char* lds;
    int tid, lane, wave, G, bid;
    unsigned* ctl;
    unsigned char* ws;
};

namespace pg8 {
#define PG8_LAS __attribute__((address_space(3)))
typedef short bf16x8 __attribute__((ext_vector_type(8)));
constexpr int BM = 256, BK = 64, HALF = 128, HTB = HALF * BK * 2  , STAGE_BYTES = 8 * HTB, NXCD = 8, WGM = 8;

__host__ __device__ __forceinline__ int lds_byte(int r, int c) { const int st = (r >> 4) * 2 + (c >> 5), rr = r & 15, cc = c & 31, ob = rr * 64 + cc * 2; return st * 1024 + (ob ^ (((ob >> 9) & 1) << 5)); }
__host__ __device__ __forceinline__ void stage_rc(int b, int& R, int& C) { const int st = b / 1024, sb = b % 1024, swz = sb ^ (((sb >> 9) & 1) << 5); R = (st >> 1) * 16 + swz / 64; C = (st & 1) * 32 + (swz % 64) / 2; }
__host__ __device__ __forceinline__ int perm32(int rho) { const int n = rho >> 4, i = rho & 15; return 8 * (i >> 2) + 4 * n + (i & 3); }

struct Unit { int pm, pn, e, mt; };
struct Gemm { const bf16_t* A; const bf16_t* Bt; int M, N, K; };

struct StaticOrder {
    int nM, nN, nwg, G, c; size_t tstep;
    __device__ void init(int M, int N, int K, int G_, int c_) { nM = M / BM; nN = N / BM; nwg = nM * nN; G = G_; c = c_; tstep = (size_t)BM * K * 2; }
    __device__ bool next(int i, Unit& u) const {
        const long L = (long)i * G + c; if (L >= nwg) return false;
        int wgid = (int)L; { const int q = nwg / NXCD, r = nwg % NXCD, xcd = wgid % NXCD, off = wgid / NXCD; wgid = (xcd < r ? xcd * (q + 1) : r * (q + 1) + (xcd - r) * q) + off; }
        const int nig = WGM * nN, gid = wgid / nig, fm = gid * WGM, gsz = (nM - fm) < WGM ? (nM - fm) : WGM;
        u.pm = fm + ((wgid % nig) % gsz); u.pn = (wgid % nig) / gsz; u.e = 0; u.mt = 0; return true;
    }
    __device__ __forceinline__ size_t a_off(const Unit& u) const { return (size_t)u.pm * tstep; }
    __device__ __forceinline__ size_t b_off(const Unit& u) const { return (size_t)u.pn * tstep; }
    __device__ __forceinline__ void a_ready(const Unit&) const {}
    __device__ __forceinline__ void done(const Unit&) const {}
};
template <int NPN, bool A_IS_XG> struct MoeOrder {
    const PG8_LAS int* tb; int G, c, ntile; size_t bexp;
    __device__ void init(const PG8_LAS int* tb_, int G_, int c_, int Nexp, int K) { tb = tb_; G = G_; c = c_; ntile = tb_[32]; bexp = (size_t)Nexp * K * 2; }
    __device__ bool next(int i, Unit& u) const {
        int mtg, pn;
        if (G == 256) { constexpr int MPR = 256 / NPN, MPX = MPR / 8; mtg = MPR * i + MPX * (c & 7) + (c >> 3) / NPN; pn = (c >> 3) % NPN; }
        else { const long L = (long)i * G + c; mtg = (int)(L / NPN); pn = (int)(L % NPN); }
        if (mtg >= ntile) return false;
        int e = 0;
        for (int q = 1; q < 32; ++q) if (tb[q] <= mtg) e = q;
        u.pm = mtg; u.pn = pn; u.e = e; u.mt = mtg - tb[e]; return true;
    }
    __device__ __forceinline__ size_t a_off(const Unit& u) const { return A_IS_XG ? ((size_t)u.e * T + (size_t)u.mt * BM) * (D * 2) : (size_t)u.pm * BM * (D * 2); }
    __device__ __forceinline__ size_t b_off(const Unit& u) const { return (size_t)u.e * bexp + (size_t)u.pn * BM * (D * 2); }
    __device__ __forceinline__ void a_ready(const Unit&) const {}
    __device__ __forceinline__ void done(const Unit&) const {}
};

__device__ __forceinline__ u32x4 pack_v(const f32x4 v0, const f32x4 v1) { u32x4 w; w.x = cvt_pk_bf16(v0[0], v0[1]); w.y = cvt_pk_bf16(v0[2], v0[3]); w.z = cvt_pk_bf16(v1[0], v1[1]); w.w = cvt_pk_bf16(v1[2], v1[3]); return w; }

struct EpiStore {
    static constexpr bool PERM = true, AFTER_DRAIN = false;
    bf16_t* O; int ldc;
    __device__ __forceinline__ void operator()(const f32x4 (&acc)[2][2][4][2], const Unit& u, int wr, int wc, int fr, int fq) const {
        const int row0 = u.pm * BM + wr * 64 + fr, col0 = u.pn * BM + wc * 32 + 8 * fq;
#pragma unroll
        for (int ai = 0; ai < 2; ++ai)
#pragma unroll
            for (int m = 0; m < 4; ++m) { bf16_t* rowp = O + (size_t)(row0 + ai * HALF + m * 16) * ldc + col0;
#pragma unroll
                for (int bj = 0; bj < 2; ++bj) *(u32x4*)(rowp + bj * HALF) = pack_v(acc[ai][bj][m][0], acc[ai][bj][m][1]); }
    }
};
struct EpiGlu {
    static constexpr bool PERM = true, AFTER_DRAIN = false;
    const bf16_t* Z; bf16_t* MIX; const float* bias;
    __device__ __forceinline__ void operator()(const f32x4 (&acc)[2][2][4][2], const Unit& u, int wr, int wc, int fr, int fq) const {
        const int row0 = u.pm * BM + wr * 64 + fr, col0 = u.pn * BM + wc * 32 + 8 * fq;
        f32x4 bv[2][2];
#pragma unroll
        for (int bj = 0; bj < 2; ++bj)
#pragma unroll
            for (int n = 0; n < 2; ++n) bv[bj][n] = *(const f32x4*)(bias + col0 + bj * HALF + 4 * n);
#pragma unroll
        for (int ai = 0; ai < 2; ++ai)
#pragma unroll
            for (int m = 0; m < 4; ++m) { const size_t row = (size_t)(row0 + ai * HALF + m * 16);
#pragma unroll
                for (int bj = 0; bj < 2; ++bj) {
                    const u32x4 zw = *(const u32x4*)(Z + row * SSM_W + col0 + bj * HALF); float z[8]; unpack8(zw, z);
                    const f32x4 a0 = acc[ai][bj][m][0] + bv[bj][0], a1 = acc[ai][bj][m][1] + bv[bj][1];
                    float o[8];
#pragma unroll
                    for (int j = 0; j < 4; ++j) { o[j] = z[j] * sigmoidf_(a0[j]); o[4 + j] = z[4 + j] * sigmoidf_(a1[j]); }
                    *(u32x4*)(MIX + row * D + 512 + col0 + bj * HALF) = pack8(o); } }
    }
};
struct EpiRope {
    static constexpr bool PERM = true, AFTER_DRAIN = false;
    bf16_t* O; const f32x2* rope;
    __device__ __forceinline__ void operator()(const f32x4 (&acc)[2][2][4][2], const Unit& u, int wr, int wc, int fr, int fq) const {
        const int part = u.pn >> 2, tp = u.pn & 3;
        const int row0 = u.pm * BM + wr * 64 + fr, colb = part * 1024 + (4 * tp + wc) * 64 + 8 * fq;
        const float qs = part == 0 ? 0.125f * 1.4426950408889634f : 1.0f;
#pragma unroll
        for (int ai = 0; ai < 2; ++ai)
#pragma unroll
            for (int m = 0; m < 4; ++m) { const int row = row0 + ai * HALF + m * 16; bf16_t* rowp = O + (size_t)row * 3072 + colb;
                const f32x4 x1a = acc[ai][0][m][0], x1b = acc[ai][0][m][1], x2a = acc[ai][1][m][0], x2b = acc[ai][1][m][1];
                if (part < 2) {
                    const f32x4* rp = (const f32x4*)(rope + (size_t)(row & (SEQ - 1)) * 32 + 8 * fq);
                    const f32x4 c01 = rp[0], c23 = rp[1], c45 = rp[2], c67 = rp[3];
                    float o1[8], o2[8];
                    const float cs[8] = {c01[0], c01[2], c23[0], c23[2], c45[0], c45[2], c67[0], c67[2]}, sn[8] = {c01[1], c01[3], c23[1], c23[3], c45[1], c45[3], c67[1], c67[3]};
                    const float x1[8] = {x1a[0], x1a[1], x1a[2], x1a[3], x1b[0], x1b[1], x1b[2], x1b[3]}, x2[8] = {x2a[0], x2a[1], x2a[2], x2a[3], x2b[0], x2b[1], x2b[2], x2b[3]};
#pragma unroll
                    for (int j = 0; j < 8; ++j) { o1[j] = (x1[j] * cs[j] - x2[j] * sn[j]) * qs; o2[j] = (x2[j] * cs[j] + x1[j] * sn[j]) * qs; }
                    *(u32x4*)(rowp) = pack8(o1); *(u32x4*)(rowp + 32) = pack8(o2);
                } else { *(u32x4*)(rowp) = pack_v(x1a, x1b); *(u32x4*)(rowp + 32) = pack_v(x2a, x2b); } }
    }
};
struct EpiSwiglu {
    static constexpr bool PERM = true, AFTER_DRAIN = false;
    bf16_t* ACT; const float* bgu;
    __device__ __forceinline__ void operator()(const f32x4 (&acc)[2][2][4][2], const Unit& u, int wr, int wc, int fr, int fq) const {
        const int row0 = u.pm * BM + wr * 64 + fr, j0 = u.pn * 128 + wc * 32 + 8 * fq;
        const float* bb = bgu + (size_t)u.e * 2048 + j0;
        const f32x4 bg0 = *(const f32x4*)(bb), bg1 = *(const f32x4*)(bb + 4), bl0 = *(const f32x4*)(bb + 1024), bl1 = *(const f32x4*)(bb + 1028);
#pragma unroll
        for (int ai = 0; ai < 2; ++ai)
#pragma unroll
            for (int m = 0; m < 4; ++m) { const size_t row = (size_t)(row0 + ai * HALF + m * 16);
                const f32x4 g0 = acc[ai][0][m][0] + bg0, g1 = acc[ai][0][m][1] + bg1, l0 = acc[ai][1][m][0] + bl0, l1 = acc[ai][1][m][1] + bl1;
                float o[8];
#pragma unroll
                for (int j = 0; j < 4; ++j) {
                    const float ga = fminf(g0[j], SW_LIMIT), gb = fminf(g1[j], SW_LIMIT);
                    const float la = fminf(fmaxf(l0[j], -SW_LIMIT), SW_LIMIT), lb = fminf(fmaxf(l1[j], -SW_LIMIT), SW_LIMIT);
                    o[j] = (la + 1.0f) * (ga * sigmoidf_(SW_ALPHA * ga)); o[4 + j] = (lb + 1.0f) * (gb * sigmoidf_(SW_ALPHA * gb)); }
                *(u32x4*)(ACT + row * D + j0) = pack8(o); }
    }
};
struct EpiDown {
    static constexpr bool PERM = true, AFTER_DRAIN = false;
    bf16_t* Y; const float* bd; const float* glist;
    __device__ __forceinline__ void operator()(const f32x4 (&acc)[2][2][4][2], const Unit& u, int wr, int wc, int fr, int fq) const {
        const int rl0 = wr * 64 + fr, col0 = u.pn * BM + wc * 32 + 8 * fq;
        const float* bb = bd + (size_t)u.e * D + col0; const float* gl = glist + (size_t)u.e * T + (size_t)u.mt * BM + rl0;
        bf16_t* yb = Y + ((size_t)u.pm * BM + rl0) * D + col0;
#pragma unroll
        for (int bj = 0; bj < 2; ++bj) {
            const f32x4 b0 = *(const f32x4*)(bb + bj * HALF), b1 = *(const f32x4*)(bb + bj * HALF + 4);
#pragma unroll
            for (int ai = 0; ai < 2; ++ai)
#pragma unroll
                for (int m = 0; m < 4; ++m) { const int rl = ai * HALF + m * 16; const float gt = gl[rl];
                    *(u32x4*)(yb + (size_t)rl * D + bj * HALF) = pack_v((acc[ai][bj][m][0] + b0) * gt, (acc[ai][bj][m][1] + b1) * gt); }
        }
    }
};

template <class Epi, class Sched, bool ALIGN_EPI = false, bool SP2 = false>
__device__ __forceinline__ void gemm_phase(PG8_LAS unsigned char* lds, const Gemm g, const Sched& S, const Epi& E) {
    int tid = threadIdx.x; asm volatile("" : "+v"(tid)); const int wid = __builtin_amdgcn_readfirstlane(tid >> 6), lane = tid & 63, wr = wid >> 2, wc = wid & 3, fr = lane & 15, fq = lane >> 4;
    const int K = g.K, nt = K / BK;
    unsigned voffA[2], voffB[2];
#pragma unroll
    for (int i = 0; i < 2; ++i) { int R, C; stage_rc(tid * 16 + i * 8192, R, C); const int Rb = Epi::PERM ? ((R & ~31) + perm32(R & 31)) : R;
        voffA[i] = (unsigned)(R * K + C) * 2u; voffB[i] = (unsigned)(Rb * K + C) * 2u; }
    const size_t kstep = (size_t)(BK * 2);
    const size_t hstep = (size_t)HALF * K * 2;
    const unsigned ldsw = (unsigned)wid * 1024u;
    const int aoff = lds_byte(wr * 64 + fr, fq * 8), boff = lds_byte(wc * 32 + fr, fq * 8);
#define PG8_SA(b, h) (((b) * 2 + (h)) * HTB)
#define PG8_SB(b, h) ((4 + (b) * 2 + (h)) * HTB)
#define PG8_STAGE(bufoff, gbase, voff) do { _Pragma("unroll") for (int _i = 0; _i < 2; ++_i) \
        __builtin_amdgcn_global_load_lds((const unsigned*)((const char*)(gbase) + (voff)[_i]), (PG8_LAS unsigned*)(lds + (bufoff) + ldsw + _i * 8192), 16, 0, 0); } while (0)
#define PG8_LDA(dst, b, h) do { _Pragma("unroll") for (int m = 0; m < 4; ++m) _Pragma("unroll") for (int k = 0; k < 2; ++k) dst[m][k] = *(const PG8_LAS bf16x8*)(lds + PG8_SA(b, h) + aoff + m * 2048 + k * 1024); } while (0)
#define PG8_LDB(dst, b, h) do { _Pragma("unroll") for (int n = 0; n < 2; ++n) _Pragma("unroll") for (int k = 0; k < 2; ++k) dst[n][k] = *(const PG8_LAS bf16x8*)(lds + PG8_SB(b, h) + boff + n * 2048 + k * 1024); } while (0)
#define PG8_MMA(ai, bj, At, Bt) do { __builtin_amdgcn_s_setprio(1); _Pragma("unroll") for (int m = 0; m < 4; ++m) _Pragma("unroll") for (int n = 0; n < 2; ++n) _Pragma("unroll") for (int k = 0; k < 2; ++k) \
        acc[ai][bj][m][n] = __builtin_amdgcn_mfma_f32_16x16x32_bf16(Bt[n][k], At[m][k], acc[ai][bj][m][n], 0, 0, 0); __builtin_amdgcn_s_setprio(0); } while (0)
#define PG8_WAIT_V(n) asm volatile("s_waitcnt vmcnt(" #n ")" ::: "memory")
#define PG8_WAIT_L(n) asm volatile("s_waitcnt lgkmcnt(" #n ")" ::: "memory")
#define PG8_BAR __builtin_amdgcn_s_barrier()
#define PG8_SCHED __builtin_amdgcn_sched_barrier(0)
    Unit cur, nxt; int ui = 0;
    if (!S.next(0, cur)) return;
    f32x4 acc[2][2][4][2];
#pragma unroll
    for (int a = 0; a < 2; ++a)
#pragma unroll
        for (int b = 0; b < 2; ++b)
#pragma unroll
            for (int m = 0; m < 4; ++m)
#pragma unroll
                for (int n = 0; n < 2; ++n) acc[a][b][m][n] = (f32x4){0.f, 0.f, 0.f, 0.f};
    bf16x8 At[4][2], B0[2][2], B1[2][2];
    const char* cA = (const char*)g.A + S.a_off(cur); const char* cB = (const char*)g.Bt + S.b_off(cur);
    S.a_ready(cur);
    if constexpr (SP2) {
        PG8_STAGE(PG8_SB(0, 0), cB, voffB); PG8_STAGE(PG8_SB(0, 1), cB + hstep, voffB); PG8_STAGE(PG8_SA(0, 0), cA, voffA); PG8_STAGE(PG8_SA(0, 1), cA + hstep, voffA);
        if (wr == 1) PG8_BAR;
        PG8_WAIT_V(2); PG8_BAR;
        PG8_STAGE(PG8_SB(1, 0), cB + kstep, voffB); PG8_STAGE(PG8_SA(1, 0), cA + kstep, voffA); PG8_STAGE(PG8_SB(1, 1), cB + hstep + kstep, voffB);
        PG8_WAIT_V(6); PG8_BAR;
    } else {
        PG8_STAGE(PG8_SB(0, 0), cB, voffB); PG8_STAGE(PG8_SA(0, 0), cA, voffA); PG8_STAGE(PG8_SB(0, 1), cB + hstep, voffB); PG8_STAGE(PG8_SA(0, 1), cA + hstep, voffA);
        if (wr == 1) PG8_BAR;
        PG8_WAIT_V(4); PG8_BAR;
        PG8_STAGE(PG8_SB(1, 0), cB + kstep, voffB); PG8_STAGE(PG8_SA(1, 0), cA + kstep, voffA); PG8_STAGE(PG8_SB(1, 1), cB + hstep + kstep, voffB);
        PG8_WAIT_V(6); PG8_BAR;
    }
    for (;;) {
        const bool has_next = S.next(ui + 1, nxt);
        const char* nA = has_next ? (const char*)g.A + S.a_off(nxt) : cA; const char* nB = has_next ? (const char*)g.Bt + S.b_off(nxt) : cB;
        for (int t = 0; t < nt; t += 2) {
            const bool last = (t == nt - 2);
            const char* a1 = cA + (size_t)(t + 1) * kstep;
            const char* a2 = last ? nA : cA + (size_t)(t + 2) * kstep; const char* b2 = last ? nB : cB + (size_t)(t + 2) * kstep;
            const char* a3 = a2 + kstep; const char* b3 = b2 + kstep;
            if (last && has_next) S.a_ready(nxt);
            if constexpr (SP2) {
            PG8_LDB(B0, 0, 0); PG8_LDB(B1, 0, 1); PG8_SCHED; PG8_LDA(At, 0, 0); PG8_STAGE(PG8_SA(1, 1), a1 + hstep, voffA);
            PG8_WAIT_V(8); PG8_WAIT_L(0); PG8_BAR; PG8_MMA(0, 0, At, B0); PG8_MMA(0, 1, At, B1); PG8_BAR; PG8_SCHED;
            PG8_LDA(At, 0, 1); PG8_STAGE(PG8_SB(0, 0), b2, voffB); PG8_STAGE(PG8_SB(0, 1), b2 + hstep, voffB); PG8_STAGE(PG8_SA(0, 0), a2, voffA);
            PG8_WAIT_V(8); PG8_WAIT_L(0); PG8_BAR; PG8_MMA(1, 0, At, B0); PG8_MMA(1, 1, At, B1); PG8_BAR; PG8_SCHED;
            PG8_LDB(B0, 1, 0); PG8_LDB(B1, 1, 1); PG8_SCHED; PG8_LDA(At, 1, 0); PG8_STAGE(PG8_SA(0, 1), a2 + hstep, voffA);
            PG8_WAIT_V(8); PG8_WAIT_L(0); PG8_BAR; PG8_MMA(0, 0, At, B0); PG8_MMA(0, 1, At, B1); PG8_BAR; PG8_SCHED;
            PG8_LDA(At, 1, 1); PG8_STAGE(PG8_SB(1, 0), b3, voffB); PG8_STAGE(PG8_SB(1, 1), b3 + hstep, voffB); PG8_STAGE(PG8_SA(1, 0), a3, voffA);
            PG8_WAIT_V(8); PG8_WAIT_L(0); PG8_BAR; PG8_MMA(1, 0, At, B0); PG8_MMA(1, 1, At, B1); PG8_BAR; PG8_SCHED;
            } else {
            PG8_LDB(B0, 0, 0); PG8_SCHED; PG8_LDA(At, 0, 0); PG8_STAGE(PG8_SA(1, 1), a1 + hstep, voffA);
            PG8_WAIT_L(8); PG8_BAR; PG8_WAIT_L(0); PG8_MMA(0, 0, At, B0); PG8_BAR; PG8_SCHED;
            PG8_LDB(B1, 0, 1); PG8_STAGE(PG8_SB(0, 0), b2, voffB);
            PG8_BAR; PG8_WAIT_L(0); PG8_MMA(0, 1, At, B1); PG8_BAR;
            PG8_LDA(At, 0, 1); PG8_STAGE(PG8_SA(0, 0), a2, voffA);
            PG8_BAR; PG8_WAIT_L(0); PG8_MMA(1, 0, At, B0); PG8_BAR; PG8_SCHED;
            PG8_STAGE(PG8_SB(0, 1), b2 + hstep, voffB);
            PG8_WAIT_V(6); PG8_BAR; PG8_MMA(1, 1, At, B1); PG8_BAR;
            PG8_LDB(B0, 1, 0); PG8_SCHED; PG8_LDA(At, 1, 0); PG8_STAGE(PG8_SA(0, 1), a2 + hstep, voffA);
            PG8_WAIT_L(8); PG8_BAR; PG8_WAIT_L(0); PG8_MMA(0, 0, At, B0); PG8_BAR; PG8_SCHED;
            PG8_LDB(B1, 1, 1); PG8_STAGE(PG8_SB(1, 0), b3, voffB);
            PG8_BAR; PG8_WAIT_L(0); PG8_MMA(0, 1, At, B1); PG8_BAR;
            PG8_LDA(At, 1, 1); PG8_STAGE(PG8_SA(1, 0), a3, voffA);
            PG8_BAR; PG8_WAIT_L(0); PG8_MMA(1, 0, At, B0); PG8_BAR; PG8_SCHED;
            PG8_STAGE(PG8_SB(1, 1), b3 + hstep, voffB);
            PG8_WAIT_V(6); PG8_BAR; PG8_MMA(1, 1, At, B1); PG8_BAR;
            }
        }
        if constexpr (ALIGN_EPI) { if (wr == 0) PG8_BAR; }
        if constexpr (!Epi::AFTER_DRAIN) { E(acc, cur, wr, wc, fr, fq); S.done(cur); }
        if (!has_next) break;
#pragma unroll
        for (int a = 0; a < 2; ++a)
#pragma unroll
            for (int b = 0; b < 2; ++b)
#pragma unroll
                for (int m = 0; m < 4; ++m)
#pragma unroll
                    for (int n = 0; n < 2; ++n) acc[a][b][m][n] = (f32x4){0.f, 0.f, 0.f, 0.f};
        cur = nxt; cA = nA; cB = nB; ++ui;
        if constexpr (ALIGN_EPI) { if (wr == 1) PG8_BAR; }
    }
    PG8_WAIT_V(0);
    if constexpr (!ALIGN_EPI) { if (wr == 0) PG8_BAR; }
    PG8_BAR;
    if constexpr (Epi::AFTER_DRAIN) { E.fused(acc, cur, wr, wc, fr, fq, lds, wid, lane); S.done(cur); }
#undef PG8_SA
#undef PG8_SB
#undef PG8_STAGE
#undef PG8_LDA
#undef PG8_LDB
#undef PG8_MMA
#undef PG8_WAIT_V
#undef PG8_WAIT_L
#undef PG8_BAR
#undef PG8_SCHED
}
}

template <int MODE>
__device__ __forceinline__ void transpose_item(const float* W, int K, int N, bf16_t* WT, LAS float* scr, int item, int lane) {
    const int nblk = N / 32, kb = item / nblk, nb = item % nblk, k0 = 64 * kb, n0 = 32 * nb;
    int dr = n0;
    if (MODE == 1) { const int j = n0 & 1023, half = n0 >> 10; dr = 256 * (j >> 7) + 128 * half + (j & 127); }
    if (MODE == 2) { const int part = n0 >> 10, c = n0 & 1023, head = c >> 6, half = (c >> 5) & 1; dr = part * 1024 + (head >> 2) * 256 + half * 128 + (head & 3) * 32; }
#pragma unroll 8
    for (int i = 0; i < 32; ++i) { const int kk = 2 * i + (lane >> 5); scr[kk * 33 + (lane & 31)] = W[(size_t)(k0 + kk) * N + n0 + (lane & 31)]; }
    WAVE_SYNC();
    const int c = lane & 7;
#pragma unroll
    for (int j = 0; j < 4; ++j) { const int n = (lane >> 3) + 8 * j; const LAS float* s = scr + (8 * c) * 33 + n;
        u32x4 o; o.x = pk2(s[0 * 33], s[1 * 33]); o.y = pk2(s[2 * 33], s[3 * 33]); o.z = pk2(s[4 * 33], s[5 * 33]); o.w = pk2(s[6 * 33], s[7 * 33]);
        *(u32x4*)(WT + (size_t)(dr + n) * K + k0 + 8 * c) = o; }
    WAVE_SYNC();
}

__device__ __forceinline__ const float* ld_ptr(volatile LAS unsigned long long* t, int k) {
    const unsigned long long v = t[k]; const unsigned lo = __builtin_amdgcn_readfirstlane((unsigned)v), hi = __builtin_amdgcn_readfirstlane((unsigned)(v >> 32));
    return (const float*)(const GAS float*)(((unsigned long long)hi << 32) | lo);
}
__device__ __forceinline__ void phase_prologue(const Ctx& X, volatile LAS unsigned long long* ptab) {
#define in_(k) ld_ptr(ptab, k)
    const float* a_re = in_(3); const float* a_im = in_(4); const float* log_dt = in_(5); const float* b_re = in_(6); const float* b_im = in_(7);
    float2* Abar = (float2*)(X.ws + WS_S5A); float2* Bbar = (float2*)(X.ws + WS_S5B); float2* rope = (float2*)(X.ws + WS_ROPE);
    const int gt = X.bid * NTHR + X.tid, NT = X.G * NTHR;
    for (int it = gt; it < 2 * SSM_G * SSM_P; it += NT) {
        const int ig = it >> 6;
        const double lam_re = fmin((double)a_re[it], -1e-4), lam_im = (double)a_im[it];
        const double dt = exp((double)log_dt[ig]);
        const double mag = exp(lam_re * dt), ang = lam_im * dt;
        const double abr = mag * cos(ang), abi = mag * sin(ang);
        const double nr = abr - 1.0, ni = abi, den = lam_re * lam_re + lam_im * lam_im;
        const double cr = (nr * lam_re + ni * lam_im) / den, ci = (ni * lam_re - nr * lam_im) / den;
        Abar[it] = make_float2((float)abr, (float)abi);
        for (int h = 0; h < SSM_H; ++h) {
            const double br = (double)b_re[it * 16 + h], bi = (double)b_im[it * 16 + h];
            Bbar[it * 16 + h] = make_float2((float)(cr * br - ci * bi), (float)(cr * bi + ci * br));
        }
    }
    for (int it = gt; it < SEQ * 32; it += NT) {
        const int pos = it >> 5, i = it & 31;
        const float inv = powf(10000.0f, -(float)i / 32.0f);
        const float ang = (float)pos * inv;
        rope[it] = make_float2((float)cos((double)ang), (float)sin((double)ang));
    }
    { const float* x = in_(0); bf16_t* H0 = (bf16_t*)(X.ws + WS_H0);
      const size_t n8 = (size_t)T * D / 8;
      for (size_t i8 = (size_t)gt; i8 < n8; i8 += (size_t)NT) {
          const f32x4 a = *(const f32x4*)(x + i8 * 8), b = *(const f32x4*)(x + i8 * 8 + 4);
          u32x4 o; o.x = pk2(a[0], a[1]); o.y = pk2(a[2], a[3]); o.z = pk2(b[0], b[1]); o.w = pk2(b[2], b[3]);
          *(u32x4*)(H0 + i8 * 8) = o; } }
    LAS float* scr = (LAS float*)(X.lds + X.wave * 16384);
    const int gw = X.bid * NWAVES + X.wave, NGW = X.G * NWAVES;
    constexpr int I_GU = 16 * 64, I_DN = 16 * 32, I_IN = 16 * 64, I_GLU = 8 * 16, I_OUT = 16 * 32, I_QKV = 16 * 96, I_O = 16 * 32;
    constexpr int N_GU = 128 * I_GU, N_DN = 128 * I_DN, N_IN = 2 * I_IN, N_GLU = 2 * I_GLU, N_OUT = 2 * I_OUT, N_QKV = 2 * I_QKV, N_O = 2 * I_O;
    constexpr int NITEMS = N_GU + N_DN + N_IN + N_GLU + N_OUT + N_QKV + N_O;
    for (int it = gw; it < NITEMS; it += NGW) {
        int r = it;
        if (r < N_GU) { const int m = r / I_GU; transpose_item<1>(in_(22) + (size_t)m * D * 2048, D, 2048, (bf16_t*)(X.ws + WS_WGU) + (size_t)m * 2048 * D, scr, r % I_GU, X.lane); continue; } r -= N_GU;
        if (r < N_DN) { const int m = r / I_DN; transpose_item<0>(in_(24) + (size_t)m * D * D, D, D, (bf16_t*)(X.ws + WS_WDN) + (size_t)m * D * D, scr, r % I_DN, X.lane); continue; } r -= N_DN;
        if (r < N_IN) { const int m = r / I_IN; transpose_item<0>(in_(1) + (size_t)m * D * 2048, D, 2048, (bf16_t*)(X.ws + WS_WIN) + (size_t)m * 2048 * D, scr, r % I_IN, X.lane); continue; } r -= N_IN;
        if (r < N_GLU) { const int m = r / I_GLU; transpose_item<0>(in_(11) + (size_t)m * 512 * 512, 512, 512, (bf16_t*)(X.ws + WS_WGLU) + (size_t)m * 512 * 512, scr, r % I_GLU, X.lane); continue; } r -= N_GLU;
        if (r < N_OUT) { const int m = r / I_OUT; transpose_item<0>(in_(13) + (size_t)m * D * D, D, D, (bf16_t*)(X.ws + WS_WOUT) + (size_t)m * D * D, scr, r % I_OUT, X.lane); continue; } r -= N_OUT;
        if (r < N_QKV) { const int m = r / I_QKV; transpose_item<2>(in_(14) + (size_t)m * D * 3072, D, 3072, (bf16_t*)(X.ws + WS_WQKV) + (size_t)m * 3072 * D, scr, r % I_QKV, X.lane); continue; } r -= N_QKV;
        { const int m = r / I_O; transpose_item<0>(in_(15) + (size_t)m * D * D, D, D, (bf16_t*)(X.ws + WS_WO) + (size_t)m * D * D, scr, r % I_O, X.lane); }
    }
}

#undef in_
typedef float f32x4v __attribute__((ext_vector_type(4)));
template <int PASS>
__device__ __forceinline__ void phase_s5(const Ctx& X, int i, const bf16_t* proj, const float* conv_w, const float* c_re, const float* c_im, const float* d_skip, bf16_t* mix, bf16_t* Z) {
    using pg8::bf16x8;
    if (PASS == 2) {
        const float* w = conv_w + (size_t)i * 3 * CONV_CH;
        const size_t n = (size_t)T * (CONV_CH / 8);
        for (size_t idx = (size_t)X.bid * NTHR + X.tid; idx < n; idx += (size_t)X.G * NTHR) {
            const int bt = (int)(idx >> 6), c = (int)(idx & 63) * 8, pos = bt & (SEQ - 1);
            const bf16_t* pr = proj + (size_t)bt * 2048;
            float gb[8], a2[8], b2[8], a1[8], b1[8], a0[8], b0[8];
            unpack8(*(const u32x4*)(pr + c), gb); unpack8(*(const u32x4*)(pr + 512 + c), a2); unpack8(*(const u32x4*)(pr + 1024 + c), b2);
            if (pos >= 1) { unpack8(*(const u32x4*)(pr + 512 + c - 2048), a1); unpack8(*(const u32x4*)(pr + 1024 + c - 2048), b1); }
            if (pos >= 2) { unpack8(*(const u32x4*)(pr + 512 + c - 4096), a0); unpack8(*(const u32x4*)(pr + 1024 + c - 4096), b0); }
            float o[8];
#pragma unroll
            for (int j = 0; j < 8; ++j) {
                float s = w[2 * CONV_CH + c + j] * (a2[j] * b2[j]);
                if (pos >= 1) s += w[1 * CONV_CH + c + j] * (a1[j] * b1[j]);
                if (pos >= 2) s += w[0 * CONV_CH + c + j] * (a0[j] * b0[j]);
                o[j] = gb[j] * s; }
            *(u32x4*)(mix + (size_t)bt * D + c) = pack8(o);
        }
    }
    const int lane = X.lane, n16 = lane & 15, kq = lane >> 4;
    LAS float* BuT = (LAS float*)(X.lds + X.wave * 15360);
    LAS unsigned char* xsb = X.lds + X.wave * 15360 + 10240;
    const float2* Abar = (const float2*)(X.ws + WS_S5A); const float2* Bbar = (const float2*)(X.ws + WS_S5B);
    float2* Sst = (float2*)(X.ws + WS_S5S);
    const int gw = X.bid * NWAVES + X.wave, NGW = X.G * NWAVES;
    for (int task = gw; task < BATCH * 64 * SSM_G; task += NGW) {
        const int g = task & 31, c = (task >> 5) & 63, b = task >> 11, ig = i * 32 + g;
        const float2 A = Abar[ig * 64 + lane];
        bf16x8 bfr[8];
#pragma unroll
        for (int cb = 0; cb < 8; ++cb) {
            u32x4 w = (u32x4){0u, 0u, 0u, 0u};
            if (kq < 2) { const float2* bp = Bbar + ((size_t)(ig * 64 + 16 * (cb & 3) + n16)) * 16 + 8 * kq; float v[8];
#pragma unroll
                for (int j = 0; j < 8; ++j) { const float2 t2 = bp[j]; v[j] = cb < 4 ? t2.x : t2.y; }
                w = pack8(v); }
            bfr[cb] = __builtin_bit_cast(bf16x8, w);
        }
        bf16x8 cfr[4]; bf16x8 dfr;
        if (PASS == 2) {
#pragma unroll
            for (int ks = 0; ks < 4; ++ks) { const int p0 = 16 * ks + 4 * kq; const f32x4 cr = *(const f32x4*)(c_re + (size_t)(ig * 16 + n16) * 64 + p0), ci = *(const f32x4*)(c_im + (size_t)(ig * 16 + n16) * 64 + p0);
                u32x4 w; w.x = cvt_pk_bf16(cr[0], -ci[0]); w.y = cvt_pk_bf16(cr[1], -ci[1]); w.z = cvt_pk_bf16(cr[2], -ci[2]); w.w = cvt_pk_bf16(cr[3], -ci[3]); cfr[ks] = __builtin_bit_cast(bf16x8, w); }
            { const float dv = d_skip[ig * 16 + n16]; float v[8];
#pragma unroll
              for (int j = 0; j < 8; ++j) v[j] = (kq < 2 && 8 * kq + j == n16) ? dv : 0.f;
              dfr = __builtin_bit_cast(bf16x8, pack8(v)); }
        }
        float xr = 0.f, xi = 0.f;
        if (PASS == 2) { const float2 xin = ((const float2*)(X.ws + WS_S5X))[((size_t)(b * 32 + g) * 64 + c) * 64 + lane]; xr = xin.x; xi = xin.y; }
        const bf16_t* ub = proj + ((size_t)b * SEQ + (size_t)c * 128) * 2048 + 1536 + g * 16;
        bf16_t* zb = Z + ((size_t)b * SEQ + (size_t)c * 128) * SSM_W + g * 16;
        u32x4 uw = (u32x4){0u, 0u, 0u, 0u};
        if (kq < 2) uw = *(const u32x4*)(ub + (size_t)n16 * 2048 + 8 * kq);
#pragma nounroll
        for (int blk = 0; blk < 8; ++blk) {
            const bf16x8 ufr = __builtin_bit_cast(bf16x8, uw);
            u32x4 un = (u32x4){0u, 0u, 0u, 0u};
            if (kq < 2 && blk < 7) un = *(const u32x4*)(ub + (size_t)((blk + 1) * 16 + n16) * 2048 + 8 * kq);
#pragma unroll
            for (int cb = 0; cb < 8; ++cb) {
                f32x4v acc = (f32x4v){0.f, 0.f, 0.f, 0.f};
                acc = __builtin_amdgcn_mfma_f32_16x16x32_bf16(ufr, bfr[cb], acc, 0, 0, 0);
                *(LAS f32x4v*)(BuT + (16 * cb + n16) * 20 + 4 * kq) = acc;
            }
            WAVE_SYNC();
#pragma unroll
            for (int k4 = 0; k4 < 4; ++k4) {
                const f32x4v br = *(const LAS f32x4v*)(BuT + lane * 20 + 4 * k4), bi = *(const LAS f32x4v*)(BuT + (64 + lane) * 20 + 4 * k4);
#pragma unroll
                for (int s = 0; s < 4; ++s) {
                    float nr = fmaf(-A.y, xi, fmaf(A.x, xr, br[s])); asm volatile("" : "+v"(nr));
                    float ni = fmaf(A.y, xr, fmaf(A.x, xi, bi[s])); asm volatile("" : "+v"(ni));
                    xr = nr; xi = ni;
                    if (PASS == 2) *(LAS unsigned*)(xsb + (4 * k4 + s) * 272 + lane * 4) = cvt_pk_bf16(xr, xi);
                }
            }
            if (PASS == 2) {
                WAVE_SYNC();
                f32x4v y = (f32x4v){0.f, 0.f, 0.f, 0.f};
                bf16x8 xa[4];
#pragma unroll
                for (int ks = 0; ks < 4; ++ks) xa[ks] = *(const LAS bf16x8*)(xsb + n16 * 272 + ks * 64 + kq * 16);
                WAVE_SYNC(); __builtin_amdgcn_sched_barrier(0);
#pragma unroll
                for (int ks = 0; ks < 4; ++ks) y = __builtin_amdgcn_mfma_f32_16x16x32_bf16(xa[ks], cfr[ks], y, 0, 0, 0);
                y = __builtin_amdgcn_mfma_f32_16x16x32_bf16(ufr, dfr, y, 0, 0, 0);
                asm volatile("" :: "v"(xa[0]), "v"(xa[1]), "v"(xa[2]), "v"(xa[3]), "v"(ufr));
#pragma unroll
                for (int q = 0; q < 4; ++q) zb[(size_t)(blk * 16 + 4 * kq + q) * SSM_W + n16] = (bf16_t)f2bf(gelu_tanh(y[q]));
            }
            WAVE_SYNC();
            uw = un;
        }
        if (PASS == 1) Sst[((size_t)(b * 32 + g) * 64 + c) * 64 + lane] = make_float2(xr, xi);
    }
}

__device__ __forceinline__ void phase_s5_carry(const Ctx& X, int i) {
    const float2* Abar = (const float2*)(X.ws + WS_S5A); const float2* Sst = (const float2*)(X.ws + WS_S5S); float2* Xin = (float2*)(X.ws + WS_S5X);
    const int gw = X.bid * NWAVES + X.wave, NGW = X.G * NWAVES, lane = X.lane;
    for (int bg = gw; bg < BATCH * SSM_G; bg += NGW) {
        const float2 A = Abar[(i * 32 + (bg & 31)) * 64 + lane];
        float pr_ = A.x, pi_ = A.y;
#pragma unroll
        for (int q = 0; q < 7; ++q) { const float nr = pr_ * pr_ - pi_ * pi_, ni = 2.f * pr_ * pi_; pr_ = nr; pi_ = ni; }
        float xr = 0.f, xi = 0.f;
        const size_t base = (size_t)bg * 64 * 64 + lane;
#pragma unroll 8
        for (int c = 0; c < 64; ++c) {
            Xin[base + (size_t)c * 64] = make_float2(xr, xi);
            const float2 s = Sst[base + (size_t)c * 64];
            const float nr = pr_ * xr - pi_ * xi + s.x, ni = pr_ * xi + pi_ * xr + s.y; xr = nr; xi = ni;
        }
    }
}

typedef short v4i16_t __attribute__((ext_vector_type(4)));
typedef float f32x16 __attribute__((ext_vector_type(16)));
__device__ __forceinline__ v4i16_t vtr16(const LAS unsigned char* p) { return __builtin_amdgcn_ds_read_tr16_b64_v4i16((LAS v4i16_t*)p); }
__device__ __forceinline__ void phase_attn(const Ctx& X, const bf16_t* proj, bf16_t* att) {
    using pg8::bf16x8;
    const int lane = X.lane, i32 = lane & 31, hi = lane >> 5;
    LAS unsigned char* vbuf = X.lds + X.wave * 8192;
    const int gw = X.bid * NWAVES + X.wave, NGW = X.G * NWAVES;
    const float NEG = -3.0e38f;
    const int vrd = ((lane >> 4) & 1) * 32 + (lane & 3) * 8 + (4 * hi + ((lane & 15) >> 2)) * 64;
    for (int task = gw; task < BATCH * NH * 256; task += NGW) {
        const int r = task & 15, blk = (task >> 4) & 15, hh = (task >> 8) & 15, b = task >> 12;
        const bf16_t* base = proj + (size_t)b * SEQ * 3072 + hh * 64;
        const int t0 = 512 * blk + r;
        bf16x8 qf[4];
        { const bf16_t* qp = base + (size_t)(t0 + 16 * i32) * 3072 + 8 * hi;
#pragma unroll
          for (int d0 = 0; d0 < 4; ++d0) qf[d0] = *(const bf16x8*)(qp + 16 * d0); }
        float m_run = NEG, l_run = 0.f;
        f32x16 o0, o1;
#pragma unroll
        for (int q = 0; q < 16; ++q) { o0[q] = 0.f; o1[q] = 0.f; }
        for (int pat = 0; pat < 3; ++pat) {
            const int dil = pat == 0 ? 16 : (pat == 1 ? 4 : 1), qs = pat == 0 ? 1 : (pat == 1 ? 4 : 16), ntl = pat == 0 ? 5 : (pat == 1 ? 8 : 20);
            const int rr = pat == 0 ? r : (pat == 1 ? (r & 3) : 0);
            const int M0 = (t0 - rr) / dil, Mstart = M0 - 128;
            const int qi = qs * i32;
            bf16x8 kf[4];
            auto keypos = [&](int M) { int p = dil * M + rr; p = p < 0 ? 0 : p; p = p > SEQ - 1 ? SEQ - 1 : p; return p; };
            auto issue = [&](int kt, bf16x8 (&kk)[4], int bufsel) {
                const bf16_t* kp = base + (size_t)keypos(Mstart + 32 * kt + i32) * 3072 + 1024 + 8 * hi;
#pragma unroll
                for (int d0 = 0; d0 < 4; ++d0) kk[d0] = *(const bf16x8*)(kp + 16 * d0);
#pragma unroll
                for (int kg = 0; kg < 2; ++kg) {
                    const bf16_t* vp = base + (size_t)keypos(Mstart + 32 * kt + 16 * kg + (lane >> 2)) * 3072 + 2048 + (lane & 3) * 8;
#pragma unroll
                    for (int dh = 0; dh < 2; ++dh)
                        __builtin_amdgcn_global_load_lds((const unsigned*)(vp + 32 * dh), (LAS unsigned*)(vbuf + bufsel * 4096 + (dh * 2 + kg) * 1024), 16, 0, 0);
                }
            };
            asm volatile("s_waitcnt lgkmcnt(0)" ::: "memory");
            issue(0, kf, 0);
            for (int kt = 0; kt < ntl; ++kt) {
                asm volatile("s_waitcnt vmcnt(0) lgkmcnt(0)" ::: "memory");
                bf16x8 kn[4];
                const int ktn = kt + 1 < ntl ? kt + 1 : kt;
                issue(ktn, kn, (kt + 1) & 1);
                f32x16 s;
#pragma unroll
                for (int q = 0; q < 16; ++q) s[q] = 0.f;
#pragma unroll
                for (int d0 = 0; d0 < 4; ++d0) s = __builtin_amdgcn_mfma_f32_32x32x16_bf16(kf[d0], qf[d0], s, 0, 0, 0);
                const int hi_ = qi + 128 - 32 * kt; int lo = hi_ - 128; { const int nk = -(Mstart + 32 * kt); lo = lo > nk ? lo : nk; }
                const int rb = 4 * hi - lo; const unsigned span = (unsigned)(hi_ - lo);
                const bool any = hi_ >= lo;
                float tmax = NEG;
#pragma unroll
                for (int q = 0; q < 16; ++q) { const int rowc = (q & 3) + 8 * (q >> 2); const bool ok = any && ((unsigned)(rowc + rb) <= span) && (rowc + rb >= 0); s[q] = ok ? s[q] : NEG; tmax = fmaxf(tmax, s[q]); }
                tmax = fmaxf(tmax, __shfl_xor(tmax, 32));
                const float m_new = fmaxf(m_run, tmax), sc = __builtin_amdgcn_exp2f(m_run - m_new);
                m_run = m_new;
                float ps = 0.f;
#pragma unroll
                for (int q = 0; q < 16; ++q) { s[q] = __builtin_amdgcn_exp2f(s[q] - m_new); ps += s[q]; }
                l_run = l_run * sc + ps;
#pragma unroll
                for (int q = 0; q < 16; ++q) { o0[q] *= sc; o1[q] *= sc; }
                u32x4 pw0, pw1;
                pw0.x = cvt_pk_bf16(s[0], s[1]); pw0.y = cvt_pk_bf16(s[2], s[3]); pw0.z = cvt_pk_bf16(s[4], s[5]); pw0.w = cvt_pk_bf16(s[6], s[7]);
                pw1.x = cvt_pk_bf16(s[8], s[9]); pw1.y = cvt_pk_bf16(s[10], s[11]); pw1.z = cvt_pk_bf16(s[12], s[13]); pw1.w = cvt_pk_bf16(s[14], s[15]);
                const bf16x8 pf0 = __builtin_bit_cast(bf16x8, pw0), pf1 = __builtin_bit_cast(bf16x8, pw1);
                const LAS unsigned char* vb = vbuf + (kt & 1) * 4096 + vrd;
#pragma unroll
                for (int dh = 0; dh < 2; ++dh) {
#pragma unroll
                    for (int kg = 0; kg < 2; ++kg) {
                        const v4i16_t vlo = vtr16(vb + (dh * 2 + kg) * 1024), vhi = vtr16(vb + (dh * 2 + kg) * 1024 + 512);
                        const bf16x8 vf = (bf16x8){vlo[0], vlo[1], vlo[2], vlo[3], vhi[0], vhi[1], vhi[2], vhi[3]};
                        if (dh == 0) o0 = __builtin_amdgcn_mfma_f32_32x32x16_bf16(vf, kg == 0 ? pf0 : pf1, o0, 0, 0, 0);
                        else o1 = __builtin_amdgcn_mfma_f32_32x32x16_bf16(vf, kg == 0 ? pf0 : pf1, o1, 0, 0, 0);
                    }
                }
#pragma unroll
                for (int d0 = 0; d0 < 4; ++d0) kf[d0] = kn[d0];
            }
            asm volatile("s_waitcnt vmcnt(0) lgkmcnt(0)" ::: "memory");
        }
        const float lt = l_run + __shfl_xor(l_run, 32), rl = 1.0f / lt;
        bf16_t* op = att + (size_t)(b * SEQ + t0 + 16 * i32) * D + hh * 64 + 4 * hi;
#pragma unroll
        for (int gq = 0; gq < 4; ++gq) {
            u32x2 w0, w1;
            w0.x = cvt_pk_bf16(o0[4 * gq] * rl, o0[4 * gq + 1] * rl); w0.y = cvt_pk_bf16(o0[4 * gq + 2] * rl, o0[4 * gq + 3] * rl);
            w1.x = cvt_pk_bf16(o1[4 * gq] * rl, o1[4 * gq + 1] * rl); w1.y = cvt_pk_bf16(o1[4 * gq + 2] * rl, o1[4 * gq + 3] * rl);
            *(u32x2*)(op + 8 * gq) = w0; *(u32x2*)(op + 32 + 8 * gq) = w1;
        }
    }
}

__device__ __forceinline__ void phase_ln_router(const Ctx& X, int layer, const bf16_t* hin, const bf16_t* mixo, const float* g, const float* bta, const float* rw, const float* rb, bf16_t* h1) {
    LAS f32x4* hf4 = (LAS f32x4*)(X.lds + X.wave * 16384);
    LAS int* s_cnt = (LAS int*)(X.lds + TAB_OFF);
    LAS int* s_gb = s_cnt + 32;
    const int lane = X.lane;
    int* tok_e = (int*)(X.ws + WS_TOKE); int* tok_r = (int*)(X.ws + WS_TOKR); float* glist = (float*)(X.ws + WS_GLIST); bf16_t* XG = (bf16_t*)(X.ws + WS_XG);
    unsigned* cnt = X.ctl + CW_CNT + layer * 32 * 64;
    float gg[16], bb[16];
#pragma unroll
    for (int j = 0; j < 2; ++j) {
        const f32x4 g0 = *(const f32x4*)(g + j * 512 + lane * 8), g1 = *(const f32x4*)(g + j * 512 + lane * 8 + 4), b0 = *(const f32x4*)(bta + j * 512 + lane * 8), b1 = *(const f32x4*)(bta + j * 512 + lane * 8 + 4);
#pragma unroll
        for (int q = 0; q < 4; ++q) { gg[j * 8 + q] = g0[q]; gg[j * 8 + 4 + q] = g1[q]; bb[j * 8 + q] = b0[q]; bb[j * 8 + 4 + q] = b1[q]; }
    }
    for (int tb = X.bid * 128; tb < T; tb += X.G * 128) {
        for (int rnd = 0; rnd < 4; ++rnd) {
            __syncthreads();
            if (X.tid < 32) s_cnt[X.tid] = 0;
            __syncthreads();
            const int t0 = tb + rnd * 32 + X.wave * 4;
            float v[4][16];
#pragma unroll
            for (int tl = 0; tl < 4; ++tl) {
                const size_t rowo = (size_t)(t0 + tl) * D;
                float s = 0.f;
#pragma unroll
                for (int j = 0; j < 2; ++j) { float a[8], m[8]; unpack8(*(const u32x4*)(hin + rowo + j * 512 + lane * 8), a); unpack8(*(const u32x4*)(mixo + rowo + j * 512 + lane * 8), m);
#pragma unroll
                    for (int q = 0; q < 8; ++q) { v[tl][j * 8 + q] = DN_ALPHA * a[q] + m[q]; s += v[tl][j * 8 + q]; } }
                const float mean = wave_sum(s) * (1.f / D); float s2 = 0.f;
#pragma unroll
                for (int q = 0; q < 16; ++q) { v[tl][q] -= mean; s2 += v[tl][q] * v[tl][q]; }
                const float rstd = rsqrtf(wave_sum(s2) * (1.f / D) + LN_EPS);
#pragma unroll
                for (int q = 0; q < 16; ++q) v[tl][q] = v[tl][q] * rstd * gg[q] + bb[q];
#pragma unroll
                for (int j = 0; j < 2; ++j) { u32x4 o; o.x = cvt_pk_bf16(v[tl][j * 8 + 0], v[tl][j * 8 + 1]); o.y = cvt_pk_bf16(v[tl][j * 8 + 2], v[tl][j * 8 + 3]); o.z = cvt_pk_bf16(v[tl][j * 8 + 4], v[tl][j * 8 + 5]); o.w = cvt_pk_bf16(v[tl][j * 8 + 6], v[tl][j * 8 + 7]);
                    *(u32x4*)(h1 + rowo + j * 512 + lane * 8) = o; }
            }
#pragma unroll
            for (int q = 0; q < 16; ++q) hf4[q * 64 + lane] = (f32x4){v[0][q], v[1][q], v[2][q], v[3][q]};
            WAVE_SYNC();
            const int e = lane & 31, half = lane >> 5;
            f32x4 acc = (f32x4){0.f, 0.f, 0.f, 0.f};
            for (int c = 0; c < 8; ++c) {
                const float* rwc = rw + (size_t)(512 * half + c) * NE + e;
                const LAS f32x4* hp = hf4 + (half * 8 + c) * 64;
#pragma unroll 8
                for (int l = 0; l < 64; ++l) { const float w = rwc[(size_t)l * 8 * NE]; const f32x4 x = hp[l]; acc += x * w; }
            }
            float lg[4];
#pragma unroll
            for (int tl = 0; tl < 4; ++tl) { float a = acc[tl]; a += __shfl_xor(a, 32); lg[tl] = a + rb[e]; }
            int my_e = 0; float my_g = 0.f;
#pragma unroll
            for (int tl = 0; tl < 4; ++tl) {
                float cur = lg[tl];
                float sv0 = 0.f, sv1 = 0.f, sv2 = 0.f, sv3 = 0.f; int si0 = 0, si1 = 0, si2 = 0, si3 = 0;
#pragma unroll
                for (int k = 0; k < 4; ++k) {
                    float bv = cur; int bi = e;
#pragma unroll
                    for (int o = 1; o < 32; o <<= 1) { const float ov = __shfl_xor(bv, o); const int oi = __shfl_xor(bi, o); if (ov > bv || (ov == bv && oi < bi)) { bv = ov; bi = oi; } }
                    if (k == 0) { sv0 = bv; si0 = bi; } else if (k == 1) { sv1 = bv; si1 = bi; } else if (k == 2) { sv2 = bv; si2 = bi; } else { sv3 = bv; si3 = bi; }
                    if (e == bi) cur = -INFINITY;
                }
                const float e1 = __expf(sv1 - sv0), e2 = __expf(sv2 - sv0), e3 = __expf(sv3 - sv0), inv = 1.f / (1.f + e1 + e2 + e3);
                if ((lane >> 2) == tl) { const int k = lane & 3; my_e = k == 0 ? si0 : k == 1 ? si1 : k == 2 ? si2 : si3; my_g = (k == 0 ? 1.f : k == 1 ? e1 : k == 2 ? e2 : e3) * inv; }
            }
            int my_lr = 0;
            if (lane < 16) my_lr = __hip_atomic_fetch_add(&s_cnt[my_e], 1, __ATOMIC_RELAXED, __HIP_MEMORY_SCOPE_WORKGROUP);
            __syncthreads();
            if (X.tid < 32) { const int c = s_cnt[X.tid]; s_gb[X.tid] = c ? (int)atomicAdd(cnt + X.tid * 64, (unsigned)c) : 0; }
            __syncthreads();
            int my_r = 0;
            if (lane < 16) { my_r = s_gb[my_e] + my_lr; const int t = t0 + (lane >> 2); tok_e[t * 4 + (lane & 3)] = my_e; tok_r[t * 4 + (lane & 3)] = my_r; glist[(size_t)my_e * T + my_r] = my_g; }
#pragma unroll
            for (int tl = 0; tl < 4; ++tl) {
                u32x4 o0, o1;
                o0.x = cvt_pk_bf16(v[tl][0], v[tl][1]); o0.y = cvt_pk_bf16(v[tl][2], v[tl][3]); o0.z = cvt_pk_bf16(v[tl][4], v[tl][5]); o0.w = cvt_pk_bf16(v[tl][6], v[tl][7]);
                o1.x = cvt_pk_bf16(v[tl][8], v[tl][9]); o1.y = cvt_pk_bf16(v[tl][10], v[tl][11]); o1.z = cvt_pk_bf16(v[tl][12], v[tl][13]); o1.w = cvt_pk_bf16(v[tl][14], v[tl][15]);
#pragma unroll
                for (int k = 0; k < 4; ++k) { const int ee = __shfl(my_e, tl * 4 + k), rr = __shfl(my_r, tl * 4 + k);
                    bf16_t* dst = XG + ((size_t)ee * T + rr) * D + lane * 8;
                    *(u32x4*)(dst) = o0; *(u32x4*)(dst + 512) = o1; }
            }
        }
    }
}

__device__ __forceinline__ void load_tile_table(const Ctx& X, int layer, LAS int* tb) {
    __syncthreads();
    if (X.tid < 64) {
        const int c = X.tid < 32 ? (int)__hip_atomic_load(X.ctl + CW_CNT + (layer * 32 + X.tid) * 64, RLX_AGENT) : 0;
        const int tl = (c + 255) >> 8; int incl = tl;
#pragma unroll
        for (int o = 1; o < 32; o <<= 1) { const int t = __shfl_up(incl, o); if ((X.tid & 31) >= o) incl += t; }
        if (X.tid < 32) { tb[X.tid] = incl - tl; if (X.tid == 31) tb[32] = incl; }
    }
    __syncthreads();
}

template <bool OUT_F32>
__device__ __forceinline__ void phase_combine_ln(const Ctx& X, int layer, const bf16_t* h1, const bf16_t* Y, const float* g, const float* bta, void* outp) {
    const int lane = X.lane;
    const int gw = X.bid * NWAVES + X.wave, NGW = X.G * NWAVES;
    const int* tok_e = (const int*)(X.ws + WS_TOKE); const int* tok_r = (const int*)(X.ws + WS_TOKR);
    int basev = 0;
    { const int c = lane < 32 ? (int)__hip_atomic_load(X.ctl + CW_CNT + (layer * 32 + lane) * 64, RLX_AGENT) : 0; const int pc = ((c + 255) >> 8) << 8; int incl = pc;
#pragma unroll
      for (int o = 1; o < 32; o <<= 1) { const int t = __shfl_up(incl, o); if ((lane & 31) >= o) incl += t; }
      basev = incl - pc; }
    float gg[16], bb[16];
#pragma unroll
    for (int j = 0; j < 2; ++j) {
        const f32x4 g0 = *(const f32x4*)(g + j * 512 + lane * 8), g1 = *(const f32x4*)(g + j * 512 + lane * 8 + 4), b0 = *(const f32x4*)(bta + j * 512 + lane * 8), b1 = *(const f32x4*)(bta + j * 512 + lane * 8 + 4);
#pragma unroll
        for (int q = 0; q < 4; ++q) { gg[j * 8 + q] = g0[q]; gg[j * 8 + 4 + q] = g1[q]; bb[j * 8 + q] = b0[q]; bb[j * 8 + 4 + q] = b1[q]; }
    }
    for (int bt = gw; bt < T; bt += NGW) {
        int myslot = 0;
        if (lane < 4) myslot = tok_r[bt * 4 + lane];
        const int mye = lane < 4 ? tok_e[bt * 4 + lane] : 0;
        myslot += __shfl(basev, mye);
        const int s0 = __shfl(myslot, 0), s1 = __shfl(myslot, 1), s2 = __shfl(myslot, 2), s3 = __shfl(myslot, 3);
        float v[16]; float s = 0.f;
#pragma unroll
        for (int j = 0; j < 2; ++j) {
            const int off = j * 512 + lane * 8;
            float a[8], y0[8], y1[8], y2[8], y3[8];
            unpack8(*(const u32x4*)(h1 + (size_t)bt * D + off), a);
            unpack8(*(const u32x4*)(Y + (size_t)s0 * D + off), y0); unpack8(*(const u32x4*)(Y + (size_t)s1 * D + off), y1); unpack8(*(const u32x4*)(Y + (size_t)s2 * D + off), y2); unpack8(*(const u32x4*)(Y + (size_t)s3 * D + off), y3);
#pragma unroll
            for (int q = 0; q < 8; ++q) { v[j * 8 + q] = DN_ALPHA * a[q] + (((y0[q] + y1[q]) + y2[q]) + y3[q]); s += v[j * 8 + q]; }
        }
        const float mean = wave_sum(s) * (1.f / D); float s2q = 0.f;
#pragma unroll
        for (int q = 0; q < 16; ++q) { v[q] -= mean; s2q += v[q] * v[q]; }
        const float rstd = rsqrtf(wave_sum(s2q) * (1.f / D) + LN_EPS);
#pragma unroll
        for (int q = 0; q < 16; ++q) v[q] = v[q] * rstd * gg[q] + bb[q];
#pragma unroll
        for (int j = 0; j < 2; ++j) {
            const size_t o = (size_t)bt * D + j * 512 + lane * 8;
            if (OUT_F32) { float* op = (float*)outp + o; *(f32x4*)(op) = (f32x4){v[j * 8 + 0], v[j * 8 + 1], v[j * 8 + 2], v[j * 8 + 3]}; *(f32x4*)(op + 4) = (f32x4){v[j * 8 + 4], v[j * 8 + 5], v[j * 8 + 6], v[j * 8 + 7]}; }
            else { u32x4 w; w.x = cvt_pk_bf16(v[j * 8 + 0], v[j * 8 + 1]); w.y = cvt_pk_bf16(v[j * 8 + 2], v[j * 8 + 3]); w.z = cvt_pk_bf16(v[j * 8 + 4], v[j * 8 + 5]); w.w = cvt_pk_bf16(v[j * 8 + 6], v[j * 8 + 7]); *(u32x4*)((bf16_t*)outp + o) = w; }
        }
    }
}


__device__ __forceinline__ Ctx refresh_ctx(const Ctx& X0) {
    Ctx X = X0; int t = threadIdx.x; asm volatile("" : "+v"(t)); X.tid = t; X.lane = t & 63; X.wave = __builtin_amdgcn_readfirstlane(t >> 6); return X;
}
struct Args { const float* in[26]; float* out; unsigned char* ws; int ph_lo, ph_hi; };
constexpr int N_PHASES = 1 + 2 * (6 + 4) + 2 * (3 + 4);
#define GP_ALIGN true
#define GP_SP2 true

__global__ void __launch_bounds__(NTHR, 2) mk_fwd(Args args) {
    extern __shared__ __attribute__((aligned(16))) unsigned char lds_raw[];
    Ctx X0;
    X0.lds = (LAS unsigned char*)lds_raw;
    X0.tid = threadIdx.x; X0.lane = X0.tid & 63; X0.wave = __builtin_amdgcn_readfirstlane(X0.tid >> 6);
    X0.G = gridDim.x; X0.bid = blockIdx.x;
    X0.ws = args.ws; X0.ctl = (unsigned*)(args.ws + WS_CTL);
    volatile LAS unsigned* MISC = (volatile LAS unsigned*)(X0.lds + MISC_OFF);
    if (X0.tid < 32) MISC[X0.tid] = 0u;
    __syncthreads();
    XcdBarrier bar; bar.bar = X0.ctl + CW_BAR; bar.x = 0; bar.st = nullptr;
    if (MK_ONE_LAUNCH) bar = xcd_barrier_post(X0.ctl + CW_BAR, MISC + 8);
    volatile LAS unsigned long long* ptab = (volatile LAS unsigned long long*)(X0.lds + TAB_OFF + 1024);
    if (X0.tid < 26) ptab[X0.tid] = (unsigned long long)args.in[X0.tid];
    __syncthreads();
#define INP(k) ld_ptr(ptab, k)
    const int lo = args.ph_lo, hi = args.ph_hi;
    int ph = 0;
#define IN() (lo <= ph && ph < hi)
#define SEAM() do { if (MK_ONE_LAUNCH && lo <= ph && ph + 1 < hi) xcd_barrier(bar); ++ph; } while (0)

    bf16_t* H0 = (bf16_t*)(X0.ws + WS_H0); bf16_t* H1 = (bf16_t*)(X0.ws + WS_H1); bf16_t* PROJ = (bf16_t*)(X0.ws + WS_PROJ);
    bf16_t* MIX = (bf16_t*)(X0.ws + WS_MIX); bf16_t* MIXO = (bf16_t*)(X0.ws + WS_MIXO); bf16_t* Z = (bf16_t*)(X0.ws + WS_Z);
    bf16_t* ACT = (bf16_t*)(X0.ws + WS_ACT); bf16_t* Y = (bf16_t*)(X0.ws + WS_Y);
    LAS int* tb = (LAS int*)(X0.lds + TAB_OFF + 512);

    if (IN()) { const Ctx X = refresh_ctx(X0); phase_prologue(X, ptab); }
    SEAM();

#pragma nounroll
    for (int layer = 0; layer < DEPTH; ++layer) {
        const int i = layer >> 1;
        if ((layer & 1) == 0) {
            if (IN()) { const Ctx X = refresh_ctx(X0); pg8::Gemm gm{H0, (const bf16_t*)(X.ws + WS_WIN) + (size_t)i * 2048 * D, T, 2048, D}; pg8::StaticOrder S; S.init(T, 2048, D, X.G, X.bid);
                pg8::EpiStore E{PROJ, 2048};
                pg8::gemm_phase<pg8::EpiStore, pg8::StaticOrder, GP_ALIGN, GP_SP2>(X.lds, gm, S, E); }
            SEAM();
            if (IN()) { const Ctx X = refresh_ctx(X0); phase_s5<1>(X, i, PROJ, INP(2), INP(8), INP(9), INP(10), MIX, Z); }
            SEAM();
            if (IN()) { const Ctx X = refresh_ctx(X0); phase_s5_carry(X, i); }
            SEAM();
            if (IN()) { const Ctx X = refresh_ctx(X0); phase_s5<2>(X, i, PROJ, INP(2), INP(8), INP(9), INP(10), MIX, Z); }
            SEAM();
            if (IN()) { const Ctx X = refresh_ctx(X0); pg8::Gemm gm{Z, (const bf16_t*)(X.ws + WS_WGLU) + (size_t)i * 512 * 512, T, 512, 512}; pg8::StaticOrder S; S.init(T, 512, 512, X.G, X.bid);
                pg8::EpiGlu E{Z, MIX, INP(12) + (size_t)i * SSM_W};
                pg8::gemm_phase<pg8::EpiGlu, pg8::StaticOrder, GP_ALIGN, GP_SP2>(X.lds, gm, S, E); }
            SEAM();
            if (IN()) { const Ctx X = refresh_ctx(X0); pg8::Gemm gm{MIX, (const bf16_t*)(X.ws + WS_WOUT) + (size_t)i * D * D, T, D, D}; pg8::StaticOrder S; S.init(T, D, D, X.G, X.bid);
                pg8::EpiStore E{MIXO, D};
                pg8::gemm_phase<pg8::EpiStore, pg8::StaticOrder, GP_ALIGN, GP_SP2>(X.lds, gm, S, E); }
            SEAM();
        } else {
            if (IN()) { const Ctx X = refresh_ctx(X0); pg8::Gemm gm{H0, (const bf16_t*)(X.ws + WS_WQKV) + (size_t)i * 3072 * D, T, 3072, D}; pg8::StaticOrder S; S.init(T, 3072, D, X.G, X.bid);
                pg8::EpiRope E{PROJ, (const f32x2*)(X.ws + WS_ROPE)};
                pg8::gemm_phase<pg8::EpiRope, pg8::StaticOrder, GP_ALIGN, GP_SP2>(X.lds, gm, S, E); }
            SEAM();
            if (IN()) { const Ctx X = refresh_ctx(X0); phase_attn(X, PROJ, MIX); }
            SEAM();
            if (IN()) { const Ctx X = refresh_ctx(X0); pg8::Gemm gm{MIX, (const bf16_t*)(X.ws + WS_WO) + (size_t)i * D * D, T, D, D}; pg8::StaticOrder S; S.init(T, D, D, X.G, X.bid);
                pg8::EpiStore E{MIXO, D};
                pg8::gemm_phase<pg8::EpiStore, pg8::StaticOrder, GP_ALIGN, GP_SP2>(X.lds, gm, S, E); }
            SEAM();
        }
        if (IN()) { const Ctx X = refresh_ctx(X0); phase_ln_router(X, layer, H0, MIXO, INP(16) + layer * D, INP(17) + layer * D, INP(20) + (size_t)layer * D * NE, INP(21) + layer * NE, H1); }
        SEAM();
        if (IN()) { const Ctx X = refresh_ctx(X0); load_tile_table(X, layer, tb);
            pg8::Gemm gm{(const bf16_t*)(X.ws + WS_XG), (const bf16_t*)(X.ws + WS_WGU) + (size_t)layer * NE * 2048 * D, 0, 2048, D};
            pg8::MoeOrder<8, true> S; S.init(tb, X.G, X.bid, 2048, D);
            pg8::EpiSwiglu E{ACT, INP(23) + (size_t)layer * NE * 2048};
            pg8::gemm_phase<pg8::EpiSwiglu, pg8::MoeOrder<8, true>, GP_ALIGN, GP_SP2>(X.lds, gm, S, E); }
        SEAM();
        if (IN()) { const Ctx X = refresh_ctx(X0); load_tile_table(X, layer, tb);
            pg8::Gemm gm{ACT, (const bf16_t*)(X.ws + WS_WDN) + (size_t)layer * NE * D * D, 0, D, D};
            pg8::MoeOrder<4, false> S; S.init(tb, X.G, X.bid, D, D);
            pg8::EpiDown E{Y, INP(25) + (size_t)layer * NE * D, (const float*)(X.ws + WS_GLIST)};
            pg8::gemm_phase<pg8::EpiDown, pg8::MoeOrder<4, false>, GP_ALIGN, GP_SP2>(X.lds, gm, S, E); }
        SEAM();
        if (IN()) { const Ctx X = refresh_ctx(X0);
            if (layer == DEPTH - 1) phase_combine_ln<true>(X, layer, H1, Y, INP(18) + layer * D, INP(19) + layer * D, (void*)args.out);
            else phase_combine_ln<false>(X, layer, H1, Y, INP(18) + layer * D, INP(19) + layer * D, (void*)H0);
        }
        SEAM();
    }
#undef IN
#undef SEAM
}

extern "C" void kernel_launch(void* const* d_in, const int* in_sizes, int n_in, void* d_out, int out_size, void* d_ws, size_t ws_size, hipStream_t stream) {
    static int grid = 0;
    if (grid == 0) {
        if (n_in != 26 || out_size != T * D || ws_size < WS_END) { fprintf(stderr, "kernel_launch: unexpected shapes n_in %d out %d ws %zu (need %zu)\n", n_in, out_size, ws_size, (size_t)WS_END); grid = -1; return; }
        int dev = 0, cus = 0, per_cu = 0;
        if (hipGetDevice(&dev) != hipSuccess || hipDeviceGetAttribute(&cus, hipDeviceAttributeMultiprocessorCount, dev) != hipSuccess) { grid = -1; return; }
        if (hipFuncSetAttribute((const void*)mk_fwd, hipFuncAttributeMaxDynamicSharedMemorySize, LDS_BYTES) != hipSuccess) { fprintf(stderr, "kernel_launch: hipFuncSetAttribute failed\n"); grid = -1; return; }
        if (hipOccupancyMaxActiveBlocksPerMultiprocessor(&per_cu, (const void*)mk_fwd, NTHR, LDS_BYTES) != hipSuccess || per_cu < 1) fprintf(stderr, "kernel_launch: occupancy query says %d\n", per_cu);
        (void)hipGetLastError();
        grid = cus;
    }
    if (grid < 0) return;
    if (hipMemsetAsync((char*)d_ws + WS_CTL, 0, CTL_ZERO_BYTES, stream) != hipSuccess) return;
    Args a{};
    for (int i = 0; i < 26; ++i) a.in[i] = (const float*)d_in[i];
    a.out = (float*)d_out; a.ws = (unsigned char*)d_ws;
#if MK_ONE_LAUNCH
    a.ph_lo = 0; a.ph_hi = N_PHASES;
    hipLaunchKernelGGL(mk_fwd, dim3(grid), dim3(NTHR), LDS_BYTES, stream, a);
#else
    for (int p = 0; p < N_PHASES; ++p) { a.ph_lo = p; a.ph_hi = p + 1; hipLaunchKernelGGL(mk_fwd, dim3(grid), dim3(NTHR), LDS_BYTES, stream, a); }
#endif
}
```

```cpp
#include <hip/hip_runtime.h>
#include <cstdio>
#include <cstdint>

#ifndef MK_ONE_LAUNCH
#define MK_ONE_LAUNCH 1
#endif

#define GAS __attribute__((address_space(1)))
#define LAS __attribute__((address_space(3)))
#define RLX_AGENT __ATOMIC_RELAXED, __HIP_MEMORY_SCOPE_AGENT
#define WAVE_SYNC() asm volatile("s_waitcnt lgkmcnt(0)" ::: "memory")
typedef float f32x4 __attribute__((ext_vector_type(4)));
typedef float f32x2 __attribute__((ext_vector_type(2)));
typedef unsigned u32x4 __attribute__((ext_vector_type(4)));
typedef unsigned u32x2 __attribute__((ext_vector_type(2)));
typedef unsigned short bf16_t;

constexpr int BATCH = 4, SEQ = 8192, D = 1024, T = BATCH * SEQ, DEPTH = 4;
constexpr int CONV_CH = 512, SSM_W = 512, SSM_G = 32, SSM_H = 16, SSM_P = 64;
constexpr int NH = 16, HD = 64;
constexpr int NE = 32, TOPK = 4, NA = T * TOPK;
constexpr float SW_LIMIT = 7.0f, SW_ALPHA = 1.702f;
constexpr float LN_EPS = 1e-5f;
constexpr float DN_ALPHA = 1.6817928305074290860622509524664f;
constexpr int NWAVES = 8, NTHR = 512;

constexpr size_t MiB = 1u << 20;
constexpr size_t WS_CTL = 0, CTL_ZERO_BYTES = 1 * MiB;
constexpr size_t WS_S5A = 1 * MiB;
constexpr size_t WS_S5B = 1 * MiB + 65536;
constexpr size_t WS_ROPE = 2 * MiB;
constexpr size_t WS_S5X = 48 * MiB;
constexpr size_t WS_TOKE = 4 * MiB;
constexpr size_t WS_TOKR = 4 * MiB + 524288;
constexpr size_t WS_RWH = 5 * MiB;
constexpr size_t WS_RWL = 5 * MiB + 262144;
constexpr size_t WS_GLIST = 8 * MiB;
constexpr size_t WS_S5S = 12 * MiB;
constexpr size_t WS_WIN = 16 * MiB;
constexpr size_t WS_WGLU = 24 * MiB;
constexpr size_t WS_WOUT = 26 * MiB;
constexpr size_t WS_WQKV = 32 * MiB;
constexpr size_t WS_WO = 44 * MiB;
constexpr size_t WS_WGU = 64 * MiB;
constexpr size_t WS_WDN = 576 * MiB;
constexpr size_t WS_H0 = 832 * MiB;
constexpr size_t WS_H1 = 896 * MiB;
constexpr size_t WS_PROJ = 960 * MiB;
constexpr size_t WS_MIX = 1152 * MiB;
constexpr size_t WS_MIXO = 1216 * MiB;
constexpr size_t WS_Z = 1280 * MiB;
constexpr size_t WS_ACT = 1312 * MiB;
constexpr size_t WS_Y = 1584 * MiB;
constexpr size_t WS_XG = 1856 * MiB;
constexpr size_t WS_END = 3904 * MiB;
constexpr int CW_BAR = 4096;
constexpr int CW_CNT = 16384;

constexpr int LDS_BYTES = 147456;
constexpr int MISC_OFF = 131072 + 320;
constexpr int TAB_OFF = 131072 + 1024;

#define XB_TMO      128
#define XB_XCNT(j)  (256  + 64 * (j))
#define XB_XSUB(j)  (1280 + 64 * (j))
#define XB_XGEN(j)  (2304 + 64 * (j))
#define XB_TOP      3328
#define XB_TOPGEN   3392
#define XCD_BAR_WORDS 3456
#define XB_SPIN_CAP (1u << 22)

__device__ __forceinline__ unsigned xb_ld(unsigned* p)              { return __hip_atomic_load(p, __ATOMIC_RELAXED, __HIP_MEMORY_SCOPE_AGENT); }
__device__ __forceinline__ unsigned xb_add(unsigned* p, unsigned v) { return __hip_atomic_fetch_add(p, v, __ATOMIC_RELAXED, __HIP_MEMORY_SCOPE_AGENT); }
__device__ __forceinline__ unsigned xb_xcc_id() { return (unsigned)__builtin_amdgcn_s_getreg((3 << 11) | 20) & 0xFu; }
#define XB_SPIN(cond, bar) do { unsigned _sp = 0; while (cond) { __builtin_amdgcn_s_sleep(1); \
    if ((++_sp & 255u) == 0u) { if (xb_ld(&(bar)[XB_TMO])) break; if (_sp > XB_SPIN_CAP) { atomicAdd(&(bar)[XB_TMO], 1u); break; } } } } while (0)

struct XcdBarrier { unsigned* bar; unsigned x; volatile LAS unsigned* st; };

__device__ __forceinline__ XcdBarrier xcd_barrier_post(unsigned* bar, volatile LAS unsigned* st) {
    XcdBarrier b; b.bar = bar; b.x = xb_xcc_id(); b.st = st;
    if (threadIdx.x == 0) (void)xb_add(&bar[XB_XCNT(b.x)], 1u);
    return b;
}
__device__ __forceinline__ void xcd_barrier_complete(unsigned* bar, unsigned x, unsigned& nloc, unsigned& nx) {
    const unsigned G = gridDim.x * gridDim.y * gridDim.z;
    unsigned sum, cnt, mine, sp = 0u;
    for (;;) {
        sum = 0u; cnt = 0u; mine = 0u;
#pragma unroll
        for (unsigned j = 0; j < 16; ++j) { const unsigned c = xb_ld(&bar[XB_XCNT(j)]); sum += c; cnt += (c > 0u) ? 1u : 0u; mine = (j == x) ? c : mine; }
        if (sum == G) break;
        __builtin_amdgcn_s_sleep(1);
        if ((++sp & 255u) == 0u) { if (xb_ld(&bar[XB_TMO])) break; if (sp > XB_SPIN_CAP) { atomicAdd(&bar[XB_TMO], 1u); break; } }
    }
    nloc = mine > 0u ? mine : 1u; nx = cnt > 0u ? cnt : 1u;
}
__device__ __forceinline__ void xcd_barrier(const XcdBarrier& b) {
    asm volatile("s_waitcnt vmcnt(0)" ::: "memory");
    __syncthreads();
    if (threadIdx.x == 0) {
        unsigned* bar = b.bar;
        __builtin_amdgcn_s_waitcnt(0);
        unsigned nloc = b.st[0], nx = b.st[1];
        if (nloc == 0u) { xcd_barrier_complete(bar, b.x, nloc, nx); b.st[0] = nloc; b.st[1] = nx; }
        const unsigned old = xb_add(&bar[XB_XSUB(b.x)], 1u);
        const unsigned gen = old / nloc;
        if (old + 1u == (gen + 1u) * nloc) {
            __builtin_amdgcn_fence(__ATOMIC_RELEASE, "agent");
            asm volatile("s_waitcnt vmcnt(0)" ::: "memory");
            const unsigned og = xb_add(&bar[XB_TOP], 1u);
            const unsigned tg = og / nx;
            if (og + 1u == (tg + 1u) * nx) xb_add(&bar[XB_TOPGEN], 1u);
            else XB_SPIN(xb_ld(&bar[XB_TOPGEN]) == tg, bar);
            __builtin_amdgcn_fence(__ATOMIC_ACQUIRE, "agent");
            xb_add(&bar[XB_XGEN(b.x)], 1u);
            asm volatile("s_waitcnt vmcnt(0)" ::: "memory");
        } else {
            XB_SPIN(xb_ld(&bar[XB_XGEN(b.x)]) == gen, bar);
            __builtin_amdgcn_fence(__ATOMIC_ACQUIRE, "agent");
            asm volatile("s_waitcnt vmcnt(0)" ::: "memory");
        }
    }
    __syncthreads();
}

__device__ __forceinline__ float wave_sum(float v) {
#pragma unroll
    for (int o = 1; o < 64; o <<= 1) v += __shfl_xor(v, o);
    return v;
}
__device__ __forceinline__ float wave_max(float v) {
#pragma unroll
    for (int o = 1; o < 64; o <<= 1) v = fmaxf(v, __shfl_xor(v, o));
    return v;
}
__device__ __forceinline__ float sigmoidf_(float x) { return __builtin_amdgcn_rcpf(1.0f + __builtin_amdgcn_exp2f(-1.4426950408889634f * x)); }
__device__ __forceinline__ float gelu_tanh(float y) { return y * sigmoidf_(1.5957691216057308f * (y + 0.044715f * y * y * y)); }
__device__ __forceinline__ float opaque_f(float v) { asm volatile("" : "+s"(v)); return v; }
__device__ __forceinline__ int opaque_i(int v) { asm volatile("" : "+s"(v)); return v; }
__device__ __forceinline__ int seqpos(int bt) { return bt - ((bt >> 13) << 13); }
__device__ __forceinline__ unsigned f2bf(float f) { unsigned u = __builtin_bit_cast(unsigned, f); return (u + 0x7fffu + ((u >> 16) & 1u)) >> 16; }
__device__ __forceinline__ unsigned pk2(float lo, float hi) { return f2bf(lo) | (f2bf(hi) << 16); }
typedef float f32x2_t_ __attribute__((ext_vector_type(2))); typedef __bf16 bf16x2_t_ __attribute__((ext_vector_type(2)));
__device__ __forceinline__ unsigned cvt_pk_bf16(float lo, float hi) { const f32x2_t_ v = {lo, hi}; const bf16x2_t_ b = __builtin_convertvector(v, bf16x2_t_); return __builtin_bit_cast(unsigned, b); }
__device__ __forceinline__ float bf_lo(unsigned w) { return __builtin_bit_cast(float, w << 16); }
__device__ __forceinline__ float bf_hi(unsigned w) { return __builtin_bit_cast(float, w & 0xffff0000u); }
__device__ __forceinline__ float bf2f(bf16_t b) { return __builtin_bit_cast(float, ((unsigned)b) << 16); }
__device__ __forceinline__ void unpack8(const u32x4 w, float (&f)[8]) { f[0] = bf_lo(w.x); f[1] = bf_hi(w.x); f[2] = bf_lo(w.y); f[3] = bf_hi(w.y); f[4] = bf_lo(w.z); f[5] = bf_hi(w.z); f[6] = bf_lo(w.w); f[7] = bf_hi(w.w); }
__device__ __forceinline__ u32x4 pack8(const float (&f)[8]) { u32x4 w; w.x = cvt_pk_bf16(f[0], f[1]); w.y = cvt_pk_bf16(f[2], f[3]); w.z = cvt_pk_bf16(f[4], f[5]); w.w = cvt_pk_bf16(f[6], f[7]); return w; }

__device__ __forceinline__ unsigned pk4_fp8(float a, float b, float c, float d) {
    int w = __builtin_amdgcn_cvt_pk_fp8_f32(a, b, 0, false); w = __builtin_amdgcn_cvt_pk_fp8_f32(c, d, w, true); return (unsigned)w; }
__device__ __forceinline__ u32x2 pack8_fp8(const float (&f)[8]) { u32x2 w; w.x = pk4_fp8(f[0], f[1], f[2], f[3]); w.y = pk4_fp8(f[4], f[5], f[6], f[7]); return w; }
constexpr int W8_SHIFT_GU = 5, W8_SHIFT_DN = 6;

__device__ __forceinline__ int lane_id() { return (int)__builtin_amdgcn_mbcnt_hi(~0u, __builtin_amdgcn_mbcnt_lo(~0u, 0u)); }

struct Ctx {
    LAS unsigned char* lds;
    int tid, lane, wave, G, bid;
    unsigned* ctl;
    unsigned char* ws;
};

namespace pg8 {
#define PG8_LAS __attribute__((address_space(3)))
typedef short bf16x8 __attribute__((ext_vector_type(8)));
constexpr int BM = 256, BK = 64, HALF = 128, HTB = HALF * BK * 2  , STAGE_BYTES = 8 * HTB, NXCD = 8, WGM = 8;

__host__ __device__ __forceinline__ int lds_byte(int r, int c) { const int st = (r >> 4) * 2 + (c >> 5), rr = r & 15, cc = c & 31, ob = rr * 64 + cc * 2; return st * 1024 + (ob ^ (((ob >> 9) & 1) << 5)); }
__host__ __device__ __forceinline__ void stage_rc(int b, int& R, int& C) { const int st = b / 1024, sb = b % 1024, swz = sb ^ (((sb >> 9) & 1) << 5); R = (st >> 1) * 16 + swz / 64; C = (st & 1) * 32 + (swz % 64) / 2; }
__host__ __device__ __forceinline__ int perm32(int rho) { const int n = rho >> 4, i = rho & 15; return 8 * (i >> 2) + 4 * n + (i & 3); }

struct Unit { int pm, pn, e, mt; };
struct Gemm { const bf16_t* A; const bf16_t* Bt; int M, N, K; };

struct StaticOrder {
    int nM, nN, nwg, G, c; size_t tstep;
    __device__ void init(int M, int N, int K, int G_, int c_) { nM = M / BM; nN = N / BM; nwg = nM * nN; G = G_; c = c_; tstep = (size_t)BM * K * 2; }
    __device__ bool next(int i, Unit& u) const {
        const long L = (long)i * G + c; if (L >= nwg) return false;
        int wgid = (int)L; { const int q = nwg / NXCD, r = nwg % NXCD, xcd = wgid % NXCD, off = wgid / NXCD; wgid = (xcd < r ? xcd * (q + 1) : r * (q + 1) + (xcd - r) * q) + off; }
        const int nig = WGM * nN, gid = wgid / nig, fm = gid * WGM, gsz = (nM - fm) < WGM ? (nM - fm) : WGM;
        u.pm = fm + ((wgid % nig) % gsz); u.pn = (wgid % nig) / gsz; u.e = 0; u.mt = 0; return true;
    }
    __device__ __forceinline__ size_t a_off(const Unit& u) const { return (size_t)u.pm * tstep; }
    __device__ __forceinline__ size_t b_off(const Unit& u) const { return (size_t)u.pn * tstep; }
    __device__ __forceinline__ void a_ready(const Unit&) const {}
    __device__ __forceinline__ void done(const Unit&) const {}
};
template <int NPN, bool A_IS_XG> struct MoeOrder {
    const PG8_LAS int* tb; int G, c, ntile; size_t bexp, rowb;
    __device__ void init(const PG8_LAS int* tb_, int G_, int c_, int Nexp, int K) { tb = tb_; G = G_; c = c_; ntile = tb_[32]; rowb = (size_t)K * 2; bexp = (size_t)Nexp * rowb; }
    __device__ bool next(int i, Unit& u) const {
        int mtg, pn;
        if (G == 256) { constexpr int MPR = 256 / NPN, MPX = MPR / 8; mtg = MPR * i + MPX * (c & 7) + (c >> 3) / NPN; pn = (c >> 3) % NPN; }
        else { const long L = (long)i * G + c; mtg = (int)(L / NPN); pn = (int)(L % NPN); }
        if (mtg >= ntile) return false;
        int e = 0;
#pragma unroll
        for (int st = 16; st >= 1; st >>= 1) { const int tv = __builtin_amdgcn_readfirstlane(tb[e + st]); if (tv <= mtg) e += st; }
        u.pm = mtg; u.pn = pn; u.e = e; u.mt = mtg - tb[e]; return true;
    }
    __device__ __forceinline__ size_t a_off(const Unit& u) const { return A_IS_XG ? ((size_t)u.e * T + (size_t)u.mt * BM) * rowb : (size_t)u.pm * BM * rowb; }
    __device__ __forceinline__ size_t b_off(const Unit& u) const { return (size_t)u.e * bexp + (size_t)u.pn * BM * rowb; }
    __device__ __forceinline__ void a_ready(const Unit&) const {}
    __device__ __forceinline__ void done(const Unit&) const {}
};

__device__ __forceinline__ u32x4 pack_v(const f32x4 v0, const f32x4 v1) { u32x4 w; w.x = cvt_pk_bf16(v0[0], v0[1]); w.y = cvt_pk_bf16(v0[2], v0[3]); w.z = cvt_pk_bf16(v1[0], v1[1]); w.w = cvt_pk_bf16(v1[2], v1[3]); return w; }

struct EpiStore {
    static constexpr bool PERM = true, AFTER_DRAIN = false, BIAS_INIT = false;
    bf16_t* O; int ldc;
    __device__ __forceinline__ void operator()(const f32x4 (&acc)[2][2][4][2], const Unit& u, int wr, int wc, int fr, int fq) const {
        const int row0 = u.pm * BM + wr * 64 + fr, col0 = u.pn * BM + wc * 32 + 8 * fq;
#pragma unroll
        for (int ai = 0; ai < 2; ++ai)
#pragma unroll
            for (int m = 0; m < 4; ++m) { bf16_t* rowp = O + (size_t)(row0 + ai * HALF + m * 16) * ldc + col0;
#pragma unroll
                for (int bj = 0; bj < 2; ++bj) *(u32x4*)(rowp + bj * HALF) = pack_v(acc[ai][bj][m][0], acc[ai][bj][m][1]); }
    }
};
struct EpiGlu {
    static constexpr bool PERM = true, AFTER_DRAIN = false, BIAS_INIT = false;
    const bf16_t* Z; bf16_t* MIX; const float* bias;
    __device__ __forceinline__ void operator()(const f32x4 (&acc)[2][2][4][2], const Unit& u, int wr, int wc, int fr, int fq) const {
        const int row0 = u.pm * BM + wr * 64 + fr, col0 = u.pn * BM + wc * 32 + 8 * fq;
        f32x4 bv[2][2];
#pragma unroll
        for (int bj = 0; bj < 2; ++bj)
#pragma unroll
            for (int n = 0; n < 2; ++n) bv[bj][n] = *(const f32x4*)(bias + col0 + bj * HALF + 4 * n);
#pragma unroll
        for (int ai = 0; ai < 2; ++ai)
#pragma unroll
            for (int m = 0; m < 4; ++m) { const size_t row = (size_t)(row0 + ai * HALF + m * 16);
#pragma unroll
                for (int bj = 0; bj < 2; ++bj) {
                    const u32x4 zw = *(const u32x4*)(Z + row * SSM_W + col0 + bj * HALF); float z[8]; unpack8(zw, z);
                    const f32x4 a0 = acc[ai][bj][m][0] + bv[bj][0], a1 = acc[ai][bj][m][1] + bv[bj][1];
                    float o[8];
#pragma unroll
                    for (int j = 0; j < 4; ++j) { o[j] = z[j] * sigmoidf_(a0[j]); o[4 + j] = z[4 + j] * sigmoidf_(a1[j]); }
                    *(u32x4*)(MIX + row * D + 512 + col0 + bj * HALF) = pack8(o); } }
    }
};
struct EpiRope {
    static constexpr bool PERM = true, AFTER_DRAIN = false, BIAS_INIT = false;
    bf16_t* O; const f32x2* rope;
    __device__ __forceinline__ void operator()(const f32x4 (&acc)[2][2][4][2], const Unit& u, int wr, int wc, int fr, int fq) const {
        const int part = u.pn >> 2, tp = u.pn & 3;
        const int row0 = u.pm * BM + wr * 64 + fr, colb = part * 1024 + (4 * tp + wc) * 64 + 8 * fq;
        const float qs = part == 0 ? 0.125f * 1.4426950408889634f : 1.0f;
#pragma unroll
        for (int ai = 0; ai < 2; ++ai)
#pragma unroll
            for (int m = 0; m < 4; ++m) { const int row = row0 + ai * HALF + m * 16; bf16_t* rowp = O + (size_t)row * 3072 + colb;
                const f32x4 x1a = acc[ai][0][m][0], x1b = acc[ai][0][m][1], x2a = acc[ai][1][m][0], x2b = acc[ai][1][m][1];
                if (part < 2) {
                    const f32x4* rp = (const f32x4*)(rope + (size_t)seqpos(row) * 32 + 8 * fq);
                    const f32x4 c01 = rp[0], c23 = rp[1], c45 = rp[2], c67 = rp[3];
                    float o1[8], o2[8];
                    const float cs[8] = {c01[0], c01[2], c23[0], c23[2], c45[0], c45[2], c67[0], c67[2]}, sn[8] = {c01[1], c01[3], c23[1], c23[3], c45[1], c45[3], c67[1], c67[3]};
                    const float x1[8] = {x1a[0], x1a[1], x1a[2], x1a[3], x1b[0], x1b[1], x1b[2], x1b[3]}, x2[8] = {x2a[0], x2a[1], x2a[2], x2a[3], x2b[0], x2b[1], x2b[2], x2b[3]};
#pragma unroll
                    for (int j = 0; j < 8; ++j) { o1[j] = (x1[j] * cs[j] - x2[j] * sn[j]) * qs; o2[j] = (x2[j] * cs[j] + x1[j] * sn[j]) * qs; }
                    *(u32x4*)(rowp) = pack8(o1); *(u32x4*)(rowp + 32) = pack8(o2);
                } else { *(u32x4*)(rowp) = pack_v(x1a, x1b); *(u32x4*)(rowp + 32) = pack_v(x2a, x2b); } }
    }
};
struct EpiSwiglu {
    static constexpr bool PERM = true, AFTER_DRAIN = false, BIAS_INIT = true;
    bf16_t* ACT; const float* bgu;
    __device__ __forceinline__ void init(f32x4 (&acc)[2][2][4][2], const Unit& u, int wc, int fq) const {
        const float* bb = bgu + (size_t)u.e * 2048 + u.pn * 128 + wc * 32 + 8 * fq;
        const f32x4 bg0 = *(const f32x4*)(bb), bg1 = *(const f32x4*)(bb + 4), bl0 = *(const f32x4*)(bb + 1024), bl1 = *(const f32x4*)(bb + 1028);
#pragma unroll
        for (int ai = 0; ai < 2; ++ai)
#pragma unroll
            for (int m = 0; m < 4; ++m) { acc[ai][0][m][0] = bg0; acc[ai][0][m][1] = bg1; acc[ai][1][m][0] = bl0; acc[ai][1][m][1] = bl1; }
    }
    __device__ __forceinline__ void operator()(const f32x4 (&acc)[2][2][4][2], const Unit& u, int wr, int wc, int fr, int fq) const {
        const int row0 = u.pm * BM + wr * 64 + fr, j0 = u.pn * 128 + wc * 32 + 8 * fq;
        unsigned char* ab = (unsigned char*)ACT + (size_t)row0 * D + j0;
#pragma unroll
        for (int ai = 0; ai < 2; ++ai)
#pragma unroll
            for (int m = 0; m < 4; ++m) {
                const f32x4 g0 = acc[ai][0][m][0], g1 = acc[ai][0][m][1], l0 = acc[ai][1][m][0], l1 = acc[ai][1][m][1];
                float o[8];
#pragma unroll
                for (int j = 0; j < 4; ++j) {
                    const float ga = fminf(g0[j], SW_LIMIT), gb = fminf(g1[j], SW_LIMIT);
                    const float la = fminf(fmaxf(l0[j], -SW_LIMIT), SW_LIMIT), lb = fminf(fmaxf(l1[j], -SW_LIMIT), SW_LIMIT);
                    o[j] = (la + 1.0f) * (ga * sigmoidf_(SW_ALPHA * ga)); o[4 + j] = (lb + 1.0f) * (gb * sigmoidf_(SW_ALPHA * gb)); }
                *(u32x2*)(ab + (size_t)(ai * HALF + m * 16) * D) = pack8_fp8(o); }
    }
};
struct EpiDown {
    static constexpr bool PERM = true, AFTER_DRAIN = false, BIAS_INIT = true;
    bf16_t* Y; const float* bd; const float* glist;
    __device__ __forceinline__ void init(f32x4 (&acc)[2][2][4][2], const Unit& u, int wc, int fq) const {
        const float* bb = bd + (size_t)u.e * D + u.pn * BM + wc * 32 + 8 * fq;
        const f32x4 b00 = *(const f32x4*)(bb), b01 = *(const f32x4*)(bb + 4), b10 = *(const f32x4*)(bb + HALF), b11 = *(const f32x4*)(bb + HALF + 4);
#pragma unroll
        for (int ai = 0; ai < 2; ++ai)
#pragma unroll
            for (int m = 0; m < 4; ++m) { acc[ai][0][m][0] = b00; acc[ai][0][m][1] = b01; acc[ai][1][m][0] = b10; acc[ai][1][m][1] = b11; }
    }
    __device__ __forceinline__ void operator()(const f32x4 (&acc)[2][2][4][2], const Unit& u, int wr, int wc, int fr, int fq) const {
        const int rl0 = wr * 64 + fr, col0 = u.pn * BM + wc * 32 + 8 * fq;
        const float* gl = glist + (size_t)u.e * T + (size_t)u.mt * BM + rl0;
        bf16_t* yb = Y + ((size_t)u.pm * BM + rl0) * D + col0;
#pragma unroll
        for (int ai = 0; ai < 2; ++ai)
#pragma unroll
            for (int m = 0; m < 4; ++m) { const int rl = ai * HALF + m * 16; const float gt = gl[rl];
#pragma unroll
                for (int bj = 0; bj < 2; ++bj) *(u32x4*)(yb + (size_t)rl * D + bj * HALF) = pack_v(acc[ai][bj][m][0] * gt, acc[ai][bj][m][1] * gt); }
    }
};

template <class Epi, class Sched, bool ALIGN_EPI = false, bool SP2 = false, bool FP8 = false>
__device__ __forceinline__ void gemm_phase(PG8_LAS unsigned char* lds, const Gemm g, const Sched& S, const Epi& E, int wave_, int scale_w = 127, int scale_x = 127) {
    int tid = wave_ * 64 + lane_id(); asm volatile("" : "+v"(tid)); const int wid = wave_, lane = tid & 63, wr = wid >> 2, wc = wid & 3, fr = lane & 15, fq = lane >> 4;
    const int K = g.K, nt = K / BK;
    unsigned voffA[2], voffB[2];
#pragma unroll
    for (int i = 0; i < 2; ++i) { int R, C; stage_rc(tid * 16 + i * 8192, R, C); const int Rb = Epi::PERM ? ((R & ~31) + perm32(R & 31)) : R;
        voffA[i] = (unsigned)(R * K + C) * 2u; voffB[i] = (unsigned)(Rb * K + C) * 2u; }
    const unsigned kstep = (unsigned)(BK * 2);
    const unsigned hstep = (unsigned)HALF * (unsigned)K * 2u;
    const unsigned ldsw = (unsigned)wid * 1024u;
    const int aoff = lds_byte(wr * 64 + fr, fq * 8), boff = lds_byte(wc * 32 + fr, fq * 8);
#define PG8_SA(b, h) (((b) * 2 + (h)) * HTB)
#define PG8_SB(b, h) ((4 + (b) * 2 + (h)) * HTB)
#define PG8_STAGE(bufoff, gbase, voff) do { _Pragma("unroll") for (int _i = 0; _i < 2; ++_i) \
        __builtin_amdgcn_raw_ptr_buffer_load_lds(rsrc_##voff, (PG8_LAS unsigned*)(lds + (bufoff) + ldsw + _i * 8192), 16, (voff)[_i], (gbase), 0, 0); } while (0)
#define PG8_LDA(dst, b, h) do { if constexpr (FP8) { _Pragma("unroll") for (int m = 0; m < 4; ++m) { const v4i_ lo_ = *(const PG8_LAS v4i_*)(lds + PG8_SA(b, h) + aoff + m * 2048), hi_ = *(const PG8_LAS v4i_*)(lds + PG8_SA(b, h) + aoff + m * 2048 + 1024); dst##8[m] = __builtin_shufflevector(lo_, hi_, 0, 1, 2, 3, 4, 5, 6, 7); } } \
        else { _Pragma("unroll") for (int m = 0; m < 4; ++m) _Pragma("unroll") for (int k = 0; k < 2; ++k) dst[m][k] = *(const PG8_LAS bf16x8*)(lds + PG8_SA(b, h) + aoff + m * 2048 + k * 1024); } } while (0)
#define PG8_LDB(dst, b, h) do { if constexpr (FP8) { _Pragma("unroll") for (int n = 0; n < 2; ++n) { const v4i_ lo_ = *(const PG8_LAS v4i_*)(lds + PG8_SB(b, h) + boff + n * 2048), hi_ = *(const PG8_LAS v4i_*)(lds + PG8_SB(b, h) + boff + n * 2048 + 1024); dst##8[n] = __builtin_shufflevector(lo_, hi_, 0, 1, 2, 3, 4, 5, 6, 7); } } \
        else { _Pragma("unroll") for (int n = 0; n < 2; ++n) _Pragma("unroll") for (int k = 0; k < 2; ++k) dst[n][k] = *(const PG8_LAS bf16x8*)(lds + PG8_SB(b, h) + boff + n * 2048 + k * 1024); } } while (0)
#define PG8_MMA(ai, bj, At, Bt) do { __builtin_amdgcn_s_setprio(1); _Pragma("unroll") for (int m = 0; m < 4; ++m) _Pragma("unroll") for (int n = 0; n < 2; ++n) { \
        if constexpr (FP8) acc[ai][bj][m][n] = __builtin_amdgcn_mfma_scale_f32_16x16x128_f8f6f4(Bt##8[n], At##8[m], acc[ai][bj][m][n], 0, 0, 0, scale_w, 0, scale_x); \
        else { _Pragma("unroll") for (int k = 0; k < 2; ++k) acc[ai][bj][m][n] = __builtin_amdgcn_mfma_f32_16x16x32_bf16(Bt[n][k], At[m][k], acc[ai][bj][m][n], 0, 0, 0); } } \
        __builtin_amdgcn_s_setprio(0); } while (0)
#define PG8_WAIT_V(n) asm volatile("s_waitcnt vmcnt(" #n ")" ::: "memory")
#define PG8_WAIT_L(n) asm volatile("s_waitcnt lgkmcnt(" #n ")" ::: "memory")
#define PG8_BAR __builtin_amdgcn_s_barrier()
#define PG8_SCHED __builtin_amdgcn_sched_barrier(0)
#define PG8_ACC_INIT(u_) do { if constexpr (Epi::BIAS_INIT) { int tz_ = lane_id(); asm volatile("" : "+v"(tz_)); E.init(acc, u_, wc, (tz_ & 63) >> 4); } else { \
        _Pragma("unroll") for (int a = 0; a < 2; ++a) _Pragma("unroll") for (int b = 0; b < 2; ++b) _Pragma("unroll") for (int m = 0; m < 4; ++m) _Pragma("unroll") for (int n = 0; n < 2; ++n) acc[a][b][m][n] = (f32x4){0.f, 0.f, 0.f, 0.f}; } } while (0)
    Unit cur, nxt; int ui = 0;
    if (!S.next(0, cur)) return;
    f32x4 acc[2][2][4][2];
    PG8_ACC_INIT(cur);
    typedef int v4i_ __attribute__((ext_vector_type(4))); typedef int v8i_ __attribute__((ext_vector_type(8)));
    bf16x8 At[4][2], B0[2][2], B1[2][2]; v8i_ At8[4], B08[2], B18[2];
    const auto rsrc_voffA = __builtin_amdgcn_make_buffer_rsrc((void*)g.A, 0, -1, 0x00020000), rsrc_voffB = __builtin_amdgcn_make_buffer_rsrc((void*)g.Bt, 0, -1, 0x00020000);
    unsigned cA = (unsigned)__builtin_amdgcn_readfirstlane((int)(unsigned)S.a_off(cur)), cB = (unsigned)__builtin_amdgcn_readfirstlane((int)(unsigned)S.b_off(cur));
    S.a_ready(cur);
    if constexpr (SP2) {
        PG8_STAGE(PG8_SB(0, 0), cB, voffB); PG8_STAGE(PG8_SB(0, 1), cB + hstep, voffB); PG8_STAGE(PG8_SA(0, 0), cA, voffA); PG8_STAGE(PG8_SA(0, 1), cA + hstep, voffA);
        if (wr == 1) PG8_BAR;
        PG8_WAIT_V(2); PG8_BAR;
        PG8_STAGE(PG8_SB(1, 0), cB + kstep, voffB); PG8_STAGE(PG8_SA(1, 0), cA + kstep, voffA); PG8_STAGE(PG8_SB(1, 1), cB + hstep + kstep, voffB);
        PG8_WAIT_V(6); PG8_BAR;
    } else {
        PG8_STAGE(PG8_SB(0, 0), cB, voffB); PG8_STAGE(PG8_SA(0, 0), cA, voffA); PG8_STAGE(PG8_SB(0, 1), cB + hstep, voffB); PG8_STAGE(PG8_SA(0, 1), cA + hstep, voffA);
        if (wr == 1) PG8_BAR;
        PG8_WAIT_V(4); PG8_BAR;
        PG8_STAGE(PG8_SB(1, 0), cB + kstep, voffB); PG8_STAGE(PG8_SA(1, 0), cA + kstep, voffA); PG8_STAGE(PG8_SB(1, 1), cB + hstep + kstep, voffB);
        PG8_WAIT_V(6); PG8_BAR;
    }
    for (;;) {
        const bool has_next = S.next(ui + 1, nxt);
        const unsigned nA = has_next ? (unsigned)__builtin_amdgcn_readfirstlane((int)(unsigned)S.a_off(nxt)) : cA, nB = has_next ? (unsigned)__builtin_amdgcn_readfirstlane((int)(unsigned)S.b_off(nxt)) : cB;
#pragma nounroll
        for (int t = 0; t < nt; t += 2) {
            const bool last = (t == nt - 2);
            const unsigned a1 = cA + (unsigned)(t + 1) * kstep;
            const unsigned a2 = last ? nA : cA + (unsigned)(t + 2) * kstep, b2 = last ? nB : cB + (unsigned)(t + 2) * kstep;
            const unsigned a3 = a2 + kstep, b3 = b2 + kstep;
            if (last && has_next) S.a_ready(nxt);
            if constexpr (SP2) {
            PG8_LDB(B0, 0, 0); PG8_LDB(B1, 0, 1); PG8_SCHED; PG8_LDA(At, 0, 0); PG8_STAGE(PG8_SA(1, 1), a1 + hstep, voffA);
            PG8_WAIT_V(8); PG8_WAIT_L(0); PG8_BAR; PG8_MMA(0, 0, At, B0); PG8_MMA(0, 1, At, B1); PG8_BAR; PG8_SCHED;
            PG8_LDA(At, 0, 1); PG8_STAGE(PG8_SB(0, 0), b2, voffB); PG8_STAGE(PG8_SB(0, 1), b2 + hstep, voffB); PG8_STAGE(PG8_SA(0, 0), a2, voffA);
            PG8_WAIT_V(8); PG8_WAIT_L(0); PG8_BAR; PG8_MMA(1, 0, At, B0); PG8_MMA(1, 1, At, B1); PG8_BAR; PG8_SCHED;
            PG8_LDB(B0, 1, 0); PG8_LDB(B1, 1, 1); PG8_SCHED; PG8_LDA(At, 1, 0); PG8_STAGE(PG8_SA(0, 1), a2 + hstep, voffA);
            PG8_WAIT_V(8); PG8_WAIT_L(0); PG8_BAR; PG8_MMA(0, 0, At, B0); PG8_MMA(0, 1, At, B1); PG8_BAR; PG8_SCHED;
            PG8_LDA(At, 1, 1); PG8_STAGE(PG8_SB(1, 0), b3, voffB); PG8_STAGE(PG8_SB(1, 1), b3 + hstep, voffB); PG8_STAGE(PG8_SA(1, 0), a3, voffA);
            PG8_WAIT_V(8); PG8_WAIT_L(0); PG8_BAR; PG8_MMA(1, 0, At, B0); PG8_MMA(1, 1, At, B1); PG8_BAR; PG8_SCHED;
            } else {
            PG8_LDB(B0, 0, 0); PG8_SCHED; PG8_LDA(At, 0, 0); PG8_STAGE(PG8_SA(1, 1), a1 + hstep, voffA);
            PG8_WAIT_L(8); PG8_BAR; PG8_WAIT_L(0); PG8_MMA(0, 0, At, B0); PG8_BAR; PG8_SCHED;
            PG8_LDB(B1, 0, 1); PG8_STAGE(PG8_SB(0, 0), b2, voffB);
            PG8_BAR; PG8_WAIT_L(0); PG8_MMA(0, 1, At, B1); PG8_BAR;
            PG8_LDA(At, 0, 1); PG8_STAGE(PG8_SA(0, 0), a2, voffA);
            PG8_BAR; PG8_WAIT_L(0); PG8_MMA(1, 0, At, B0); PG8_BAR; PG8_SCHED;
            PG8_STAGE(PG8_SB(0, 1), b2 + hstep, voffB);
            PG8_WAIT_V(6); PG8_BAR; PG8_MMA(1, 1, At, B1); PG8_BAR;
            PG8_LDB(B0, 1, 0); PG8_SCHED; PG8_LDA(At, 1, 0); PG8_STAGE(PG8_SA(0, 1), a2 + hstep, voffA);
            PG8_WAIT_L(8); PG8_BAR; PG8_WAIT_L(0); PG8_MMA(0, 0, At, B0); PG8_BAR; PG8_SCHED;
            PG8_LDB(B1, 1, 1); PG8_STAGE(PG8_SB(1, 0), b3, voffB);
            PG8_BAR; PG8_WAIT_L(0); PG8_MMA(0, 1, At, B1); PG8_BAR;
            PG8_LDA(At, 1, 1); PG8_STAGE(PG8_SA(1, 0), a3, voffA);
            PG8_BAR; PG8_WAIT_L(0); PG8_MMA(1, 0, At, B0); PG8_BAR; PG8_SCHED;
            PG8_STAGE(PG8_SB(1, 1), b3 + hstep, voffB);
            PG8_WAIT_V(6); PG8_BAR; PG8_MMA(1, 1, At, B1); PG8_BAR;
            }
        }
        if constexpr (ALIGN_EPI) { if (wr == 0) PG8_BAR; }
        if constexpr (!Epi::AFTER_DRAIN) { int tz = lane_id(); asm volatile("" : "+v"(tz));
            E(acc, cur, wr, wc, tz & 15, (tz & 63) >> 4); S.done(cur); }
        if (!has_next) break;
        PG8_ACC_INIT(nxt);
        cur = nxt; cA = nA; cB = nB; ++ui;
        if constexpr (ALIGN_EPI) { if (wr == 1) PG8_BAR; }
    }
    PG8_WAIT_V(0);
    if constexpr (!ALIGN_EPI) { if (wr == 0) PG8_BAR; }
    PG8_BAR;
    if constexpr (Epi::AFTER_DRAIN) { E.fused(acc, cur, wr, wc, fr, fq, lds, wid, lane); S.done(cur); }
#undef PG8_SA
#undef PG8_SB
#undef PG8_ACC_INIT
#undef PG8_STAGE
#undef PG8_LDA
#undef PG8_LDB
#undef PG8_MMA
#undef PG8_WAIT_V
#undef PG8_WAIT_L
#undef PG8_BAR
#undef PG8_SCHED
}
}

template <int MODE>
__device__ __forceinline__ void transpose_item(const float* W, int K, int N, bf16_t* WT, LAS float* scr, int item, int lane) {
    const int nblk = N / 32, kb = item / nblk, nb = item % nblk, k0 = 64 * kb, n0 = 32 * nb;
    int dr = n0;
    if (MODE == 1) { const int j = n0 & 1023, half = n0 >> 10; dr = 256 * (j >> 7) + 128 * half + (j & 127); }
    if (MODE == 2) { const int part = n0 >> 10, c = n0 & 1023, head = c >> 6, half = (c >> 5) & 1; dr = part * 1024 + (head >> 2) * 256 + half * 128 + (head & 3) * 32; }
#pragma unroll 8
    for (int i = 0; i < 32; ++i) { const int kk = 2 * i + (lane >> 5); scr[kk * 33 + (lane & 31)] = W[(size_t)(k0 + kk) * N + n0 + (lane & 31)]; }
    WAVE_SYNC();
    const int c = lane & 7;
#pragma unroll
    for (int j = 0; j < 4; ++j) { const int n = (lane >> 3) + 8 * j; const LAS float* s = scr + (8 * c) * 33 + n;
        u32x4 o; o.x = pk2(s[0 * 33], s[1 * 33]); o.y = pk2(s[2 * 33], s[3 * 33]); o.z = pk2(s[4 * 33], s[5 * 33]); o.w = pk2(s[6 * 33], s[7 * 33]);
        *(u32x4*)(WT + (size_t)(dr + n) * K + k0 + 8 * c) = o; }
    WAVE_SYNC();
}

template <int MODE>
__device__ __forceinline__ void transpose_item_fp8(const float* W, int K, int N, unsigned char* WT, LAS float* scr, int item, int lane, float scale) {
    const int nblk = N / 32, kb = item / nblk, nb = item % nblk, k0 = 64 * kb, n0 = 32 * nb;
    int dr = n0;
    if (MODE == 1) { const int j = n0 & 1023, half = n0 >> 10; dr = 256 * (j >> 7) + 128 * half + (j & 127); }
#pragma unroll 8
    for (int i = 0; i < 32; ++i) { const int kk = 2 * i + (lane >> 5); scr[kk * 33 + (lane & 31)] = W[(size_t)(k0 + kk) * N + n0 + (lane & 31)] * scale; }
    WAVE_SYNC();
#pragma unroll
    for (int j = 0; j < 2; ++j) { const int n = lane & 31, c = (lane >> 5) + 2 * j; const LAS float* s = scr + (16 * c) * 33 + n;
        u32x4 o; o.x = pk4_fp8(s[0 * 33], s[1 * 33], s[2 * 33], s[3 * 33]); o.y = pk4_fp8(s[4 * 33], s[5 * 33], s[6 * 33], s[7 * 33]);
        o.z = pk4_fp8(s[8 * 33], s[9 * 33], s[10 * 33], s[11 * 33]); o.w = pk4_fp8(s[12 * 33], s[13 * 33], s[14 * 33], s[15 * 33]);
        *(u32x4*)(WT + (size_t)(dr + n) * K + k0 + 16 * c) = o; }
    WAVE_SYNC();
}

__device__ __forceinline__ const float* ld_ptr(volatile LAS unsigned long long* t, int k) {
    const unsigned long long v = t[k]; const unsigned lo = __builtin_amdgcn_readfirstlane((unsigned)v), hi = __builtin_amdgcn_readfirstlane((unsigned)(v >> 32));
    return (const float*)(const GAS float*)(((unsigned long long)hi << 32) | lo);
}
__device__ __forceinline__ void phase_prologue(const Ctx& X, volatile LAS unsigned long long* ptab) {
#define in_(k) ld_ptr(ptab, k)
    const float* a_re = in_(3); const float* a_im = in_(4); const float* log_dt = in_(5); const float* b_re = in_(6); const float* b_im = in_(7);
    float2* Abar = (float2*)(X.ws + WS_S5A); float2* Bbar = (float2*)(X.ws + WS_S5B); float2* rope = (float2*)(X.ws + WS_ROPE);
    const int gt = X.bid * NTHR + X.tid, NT = X.G * NTHR;
    for (int it = gt; it < 2 * SSM_G * SSM_P; it += NT) {
        const int ig = it >> 6;
        const double lam_re = fmin((double)a_re[it], -1e-4), lam_im = (double)a_im[it];
        const double dt = exp((double)log_dt[ig]);
        const double mag = exp(lam_re * dt), ang = lam_im * dt;
        const double abr = mag * cos(ang), abi = mag * sin(ang);
        const double nr = abr - 1.0, ni = abi, den = lam_re * lam_re + lam_im * lam_im;
        const double cr = (nr * lam_re + ni * lam_im) / den, ci = (ni * lam_re - nr * lam_im) / den;
        Abar[it] = make_float2((float)abr, (float)abi);
        for (int h = 0; h < SSM_H; ++h) {
            const double br = (double)b_re[it * 16 + h], bi = (double)b_im[it * 16 + h];
            Bbar[it * 16 + h] = make_float2((float)(cr * br - ci * bi), (float)(cr * bi + ci * br));
        }
    }
    for (int it = gt; it < SEQ * 32; it += NT) {
        const int pos = it >> 5, i = it & 31;
        const float inv = powf(10000.0f, -(float)i / 32.0f);
        const float ang = (float)pos * inv;
        rope[it] = make_float2((float)cos((double)ang), (float)sin((double)ang));
    }
    { const float* rw = in_(20); bf16_t* RWh = (bf16_t*)(X.ws + WS_RWH); bf16_t* RWl = (bf16_t*)(X.ws + WS_RWL);
      for (int it = gt; it < DEPTH * NE * D; it += NT) { const int k = it & 1023, e = (it >> 10) & 31, l = it >> 15;
          const float w = rw[((size_t)l * D + k) * NE + e]; const unsigned hb = f2bf(w); RWh[it] = (bf16_t)hb; RWl[it] = (bf16_t)f2bf(w - bf2f((bf16_t)hb)); } }
    { const float* x = in_(0); bf16_t* H0 = (bf16_t*)(X.ws + WS_H0);
      const size_t n8 = (size_t)T * D / 8;
      for (size_t i8 = (size_t)gt; i8 < n8; i8 += (size_t)NT) {
          const f32x4 a = *(const f32x4*)(x + i8 * 8), b = *(const f32x4*)(x + i8 * 8 + 4);
          u32x4 o; o.x = pk2(a[0], a[1]); o.y = pk2(a[2], a[3]); o.z = pk2(b[0], b[1]); o.w = pk2(b[2], b[3]);
          *(u32x4*)(H0 + i8 * 8) = o; } }
    LAS float* scr = (LAS float*)(X.lds + X.wave * 16384);
    const int gw = X.bid * NWAVES + X.wave, NGW = X.G * NWAVES;
    constexpr int I_GU = 16 * 64, I_DN = 16 * 32, I_IN = 16 * 64, I_GLU = 8 * 16, I_OUT = 16 * 32, I_QKV = 16 * 96, I_O = 16 * 32;
    constexpr int N_GU = 128 * I_GU, N_DN = 128 * I_DN, N_IN = 2 * I_IN, N_GLU = 2 * I_GLU, N_OUT = 2 * I_OUT, N_QKV = 2 * I_QKV, N_O = 2 * I_O;
    constexpr int NITEMS = N_GU + N_DN + N_IN + N_GLU + N_OUT + N_QKV + N_O;
    for (int it = gw; it < NITEMS; it += NGW) {
        int r = it;
        if (r < N_GU) { const int m = r / I_GU; transpose_item_fp8<1>(in_(22) + (size_t)m * D * 2048, D, 2048, X.ws + WS_WGU + (size_t)m * 2048 * D, scr, r % I_GU, X.lane, (float)(1 << W8_SHIFT_GU)); continue; } r -= N_GU;
        if (r < N_DN) { const int m = r / I_DN; transpose_item_fp8<0>(in_(24) + (size_t)m * D * D, D, D, X.ws + WS_WDN + (size_t)m * D * D, scr, r % I_DN, X.lane, (float)(1 << W8_SHIFT_DN)); continue; } r -= N_DN;
        if (r < N_IN) { const int m = r / I_IN; transpose_item<0>(in_(1) + (size_t)m * D * 2048, D, 2048, (bf16_t*)(X.ws + WS_WIN) + (size_t)m * 2048 * D, scr, r % I_IN, X.lane); continue; } r -= N_IN;
        if (r < N_GLU) { const int m = r / I_GLU; transpose_item<0>(in_(11) + (size_t)m * 512 * 512, 512, 512, (bf16_t*)(X.ws + WS_WGLU) + (size_t)m * 512 * 512, scr, r % I_GLU, X.lane); continue; } r -= N_GLU;
        if (r < N_OUT) { const int m = r / I_OUT; transpose_item<0>(in_(13) + (size_t)m * D * D, D, D, (bf16_t*)(X.ws + WS_WOUT) + (size_t)m * D * D, scr, r % I_OUT, X.lane); continue; } r -= N_OUT;
        if (r < N_QKV) { const int m = r / I_QKV; transpose_item<2>(in_(14) + (size_t)m * D * 3072, D, 3072, (bf16_t*)(X.ws + WS_WQKV) + (size_t)m * 3072 * D, scr, r % I_QKV, X.lane); continue; } r -= N_QKV;
        { const int m = r / I_O; transpose_item<0>(in_(15) + (size_t)m * D * D, D, D, (bf16_t*)(X.ws + WS_WO) + (size_t)m * D * D, scr, r % I_O, X.lane); }
    }
}

#undef in_
typedef float f32x4v __attribute__((ext_vector_type(4)));
template <int PASS>
__device__ __forceinline__ void phase_s5(const Ctx& X, int i, const bf16_t* proj, const float* conv_w, const float* c_re, const float* c_im, const float* d_skip, bf16_t* mix, bf16_t* Z) {
    using pg8::bf16x8;
    if (PASS == 2) {
        const float* w = conv_w + (size_t)i * 3 * CONV_CH;
        const size_t n = (size_t)T * (CONV_CH / 8);
        for (size_t idx = (size_t)X.bid * NTHR + X.tid; idx < n; idx += (size_t)X.G * NTHR) {
            const int bt = (int)(idx >> 6), c = (int)(idx & 63) * 8, pos = seqpos(bt);
            const bf16_t* pr = proj + (size_t)bt * 2048;
            float gb[8], a2[8], b2[8], a1[8], b1[8], a0[8], b0[8];
            unpack8(*(const u32x4*)(pr + c), gb); unpack8(*(const u32x4*)(pr + 512 + c), a2); unpack8(*(const u32x4*)(pr + 1024 + c), b2);
            if (pos >= 1) { unpack8(*(const u32x4*)(pr + 512 + c - 2048), a1); unpack8(*(const u32x4*)(pr + 1024 + c - 2048), b1); }
            if (pos >= 2) { unpack8(*(const u32x4*)(pr + 512 + c - 4096), a0); unpack8(*(const u32x4*)(pr + 1024 + c - 4096), b0); }
            float o[8];
#pragma unroll
            for (int j = 0; j < 8; ++j) {
                float s = w[2 * CONV_CH + c + j] * (a2[j] * b2[j]);
                if (pos >= 1) s += w[1 * CONV_CH + c + j] * (a1[j] * b1[j]);
                if (pos >= 2) s += w[0 * CONV_CH + c + j] * (a0[j] * b0[j]);
                o[j] = gb[j] * s; }
            *(u32x4*)(mix + (size_t)bt * D + c) = pack8(o);
        }
    }
    const int lane = X.lane, n16 = lane & 15, kq = lane >> 4;
    LAS float* BuT = (LAS float*)(X.lds + X.wave * 15360);
    LAS unsigned char* xsb = X.lds + X.wave * 15360 + 10240;
    const float2* Abar = (const float2*)(X.ws + WS_S5A); const float2* Bbar = (const float2*)(X.ws + WS_S5B);
    float2* Sst = (float2*)(X.ws + WS_S5S);
    const int gw = X.bid * NWAVES + X.wave, NGW = X.G * NWAVES;
    for (int task = gw; task < BATCH * 64 * SSM_G; task += NGW) {
        const int g = task & 31, c = (task >> 5) & 63, b = task >> 11, ig = i * 32 + g;
        const float2 A = Abar[ig * 64 + lane];
        bf16x8 bfr[8];
#pragma unroll
        for (int cb = 0; cb < 8; ++cb) {
            u32x4 w = (u32x4){0u, 0u, 0u, 0u};
            if (kq < 2) { const float2* bp = Bbar + ((size_t)(ig * 64 + 16 * (cb & 3) + n16)) * 16 + 8 * kq; float v[8];
#pragma unroll
                for (int j = 0; j < 8; ++j) { const float2 t2 = bp[j]; v[j] = cb < 4 ? t2.x : t2.y; }
                w = pack8(v); }
            bfr[cb] = __builtin_bit_cast(bf16x8, w);
        }
        bf16x8 cfr[4]; bf16x8 dfr;
        if (PASS == 2) {
#pragma unroll
            for (int ks = 0; ks < 4; ++ks) { const int p0 = 16 * ks + 4 * kq; const f32x4 cr = *(const f32x4*)(c_re + (size_t)(ig * 16 + n16) * 64 + p0), ci = *(const f32x4*)(c_im + (size_t)(ig * 16 + n16) * 64 + p0);
                u32x4 w; w.x = cvt_pk_bf16(cr[0], -ci[0]); w.y = cvt_pk_bf16(cr[1], -ci[1]); w.z = cvt_pk_bf16(cr[2], -ci[2]); w.w = cvt_pk_bf16(cr[3], -ci[3]); cfr[ks] = __builtin_bit_cast(bf16x8, w); }
            { const float dv = d_skip[ig * 16 + n16]; float v[8];
#pragma unroll
              for (int j = 0; j < 8; ++j) v[j] = (kq < 2 && 8 * kq + j == n16) ? dv : 0.f;
              dfr = __builtin_bit_cast(bf16x8, pack8(v)); }
        }
        float xr = 0.f, xi = 0.f;
        if (PASS == 2) { const float2 xin = ((const float2*)(X.ws + WS_S5X))[((size_t)(b * 32 + g) * 64 + c) * 64 + lane]; xr = xin.x; xi = xin.y; }
        const bf16_t* ub = proj + ((size_t)b * SEQ + (size_t)c * 128) * 2048 + 1536 + g * 16;
        bf16_t* zb = Z + ((size_t)b * SEQ + (size_t)c * 128) * SSM_W + g * 16;
        u32x4 uw = (u32x4){0u, 0u, 0u, 0u};
        if (kq < 2) uw = *(const u32x4*)(ub + (size_t)n16 * 2048 + 8 * kq);
#pragma nounroll
        for (int blk = 0; blk < 8; ++blk) {
            const bf16x8 ufr = __builtin_bit_cast(bf16x8, uw);
            u32x4 un = (u32x4){0u, 0u, 0u, 0u};
            if (kq < 2 && blk < 7) un = *(const u32x4*)(ub + (size_t)((blk + 1) * 16 + n16) * 2048 + 8 * kq);
#pragma unroll
            for (int cb = 0; cb < 8; ++cb) {
                f32x4v acc = (f32x4v){0.f, 0.f, 0.f, 0.f};
                acc = __builtin_amdgcn_mfma_f32_16x16x32_bf16(ufr, bfr[cb], acc, 0, 0, 0);
                *(LAS f32x4v*)(BuT + (16 * cb + n16) * 20 + 4 * kq) = acc;
            }
            WAVE_SYNC();
#pragma unroll
            for (int k4 = 0; k4 < 4; ++k4) {
                const f32x4v br = *(const LAS f32x4v*)(BuT + lane * 20 + 4 * k4), bi = *(const LAS f32x4v*)(BuT + (64 + lane) * 20 + 4 * k4);
#pragma unroll
                for (int s = 0; s < 4; ++s) {
                    float nr = fmaf(-A.y, xi, fmaf(A.x, xr, br[s])); asm volatile("" : "+v"(nr));
                    float ni = fmaf(A.y, xr, fmaf(A.x, xi, bi[s])); asm volatile("" : "+v"(ni));
                    xr = nr; xi = ni;
                    if (PASS == 2) *(LAS unsigned*)(xsb + (4 * k4 + s) * 272 + lane * 4) = cvt_pk_bf16(xr, xi);
                }
            }
            if (PASS == 2) {
                WAVE_SYNC();
                f32x4v y = (f32x4v){0.f, 0.f, 0.f, 0.f};
                bf16x8 xa[4];
#pragma unroll
                for (int ks = 0; ks < 4; ++ks) xa[ks] = *(const LAS bf16x8*)(xsb + n16 * 272 + ks * 64 + kq * 16);
                WAVE_SYNC(); __builtin_amdgcn_sched_barrier(0);
#pragma unroll
                for (int ks = 0; ks < 4; ++ks) y = __builtin_amdgcn_mfma_f32_16x16x32_bf16(xa[ks], cfr[ks], y, 0, 0, 0);
                y = __builtin_amdgcn_mfma_f32_16x16x32_bf16(ufr, dfr, y, 0, 0, 0);
                asm volatile("" :: "v"(xa[0]), "v"(xa[1]), "v"(xa[2]), "v"(xa[3]), "v"(ufr));
#pragma unroll
                for (int q = 0; q < 4; ++q) zb[(size_t)(blk * 16 + 4 * kq + q) * SSM_W + n16] = (bf16_t)f2bf(gelu_tanh(y[q]));
            }
            WAVE_SYNC();
            uw = un;
        }
        if (PASS == 1) Sst[((size_t)(b * 32 + g) * 64 + c) * 64 + lane] = make_float2(xr, xi);
    }
}

__device__ __forceinline__ void phase_s5_carry(const Ctx& X, int i) {
    const float2* Abar = (const float2*)(X.ws + WS_S5A); const float2* Sst = (const float2*)(X.ws + WS_S5S); float2* Xin = (float2*)(X.ws + WS_S5X);
    const int gw = X.bid * NWAVES + X.wave, NGW = X.G * NWAVES, lane = X.lane;
    for (int bg = gw; bg < BATCH * SSM_G; bg += NGW) {
        const float2 A = Abar[(i * 32 + (bg & 31)) * 64 + lane];
        float pr_ = A.x, pi_ = A.y;
#pragma unroll
        for (int q = 0; q < 7; ++q) { const float nr = pr_ * pr_ - pi_ * pi_, ni = 2.f * pr_ * pi_; pr_ = nr; pi_ = ni; }
        float xr = 0.f, xi = 0.f;
        const size_t base = (size_t)bg * 64 * 64 + lane;
#pragma unroll 8
        for (int c = 0; c < 64; ++c) {
            Xin[base + (size_t)c * 64] = make_float2(xr, xi);
            const float2 s = Sst[base + (size_t)c * 64];
            const float nr = pr_ * xr - pi_ * xi + s.x, ni = pr_ * xi + pi_ * xr + s.y; xr = nr; xi = ni;
        }
    }
}

typedef short v4i16_t __attribute__((ext_vector_type(4)));
typedef float f32x16 __attribute__((ext_vector_type(16)));
__device__ __forceinline__ v4i16_t vtr16(const LAS unsigned char* p) { return __builtin_amdgcn_ds_read_tr16_b64_v4i16((LAS v4i16_t*)p); }
__device__ __forceinline__ void phase_attn(const Ctx& X, const bf16_t* proj, bf16_t* att) {
    using pg8::bf16x8;
    const int lane = X.lane, i32 = lane & 31, hi = lane >> 5;
    LAS unsigned char* vbuf = X.lds + X.wave * 8192;
    const int gw = X.bid * NWAVES + X.wave, NGW = X.G * NWAVES;
    const float NEG = opaque_f(-3.0e38f); const int seqmax = opaque_i(SEQ - 1);
    const int vrd = ((lane >> 4) & 1) * 32 + (lane & 3) * 8 + (4 * hi + ((lane & 15) >> 2)) * 64;
    for (int task = gw; task < BATCH * NH * 256; task += NGW) {
        const int r = task & 15, blk = (task >> 4) & 15, hh = (task >> 8) & 15, b = task >> 12;
        const bf16_t* base = proj + (size_t)b * SEQ * 3072 + hh * 64;
        const int t0 = 512 * blk + r;
        bf16x8 qf[4];
        { const bf16_t* qp = base + (size_t)(t0 + 16 * i32) * 3072 + 8 * hi;
#pragma unroll
          for (int d0 = 0; d0 < 4; ++d0) qf[d0] = *(const bf16x8*)(qp + 16 * d0); }
        float m_run = NEG, l_run = 0.f;
        f32x16 o0, o1;
#pragma unroll
        for (int q = 0; q < 16; ++q) { o0[q] = 0.f; o1[q] = 0.f; }
        for (int pat = 0; pat < 3; ++pat) {
            const int dil = pat == 0 ? 16 : (pat == 1 ? 4 : 1), qs = pat == 0 ? 1 : (pat == 1 ? 4 : 16), ntl = pat == 0 ? 5 : (pat == 1 ? 8 : 20);
            const int rr = pat == 0 ? r : (pat == 1 ? (r & 3) : 0);
            const int M0 = (t0 - rr) / dil, Mstart = M0 - 128;
            const int qi = qs * i32;
            bf16x8 kf[4];
            auto keypos = [&](int M) { int p = dil * M + rr; p = p < 0 ? 0 : p; p = p > seqmax ? seqmax : p; return p; };
            auto issue = [&](int kt, bf16x8 (&kk)[4], int bufsel) {
                const bf16_t* kp = base + (size_t)keypos(Mstart + 32 * kt + i32) * 3072 + 1024 + 8 * hi;
#pragma unroll
                for (int d0 = 0; d0 < 4; ++d0) kk[d0] = *(const bf16x8*)(kp + 16 * d0);
#pragma unroll
                for (int kg = 0; kg < 2; ++kg) {
                    const bf16_t* vp = base + (size_t)keypos(Mstart + 32 * kt + 16 * kg + (lane >> 2)) * 3072 + 2048 + (lane & 3) * 8;
#pragma unroll
                    for (int dh = 0; dh < 2; ++dh)
                        __builtin_amdgcn_global_load_lds((const unsigned*)(vp + 32 * dh), (LAS unsigned*)(vbuf + bufsel * 4096 + (dh * 2 + kg) * 1024), 16, 0, 0);
                }
            };
            asm volatile("s_waitcnt lgkmcnt(0)" ::: "memory");
            issue(0, kf, 0);
            for (int kt = 0; kt < ntl; ++kt) {
                asm volatile("s_waitcnt vmcnt(0) lgkmcnt(0)" ::: "memory");
                bf16x8 kn[4];
                const int ktn = kt + 1 < ntl ? kt + 1 : kt;
                issue(ktn, kn, (kt + 1) & 1);
                f32x16 s;
#pragma unroll
                for (int q = 0; q < 16; ++q) s[q] = 0.f;
#pragma unroll
                for (int d0 = 0; d0 < 4; ++d0) s = __builtin_amdgcn_mfma_f32_32x32x16_bf16(kf[d0], qf[d0], s, 0, 0, 0);
                const int hi_ = qi + 128 - 32 * kt; int lo = hi_ - 128; { const int nk = -(Mstart + 32 * kt); lo = lo > nk ? lo : nk; }
                const int rb = 4 * hi - lo; const unsigned span = (unsigned)(hi_ - lo);
                const bool any = hi_ >= lo;
                float tmax = NEG;
#pragma unroll
                for (int q = 0; q < 16; ++q) { const int rowc = (q & 3) + 8 * (q >> 2); const bool ok = any && ((unsigned)(rowc + rb) <= span) && (rowc + rb >= 0); s[q] = ok ? s[q] : NEG; tmax = fmaxf(tmax, s[q]); }
                tmax = fmaxf(tmax, __shfl_xor(tmax, 32));
                const float m_new = fmaxf(m_run, tmax), sc = __builtin_amdgcn_exp2f(m_run - m_new);
                m_run = m_new;
                float ps = 0.f;
#pragma unroll
                for (int q = 0; q < 16; ++q) { s[q] = __builtin_amdgcn_exp2f(s[q] - m_new); ps += s[q]; }
                l_run = l_run * sc + ps;
#pragma unroll
                for (int q = 0; q < 16; ++q) { o0[q] *= sc; o1[q] *= sc; }
                u32x4 pw0, pw1;
                pw0.x = cvt_pk_bf16(s[0], s[1]); pw0.y = cvt_pk_bf16(s[2], s[3]); pw0.z = cvt_pk_bf16(s[4], s[5]); pw0.w = cvt_pk_bf16(s[6], s[7]);
                pw1.x = cvt_pk_bf16(s[8], s[9]); pw1.y = cvt_pk_bf16(s[10], s[11]); pw1.z = cvt_pk_bf16(s[12], s[13]); pw1.w = cvt_pk_bf16(s[14], s[15]);
                const bf16x8 pf0 = __builtin_bit_cast(bf16x8, pw0), pf1 = __builtin_bit_cast(bf16x8, pw1);
                const LAS unsigned char* vb = vbuf + (kt & 1) * 4096 + vrd;
#pragma unroll
                for (int dh = 0; dh < 2; ++dh) {
#pragma unroll
                    for (int kg = 0; kg < 2; ++kg) {
                        const v4i16_t vlo = vtr16(vb + (dh * 2 + kg) * 1024), vhi = vtr16(vb + (dh * 2 + kg) * 1024 + 512);
                        const bf16x8 vf = (bf16x8){vlo[0], vlo[1], vlo[2], vlo[3], vhi[0], vhi[1], vhi[2], vhi[3]};
                        if (dh == 0) o0 = __builtin_amdgcn_mfma_f32_32x32x16_bf16(vf, kg == 0 ? pf0 : pf1, o0, 0, 0, 0);
                        else o1 = __builtin_amdgcn_mfma_f32_32x32x16_bf16(vf, kg == 0 ? pf0 : pf1, o1, 0, 0, 0);
                    }
                }
#pragma unroll
                for (int d0 = 0; d0 < 4; ++d0) kf[d0] = kn[d0];
            }
            asm volatile("s_waitcnt vmcnt(0) lgkmcnt(0)" ::: "memory");
        }
        const float lt = l_run + __shfl_xor(l_run, 32), rl = 1.0f / lt;
        bf16_t* op = att + (size_t)(b * SEQ + t0 + 16 * i32) * D + hh * 64 + 4 * hi;
#pragma unroll
        for (int gq = 0; gq < 4; ++gq) {
            u32x2 w0, w1;
            w0.x = cvt_pk_bf16(o0[4 * gq] * rl, o0[4 * gq + 1] * rl); w0.y = cvt_pk_bf16(o0[4 * gq + 2] * rl, o0[4 * gq + 3] * rl);
            w1.x = cvt_pk_bf16(o1[4 * gq] * rl, o1[4 * gq + 1] * rl); w1.y = cvt_pk_bf16(o1[4 * gq + 2] * rl, o1[4 * gq + 3] * rl);
            *(u32x2*)(op + 8 * gq) = w0; *(u32x2*)(op + 32 + 8 * gq) = w1;
        }
    }
}

__device__ __forceinline__ void phase_ln_router(const Ctx& X, int layer, const bf16_t* hin, const bf16_t* mixo, const float* g, const float* bta, const float* rb, bf16_t* h1) {
    using pg8::bf16x8;
    LAS unsigned char* Ah = X.lds;
    LAS unsigned char* Al = X.lds + 65536;
    LAS float* P = (LAS float*)X.lds;
    LAS int* s_cnt = (LAS int*)(X.lds + TAB_OFF);
    LAS int* s_gb = s_cnt + 32;
    const int lane = X.lane, w = X.wave, tok = lane & 31, hi = lane >> 5;
    int* tok_e = (int*)(X.ws + WS_TOKE); int* tok_r = (int*)(X.ws + WS_TOKR); float* glist = (float*)(X.ws + WS_GLIST); unsigned char* XG8 = X.ws + WS_XG;
    unsigned* cnt = X.ctl + CW_CNT + layer * 32 * 64;
    bf16x8 wfh[8], wfl[8];
    { const bf16_t* rwh = (const bf16_t*)(X.ws + WS_RWH) + ((size_t)layer * NE + tok) * D + 128 * w + 8 * hi; const bf16_t* rwl = (const bf16_t*)(X.ws + WS_RWL) + ((size_t)layer * NE + tok) * D + 128 * w + 8 * hi;
#pragma unroll
      for (int i = 0; i < 8; ++i) { wfh[i] = *(const bf16x8*)(rwh + 16 * i); wfl[i] = *(const bf16x8*)(rwl + 16 * i); } }
    const float rbe = rb[tok]; const float ninf = opaque_f(-INFINITY);
    for (int tb = X.bid * 128; tb < T; tb += X.G * 128) {
        for (int rnd = 0; rnd < 4; ++rnd) {
            __syncthreads();
            if (X.tid < 32) s_cnt[X.tid] = 0;
            const int t0 = tb + rnd * 32 + w * 4;
            float v[4][16];
            float gg[16], bb[16];
            { const float* g2 = g; const float* b2 = bta; asm volatile("" : "+s"(g2), "+s"(b2));
#pragma unroll
              for (int j = 0; j < 2; ++j) {
                const f32x4 g0 = *(const f32x4*)(g2 + j * 512 + lane * 8), g1 = *(const f32x4*)(g2 + j * 512 + lane * 8 + 4), b0 = *(const f32x4*)(b2 + j * 512 + lane * 8), b1 = *(const f32x4*)(b2 + j * 512 + lane * 8 + 4);
#pragma unroll
                for (int q = 0; q < 4; ++q) { gg[j * 8 + q] = g0[q]; gg[j * 8 + 4 + q] = g1[q]; bb[j * 8 + q] = b0[q]; bb[j * 8 + 4 + q] = b1[q]; } } }
#pragma unroll
            for (int tl = 0; tl < 4; ++tl) {
                const size_t rowo = (size_t)(t0 + tl) * D;
                float s = 0.f;
#pragma unroll
                for (int j = 0; j < 2; ++j) { float a[8], m[8]; unpack8(*(const u32x4*)(hin + rowo + j * 512 + lane * 8), a); unpack8(*(const u32x4*)(mixo + rowo + j * 512 + lane * 8), m);
#pragma unroll
                    for (int q = 0; q < 8; ++q) { v[tl][j * 8 + q] = DN_ALPHA * a[q] + m[q]; s += v[tl][j * 8 + q]; } }
                const float mean = wave_sum(s) * (1.f / D); float s2 = 0.f;
#pragma unroll
                for (int q = 0; q < 16; ++q) { v[tl][q] -= mean; s2 += v[tl][q] * v[tl][q]; }
                const float rstd = rsqrtf(wave_sum(s2) * (1.f / D) + opaque_f(LN_EPS));
#pragma unroll
                for (int q = 0; q < 16; ++q) v[tl][q] = v[tl][q] * rstd * gg[q] + bb[q];
                const int tr = w * 4 + tl;
#pragma unroll
                for (int j = 0; j < 2; ++j) {
                    u32x4 oh, ol; float lo[8];
                    oh.x = cvt_pk_bf16(v[tl][j * 8 + 0], v[tl][j * 8 + 1]); oh.y = cvt_pk_bf16(v[tl][j * 8 + 2], v[tl][j * 8 + 3]); oh.z = cvt_pk_bf16(v[tl][j * 8 + 4], v[tl][j * 8 + 5]); oh.w = cvt_pk_bf16(v[tl][j * 8 + 6], v[tl][j * 8 + 7]);
                    float hf[8]; unpack8(oh, hf);
#pragma unroll
                    for (int q = 0; q < 8; ++q) lo[q] = v[tl][j * 8 + q] - hf[q];
                    ol = pack8(lo);
                    *(u32x4*)(h1 + rowo + j * 512 + lane * 8) = oh;
                    const int ch = ((lane + 64 * j) ^ (tr & 7)) << 4;
                    *(LAS u32x4*)(Ah + tr * 2048 + ch) = oh; *(LAS u32x4*)(Al + tr * 2048 + ch) = ol;
                }
            }
            __syncthreads();
            f32x16 acc;
#pragma unroll
            for (int q = 0; q < 16; ++q) acc[q] = 0.f;
#pragma unroll
            for (int i = 0; i < 8; ++i) {
                const int ch = ((2 * (8 * w + i) + hi) ^ (tok & 7)) << 4;
                const bf16x8 bh = *(const LAS bf16x8*)(Ah + tok * 2048 + ch), bl = *(const LAS bf16x8*)(Al + tok * 2048 + ch);
                acc = __builtin_amdgcn_mfma_f32_32x32x16_bf16(wfh[i], bh, acc, 0, 0, 0);
                acc = __builtin_amdgcn_mfma_f32_32x32x16_bf16(wfl[i], bh, acc, 0, 0, 0);
                acc = __builtin_amdgcn_mfma_f32_32x32x16_bf16(wfh[i], bl, acc, 0, 0, 0);
            }
            __syncthreads();
#pragma unroll
            for (int q = 0; q < 16; ++q) P[(w * 32 + tok) * 33 + (q & 3) + 8 * (q >> 2) + 4 * hi] = acc[q];
            __syncthreads();
            float lg[4];
#pragma unroll
            for (int tl = 0; tl < 4; ++tl) { float a = 0.f;
#pragma unroll
                for (int ww = 0; ww < 4; ++ww) a += P[((hi * 4 + ww) * 32 + (w * 4 + tl)) * 33 + tok];
                a += __shfl_xor(a, 32); lg[tl] = a + rbe; }
            const int e = tok;
            int my_e = 0; float my_g = 0.f;
#pragma unroll
            for (int tl = 0; tl < 4; ++tl) {
                float cur = lg[tl];
                float sv0 = 0.f, sv1 = 0.f, sv2 = 0.f, sv3 = 0.f; int si0 = 0, si1 = 0, si2 = 0, si3 = 0;
#pragma unroll
                for (int k = 0; k < 4; ++k) {
                    float bv = cur; int bi = e;
#pragma unroll
                    for (int o = 1; o < 32; o <<= 1) { const float ov = __shfl_xor(bv, o); const int oi = __shfl_xor(bi, o); if (ov > bv || (ov == bv && oi < bi)) { bv = ov; bi = oi; } }
                    if (k == 0) { sv0 = bv; si0 = bi; } else if (k == 1) { sv1 = bv; si1 = bi; } else if (k == 2) { sv2 = bv; si2 = bi; } else { sv3 = bv; si3 = bi; }
                    if (e == bi) cur = ninf;
                }
                const float e1 = __expf(sv1 - sv0), e2 = __expf(sv2 - sv0), e3 = __expf(sv3 - sv0), inv = 1.f / (1.f + e1 + e2 + e3);
                if ((lane >> 2) == tl) { const int k = lane & 3; my_e = k == 0 ? si0 : k == 1 ? si1 : k == 2 ? si2 : si3; my_g = (k == 0 ? 1.f : k == 1 ? e1 : k == 2 ? e2 : e3) * inv; }
            }
            int my_lr = 0;
            if (lane < 16) my_lr = __hip_atomic_fetch_add(&s_cnt[my_e], 1, __ATOMIC_RELAXED, __HIP_MEMORY_SCOPE_WORKGROUP);
            __syncthreads();
            if (X.tid < 32) { const int c = s_cnt[X.tid]; s_gb[X.tid] = c ? (int)atomicAdd(cnt + X.tid * 64, (unsigned)c) : 0; }
            __syncthreads();
            int my_r = 0;
            if (lane < 16) { my_r = s_gb[my_e] + my_lr; const int t = t0 + (lane >> 2); tok_e[t * 4 + (lane & 3)] = my_e; tok_r[t * 4 + (lane & 3)] = my_r; glist[(size_t)my_e * T + my_r] = my_g; }
#pragma unroll
            for (int tl = 0; tl < 4; ++tl) {
                u32x2 o0, o1;
                o0.x = pk4_fp8(v[tl][0], v[tl][1], v[tl][2], v[tl][3]); o0.y = pk4_fp8(v[tl][4], v[tl][5], v[tl][6], v[tl][7]);
                o1.x = pk4_fp8(v[tl][8], v[tl][9], v[tl][10], v[tl][11]); o1.y = pk4_fp8(v[tl][12], v[tl][13], v[tl][14], v[tl][15]);
#pragma unroll
                for (int k = 0; k < 4; ++k) { const int ee = __shfl(my_e, tl * 4 + k), rr = __shfl(my_r, tl * 4 + k);
                    unsigned char* dst = XG8 + ((size_t)ee * T + rr) * D + lane * 8;
                    *(u32x2*)(dst) = o0; *(u32x2*)(dst + 512) = o1; }
            }
        }
    }
}

__device__ __forceinline__ void load_tile_table(const Ctx& X, int layer, LAS int* tb) {
    __syncthreads();
    if (X.tid < 64) {
        const int c = X.tid < 32 ? (int)__hip_atomic_load(X.ctl + CW_CNT + (layer * 32 + X.tid) * 64, RLX_AGENT) : 0;
        const int tl = (c + 255) >> 8; int incl = tl;
#pragma unroll
        for (int o = 1; o < 32; o <<= 1) { const int t = __shfl_up(incl, o); if ((X.tid & 31) >= o) incl += t; }
        if (X.tid < 32) { tb[X.tid] = incl - tl; if (X.tid == 31) tb[32] = incl; }
    }
    __syncthreads();
}

template <bool OUT_F32>
__device__ __forceinline__ void phase_combine_ln(const Ctx& X, int layer, const bf16_t* h1, const bf16_t* Y, const float* g, const float* bta, void* outp) {
    const int lane = X.lane;
    const int gw = X.bid * NWAVES + X.wave, NGW = X.G * NWAVES;
    const int* tok_e = (const int*)(X.ws + WS_TOKE); const int* tok_r = (const int*)(X.ws + WS_TOKR);
    int basev = 0;
    { const int c = lane < 32 ? (int)__hip_atomic_load(X.ctl + CW_CNT + (layer * 32 + lane) * 64, RLX_AGENT) : 0; const int pc = ((c + 255) >> 8) << 8; int incl = pc;
#pragma unroll
      for (int o = 1; o < 32; o <<= 1) { const int t = __shfl_up(incl, o); if ((lane & 31) >= o) incl += t; }
      basev = incl - pc; }
    float gg[16], bb[16];
#pragma unroll
    for (int j = 0; j < 2; ++j) {
        const f32x4 g0 = *(const f32x4*)(g + j * 512 + lane * 8), g1 = *(const f32x4*)(g + j * 512 + lane * 8 + 4), b0 = *(const f32x4*)(bta + j * 512 + lane * 8), b1 = *(const f32x4*)(bta + j * 512 + lane * 8 + 4);
#pragma unroll
        for (int q = 0; q < 4; ++q) { gg[j * 8 + q] = g0[q]; gg[j * 8 + 4 + q] = g1[q]; bb[j * 8 + q] = b0[q]; bb[j * 8 + 4 + q] = b1[q]; }
    }
    for (int bt = gw; bt < T; bt += NGW) {
        int myslot = 0;
        if (lane < 4) myslot = tok_r[bt * 4 + lane];
        const int mye = lane < 4 ? tok_e[bt * 4 + lane] : 0;
        myslot += __shfl(basev, mye);
        const int s0 = __shfl(myslot, 0), s1 = __shfl(myslot, 1), s2 = __shfl(myslot, 2), s3 = __shfl(myslot, 3);
        float v[16]; float s = 0.f;
#pragma unroll
        for (int j = 0; j < 2; ++j) {
            const int off = j * 512 + lane * 8;
            float a[8], y0[8], y1[8], y2[8], y3[8];
            unpack8(*(const u32x4*)(h1 + (size_t)bt * D + off), a);
            unpack8(*(const u32x4*)(Y + (size_t)s0 * D + off), y0); unpack8(*(const u32x4*)(Y + (size_t)s1 * D + off), y1); unpack8(*(const u32x4*)(Y + (size_t)s2 * D + off), y2); unpack8(*(const u32x4*)(Y + (size_t)s3 * D + off), y3);
#pragma unroll
            for (int q = 0; q < 8; ++q) { v[j * 8 + q] = DN_ALPHA * a[q] + (((y0[q] + y1[q]) + y2[q]) + y3[q]); s += v[j * 8 + q]; }
        }
        const float mean = wave_sum(s) * (1.f / D); float s2q = 0.f;
#pragma unroll
        for (int q = 0; q < 16; ++q) { v[q] -= mean; s2q += v[q] * v[q]; }
        const float rstd = rsqrtf(wave_sum(s2q) * (1.f / D) + opaque_f(LN_EPS));
#pragma unroll
        for (int q = 0; q < 16; ++q) v[q] = v[q] * rstd * gg[q] + bb[q];
#pragma unroll
        for (int j = 0; j < 2; ++j) {
            const size_t o = (size_t)bt * D + j * 512 + lane * 8;
            if (OUT_F32) { float* op = (float*)outp + o; *(f32x4*)(op) = (f32x4){v[j * 8 + 0], v[j * 8 + 1], v[j * 8 + 2], v[j * 8 + 3]}; *(f32x4*)(op + 4) = (f32x4){v[j * 8 + 4], v[j * 8 + 5], v[j * 8 + 6], v[j * 8 + 7]}; }
            else { u32x4 w; w.x = cvt_pk_bf16(v[j * 8 + 0], v[j * 8 + 1]); w.y = cvt_pk_bf16(v[j * 8 + 2], v[j * 8 + 3]); w.z = cvt_pk_bf16(v[j * 8 + 4], v[j * 8 + 5]); w.w = cvt_pk_bf16(v[j * 8 + 6], v[j * 8 + 7]); *(u32x4*)((bf16_t*)outp + o) = w; }
        }
    }
}


__device__ __forceinline__ Ctx refresh_ctx(const Ctx& X0) {
    Ctx X = X0; int wv = X0.wave; asm volatile("" : "+s"(wv)); int t = wv * 64 + lane_id(); asm volatile("" : "+v"(t)); X.tid = t; X.lane = t & 63; X.wave = wv;
    asm volatile("" : "+s"(X.ws), "+s"(X.ctl), "+s"(X.G), "+s"(X.bid));
    return X;
}
struct Args { const float* in[26]; float* out; unsigned char* ws; int ph_lo, ph_hi; };
constexpr int N_PHASES = 1 + 2 * (6 + 4) + 2 * (3 + 4);
#define GP_ALIGN true
#define GP_SP2 true

__global__ void __launch_bounds__(NTHR, 2) mk_fwd(Args args) {
    extern __shared__ __attribute__((aligned(16))) unsigned char lds_raw[];
    Ctx X0;
    X0.lds = (LAS unsigned char*)lds_raw;
    X0.tid = threadIdx.x; X0.lane = X0.tid & 63; X0.wave = __builtin_amdgcn_readfirstlane(X0.tid >> 6);
    X0.G = gridDim.x; X0.bid = blockIdx.x;
    X0.ws = args.ws; X0.ctl = (unsigned*)(args.ws + WS_CTL);
    volatile LAS unsigned* MISC = (volatile LAS unsigned*)(X0.lds + MISC_OFF);
    if (X0.tid < 32) MISC[X0.tid] = 0u;
    __syncthreads();
    XcdBarrier bar; bar.bar = X0.ctl + CW_BAR; bar.x = 0; bar.st = nullptr;
    if (MK_ONE_LAUNCH) bar = xcd_barrier_post(X0.ctl + CW_BAR, MISC + 8);
    volatile LAS unsigned long long* ptab = (volatile LAS unsigned long long*)(X0.lds + TAB_OFF + 1024);
    if (X0.tid < 26) ptab[X0.tid] = (unsigned long long)args.in[X0.tid];
    __syncthreads();
#define INP(k) ld_ptr(ptab, k)
    const int lo = args.ph_lo, hi = args.ph_hi;
    int ph = 0;
#define IN() (lo <= ph && ph < hi)
#define SEAM() do { if (MK_ONE_LAUNCH && lo <= ph && ph + 1 < hi) xcd_barrier(bar); ++ph; } while (0)

#define H0 ((bf16_t*)(X.ws + WS_H0))
#define H1 ((bf16_t*)(X.ws + WS_H1))
#define PROJ ((bf16_t*)(X.ws + WS_PROJ))
#define MIX ((bf16_t*)(X.ws + WS_MIX))
#define MIXO ((bf16_t*)(X.ws + WS_MIXO))
#define Z ((bf16_t*)(X.ws + WS_Z))
#define ACT ((bf16_t*)(X.ws + WS_ACT))
#define Y ((bf16_t*)(X.ws + WS_Y))
#define tb ((LAS int*)(X.lds + TAB_OFF + 512))

#ifndef DUP_MASK
#define DUP_MASK 0
#endif
    enum { P_PRO, P_E1, P_S5A, P_S5C, P_S5B, P_E3, P_E4, P_O1, P_ATT, P_O3, P_LNA, P_M1, P_M2, P_LNB };
#define PHASE_BEGIN(k) _Pragma("nounroll") for (int _r = 0; _r < ((((DUP_MASK) >> (k)) & 1) + 1); ++_r) { if (IN()) { const Ctx X = refresh_ctx(X0);
#define PHASE_END } SEAM(); }
    PHASE_BEGIN(P_PRO)  phase_prologue(X, ptab);  PHASE_END

#pragma nounroll
    for (int layer = 0; layer < DEPTH; ++layer) {
        const int i = layer >> 1;
        if ((layer & 1) == 0) {
            PHASE_BEGIN(P_E1)  pg8::Gemm gm{H0, (const bf16_t*)(X.ws + WS_WIN) + (size_t)i * 2048 * D, T, 2048, D}; pg8::StaticOrder S; S.init(T, 2048, D, X.G, X.bid);
                pg8::EpiStore E{PROJ, 2048};
                pg8::gemm_phase<pg8::EpiStore, pg8::StaticOrder, GP_ALIGN, GP_SP2>(X.lds, gm, S, E, X.wave);  PHASE_END
            PHASE_BEGIN(P_S5A)  phase_s5<1>(X, i, PROJ, INP(2), INP(8), INP(9), INP(10), MIX, Z);  PHASE_END
            PHASE_BEGIN(P_S5C)  phase_s5_carry(X, i);  PHASE_END
            PHASE_BEGIN(P_S5B)  phase_s5<2>(X, i, PROJ, INP(2), INP(8), INP(9), INP(10), MIX, Z);  PHASE_END
            PHASE_BEGIN(P_E3)  pg8::Gemm gm{Z, (const bf16_t*)(X.ws + WS_WGLU) + (size_t)i * 512 * 512, T, 512, 512}; pg8::StaticOrder S; S.init(T, 512, 512, X.G, X.bid);
                pg8::EpiGlu E{Z, MIX, INP(12) + (size_t)i * SSM_W};
                pg8::gemm_phase<pg8::EpiGlu, pg8::StaticOrder, GP_ALIGN, GP_SP2>(X.lds, gm, S, E, X.wave);  PHASE_END
            PHASE_BEGIN(P_E4)  pg8::Gemm gm{MIX, (const bf16_t*)(X.ws + WS_WOUT) + (size_t)i * D * D, T, D, D}; pg8::StaticOrder S; S.init(T, D, D, X.G, X.bid);
                pg8::EpiStore E{MIXO, D};
                pg8::gemm_phase<pg8::EpiStore, pg8::StaticOrder, GP_ALIGN, GP_SP2>(X.lds, gm, S, E, X.wave);  PHASE_END
        } else {
            PHASE_BEGIN(P_O1)  pg8::Gemm gm{H0, (const bf16_t*)(X.ws + WS_WQKV) + (size_t)i * 3072 * D, T, 3072, D}; pg8::StaticOrder S; S.init(T, 3072, D, X.G, X.bid);
                pg8::EpiRope E{PROJ, (const f32x2*)(X.ws + WS_ROPE)};
                pg8::gemm_phase<pg8::EpiRope, pg8::StaticOrder, GP_ALIGN, GP_SP2>(X.lds, gm, S, E, X.wave);  PHASE_END
            PHASE_BEGIN(P_ATT)  phase_attn(X, PROJ, MIX);  PHASE_END
            PHASE_BEGIN(P_O3)  pg8::Gemm gm{MIX, (const bf16_t*)(X.ws + WS_WO) + (size_t)i * D * D, T, D, D}; pg8::StaticOrder S; S.init(T, D, D, X.G, X.bid);
                pg8::EpiStore E{MIXO, D};
                pg8::gemm_phase<pg8::EpiStore, pg8::StaticOrder, GP_ALIGN, GP_SP2>(X.lds, gm, S, E, X.wave);  PHASE_END
        }
        PHASE_BEGIN(P_LNA)  phase_ln_router(X, layer, H0, MIXO, INP(16) + layer * D, INP(17) + layer * D, INP(21) + layer * NE, H1);  PHASE_END
        PHASE_BEGIN(P_M1)  load_tile_table(X, layer, tb);
            pg8::Gemm gm{(const bf16_t*)(X.ws + WS_XG), (const bf16_t*)(X.ws + WS_WGU + (size_t)layer * NE * 2048 * D), 0, 2048, D / 2};
            pg8::MoeOrder<8, true> S; S.init(tb, X.G, X.bid, 2048, D / 2);
            pg8::EpiSwiglu E{ACT, INP(23) + (size_t)layer * NE * 2048};
            pg8::gemm_phase<pg8::EpiSwiglu, pg8::MoeOrder<8, true>, GP_ALIGN, GP_SP2, true>(X.lds, gm, S, E, X.wave, opaque_i(127 - W8_SHIFT_GU), opaque_i(127));  PHASE_END
        PHASE_BEGIN(P_M2)  load_tile_table(X, layer, tb);
            pg8::Gemm gm{ACT, (const bf16_t*)(X.ws + WS_WDN + (size_t)layer * NE * D * D), 0, D, D / 2};
            pg8::MoeOrder<4, false> S; S.init(tb, X.G, X.bid, D, D / 2);
            pg8::EpiDown E{Y, INP(25) + (size_t)layer * NE * D, (const float*)(X.ws + WS_GLIST)};
            pg8::gemm_phase<pg8::EpiDown, pg8::MoeOrder<4, false>, GP_ALIGN, GP_SP2, true>(X.lds, gm, S, E, X.wave, opaque_i(127 - W8_SHIFT_DN), opaque_i(127));  PHASE_END
        PHASE_BEGIN(P_LNB)
            if (layer == DEPTH - 1) phase_combine_ln<true>(X, layer, H1, Y, INP(18) + layer * D, INP(19) + layer * D, (void*)args.out);
            else phase_combine_ln<false>(X, layer, H1, Y, INP(18) + layer * D, INP(19) + layer * D, (void*)H0);
         PHASE_END
    }
#undef IN
#undef SEAM
#undef PHASE_BEGIN
#undef PHASE_END
#undef H0
#undef H1
#undef PROJ
#undef MIX
#undef MIXO
#undef Z
#undef ACT
#undef Y
#undef tb
}

extern "C" void kernel_launch(void* const* d_in, const int* in_sizes, int n_in, void* d_out, int out_size, void* d_ws, size_t ws_size, hipStream_t stream) {
    static int grid = 0;
    if (grid == 0) {
        if (n_in != 26 || out_size != T * D || ws_size < WS_END) { fprintf(stderr, "kernel_launch: unexpected shapes n_in %d out %d ws %zu (need %zu)\n", n_in, out_size, ws_size, (size_t)WS_END); grid = -1; return; }
        int dev = 0, cus = 0, per_cu = 0;
        if (hipGetDevice(&dev) != hipSuccess || hipDeviceGetAttribute(&cus, hipDeviceAttributeMultiprocessorCount, dev) != hipSuccess) { grid = -1; return; }
        if (hipFuncSetAttribute((const void*)mk_fwd, hipFuncAttributeMaxDynamicSharedMemorySize, LDS_BYTES) != hipSuccess) { fprintf(stderr, "kernel_launch: hipFuncSetAttribute failed\n"); grid = -1; return; }
        if (hipOccupancyMaxActiveBlocksPerMultiprocessor(&per_cu, (const void*)mk_fwd, NTHR, LDS_BYTES) != hipSuccess || per_cu < 1) fprintf(stderr, "kernel_launch: occupancy query says %d\n", per_cu);
        (void)hipGetLastError();
        grid = cus;
    }
    if (grid < 0) return;
    if (hipMemsetAsync((char*)d_ws + WS_CTL, 0, CTL_ZERO_BYTES, stream) != hipSuccess) return;
    Args a{};
    for (int i = 0; i < 26; ++i) a.in[i] = (const float*)d_in[i];
    a.out = (float*)d_out; a.ws = (unsigned char*)d_ws;
#if MK_ONE_LAUNCH
    a.ph_lo = 0; a.ph_hi = DUP_MASK ? 100000 : N_PHASES;
    hipLaunchKernelGGL(mk_fwd, dim3(grid), dim3(NTHR), LDS_BYTES, stream, a);
#else
    for (int p = 0; p < N_PHASES; ++p) { a.ph_lo = p; a.ph_hi = p + 1; hipLaunchKernelGGL(mk_fwd, dim3(grid), dim3(NTHR), LDS_BYTES, stream, a); }
#endif
}
```

```cpp
#include <hip/hip_runtime.h>
#include <cstdio>
#include <cstdint>

#ifndef MK_ONE_LAUNCH
#define MK_ONE_LAUNCH 1
#endif

#define GAS __attribute__((address_space(1)))
#define LAS __attribute__((address_space(3)))
#define RLX_AGENT __ATOMIC_RELAXED, __HIP_MEMORY_SCOPE_AGENT
#define WAVE_SYNC() asm volatile("s_waitcnt lgkmcnt(0)" ::: "memory")
typedef float f32x4 __attribute__((ext_vector_type(4)));
typedef float f32x2 __attribute__((ext_vector_type(2)));
typedef unsigned u32x4 __attribute__((ext_vector_type(4)));
typedef unsigned u32x2 __attribute__((ext_vector_type(2)));
typedef unsigned short bf16_t;

constexpr int BATCH = 4, SEQ = 8192, D = 1024, T = BATCH * SEQ, DEPTH = 4;
constexpr int CONV_CH = 512, SSM_W = 512, SSM_G = 32, SSM_H = 16, SSM_P = 64;
constexpr int NH = 16, HD = 64;
constexpr int NE = 32, TOPK = 4, NA = T * TOPK;
constexpr float SW_LIMIT = 7.0f, SW_ALPHA = 1.702f;
constexpr float LN_EPS = 1e-5f;
constexpr float DN_ALPHA = 1.6817928305074290860622509524664f;
constexpr int NWAVES = 8, NTHR = 512;

constexpr size_t MiB = 1u << 20;
constexpr size_t WS_CTL = 0, CTL_ZERO_BYTES = 1 * MiB;
constexpr size_t WS_S5A = 1 * MiB;
constexpr size_t WS_S5B = 1 * MiB + 65536;
constexpr size_t WS_ROPE = 2 * MiB;
constexpr size_t WS_S5X = 48 * MiB;
constexpr size_t WS_TOKE = 4 * MiB;
constexpr size_t WS_TOKR = 4 * MiB + 524288;
constexpr size_t WS_RWH = 5 * MiB;
constexpr size_t WS_RWL = 5 * MiB + 262144;
constexpr size_t WS_GLIST = 8 * MiB;
constexpr size_t WS_S5S = 12 * MiB;
constexpr size_t WS_WIN = 16 * MiB;
constexpr size_t WS_WGLU = 24 * MiB;
constexpr size_t WS_WOUT = 26 * MiB;
constexpr size_t WS_WQKV = 32 * MiB;
constexpr size_t WS_WO = 44 * MiB;
constexpr size_t WS_WGU = 64 * MiB;
constexpr size_t WS_WDN = 576 * MiB;
constexpr size_t WS_H0 = 832 * MiB;
constexpr size_t WS_H1 = 896 * MiB;
constexpr size_t WS_PROJ = 960 * MiB;
constexpr size_t WS_MIX = 1152 * MiB;
constexpr size_t WS_MIXO = 1216 * MiB;
constexpr size_t WS_Z = 1280 * MiB;
constexpr size_t WS_ACT = 1312 * MiB;
constexpr size_t WS_Y = 1584 * MiB;
constexpr size_t WS_XG = 1856 * MiB;
constexpr size_t WS_END = 3904 * MiB;
constexpr int CW_BAR = 4096;
constexpr int CW_CNT = 16384;

constexpr int LDS_BYTES = 147456;
constexpr int MISC_OFF = 131072 + 320;
constexpr int TAB_OFF = 131072 + 1024;

#define XB_TMO      128
#define XB_XCNT(j)  (256  + 64 * (j))
#define XB_XSUB(j)  (1280 + 64 * (j))
#define XB_XGEN(j)  (2304 + 64 * (j))
#define XB_TOP      3328
#define XB_TOPGEN   3392
#define XCD_BAR_WORDS 3456
#define XB_SPIN_CAP (1u << 22)

__device__ __forceinline__ unsigned xb_ld(unsigned* p)              { return __hip_atomic_load(p, __ATOMIC_RELAXED, __HIP_MEMORY_SCOPE_AGENT); }
__device__ __forceinline__ unsigned xb_add(unsigned* p, unsigned v) { return __hip_atomic_fetch_add(p, v, __ATOMIC_RELAXED, __HIP_MEMORY_SCOPE_AGENT); }
__device__ __forceinline__ unsigned xb_xcc_id() { return (unsigned)__builtin_amdgcn_s_getreg((3 << 11) | 20) & 0xFu; }
#define XB_SPIN(cond, bar) do { unsigned _sp = 0; while (cond) { __builtin_amdgcn_s_sleep(1); \
    if ((++_sp & 255u) == 0u) { if (xb_ld(&(bar)[XB_TMO])) break; if (_sp > XB_SPIN_CAP) { atomicAdd(&(bar)[XB_TMO], 1u); break; } } } } while (0)

struct XcdBarrier { unsigned* bar; unsigned x; volatile LAS unsigned* st; };

__device__ __forceinline__ XcdBarrier xcd_barrier_post(unsigned* bar, volatile LAS unsigned* st) {
    XcdBarrier b; b.bar = bar; b.x = xb_xcc_id(); b.st = st;
    if (threadIdx.x == 0) (void)xb_add(&bar[XB_XCNT(b.x)], 1u);
    return b;
}
__device__ __forceinline__ void xcd_barrier_complete(unsigned* bar, unsigned x, unsigned& nloc, unsigned& nx) {
    const unsigned G = gridDim.x * gridDim.y * gridDim.z;
    unsigned sum, cnt, mine, sp = 0u;
    for (;;) {
        sum = 0u; cnt = 0u; mine = 0u;
#pragma unroll
        for (unsigned j = 0; j < 16; ++j) { const unsigned c = xb_ld(&bar[XB_XCNT(j)]); sum += c; cnt += (c > 0u) ? 1u : 0u; mine = (j == x) ? c : mine; }
        if (sum == G) break;
        __builtin_amdgcn_s_sleep(1);
        if ((++sp & 255u) == 0u) { if (xb_ld(&bar[XB_TMO])) break; if (sp > XB_SPIN_CAP) { atomicAdd(&bar[XB_TMO], 1u); break; } }
    }
    nloc = mine > 0u ? mine : 1u; nx = cnt > 0u ? cnt : 1u;
}
__device__ __forceinline__ void xcd_barrier(const XcdBarrier& b) {
    asm volatile("s_waitcnt vmcnt(0)" ::: "memory");
    __syncthreads();
    if (threadIdx.x == 0) {
        unsigned* bar = b.bar;
        __builtin_amdgcn_s_waitcnt(0);
        unsigned nloc = b.st[0], nx = b.st[1];
        if (nloc == 0u) { xcd_barrier_complete(bar, b.x, nloc, nx); b.st[0] = nloc; b.st[1] = nx; }
        const unsigned old = xb_add(&bar[XB_XSUB(b.x)], 1u);
        const unsigned gen = old / nloc;
        if (old + 1u == (gen + 1u) * nloc) {
            __builtin_amdgcn_fence(__ATOMIC_RELEASE, "agent");
            asm volatile("s_waitcnt vmcnt(0)" ::: "memory");
            const unsigned og = xb_add(&bar[XB_TOP], 1u);
            const unsigned tg = og / nx;
            if (og + 1u == (tg + 1u) * nx) xb_add(&bar[XB_TOPGEN], 1u);
            else XB_SPIN(xb_ld(&bar[XB_TOPGEN]) == tg, bar);
            __builtin_amdgcn_fence(__ATOMIC_ACQUIRE, "agent");
            xb_add(&bar[XB_XGEN(b.x)], 1u);
            asm volatile("s_waitcnt vmcnt(0)" ::: "memory");
        } else {
            XB_SPIN(xb_ld(&bar[XB_XGEN(b.x)]) == gen, bar);
            __builtin_amdgcn_fence(__ATOMIC_ACQUIRE, "agent");
            asm volatile("s_waitcnt vmcnt(0)" ::: "memory");
        }
    }
    __syncthreads();
}

__device__ __forceinline__ float wave_sum(float v) {
#pragma unroll
    for (int o = 1; o < 64; o <<= 1) v += __shfl_xor(v, o);
    return v;
}
__device__ __forceinline__ float wave_max(float v) {
#pragma unroll
    for (int o = 1; o < 64; o <<= 1) v = fmaxf(v, __shfl_xor(v, o));
    return v;
}
__device__ __forceinline__ float sigmoidf_(float x) { return __builtin_amdgcn_rcpf(1.0f + __builtin_amdgcn_exp2f(-1.4426950408889634f * x)); }
__device__ __forceinline__ float gelu_tanh(float y) { return y * sigmoidf_(1.5957691216057308f * (y + 0.044715f * y * y * y)); }
__device__ __forceinline__ float opaque_f(float v) { asm volatile("" : "+s"(v)); return v; }
__device__ __forceinline__ int opaque_i(int v) { asm volatile("" : "+s"(v)); return v; }
__device__ __forceinline__ int seqpos(int bt) { return bt - ((bt >> 13) << 13); }
__device__ __forceinline__ unsigned f2bf(float f) { unsigned u = __builtin_bit_cast(unsigned, f); return (u + 0x7fffu + ((u >> 16) & 1u)) >> 16; }
__device__ __forceinline__ unsigned pk2(float lo, float hi) { return f2bf(lo) | (f2bf(hi) << 16); }
typedef float f32x2_t_ __attribute__((ext_vector_type(2))); typedef __bf16 bf16x2_t_ __attribute__((ext_vector_type(2)));
__device__ __forceinline__ unsigned cvt_pk_bf16(float lo, float hi) { const f32x2_t_ v = {lo, hi}; const bf16x2_t_ b = __builtin_convertvector(v, bf16x2_t_); return __builtin_bit_cast(unsigned, b); }
__device__ __forceinline__ float bf_lo(unsigned w) { return __builtin_bit_cast(float, w << 16); }
__device__ __forceinline__ float bf_hi(unsigned w) { return __builtin_bit_cast(float, w & 0xffff0000u); }
__device__ __forceinline__ float bf2f(bf16_t b) { return __builtin_bit_cast(float, ((unsigned)b) << 16); }
__device__ __forceinline__ void unpack8(const u32x4 w, float (&f)[8]) { f[0] = bf_lo(w.x); f[1] = bf_hi(w.x); f[2] = bf_lo(w.y); f[3] = bf_hi(w.y); f[4] = bf_lo(w.z); f[5] = bf_hi(w.z); f[6] = bf_lo(w.w); f[7] = bf_hi(w.w); }
__device__ __forceinline__ u32x4 pack8(const float (&f)[8]) { u32x4 w; w.x = cvt_pk_bf16(f[0], f[1]); w.y = cvt_pk_bf16(f[2], f[3]); w.z = cvt_pk_bf16(f[4], f[5]); w.w = cvt_pk_bf16(f[6], f[7]); return w; }

__device__ __forceinline__ unsigned pk4_fp8(float a, float b, float c, float d) {
    int w = __builtin_amdgcn_cvt_pk_fp8_f32(a, b, 0, false); w = __builtin_amdgcn_cvt_pk_fp8_f32(c, d, w, true); return (unsigned)w; }
__device__ __forceinline__ u32x2 pack8_fp8(const float (&f)[8]) { u32x2 w; w.x = pk4_fp8(f[0], f[1], f[2], f[3]); w.y = pk4_fp8(f[4], f[5], f[6], f[7]); return w; }
constexpr int W8_SHIFT_GU = 5, W8_SHIFT_DN = 6;

__device__ __forceinline__ int lane_id() { return (int)__builtin_amdgcn_mbcnt_hi(~0u, __builtin_amdgcn_mbcnt_lo(~0u, 0u)); }

struct Ctx {
    LAS unsigned char* lds;
    int tid, lane, wave, G, bid;
    unsigned* ctl;
    GAS unsigned char* ws;
};

namespace pg8 {
#define PG8_LAS __attribute__((address_space(3)))
typedef short bf16x8 __attribute__((ext_vector_type(8)));
constexpr int BM = 256, BK = 64, HALF = 128, HTB = HALF * BK * 2  , STAGE_BYTES = 8 * HTB, NXCD = 8, WGM = 8;

__host__ __device__ __forceinline__ int lds_byte(int r, int c) { const int st = (r >> 4) * 2 + (c >> 5), rr = r & 15, cc = c & 31, ob = rr * 64 + cc * 2; return st * 1024 + (ob ^ (((ob >> 9) & 1) << 5)); }
__host__ __device__ __forceinline__ void stage_rc(int b, int& R, int& C) { const int st = b / 1024, sb = b % 1024, swz = sb ^ (((sb >> 9) & 1) << 5); R = (st >> 1) * 16 + swz / 64; C = (st & 1) * 32 + (swz % 64) / 2; }
__host__ __device__ __forceinline__ int perm32(int rho) { const int n = rho >> 4, i = rho & 15; return 8 * (i >> 2) + 4 * n + (i & 3); }

struct Unit { int pm, pn, e, mt; };
struct Gemm { const bf16_t* A; const bf16_t* Bt; int M, N, K; };

struct StaticOrder {
    int nM, nN, nwg, G, c; size_t tstep;
    __device__ void init(int M, int N, int K, int G_, int c_) { nM = M / BM; nN = N / BM; nwg = nM * nN; G = G_; c = c_; tstep = (size_t)BM * K * 2; }
    __device__ bool next(int i, Unit& u) const {
        const long L = (long)i * G + c; if (L >= nwg) return false;
        int wgid = (int)L; { const int q = nwg / NXCD, r = nwg % NXCD, xcd = wgid % NXCD, off = wgid / NXCD; wgid = (xcd < r ? xcd * (q + 1) : r * (q + 1) + (xcd - r) * q) + off; }
        const int nig = WGM * nN, gid = wgid / nig, fm = gid * WGM, gsz = (nM - fm) < WGM ? (nM - fm) : WGM;
        u.pm = fm + ((wgid % nig) % gsz); u.pn = (wgid % nig) / gsz; u.e = 0; u.mt = 0; return true;
    }
    __device__ __forceinline__ size_t a_off(const Unit& u) const { return (size_t)u.pm * tstep; }
    __device__ __forceinline__ size_t b_off(const Unit& u) const { return (size_t)u.pn * tstep; }
    __device__ __forceinline__ void a_ready(const Unit&) const {}
    __device__ __forceinline__ void done(const Unit&) const {}
};
template <int NPN, bool A_IS_XG> struct MoeOrder {
    const PG8_LAS int* tb; int G, c, ntile; size_t bexp, rowb;
    __device__ void init(const PG8_LAS int* tb_, int G_, int c_, int Nexp, int K) { tb = tb_; G = G_; c = c_; ntile = tb_[32]; rowb = (size_t)K * 2; bexp = (size_t)Nexp * rowb; }
    __device__ bool next(int i, Unit& u) const {
        int mtg, pn;
        if (G == 256) { constexpr int MPR = 256 / NPN, MPX = MPR / 8; mtg = MPR * i + MPX * (c & 7) + (c >> 3) / NPN; pn = (c >> 3) % NPN; }
        else { const long L = (long)i * G + c; mtg = (int)(L / NPN); pn = (int)(L % NPN); }
        if (mtg >= ntile) return false;
        int e = 0;
#pragma unroll
        for (int st = 16; st >= 1; st >>= 1) { const int tv = __builtin_amdgcn_readfirstlane(tb[e + st]); if (tv <= mtg) e += st; }
        u.pm = mtg; u.pn = pn; u.e = e; u.mt = mtg - tb[e]; return true;
    }
    __device__ __forceinline__ size_t a_off(const Unit& u) const { return A_IS_XG ? ((size_t)u.e * T + (size_t)u.mt * BM) * rowb : (size_t)u.pm * BM * rowb; }
    __device__ __forceinline__ size_t b_off(const Unit& u) const { return (size_t)u.e * bexp + (size_t)u.pn * BM * rowb; }
    __device__ __forceinline__ void a_ready(const Unit&) const {}
    __device__ __forceinline__ void done(const Unit&) const {}
};

__device__ __forceinline__ u32x4 pack_v(const f32x4 v0, const f32x4 v1) { u32x4 w; w.x = cvt_pk_bf16(v0[0], v0[1]); w.y = cvt_pk_bf16(v0[2], v0[3]); w.z = cvt_pk_bf16(v1[0], v1[1]); w.w = cvt_pk_bf16(v1[2], v1[3]); return w; }

struct EpiStore {
    static constexpr bool PERM = true, AFTER_DRAIN = false, BIAS_INIT = false;
    bf16_t* O; int ldc;
    __device__ __forceinline__ void operator()(const f32x4 (&acc)[2][2][4][2], const Unit& u, int wr, int wc, int fr, int fq) const {
        const int row0 = u.pm * BM + wr * 64 + fr, col0 = u.pn * BM + wc * 32 + 8 * fq;
#pragma unroll
        for (int ai = 0; ai < 2; ++ai)
#pragma unroll
            for (int m = 0; m < 4; ++m) { bf16_t* rowp = O + (size_t)(row0 + ai * HALF + m * 16) * ldc + col0;
#pragma unroll
                for (int bj = 0; bj < 2; ++bj) *(u32x4*)(rowp + bj * HALF) = pack_v(acc[ai][bj][m][0], acc[ai][bj][m][1]); }
    }
};
struct EpiGlu {
    static constexpr bool PERM = true, AFTER_DRAIN = false, BIAS_INIT = false;
    const bf16_t* Z; bf16_t* MIX; const float* bias;
    __device__ __forceinline__ void operator()(const f32x4 (&acc)[2][2][4][2], const Unit& u, int wr, int wc, int fr, int fq) const {
        const int row0 = u.pm * BM + wr * 64 + fr, col0 = u.pn * BM + wc * 32 + 8 * fq;
        f32x4 bv[2][2];
#pragma unroll
        for (int bj = 0; bj < 2; ++bj)
#pragma unroll
            for (int n = 0; n < 2; ++n) bv[bj][n] = *(const f32x4*)(bias + col0 + bj * HALF + 4 * n);
#pragma unroll
        for (int ai = 0; ai < 2; ++ai)
#pragma unroll
            for (int m = 0; m < 4; ++m) { const size_t row = (size_t)(row0 + ai * HALF + m * 16);
#pragma unroll
                for (int bj = 0; bj < 2; ++bj) {
                    const u32x4 zw = *(const u32x4*)(Z + row * SSM_W + col0 + bj * HALF); float z[8]; unpack8(zw, z);
                    const f32x4 a0 = acc[ai][bj][m][0] + bv[bj][0], a1 = acc[ai][bj][m][1] + bv[bj][1];
                    float o[8];
#pragma unroll
                    for (int j = 0; j < 4; ++j) { o[j] = z[j] * sigmoidf_(a0[j]); o[4 + j] = z[4 + j] * sigmoidf_(a1[j]); }
                    *(u32x4*)(MIX + row * D + 512 + col0 + bj * HALF) = pack8(o); } }
    }
};
struct EpiRope {
    static constexpr bool PERM = true, AFTER_DRAIN = false, BIAS_INIT = false;
    bf16_t* O; const f32x2* rope;
    __device__ __forceinline__ void operator()(const f32x4 (&acc)[2][2][4][2], const Unit& u, int wr, int wc, int fr, int fq) const {
        const int part = u.pn >> 2, tp = u.pn & 3;
        const int row0 = u.pm * BM + wr * 64 + fr, colb = part * 1024 + (4 * tp + wc) * 64 + 8 * fq;
        const float qs = part == 0 ? 0.125f * 1.4426950408889634f : 1.0f;
#pragma unroll
        for (int ai = 0; ai < 2; ++ai)
#pragma unroll
            for (int m = 0; m < 4; ++m) { const int row = row0 + ai * HALF + m * 16; bf16_t* rowp = O + (size_t)row * 3072 + colb;
                const f32x4 x1a = acc[ai][0][m][0], x1b = acc[ai][0][m][1], x2a = acc[ai][1][m][0], x2b = acc[ai][1][m][1];
                if (part < 2) {
                    const f32x4* rp = (const f32x4*)(rope + (size_t)seqpos(row) * 32 + 8 * fq);
                    const f32x4 c01 = rp[0], c23 = rp[1], c45 = rp[2], c67 = rp[3];
                    float o1[8], o2[8];
                    const float cs[8] = {c01[0], c01[2], c23[0], c23[2], c45[0], c45[2], c67[0], c67[2]}, sn[8] = {c01[1], c01[3], c23[1], c23[3], c45[1], c45[3], c67[1], c67[3]};
                    const float x1[8] = {x1a[0], x1a[1], x1a[2], x1a[3], x1b[0], x1b[1], x1b[2], x1b[3]}, x2[8] = {x2a[0], x2a[1], x2a[2], x2a[3], x2b[0], x2b[1], x2b[2], x2b[3]};
#pragma unroll
                    for (int j = 0; j < 8; ++j) { o1[j] = (x1[j] * cs[j] - x2[j] * sn[j]) * qs; o2[j] = (x2[j] * cs[j] + x1[j] * sn[j]) * qs; }
                    *(u32x4*)(rowp) = pack8(o1); *(u32x4*)(rowp + 32) = pack8(o2);
                } else { *(u32x4*)(rowp) = pack_v(x1a, x1b); *(u32x4*)(rowp + 32) = pack_v(x2a, x2b); } }
    }
};
struct EpiSwiglu {
    static constexpr bool PERM = true, AFTER_DRAIN = false, BIAS_INIT = true;
    bf16_t* ACT; const float* bgu;
    __device__ __forceinline__ void init(f32x4 (&acc)[2][2][4][2], const Unit& u, int wc, int fq) const {
        const float* bb = bgu + (size_t)u.e * 2048 + u.pn * 128 + wc * 32 + 8 * fq;
        const f32x4 bg0 = *(const f32x4*)(bb), bg1 = *(const f32x4*)(bb + 4), bl0 = *(const f32x4*)(bb + 1024), bl1 = *(const f32x4*)(bb + 1028);
#pragma unroll
        for (int ai = 0; ai < 2; ++ai)
#pragma unroll
            for (int m = 0; m < 4; ++m) { acc[ai][0][m][0] = bg0; acc[ai][0][m][1] = bg1; acc[ai][1][m][0] = bl0; acc[ai][1][m][1] = bl1; }
    }
    __device__ __forceinline__ void operator()(const f32x4 (&acc)[2][2][4][2], const Unit& u, int wr, int wc, int fr, int fq) const {
        const int row0 = u.pm * BM + wr * 64 + fr, j0 = u.pn * 128 + wc * 32 + 8 * fq;
        unsigned char* ab = (unsigned char*)ACT + (size_t)row0 * D + j0;
#pragma unroll
        for (int ai = 0; ai < 2; ++ai)
#pragma unroll
            for (int m = 0; m < 4; ++m) {
                const f32x4 g0 = acc[ai][0][m][0], g1 = acc[ai][0][m][1], l0 = acc[ai][1][m][0], l1 = acc[ai][1][m][1];
                float o[8];
#pragma unroll
                for (int j = 0; j < 4; ++j) {
                    const float ga = fminf(g0[j], SW_LIMIT), gb = fminf(g1[j], SW_LIMIT);
                    const float la = fminf(fmaxf(l0[j], -SW_LIMIT), SW_LIMIT), lb = fminf(fmaxf(l1[j], -SW_LIMIT), SW_LIMIT);
                    o[j] = (la + 1.0f) * (ga * sigmoidf_(SW_ALPHA * ga)); o[4 + j] = (lb + 1.0f) * (gb * sigmoidf_(SW_ALPHA * gb)); }
                *(u32x2*)(ab + (size_t)(ai * HALF + m * 16) * D) = pack8_fp8(o); }
    }
};
struct EpiDown {
    static constexpr bool PERM = true, AFTER_DRAIN = false, BIAS_INIT = true;
    bf16_t* Y; const float* bd; const float* glist;
    __device__ __forceinline__ void init(f32x4 (&acc)[2][2][4][2], const Unit& u, int wc, int fq) const {
        const float* bb = bd + (size_t)u.e * D + u.pn * BM + wc * 32 + 8 * fq;
        const f32x4 b00 = *(const f32x4*)(bb), b01 = *(const f32x4*)(bb + 4), b10 = *(const f32x4*)(bb + HALF), b11 = *(const f32x4*)(bb + HALF + 4);
#pragma unroll
        for (int ai = 0; ai < 2; ++ai)
#pragma unroll
            for (int m = 0; m < 4; ++m) { acc[ai][0][m][0] = b00; acc[ai][0][m][1] = b01; acc[ai][1][m][0] = b10; acc[ai][1][m][1] = b11; }
    }
    __device__ __forceinline__ void operator()(const f32x4 (&acc)[2][2][4][2], const Unit& u, int wr, int wc, int fr, int fq) const {
        const int rl0 = wr * 64 + fr, col0 = u.pn * BM + wc * 32 + 8 * fq;
        const float* gl = glist + (size_t)u.e * T + (size_t)u.mt * BM + rl0;
        bf16_t* yb = Y + ((size_t)u.pm * BM + rl0) * D + col0;
#pragma unroll
        for (int ai = 0; ai < 2; ++ai)
#pragma unroll
            for (int m = 0; m < 4; ++m) { const int rl = ai * HALF + m * 16; const float gt = gl[rl];
#pragma unroll
                for (int bj = 0; bj < 2; ++bj) *(u32x4*)(yb + (size_t)rl * D + bj * HALF) = pack_v(acc[ai][bj][m][0] * gt, acc[ai][bj][m][1] * gt); }
    }
};

template <class Epi, class Sched, bool ALIGN_EPI = false, bool SP2 = false, bool FP8 = false>
__device__ __forceinline__ void gemm_phase(PG8_LAS unsigned char* lds, const Gemm g, const Sched& S, const Epi& E, int wave_, int scale_w = 127, int scale_x = 127) {
    int tid = wave_ * 64 + lane_id(); asm volatile("" : "+v"(tid)); const int wid = wave_, lane = tid & 63, wr = wid >> 2, wc = wid & 3, fr = lane & 15, fq = lane >> 4;
    const int K = g.K, nt = K / BK;
    unsigned voffA[2], voffB[2];
#pragma unroll
    for (int i = 0; i < 2; ++i) { int R, C; stage_rc(tid * 16 + i * 8192, R, C); const int Rb = Epi::PERM ? ((R & ~31) + perm32(R & 31)) : R;
        voffA[i] = (unsigned)(R * K + C) * 2u; voffB[i] = (unsigned)(Rb * K + C) * 2u; }
    const unsigned kstep = (unsigned)(BK * 2);
    const unsigned hstep = (unsigned)HALF * (unsigned)K * 2u;
    const unsigned ldsw = (unsigned)wid * 1024u;
    const int aoff = lds_byte(wr * 64 + fr, fq * 8), boff = lds_byte(wc * 32 + fr, fq * 8);
#define PG8_SA(b, h) (((b) * 2 + (h)) * HTB)
#define PG8_SB(b, h) ((4 + (b) * 2 + (h)) * HTB)
#define PG8_STAGE(bufoff, gbase, voff) do { _Pragma("unroll") for (int _i = 0; _i < 2; ++_i) \
        __builtin_amdgcn_raw_ptr_buffer_load_lds(rsrc_##voff, (PG8_LAS unsigned*)(lds + (bufoff) + ldsw + _i * 8192), 16, (voff)[_i], (gbase), 0, 0); } while (0)
#define PG8_LDA(dst, b, h) do { if constexpr (FP8) { _Pragma("unroll") for (int m = 0; m < 4; ++m) { const v4i_ lo_ = *(const PG8_LAS v4i_*)(lds + PG8_SA(b, h) + aoff + m * 2048), hi_ = *(const PG8_LAS v4i_*)(lds + PG8_SA(b, h) + aoff + m * 2048 + 1024); dst##8[m] = __builtin_shufflevector(lo_, hi_, 0, 1, 2, 3, 4, 5, 6, 7); } } \
        else { _Pragma("unroll") for (int m = 0; m < 4; ++m) _Pragma("unroll") for (int k = 0; k < 2; ++k) dst[m][k] = *(const PG8_LAS bf16x8*)(lds + PG8_SA(b, h) + aoff + m * 2048 + k * 1024); } } while (0)
#define PG8_LDB(dst, b, h) do { if constexpr (FP8) { _Pragma("unroll") for (int n = 0; n < 2; ++n) { const v4i_ lo_ = *(const PG8_LAS v4i_*)(lds + PG8_SB(b, h) + boff + n * 2048), hi_ = *(const PG8_LAS v4i_*)(lds + PG8_SB(b, h) + boff + n * 2048 + 1024); dst##8[n] = __builtin_shufflevector(lo_, hi_, 0, 1, 2, 3, 4, 5, 6, 7); } } \
        else { _Pragma("unroll") for (int n = 0; n < 2; ++n) _Pragma("unroll") for (int k = 0; k < 2; ++k) dst[n][k] = *(const PG8_LAS bf16x8*)(lds + PG8_SB(b, h) + boff + n * 2048 + k * 1024); } } while (0)
#define PG8_MMA(ai, bj, At, Bt) do { __builtin_amdgcn_s_setprio(1); _Pragma("unroll") for (int m = 0; m < 4; ++m) _Pragma("unroll") for (int n = 0; n < 2; ++n) { \
        if constexpr (FP8) acc[ai][bj][m][n] = __builtin_amdgcn_mfma_scale_f32_16x16x128_f8f6f4(Bt##8[n], At##8[m], acc[ai][bj][m][n], 0, 0, 0, scale_w, 0, scale_x); \
        else { _Pragma("unroll") for (int k = 0; k < 2; ++k) acc[ai][bj][m][n] = __builtin_amdgcn_mfma_f32_16x16x32_bf16(Bt[n][k], At[m][k], acc[ai][bj][m][n], 0, 0, 0); } } \
        __builtin_amdgcn_s_setprio(0); } while (0)
#define PG8_WAIT_V(n) asm volatile("s_waitcnt vmcnt(" #n ")" ::: "memory")
#define PG8_WAIT_L(n) asm volatile("s_waitcnt lgkmcnt(" #n ")" ::: "memory")
#define PG8_BAR __builtin_amdgcn_s_barrier()
#define PG8_SCHED __builtin_amdgcn_sched_barrier(0)
#define PG8_ACC_INIT(u_) do { if constexpr (Epi::BIAS_INIT) { int tz_ = lane_id(); asm volatile("" : "+v"(tz_)); E.init(acc, u_, wc, (tz_ & 63) >> 4); } else { \
        _Pragma("unroll") for (int a = 0; a < 2; ++a) _Pragma("unroll") for (int b = 0; b < 2; ++b) _Pragma("unroll") for (int m = 0; m < 4; ++m) _Pragma("unroll") for (int n = 0; n < 2; ++n) acc[a][b][m][n] = (f32x4){0.f, 0.f, 0.f, 0.f}; } } while (0)
    Unit cur, nxt; int ui = 0;
    if (!S.next(0, cur)) return;
    f32x4 acc[2][2][4][2];
    PG8_ACC_INIT(cur);
    typedef int v4i_ __attribute__((ext_vector_type(4))); typedef int v8i_ __attribute__((ext_vector_type(8)));
    bf16x8 At[4][2], B0[2][2], B1[2][2]; v8i_ At8[4], B08[2], B18[2];
    const auto rsrc_voffA = __builtin_amdgcn_make_buffer_rsrc((void*)g.A, 0, -1, 0x00020000), rsrc_voffB = __builtin_amdgcn_make_buffer_rsrc((void*)g.Bt, 0, -1, 0x00020000);
    unsigned cA = (unsigned)__builtin_amdgcn_readfirstlane((int)(unsigned)S.a_off(cur)), cB = (unsigned)__builtin_amdgcn_readfirstlane((int)(unsigned)S.b_off(cur));
    S.a_ready(cur);
    if constexpr (SP2) {
        PG8_STAGE(PG8_SB(0, 0), cB, voffB); PG8_STAGE(PG8_SB(0, 1), cB + hstep, voffB); PG8_STAGE(PG8_SA(0, 0), cA, voffA); PG8_STAGE(PG8_SA(0, 1), cA + hstep, voffA);
        if (wr == 1) PG8_BAR;
        PG8_WAIT_V(2); PG8_BAR;
        PG8_STAGE(PG8_SB(1, 0), cB + kstep, voffB); PG8_STAGE(PG8_SA(1, 0), cA + kstep, voffA); PG8_STAGE(PG8_SB(1, 1), cB + hstep + kstep, voffB);
        PG8_WAIT_V(6); PG8_BAR;
    } else {
        PG8_STAGE(PG8_SB(0, 0), cB, voffB); PG8_STAGE(PG8_SA(0, 0), cA, voffA); PG8_STAGE(PG8_SB(0, 1), cB + hstep, voffB); PG8_STAGE(PG8_SA(0, 1), cA + hstep, voffA);
        if (wr == 1) PG8_BAR;
        PG8_WAIT_V(4); PG8_BAR;
        PG8_STAGE(PG8_SB(1, 0), cB + kstep, voffB); PG8_STAGE(PG8_SA(1, 0), cA + kstep, voffA); PG8_STAGE(PG8_SB(1, 1), cB + hstep + kstep, voffB);
        PG8_WAIT_V(6); PG8_BAR;
    }
    for (;;) {
        const bool has_next = S.next(ui + 1, nxt);
        const unsigned nA = has_next ? (unsigned)__builtin_amdgcn_readfirstlane((int)(unsigned)S.a_off(nxt)) : cA, nB = has_next ? (unsigned)__builtin_amdgcn_readfirstlane((int)(unsigned)S.b_off(nxt)) : cB;
#pragma nounroll
        for (int t = 0; t < nt; t += 2) {
            const bool last = (t == nt - 2);
            const unsigned a1 = cA + (unsigned)(t + 1) * kstep;
            const unsigned a2 = last ? nA : cA + (unsigned)(t + 2) * kstep, b2 = last ? nB : cB + (unsigned)(t + 2) * kstep;
            const unsigned a3 = a2 + kstep, b3 = b2 + kstep;
            if (last && has_next) S.a_ready(nxt);
            if constexpr (SP2) {
            PG8_LDB(B0, 0, 0); PG8_LDB(B1, 0, 1); PG8_SCHED; PG8_LDA(At, 0, 0); PG8_STAGE(PG8_SA(1, 1), a1 + hstep, voffA);
            PG8_WAIT_V(8); PG8_WAIT_L(0); PG8_BAR; PG8_MMA(0, 0, At, B0); PG8_MMA(0, 1, At, B1); PG8_BAR; PG8_SCHED;
            PG8_LDA(At, 0, 1); PG8_STAGE(PG8_SB(0, 0), b2, voffB); PG8_STAGE(PG8_SB(0, 1), b2 + hstep, voffB); PG8_STAGE(PG8_SA(0, 0), a2, voffA);
            PG8_WAIT_V(8); PG8_WAIT_L(0); PG8_BAR; PG8_MMA(1, 0, At, B0); PG8_MMA(1, 1, At, B1); PG8_BAR; PG8_SCHED;
            PG8_LDB(B0, 1, 0); PG8_LDB(B1, 1, 1); PG8_SCHED; PG8_LDA(At, 1, 0); PG8_STAGE(PG8_SA(0, 1), a2 + hstep, voffA);
            PG8_WAIT_V(8); PG8_WAIT_L(0); PG8_BAR; PG8_MMA(0, 0, At, B0); PG8_MMA(0, 1, At, B1); PG8_BAR; PG8_SCHED;
            PG8_LDA(At, 1, 1); PG8_STAGE(PG8_SB(1, 0), b3, voffB); PG8_STAGE(PG8_SB(1, 1), b3 + hstep, voffB); PG8_STAGE(PG8_SA(1, 0), a3, voffA);
            PG8_WAIT_V(8); PG8_WAIT_L(0); PG8_BAR; PG8_MMA(1, 0, At, B0); PG8_MMA(1, 1, At, B1); PG8_BAR; PG8_SCHED;
            } else {
            PG8_LDB(B0, 0, 0); PG8_SCHED; PG8_LDA(At, 0, 0); PG8_STAGE(PG8_SA(1, 1), a1 + hstep, voffA);
            PG8_WAIT_L(8); PG8_BAR; PG8_WAIT_L(0); PG8_MMA(0, 0, At, B0); PG8_BAR; PG8_SCHED;
            PG8_LDB(B1, 0, 1); PG8_STAGE(PG8_SB(0, 0), b2, voffB);
            PG8_BAR; PG8_WAIT_L(0); PG8_MMA(0, 1, At, B1); PG8_BAR;
            PG8_LDA(At, 0, 1); PG8_STAGE(PG8_SA(0, 0), a2, voffA);
            PG8_BAR; PG8_WAIT_L(0); PG8_MMA(1, 0, At, B0); PG8_BAR; PG8_SCHED;
            PG8_STAGE(PG8_SB(0, 1), b2 + hstep, voffB);
            PG8_WAIT_V(6); PG8_BAR; PG8_MMA(1, 1, At, B1); PG8_BAR;
            PG8_LDB(B0, 1, 0); PG8_SCHED; PG8_LDA(At, 1, 0); PG8_STAGE(PG8_SA(0, 1), a2 + hstep, voffA);
            PG8_WAIT_L(8); PG8_BAR; PG8_WAIT_L(0); PG8_MMA(0, 0, At, B0); PG8_BAR; PG8_SCHED;
            PG8_LDB(B1, 1, 1); PG8_STAGE(PG8_SB(1, 0), b3, voffB);
            PG8_BAR; PG8_WAIT_L(0); PG8_MMA(0, 1, At, B1); PG8_BAR;
            PG8_LDA(At, 1, 1); PG8_STAGE(PG8_SA(1, 0), a3, voffA);
            PG8_BAR; PG8_WAIT_L(0); PG8_MMA(1, 0, At, B0); PG8_BAR; PG8_SCHED;
            PG8_STAGE(PG8_SB(1, 1), b3 + hstep, voffB);
            PG8_WAIT_V(6); PG8_BAR; PG8_MMA(1, 1, At, B1); PG8_BAR;
            }
        }
        if constexpr (ALIGN_EPI) { if (wr == 0) PG8_BAR; }
        if constexpr (!Epi::AFTER_DRAIN) { int tz = lane_id(); asm volatile("" : "+v"(tz));
            E(acc, cur, wr, wc, tz & 15, (tz & 63) >> 4); S.done(cur); }
        if (!has_next) break;
        PG8_ACC_INIT(nxt);
        cur = nxt; cA = nA; cB = nB; ++ui;
        if constexpr (ALIGN_EPI) { if (wr == 1) PG8_BAR; }
    }
    PG8_WAIT_V(0);
    if constexpr (!ALIGN_EPI) { if (wr == 0) PG8_BAR; }
    PG8_BAR;
    if constexpr (Epi::AFTER_DRAIN) { E.fused(acc, cur, wr, wc, fr, fq, lds, wid, lane); S.done(cur); }
#undef PG8_SA
#undef PG8_SB
#undef PG8_ACC_INIT
#undef PG8_STAGE
#undef PG8_LDA
#undef PG8_LDB
#undef PG8_MMA
#undef PG8_WAIT_V
#undef PG8_WAIT_L
#undef PG8_BAR
#undef PG8_SCHED
}
}

template <int MODE>
__device__ __forceinline__ void transpose_item(const float* W, int K, int N, bf16_t* WT, LAS float* scr, int item, int lane) {
    const int nblk = N / 32, kb = item / nblk, nb = item % nblk, k0 = 64 * kb, n0 = 32 * nb;
    int dr = n0;
    if (MODE == 1) { const int j = n0 & 1023, half = n0 >> 10; dr = 256 * (j >> 7) + 128 * half + (j & 127); }
    if (MODE == 2) { const int part = n0 >> 10, c = n0 & 1023, head = c >> 6, half = (c >> 5) & 1; dr = part * 1024 + (head >> 2) * 256 + half * 128 + (head & 3) * 32; }
#pragma unroll 8
    for (int i = 0; i < 32; ++i) { const int kk = 2 * i + (lane >> 5); scr[kk * 33 + (lane & 31)] = W[(size_t)(k0 + kk) * N + n0 + (lane & 31)]; }
    WAVE_SYNC();
    const int c = lane & 7;
#pragma unroll
    for (int j = 0; j < 4; ++j) { const int n = (lane >> 3) + 8 * j; const LAS float* s = scr + (8 * c) * 33 + n;
        u32x4 o; o.x = pk2(s[0 * 33], s[1 * 33]); o.y = pk2(s[2 * 33], s[3 * 33]); o.z = pk2(s[4 * 33], s[5 * 33]); o.w = pk2(s[6 * 33], s[7 * 33]);
        *(u32x4*)(WT + (size_t)(dr + n) * K + k0 + 8 * c) = o; }
    WAVE_SYNC();
}

template <int MODE>
__device__ __forceinline__ void transpose_item_fp8(const float* W, int K, int N, unsigned char* WT, LAS float* scr, int item, int lane, float scale) {
    const int nblk = N / 32, kb = item / nblk, nb = item % nblk, k0 = 64 * kb, n0 = 32 * nb;
    int dr = n0;
    if (MODE == 1) { const int j = n0 & 1023, half = n0 >> 10; dr = 256 * (j >> 7) + 128 * half + (j & 127); }
#pragma unroll 8
    for (int i = 0; i < 32; ++i) { const int kk = 2 * i + (lane >> 5); scr[kk * 33 + (lane & 31)] = W[(size_t)(k0 + kk) * N + n0 + (lane & 31)] * scale; }
    WAVE_SYNC();
#pragma unroll
    for (int j = 0; j < 2; ++j) { const int n = lane & 31, c = (lane >> 5) + 2 * j; const LAS float* s = scr + (16 * c) * 33 + n;
        u32x4 o; o.x = pk4_fp8(s[0 * 33], s[1 * 33], s[2 * 33], s[3 * 33]); o.y = pk4_fp8(s[4 * 33], s[5 * 33], s[6 * 33], s[7 * 33]);
        o.z = pk4_fp8(s[8 * 33], s[9 * 33], s[10 * 33], s[11 * 33]); o.w = pk4_fp8(s[12 * 33], s[13 * 33], s[14 * 33], s[15 * 33]);
        *(u32x4*)(WT + (size_t)(dr + n) * K + k0 + 16 * c) = o; }
    WAVE_SYNC();
}

__device__ __forceinline__ const float* ld_ptr(volatile LAS unsigned long long* t, int k) {
    const unsigned long long v = t[k]; const unsigned lo = __builtin_amdgcn_readfirstlane((unsigned)v), hi = __builtin_amdgcn_readfirstlane((unsigned)(v >> 32));
    return (const float*)(const GAS float*)(((unsigned long long)hi << 32) | lo);
}
__device__ __forceinline__ void phase_prologue(const Ctx& X, volatile LAS unsigned long long* ptab) {
#define in_(k) ld_ptr(ptab, k)
    const float* a_re = in_(3); const float* a_im = in_(4); const float* log_dt = in_(5); const float* b_re = in_(6); const float* b_im = in_(7);
    float2* Abar = (float2*)(X.ws + WS_S5A); float2* Bbar = (float2*)(X.ws + WS_S5B); float2* rope = (float2*)(X.ws + WS_ROPE);
    const int gt = X.bid * NTHR + X.tid, NT = X.G * NTHR;
    for (int it = gt; it < 2 * SSM_G * SSM_P; it += NT) {
        const int ig = it >> 6;
        const double lam_re = fmin((double)a_re[it], -1e-4), lam_im = (double)a_im[it];
        const double dt = exp((double)log_dt[ig]);
        const double mag = exp(lam_re * dt), ang = lam_im * dt;
        const double abr = mag * cos(ang), abi = mag * sin(ang);
        const double nr = abr - 1.0, ni = abi, den = lam_re * lam_re + lam_im * lam_im;
        const double cr = (nr * lam_re + ni * lam_im) / den, ci = (ni * lam_re - nr * lam_im) / den;
        Abar[it] = make_float2((float)abr, (float)abi);
        for (int h = 0; h < SSM_H; ++h) {
            const double br = (double)b_re[it * 16 + h], bi = (double)b_im[it * 16 + h];
            Bbar[it * 16 + h] = make_float2((float)(cr * br - ci * bi), (float)(cr * bi + ci * br));
        }
    }
    for (int it = gt; it < SEQ * 32; it += NT) {
        const int pos = it >> 5, i = it & 31;
        const float inv = powf(10000.0f, -(float)i / 32.0f);
        const float ang = (float)pos * inv;
        rope[it] = make_float2((float)cos((double)ang), (float)sin((double)ang));
    }
    { const float* rw = in_(20); bf16_t* RWh = (bf16_t*)(X.ws + WS_RWH); bf16_t* RWl = (bf16_t*)(X.ws + WS_RWL);
      for (int it = gt; it < DEPTH * NE * D; it += NT) { const int k = it & 1023, e = (it >> 10) & 31, l = it >> 15;
          const float w = rw[((size_t)l * D + k) * NE + e]; const unsigned hb = f2bf(w); RWh[it] = (bf16_t)hb; RWl[it] = (bf16_t)f2bf(w - bf2f((bf16_t)hb)); } }
    { const float* x = in_(0); bf16_t* H0 = (bf16_t*)(X.ws + WS_H0);
      const size_t n8 = (size_t)T * D / 8;
      for (size_t i8 = (size_t)gt; i8 < n8; i8 += (size_t)NT) {
          const f32x4 a = *(const f32x4*)(x + i8 * 8), b = *(const f32x4*)(x + i8 * 8 + 4);
          u32x4 o; o.x = pk2(a[0], a[1]); o.y = pk2(a[2], a[3]); o.z = pk2(b[0], b[1]); o.w = pk2(b[2], b[3]);
          *(u32x4*)(H0 + i8 * 8) = o; } }
    LAS float* scr = (LAS float*)(X.lds + X.wave * 16384);
    const int gw = X.bid * NWAVES + X.wave, NGW = X.G * NWAVES;
    constexpr int I_GU = 16 * 64, I_DN = 16 * 32, I_IN = 16 * 64, I_GLU = 8 * 16, I_OUT = 16 * 32, I_QKV = 16 * 96, I_O = 16 * 32;
    constexpr int N_GU = 128 * I_GU, N_DN = 128 * I_DN, N_IN = 2 * I_IN, N_GLU = 2 * I_GLU, N_OUT = 2 * I_OUT, N_QKV = 2 * I_QKV, N_O = 2 * I_O;
    constexpr int NITEMS = N_GU + N_DN + N_IN + N_GLU + N_OUT + N_QKV + N_O;
    for (int it = gw; it < NITEMS; it += NGW) {
        int r = it;
        if (r < N_GU) { const int m = r / I_GU; transpose_item_fp8<1>(in_(22) + (size_t)m * D * 2048, D, 2048, (unsigned char*)(X.ws + WS_WGU + (size_t)m * 2048 * D), scr, r % I_GU, X.lane, (float)(1 << W8_SHIFT_GU)); continue; } r -= N_GU;
        if (r < N_DN) { const int m = r / I_DN; transpose_item_fp8<0>(in_(24) + (size_t)m * D * D, D, D, (unsigned char*)(X.ws + WS_WDN + (size_t)m * D * D), scr, r % I_DN, X.lane, (float)(1 << W8_SHIFT_DN)); continue; } r -= N_DN;
        if (r < N_IN) { const int m = r / I_IN; transpose_item<0>(in_(1) + (size_t)m * D * 2048, D, 2048, (bf16_t*)(X.ws + WS_WIN) + (size_t)m * 2048 * D, scr, r % I_IN, X.lane); continue; } r -= N_IN;
        if (r < N_GLU) { const int m = r / I_GLU; transpose_item<0>(in_(11) + (size_t)m * 512 * 512, 512, 512, (bf16_t*)(X.ws + WS_WGLU) + (size_t)m * 512 * 512, scr, r % I_GLU, X.lane); continue; } r -= N_GLU;
        if (r < N_OUT) { const int m = r / I_OUT; transpose_item<0>(in_(13) + (size_t)m * D * D, D, D, (bf16_t*)(X.ws + WS_WOUT) + (size_t)m * D * D, scr, r % I_OUT, X.lane); continue; } r -= N_OUT;
        if (r < N_QKV) { const int m = r / I_QKV; transpose_item<2>(in_(14) + (size_t)m * D * 3072, D, 3072, (bf16_t*)(X.ws + WS_WQKV) + (size_t)m * 3072 * D, scr, r % I_QKV, X.lane); continue; } r -= N_QKV;
        { const int m = r / I_O; transpose_item<0>(in_(15) + (size_t)m * D * D, D, D, (bf16_t*)(X.ws + WS_WO) + (size_t)m * D * D, scr, r % I_O, X.lane); }
    }
}

#undef in_
typedef float f32x4v __attribute__((ext_vector_type(4)));
template <int PASS>
__device__ __forceinline__ void phase_s5(const Ctx& X, int i, const bf16_t* proj, const float* conv_w, const float* c_re, const float* c_im, const float* d_skip, bf16_t* mix, bf16_t* Z) {
    using pg8::bf16x8;
    if (PASS == 2) {
        const float* w = conv_w + (size_t)i * 3 * CONV_CH;
        const size_t n = (size_t)T * (CONV_CH / 8);
        for (size_t idx = (size_t)X.bid * NTHR + X.tid; idx < n; idx += (size_t)X.G * NTHR) {
            const int bt = (int)(idx >> 6), c = (int)(idx & 63) * 8, pos = seqpos(bt);
            const bf16_t* pr = proj + (size_t)bt * 2048;
            float gb[8], a2[8], b2[8], a1[8], b1[8], a0[8], b0[8];
            unpack8(*(const u32x4*)(pr + c), gb); unpack8(*(const u32x4*)(pr + 512 + c), a2); unpack8(*(const u32x4*)(pr + 1024 + c), b2);
            if (pos >= 1) { unpack8(*(const u32x4*)(pr + 512 + c - 2048), a1); unpack8(*(const u32x4*)(pr + 1024 + c - 2048), b1); }
            if (pos >= 2) { unpack8(*(const u32x4*)(pr + 512 + c - 4096), a0); unpack8(*(const u32x4*)(pr + 1024 + c - 4096), b0); }
            float o[8];
#pragma unroll
            for (int j = 0; j < 8; ++j) {
                float s = w[2 * CONV_CH + c + j] * (a2[j] * b2[j]);
                if (pos >= 1) s += w[1 * CONV_CH + c + j] * (a1[j] * b1[j]);
                if (pos >= 2) s += w[0 * CONV_CH + c + j] * (a0[j] * b0[j]);
                o[j] = gb[j] * s; }
            *(u32x4*)(mix + (size_t)bt * D + c) = pack8(o);
        }
    }
    const int lane = X.lane, n16 = lane & 15, kq = lane >> 4;
    LAS float* BuT = (LAS float*)(X.lds + X.wave * 15360);
    LAS unsigned char* xsb = X.lds + X.wave * 15360 + 10240;
    const float2* Abar = (const float2*)(X.ws + WS_S5A); const float2* Bbar = (const float2*)(X.ws + WS_S5B);
    float2* Sst = (float2*)(X.ws + WS_S5S);
    const int gw = X.bid * NWAVES + X.wave, NGW = X.G * NWAVES;
    const int g = gw & 31, ig = i * 32 + g;
        const float2 A = Abar[ig * 64 + lane];
    bf16x8 bfr[8];
#pragma unroll
    for (int cb = 0; cb < 8; ++cb) {
        u32x4 w = (u32x4){0u, 0u, 0u, 0u};
        if (kq < 2) { const float2* bp = Bbar + ((size_t)(ig * 64 + 16 * (cb & 3) + n16)) * 16 + 8 * kq; float v[8];
#pragma unroll
            for (int j = 0; j < 8; ++j) { const float2 t2 = bp[j]; v[j] = cb < 4 ? t2.x : t2.y; }
            w = pack8(v); }
        bfr[cb] = __builtin_bit_cast(bf16x8, w);
    }
    bf16x8 cfr[4]; bf16x8 dfr;
    if (PASS == 2) {
#pragma unroll
        for (int ks = 0; ks < 4; ++ks) { const int p0 = 16 * ks + 4 * kq; const f32x4 cr = *(const f32x4*)(c_re + (size_t)(ig * 16 + n16) * 64 + p0), ci = *(const f32x4*)(c_im + (size_t)(ig * 16 + n16) * 64 + p0);
            u32x4 w; w.x = cvt_pk_bf16(cr[0], -ci[0]); w.y = cvt_pk_bf16(cr[1], -ci[1]); w.z = cvt_pk_bf16(cr[2], -ci[2]); w.w = cvt_pk_bf16(cr[3], -ci[3]); cfr[ks] = __builtin_bit_cast(bf16x8, w); }
        { const float dv = d_skip[ig * 16 + n16]; float v[8];
#pragma unroll
          for (int j = 0; j < 8; ++j) v[j] = (kq < 2 && 8 * kq + j == n16) ? dv : 0.f;
          dfr = __builtin_bit_cast(bf16x8, pack8(v)); }
    }
    for (int task = gw; task < BATCH * 64 * SSM_G; task += NGW) {
        const int c = (task >> 5) & 63, b = task >> 11;
        float xr = 0.f, xi = 0.f;
        if (PASS == 2) { const float2 xin = ((const float2*)(X.ws + WS_S5X))[((size_t)(b * 32 + g) * 64 + c) * 64 + lane]; xr = xin.x; xi = xin.y; }
        const bf16_t* ub = proj + ((size_t)b * SEQ + (size_t)c * 128) * 2048 + 1536 + g * 16;
        bf16_t* zb = Z + ((size_t)b * SEQ + (size_t)c * 128) * SSM_W + g * 16;
        u32x4 uw = (u32x4){0u, 0u, 0u, 0u};
        if (kq < 2) uw = *(const u32x4*)(ub + (size_t)n16 * 2048 + 8 * kq);
#pragma nounroll
        for (int blk = 0; blk < 8; ++blk) {
            const bf16x8 ufr = __builtin_bit_cast(bf16x8, uw);
            u32x4 un = (u32x4){0u, 0u, 0u, 0u};
            if (kq < 2 && blk < 7) un = *(const u32x4*)(ub + (size_t)((blk + 1) * 16 + n16) * 2048 + 8 * kq);
#pragma unroll
            for (int cb = 0; cb < 8; ++cb) {
                f32x4v acc = (f32x4v){0.f, 0.f, 0.f, 0.f};
                acc = __builtin_amdgcn_mfma_f32_16x16x32_bf16(ufr, bfr[cb], acc, 0, 0, 0);
                *(LAS f32x4v*)(BuT + (16 * cb + n16) * 20 + 4 * kq) = acc;
            }
            WAVE_SYNC();
#pragma unroll
            for (int k4 = 0; k4 < 4; ++k4) {
                const f32x4v br = *(const LAS f32x4v*)(BuT + lane * 20 + 4 * k4), bi = *(const LAS f32x4v*)(BuT + (64 + lane) * 20 + 4 * k4);
#pragma unroll
                for (int s = 0; s < 4; ++s) {
                    float nr = fmaf(-A.y, xi, fmaf(A.x, xr, br[s])); asm volatile("" : "+v"(nr));
                    float ni = fmaf(A.y, xr, fmaf(A.x, xi, bi[s])); asm volatile("" : "+v"(ni));
                    xr = nr; xi = ni;
                    if (PASS == 2) *(LAS unsigned*)(xsb + (4 * k4 + s) * 272 + lane * 4) = cvt_pk_bf16(xr, xi);
                }
            }
            if (PASS == 2) {
                WAVE_SYNC();
                f32x4v y = (f32x4v){0.f, 0.f, 0.f, 0.f};
                bf16x8 xa[4];
#pragma unroll
                for (int ks = 0; ks < 4; ++ks) xa[ks] = *(const LAS bf16x8*)(xsb + n16 * 272 + ks * 64 + kq * 16);
                WAVE_SYNC(); __builtin_amdgcn_sched_barrier(0);
#pragma unroll
                for (int ks = 0; ks < 4; ++ks) y = __builtin_amdgcn_mfma_f32_16x16x32_bf16(xa[ks], cfr[ks], y, 0, 0, 0);
                y = __builtin_amdgcn_mfma_f32_16x16x32_bf16(ufr, dfr, y, 0, 0, 0);
                asm volatile("" :: "v"(xa[0]), "v"(xa[1]), "v"(xa[2]), "v"(xa[3]), "v"(ufr));
#pragma unroll
                for (int q = 0; q < 4; ++q) zb[(size_t)(blk * 16 + 4 * kq + q) * SSM_W + n16] = (bf16_t)f2bf(gelu_tanh(y[q]));
            }
            WAVE_SYNC();
            uw = un;
        }
        if (PASS == 1) Sst[((size_t)(b * 32 + g) * 64 + c) * 64 + lane] = make_float2(xr, xi);
    }
}

__device__ __forceinline__ void phase_s5_carry(const Ctx& X, int i) {
    const float2* Abar = (const float2*)(X.ws + WS_S5A); const float2* Sst = (const float2*)(X.ws + WS_S5S); float2* Xin = (float2*)(X.ws + WS_S5X);
    const int gw = X.bid * NWAVES + X.wave, NGW = X.G * NWAVES, lane = X.lane;
    for (int bg = gw; bg < BATCH * SSM_G; bg += NGW) {
        const float2 A = Abar[(i * 32 + (bg & 31)) * 64 + lane];
        float pr_ = A.x, pi_ = A.y;
#pragma unroll
        for (int q = 0; q < 7; ++q) { const float nr = pr_ * pr_ - pi_ * pi_, ni = 2.f * pr_ * pi_; pr_ = nr; pi_ = ni; }
        float xr = 0.f, xi = 0.f;
        const size_t base = (size_t)bg * 64 * 64 + lane;
#pragma unroll 8
        for (int c = 0; c < 64; ++c) {
            Xin[base + (size_t)c * 64] = make_float2(xr, xi);
            const float2 s = Sst[base + (size_t)c * 64];
            const float nr = pr_ * xr - pi_ * xi + s.x, ni = pr_ * xi + pi_ * xr + s.y; xr = nr; xi = ni;
        }
    }
}

typedef short v4i16_t __attribute__((ext_vector_type(4)));
typedef float f32x16 __attribute__((ext_vector_type(16)));
__device__ __forceinline__ v4i16_t vtr16(const LAS unsigned char* p) { return __builtin_amdgcn_ds_read_tr16_b64_v4i16((LAS v4i16_t*)p); }
template <int PASS>
__device__ __forceinline__ void phase_attn(const Ctx& X, const bf16_t* proj, bf16_t* att, bf16_t* ost, float2* ml) {
    using pg8::bf16x8;
    const int lane = X.lane, i32 = lane & 31, hi = lane >> 5;
    LAS unsigned char* vbuf = X.lds + X.wave * 8192;
    const int gw = X.bid * NWAVES + X.wave, NGW = X.G * NWAVES;
    const float NEG = opaque_f(-3.0e38f); const int seqmax = opaque_i(SEQ - 1);
    const int vrd = ((lane >> 4) & 1) * 32 + (lane & 3) * 8 + (4 * hi + ((lane & 15) >> 2)) * 64;
    const bool xdeal = (X.G == 256);
    for (int it = 0; it < (xdeal ? 8 : (BATCH * NH * 256 + NGW - 1) / NGW); ++it) {
        const int task = xdeal ? (((it * 8 + (X.bid & 7)) << 8) | ((X.bid >> 3) * 8 + X.wave)) : (gw + it * NGW);
        if (task >= BATCH * NH * 256) break;
        const int QST = PASS == 0 ? 4 : 16;
        const int r = PASS == 0 ? (task & 3) : (task & 15), blk = PASS == 0 ? ((task >> 2) & 63) : ((task >> 4) & 15), hh = (task >> 8) & 15, b = task >> 12;
        const bf16_t* base = proj + (size_t)b * SEQ * 3072 + hh * 64;
        const int t0 = (PASS == 0 ? 128 : 512) * blk + r;
        bf16x8 qf[4];
        { const bf16_t* qp = base + (size_t)(t0 + QST * i32) * 3072 + 8 * hi;
#pragma unroll
          for (int d0 = 0; d0 < 4; ++d0) qf[d0] = *(const bf16x8*)(qp + 16 * d0); }
        float m_run = NEG, l_run = 0.f;
        f32x16 o0, o1;
#pragma unroll
        for (int q = 0; q < 16; ++q) { o0[q] = 0.f; o1[q] = 0.f; }
        const size_t srow = (size_t)(b * SEQ + t0 + QST * i32);
        if (PASS == 1) {
            const float2 mlv = ml[srow * NH + hh]; m_run = mlv.x; l_run = hi == 0 ? mlv.y : 0.f;
            const bf16_t* sp = ost + srow * D + hh * 64 + 4 * hi;
#pragma unroll
            for (int gq = 0; gq < 4; ++gq) { const u32x2 w0 = *(const u32x2*)(sp + 8 * gq), w1 = *(const u32x2*)(sp + 32 + 8 * gq);
                o0[4 * gq] = bf_lo(w0.x); o0[4 * gq + 1] = bf_hi(w0.x); o0[4 * gq + 2] = bf_lo(w0.y); o0[4 * gq + 3] = bf_hi(w0.y);
                o1[4 * gq] = bf_lo(w1.x); o1[4 * gq + 1] = bf_hi(w1.x); o1[4 * gq + 2] = bf_lo(w1.y); o1[4 * gq + 3] = bf_hi(w1.y); }
        }
        for (int pat = 0; pat < (PASS == 0 ? 2 : 1); ++pat) {
            const int dil = PASS == 1 ? 16 : (pat == 0 ? 4 : 1), qs = PASS == 1 ? 1 : (pat == 0 ? 1 : 4), ntl = PASS == 1 ? 5 : (pat == 0 ? 5 : 8);
            const int rr = PASS == 1 ? r : (pat == 0 ? r : 0);
            const int M0 = (t0 - rr) / dil, Mstart = M0 - 128;
            const int qi = qs * i32;
            bf16x8 kf[4];
            auto keypos = [&](int M) { int p = dil * M + rr; p = p < 0 ? 0 : p; p = p > seqmax ? seqmax : p; return p; };
            auto issue = [&](int kt, bf16x8 (&kk)[4], int bufsel) {
                const bf16_t* kp = base + (size_t)keypos(Mstart + 32 * kt + i32) * 3072 + 1024 + 8 * hi;
#pragma unroll
                for (int d0 = 0; d0 < 4; ++d0) kk[d0] = *(const bf16x8*)(kp + 16 * d0);
#pragma unroll
                for (int kg = 0; kg < 2; ++kg) {
                    const bf16_t* vp = base + (size_t)keypos(Mstart + 32 * kt + 16 * kg + (lane >> 2)) * 3072 + 2048 + (lane & 3) * 8;
#pragma unroll
                    for (int dh = 0; dh < 2; ++dh)
                        __builtin_amdgcn_global_load_lds((const unsigned*)(vp + 32 * dh), (LAS unsigned*)(vbuf + bufsel * 4096 + (dh * 2 + kg) * 1024), 16, 0, 0);
                }
            };
            asm volatile("s_waitcnt lgkmcnt(0)" ::: "memory");
            issue(0, kf, 0);
            for (int kt = 0; kt < ntl; ++kt) {
                asm volatile("s_waitcnt vmcnt(0) lgkmcnt(0)" ::: "memory");
                bf16x8 kn[4];
                const int ktn = kt + 1 < ntl ? kt + 1 : kt;
                issue(ktn, kn, (kt + 1) & 1);
                f32x16 s;
#pragma unroll
                for (int q = 0; q < 16; ++q) s[q] = 0.f;
#pragma unroll
                for (int d0 = 0; d0 < 4; ++d0) s = __builtin_amdgcn_mfma_f32_32x32x16_bf16(kf[d0], qf[d0], s, 0, 0, 0);
                const int hi_ = qi + 128 - 32 * kt; int lo = hi_ - 128; { const int nk = -(Mstart + 32 * kt); lo = lo > nk ? lo : nk; }
                const int rb = 4 * hi - lo; const unsigned span = (unsigned)(hi_ - lo);
                const bool any = hi_ >= lo;
                float tmax = NEG;
#pragma unroll
                for (int q = 0; q < 16; ++q) { const int rowc = (q & 3) + 8 * (q >> 2); const bool ok = any && ((unsigned)(rowc + rb) <= span) && (rowc + rb >= 0); s[q] = ok ? s[q] : NEG; tmax = fmaxf(tmax, s[q]); }
                tmax = fmaxf(tmax, __shfl_xor(tmax, 32));
                const float m_new = fmaxf(m_run, tmax), sc = __builtin_amdgcn_exp2f(m_run - m_new);
                m_run = m_new;
                float ps = 0.f;
#pragma unroll
                for (int q = 0; q < 16; ++q) { s[q] = __builtin_amdgcn_exp2f(s[q] - m_new); ps += s[q]; }
                l_run = l_run * sc + ps;
#pragma unroll
                for (int q = 0; q < 16; ++q) { o0[q] *= sc; o1[q] *= sc; }
                u32x4 pw0, pw1;
                pw0.x = cvt_pk_bf16(s[0], s[1]); pw0.y = cvt_pk_bf16(s[2], s[3]); pw0.z = cvt_pk_bf16(s[4], s[5]); pw0.w = cvt_pk_bf16(s[6], s[7]);
                pw1.x = cvt_pk_bf16(s[8], s[9]); pw1.y = cvt_pk_bf16(s[10], s[11]); pw1.z = cvt_pk_bf16(s[12], s[13]); pw1.w = cvt_pk_bf16(s[14], s[15]);
                const bf16x8 pf0 = __builtin_bit_cast(bf16x8, pw0), pf1 = __builtin_bit_cast(bf16x8, pw1);
                const LAS unsigned char* vb = vbuf + (kt & 1) * 4096 + vrd;
#pragma unroll
                for (int dh = 0; dh < 2; ++dh) {
#pragma unroll
                    for (int kg = 0; kg < 2; ++kg) {
                        const v4i16_t vlo = vtr16(vb + (dh * 2 + kg) * 1024), vhi = vtr16(vb + (dh * 2 + kg) * 1024 + 512);
                        const bf16x8 vf = (bf16x8){vlo[0], vlo[1], vlo[2], vlo[3], vhi[0], vhi[1], vhi[2], vhi[3]};
                        if (dh == 0) o0 = __builtin_amdgcn_mfma_f32_32x32x16_bf16(vf, kg == 0 ? pf0 : pf1, o0, 0, 0, 0);
                        else o1 = __builtin_amdgcn_mfma_f32_32x32x16_bf16(vf, kg == 0 ? pf0 : pf1, o1, 0, 0, 0);
                    }
                }
#pragma unroll
                for (int d0 = 0; d0 < 4; ++d0) kf[d0] = kn[d0];
            }
            asm volatile("s_waitcnt vmcnt(0) lgkmcnt(0)" ::: "memory");
        }
        const float lt = l_run + __shfl_xor(l_run, 32), rl = PASS == 1 ? 1.0f / lt : 1.0f;
        if (PASS == 0 && hi == 0) ml[srow * NH + hh] = make_float2(m_run, lt);
        bf16_t* op = (PASS == 1 ? att : ost) + srow * D + hh * 64 + 4 * hi;
#pragma unroll
        for (int gq = 0; gq < 4; ++gq) {
            u32x2 w0, w1;
            w0.x = cvt_pk_bf16(o0[4 * gq] * rl, o0[4 * gq + 1] * rl); w0.y = cvt_pk_bf16(o0[4 * gq + 2] * rl, o0[4 * gq + 3] * rl);
            w1.x = cvt_pk_bf16(o1[4 * gq] * rl, o1[4 * gq + 1] * rl); w1.y = cvt_pk_bf16(o1[4 * gq + 2] * rl, o1[4 * gq + 3] * rl);
            *(u32x2*)(op + 8 * gq) = w0; *(u32x2*)(op + 32 + 8 * gq) = w1;
        }
    }
}

__device__ __forceinline__ void phase_ln_router(const Ctx& X, int layer, const bf16_t* hin, const bf16_t* mixo, const float* g, const float* bta, const float* rb, bf16_t* h1) {
    using pg8::bf16x8;
    LAS unsigned char* Ah = X.lds;
    LAS unsigned char* Al = X.lds + 65536;
    LAS float* P = (LAS float*)X.lds;
    LAS int* s_cnt = (LAS int*)(X.lds + TAB_OFF);
    LAS int* s_gb = s_cnt + 32;
    const int lane = X.lane, w = X.wave, tok = lane & 31, hi = lane >> 5;
    int* tok_e = (int*)(X.ws + WS_TOKE); int* tok_r = (int*)(X.ws + WS_TOKR); float* glist = (float*)(X.ws + WS_GLIST); unsigned char* XG8 = (unsigned char*)(X.ws + WS_XG);
    unsigned* cnt = X.ctl + CW_CNT + layer * 32 * 64;
    bf16x8 wfh[8], wfl[8];
    { const bf16_t* rwh = (const bf16_t*)(X.ws + WS_RWH) + ((size_t)layer * NE + tok) * D + 128 * w + 8 * hi; const bf16_t* rwl = (const bf16_t*)(X.ws + WS_RWL) + ((size_t)layer * NE + tok) * D + 128 * w + 8 * hi;
#pragma unroll
      for (int i = 0; i < 8; ++i) { wfh[i] = *(const bf16x8*)(rwh + 16 * i); wfl[i] = *(const bf16x8*)(rwl + 16 * i); } }
    const float rbe = rb[tok]; const float ninf = opaque_f(-INFINITY);
    for (int tb = X.bid * 128; tb < T; tb += X.G * 128) {
        for (int rnd = 0; rnd < 4; ++rnd) {
            __syncthreads();
            if (X.tid < 32) s_cnt[X.tid] = 0;
            const int t0 = tb + rnd * 32 + w * 4;
            float v[4][16];
            float gg[16], bb[16];
            { const float* g2 = g; const float* b2 = bta; asm volatile("" : "+s"(g2), "+s"(b2));
#pragma unroll
              for (int j = 0; j < 2; ++j) {
                const f32x4 g0 = *(const f32x4*)(g2 + j * 512 + lane * 8), g1 = *(const f32x4*)(g2 + j * 512 + lane * 8 + 4), b0 = *(const f32x4*)(b2 + j * 512 + lane * 8), b1 = *(const f32x4*)(b2 + j * 512 + lane * 8 + 4);
#pragma unroll
                for (int q = 0; q < 4; ++q) { gg[j * 8 + q] = g0[q]; gg[j * 8 + 4 + q] = g1[q]; bb[j * 8 + q] = b0[q]; bb[j * 8 + 4 + q] = b1[q]; } } }
#pragma unroll
            for (int tl = 0; tl < 4; ++tl) {
                const size_t rowo = (size_t)(t0 + tl) * D;
                float s = 0.f;
#pragma unroll
                for (int j = 0; j < 2; ++j) { float a[8], m[8]; unpack8(*(const u32x4*)(hin + rowo + j * 512 + lane * 8), a); unpack8(*(const u32x4*)(mixo + rowo + j * 512 + lane * 8), m);
#pragma unroll
                    for (int q = 0; q < 8; ++q) { v[tl][j * 8 + q] = DN_ALPHA * a[q] + m[q]; s += v[tl][j * 8 + q]; } }
                const float mean = wave_sum(s) * (1.f / D); float s2 = 0.f;
#pragma unroll
                for (int q = 0; q < 16; ++q) { v[tl][q] -= mean; s2 += v[tl][q] * v[tl][q]; }
                const float rstd = rsqrtf(wave_sum(s2) * (1.f / D) + opaque_f(LN_EPS));
#pragma unroll
                for (int q = 0; q < 16; ++q) v[tl][q] = v[tl][q] * rstd * gg[q] + bb[q];
                const int tr = w * 4 + tl;
#pragma unroll
                for (int j = 0; j < 2; ++j) {
                    u32x4 oh, ol; float lo[8];
                    oh.x = cvt_pk_bf16(v[tl][j * 8 + 0], v[tl][j * 8 + 1]); oh.y = cvt_pk_bf16(v[tl][j * 8 + 2], v[tl][j * 8 + 3]); oh.z = cvt_pk_bf16(v[tl][j * 8 + 4], v[tl][j * 8 + 5]); oh.w = cvt_pk_bf16(v[tl][j * 8 + 6], v[tl][j * 8 + 7]);
                    float hf[8]; unpack8(oh, hf);
#pragma unroll
                    for (int q = 0; q < 8; ++q) lo[q] = v[tl][j * 8 + q] - hf[q];
                    ol = pack8(lo);
                    *(u32x4*)(h1 + rowo + j * 512 + lane * 8) = oh;
                    const int ch = ((lane + 64 * j) ^ (tr & 7)) << 4;
                    *(LAS u32x4*)(Ah + tr * 2048 + ch) = oh; *(LAS u32x4*)(Al + tr * 2048 + ch) = ol;
                }
            }
            __syncthreads();
            f32x16 acc;
#pragma unroll
            for (int q = 0; q < 16; ++q) acc[q] = 0.f;
#pragma unroll
            for (int i = 0; i < 8; ++i) {
                const int ch = ((2 * (8 * w + i) + hi) ^ (tok & 7)) << 4;
                const bf16x8 bh = *(const LAS bf16x8*)(Ah + tok * 2048 + ch), bl = *(const LAS bf16x8*)(Al + tok * 2048 + ch);
                acc = __builtin_amdgcn_mfma_f32_32x32x16_bf16(wfh[i], bh, acc, 0, 0, 0);
                acc = __builtin_amdgcn_mfma_f32_32x32x16_bf16(wfl[i], bh, acc, 0, 0, 0);
                acc = __builtin_amdgcn_mfma_f32_32x32x16_bf16(wfh[i], bl, acc, 0, 0, 0);
            }
            __syncthreads();
#pragma unroll
            for (int q = 0; q < 16; ++q) P[(w * 32 + tok) * 33 + (q & 3) + 8 * (q >> 2) + 4 * hi] = acc[q];
            __syncthreads();
            float lg[4];
#pragma unroll
            for (int tl = 0; tl < 4; ++tl) { float a = 0.f;
#pragma unroll
                for (int ww = 0; ww < 4; ++ww) a += P[((hi * 4 + ww) * 32 + (w * 4 + tl)) * 33 + tok];
                a += __shfl_xor(a, 32); lg[tl] = a + rbe; }
            const int e = tok;
            int my_e = 0; float my_g = 0.f;
#pragma unroll
            for (int tl = 0; tl < 4; ++tl) {
                float cur = lg[tl];
                float sv0 = 0.f, sv1 = 0.f, sv2 = 0.f, sv3 = 0.f; int si0 = 0, si1 = 0, si2 = 0, si3 = 0;
#pragma unroll
                for (int k = 0; k < 4; ++k) {
                    float bv = cur; int bi = e;
#pragma unroll
                    for (int o = 1; o < 32; o <<= 1) { const float ov = __shfl_xor(bv, o); const int oi = __shfl_xor(bi, o); if (ov > bv || (ov == bv && oi < bi)) { bv = ov; bi = oi; } }
                    if (k == 0) { sv0 = bv; si0 = bi; } else if (k == 1) { sv1 = bv; si1 = bi; } else if (k == 2) { sv2 = bv; si2 = bi; } else { sv3 = bv; si3 = bi; }
                    if (e == bi) cur = ninf;
                }
                const float e1 = __expf(sv1 - sv0), e2 = __expf(sv2 - sv0), e3 = __expf(sv3 - sv0), inv = 1.f / (1.f + e1 + e2 + e3);
                if ((lane >> 2) == tl) { const int k = lane & 3; my_e = k == 0 ? si0 : k == 1 ? si1 : k == 2 ? si2 : si3; my_g = (k == 0 ? 1.f : k == 1 ? e1 : k == 2 ? e2 : e3) * inv; }
            }
            int my_lr = 0;
            if (lane < 16) my_lr = __hip_atomic_fetch_add(&s_cnt[my_e], 1, __ATOMIC_RELAXED, __HIP_MEMORY_SCOPE_WORKGROUP);
            __syncthreads();
            if (X.tid < 32) { const int c = s_cnt[X.tid]; s_gb[X.tid] = c ? (int)atomicAdd(cnt + X.tid * 64, (unsigned)c) : 0; }
            __syncthreads();
            int my_r = 0;
            if (lane < 16) { my_r = s_gb[my_e] + my_lr; const int t = t0 + (lane >> 2); tok_e[t * 4 + (lane & 3)] = my_e; tok_r[t * 4 + (lane & 3)] = my_r; glist[(size_t)my_e * T + my_r] = my_g; }
#pragma unroll
            for (int tl = 0; tl < 4; ++tl) {
                u32x2 o0, o1;
                o0.x = pk4_fp8(v[tl][0], v[tl][1], v[tl][2], v[tl][3]); o0.y = pk4_fp8(v[tl][4], v[tl][5], v[tl][6], v[tl][7]);
                o1.x = pk4_fp8(v[tl][8], v[tl][9], v[tl][10], v[tl][11]); o1.y = pk4_fp8(v[tl][12], v[tl][13], v[tl][14], v[tl][15]);
#pragma unroll
                for (int k = 0; k < 4; ++k) { const int ee = __shfl(my_e, tl * 4 + k), rr = __shfl(my_r, tl * 4 + k);
                    unsigned char* dst = XG8 + ((size_t)ee * T + rr) * D + lane * 8;
                    *(u32x2*)(dst) = o0; *(u32x2*)(dst + 512) = o1; }
            }
        }
    }
}

__device__ __forceinline__ void load_tile_table(const Ctx& X, int layer, LAS int* tb) {
    __syncthreads();
    if (X.tid < 64) {
        const int c = X.tid < 32 ? (int)__hip_atomic_load(X.ctl + CW_CNT + (layer * 32 + X.tid) * 64, RLX_AGENT) : 0;
        const int tl = (c + 255) >> 8; int incl = tl;
#pragma unroll
        for (int o = 1; o < 32; o <<= 1) { const int t = __shfl_up(incl, o); if ((X.tid & 31) >= o) incl += t; }
        if (X.tid < 32) { tb[X.tid] = incl - tl; if (X.tid == 31) tb[32] = incl; }
    }
    __syncthreads();
}

template <bool OUT_F32>
__device__ __forceinline__ void phase_combine_ln(const Ctx& X, int layer, const bf16_t* h1, const bf16_t* Y, const float* g, const float* bta, void* outp) {
    const int lane = X.lane;
    const int gw = X.bid * NWAVES + X.wave, NGW = X.G * NWAVES;
    const int* tok_e = (const int*)(X.ws + WS_TOKE); const int* tok_r = (const int*)(X.ws + WS_TOKR);
    int basev = 0;
    { const int c = lane < 32 ? (int)__hip_atomic_load(X.ctl + CW_CNT + (layer * 32 + lane) * 64, RLX_AGENT) : 0; const int pc = ((c + 255) >> 8) << 8; int incl = pc;
#pragma unroll
      for (int o = 1; o < 32; o <<= 1) { const int t = __shfl_up(incl, o); if ((lane & 31) >= o) incl += t; }
      basev = incl - pc; }
    float gg[16], bb[16];
#pragma unroll
    for (int j = 0; j < 2; ++j) {
        const f32x4 g0 = *(const f32x4*)(g + j * 512 + lane * 8), g1 = *(const f32x4*)(g + j * 512 + lane * 8 + 4), b0 = *(const f32x4*)(bta + j * 512 + lane * 8), b1 = *(const f32x4*)(bta + j * 512 + lane * 8 + 4);
#pragma unroll
        for (int q = 0; q < 4; ++q) { gg[j * 8 + q] = g0[q]; gg[j * 8 + 4 + q] = g1[q]; bb[j * 8 + q] = b0[q]; bb[j * 8 + 4 + q] = b1[q]; }
    }
    for (int bt = gw; bt < T; bt += NGW) {
        int myslot = 0;
        if (lane < 4) myslot = tok_r[bt * 4 + lane];
        const int mye = lane < 4 ? tok_e[bt * 4 + lane] : 0;
        myslot += __shfl(basev, mye);
        const int s0 = __shfl(myslot, 0), s1 = __shfl(myslot, 1), s2 = __shfl(myslot, 2), s3 = __shfl(myslot, 3);
        float v[16]; float s = 0.f;
#pragma unroll
        for (int j = 0; j < 2; ++j) {
            const int off = j * 512 + lane * 8;
            float a[8], y0[8], y1[8], y2[8], y3[8];
            unpack8(*(const u32x4*)(h1 + (size_t)bt * D + off), a);
            unpack8(*(const u32x4*)(Y + (size_t)s0 * D + off), y0); unpack8(*(const u32x4*)(Y + (size_t)s1 * D + off), y1); unpack8(*(const u32x4*)(Y + (size_t)s2 * D + off), y2); unpack8(*(const u32x4*)(Y + (size_t)s3 * D + off), y3);
#pragma unroll
            for (int q = 0; q < 8; ++q) { v[j * 8 + q] = DN_ALPHA * a[q] + (((y0[q] + y1[q]) + y2[q]) + y3[q]); s += v[j * 8 + q]; }
        }
        const float mean = wave_sum(s) * (1.f / D); float s2q = 0.f;
#pragma unroll
        for (int q = 0; q < 16; ++q) { v[q] -= mean; s2q += v[q] * v[q]; }
        const float rstd = rsqrtf(wave_sum(s2q) * (1.f / D) + opaque_f(LN_EPS));
#pragma unroll
        for (int q = 0; q < 16; ++q) v[q] = v[q] * rstd * gg[q] + bb[q];
#pragma unroll
        for (int j = 0; j < 2; ++j) {
            const size_t o = (size_t)bt * D + j * 512 + lane * 8;
            if (OUT_F32) { float* op = (float*)outp + o; *(f32x4*)(op) = (f32x4){v[j * 8 + 0], v[j * 8 + 1], v[j * 8 + 2], v[j * 8 + 3]}; *(f32x4*)(op + 4) = (f32x4){v[j * 8 + 4], v[j * 8 + 5], v[j * 8 + 6], v[j * 8 + 7]}; }
            else { u32x4 w; w.x = cvt_pk_bf16(v[j * 8 + 0], v[j * 8 + 1]); w.y = cvt_pk_bf16(v[j * 8 + 2], v[j * 8 + 3]); w.z = cvt_pk_bf16(v[j * 8 + 4], v[j * 8 + 5]); w.w = cvt_pk_bf16(v[j * 8 + 6], v[j * 8 + 7]); *(u32x4*)((bf16_t*)outp + o) = w; }
        }
    }
}


__device__ __forceinline__ Ctx refresh_ctx(const Ctx& X0) {
    Ctx X = X0; int wv = X0.wave; asm volatile("" : "+s"(wv)); int t = wv * 64 + lane_id(); asm volatile("" : "+v"(t)); X.tid = t; X.lane = t & 63; X.wave = wv;
    asm volatile("" : "+s"(X.ws), "+s"(X.ctl), "+s"(X.G), "+s"(X.bid));
    return X;
}
struct Args { const float* in[26]; float* out; unsigned char* ws; int ph_lo, ph_hi; };
constexpr int N_PHASES = 1 + 2 * (6 + 4) + 2 * (4 + 4);
#define GP_ALIGN true
#define GP_SP2 true

__global__ void __launch_bounds__(NTHR, 2) mk_fwd(Args args) {
    extern __shared__ __attribute__((aligned(16))) unsigned char lds_raw[];
    Ctx X0;
    X0.lds = (LAS unsigned char*)lds_raw;
    X0.tid = threadIdx.x; X0.lane = X0.tid & 63; X0.wave = __builtin_amdgcn_readfirstlane(X0.tid >> 6);
    X0.G = gridDim.x; X0.bid = blockIdx.x;
    X0.ws = (GAS unsigned char*)args.ws; X0.ctl = (unsigned*)(args.ws + WS_CTL);
    volatile LAS unsigned* MISC = (volatile LAS unsigned*)(X0.lds + MISC_OFF);
    if (X0.tid < 32) MISC[X0.tid] = 0u;
    __syncthreads();
    XcdBarrier bar; bar.bar = X0.ctl + CW_BAR; bar.x = 0; bar.st = nullptr;
    if (MK_ONE_LAUNCH) bar = xcd_barrier_post(X0.ctl + CW_BAR, MISC + 8);
    volatile LAS unsigned long long* ptab = (volatile LAS unsigned long long*)(X0.lds + TAB_OFF + 1024);
    if (X0.tid < 26) ptab[X0.tid] = (unsigned long long)args.in[X0.tid];
    __syncthreads();
#define INP(k) ld_ptr(ptab, k)
    const int lo = args.ph_lo, hi = args.ph_hi;
    int ph = 0;
#define IN() (lo <= ph && ph < hi)
#define SEAM() do { if (MK_ONE_LAUNCH && lo <= ph && ph + 1 < hi) xcd_barrier(bar); ++ph; } while (0)

#define H0 ((bf16_t*)(X.ws + WS_H0))
#define H1 ((bf16_t*)(X.ws + WS_H1))
#define PROJ ((bf16_t*)(X.ws + WS_PROJ))
#define MIX ((bf16_t*)(X.ws + WS_MIX))
#define MIXO ((bf16_t*)(X.ws + WS_MIXO))
#define Z ((bf16_t*)(X.ws + WS_Z))
#define ACT ((bf16_t*)(X.ws + WS_ACT))
#define Y ((bf16_t*)(X.ws + WS_Y))
#define tb ((LAS int*)(X.lds + TAB_OFF + 512))

#ifndef DUP_MASK
#define DUP_MASK 0
#endif
    enum { P_PRO, P_E1, P_S5A, P_S5C, P_S5B, P_E3, P_E4, P_O1, P_ATT, P_O3, P_LNA, P_M1, P_M2, P_LNB };
#define PHASE_BEGIN(k) _Pragma("nounroll") for (int _r = 0; _r < ((((DUP_MASK) >> (k)) & 1) + 1); ++_r) { if (IN()) { const Ctx X = refresh_ctx(X0);
#define PHASE_END } SEAM(); }
    PHASE_BEGIN(P_PRO)  phase_prologue(X, ptab);  PHASE_END

#pragma nounroll
    for (int layer = 0; layer < DEPTH; ++layer) {
        const int i = layer >> 1;
        if ((layer & 1) == 0) {
            PHASE_BEGIN(P_E1)  pg8::Gemm gm{H0, (const bf16_t*)(X.ws + WS_WIN) + (size_t)i * 2048 * D, T, 2048, D}; pg8::StaticOrder S; S.init(T, 2048, D, X.G, X.bid);
                pg8::EpiStore E{PROJ, 2048};
                pg8::gemm_phase<pg8::EpiStore, pg8::StaticOrder, GP_ALIGN, GP_SP2>(X.lds, gm, S, E, X.wave);  PHASE_END
            PHASE_BEGIN(P_S5A)  phase_s5<1>(X, i, PROJ, INP(2), INP(8), INP(9), INP(10), MIX, Z);  PHASE_END
            PHASE_BEGIN(P_S5C)  phase_s5_carry(X, i);  PHASE_END
            PHASE_BEGIN(P_S5B)  phase_s5<2>(X, i, PROJ, INP(2), INP(8), INP(9), INP(10), MIX, Z);  PHASE_END
            PHASE_BEGIN(P_E3)  pg8::Gemm gm{Z, (const bf16_t*)(X.ws + WS_WGLU) + (size_t)i * 512 * 512, T, 512, 512}; pg8::StaticOrder S; S.init(T, 512, 512, X.G, X.bid);
                pg8::EpiGlu E{Z, MIX, INP(12) + (size_t)i * SSM_W};
                pg8::gemm_phase<pg8::EpiGlu, pg8::StaticOrder, GP_ALIGN, GP_SP2>(X.lds, gm, S, E, X.wave);  PHASE_END
            PHASE_BEGIN(P_E4)  pg8::Gemm gm{MIX, (const bf16_t*)(X.ws + WS_WOUT) + (size_t)i * D * D, T, D, D}; pg8::StaticOrder S; S.init(T, D, D, X.G, X.bid);
                pg8::EpiStore E{MIXO, D};
                pg8::gemm_phase<pg8::EpiStore, pg8::StaticOrder, GP_ALIGN, GP_SP2>(X.lds, gm, S, E, X.wave);  PHASE_END
        } else {
            PHASE_BEGIN(P_O1)  pg8::Gemm gm{H0, (const bf16_t*)(X.ws + WS_WQKV) + (size_t)i * 3072 * D, T, 3072, D}; pg8::StaticOrder S; S.init(T, 3072, D, X.G, X.bid);
                pg8::EpiRope E{PROJ, (const f32x2*)(X.ws + WS_ROPE)};
                pg8::gemm_phase<pg8::EpiRope, pg8::StaticOrder, GP_ALIGN, GP_SP2>(X.lds, gm, S, E, X.wave);  PHASE_END
            PHASE_BEGIN(P_ATT)  phase_attn<0>(X, PROJ, MIX, MIXO, (float2*)(X.ws + WS_S5X));  PHASE_END
            PHASE_BEGIN(P_ATT)  phase_attn<1>(X, PROJ, MIX, MIXO, (float2*)(X.ws + WS_S5X));  PHASE_END
            PHASE_BEGIN(P_O3)  pg8::Gemm gm{MIX, (const bf16_t*)(X.ws + WS_WO) + (size_t)i * D * D, T, D, D}; pg8::StaticOrder S; S.init(T, D, D, X.G, X.bid);
                pg8::EpiStore E{MIXO, D};
                pg8::gemm_phase<pg8::EpiStore, pg8::StaticOrder, GP_ALIGN, GP_SP2>(X.lds, gm, S, E, X.wave);  PHASE_END
        }
        PHASE_BEGIN(P_LNA)  phase_ln_router(X, layer, H0, MIXO, INP(16) + layer * D, INP(17) + layer * D, INP(21) + layer * NE, H1);  PHASE_END
        PHASE_BEGIN(P_M1)  load_tile_table(X, layer, tb);
            pg8::Gemm gm{(const bf16_t*)(X.ws + WS_XG), (const bf16_t*)(X.ws + WS_WGU + (size_t)layer * NE * 2048 * D), 0, 2048, D / 2};
            pg8::MoeOrder<8, true> S; S.init(tb, X.G, X.bid, 2048, D / 2);
            pg8::EpiSwiglu E{ACT, INP(23) + (size_t)layer * NE * 2048};
            pg8::gemm_phase<pg8::EpiSwiglu, pg8::MoeOrder<8, true>, GP_ALIGN, GP_SP2, true>(X.lds, gm, S, E, X.wave, opaque_i(127 - W8_SHIFT_GU), opaque_i(127));  PHASE_END
        PHASE_BEGIN(P_M2)  load_tile_table(X, layer, tb);
            pg8::Gemm gm{ACT, (const bf16_t*)(X.ws + WS_WDN + (size_t)layer * NE * D * D), 0, D, D / 2};
            pg8::MoeOrder<4, false> S; S.init(tb, X.G, X.bid, D, D / 2);
            pg8::EpiDown E{Y, INP(25) + (size_t)layer * NE * D, (const float*)(X.ws + WS_GLIST)};
            pg8::gemm_phase<pg8::EpiDown, pg8::MoeOrder<4, false>, GP_ALIGN, GP_SP2, true>(X.lds, gm, S, E, X.wave, opaque_i(127 - W8_SHIFT_DN), opaque_i(127));  PHASE_END
        PHASE_BEGIN(P_LNB)
            if (layer == DEPTH - 1) phase_combine_ln<true>(X, layer, H1, Y, INP(18) + layer * D, INP(19) + layer * D, (void*)args.out);
            else phase_combine_ln<false>(X, layer, H1, Y, INP(18) + layer * D, INP(19) + layer * D, (void*)H0);
         PHASE_END
    }
#undef IN
#undef SEAM
#undef PHASE_BEGIN
#undef PHASE_END
#undef H0
#undef H1
#undef PROJ
#undef MIX
#undef MIXO
#undef Z
#undef ACT
#undef Y
#undef tb
}

extern "C" void kernel_launch(void* const* d_in, const int* in_sizes, int n_in, void* d_out, int out_size, void* d_ws, size_t ws_size, hipStream_t stream) {
    static int grid = 0;
    if (grid == 0) {
        if (n_in != 26 || out_size != T * D || ws_size < WS_END) { fprintf(stderr, "kernel_launch: unexpected shapes n_in %d out %d ws %zu (need %zu)\n", n_in, out_size, ws_size, (size_t)WS_END); grid = -1; return; }
        int dev = 0, cus = 0, per_cu = 0;
        if (hipGetDevice(&dev) != hipSuccess || hipDeviceGetAttribute(&cus, hipDeviceAttributeMultiprocessorCount, dev) != hipSuccess) { grid = -1; return; }
        if (hipFuncSetAttribute((const void*)mk_fwd, hipFuncAttributeMaxDynamicSharedMemorySize, LDS_BYTES) != hipSuccess) { fprintf(stderr, "kernel_launch: hipFuncSetAttribute failed\n"); grid = -1; return; }
        if (hipOccupancyMaxActiveBlocksPerMultiprocessor(&per_cu, (const void*)mk_fwd, NTHR, LDS_BYTES) != hipSuccess || per_cu < 1) fprintf(stderr, "kernel_launch: occupancy query says %d\n", per_cu);
        (void)hipGetLastError();
        grid = cus;
    }
    if (grid < 0) return;
    if (hipMemsetAsync((char*)d_ws + WS_CTL, 0, CTL_ZERO_BYTES, stream) != hipSuccess) return;
    Args a{};
    for (int i = 0; i < 26; ++i) a.in[i] = (const float*)d_in[i];
    a.out = (float*)d_out; a.ws = (unsigned char*)d_ws;
#if MK_ONE_LAUNCH
    a.ph_lo = 0; a.ph_hi = DUP_MASK ? 100000 : N_PHASES;
    hipLaunchKernelGGL(mk_fwd, dim3(grid), dim3(NTHR), LDS_BYTES, stream, a);
#else
    for (int p = 0; p < N_PHASES; ++p) { a.ph_lo = p; a.ph_hi = p + 1; hipLaunchKernelGGL(mk_fwd, dim3(grid), dim3(NTHR), LDS_BYTES, stream, a); }
#endif
}
```

```cpp
#include <hip/hip_runtime.h>
#include <cstdio>
#include <cstdint>

#ifndef MK_ONE_LAUNCH
#define MK_ONE_LAUNCH 1
#endif

#define GAS __attribute__((address_space(1)))
#define LAS __attribute__((address_space(3)))
#define RLX_AGENT __ATOMIC_RELAXED, __HIP_MEMORY_SCOPE_AGENT
#define WAVE_SYNC() asm volatile("s_waitcnt lgkmcnt(0)" ::: "memory")
typedef float f32x4 __attribute__((ext_vector_type(4)));
typedef float f32x2 __attribute__((ext_vector_type(2)));
typedef unsigned u32x4 __attribute__((ext_vector_type(4)));
typedef unsigned u32x2 __attribute__((ext_vector_type(2)));
typedef unsigned short bf16_t;

constexpr int BATCH = 4, SEQ = 8192, D = 1024, T = BATCH * SEQ, DEPTH = 4;
constexpr int CONV_CH = 512, SSM_W = 512, SSM_G = 32, SSM_H = 16, SSM_P = 64;
constexpr int NH = 16, HD = 64;
constexpr int NE = 32, TOPK = 4, NA = T * TOPK;
constexpr float SW_LIMIT = 7.0f, SW_ALPHA = 1.702f;
constexpr float LN_EPS = 1e-5f;
constexpr float DN_ALPHA = 1.6817928305074290860622509524664f;
constexpr int NWAVES = 8, NTHR = 512;

constexpr size_t MiB = 1u << 20;
constexpr size_t WS_CTL = 0, CTL_ZERO_BYTES = 1 * MiB;
constexpr size_t WS_S5A = 1 * MiB;
constexpr size_t WS_S5B = 1 * MiB + 65536;
constexpr size_t WS_ROPE = 2 * MiB;
constexpr size_t WS_S5X = 48 * MiB;
constexpr size_t WS_TOKE = 4 * MiB;
constexpr size_t WS_TOKR = 4 * MiB + 524288;
constexpr size_t WS_RWH = 5 * MiB;
constexpr size_t WS_RWL = 5 * MiB + 262144;
constexpr size_t WS_GLIST = 8 * MiB;
constexpr size_t WS_S5S = 12 * MiB;
constexpr size_t WS_WIN = 16 * MiB;
constexpr size_t WS_WGLU = 24 * MiB;
constexpr size_t WS_WOUT = 26 * MiB;
constexpr size_t WS_WQKV = 32 * MiB;
constexpr size_t WS_WO = 44 * MiB;
constexpr size_t WS_WGU = 64 * MiB;
constexpr size_t WS_WDN = 576 * MiB;
constexpr size_t WS_H0 = 832 * MiB;
constexpr size_t WS_H1 = 896 * MiB;
constexpr size_t WS_PROJ = 960 * MiB;
constexpr size_t WS_MIX = 1152 * MiB;
constexpr size_t WS_MIXO = 1216 * MiB;
constexpr size_t WS_Z = 1280 * MiB;
constexpr size_t WS_ACT = 1312 * MiB;
constexpr size_t WS_Y = 1584 * MiB;
constexpr size_t WS_XG = 1856 * MiB;
constexpr size_t WS_END = 3904 * MiB;
constexpr int CW_BAR = 4096;
constexpr int CW_CNT = 16384;

constexpr int LDS_BYTES = 147456;
constexpr int MISC_OFF = 131072 + 320;
constexpr int TAB_OFF = 131072 + 1024;

#define XB_TMO      128
#define XB_XCNT(j)  (256  + 64 * (j))
#define XB_XSUB(j)  (1280 + 64 * (j))
#define XB_XGEN(j)  (2304 + 64 * (j))
#define XB_TOP      3328
#define XB_TOPGEN   3392
#define XCD_BAR_WORDS 3456
#define XB_SPIN_CAP (1u << 22)

__device__ __forceinline__ unsigned xb_ld(unsigned* p)              { return __hip_atomic_load(p, __ATOMIC_RELAXED, __HIP_MEMORY_SCOPE_AGENT); }
__device__ __forceinline__ unsigned xb_add(unsigned* p, unsigned v) { return __hip_atomic_fetch_add(p, v, __ATOMIC_RELAXED, __HIP_MEMORY_SCOPE_AGENT); }
__device__ __forceinline__ unsigned xb_xcc_id() { return (unsigned)__builtin_amdgcn_s_getreg((3 << 11) | 20) & 0xFu; }
#define XB_SPIN(cond, bar) do { unsigned _sp = 0; while (cond) { __builtin_amdgcn_s_sleep(1); \
    if ((++_sp & 255u) == 0u) { if (xb_ld(&(bar)[XB_TMO])) break; if (_sp > XB_SPIN_CAP) { atomicAdd(&(bar)[XB_TMO], 1u); break; } } } } while (0)

struct XcdBarrier { unsigned* bar; unsigned x; volatile LAS unsigned* st; };

__device__ __forceinline__ XcdBarrier xcd_barrier_post(unsigned* bar, volatile LAS unsigned* st) {
    XcdBarrier b; b.bar = bar; b.x = xb_xcc_id(); b.st = st;
    if (threadIdx.x == 0) (void)xb_add(&bar[XB_XCNT(b.x)], 1u);
    return b;
}
__device__ __forceinline__ void xcd_barrier_complete(unsigned* bar, unsigned x, unsigned& nloc, unsigned& nx) {
    const unsigned G = gridDim.x * gridDim.y * gridDim.z;
    unsigned sum, cnt, mine, sp = 0u;
    for (;;) {
        sum = 0u; cnt = 0u; mine = 0u;
#pragma unroll
        for (unsigned j = 0; j < 16; ++j) { const unsigned c = xb_ld(&bar[XB_XCNT(j)]); sum += c; cnt += (c > 0u) ? 1u : 0u; mine = (j == x) ? c : mine; }
        if (sum == G) break;
        __builtin_amdgcn_s_sleep(1);
        if ((++sp & 255u) == 0u) { if (xb_ld(&bar[XB_TMO])) break; if (sp > XB_SPIN_CAP) { atomicAdd(&bar[XB_TMO], 1u); break; } }
    }
    nloc = mine > 0u ? mine : 1u; nx = cnt > 0u ? cnt : 1u;
}
__device__ __forceinline__ void xcd_barrier(const XcdBarrier& b) {
    asm volatile("s_waitcnt vmcnt(0)" ::: "memory");
    __syncthreads();
    if (threadIdx.x == 0) {
        unsigned* bar = b.bar;
        __builtin_amdgcn_s_waitcnt(0);
        unsigned nloc = b.st[0], nx = b.st[1];
        if (nloc == 0u) { xcd_barrier_complete(bar, b.x, nloc, nx); b.st[0] = nloc; b.st[1] = nx; }
        const unsigned old = xb_add(&bar[XB_XSUB(b.x)], 1u);
        const unsigned gen = old / nloc;
        if (old + 1u == (gen + 1u) * nloc) {
            __builtin_amdgcn_fence(__ATOMIC_RELEASE, "agent");
            asm volatile("s_waitcnt vmcnt(0)" ::: "memory");
            const unsigned og = xb_add(&bar[XB_TOP], 1u);
            const unsigned tg = og / nx;
            if (og + 1u == (tg + 1u) * nx) xb_add(&bar[XB_TOPGEN], 1u);
            else XB_SPIN(xb_ld(&bar[XB_TOPGEN]) == tg, bar);
            __builtin_amdgcn_fence(__ATOMIC_ACQUIRE, "agent");
            xb_add(&bar[XB_XGEN(b.x)], 1u);
            asm volatile("s_waitcnt vmcnt(0)" ::: "memory");
        } else {
            XB_SPIN(xb_ld(&bar[XB_XGEN(b.x)]) == gen, bar);
            __builtin_amdgcn_fence(__ATOMIC_ACQUIRE, "agent");
            asm volatile("s_waitcnt vmcnt(0)" ::: "memory");
        }
    }
    __syncthreads();
}

__device__ __forceinline__ float wave_sum(float v) {
#pragma unroll
    for (int o = 1; o < 64; o <<= 1) v += __shfl_xor(v, o);
    return v;
}
__device__ __forceinline__ float wave_max(float v) {
#pragma unroll
    for (int o = 1; o < 64; o <<= 1) v = fmaxf(v, __shfl_xor(v, o));
    return v;
}
__device__ __forceinline__ float sigmoidf_(float x) { return __builtin_amdgcn_rcpf(1.0f + __builtin_amdgcn_exp2f(-1.4426950408889634f * x)); }
__device__ __forceinline__ float gelu_tanh(float y) { return y * sigmoidf_(1.5957691216057308f * (y + 0.044715f * y * y * y)); }
__device__ __forceinline__ float opaque_f(float v) { asm volatile("" : "+s"(v)); return v; }
__device__ __forceinline__ int opaque_i(int v) { asm volatile("" : "+s"(v)); return v; }
__device__ __forceinline__ int seqpos(int bt) { return bt - ((bt >> 13) << 13); }
__device__ __forceinline__ unsigned f2bf(float f) { unsigned u = __builtin_bit_cast(unsigned, f); return (u + 0x7fffu + ((u >> 16) & 1u)) >> 16; }
__device__ __forceinline__ unsigned pk2(float lo, float hi) { return f2bf(lo) | (f2bf(hi) << 16); }
typedef float f32x2_t_ __attribute__((ext_vector_type(2))); typedef __bf16 bf16x2_t_ __attribute__((ext_vector_type(2)));
__device__ __forceinline__ unsigned cvt_pk_bf16(float lo, float hi) { const f32x2_t_ v = {lo, hi}; const bf16x2_t_ b = __builtin_convertvector(v, bf16x2_t_); return __builtin_bit_cast(unsigned, b); }
__device__ __forceinline__ float bf_lo(unsigned w) { return __builtin_bit_cast(float, w << 16); }
__device__ __forceinline__ float bf_hi(unsigned w) { return __builtin_bit_cast(float, w & 0xffff0000u); }
__device__ __forceinline__ float bf2f(bf16_t b) { return __builtin_bit_cast(float, ((unsigned)b) << 16); }
__device__ __forceinline__ void unpack8(const u32x4 w, float (&f)[8]) { f[0] = bf_lo(w.x); f[1] = bf_hi(w.x); f[2] = bf_lo(w.y); f[3] = bf_hi(w.y); f[4] = bf_lo(w.z); f[5] = bf_hi(w.z); f[6] = bf_lo(w.w); f[7] = bf_hi(w.w); }
__device__ __forceinline__ u32x4 pack8(const float (&f)[8]) { u32x4 w; w.x = cvt_pk_bf16(f[0], f[1]); w.y = cvt_pk_bf16(f[2], f[3]); w.z = cvt_pk_bf16(f[4], f[5]); w.w = cvt_pk_bf16(f[6], f[7]); return w; }

__device__ __forceinline__ unsigned pk4_fp8(float a, float b, float c, float d) {
    int w = __builtin_amdgcn_cvt_pk_fp8_f32(a, b, 0, false); w = __builtin_amdgcn_cvt_pk_fp8_f32(c, d, w, true); return (unsigned)w; }
__device__ __forceinline__ u32x2 pack8_fp8(const float (&f)[8]) { u32x2 w; w.x = pk4_fp8(f[0], f[1], f[2], f[3]); w.y = pk4_fp8(f[4], f[5], f[6], f[7]); return w; }
typedef float f32x2v_ __attribute__((ext_vector_type(2)));
__device__ __forceinline__ void unpack8_fp8(const u32x2 w, float (&f)[8]) {
    const f32x2v_ a = __builtin_amdgcn_cvt_pk_f32_fp8((int)w.x, false), b = __builtin_amdgcn_cvt_pk_f32_fp8((int)w.x, true), c = __builtin_amdgcn_cvt_pk_f32_fp8((int)w.y, false), d = __builtin_amdgcn_cvt_pk_f32_fp8((int)w.y, true);
    f[0] = a.x; f[1] = a.y; f[2] = b.x; f[3] = b.y; f[4] = c.x; f[5] = c.y; f[6] = d.x; f[7] = d.y; }
constexpr float Y8_SCALE = 16.0f;
constexpr int W8_SHIFT_GU = 5, W8_SHIFT_DN = 6;

__device__ __forceinline__ int lane_id() { return (int)__builtin_amdgcn_mbcnt_hi(~0u, __builtin_amdgcn_mbcnt_lo(~0u, 0u)); }

struct Ctx {
    LAS unsigned char* lds;
    int tid, lane, wave, G, bid;
    unsigned* ctl;
    GAS unsigned char* ws;
};

namespace pg8 {
#define PG8_LAS __attribute__((address_space(3)))
typedef short bf16x8 __attribute__((ext_vector_type(8)));
constexpr int BM = 256, BK = 64, HALF = 128, HTB = HALF * BK * 2  , STAGE_BYTES = 8 * HTB, NXCD = 8, WGM = 8;

__host__ __device__ __forceinline__ int lds_byte(int r, int c) { const int st = (r >> 4) * 2 + (c >> 5), rr = r & 15, cc = c & 31, ob = rr * 64 + cc * 2; return st * 1024 + (ob ^ (((ob >> 9) & 1) << 5)); }
__host__ __device__ __forceinline__ void stage_rc(int b, int& R, int& C) { const int st = b / 1024, sb = b % 1024, swz = sb ^ (((sb >> 9) & 1) << 5); R = (st >> 1) * 16 + swz / 64; C = (st & 1) * 32 + (swz % 64) / 2; }
__host__ __device__ __forceinline__ int perm32(int rho) { const int n = rho >> 4, i = rho & 15; return 8 * (i >> 2) + 4 * n + (i & 3); }

struct Unit { int pm, pn, e, mt; };
struct Gemm { const bf16_t* A; const bf16_t* Bt; int M, N, K; };

struct StaticOrder {
    int nM, nN, nwg, G, c; size_t tstep;
    __device__ void init(int M, int N, int K, int G_, int c_) { nM = M / BM; nN = N / BM; nwg = nM * nN; G = G_; c = c_; tstep = (size_t)BM * K * 2; }
    __device__ bool next(int i, Unit& u) const {
        const long L = (long)i * G + c; if (L >= nwg) return false;
        int wgid = (int)L; { const int q = nwg / NXCD, r = nwg % NXCD, xcd = wgid % NXCD, off = wgid / NXCD; wgid = (xcd < r ? xcd * (q + 1) : r * (q + 1) + (xcd - r) * q) + off; }
        const int nig = WGM * nN, gid = wgid / nig, fm = gid * WGM, gsz = (nM - fm) < WGM ? (nM - fm) : WGM;
        u.pm = fm + ((wgid % nig) % gsz); u.pn = (wgid % nig) / gsz; u.e = 0; u.mt = 0; return true;
    }
    __device__ __forceinline__ size_t a_off(const Unit& u) const { return (size_t)u.pm * tstep; }
    __device__ __forceinline__ size_t b_off(const Unit& u) const { return (size_t)u.pn * tstep; }
    __device__ __forceinline__ void a_ready(const Unit&) const {}
    __device__ __forceinline__ void done(const Unit&) const {}
};
template <int NPN, bool A_IS_XG> struct MoeOrder {
    const PG8_LAS int* tb; int G, c, ntile; size_t bexp, rowb;
    __device__ void init(const PG8_LAS int* tb_, int G_, int c_, int Nexp, int K) { tb = tb_; G = G_; c = c_; ntile = tb_[32]; rowb = (size_t)K * 2; bexp = (size_t)Nexp * rowb; }
    __device__ bool next(int i, Unit& u) const {
        int mtg, pn;
        if (G == 256) { constexpr int MPR = 256 / NPN, MPX = MPR / 8; mtg = MPR * i + MPX * (c & 7) + (c >> 3) / NPN; pn = (c >> 3) % NPN; }
        else { const long L = (long)i * G + c; mtg = (int)(L / NPN); pn = (int)(L % NPN); }
        if (mtg >= ntile) return false;
        int e = 0;
#pragma unroll
        for (int st = 16; st >= 1; st >>= 1) { const int tv = __builtin_amdgcn_readfirstlane(tb[e + st]); if (tv <= mtg) e += st; }
        u.pm = mtg; u.pn = pn; u.e = e; u.mt = mtg - tb[e]; return true;
    }
    __device__ __forceinline__ size_t a_off(const Unit& u) const { return A_IS_XG ? ((size_t)u.e * T + (size_t)u.mt * BM) * rowb : (size_t)u.pm * BM * rowb; }
    __device__ __forceinline__ size_t b_off(const Unit& u) const { return (size_t)u.e * bexp + (size_t)u.pn * BM * rowb; }
    __device__ __forceinline__ void a_ready(const Unit&) const {}
    __device__ __forceinline__ void done(const Unit&) const {}
};

__device__ __forceinline__ u32x4 pack_v(const f32x4 v0, const f32x4 v1) { u32x4 w; w.x = cvt_pk_bf16(v0[0], v0[1]); w.y = cvt_pk_bf16(v0[2], v0[3]); w.z = cvt_pk_bf16(v1[0], v1[1]); w.w = cvt_pk_bf16(v1[2], v1[3]); return w; }

struct EpiStore {
    static constexpr bool PERM = true, AFTER_DRAIN = false, BIAS_INIT = false;
    bf16_t* O; int ldc;
    __device__ __forceinline__ void operator()(const f32x4 (&acc)[2][2][4][2], const Unit& u, int wr, int wc, int fr, int fq) const {
        const int row0 = u.pm * BM + wr * 64 + fr, col0 = u.pn * BM + wc * 32 + 8 * fq;
#pragma unroll
        for (int ai = 0; ai < 2; ++ai)
#pragma unroll
            for (int m = 0; m < 4; ++m) { bf16_t* rowp = O + (size_t)(row0 + ai * HALF + m * 16) * ldc + col0;
#pragma unroll
                for (int bj = 0; bj < 2; ++bj) *(u32x4*)(rowp + bj * HALF) = pack_v(acc[ai][bj][m][0], acc[ai][bj][m][1]); }
    }
};
struct EpiGlu {
    static constexpr bool PERM = true, AFTER_DRAIN = false, BIAS_INIT = false;
    const bf16_t* Z; bf16_t* MIX; const float* bias;
    __device__ __forceinline__ void operator()(const f32x4 (&acc)[2][2][4][2], const Unit& u, int wr, int wc, int fr, int fq) const {
        const int row0 = u.pm * BM + wr * 64 + fr, col0 = u.pn * BM + wc * 32 + 8 * fq;
        f32x4 bv[2][2];
#pragma unroll
        for (int bj = 0; bj < 2; ++bj)
#pragma unroll
            for (int n = 0; n < 2; ++n) bv[bj][n] = *(const f32x4*)(bias + col0 + bj * HALF + 4 * n);
#pragma unroll
        for (int ai = 0; ai < 2; ++ai)
#pragma unroll
            for (int m = 0; m < 4; ++m) { const size_t row = (size_t)(row0 + ai * HALF + m * 16);
#pragma unroll
                for (int bj = 0; bj < 2; ++bj) {
                    const u32x4 zw = *(const u32x4*)(Z + row * SSM_W + col0 + bj * HALF); float z[8]; unpack8(zw, z);
                    const f32x4 a0 = acc[ai][bj][m][0] + bv[bj][0], a1 = acc[ai][bj][m][1] + bv[bj][1];
                    float o[8];
#pragma unroll
                    for (int j = 0; j < 4; ++j) { o[j] = z[j] * sigmoidf_(a0[j]); o[4 + j] = z[4 + j] * sigmoidf_(a1[j]); }
                    *(u32x4*)(MIX + row * D + 512 + col0 + bj * HALF) = pack8(o); } }
    }
};
struct EpiRope {
    static constexpr bool PERM = true, AFTER_DRAIN = false, BIAS_INIT = false;
    bf16_t* O; const f32x2* rope;
    __device__ __forceinline__ void operator()(const f32x4 (&acc)[2][2][4][2], const Unit& u, int wr, int wc, int fr, int fq) const {
        const int part = u.pn >> 2, tp = u.pn & 3;
        const int row0 = u.pm * BM + wr * 64 + fr, colb = part * 1024 + (4 * tp + wc) * 64 + 8 * fq;
        const float qs = part == 0 ? 0.125f * 1.4426950408889634f : 1.0f;
#pragma unroll
        for (int ai = 0; ai < 2; ++ai)
#pragma unroll
            for (int m = 0; m < 4; ++m) { const int row = row0 + ai * HALF + m * 16; bf16_t* rowp = O + (size_t)row * 3072 + colb;
                const f32x4 x1a = acc[ai][0][m][0], x1b = acc[ai][0][m][1], x2a = acc[ai][1][m][0], x2b = acc[ai][1][m][1];
                if (part < 2) {
                    const f32x4* rp = (const f32x4*)(rope + (size_t)seqpos(row) * 32 + 8 * fq);
                    const f32x4 c01 = rp[0], c23 = rp[1], c45 = rp[2], c67 = rp[3];
                    float o1[8], o2[8];
                    const float cs[8] = {c01[0], c01[2], c23[0], c23[2], c45[0], c45[2], c67[0], c67[2]}, sn[8] = {c01[1], c01[3], c23[1], c23[3], c45[1], c45[3], c67[1], c67[3]};
                    const float x1[8] = {x1a[0], x1a[1], x1a[2], x1a[3], x1b[0], x1b[1], x1b[2], x1b[3]}, x2[8] = {x2a[0], x2a[1], x2a[2], x2a[3], x2b[0], x2b[1], x2b[2], x2b[3]};
#pragma unroll
                    for (int j = 0; j < 8; ++j) { o1[j] = (x1[j] * cs[j] - x2[j] * sn[j]) * qs; o2[j] = (x2[j] * cs[j] + x1[j] * sn[j]) * qs; }
                    *(u32x4*)(rowp) = pack8(o1); *(u32x4*)(rowp + 32) = pack8(o2);
                } else { *(u32x4*)(rowp) = pack_v(x1a, x1b); *(u32x4*)(rowp + 32) = pack_v(x2a, x2b); } }
    }
};
struct EpiSwiglu {
    static constexpr bool PERM = true, AFTER_DRAIN = false, BIAS_INIT = true;
    bf16_t* ACT; const float* bgu;
    __device__ __forceinline__ void init(f32x4 (&acc)[2][2][4][2], const Unit& u, int wc, int fq) const {
        const float* bb = bgu + (size_t)u.e * 2048 + u.pn * 128 + wc * 32 + 8 * fq;
        const f32x4 bg0 = *(const f32x4*)(bb), bg1 = *(const f32x4*)(bb + 4), bl0 = *(const f32x4*)(bb + 1024), bl1 = *(const f32x4*)(bb + 1028);
#pragma unroll
        for (int ai = 0; ai < 2; ++ai)
#pragma unroll
            for (int m = 0; m < 4; ++m) { acc[ai][0][m][0] = bg0; acc[ai][0][m][1] = bg1; acc[ai][1][m][0] = bl0; acc[ai][1][m][1] = bl1; }
    }
    __device__ __forceinline__ void operator()(const f32x4 (&acc)[2][2][4][2], const Unit& u, int wr, int wc, int fr, int fq) const {
        const int row0 = u.pm * BM + wr * 64 + fr, j0 = u.pn * 128 + wc * 32 + 8 * fq;
        unsigned char* ab = (unsigned char*)ACT + (size_t)row0 * D + j0;
#pragma unroll
        for (int ai = 0; ai < 2; ++ai)
#pragma unroll
            for (int m = 0; m < 4; ++m) {
                const f32x4 g0 = acc[ai][0][m][0], g1 = acc[ai][0][m][1], l0 = acc[ai][1][m][0], l1 = acc[ai][1][m][1];
                float o[8];
#pragma unroll
                for (int j = 0; j < 4; ++j) {
                    const float ga = fminf(g0[j], SW_LIMIT), gb = fminf(g1[j], SW_LIMIT);
                    const float la = fminf(fmaxf(l0[j], -SW_LIMIT), SW_LIMIT), lb = fminf(fmaxf(l1[j], -SW_LIMIT), SW_LIMIT);
                    o[j] = (la + 1.0f) * (ga * sigmoidf_(SW_ALPHA * ga)); o[4 + j] = (lb + 1.0f) * (gb * sigmoidf_(SW_ALPHA * gb)); }
                *(u32x2*)(ab + (size_t)(ai * HALF + m * 16) * D) = pack8_fp8(o); }
    }
};
struct EpiDown {
    static constexpr bool PERM = true, AFTER_DRAIN = false, BIAS_INIT = true;
    bf16_t* Y; const float* bd; const float* glist;
    __device__ __forceinline__ void init(f32x4 (&acc)[2][2][4][2], const Unit& u, int wc, int fq) const {
        const float* bb = bd + (size_t)u.e * D + u.pn * BM + wc * 32 + 8 * fq;
        const f32x4 b00 = *(const f32x4*)(bb), b01 = *(const f32x4*)(bb + 4), b10 = *(const f32x4*)(bb + HALF), b11 = *(const f32x4*)(bb + HALF + 4);
#pragma unroll
        for (int ai = 0; ai < 2; ++ai)
#pragma unroll
            for (int m = 0; m < 4; ++m) { acc[ai][0][m][0] = b00; acc[ai][0][m][1] = b01; acc[ai][1][m][0] = b10; acc[ai][1][m][1] = b11; }
    }
    __device__ __forceinline__ void operator()(const f32x4 (&acc)[2][2][4][2], const Unit& u, int wr, int wc, int fr, int fq) const {
        const int rl0 = wr * 64 + fr, col0 = u.pn * BM + wc * 32 + 8 * fq;
        const float* gl = glist + (size_t)u.e * T + (size_t)u.mt * BM + rl0;
        unsigned char* yb = (unsigned char*)Y + ((size_t)u.pm * BM + rl0) * D + col0;
#pragma unroll
        for (int ai = 0; ai < 2; ++ai)
#pragma unroll
            for (int m = 0; m < 4; ++m) { const int rl = ai * HALF + m * 16; const float gt = gl[rl] * Y8_SCALE;
#pragma unroll
                for (int bj = 0; bj < 2; ++bj) { const f32x4 v0 = acc[ai][bj][m][0] * gt, v1 = acc[ai][bj][m][1] * gt; u32x2 w; w.x = pk4_fp8(v0[0], v0[1], v0[2], v0[3]); w.y = pk4_fp8(v1[0], v1[1], v1[2], v1[3]);
                    *(u32x2*)(yb + (size_t)rl * D + bj * HALF) = w; } }
    }
};

template <class Epi, class Sched, bool ALIGN_EPI = false, bool SP2 = false, bool FP8 = false>
__device__ __forceinline__ void gemm_phase(PG8_LAS unsigned char* lds, const Gemm g, const Sched& S, const Epi& E, int wave_, int scale_w = 127, int scale_x = 127) {
    int tid = wave_ * 64 + lane_id(); asm volatile("" : "+v"(tid)); const int wid = wave_, lane = tid & 63, wr = wid >> 2, wc = wid & 3, fr = lane & 15, fq = lane >> 4;
    const int K = g.K, nt = K / BK;
    unsigned voffA[2], voffB[2];
#pragma unroll
    for (int i = 0; i < 2; ++i) { int R, C; stage_rc(tid * 16 + i * 8192, R, C); const int Rb = Epi::PERM ? ((R & ~31) + perm32(R & 31)) : R;
        voffA[i] = (unsigned)(R * K + C) * 2u; voffB[i] = (unsigned)(Rb * K + C) * 2u; }
    const unsigned kstep = (unsigned)(BK * 2);
    const unsigned hstep = (unsigned)HALF * (unsigned)K * 2u;
    const unsigned ldsw = (unsigned)wid * 1024u;
    const int aoff = lds_byte(wr * 64 + fr, fq * 8), boff = lds_byte(wc * 32 + fr, fq * 8);
#define PG8_SA(b, h) (((b) * 2 + (h)) * HTB)
#define PG8_SB(b, h) ((4 + (b) * 2 + (h)) * HTB)
#define PG8_STAGE(bufoff, gbase, voff) do { _Pragma("unroll") for (int _i = 0; _i < 2; ++_i) \
        __builtin_amdgcn_raw_ptr_buffer_load_lds(rsrc_##voff, (PG8_LAS unsigned*)(lds + (bufoff) + ldsw + _i * 8192), 16, (voff)[_i], (gbase), 0, 0); } while (0)
#define PG8_LDA(dst, b, h) do { if constexpr (FP8) { _Pragma("unroll") for (int m = 0; m < 4; ++m) { const v4i_ lo_ = *(const PG8_LAS v4i_*)(lds + PG8_SA(b, h) + aoff + m * 2048), hi_ = *(const PG8_LAS v4i_*)(lds + PG8_SA(b, h) + aoff + m * 2048 + 1024); dst##8[m] = __builtin_shufflevector(lo_, hi_, 0, 1, 2, 3, 4, 5, 6, 7); } } \
        else { _Pragma("unroll") for (int m = 0; m < 4; ++m) _Pragma("unroll") for (int k = 0; k < 2; ++k) dst[m][k] = *(const PG8_LAS bf16x8*)(lds + PG8_SA(b, h) + aoff + m * 2048 + k * 1024); } } while (0)
#define PG8_LDB(dst, b, h) do { if constexpr (FP8) { _Pragma("unroll") for (int n = 0; n < 2; ++n) { const v4i_ lo_ = *(const PG8_LAS v4i_*)(lds + PG8_SB(b, h) + boff + n * 2048), hi_ = *(const PG8_LAS v4i_*)(lds + PG8_SB(b, h) + boff + n * 2048 + 1024); dst##8[n] = __builtin_shufflevector(lo_, hi_, 0, 1, 2, 3, 4, 5, 6, 7); } } \
        else { _Pragma("unroll") for (int n = 0; n < 2; ++n) _Pragma("unroll") for (int k = 0; k < 2; ++k) dst[n][k] = *(const PG8_LAS bf16x8*)(lds + PG8_SB(b, h) + boff + n * 2048 + k * 1024); } } while (0)
#define PG8_MMA(ai, bj, At, Bt) do { __builtin_amdgcn_s_setprio(1); _Pragma("unroll") for (int m = 0; m < 4; ++m) _Pragma("unroll") for (int n = 0; n < 2; ++n) { \
        if constexpr (FP8) acc[ai][bj][m][n] = __builtin_amdgcn_mfma_scale_f32_16x16x128_f8f6f4(Bt##8[n], At##8[m], acc[ai][bj][m][n], 0, 0, 0, scale_w, 0, scale_x); \
        else { _Pragma("unroll") for (int k = 0; k < 2; ++k) acc[ai][bj][m][n] = __builtin_amdgcn_mfma_f32_16x16x32_bf16(Bt[n][k], At[m][k], acc[ai][bj][m][n], 0, 0, 0); } } \
        __builtin_amdgcn_s_setprio(0); } while (0)
#define PG8_WAIT_V(n) asm volatile("s_waitcnt vmcnt(" #n ")" ::: "memory")
#define PG8_WAIT_L(n) asm volatile("s_waitcnt lgkmcnt(" #n ")" ::: "memory")
#define PG8_BAR __builtin_amdgcn_s_barrier()
#define PG8_SCHED __builtin_amdgcn_sched_barrier(0)
#define PG8_ACC_INIT(u_) do { if constexpr (Epi::BIAS_INIT) { int tz_ = lane_id(); asm volatile("" : "+v"(tz_)); E.init(acc, u_, wc, (tz_ & 63) >> 4); } else { \
        _Pragma("unroll") for (int a = 0; a < 2; ++a) _Pragma("unroll") for (int b = 0; b < 2; ++b) _Pragma("unroll") for (int m = 0; m < 4; ++m) _Pragma("unroll") for (int n = 0; n < 2; ++n) acc[a][b][m][n] = (f32x4){0.f, 0.f, 0.f, 0.f}; } } while (0)
    Unit cur, nxt; int ui = 0;
    if (!S.next(0, cur)) return;
    f32x4 acc[2][2][4][2];
    PG8_ACC_INIT(cur);
    typedef int v4i_ __attribute__((ext_vector_type(4))); typedef int v8i_ __attribute__((ext_vector_type(8)));
    bf16x8 At[4][2], B0[2][2], B1[2][2]; v8i_ At8[4], B08[2], B18[2];
    const auto rsrc_voffA = __builtin_amdgcn_make_buffer_rsrc((void*)g.A, 0, -1, 0x00020000), rsrc_voffB = __builtin_amdgcn_make_buffer_rsrc((void*)g.Bt, 0, -1, 0x00020000);
    unsigned cA = (unsigned)__builtin_amdgcn_readfirstlane((int)(unsigned)S.a_off(cur)), cB = (unsigned)__builtin_amdgcn_readfirstlane((int)(unsigned)S.b_off(cur));
    S.a_ready(cur);
    if constexpr (SP2) {
        PG8_STAGE(PG8_SB(0, 0), cB, voffB); PG8_STAGE(PG8_SB(0, 1), cB + hstep, voffB); PG8_STAGE(PG8_SA(0, 0), cA, voffA); PG8_STAGE(PG8_SA(0, 1), cA + hstep, voffA);
        if (wr == 1) PG8_BAR;
        PG8_WAIT_V(2); PG8_BAR;
        PG8_STAGE(PG8_SB(1, 0), cB + kstep, voffB); PG8_STAGE(PG8_SA(1, 0), cA + kstep, voffA); PG8_STAGE(PG8_SB(1, 1), cB + hstep + kstep, voffB);
        PG8_WAIT_V(6); PG8_BAR;
    } else {
        PG8_STAGE(PG8_SB(0, 0), cB, voffB); PG8_STAGE(PG8_SA(0, 0), cA, voffA); PG8_STAGE(PG8_SB(0, 1), cB + hstep, voffB); PG8_STAGE(PG8_SA(0, 1), cA + hstep, voffA);
        if (wr == 1) PG8_BAR;
        PG8_WAIT_V(4); PG8_BAR;
        PG8_STAGE(PG8_SB(1, 0), cB + kstep, voffB); PG8_STAGE(PG8_SA(1, 0), cA + kstep, voffA); PG8_STAGE(PG8_SB(1, 1), cB + hstep + kstep, voffB);
        PG8_WAIT_V(6); PG8_BAR;
    }
    for (;;) {
        const bool has_next = S.next(ui + 1, nxt);
        const unsigned nA = has_next ? (unsigned)__builtin_amdgcn_readfirstlane((int)(unsigned)S.a_off(nxt)) : cA, nB = has_next ? (unsigned)__builtin_amdgcn_readfirstlane((int)(unsigned)S.b_off(nxt)) : cB;
#pragma nounroll
        for (int t = 0; t < nt; t += 2) {
            const bool last = (t == nt - 2);
            const unsigned a1 = cA + (unsigned)(t + 1) * kstep;
            const unsigned a2 = last ? nA : cA + (unsigned)(t + 2) * kstep, b2 = last ? nB : cB + (unsigned)(t + 2) * kstep;
            const unsigned a3 = a2 + kstep, b3 = b2 + kstep;
            if (last && has_next) S.a_ready(nxt);
            if constexpr (SP2) {
            PG8_LDB(B0, 0, 0); PG8_LDB(B1, 0, 1); PG8_SCHED; PG8_LDA(At, 0, 0); PG8_STAGE(PG8_SA(1, 1), a1 + hstep, voffA);
            PG8_WAIT_V(8); PG8_WAIT_L(0); PG8_BAR; PG8_MMA(0, 0, At, B0); PG8_MMA(0, 1, At, B1); PG8_BAR; PG8_SCHED;
            PG8_LDA(At, 0, 1); PG8_STAGE(PG8_SB(0, 0), b2, voffB); PG8_STAGE(PG8_SB(0, 1), b2 + hstep, voffB); PG8_STAGE(PG8_SA(0, 0), a2, voffA);
            PG8_WAIT_V(8); PG8_WAIT_L(0); PG8_BAR; PG8_MMA(1, 0, At, B0); PG8_MMA(1, 1, At, B1); PG8_BAR; PG8_SCHED;
            PG8_LDB(B0, 1, 0); PG8_LDB(B1, 1, 1); PG8_SCHED; PG8_LDA(At, 1, 0); PG8_STAGE(PG8_SA(0, 1), a2 + hstep, voffA);
            PG8_WAIT_V(8); PG8_WAIT_L(0); PG8_BAR; PG8_MMA(0, 0, At, B0); PG8_MMA(0, 1, At, B1); PG8_BAR; PG8_SCHED;
            PG8_LDA(At, 1, 1); PG8_STAGE(PG8_SB(1, 0), b3, voffB); PG8_STAGE(PG8_SB(1, 1), b3 + hstep, voffB); PG8_STAGE(PG8_SA(1, 0), a3, voffA);
            PG8_WAIT_V(8); PG8_WAIT_L(0); PG8_BAR; PG8_MMA(1, 0, At, B0); PG8_MMA(1, 1, At, B1); PG8_BAR; PG8_SCHED;
            } else {
            PG8_LDB(B0, 0, 0); PG8_SCHED; PG8_LDA(At, 0, 0); PG8_STAGE(PG8_SA(1, 1), a1 + hstep, voffA);
            PG8_WAIT_L(8); PG8_BAR; PG8_WAIT_L(0); PG8_MMA(0, 0, At, B0); PG8_BAR; PG8_SCHED;
            PG8_LDB(B1, 0, 1); PG8_STAGE(PG8_SB(0, 0), b2, voffB);
            PG8_BAR; PG8_WAIT_L(0); PG8_MMA(0, 1, At, B1); PG8_BAR;
            PG8_LDA(At, 0, 1); PG8_STAGE(PG8_SA(0, 0), a2, voffA);
            PG8_BAR; PG8_WAIT_L(0); PG8_MMA(1, 0, At, B0); PG8_BAR; PG8_SCHED;
            PG8_STAGE(PG8_SB(0, 1), b2 + hstep, voffB);
            PG8_WAIT_V(6); PG8_BAR; PG8_MMA(1, 1, At, B1); PG8_BAR;
            PG8_LDB(B0, 1, 0); PG8_SCHED; PG8_LDA(At, 1, 0); PG8_STAGE(PG8_SA(0, 1), a2 + hstep, voffA);
            PG8_WAIT_L(8); PG8_BAR; PG8_WAIT_L(0); PG8_MMA(0, 0, At, B0); PG8_BAR; PG8_SCHED;
            PG8_LDB(B1, 1, 1); PG8_STAGE(PG8_SB(1, 0), b3, voffB);
            PG8_BAR; PG8_WAIT_L(0); PG8_MMA(0, 1, At, B1); PG8_BAR;
            PG8_LDA(At, 1, 1); PG8_STAGE(PG8_SA(1, 0), a3, voffA);
            PG8_BAR; PG8_WAIT_L(0); PG8_MMA(1, 0, At, B0); PG8_BAR; PG8_SCHED;
            PG8_STAGE(PG8_SB(1, 1), b3 + hstep, voffB);
            PG8_WAIT_V(6); PG8_BAR; PG8_MMA(1, 1, At, B1); PG8_BAR;
            }
        }
        if constexpr (ALIGN_EPI) { if (wr == 0) PG8_BAR; }
        if constexpr (!Epi::AFTER_DRAIN) { int tz = lane_id(); asm volatile("" : "+v"(tz));
            E(acc, cur, wr, wc, tz & 15, (tz & 63) >> 4); S.done(cur); }
        if (!has_next) break;
        PG8_ACC_INIT(nxt);
        cur = nxt; cA = nA; cB = nB; ++ui;
        if constexpr (ALIGN_EPI) { if (wr == 1) PG8_BAR; }
    }
    PG8_WAIT_V(0);
    if constexpr (!ALIGN_EPI) { if (wr == 0) PG8_BAR; }
    PG8_BAR;
    if constexpr (Epi::AFTER_DRAIN) { E.fused(acc, cur, wr, wc, fr, fq, lds, wid, lane); S.done(cur); }
#undef PG8_SA
#undef PG8_SB
#undef PG8_ACC_INIT
#undef PG8_STAGE
#undef PG8_LDA
#undef PG8_LDB
#undef PG8_MMA
#undef PG8_WAIT_V
#undef PG8_WAIT_L
#undef PG8_BAR
#undef PG8_SCHED
}
}

template <int MODE>
__device__ __forceinline__ void transpose_item(const float* W, int K, int N, bf16_t* WT, LAS float* scr, int item, int lane) {
    const int nblk = N / 32, kb = item / nblk, nb = item % nblk, k0 = 64 * kb, n0 = 32 * nb;
    int dr = n0;
    if (MODE == 1) { const int j = n0 & 1023, half = n0 >> 10; dr = 256 * (j >> 7) + 128 * half + (j & 127); }
    if (MODE == 2) { const int part = n0 >> 10, c = n0 & 1023, head = c >> 6, half = (c >> 5) & 1; dr = part * 1024 + (head >> 2) * 256 + half * 128 + (head & 3) * 32; }
#pragma unroll 8
    for (int i = 0; i < 32; ++i) { const int kk = 2 * i + (lane >> 5); scr[kk * 33 + (lane & 31)] = W[(size_t)(k0 + kk) * N + n0 + (lane & 31)]; }
    WAVE_SYNC();
    const int c = lane & 7;
#pragma unroll
    for (int j = 0; j < 4; ++j) { const int n = (lane >> 3) + 8 * j; const LAS float* s = scr + (8 * c) * 33 + n;
        u32x4 o; o.x = pk2(s[0 * 33], s[1 * 33]); o.y = pk2(s[2 * 33], s[3 * 33]); o.z = pk2(s[4 * 33], s[5 * 33]); o.w = pk2(s[6 * 33], s[7 * 33]);
        *(u32x4*)(WT + (size_t)(dr + n) * K + k0 + 8 * c) = o; }
    WAVE_SYNC();
}

template <int MODE>
__device__ __forceinline__ void transpose_item_fp8(const float* W, int K, int N, unsigned char* WT, LAS float* scr, int item, int lane, float scale) {
    const int nblk = N / 32, kb = item / nblk, nb = item % nblk, k0 = 64 * kb, n0 = 32 * nb;
    int dr = n0;
    if (MODE == 1) { const int j = n0 & 1023, half = n0 >> 10; dr = 256 * (j >> 7) + 128 * half + (j & 127); }
#pragma unroll 8
    for (int i = 0; i < 32; ++i) { const int kk = 2 * i + (lane >> 5); scr[kk * 33 + (lane & 31)] = W[(size_t)(k0 + kk) * N + n0 + (lane & 31)] * scale; }
    WAVE_SYNC();
#pragma unroll
    for (int j = 0; j < 2; ++j) { const int n = lane & 31, c = (lane >> 5) + 2 * j; const LAS float* s = scr + (16 * c) * 33 + n;
        u32x4 o; o.x = pk4_fp8(s[0 * 33], s[1 * 33], s[2 * 33], s[3 * 33]); o.y = pk4_fp8(s[4 * 33], s[5 * 33], s[6 * 33], s[7 * 33]);
        o.z = pk4_fp8(s[8 * 33], s[9 * 33], s[10 * 33], s[11 * 33]); o.w = pk4_fp8(s[12 * 33], s[13 * 33], s[14 * 33], s[15 * 33]);
        *(u32x4*)(WT + (size_t)(dr + n) * K + k0 + 16 * c) = o; }
    WAVE_SYNC();
}

__device__ __forceinline__ const float* ld_ptr(volatile LAS unsigned long long* t, int k) {
    const unsigned long long v = t[k]; const unsigned lo = __builtin_amdgcn_readfirstlane((unsigned)v), hi = __builtin_amdgcn_readfirstlane((unsigned)(v >> 32));
    return (const float*)(const GAS float*)(((unsigned long long)hi << 32) | lo);
}
__device__ __forceinline__ void phase_prologue(const Ctx& X, volatile LAS unsigned long long* ptab) {
#define in_(k) ld_ptr(ptab, k)
    const float* a_re = in_(3); const float* a_im = in_(4); const float* log_dt = in_(5); const float* b_re = in_(6); const float* b_im = in_(7);
    float2* Abar = (float2*)(X.ws + WS_S5A); float2* Bbar = (float2*)(X.ws + WS_S5B); float2* rope = (float2*)(X.ws + WS_ROPE);
    const int gt = X.bid * NTHR + X.tid, NT = X.G * NTHR;
    for (int it = gt; it < 2 * SSM_G * SSM_P; it += NT) {
        const int ig = it >> 6;
        const double lam_re = fmin((double)a_re[it], -1e-4), lam_im = (double)a_im[it];
        const double dt = exp((double)log_dt[ig]);
        const double mag = exp(lam_re * dt), ang = lam_im * dt;
        const double abr = mag * cos(ang), abi = mag * sin(ang);
        const double nr = abr - 1.0, ni = abi, den = lam_re * lam_re + lam_im * lam_im;
        const double cr = (nr * lam_re + ni * lam_im) / den, ci = (ni * lam_re - nr * lam_im) / den;
        Abar[it] = make_float2((float)abr, (float)abi);
        for (int h = 0; h < SSM_H; ++h) {
            const double br = (double)b_re[it * 16 + h], bi = (double)b_im[it * 16 + h];
            Bbar[it * 16 + h] = make_float2((float)(cr * br - ci * bi), (float)(cr * bi + ci * br));
        }
    }
    for (int it = gt; it < SEQ * 32; it += NT) {
        const int pos = it >> 5, i = it & 31;
        const float inv = powf(10000.0f, -(float)i / 32.0f);
        const float ang = (float)pos * inv;
        rope[it] = make_float2((float)cos((double)ang), (float)sin((double)ang));
    }
    { const float* rw = in_(20); bf16_t* RWh = (bf16_t*)(X.ws + WS_RWH); bf16_t* RWl = (bf16_t*)(X.ws + WS_RWL);
      for (int it = gt; it < DEPTH * NE * D; it += NT) { const int k = it & 1023, e = (it >> 10) & 31, l = it >> 15;
          const float w = rw[((size_t)l * D + k) * NE + e]; const unsigned hb = f2bf(w); RWh[it] = (bf16_t)hb; RWl[it] = (bf16_t)f2bf(w - bf2f((bf16_t)hb)); } }
    { const float* x = in_(0); bf16_t* H0 = (bf16_t*)(X.ws + WS_H0);
      const size_t n8 = (size_t)T * D / 8;
      for (size_t i8 = (size_t)gt; i8 < n8; i8 += (size_t)NT) {
          const f32x4 a = *(const f32x4*)(x + i8 * 8), b = *(const f32x4*)(x + i8 * 8 + 4);
          u32x4 o; o.x = pk2(a[0], a[1]); o.y = pk2(a[2], a[3]); o.z = pk2(b[0], b[1]); o.w = pk2(b[2], b[3]);
          *(u32x4*)(H0 + i8 * 8) = o; } }
    LAS float* scr = (LAS float*)(X.lds + X.wave * 16384);
    const int gw = X.bid * NWAVES + X.wave, NGW = X.G * NWAVES;
    constexpr int I_GU = 16 * 64, I_DN = 16 * 32, I_IN = 16 * 64, I_GLU = 8 * 16, I_OUT = 16 * 32, I_QKV = 16 * 96, I_O = 16 * 32;
    constexpr int N_GU = 128 * I_GU, N_DN = 128 * I_DN, N_IN = 2 * I_IN, N_GLU = 2 * I_GLU, N_OUT = 2 * I_OUT, N_QKV = 2 * I_QKV, N_O = 2 * I_O;
    constexpr int NITEMS = N_GU + N_DN + N_IN + N_GLU + N_OUT + N_QKV + N_O;
    for (int it = gw; it < NITEMS; it += NGW) {
        int r = it;
        if (r < N_GU) { const int m = r / I_GU; transpose_item_fp8<1>(in_(22) + (size_t)m * D * 2048, D, 2048, (unsigned char*)(X.ws + WS_WGU + (size_t)m * 2048 * D), scr, r % I_GU, X.lane, (float)(1 << W8_SHIFT_GU)); continue; } r -= N_GU;
        if (r < N_DN) { const int m = r / I_DN; transpose_item_fp8<0>(in_(24) + (size_t)m * D * D, D, D, (unsigned char*)(X.ws + WS_WDN + (size_t)m * D * D), scr, r % I_DN, X.lane, (float)(1 << W8_SHIFT_DN)); continue; } r -= N_DN;
        if (r < N_IN) { const int m = r / I_IN; transpose_item<0>(in_(1) + (size_t)m * D * 2048, D, 2048, (bf16_t*)(X.ws + WS_WIN) + (size_t)m * 2048 * D, scr, r % I_IN, X.lane); continue; } r -= N_IN;
        if (r < N_GLU) { const int m = r / I_GLU; transpose_item<0>(in_(11) + (size_t)m * 512 * 512, 512, 512, (bf16_t*)(X.ws + WS_WGLU) + (size_t)m * 512 * 512, scr, r % I_GLU, X.lane); continue; } r -= N_GLU;
        if (r < N_OUT) { const int m = r / I_OUT; transpose_item<0>(in_(13) + (size_t)m * D * D, D, D, (bf16_t*)(X.ws + WS_WOUT) + (size_t)m * D * D, scr, r % I_OUT, X.lane); continue; } r -= N_OUT;
        if (r < N_QKV) { const int m = r / I_QKV; transpose_item<2>(in_(14) + (size_t)m * D * 3072, D, 3072, (bf16_t*)(X.ws + WS_WQKV) + (size_t)m * 3072 * D, scr, r % I_QKV, X.lane); continue; } r -= N_QKV;
        { const int m = r / I_O; transpose_item<0>(in_(15) + (size_t)m * D * D, D, D, (bf16_t*)(X.ws + WS_WO) + (size_t)m * D * D, scr, r % I_O, X.lane); }
    }
}

#undef in_
typedef float f32x4v __attribute__((ext_vector_type(4)));
template <int PASS>
__device__ __forceinline__ void phase_s5(const Ctx& X, int i, const bf16_t* proj, const float* conv_w, const float* c_re, const float* c_im, const float* d_skip, bf16_t* mix, bf16_t* Z) {
    using pg8::bf16x8;
    if (PASS == 2) {
        const float* w = conv_w + (size_t)i * 3 * CONV_CH;
        const size_t n = (size_t)T * (CONV_CH / 8);
        for (size_t idx = (size_t)X.bid * NTHR + X.tid; idx < n; idx += (size_t)X.G * NTHR) {
            const int bt = (int)(idx >> 6), c = (int)(idx & 63) * 8, pos = seqpos(bt);
            const bf16_t* pr = proj + (size_t)bt * 2048;
            float gb[8], a2[8], b2[8], a1[8], b1[8], a0[8], b0[8];
            unpack8(*(const u32x4*)(pr + c), gb); unpack8(*(const u32x4*)(pr + 512 + c), a2); unpack8(*(const u32x4*)(pr + 1024 + c), b2);
            if (pos >= 1) { unpack8(*(const u32x4*)(pr + 512 + c - 2048), a1); unpack8(*(const u32x4*)(pr + 1024 + c - 2048), b1); }
            if (pos >= 2) { unpack8(*(const u32x4*)(pr + 512 + c - 4096), a0); unpack8(*(const u32x4*)(pr + 1024 + c - 4096), b0); }
            float o[8];
#pragma unroll
            for (int j = 0; j < 8; ++j) {
                float s = w[2 * CONV_CH + c + j] * (a2[j] * b2[j]);
                if (pos >= 1) s += w[1 * CONV_CH + c + j] * (a1[j] * b1[j]);
                if (pos >= 2) s += w[0 * CONV_CH + c + j] * (a0[j] * b0[j]);
                o[j] = gb[j] * s; }
            *(u32x4*)(mix + (size_t)bt * D + c) = pack8(o);
        }
    }
    const int lane = X.lane, n16 = lane & 15, kq = lane >> 4;
    LAS float* BuT = (LAS float*)(X.lds + X.wave * 15360);
    LAS unsigned char* xsb = X.lds + X.wave * 15360 + 10240;
    const float2* Abar = (const float2*)(X.ws + WS_S5A); const float2* Bbar = (const float2*)(X.ws + WS_S5B);
    float2* Sst = (float2*)(X.ws + WS_S5S);
    const int gw = X.bid * NWAVES + X.wave, NGW = X.G * NWAVES;
    const int g = gw & 31, ig = i * 32 + g;
        const float2 A = Abar[ig * 64 + lane];
    bf16x8 bfr[8];
#pragma unroll
    for (int cb = 0; cb < 8; ++cb) {
        u32x4 w = (u32x4){0u, 0u, 0u, 0u};
        if (kq < 2) { const float2* bp = Bbar + ((size_t)(ig * 64 + 16 * (cb & 3) + n16)) * 16 + 8 * kq; float v[8];
#pragma unroll
            for (int j = 0; j < 8; ++j) { const float2 t2 = bp[j]; v[j] = cb < 4 ? t2.x : t2.y; }
            w = pack8(v); }
        bfr[cb] = __builtin_bit_cast(bf16x8, w);
    }
    bf16x8 cfr[4]; bf16x8 dfr;
    if (PASS == 2) {
#pragma unroll
        for (int ks = 0; ks < 4; ++ks) { const int p0 = 16 * ks + 4 * kq; const f32x4 cr = *(const f32x4*)(c_re + (size_t)(ig * 16 + n16) * 64 + p0), ci = *(const f32x4*)(c_im + (size_t)(ig * 16 + n16) * 64 + p0);
            u32x4 w; w.x = cvt_pk_bf16(cr[0], -ci[0]); w.y = cvt_pk_bf16(cr[1], -ci[1]); w.z = cvt_pk_bf16(cr[2], -ci[2]); w.w = cvt_pk_bf16(cr[3], -ci[3]); cfr[ks] = __builtin_bit_cast(bf16x8, w); }
        { const float dv = d_skip[ig * 16 + n16]; float v[8];
#pragma unroll
          for (int j = 0; j < 8; ++j) v[j] = (kq < 2 && 8 * kq + j == n16) ? dv : 0.f;
          dfr = __builtin_bit_cast(bf16x8, pack8(v)); }
    }
    for (int task = gw; task < BATCH * 64 * SSM_G; task += NGW) {
        const int c = (task >> 5) & 63, b = task >> 11;
        float xr = 0.f, xi = 0.f;
        if (PASS == 2) { const float2 xin = ((const float2*)(X.ws + WS_S5X))[((size_t)(b * 32 + g) * 64 + c) * 64 + lane]; xr = xin.x; xi = xin.y; }
        const bf16_t* ub = proj + ((size_t)b * SEQ + (size_t)c * 128) * 2048 + 1536 + g * 16;
        bf16_t* zb = Z + ((size_t)b * SEQ + (size_t)c * 128) * SSM_W + g * 16;
        u32x4 uw = (u32x4){0u, 0u, 0u, 0u};
        if (kq < 2) uw = *(const u32x4*)(ub + (size_t)n16 * 2048 + 8 * kq);
#pragma nounroll
        for (int blk = 0; blk < 8; ++blk) {
            const bf16x8 ufr = __builtin_bit_cast(bf16x8, uw);
            u32x4 un = (u32x4){0u, 0u, 0u, 0u};
            if (kq < 2 && blk < 7) un = *(const u32x4*)(ub + (size_t)((blk + 1) * 16 + n16) * 2048 + 8 * kq);
#pragma unroll
            for (int cb = 0; cb < 8; ++cb) {
                f32x4v acc = (f32x4v){0.f, 0.f, 0.f, 0.f};
                acc = __builtin_amdgcn_mfma_f32_16x16x32_bf16(ufr, bfr[cb], acc, 0, 0, 0);
                *(LAS f32x4v*)(BuT + (16 * cb + n16) * 20 + 4 * kq) = acc;
            }
            WAVE_SYNC();
#pragma unroll
            for (int k4 = 0; k4 < 4; ++k4) {
                const f32x4v br = *(const LAS f32x4v*)(BuT + lane * 20 + 4 * k4), bi = *(const LAS f32x4v*)(BuT + (64 + lane) * 20 + 4 * k4);
#pragma unroll
                for (int s = 0; s < 4; ++s) {
                    float nr = fmaf(-A.y, xi, fmaf(A.x, xr, br[s])); asm volatile("" : "+v"(nr));
                    float ni = fmaf(A.y, xr, fmaf(A.x, xi, bi[s])); asm volatile("" : "+v"(ni));
                    xr = nr; xi = ni;
                    if (PASS == 2) *(LAS unsigned*)(xsb + (4 * k4 + s) * 272 + lane * 4) = cvt_pk_bf16(xr, xi);
                }
            }
            if (PASS == 2) {
                WAVE_SYNC();
                f32x4v y = (f32x4v){0.f, 0.f, 0.f, 0.f};
                bf16x8 xa[4];
#pragma unroll
                for (int ks = 0; ks < 4; ++ks) xa[ks] = *(const LAS bf16x8*)(xsb + n16 * 272 + ks * 64 + kq * 16);
                WAVE_SYNC(); __builtin_amdgcn_sched_barrier(0);
#pragma unroll
                for (int ks = 0; ks < 4; ++ks) y = __builtin_amdgcn_mfma_f32_16x16x32_bf16(xa[ks], cfr[ks], y, 0, 0, 0);
                y = __builtin_amdgcn_mfma_f32_16x16x32_bf16(ufr, dfr, y, 0, 0, 0);
                asm volatile("" :: "v"(xa[0]), "v"(xa[1]), "v"(xa[2]), "v"(xa[3]), "v"(ufr));
#pragma unroll
                for (int q = 0; q < 4; ++q) zb[(size_t)(blk * 16 + 4 * kq + q) * SSM_W + n16] = (bf16_t)f2bf(gelu_tanh(y[q]));
            }
            WAVE_SYNC();
            uw = un;
        }
        if (PASS == 1) Sst[((size_t)(b * 32 + g) * 64 + c) * 64 + lane] = make_float2(xr, xi);
    }
}

__device__ __forceinline__ void phase_s5_carry(const Ctx& X, int i) {
    const float2* Abar = (const float2*)(X.ws + WS_S5A); const float2* Sst = (const float2*)(X.ws + WS_S5S); float2* Xin = (float2*)(X.ws + WS_S5X);
    const int gw = X.bid * NWAVES + X.wave, NGW = X.G * NWAVES, lane = X.lane;
    for (int bg = gw; bg < BATCH * SSM_G; bg += NGW) {
        const float2 A = Abar[(i * 32 + (bg & 31)) * 64 + lane];
        float pr_ = A.x, pi_ = A.y;
#pragma unroll
        for (int q = 0; q < 7; ++q) { const float nr = pr_ * pr_ - pi_ * pi_, ni = 2.f * pr_ * pi_; pr_ = nr; pi_ = ni; }
        float xr = 0.f, xi = 0.f;
        const size_t base = (size_t)bg * 64 * 64 + lane;
#pragma unroll 8
        for (int c = 0; c < 64; ++c) {
            Xin[base + (size_t)c * 64] = make_float2(xr, xi);
            const float2 s = Sst[base + (size_t)c * 64];
            const float nr = pr_ * xr - pi_ * xi + s.x, ni = pr_ * xi + pi_ * xr + s.y; xr = nr; xi = ni;
        }
    }
}

typedef short v4i16_t __attribute__((ext_vector_type(4)));
typedef float f32x16 __attribute__((ext_vector_type(16)));
__device__ __forceinline__ v4i16_t vtr16(const LAS unsigned char* p) { return __builtin_amdgcn_ds_read_tr16_b64_v4i16((LAS v4i16_t*)p); }
template <int PASS>
__device__ __forceinline__ void phase_attn(const Ctx& X, const bf16_t* proj, bf16_t* att, bf16_t* ost, float2* ml) {
    using pg8::bf16x8;
    const int lane = X.lane, i32 = lane & 31, hi = lane >> 5;
    LAS unsigned char* vbuf = X.lds + X.wave * 8192;
    const int gw = X.bid * NWAVES + X.wave, NGW = X.G * NWAVES;
    const float NEG = opaque_f(-3.0e38f); const int seqmax = opaque_i(SEQ - 1);
    const int vrd = ((lane >> 4) & 1) * 32 + (lane & 3) * 8 + (4 * hi + ((lane & 15) >> 2)) * 64;
    const bool xdeal = (X.G == 256);
    for (int it = 0; it < (xdeal ? 8 : (BATCH * NH * 256 + NGW - 1) / NGW); ++it) {
        const int task = xdeal ? (((it * 8 + (X.bid & 7)) << 8) | ((X.bid >> 3) * 8 + X.wave)) : (gw + it * NGW);
        if (task >= BATCH * NH * 256) break;
        const int QST = PASS == 0 ? 4 : 16;
        const int r = PASS == 0 ? (task & 3) : (task & 15), blk = PASS == 0 ? ((task >> 2) & 63) : ((task >> 4) & 15), hh = (task >> 8) & 15, b = task >> 12;
        const bf16_t* base = proj + (size_t)b * SEQ * 3072 + hh * 64;
        const int t0 = (PASS == 0 ? 128 : 512) * blk + r;
        bf16x8 qf[4];
        { const bf16_t* qp = base + (size_t)(t0 + QST * i32) * 3072 + 8 * hi;
#pragma unroll
          for (int d0 = 0; d0 < 4; ++d0) qf[d0] = *(const bf16x8*)(qp + 16 * d0); }
        float m_run = NEG, l_run = 0.f;
        f32x16 o0, o1;
#pragma unroll
        for (int q = 0; q < 16; ++q) { o0[q] = 0.f; o1[q] = 0.f; }
        const size_t srow = (size_t)(b * SEQ + t0 + QST * i32);
        if (PASS == 1) {
            const float2 mlv = ml[srow * NH + hh]; m_run = mlv.x; l_run = hi == 0 ? mlv.y : 0.f;
            const bf16_t* sp = ost + srow * D + hh * 64 + 4 * hi;
#pragma unroll
            for (int gq = 0; gq < 4; ++gq) { const u32x2 w0 = *(const u32x2*)(sp + 8 * gq), w1 = *(const u32x2*)(sp + 32 + 8 * gq);
                o0[4 * gq] = bf_lo(w0.x); o0[4 * gq + 1] = bf_hi(w0.x); o0[4 * gq + 2] = bf_lo(w0.y); o0[4 * gq + 3] = bf_hi(w0.y);
                o1[4 * gq] = bf_lo(w1.x); o1[4 * gq + 1] = bf_hi(w1.x); o1[4 * gq + 2] = bf_lo(w1.y); o1[4 * gq + 3] = bf_hi(w1.y); }
        }
        for (int pat = 0; pat < (PASS == 0 ? 2 : 1); ++pat) {
            const int dil = PASS == 1 ? 16 : (pat == 0 ? 4 : 1), qs = PASS == 1 ? 1 : (pat == 0 ? 1 : 4), ntl = PASS == 1 ? 5 : (pat == 0 ? 5 : 8);
            const int rr = PASS == 1 ? r : (pat == 0 ? r : 0);
            const int M0 = (t0 - rr) / dil, Mstart = M0 - 128;
            const int qi = qs * i32;
            bf16x8 kf[4];
            auto keypos = [&](int M) { int p = dil * M + rr; p = p < 0 ? 0 : p; p = p > seqmax ? seqmax : p; return p; };
            auto issue = [&](int kt, bf16x8 (&kk)[4], int bufsel) {
                const bf16_t* kp = base + (size_t)keypos(Mstart + 32 * kt + i32) * 3072 + 1024 + 8 * hi;
#pragma unroll
                for (int d0 = 0; d0 < 4; ++d0) kk[d0] = *(const bf16x8*)(kp + 16 * d0);
#pragma unroll
                for (int kg = 0; kg < 2; ++kg) {
                    const bf16_t* vp = base + (size_t)keypos(Mstart + 32 * kt + 16 * kg + (lane >> 2)) * 3072 + 2048 + (lane & 3) * 8;
#pragma unroll
                    for (int dh = 0; dh < 2; ++dh)
                        __builtin_amdgcn_global_load_lds((const unsigned*)(vp + 32 * dh), (LAS unsigned*)(vbuf + bufsel * 4096 + (dh * 2 + kg) * 1024), 16, 0, 0);
                }
            };
            asm volatile("s_waitcnt lgkmcnt(0)" ::: "memory");
            issue(0, kf, 0);
            for (int kt = 0; kt < ntl; ++kt) {
                asm volatile("s_waitcnt vmcnt(0) lgkmcnt(0)" ::: "memory");
                bf16x8 kn[4];
                const int ktn = kt + 1 < ntl ? kt + 1 : kt;
                issue(ktn, kn, (kt + 1) & 1);
                f32x16 s;
#pragma unroll
                for (int q = 0; q < 16; ++q) s[q] = 0.f;
#pragma unroll
                for (int d0 = 0; d0 < 4; ++d0) s = __builtin_amdgcn_mfma_f32_32x32x16_bf16(kf[d0], qf[d0], s, 0, 0, 0);
                const int hi_ = qi + 128 - 32 * kt; int lo = hi_ - 128; { const int nk = -(Mstart + 32 * kt); lo = lo > nk ? lo : nk; }
                const int rb = 4 * hi - lo; const unsigned span = (unsigned)(hi_ - lo);
                const bool any = hi_ >= lo;
                float tmax = NEG;
#pragma unroll
                for (int q = 0; q < 16; ++q) { const int rowc = (q & 3) + 8 * (q >> 2); const bool ok = any && ((unsigned)(rowc + rb) <= span) && (rowc + rb >= 0); s[q] = ok ? s[q] : NEG; tmax = fmaxf(tmax, s[q]); }
                tmax = fmaxf(tmax, __shfl_xor(tmax, 32));
                const float m_new = fmaxf(m_run, tmax), sc = __builtin_amdgcn_exp2f(m_run - m_new);
                m_run = m_new;
                float ps = 0.f;
#pragma unroll
                for (int q = 0; q < 16; ++q) { s[q] = __builtin_amdgcn_exp2f(s[q] - m_new); ps += s[q]; }
                l_run = l_run * sc + ps;
#pragma unroll
                for (int q = 0; q < 16; ++q) { o0[q] *= sc; o1[q] *= sc; }
                u32x4 pw0, pw1;
                pw0.x = cvt_pk_bf16(s[0], s[1]); pw0.y = cvt_pk_bf16(s[2], s[3]); pw0.z = cvt_pk_bf16(s[4], s[5]); pw0.w = cvt_pk_bf16(s[6], s[7]);
                pw1.x = cvt_pk_bf16(s[8], s[9]); pw1.y = cvt_pk_bf16(s[10], s[11]); pw1.z = cvt_pk_bf16(s[12], s[13]); pw1.w = cvt_pk_bf16(s[14], s[15]);
                const bf16x8 pf0 = __builtin_bit_cast(bf16x8, pw0), pf1 = __builtin_bit_cast(bf16x8, pw1);
                const LAS unsigned char* vb = vbuf + (kt & 1) * 4096 + vrd;
#pragma unroll
                for (int dh = 0; dh < 2; ++dh) {
#pragma unroll
                    for (int kg = 0; kg < 2; ++kg) {
                        const v4i16_t vlo = vtr16(vb + (dh * 2 + kg) * 1024), vhi = vtr16(vb + (dh * 2 + kg) * 1024 + 512);
                        const bf16x8 vf = (bf16x8){vlo[0], vlo[1], vlo[2], vlo[3], vhi[0], vhi[1], vhi[2], vhi[3]};
                        if (dh == 0) o0 = __builtin_amdgcn_mfma_f32_32x32x16_bf16(vf, kg == 0 ? pf0 : pf1, o0, 0, 0, 0);
                        else o1 = __builtin_amdgcn_mfma_f32_32x32x16_bf16(vf, kg == 0 ? pf0 : pf1, o1, 0, 0, 0);
                    }
                }
#pragma unroll
                for (int d0 = 0; d0 < 4; ++d0) kf[d0] = kn[d0];
            }
            asm volatile("s_waitcnt vmcnt(0) lgkmcnt(0)" ::: "memory");
        }
        const float lt = l_run + __shfl_xor(l_run, 32), rl = PASS == 1 ? 1.0f / lt : 1.0f;
        if (PASS == 0 && hi == 0) ml[srow * NH + hh] = make_float2(m_run, lt);
        bf16_t* op = (PASS == 1 ? att : ost) + srow * D + hh * 64 + 4 * hi;
#pragma unroll
        for (int gq = 0; gq < 4; ++gq) {
            u32x2 w0, w1;
            w0.x = cvt_pk_bf16(o0[4 * gq] * rl, o0[4 * gq + 1] * rl); w0.y = cvt_pk_bf16(o0[4 * gq + 2] * rl, o0[4 * gq + 3] * rl);
            w1.x = cvt_pk_bf16(o1[4 * gq] * rl, o1[4 * gq + 1] * rl); w1.y = cvt_pk_bf16(o1[4 * gq + 2] * rl, o1[4 * gq + 3] * rl);
            *(u32x2*)(op + 8 * gq) = w0; *(u32x2*)(op + 32 + 8 * gq) = w1;
        }
    }
}

__device__ __forceinline__ void phase_ln_router(const Ctx& X, int layer, const bf16_t* hin, const bf16_t* mixo, const float* g, const float* bta, const float* rb, bf16_t* h1) {
    using pg8::bf16x8;
    LAS unsigned char* Ah = X.lds;
    LAS unsigned char* Al = X.lds + 65536;
    LAS float* P = (LAS float*)X.lds;
    LAS int* s_cnt = (LAS int*)(X.lds + TAB_OFF);
    LAS int* s_gb = s_cnt + 32;
    const int lane = X.lane, w = X.wave, tok = lane & 31, hi = lane >> 5;
    int* tok_e = (int*)(X.ws + WS_TOKE); int* tok_r = (int*)(X.ws + WS_TOKR); float* glist = (float*)(X.ws + WS_GLIST); unsigned char* XG8 = (unsigned char*)(X.ws + WS_XG);
    unsigned* cnt = X.ctl + CW_CNT + layer * 32 * 64;
    bf16x8 wfh[8], wfl[8];
    { const bf16_t* rwh = (const bf16_t*)(X.ws + WS_RWH) + ((size_t)layer * NE + tok) * D + 128 * w + 8 * hi; const bf16_t* rwl = (const bf16_t*)(X.ws + WS_RWL) + ((size_t)layer * NE + tok) * D + 128 * w + 8 * hi;
#pragma unroll
      for (int i = 0; i < 8; ++i) { wfh[i] = *(const bf16x8*)(rwh + 16 * i); wfl[i] = *(const bf16x8*)(rwl + 16 * i); } }
    const float rbe = rb[tok]; const float ninf = opaque_f(-INFINITY);
    for (int tb = X.bid * 128; tb < T; tb += X.G * 128) {
        for (int rnd = 0; rnd < 4; ++rnd) {
            __syncthreads();
            if (X.tid < 32) s_cnt[X.tid] = 0;
            const int t0 = tb + rnd * 32 + w * 4;
            float v[4][16];
            float gg[16], bb[16];
            { const float* g2 = g; const float* b2 = bta; asm volatile("" : "+s"(g2), "+s"(b2));
#pragma unroll
              for (int j = 0; j < 2; ++j) {
                const f32x4 g0 = *(const f32x4*)(g2 + j * 512 + lane * 8), g1 = *(const f32x4*)(g2 + j * 512 + lane * 8 + 4), b0 = *(const f32x4*)(b2 + j * 512 + lane * 8), b1 = *(const f32x4*)(b2 + j * 512 + lane * 8 + 4);
#pragma unroll
                for (int q = 0; q < 4; ++q) { gg[j * 8 + q] = g0[q]; gg[j * 8 + 4 + q] = g1[q]; bb[j * 8 + q] = b0[q]; bb[j * 8 + 4 + q] = b1[q]; } } }
#pragma unroll
            for (int tl = 0; tl < 4; ++tl) {
                const size_t rowo = (size_t)(t0 + tl) * D;
                float s = 0.f;
#pragma unroll
                for (int j = 0; j < 2; ++j) { float a[8], m[8]; unpack8(*(const u32x4*)(hin + rowo + j * 512 + lane * 8), a); unpack8(*(const u32x4*)(mixo + rowo + j * 512 + lane * 8), m);
#pragma unroll
                    for (int q = 0; q < 8; ++q) { v[tl][j * 8 + q] = DN_ALPHA * a[q] + m[q]; s += v[tl][j * 8 + q]; } }
                const float mean = wave_sum(s) * (1.f / D); float s2 = 0.f;
#pragma unroll
                for (int q = 0; q < 16; ++q) { v[tl][q] -= mean; s2 += v[tl][q] * v[tl][q]; }
                const float rstd = rsqrtf(wave_sum(s2) * (1.f / D) + opaque_f(LN_EPS));
#pragma unroll
                for (int q = 0; q < 16; ++q) v[tl][q] = v[tl][q] * rstd * gg[q] + bb[q];
                const int tr = w * 4 + tl;
#pragma unroll
                for (int j = 0; j < 2; ++j) {
                    u32x4 oh, ol; float lo[8];
                    oh.x = cvt_pk_bf16(v[tl][j * 8 + 0], v[tl][j * 8 + 1]); oh.y = cvt_pk_bf16(v[tl][j * 8 + 2], v[tl][j * 8 + 3]); oh.z = cvt_pk_bf16(v[tl][j * 8 + 4], v[tl][j * 8 + 5]); oh.w = cvt_pk_bf16(v[tl][j * 8 + 6], v[tl][j * 8 + 7]);
                    float hf[8]; unpack8(oh, hf);
#pragma unroll
                    for (int q = 0; q < 8; ++q) lo[q] = v[tl][j * 8 + q] - hf[q];
                    ol = pack8(lo);
                    *(u32x4*)(h1 + rowo + j * 512 + lane * 8) = oh;
                    const int ch = ((lane + 64 * j) ^ (tr & 7)) << 4;
                    *(LAS u32x4*)(Ah + tr * 2048 + ch) = oh; *(LAS u32x4*)(Al + tr * 2048 + ch) = ol;
                }
            }
            __syncthreads();
            f32x16 acc;
#pragma unroll
            for (int q = 0; q < 16; ++q) acc[q] = 0.f;
#pragma unroll
            for (int i = 0; i < 8; ++i) {
                const int ch = ((2 * (8 * w + i) + hi) ^ (tok & 7)) << 4;
                const bf16x8 bh = *(const LAS bf16x8*)(Ah + tok * 2048 + ch), bl = *(const LAS bf16x8*)(Al + tok * 2048 + ch);
                acc = __builtin_amdgcn_mfma_f32_32x32x16_bf16(wfh[i], bh, acc, 0, 0, 0);
                acc = __builtin_amdgcn_mfma_f32_32x32x16_bf16(wfl[i], bh, acc, 0, 0, 0);
                acc = __builtin_amdgcn_mfma_f32_32x32x16_bf16(wfh[i], bl, acc, 0, 0, 0);
            }
            __syncthreads();
#pragma unroll
            for (int q = 0; q < 16; ++q) P[(w * 32 + tok) * 33 + (q & 3) + 8 * (q >> 2) + 4 * hi] = acc[q];
            __syncthreads();
            float lg[4];
#pragma unroll
            for (int tl = 0; tl < 4; ++tl) { float a = 0.f;
#pragma unroll
                for (int ww = 0; ww < 4; ++ww) a += P[((hi * 4 + ww) * 32 + (w * 4 + tl)) * 33 + tok];
                a += __shfl_xor(a, 32); lg[tl] = a + rbe; }
            const int e = tok;
            int my_e = 0; float my_g = 0.f;
#pragma unroll
            for (int tl = 0; tl < 4; ++tl) {
                float cur = lg[tl];
                float sv0 = 0.f, sv1 = 0.f, sv2 = 0.f, sv3 = 0.f; int si0 = 0, si1 = 0, si2 = 0, si3 = 0;
#pragma unroll
                for (int k = 0; k < 4; ++k) {
                    float bv = cur; int bi = e;
#pragma unroll
                    for (int o = 1; o < 32; o <<= 1) { const float ov = __shfl_xor(bv, o); const int oi = __shfl_xor(bi, o); if (ov > bv || (ov == bv && oi < bi)) { bv = ov; bi = oi; } }
                    if (k == 0) { sv0 = bv; si0 = bi; } else if (k == 1) { sv1 = bv; si1 = bi; } else if (k == 2) { sv2 = bv; si2 = bi; } else { sv3 = bv; si3 = bi; }
                    if (e == bi) cur = ninf;
                }
                const float e1 = __expf(sv1 - sv0), e2 = __expf(sv2 - sv0), e3 = __expf(sv3 - sv0), inv = 1.f / (1.f + e1 + e2 + e3);
                if ((lane >> 2) == tl) { const int k = lane & 3; my_e = k == 0 ? si0 : k == 1 ? si1 : k == 2 ? si2 : si3; my_g = (k == 0 ? 1.f : k == 1 ? e1 : k == 2 ? e2 : e3) * inv; }
            }
            int my_lr = 0;
            if (lane < 16) my_lr = __hip_atomic_fetch_add(&s_cnt[my_e], 1, __ATOMIC_RELAXED, __HIP_MEMORY_SCOPE_WORKGROUP);
            __syncthreads();
            if (X.tid < 32) { const int c = s_cnt[X.tid]; s_gb[X.tid] = c ? (int)atomicAdd(cnt + X.tid * 64, (unsigned)c) : 0; }
            __syncthreads();
            int my_r = 0;
            if (lane < 16) { my_r = s_gb[my_e] + my_lr; const int t = t0 + (lane >> 2); tok_e[t * 4 + (lane & 3)] = my_e; tok_r[t * 4 + (lane & 3)] = my_r; glist[(size_t)my_e * T + my_r] = my_g; }
#pragma unroll
            for (int tl = 0; tl < 4; ++tl) {
                u32x2 o0, o1;
                o0.x = pk4_fp8(v[tl][0], v[tl][1], v[tl][2], v[tl][3]); o0.y = pk4_fp8(v[tl][4], v[tl][5], v[tl][6], v[tl][7]);
                o1.x = pk4_fp8(v[tl][8], v[tl][9], v[tl][10], v[tl][11]); o1.y = pk4_fp8(v[tl][12], v[tl][13], v[tl][14], v[tl][15]);
#pragma unroll
                for (int k = 0; k < 4; ++k) { const int ee = __shfl(my_e, tl * 4 + k), rr = __shfl(my_r, tl * 4 + k);
                    unsigned char* dst = XG8 + ((size_t)ee * T + rr) * D + lane * 8;
                    *(u32x2*)(dst) = o0; *(u32x2*)(dst + 512) = o1; }
            }
        }
    }
}

__device__ __forceinline__ void load_tile_table(const Ctx& X, int layer, LAS int* tb) {
    __syncthreads();
    if (X.tid < 64) {
        const int c = X.tid < 32 ? (int)__hip_atomic_load(X.ctl + CW_CNT + (layer * 32 + X.tid) * 64, RLX_AGENT) : 0;
        const int tl = (c + 255) >> 8; int incl = tl;
#pragma unroll
        for (int o = 1; o < 32; o <<= 1) { const int t = __shfl_up(incl, o); if ((X.tid & 31) >= o) incl += t; }
        if (X.tid < 32) { tb[X.tid] = incl - tl; if (X.tid == 31) tb[32] = incl; }
    }
    __syncthreads();
}

template <bool OUT_F32>
__device__ __forceinline__ void phase_combine_ln(const Ctx& X, int layer, const bf16_t* h1, const bf16_t* Y, const float* g, const float* bta, void* outp) {
    const int lane = X.lane;
    const int gw = X.bid * NWAVES + X.wave, NGW = X.G * NWAVES;
    const int* tok_e = (const int*)(X.ws + WS_TOKE); const int* tok_r = (const int*)(X.ws + WS_TOKR);
    int basev = 0;
    { const int c = lane < 32 ? (int)__hip_atomic_load(X.ctl + CW_CNT + (layer * 32 + lane) * 64, RLX_AGENT) : 0; const int pc = ((c + 255) >> 8) << 8; int incl = pc;
#pragma unroll
      for (int o = 1; o < 32; o <<= 1) { const int t = __shfl_up(incl, o); if ((lane & 31) >= o) incl += t; }
      basev = incl - pc; }
    float gg[16], bb[16];
#pragma unroll
    for (int j = 0; j < 2; ++j) {
        const f32x4 g0 = *(const f32x4*)(g + j * 512 + lane * 8), g1 = *(const f32x4*)(g + j * 512 + lane * 8 + 4), b0 = *(const f32x4*)(bta + j * 512 + lane * 8), b1 = *(const f32x4*)(bta + j * 512 + lane * 8 + 4);
#pragma unroll
        for (int q = 0; q < 4; ++q) { gg[j * 8 + q] = g0[q]; gg[j * 8 + 4 + q] = g1[q]; bb[j * 8 + q] = b0[q]; bb[j * 8 + 4 + q] = b1[q]; }
    }
    for (int bt = gw; bt < T; bt += NGW) {
        int myslot = 0;
        if (lane < 4) myslot = tok_r[bt * 4 + lane];
        const int mye = lane < 4 ? tok_e[bt * 4 + lane] : 0;
        myslot += __shfl(basev, mye);
        const int s0 = __shfl(myslot, 0), s1 = __shfl(myslot, 1), s2 = __shfl(myslot, 2), s3 = __shfl(myslot, 3);
        float v[16]; float s = 0.f;
#pragma unroll
        for (int j = 0; j < 2; ++j) {
            const int off = j * 512 + lane * 8;
            float a[8], y0[8], y1[8], y2[8], y3[8];
            unpack8(*(const u32x4*)(h1 + (size_t)bt * D + off), a);
            const unsigned char* Y8 = (const unsigned char*)Y;
            unpack8_fp8(*(const u32x2*)(Y8 + (size_t)s0 * D + off), y0); unpack8_fp8(*(const u32x2*)(Y8 + (size_t)s1 * D + off), y1); unpack8_fp8(*(const u32x2*)(Y8 + (size_t)s2 * D + off), y2); unpack8_fp8(*(const u32x2*)(Y8 + (size_t)s3 * D + off), y3);
#pragma unroll
            for (int q = 0; q < 8; ++q) { v[j * 8 + q] = DN_ALPHA * a[q] + (((y0[q] + y1[q]) + y2[q]) + y3[q]) * (1.0f / Y8_SCALE); s += v[j * 8 + q]; }
        }
        const float mean = wave_sum(s) * (1.f / D); float s2q = 0.f;
#pragma unroll
        for (int q = 0; q < 16; ++q) { v[q] -= mean; s2q += v[q] * v[q]; }
        const float rstd = rsqrtf(wave_sum(s2q) * (1.f / D) + opaque_f(LN_EPS));
#pragma unroll
        for (int q = 0; q < 16; ++q) v[q] = v[q] * rstd * gg[q] + bb[q];
#pragma unroll
        for (int j = 0; j < 2; ++j) {
            const size_t o = (size_t)bt * D + j * 512 + lane * 8;
            if (OUT_F32) { float* op = (float*)outp + o; *(f32x4*)(op) = (f32x4){v[j * 8 + 0], v[j * 8 + 1], v[j * 8 + 2], v[j * 8 + 3]}; *(f32x4*)(op + 4) = (f32x4){v[j * 8 + 4], v[j * 8 + 5], v[j * 8 + 6], v[j * 8 + 7]}; }
            else { u32x4 w; w.x = cvt_pk_bf16(v[j * 8 + 0], v[j * 8 + 1]); w.y = cvt_pk_bf16(v[j * 8 + 2], v[j * 8 + 3]); w.z = cvt_pk_bf16(v[j * 8 + 4], v[j * 8 + 5]); w.w = cvt_pk_bf16(v[j * 8 + 6], v[j * 8 + 7]); *(u32x4*)((bf16_t*)outp + o) = w; }
        }
    }
}


__device__ __forceinline__ Ctx refresh_ctx(const Ctx& X0) {
    Ctx X = X0; int wv = X0.wave; asm volatile("" : "+s"(wv)); int t = wv * 64 + lane_id(); asm volatile("" : "+v"(t)); X.tid = t; X.lane = t & 63; X.wave = wv;
    asm volatile("" : "+s"(X.ws), "+s"(X.ctl), "+s"(X.G), "+s"(X.bid));
    return X;
}
struct Args { const float* in[26]; float* out; unsigned char* ws; int ph_lo, ph_hi; };
constexpr int N_PHASES = 1 + 2 * (6 + 4) + 2 * (4 + 4);
#define GP_ALIGN true
#define GP_SP2 true

__global__ void __launch_bounds__(NTHR, 2) mk_fwd(Args args) {
    extern __shared__ __attribute__((aligned(16))) unsigned char lds_raw[];
    Ctx X0;
    X0.lds = (LAS unsigned char*)lds_raw;
    X0.tid = threadIdx.x; X0.lane = X0.tid & 63; X0.wave = __builtin_amdgcn_readfirstlane(X0.tid >> 6);
    X0.G = gridDim.x; X0.bid = blockIdx.x;
    X0.ws = (GAS unsigned char*)args.ws; X0.ctl = (unsigned*)(args.ws + WS_CTL);
    volatile LAS unsigned* MISC = (volatile LAS unsigned*)(X0.lds + MISC_OFF);
    if (X0.tid < 32) MISC[X0.tid] = 0u;
    __syncthreads();
    XcdBarrier bar; bar.bar = X0.ctl + CW_BAR; bar.x = 0; bar.st = nullptr;
    if (MK_ONE_LAUNCH) bar = xcd_barrier_post(X0.ctl + CW_BAR, MISC + 8);
    volatile LAS unsigned long long* ptab = (volatile LAS unsigned long long*)(X0.lds + TAB_OFF + 1024);
    if (X0.tid < 26) ptab[X0.tid] = (unsigned long long)args.in[X0.tid];
    __syncthreads();
#define INP(k) ld_ptr(ptab, k)
    const int lo = args.ph_lo, hi = args.ph_hi;
    int ph = 0;
#define IN() (lo <= ph && ph < hi)
#define SEAM() do { if (MK_ONE_LAUNCH && lo <= ph && ph + 1 < hi) xcd_barrier(bar); ++ph; } while (0)

#define H0 ((bf16_t*)(X.ws + WS_H0))
#define H1 ((bf16_t*)(X.ws + WS_H1))
#define PROJ ((bf16_t*)(X.ws + WS_PROJ))
#define MIX ((bf16_t*)(X.ws + WS_MIX))
#define MIXO ((bf16_t*)(X.ws + WS_MIXO))
#define Z ((bf16_t*)(X.ws + WS_Z))
#define ACT ((bf16_t*)(X.ws + WS_ACT))
#define Y ((bf16_t*)(X.ws + WS_Y))
#define tb ((LAS int*)(X.lds + TAB_OFF + 512))

#ifndef DUP_MASK
#define DUP_MASK 0
#endif
    enum { P_PRO, P_E1, P_S5A, P_S5C, P_S5B, P_E3, P_E4, P_O1, P_ATT, P_O3, P_LNA, P_M1, P_M2, P_LNB };
#define PHASE_BEGIN(k) _Pragma("nounroll") for (int _r = 0; _r < ((((DUP_MASK) >> (k)) & 1) + 1); ++_r) { if (IN()) { const Ctx X = refresh_ctx(X0);
#define PHASE_END } SEAM(); }
    PHASE_BEGIN(P_PRO)  phase_prologue(X, ptab);  PHASE_END

#pragma nounroll
    for (int layer = 0; layer < DEPTH; ++layer) {
        const int i = layer >> 1;
        if ((layer & 1) == 0) {
            PHASE_BEGIN(P_E1)  pg8::Gemm gm{H0, (const bf16_t*)(X.ws + WS_WIN) + (size_t)i * 2048 * D, T, 2048, D}; pg8::StaticOrder S; S.init(T, 2048, D, X.G, X.bid);
                pg8::EpiStore E{PROJ, 2048};
                pg8::gemm_phase<pg8::EpiStore, pg8::StaticOrder, GP_ALIGN, GP_SP2>(X.lds, gm, S, E, X.wave);  PHASE_END
            PHASE_BEGIN(P_S5A)  phase_s5<1>(X, i, PROJ, INP(2), INP(8), INP(9), INP(10), MIX, Z);  PHASE_END
            PHASE_BEGIN(P_S5C)  phase_s5_carry(X, i);  PHASE_END
            PHASE_BEGIN(P_S5B)  phase_s5<2>(X, i, PROJ, INP(2), INP(8), INP(9), INP(10), MIX, Z);  PHASE_END
            PHASE_BEGIN(P_E3)  pg8::Gemm gm{Z, (const bf16_t*)(X.ws + WS_WGLU) + (size_t)i * 512 * 512, T, 512, 512}; pg8::StaticOrder S; S.init(T, 512, 512, X.G, X.bid);
                pg8::EpiGlu E{Z, MIX, INP(12) + (size_t)i * SSM_W};
                pg8::gemm_phase<pg8::EpiGlu, pg8::StaticOrder, GP_ALIGN, GP_SP2>(X.lds, gm, S, E, X.wave);  PHASE_END
            PHASE_BEGIN(P_E4)  pg8::Gemm gm{MIX, (const bf16_t*)(X.ws + WS_WOUT) + (size_t)i * D * D, T, D, D}; pg8::StaticOrder S; S.init(T, D, D, X.G, X.bid);
                pg8::EpiStore E{MIXO, D};
                pg8::gemm_phase<pg8::EpiStore, pg8::StaticOrder, GP_ALIGN, GP_SP2>(X.lds, gm, S, E, X.wave);  PHASE_END
        } else {
            PHASE_BEGIN(P_O1)  pg8::Gemm gm{H0, (const bf16_t*)(X.ws + WS_WQKV) + (size_t)i * 3072 * D, T, 3072, D}; pg8::StaticOrder S; S.init(T, 3072, D, X.G, X.bid);
                pg8::EpiRope E{PROJ, (const f32x2*)(X.ws + WS_ROPE)};
                pg8::gemm_phase<pg8::EpiRope, pg8::StaticOrder, GP_ALIGN, GP_SP2>(X.lds, gm, S, E, X.wave);  PHASE_END
            PHASE_BEGIN(P_ATT)  phase_attn<0>(X, PROJ, MIX, MIXO, (float2*)(X.ws + WS_S5X));  PHASE_END
            PHASE_BEGIN(P_ATT)  phase_attn<1>(X, PROJ, MIX, MIXO, (float2*)(X.ws + WS_S5X));  PHASE_END
            PHASE_BEGIN(P_O3)  pg8::Gemm gm{MIX, (const bf16_t*)(X.ws + WS_WO) + (size_t)i * D * D, T, D, D}; pg8::StaticOrder S; S.init(T, D, D, X.G, X.bid);
                pg8::EpiStore E{MIXO, D};
                pg8::gemm_phase<pg8::EpiStore, pg8::StaticOrder, GP_ALIGN, GP_SP2>(X.lds, gm, S, E, X.wave);  PHASE_END
        }
        PHASE_BEGIN(P_LNA)  phase_ln_router(X, layer, H0, MIXO, INP(16) + layer * D, INP(17) + layer * D, INP(21) + layer * NE, H1);  PHASE_END
        PHASE_BEGIN(P_M1)  load_tile_table(X, layer, tb);
            pg8::Gemm gm{(const bf16_t*)(X.ws + WS_XG), (const bf16_t*)(X.ws + WS_WGU + (size_t)layer * NE * 2048 * D), 0, 2048, D / 2};
            pg8::MoeOrder<8, true> S; S.init(tb, X.G, X.bid, 2048, D / 2);
            pg8::EpiSwiglu E{ACT, INP(23) + (size_t)layer * NE * 2048};
            pg8::gemm_phase<pg8::EpiSwiglu, pg8::MoeOrder<8, true>, GP_ALIGN, GP_SP2, true>(X.lds, gm, S, E, X.wave, opaque_i(127 - W8_SHIFT_GU), opaque_i(127));  PHASE_END
        PHASE_BEGIN(P_M2)  load_tile_table(X, layer, tb);
            pg8::Gemm gm{ACT, (const bf16_t*)(X.ws + WS_WDN + (size_t)layer * NE * D * D), 0, D, D / 2};
            pg8::MoeOrder<4, false> S; S.init(tb, X.G, X.bid, D, D / 2);
            pg8::EpiDown E{Y, INP(25) + (size_t)layer * NE * D, (const float*)(X.ws + WS_GLIST)};
            pg8::gemm_phase<pg8::EpiDown, pg8::MoeOrder<4, false>, GP_ALIGN, GP_SP2, true>(X.lds, gm, S, E, X.wave, opaque_i(127 - W8_SHIFT_DN), opaque_i(127));  PHASE_END
        PHASE_BEGIN(P_LNB)
            if (layer == DEPTH - 1) phase_combine_ln<true>(X, layer, H1, Y, INP(18) + layer * D, INP(19) + layer * D, (void*)args.out);
            else phase_combine_ln<false>(X, layer, H1, Y, INP(18) + layer * D, INP(19) + layer * D, (void*)H0);
         PHASE_END
    }
#undef IN
#undef SEAM
#undef PHASE_BEGIN
#undef PHASE_END
#undef H0
#undef H1
#undef PROJ
#undef MIX
#undef MIXO
#undef Z
#undef ACT
#undef Y
#undef tb
}

extern "C" void kernel_launch(void* const* d_in, const int* in_sizes, int n_in, void* d_out, int out_size, void* d_ws, size_t ws_size, hipStream_t stream) {
    static int grid = 0;
    if (grid == 0) {
        if (n_in != 26 || out_size != T * D || ws_size < WS_END) { fprintf(stderr, "kernel_launch: unexpected shapes n_in %d out %d ws %zu (need %zu)\n", n_in, out_size, ws_size, (size_t)WS_END); grid = -1; return; }
        int dev = 0, cus = 0, per_cu = 0;
        if (hipGetDevice(&dev) != hipSuccess || hipDeviceGetAttribute(&cus, hipDeviceAttributeMultiprocessorCount, dev) != hipSuccess) { grid = -1; return; }
        if (hipFuncSetAttribute((const void*)mk_fwd, hipFuncAttributeMaxDynamicSharedMemorySize, LDS_BYTES) != hipSuccess) { fprintf(stderr, "kernel_launch: hipFuncSetAttribute failed\n"); grid = -1; return; }
        if (hipOccupancyMaxActiveBlocksPerMultiprocessor(&per_cu, (const void*)mk_fwd, NTHR, LDS_BYTES) != hipSuccess || per_cu < 1) fprintf(stderr, "kernel_launch: occupancy query says %d\n", per_cu);
        (void)hipGetLastError();
        grid = cus;
    }
    if (grid < 0) return;
    if (hipMemsetAsync((char*)d_ws + WS_CTL, 0, CTL_ZERO_BYTES, stream) != hipSuccess) return;
    Args a{};
    for (int i = 0; i < 26; ++i) a.in[i] = (const float*)d_in[i];
    a.out = (float*)d_out; a.ws = (unsigned char*)d_ws;
#if MK_ONE_LAUNCH
    a.ph_lo = 0; a.ph_hi = DUP_MASK ? 100000 : N_PHASES;
    hipLaunchKernelGGL(mk_fwd, dim3(grid), dim3(NTHR), LDS_BYTES, stream, a);
#else
    for (int p = 0; p < N_PHASES; ++p) { a.ph_lo = p; a.ph_hi = p + 1; hipLaunchKernelGGL(mk_fwd, dim3(grid), dim3(NTHR), LDS_BYTES, stream, a); }
#endif
}
```

```cpp
#include <hip/hip_runtime.h>
#include <cstdio>
#include <cstdint>

#ifndef MK_ONE_LAUNCH
#define MK_ONE_LAUNCH 1
#endif

#define GAS __attribute__((address_space(1)))
#define LAS __attribute__((address_space(3)))
#define RLX_AGENT __ATOMIC_RELAXED, __HIP_MEMORY_SCOPE_AGENT
#define WAVE_SYNC() asm volatile("s_waitcnt lgkmcnt(0)" ::: "memory")
typedef float f32x4 __attribute__((ext_vector_type(4)));
typedef float f32x2 __attribute__((ext_vector_type(2)));
typedef unsigned u32x4 __attribute__((ext_vector_type(4)));
typedef unsigned u32x2 __attribute__((ext_vector_type(2)));
typedef unsigned short bf16_t;

constexpr int BATCH = 4, SEQ = 8192, D = 1024, T = BATCH * SEQ, DEPTH = 4;
constexpr int CONV_CH = 512, SSM_W = 512, SSM_G = 32, SSM_H = 16, SSM_P = 64;
constexpr int NH = 16, HD = 64;
constexpr int NE = 32, TOPK = 4, NA = T * TOPK;
constexpr float SW_LIMIT = 7.0f, SW_ALPHA = 1.702f;
constexpr float LN_EPS = 1e-5f;
constexpr float DN_ALPHA = 1.6817928305074290860622509524664f;
constexpr int NWAVES = 8, NTHR = 512;

constexpr size_t MiB = 1u << 20;
constexpr size_t WS_CTL = 0, CTL_ZERO_BYTES = 1 * MiB;
constexpr size_t WS_S5A = 1 * MiB;
constexpr size_t WS_S5B = 1 * MiB + 65536;
constexpr size_t WS_ROPE = 2 * MiB;
constexpr size_t WS_S5X = 48 * MiB;
constexpr size_t WS_TOKE = 4 * MiB;
constexpr size_t WS_TOKR = 4 * MiB + 524288;
constexpr size_t WS_RWH = 5 * MiB;
constexpr size_t WS_RWL = 5 * MiB + 262144;
constexpr size_t WS_GLIST = 8 * MiB;
constexpr size_t WS_S5S = 12 * MiB;
constexpr size_t WS_WIN = 16 * MiB;
constexpr size_t WS_WGLU = 24 * MiB;
constexpr size_t WS_WOUT = 26 * MiB;
constexpr size_t WS_WQKV = 32 * MiB;
constexpr size_t WS_WO = 44 * MiB;
constexpr size_t WS_WGU = 64 * MiB;
constexpr size_t WS_WDN = 576 * MiB;
constexpr size_t WS_H0 = 832 * MiB;
constexpr size_t WS_H1 = 896 * MiB;
constexpr size_t WS_PROJ = 960 * MiB;
constexpr size_t WS_MIX = 1152 * MiB;
constexpr size_t WS_MIXO = 1216 * MiB;
constexpr size_t WS_Z = 1280 * MiB;
constexpr size_t WS_ACT = 1312 * MiB;
constexpr size_t WS_Y = 1584 * MiB;
constexpr size_t WS_XG = 1856 * MiB;
constexpr size_t WS_END = 3904 * MiB;
constexpr int CW_BAR = 4096;
constexpr int CW_CNT = 16384;

constexpr int LDS_BYTES = 147456;
constexpr int MISC_OFF = 131072 + 320;
constexpr int TAB_OFF = 131072 + 1024;

#define XB_TMO      128
#define XB_XCNT(j)  (256  + 64 * (j))
#define XB_XSUB(j)  (1280 + 64 * (j))
#define XB_XGEN(j)  (2304 + 64 * (j))
#define XB_TOP      3328
#define XB_TOPGEN   3392
#define XCD_BAR_WORDS 3456
#define XB_SPIN_CAP (1u << 22)

__device__ __forceinline__ unsigned xb_ld(unsigned* p)              { return __hip_atomic_load(p, __ATOMIC_RELAXED, __HIP_MEMORY_SCOPE_AGENT); }
__device__ __forceinline__ unsigned xb_add(unsigned* p, unsigned v) { return __hip_atomic_fetch_add(p, v, __ATOMIC_RELAXED, __HIP_MEMORY_SCOPE_AGENT); }
__device__ __forceinline__ unsigned xb_xcc_id() { return (unsigned)__builtin_amdgcn_s_getreg((3 << 11) | 20) & 0xFu; }
#define XB_SPIN(cond, bar) do { unsigned _sp = 0; while (cond) { __builtin_amdgcn_s_sleep(1); \
    if ((++_sp & 255u) == 0u) { if (xb_ld(&(bar)[XB_TMO])) break; if (_sp > XB_SPIN_CAP) { atomicAdd(&(bar)[XB_TMO], 1u); break; } } } } while (0)

struct XcdBarrier { unsigned* bar; unsigned x; volatile LAS unsigned* st; };

__device__ __forceinline__ XcdBarrier xcd_barrier_post(unsigned* bar, volatile LAS unsigned* st) {
    XcdBarrier b; b.bar = bar; b.x = xb_xcc_id(); b.st = st;
    if (threadIdx.x == 0) (void)xb_add(&bar[XB_XCNT(b.x)], 1u);
    return b;
}
__device__ __forceinline__ void xcd_barrier_complete(unsigned* bar, unsigned x, unsigned& nloc, unsigned& nx) {
    const unsigned G = gridDim.x * gridDim.y * gridDim.z;
    unsigned sum, cnt, mine, sp = 0u;
    for (;;) {
        sum = 0u; cnt = 0u; mine = 0u;
#pragma unroll
        for (unsigned j = 0; j < 16; ++j) { const unsigned c = xb_ld(&bar[XB_XCNT(j)]); sum += c; cnt += (c > 0u) ? 1u : 0u; mine = (j == x) ? c : mine; }
        if (sum == G) break;
        __builtin_amdgcn_s_sleep(1);
        if ((++sp & 255u) == 0u) { if (xb_ld(&bar[XB_TMO])) break; if (sp > XB_SPIN_CAP) { atomicAdd(&bar[XB_TMO], 1u); break; } }
    }
    nloc = mine > 0u ? mine : 1u; nx = cnt > 0u ? cnt : 1u;
}
__device__ __forceinline__ void xcd_barrier(const XcdBarrier& b) {
    asm volatile("s_waitcnt vmcnt(0)" ::: "memory");
    __syncthreads();
    if (threadIdx.x == 0) {
        unsigned* bar = b.bar;
        __builtin_amdgcn_s_waitcnt(0);
        unsigned nloc = b.st[0], nx = b.st[1];
        if (nloc == 0u) { xcd_barrier_complete(bar, b.x, nloc, nx); b.st[0] = nloc; b.st[1] = nx; }
        const unsigned old = xb_add(&bar[XB_XSUB(b.x)], 1u);
        const unsigned gen = old / nloc;
        if (old + 1u == (gen + 1u) * nloc) {
            __builtin_amdgcn_fence(__ATOMIC_RELEASE, "agent");
            asm volatile("s_waitcnt vmcnt(0)" ::: "memory");
            const unsigned og = xb_add(&bar[XB_TOP], 1u);
            const unsigned tg = og / nx;
            if (og + 1u == (tg + 1u) * nx) xb_add(&bar[XB_TOPGEN], 1u);
            else XB_SPIN(xb_ld(&bar[XB_TOPGEN]) == tg, bar);
            __builtin_amdgcn_fence(__ATOMIC_ACQUIRE, "agent");
            xb_add(&bar[XB_XGEN(b.x)], 1u);
            asm volatile("s_waitcnt vmcnt(0)" ::: "memory");
        } else {
            XB_SPIN(xb_ld(&bar[XB_XGEN(b.x)]) == gen, bar);
            __builtin_amdgcn_fence(__ATOMIC_ACQUIRE, "agent");
            asm volatile("s_waitcnt vmcnt(0)" ::: "memory");
        }
    }
    __syncthreads();
}

__device__ __forceinline__ float wave_sum(float v) {
#pragma unroll
    for (int o = 1; o < 64; o <<= 1) v += __shfl_xor(v, o);
    return v;
}
__device__ __forceinline__ float wave_max(float v) {
#pragma unroll
    for (int o = 1; o < 64; o <<= 1) v = fmaxf(v, __shfl_xor(v, o));
    return v;
}
__device__ __forceinline__ float sigmoidf_(float x) { return __builtin_amdgcn_rcpf(1.0f + __builtin_amdgcn_exp2f(-1.4426950408889634f * x)); }
__device__ __forceinline__ float gelu_tanh(float y) { return y * sigmoidf_(1.5957691216057308f * (y + 0.044715f * y * y * y)); }
__device__ __forceinline__ float opaque_f(float v) { asm volatile("" : "+s"(v)); return v; }
__device__ __forceinline__ int opaque_i(int v) { asm volatile("" : "+s"(v)); return v; }
__device__ __forceinline__ int seqpos(int bt) { return bt - ((bt >> 13) << 13); }
__device__ __forceinline__ unsigned f2bf(float f) { unsigned u = __builtin_bit_cast(unsigned, f); return (u + 0x7fffu + ((u >> 16) & 1u)) >> 16; }
__device__ __forceinline__ unsigned pk2(float lo, float hi) { return f2bf(lo) | (f2bf(hi) << 16); }
typedef float f32x2_t_ __attribute__((ext_vector_type(2))); typedef __bf16 bf16x2_t_ __attribute__((ext_vector_type(2)));
__device__ __forceinline__ unsigned cvt_pk_bf16(float lo, float hi) { const f32x2_t_ v = {lo, hi}; const bf16x2_t_ b = __builtin_convertvector(v, bf16x2_t_); return __builtin_bit_cast(unsigned, b); }
__device__ __forceinline__ float bf_lo(unsigned w) { return __builtin_bit_cast(float, w << 16); }
__device__ __forceinline__ float bf_hi(unsigned w) { return __builtin_bit_cast(float, w & 0xffff0000u); }
__device__ __forceinline__ float bf2f(bf16_t b) { return __builtin_bit_cast(float, ((unsigned)b) << 16); }
__device__ __forceinline__ void unpack8(const u32x4 w, float (&f)[8]) { f[0] = bf_lo(w.x); f[1] = bf_hi(w.x); f[2] = bf_lo(w.y); f[3] = bf_hi(w.y); f[4] = bf_lo(w.z); f[5] = bf_hi(w.z); f[6] = bf_lo(w.w); f[7] = bf_hi(w.w); }
__device__ __forceinline__ u32x4 pack8(const float (&f)[8]) { u32x4 w; w.x = cvt_pk_bf16(f[0], f[1]); w.y = cvt_pk_bf16(f[2], f[3]); w.z = cvt_pk_bf16(f[4], f[5]); w.w = cvt_pk_bf16(f[6], f[7]); return w; }

__device__ __forceinline__ unsigned pk4_fp8(float a, float b, float c, float d) {
    int w = __builtin_amdgcn_cvt_pk_fp8_f32(a, b, 0, false); w = __builtin_amdgcn_cvt_pk_fp8_f32(c, d, w, true); return (unsigned)w; }
__device__ __forceinline__ u32x2 pack8_fp8(const float (&f)[8]) { u32x2 w; w.x = pk4_fp8(f[0], f[1], f[2], f[3]); w.y = pk4_fp8(f[4], f[5], f[6], f[7]); return w; }
typedef float f32x2v_ __attribute__((ext_vector_type(2)));
__device__ __forceinline__ void unpack8_fp8(const u32x2 w, float (&f)[8]) {
    const f32x2v_ a = __builtin_amdgcn_cvt_pk_f32_fp8((int)w.x, false), b = __builtin_amdgcn_cvt_pk_f32_fp8((int)w.x, true), c = __builtin_amdgcn_cvt_pk_f32_fp8((int)w.y, false), d = __builtin_amdgcn_cvt_pk_f32_fp8((int)w.y, true);
    f[0] = a.x; f[1] = a.y; f[2] = b.x; f[3] = b.y; f[4] = c.x; f[5] = c.y; f[6] = d.x; f[7] = d.y; }
constexpr float Y8_SCALE = 16.0f;
constexpr int W8_SHIFT_GU = 5, W8_SHIFT_DN = 6;

__device__ __forceinline__ int lane_id() { int l; asm volatile("v_mbcnt_lo_u32_b32 %0, -1, 0\n\tv_mbcnt_hi_u32_b32 %0, -1, %0" : "=v"(l)); return l; }

struct Ctx {
    LAS unsigned char* lds;
    int tid, lane, wave, G, bid;
    unsigned* ctl;
    GAS unsigned char* ws;
};

namespace pg8 {
#define PG8_LAS __attribute__((address_space(3)))
typedef short bf16x8 __attribute__((ext_vector_type(8)));
constexpr int BM = 256, BK = 64, HALF = 128, HTB = HALF * BK * 2  , STAGE_BYTES = 8 * HTB, NXCD = 8, WGM = 8;

__host__ __device__ __forceinline__ int lds_byte(int r, int c) { const int st = (r >> 4) * 2 + (c >> 5), rr = r & 15, cc = c & 31, ob = rr * 64 + cc * 2; return st * 1024 + (ob ^ (((ob >> 9) & 1) << 5)); }
__host__ __device__ __forceinline__ void stage_rc(int b, int& R, int& C) { const int st = b / 1024, sb = b % 1024, swz = sb ^ (((sb >> 9) & 1) << 5); R = (st >> 1) * 16 + swz / 64; C = (st & 1) * 32 + (swz % 64) / 2; }
__host__ __device__ __forceinline__ int perm32(int rho) { const int n = rho >> 4, i = rho & 15; return 8 * (i >> 2) + 4 * n + (i & 3); }

struct Unit { int pm, pn, e, mt; };
struct Gemm { const bf16_t* A; const bf16_t* Bt; int M, N, K; };

struct StaticOrder {
    int nM, nN, nwg, G, c; size_t tstep;
    __device__ void init(int M, int N, int K, int G_, int c_) { nM = M / BM; nN = N / BM; nwg = nM * nN; G = G_; c = c_; tstep = (size_t)BM * K * 2; }
    __device__ bool next(int i, Unit& u) const {
        const long L = (long)i * G + c; if (L >= nwg) return false;
        int wgid = (int)L; { const int q = nwg / NXCD, r = nwg % NXCD, xcd = wgid % NXCD, off = wgid / NXCD; wgid = (xcd < r ? xcd * (q + 1) : r * (q + 1) + (xcd - r) * q) + off; }
        const int nig = WGM * nN, gid = wgid / nig, fm = gid * WGM, gsz = (nM - fm) < WGM ? (nM - fm) : WGM;
        u.pm = fm + ((wgid % nig) % gsz); u.pn = (wgid % nig) / gsz; u.e = 0; u.mt = 0; return true;
    }
    __device__ __forceinline__ size_t a_off(const Unit& u) const { return (size_t)u.pm * tstep; }
    __device__ __forceinline__ size_t b_off(const Unit& u) const { return (size_t)u.pn * tstep; }
    __device__ __forceinline__ void a_ready(const Unit&) const {}
    __device__ __forceinline__ void done(const Unit&) const {}
};
template <int NPN, bool A_IS_XG> struct MoeOrder {
    const PG8_LAS int* tb; int G, c, ntile; size_t bexp, rowb;
    __device__ void init(const PG8_LAS int* tb_, int G_, int c_, int Nexp, int K) { tb = tb_; G = G_; c = c_; ntile = tb_[32]; rowb = (size_t)K * 2; bexp = (size_t)Nexp * rowb; }
    __device__ bool next(int i, Unit& u) const {
        int mtg, pn;
        if (G == 256) { constexpr int MPR = 256 / NPN, MPX = MPR / 8; mtg = MPR * i + MPX * (c & 7) + (c >> 3) / NPN; pn = (c >> 3) % NPN; }
        else { const long L = (long)i * G + c; mtg = (int)(L / NPN); pn = (int)(L % NPN); }
        if (mtg >= ntile) return false;
        int e = 0;
#pragma unroll
        for (int st = 16; st >= 1; st >>= 1) { const int tv = __builtin_amdgcn_readfirstlane(tb[e + st]); if (tv <= mtg) e += st; }
        u.pm = mtg; u.pn = pn; u.e = e; u.mt = mtg - tb[e]; return true;
    }
    __device__ __forceinline__ size_t a_off(const Unit& u) const { return A_IS_XG ? ((size_t)u.e * T + (size_t)u.mt * BM) * rowb : (size_t)u.pm * BM * rowb; }
    __device__ __forceinline__ size_t b_off(const Unit& u) const { return (size_t)u.e * bexp + (size_t)u.pn * BM * rowb; }
    __device__ __forceinline__ void a_ready(const Unit&) const {}
    __device__ __forceinline__ void done(const Unit&) const {}
};

__device__ __forceinline__ u32x4 pack_v(const f32x4 v0, const f32x4 v1) { u32x4 w; w.x = cvt_pk_bf16(v0[0], v0[1]); w.y = cvt_pk_bf16(v0[2], v0[3]); w.z = cvt_pk_bf16(v1[0], v1[1]); w.w = cvt_pk_bf16(v1[2], v1[3]); return w; }

struct EpiStore {
    static constexpr bool PERM = true, AFTER_DRAIN = false, BIAS_INIT = false;
    bf16_t* O; int ldc;
    __device__ __forceinline__ void operator()(const f32x4 (&acc)[2][2][4][2], const Unit& u, int wr, int wc, int fr, int fq) const {
        const int row0 = u.pm * BM + wr * 64 + fr, col0 = u.pn * BM + wc * 32 + 8 * fq;
#pragma unroll
        for (int ai = 0; ai < 2; ++ai)
#pragma unroll
            for (int m = 0; m < 4; ++m) { bf16_t* rowp = O + (size_t)(row0 + ai * HALF + m * 16) * ldc + col0;
#pragma unroll
                for (int bj = 0; bj < 2; ++bj) *(u32x4*)(rowp + bj * HALF) = pack_v(acc[ai][bj][m][0], acc[ai][bj][m][1]); }
    }
};
struct EpiGlu {
    static constexpr bool PERM = true, AFTER_DRAIN = false, BIAS_INIT = false;
    const bf16_t* Z; bf16_t* MIX; const float* bias;
    __device__ __forceinline__ void operator()(const f32x4 (&acc)[2][2][4][2], const Unit& u, int wr, int wc, int fr, int fq) const {
        const int row0 = u.pm * BM + wr * 64 + fr, col0 = u.pn * BM + wc * 32 + 8 * fq;
        f32x4 bv[2][2];
#pragma unroll
        for (int bj = 0; bj < 2; ++bj)
#pragma unroll
            for (int n = 0; n < 2; ++n) bv[bj][n] = *(const f32x4*)(bias + col0 + bj * HALF + 4 * n);
#pragma unroll
        for (int ai = 0; ai < 2; ++ai)
#pragma unroll
            for (int m = 0; m < 4; ++m) { const size_t row = (size_t)(row0 + ai * HALF + m * 16);
#pragma unroll
                for (int bj = 0; bj < 2; ++bj) {
                    const u32x4 zw = *(const u32x4*)(Z + row * SSM_W + col0 + bj * HALF); float z[8]; unpack8(zw, z);
                    const f32x4 a0 = acc[ai][bj][m][0] + bv[bj][0], a1 = acc[ai][bj][m][1] + bv[bj][1];
                    float o[8];
#pragma unroll
                    for (int j = 0; j < 4; ++j) { o[j] = z[j] * sigmoidf_(a0[j]); o[4 + j] = z[4 + j] * sigmoidf_(a1[j]); }
                    *(u32x4*)(MIX + row * D + 512 + col0 + bj * HALF) = pack8(o); } }
    }
};
struct EpiRope {
    static constexpr bool PERM = true, AFTER_DRAIN = false, BIAS_INIT = false;
    bf16_t* O; const f32x2* rope;
    __device__ __forceinline__ void operator()(const f32x4 (&acc)[2][2][4][2], const Unit& u, int wr, int wc, int fr, int fq) const {
        const int part = u.pn >> 2, tp = u.pn & 3;
        const int row0 = u.pm * BM + wr * 64 + fr, colb = part * 1024 + (4 * tp + wc) * 64 + 8 * fq;
        const float qs = part == 0 ? 0.125f * 1.4426950408889634f : 1.0f;
#pragma unroll
        for (int ai = 0; ai < 2; ++ai)
#pragma unroll
            for (int m = 0; m < 4; ++m) { const int row = row0 + ai * HALF + m * 16; bf16_t* rowp = O + (size_t)row * 3072 + colb;
                const f32x4 x1a = acc[ai][0][m][0], x1b = acc[ai][0][m][1], x2a = acc[ai][1][m][0], x2b = acc[ai][1][m][1];
                if (part < 2) {
                    const f32x4* rp = (const f32x4*)(rope + (size_t)seqpos(row) * 32 + 8 * fq);
                    const f32x4 c01 = rp[0], c23 = rp[1], c45 = rp[2], c67 = rp[3];
                    float o1[8], o2[8];
                    const float cs[8] = {c01[0], c01[2], c23[0], c23[2], c45[0], c45[2], c67[0], c67[2]}, sn[8] = {c01[1], c01[3], c23[1], c23[3], c45[1], c45[3], c67[1], c67[3]};
                    const float x1[8] = {x1a[0], x1a[1], x1a[2], x1a[3], x1b[0], x1b[1], x1b[2], x1b[3]}, x2[8] = {x2a[0], x2a[1], x2a[2], x2a[3], x2b[0], x2b[1], x2b[2], x2b[3]};
#pragma unroll
                    for (int j = 0; j < 8; ++j) { o1[j] = (x1[j] * cs[j] - x2[j] * sn[j]) * qs; o2[j] = (x2[j] * cs[j] + x1[j] * sn[j]) * qs; }
                    *(u32x4*)(rowp) = pack8(o1); *(u32x4*)(rowp + 32) = pack8(o2);
                } else { *(u32x4*)(rowp) = pack_v(x1a, x1b); *(u32x4*)(rowp + 32) = pack_v(x2a, x2b); } }
    }
};
struct EpiSwiglu {
    static constexpr bool PERM = true, AFTER_DRAIN = false, BIAS_INIT = true;
#ifdef PROBE_NOSTORE
    bool nostore = false;
#endif
    bf16_t* ACT; const float* bgu;
    __device__ __forceinline__ void init(f32x4 (&acc)[2][2][4][2], const Unit& u, int wc, int fq) const {
        const float* bb = bgu + (size_t)u.e * 2048 + u.pn * 128 + wc * 32 + 8 * fq;
        const f32x4 bg0 = *(const f32x4*)(bb), bg1 = *(const f32x4*)(bb + 4), bl0 = *(const f32x4*)(bb + 1024), bl1 = *(const f32x4*)(bb + 1028);
#pragma unroll
        for (int ai = 0; ai < 2; ++ai)
#pragma unroll
            for (int m = 0; m < 4; ++m) { acc[ai][0][m][0] = bg0; acc[ai][0][m][1] = bg1; acc[ai][1][m][0] = bl0; acc[ai][1][m][1] = bl1; }
    }
    __device__ __forceinline__ void operator()(const f32x4 (&acc)[2][2][4][2], const Unit& u, int wr, int wc, int fr, int fq) const {
        const int row0 = u.pm * BM + wr * 64 + fr, j0 = u.pn * 128 + wc * 32 + 8 * fq;
        unsigned char* ab = (unsigned char*)ACT + (size_t)row0 * D + j0;
#pragma unroll
        for (int ai = 0; ai < 2; ++ai)
#pragma unroll
            for (int m = 0; m < 4; ++m) {
                const f32x4 g0 = acc[ai][0][m][0], g1 = acc[ai][0][m][1], l0 = acc[ai][1][m][0], l1 = acc[ai][1][m][1];
                float o[8];
#pragma unroll
                for (int j = 0; j < 4; ++j) {
                    const float ga = __builtin_amdgcn_fmed3f(g0[j], -3.0e38f, SW_LIMIT), gb = __builtin_amdgcn_fmed3f(g1[j], -3.0e38f, SW_LIMIT);
                    const float la = __builtin_amdgcn_fmed3f(l0[j], -SW_LIMIT, SW_LIMIT), lb = __builtin_amdgcn_fmed3f(l1[j], -SW_LIMIT, SW_LIMIT);
                    const float sa = ga * __builtin_amdgcn_rcpf(1.0f + __builtin_amdgcn_exp2f((-SW_ALPHA * 1.4426950408889634f) * ga)), sb = gb * __builtin_amdgcn_rcpf(1.0f + __builtin_amdgcn_exp2f((-SW_ALPHA * 1.4426950408889634f) * gb));
                    o[j] = fmaf(la, sa, sa); o[4 + j] = fmaf(lb, sb, sb); }
#ifdef PROBE_NOSTORE
                { const u32x2 w_ = pack8_fp8(o); if (!nostore) *(u32x2*)(ab + (size_t)(ai * HALF + m * 16) * D) = w_; else asm volatile("" :: "v"(w_)); } }
#else
                *(u32x2*)(ab + (size_t)(ai * HALF + m * 16) * D) = pack8_fp8(o); }
#endif
    }
};
struct EpiDown {
    static constexpr bool PERM = true, AFTER_DRAIN = false, BIAS_INIT = true;
#ifdef PROBE_NOSTORE
    bool nostore = false;
#endif
    bf16_t* Y; const float* bd; const float* glist;
    __device__ __forceinline__ void init(f32x4 (&acc)[2][2][4][2], const Unit& u, int wc, int fq) const {
        const float* bb = bd + (size_t)u.e * D + u.pn * BM + wc * 32 + 8 * fq;
        const f32x4 b00 = *(const f32x4*)(bb), b01 = *(const f32x4*)(bb + 4), b10 = *(const f32x4*)(bb + HALF), b11 = *(const f32x4*)(bb + HALF + 4);
#pragma unroll
        for (int ai = 0; ai < 2; ++ai)
#pragma unroll
            for (int m = 0; m < 4; ++m) { acc[ai][0][m][0] = b00; acc[ai][0][m][1] = b01; acc[ai][1][m][0] = b10; acc[ai][1][m][1] = b11; }
    }
    __device__ __forceinline__ void operator()(const f32x4 (&acc)[2][2][4][2], const Unit& u, int wr, int wc, int fr, int fq) const {
        const int rl0 = wr * 64 + fr, col0 = u.pn * BM + wc * 32 + 8 * fq;
        const float* gl = glist + (size_t)u.e * T + (size_t)u.mt * BM + rl0;
        unsigned char* yb = (unsigned char*)Y + ((size_t)u.pm * BM + rl0) * D + col0;
#pragma unroll
        for (int ai = 0; ai < 2; ++ai)
#pragma unroll
            for (int m = 0; m < 4; ++m) { const int rl = ai * HALF + m * 16; const float gt = gl[rl] * Y8_SCALE;
#pragma unroll
                for (int bj = 0; bj < 2; ++bj) { const f32x4 v0 = acc[ai][bj][m][0] * gt, v1 = acc[ai][bj][m][1] * gt; u32x2 w; w.x = pk4_fp8(v0[0], v0[1], v0[2], v0[3]); w.y = pk4_fp8(v1[0], v1[1], v1[2], v1[3]);
#ifdef PROBE_NOSTORE
                    if (nostore) asm volatile("" :: "v"(w)); else
#endif
                    *(u32x2*)(yb + (size_t)rl * D + bj * HALF) = w; } }
    }
};

template <class Epi, class Sched, bool ALIGN_EPI = false, bool SP2 = false, bool FP8 = false, int PROBE = 0>
__device__ __forceinline__ void gemm_phase(PG8_LAS unsigned char* lds, const Gemm g, const Sched& S, const Epi& E, int wave_, int scale_w = 127, int scale_x = 127) {
    int tid = wave_ * 64 + lane_id(); asm volatile("" : "+v"(tid)); const int wid = wave_, lane = tid & 63, wr = wid >> 2, wc = wid & 3, fr = lane & 15, fq = lane >> 4;
    const int K = g.K, nt = K / BK;
    unsigned voffA[2], voffB[2];
#pragma unroll
    for (int i = 0; i < 2; ++i) { int R, C; stage_rc(tid * 16 + i * 8192, R, C); const int Rb = Epi::PERM ? ((R & ~31) + perm32(R & 31)) : R;
        voffA[i] = (unsigned)(R * K + C) * 2u; voffB[i] = (unsigned)(Rb * K + C) * 2u; }
    const unsigned kstep = (unsigned)(BK * 2);
    const unsigned hstep = (unsigned)HALF * (unsigned)K * 2u;
    const unsigned ldsw = (unsigned)wid * 1024u;
    const int aoff = lds_byte(wr * 64 + fr, fq * 8), boff = lds_byte(wc * 32 + fr, fq * 8);
#define PG8_SA(b, h) (((b) * 2 + (h)) * HTB)
#define PG8_SB(b, h) ((4 + (b) * 2 + (h)) * HTB)
#define PG8_STAGE(bufoff, gbase, voff) do { if constexpr (!(PROBE & 2)) _Pragma("unroll") for (int _i = 0; _i < 2; ++_i) \
        __builtin_amdgcn_raw_ptr_buffer_load_lds(rsrc_##voff, (PG8_LAS unsigned*)(lds + (bufoff) + ldsw + _i * 8192), 16, (voff)[_i], (gbase), 0, 0); } while (0)
#define PG8_LDA(dst, b, h) do { if constexpr ((PROBE & 16) != 0) { if constexpr (FP8) { asm volatile("" : "+v"(dst##8[0]), "+v"(dst##8[1]), "+v"(dst##8[2]), "+v"(dst##8[3])); } } else if constexpr (FP8) { _Pragma("unroll") for (int m = 0; m < 4; ++m) { const v4i_ lo_ = *(const PG8_LAS v4i_*)(lds + PG8_SA(b, h) + aoff + m * 2048), hi_ = *(const PG8_LAS v4i_*)(lds + PG8_SA(b, h) + aoff + m * 2048 + 1024); dst##8[m] = __builtin_shufflevector(lo_, hi_, 0, 1, 2, 3, 4, 5, 6, 7); } } \
        else { _Pragma("unroll") for (int m = 0; m < 4; ++m) _Pragma("unroll") for (int k = 0; k < 2; ++k) dst[m][k] = *(const PG8_LAS bf16x8*)(lds + PG8_SA(b, h) + aoff + m * 2048 + k * 1024); } } while (0)
#define PG8_LDB(dst, b, h) do { if constexpr ((PROBE & 8) != 0) { if constexpr (FP8) { asm volatile("" : "+v"(dst##8[0]), "+v"(dst##8[1])); } } else if constexpr (FP8) { _Pragma("unroll") for (int n = 0; n < 2; ++n) { const v4i_ lo_ = *(const PG8_LAS v4i_*)(lds + PG8_SB(b, h) + boff + n * 2048), hi_ = *(const PG8_LAS v4i_*)(lds + PG8_SB(b, h) + boff + n * 2048 + 1024); dst##8[n] = __builtin_shufflevector(lo_, hi_, 0, 1, 2, 3, 4, 5, 6, 7); } } \
        else { _Pragma("unroll") for (int n = 0; n < 2; ++n) _Pragma("unroll") for (int k = 0; k < 2; ++k) dst[n][k] = *(const PG8_LAS bf16x8*)(lds + PG8_SB(b, h) + boff + n * 2048 + k * 1024); } } while (0)
#define PG8_MMA(ai, bj, At, Bt) do { __builtin_amdgcn_s_setprio(1); _Pragma("unroll") for (int m = 0; m < 4; ++m) _Pragma("unroll") for (int n = 0; n < 2; ++n) { \
        if constexpr ((PROBE & 4) != 0) { if constexpr (FP8) asm volatile("" :: "v"(Bt##8[n]), "v"(At##8[m])); else asm volatile("" :: "v"(Bt[n][0]), "v"(At[m][0]), "v"(Bt[n][1]), "v"(At[m][1])); } else \
        if constexpr (FP8) acc[ai][bj][m][n] = __builtin_amdgcn_mfma_scale_f32_16x16x128_f8f6f4(Bt##8[n], At##8[m], acc[ai][bj][m][n], 0, 0, 0, scale_w, 0, scale_x); \
        else { _Pragma("unroll") for (int k = 0; k < 2; ++k) acc[ai][bj][m][n] = __builtin_amdgcn_mfma_f32_16x16x32_bf16(Bt[n][k], At[m][k], acc[ai][bj][m][n], 0, 0, 0); } } \
        __builtin_amdgcn_s_setprio(0); } while (0)
#define PG8_WAIT_V(n) asm volatile("s_waitcnt vmcnt(" #n ")" ::: "memory")
#define PG8_WAIT_L(n) asm volatile("s_waitcnt lgkmcnt(" #n ")" ::: "memory")
#define PG8_BAR __builtin_amdgcn_s_barrier()
#define PG8_SCHED __builtin_amdgcn_sched_barrier(0)
#define PG8_ACC_INIT(u_) do { if constexpr (Epi::BIAS_INIT && !(PROBE & 64)) { int tz_ = lane_id(); asm volatile("" : "+v"(tz_)); E.init(acc, u_, wc, (tz_ & 63) >> 4); } else { \
        _Pragma("unroll") for (int a = 0; a < 2; ++a) _Pragma("unroll") for (int b = 0; b < 2; ++b) _Pragma("unroll") for (int m = 0; m < 4; ++m) _Pragma("unroll") for (int n = 0; n < 2; ++n) acc[a][b][m][n] = (f32x4){0.f, 0.f, 0.f, 0.f}; } } while (0)
    Unit cur, nxt; int ui = 0;
    if (!S.next(0, cur)) return;
    f32x4 acc[2][2][4][2];
    PG8_ACC_INIT(cur);
    typedef int v4i_ __attribute__((ext_vector_type(4))); typedef int v8i_ __attribute__((ext_vector_type(8)));
    bf16x8 At[4][2], B0[2][2], B1[2][2]; v8i_ At8[4], B08[2], B18[2];
    const auto rsrc_voffA = __builtin_amdgcn_make_buffer_rsrc((void*)g.A, 0, -1, 0x00020000), rsrc_voffB = __builtin_amdgcn_make_buffer_rsrc((void*)g.Bt, 0, -1, 0x00020000);
    unsigned cA = (unsigned)__builtin_amdgcn_readfirstlane((int)(unsigned)S.a_off(cur)), cB = (unsigned)__builtin_amdgcn_readfirstlane((int)(unsigned)S.b_off(cur));
    S.a_ready(cur);
    if constexpr (SP2) {
        PG8_STAGE(PG8_SB(0, 0), cB, voffB); PG8_STAGE(PG8_SB(0, 1), cB + hstep, voffB); PG8_STAGE(PG8_SA(0, 0), cA, voffA); PG8_STAGE(PG8_SA(0, 1), cA + hstep, voffA);
        if (wr == 1) PG8_BAR;
        PG8_WAIT_V(2); PG8_BAR;
        PG8_STAGE(PG8_SB(1, 0), cB + kstep, voffB); PG8_STAGE(PG8_SA(1, 0), cA + kstep, voffA); PG8_STAGE(PG8_SB(1, 1), cB + hstep + kstep, voffB);
        PG8_WAIT_V(6); PG8_BAR;
    } else {
        PG8_STAGE(PG8_SB(0, 0), cB, voffB); PG8_STAGE(PG8_SA(0, 0), cA, voffA); PG8_STAGE(PG8_SB(0, 1), cB + hstep, voffB); PG8_STAGE(PG8_SA(0, 1), cA + hstep, voffA);
        if (wr == 1) PG8_BAR;
        PG8_WAIT_V(4); PG8_BAR;
        PG8_STAGE(PG8_SB(1, 0), cB + kstep, voffB); PG8_STAGE(PG8_SA(1, 0), cA + kstep, voffA); PG8_STAGE(PG8_SB(1, 1), cB + hstep + kstep, voffB);
        PG8_WAIT_V(6); PG8_BAR;
    }
    for (;;) {
        const bool has_next = S.next(ui + 1, nxt);
        const unsigned nA = has_next ? (unsigned)__builtin_amdgcn_readfirstlane((int)(unsigned)S.a_off(nxt)) : cA, nB = has_next ? (unsigned)__builtin_amdgcn_readfirstlane((int)(unsigned)S.b_off(nxt)) : cB;
#pragma nounroll
        for (int t = 0; t < nt; t += 2) {
            const bool last = (t == nt - 2);
            const unsigned a1 = cA + (unsigned)(t + 1) * kstep;
            const unsigned a2 = last ? nA : cA + (unsigned)(t + 2) * kstep, b2 = last ? nB : cB + (unsigned)(t + 2) * kstep;
            const unsigned a3 = a2 + kstep, b3 = b2 + kstep;
            if (last && has_next) S.a_ready(nxt);
            if constexpr (SP2) {
            PG8_LDB(B0, 0, 0); PG8_LDB(B1, 0, 1); PG8_SCHED; PG8_LDA(At, 0, 0); PG8_STAGE(PG8_SA(1, 1), a1 + hstep, voffA);
            PG8_WAIT_V(8); PG8_WAIT_L(0); PG8_BAR; PG8_MMA(0, 0, At, B0); PG8_MMA(0, 1, At, B1); PG8_BAR; PG8_SCHED;
            PG8_LDA(At, 0, 1); PG8_STAGE(PG8_SB(0, 0), b2, voffB); PG8_STAGE(PG8_SB(0, 1), b2 + hstep, voffB); PG8_STAGE(PG8_SA(0, 0), a2, voffA);
            PG8_WAIT_V(8); PG8_WAIT_L(0); PG8_BAR; PG8_MMA(1, 0, At, B0); PG8_MMA(1, 1, At, B1); PG8_BAR; PG8_SCHED;
            PG8_LDB(B0, 1, 0); PG8_LDB(B1, 1, 1); PG8_SCHED; PG8_LDA(At, 1, 0); PG8_STAGE(PG8_SA(0, 1), a2 + hstep, voffA);
            PG8_WAIT_V(8); PG8_WAIT_L(0); PG8_BAR; PG8_MMA(0, 0, At, B0); PG8_MMA(0, 1, At, B1); PG8_BAR; PG8_SCHED;
            PG8_LDA(At, 1, 1); PG8_STAGE(PG8_SB(1, 0), b3, voffB); PG8_STAGE(PG8_SB(1, 1), b3 + hstep, voffB); PG8_STAGE(PG8_SA(1, 0), a3, voffA);
            PG8_WAIT_V(8); PG8_WAIT_L(0); PG8_BAR; PG8_MMA(1, 0, At, B0); PG8_MMA(1, 1, At, B1); PG8_BAR; PG8_SCHED;
            } else {
            PG8_LDB(B0, 0, 0); PG8_SCHED; PG8_LDA(At, 0, 0); PG8_STAGE(PG8_SA(1, 1), a1 + hstep, voffA);
            PG8_WAIT_L(8); PG8_BAR; PG8_WAIT_L(0); PG8_MMA(0, 0, At, B0); PG8_BAR; PG8_SCHED;
            PG8_LDB(B1, 0, 1); PG8_STAGE(PG8_SB(0, 0), b2, voffB);
            PG8_BAR; PG8_WAIT_L(0); PG8_MMA(0, 1, At, B1); PG8_BAR;
            PG8_LDA(At, 0, 1); PG8_STAGE(PG8_SA(0, 0), a2, voffA);
            PG8_BAR; PG8_WAIT_L(0); PG8_MMA(1, 0, At, B0); PG8_BAR; PG8_SCHED;
            PG8_STAGE(PG8_SB(0, 1), b2 + hstep, voffB);
            PG8_WAIT_V(6); PG8_BAR; PG8_MMA(1, 1, At, B1); PG8_BAR;
            PG8_LDB(B0, 1, 0); PG8_SCHED; PG8_LDA(At, 1, 0); PG8_STAGE(PG8_SA(0, 1), a2 + hstep, voffA);
            PG8_WAIT_L(8); PG8_BAR; PG8_WAIT_L(0); PG8_MMA(0, 0, At, B0); PG8_BAR; PG8_SCHED;
            PG8_LDB(B1, 1, 1); PG8_STAGE(PG8_SB(1, 0), b3, voffB);
            PG8_BAR; PG8_WAIT_L(0); PG8_MMA(0, 1, At, B1); PG8_BAR;
            PG8_LDA(At, 1, 1); PG8_STAGE(PG8_SA(1, 0), a3, voffA);
            PG8_BAR; PG8_WAIT_L(0); PG8_MMA(1, 0, At, B0); PG8_BAR; PG8_SCHED;
            PG8_STAGE(PG8_SB(1, 1), b3 + hstep, voffB);
            PG8_WAIT_V(6); PG8_BAR; PG8_MMA(1, 1, At, B1); PG8_BAR;
            }
        }
        if constexpr (ALIGN_EPI) { if (wr == 0) PG8_BAR; }
        if constexpr (!Epi::AFTER_DRAIN) { int tz = lane_id(); asm volatile("" : "+v"(tz));
            if constexpr ((PROBE & 1) != 0) { _Pragma("unroll") for (int a = 0; a < 2; ++a) _Pragma("unroll") for (int b = 0; b < 2; ++b) _Pragma("unroll") for (int m = 0; m < 4; ++m) _Pragma("unroll") for (int n = 0; n < 2; ++n) asm volatile("" :: "v"(acc[a][b][m][n])); }
            else E(acc, cur, wr, wc, tz & 15, (tz & 63) >> 4); S.done(cur); }
        if (!has_next) break;
        PG8_ACC_INIT(nxt);
        cur = nxt; cA = nA; cB = nB; ++ui;
        if constexpr (ALIGN_EPI) { if (wr == 1) PG8_BAR; }
    }
    PG8_WAIT_V(0);
    if constexpr (!ALIGN_EPI) { if (wr == 0) PG8_BAR; }
    PG8_BAR;
    if constexpr (Epi::AFTER_DRAIN) { E.fused(acc, cur, wr, wc, fr, fq, lds, wid, lane); S.done(cur); }
#undef PG8_SA
#undef PG8_SB
#undef PG8_ACC_INIT
#undef PG8_STAGE
#undef PG8_LDA
#undef PG8_LDB
#undef PG8_MMA
#undef PG8_WAIT_V
#undef PG8_WAIT_L
#undef PG8_BAR
#undef PG8_SCHED
}
}

template <int MODE>
__device__ __forceinline__ void transpose_item(const float* W, int K, int N, bf16_t* WT, LAS float* scr, int item, int lane) {
    const int nblk = N / 32, kb = item / nblk, nb = item % nblk, k0 = 64 * kb, n0 = 32 * nb;
    int dr = n0;
    if (MODE == 1) { const int j = n0 & 1023, half = n0 >> 10; dr = 256 * (j >> 7) + 128 * half + (j & 127); }
    if (MODE == 2) { const int part = n0 >> 10, c = n0 & 1023, head = c >> 6, half = (c >> 5) & 1; dr = part * 1024 + (head >> 2) * 256 + half * 128 + (head & 3) * 32; }
#pragma unroll 8
    for (int i = 0; i < 32; ++i) { const int kk = 2 * i + (lane >> 5); scr[kk * 33 + (lane & 31)] = W[(size_t)(k0 + kk) * N + n0 + (lane & 31)]; }
    WAVE_SYNC();
    const int c = lane & 7;
#pragma unroll
    for (int j = 0; j < 4; ++j) { const int n = (lane >> 3) + 8 * j; const LAS float* s = scr + (8 * c) * 33 + n;
        u32x4 o; o.x = pk2(s[0 * 33], s[1 * 33]); o.y = pk2(s[2 * 33], s[3 * 33]); o.z = pk2(s[4 * 33], s[5 * 33]); o.w = pk2(s[6 * 33], s[7 * 33]);
        *(u32x4*)(WT + (size_t)(dr + n) * K + k0 + 8 * c) = o; }
    WAVE_SYNC();
}

template <int MODE>
__device__ __forceinline__ void transpose_item_fp8(const float* W, int K, int N, unsigned char* WT, LAS float* scr, int item, int lane, float scale) {
    const int nblk = N / 32, kb = item / nblk, nb = item % nblk, k0 = 64 * kb, n0 = 32 * nb;
    int dr = n0;
    if (MODE == 1) { const int j = n0 & 1023, half = n0 >> 10; dr = 256 * (j >> 7) + 128 * half + (j & 127); }
#pragma unroll 8
    for (int i = 0; i < 32; ++i) { const int kk = 2 * i + (lane >> 5); scr[kk * 33 + (lane & 31)] = W[(size_t)(k0 + kk) * N + n0 + (lane & 31)] * scale; }
    WAVE_SYNC();
#pragma unroll
    for (int j = 0; j < 2; ++j) { const int n = lane & 31, c = (lane >> 5) + 2 * j; const LAS float* s = scr + (16 * c) * 33 + n;
        u32x4 o; o.x = pk4_fp8(s[0 * 33], s[1 * 33], s[2 * 33], s[3 * 33]); o.y = pk4_fp8(s[4 * 33], s[5 * 33], s[6 * 33], s[7 * 33]);
        o.z = pk4_fp8(s[8 * 33], s[9 * 33], s[10 * 33], s[11 * 33]); o.w = pk4_fp8(s[12 * 33], s[13 * 33], s[14 * 33], s[15 * 33]);
        *(u32x4*)(WT + (size_t)(dr + n) * K + k0 + 16 * c) = o; }
    WAVE_SYNC();
}

__device__ __forceinline__ const float* ld_ptr(volatile LAS unsigned long long* t, int k) {
    const unsigned long long v = t[k]; const unsigned lo = __builtin_amdgcn_readfirstlane((unsigned)v), hi = __builtin_amdgcn_readfirstlane((unsigned)(v >> 32));
    return (const float*)(const GAS float*)(((unsigned long long)hi << 32) | lo);
}
__device__ __forceinline__ void phase_prologue(const Ctx& X, volatile LAS unsigned long long* ptab) {
#define in_(k) ld_ptr(ptab, k)
    const float* a_re = in_(3); const float* a_im = in_(4); const float* log_dt = in_(5); const float* b_re = in_(6); const float* b_im = in_(7);
    float2* Abar = (float2*)(X.ws + WS_S5A); float2* Bbar = (float2*)(X.ws + WS_S5B); float2* rope = (float2*)(X.ws + WS_ROPE);
    const int gt = X.bid * NTHR + X.tid, NT = X.G * NTHR;
    for (int it = gt; it < 2 * SSM_G * SSM_P; it += NT) {
        const int ig = it >> 6;
        const double lam_re = fmin((double)a_re[it], -1e-4), lam_im = (double)a_im[it];
        const double dt = exp((double)log_dt[ig]);
        const double mag = exp(lam_re * dt), ang = lam_im * dt;
        const double abr = mag * cos(ang), abi = mag * sin(ang);
        const double nr = abr - 1.0, ni = abi, den = lam_re * lam_re + lam_im * lam_im;
        const double cr = (nr * lam_re + ni * lam_im) / den, ci = (ni * lam_re - nr * lam_im) / den;
        Abar[it] = make_float2((float)abr, (float)abi);
        for (int h = 0; h < SSM_H; ++h) {
            const double br = (double)b_re[it * 16 + h], bi = (double)b_im[it * 16 + h];
            Bbar[it * 16 + h] = make_float2((float)(cr * br - ci * bi), (float)(cr * bi + ci * br));
        }
    }
    for (int it = gt; it < SEQ * 32; it += NT) {
        const int pos = it >> 5, i = it & 31;
        const float inv = powf(10000.0f, -(float)i / 32.0f);
        const float ang = (float)pos * inv;
        rope[it] = make_float2((float)cos((double)ang), (float)sin((double)ang));
    }
    { const float* rw = in_(20); bf16_t* RWh = (bf16_t*)(X.ws + WS_RWH); bf16_t* RWl = (bf16_t*)(X.ws + WS_RWL);
      for (int it = gt; it < DEPTH * NE * D; it += NT) { const int k = it & 1023, e = (it >> 10) & 31, l = it >> 15;
          const float w = rw[((size_t)l * D + k) * NE + e]; const unsigned hb = f2bf(w); RWh[it] = (bf16_t)hb; RWl[it] = (bf16_t)f2bf(w - bf2f((bf16_t)hb)); } }
    { const float* x = in_(0); bf16_t* H0 = (bf16_t*)(X.ws + WS_H0);
      const size_t n8 = (size_t)T * D / 8;
      for (size_t i8 = (size_t)gt; i8 < n8; i8 += (size_t)NT) {
          const f32x4 a = *(const f32x4*)(x + i8 * 8), b = *(const f32x4*)(x + i8 * 8 + 4);
          u32x4 o; o.x = pk2(a[0], a[1]); o.y = pk2(a[2], a[3]); o.z = pk2(b[0], b[1]); o.w = pk2(b[2], b[3]);
          *(u32x4*)(H0 + i8 * 8) = o; } }
    LAS float* scr = (LAS float*)(X.lds + X.wave * 16384);
    const int gw = X.bid * NWAVES + X.wave, NGW = X.G * NWAVES;
    constexpr int I_GU = 16 * 64, I_DN = 16 * 32, I_IN = 16 * 64, I_GLU = 8 * 16, I_OUT = 16 * 32, I_QKV = 16 * 96, I_O = 16 * 32;
    constexpr int N_GU = 128 * I_GU, N_DN = 128 * I_DN, N_IN = 2 * I_IN, N_GLU = 2 * I_GLU, N_OUT = 2 * I_OUT, N_QKV = 2 * I_QKV, N_O = 2 * I_O;
    constexpr int NITEMS = N_GU + N_DN + N_IN + N_GLU + N_OUT + N_QKV + N_O;
    for (int it = gw; it < NITEMS; it += NGW) {
        int r = it;
        if (r < N_GU) { const int m = r / I_GU; transpose_item_fp8<1>(in_(22) + (size_t)m * D * 2048, D, 2048, (unsigned char*)(X.ws + WS_WGU + (size_t)m * 2048 * D), scr, r % I_GU, X.lane, (float)(1 << W8_SHIFT_GU)); continue; } r -= N_GU;
        if (r < N_DN) { const int m = r / I_DN; transpose_item_fp8<0>(in_(24) + (size_t)m * D * D, D, D, (unsigned char*)(X.ws + WS_WDN + (size_t)m * D * D), scr, r % I_DN, X.lane, (float)(1 << W8_SHIFT_DN)); continue; } r -= N_DN;
        if (r < N_IN) { const int m = r / I_IN; transpose_item<0>(in_(1) + (size_t)m * D * 2048, D, 2048, (bf16_t*)(X.ws + WS_WIN) + (size_t)m * 2048 * D, scr, r % I_IN, X.lane); continue; } r -= N_IN;
        if (r < N_GLU) { const int m = r / I_GLU; transpose_item<0>(in_(11) + (size_t)m * 512 * 512, 512, 512, (bf16_t*)(X.ws + WS_WGLU) + (size_t)m * 512 * 512, scr, r % I_GLU, X.lane); continue; } r -= N_GLU;
        if (r < N_OUT) { const int m = r / I_OUT; transpose_item<0>(in_(13) + (size_t)m * D * D, D, D, (bf16_t*)(X.ws + WS_WOUT) + (size_t)m * D * D, scr, r % I_OUT, X.lane); continue; } r -= N_OUT;
        if (r < N_QKV) { const int m = r / I_QKV; transpose_item<2>(in_(14) + (size_t)m * D * 3072, D, 3072, (bf16_t*)(X.ws + WS_WQKV) + (size_t)m * 3072 * D, scr, r % I_QKV, X.lane); continue; } r -= N_QKV;
        { const int m = r / I_O; transpose_item<0>(in_(15) + (size_t)m * D * D, D, D, (bf16_t*)(X.ws + WS_WO) + (size_t)m * D * D, scr, r % I_O, X.lane); }
    }
}

#undef in_
typedef float f32x4v __attribute__((ext_vector_type(4)));
template <int PASS>
__device__ __forceinline__ void phase_s5(const Ctx& X, int i, const bf16_t* proj, const float* conv_w, const float* c_re, const float* c_im, const float* d_skip, bf16_t* mix, bf16_t* Z) {
    using pg8::bf16x8;
    if (PASS == 2) {
        const float* w = conv_w + (size_t)i * 3 * CONV_CH;
        const size_t n = (size_t)T * (CONV_CH / 8);
        for (size_t idx = (size_t)X.bid * NTHR + X.tid; idx < n; idx += (size_t)X.G * NTHR) {
            const int bt = (int)(idx >> 6), c = (int)(idx & 63) * 8, pos = seqpos(bt);
            const bf16_t* pr = proj + (size_t)bt * 2048;
            float gb[8], a2[8], b2[8], a1[8], b1[8], a0[8], b0[8];
            unpack8(*(const u32x4*)(pr + c), gb); unpack8(*(const u32x4*)(pr + 512 + c), a2); unpack8(*(const u32x4*)(pr + 1024 + c), b2);
            if (pos >= 1) { unpack8(*(const u32x4*)(pr + 512 + c - 2048), a1); unpack8(*(const u32x4*)(pr + 1024 + c - 2048), b1); }
            if (pos >= 2) { unpack8(*(const u32x4*)(pr + 512 + c - 4096), a0); unpack8(*(const u32x4*)(pr + 1024 + c - 4096), b0); }
            float o[8];
#pragma unroll
            for (int j = 0; j < 8; ++j) {
                float s = w[2 * CONV_CH + c + j] * (a2[j] * b2[j]);
                if (pos >= 1) s += w[1 * CONV_CH + c + j] * (a1[j] * b1[j]);
                if (pos >= 2) s += w[0 * CONV_CH + c + j] * (a0[j] * b0[j]);
                o[j] = gb[j] * s; }
            *(u32x4*)(mix + (size_t)bt * D + c) = pack8(o);
        }
    }
    const int lane = X.lane, n16 = lane & 15, kq = lane >> 4;
    LAS float* BuT = (LAS float*)(X.lds + X.wave * 15360);
    LAS unsigned char* xsb = X.lds + X.wave * 15360 + 10240;
    const float2* Abar = (const float2*)(X.ws + WS_S5A); const float2* Bbar = (const float2*)(X.ws + WS_S5B);
    float2* Sst = (float2*)(X.ws + WS_S5S);
    const int gw = X.bid * NWAVES + X.wave, NGW = X.G * NWAVES;
    const int g = gw & 31, ig = i * 32 + g;
        const float2 A = Abar[ig * 64 + lane];
    bf16x8 bfr[8];
#pragma unroll
    for (int cb = 0; cb < 8; ++cb) {
        u32x4 w = (u32x4){0u, 0u, 0u, 0u};
        if (kq < 2) { const float2* bp = Bbar + ((size_t)(ig * 64 + 16 * (cb & 3) + n16)) * 16 + 8 * kq; float v[8];
#pragma unroll
            for (int j = 0; j < 8; ++j) { const float2 t2 = bp[j]; v[j] = cb < 4 ? t2.x : t2.y; }
            w = pack8(v); }
        bfr[cb] = __builtin_bit_cast(bf16x8, w);
    }
    bf16x8 cfr[4]; bf16x8 dfr;
    if (PASS == 2) {
#pragma unroll
        for (int ks = 0; ks < 4; ++ks) { const int p0 = 16 * ks + 4 * kq; const f32x4 cr = *(const f32x4*)(c_re + (size_t)(ig * 16 + n16) * 64 + p0), ci = *(const f32x4*)(c_im + (size_t)(ig * 16 + n16) * 64 + p0);
            u32x4 w; w.x = cvt_pk_bf16(cr[0], -ci[0]); w.y = cvt_pk_bf16(cr[1], -ci[1]); w.z = cvt_pk_bf16(cr[2], -ci[2]); w.w = cvt_pk_bf16(cr[3], -ci[3]); cfr[ks] = __builtin_bit_cast(bf16x8, w); }
        { const float dv = d_skip[ig * 16 + n16]; float v[8];
#pragma unroll
          for (int j = 0; j < 8; ++j) v[j] = (kq < 2 && 8 * kq + j == n16) ? dv : 0.f;
          dfr = __builtin_bit_cast(bf16x8, pack8(v)); }
    }
    for (int task = gw; task < BATCH * 64 * SSM_G; task += NGW) {
        const int c = (task >> 5) & 63, b = task >> 11;
        float xr = 0.f, xi = 0.f;
        if (PASS == 2) { const float2 xin = ((const float2*)(X.ws + WS_S5X))[((size_t)(b * 32 + g) * 64 + c) * 64 + lane]; xr = xin.x; xi = xin.y; }
        const bf16_t* ub = proj + ((size_t)b * SEQ + (size_t)c * 128) * 2048 + 1536 + g * 16;
        bf16_t* zb = Z + ((size_t)b * SEQ + (size_t)c * 128) * SSM_W + g * 16;
        u32x4 uw = (u32x4){0u, 0u, 0u, 0u};
        if (kq < 2) uw = *(const u32x4*)(ub + (size_t)n16 * 2048 + 8 * kq);
#pragma nounroll
        for (int blk = 0; blk < 8; ++blk) {
            const bf16x8 ufr = __builtin_bit_cast(bf16x8, uw);
            u32x4 un = (u32x4){0u, 0u, 0u, 0u};
            if (kq < 2 && blk < 7) un = *(const u32x4*)(ub + (size_t)((blk + 1) * 16 + n16) * 2048 + 8 * kq);
#pragma unroll
            for (int cb = 0; cb < 8; ++cb) {
                f32x4v acc = (f32x4v){0.f, 0.f, 0.f, 0.f};
                acc = __builtin_amdgcn_mfma_f32_16x16x32_bf16(ufr, bfr[cb], acc, 0, 0, 0);
                *(LAS f32x4v*)(BuT + (16 * cb + n16) * 20 + 4 * kq) = acc;
            }
            WAVE_SYNC();
#pragma unroll
            for (int k4 = 0; k4 < 4; ++k4) {
                const f32x4v br = *(const LAS f32x4v*)(BuT + lane * 20 + 4 * k4), bi = *(const LAS f32x4v*)(BuT + (64 + lane) * 20 + 4 * k4);
#pragma unroll
                for (int s = 0; s < 4; ++s) {
                    float nr = fmaf(-A.y, xi, fmaf(A.x, xr, br[s])); asm volatile("" : "+v"(nr));
                    float ni = fmaf(A.y, xr, fmaf(A.x, xi, bi[s])); asm volatile("" : "+v"(ni));
                    xr = nr; xi = ni;
                    if (PASS == 2) *(LAS unsigned*)(xsb + (4 * k4 + s) * 272 + lane * 4) = cvt_pk_bf16(xr, xi);
                }
            }
            if (PASS == 2) {
                WAVE_SYNC();
                f32x4v y = (f32x4v){0.f, 0.f, 0.f, 0.f};
                bf16x8 xa[4];
#pragma unroll
                for (int ks = 0; ks < 4; ++ks) xa[ks] = *(const LAS bf16x8*)(xsb + n16 * 272 + ks * 64 + kq * 16);
                WAVE_SYNC(); __builtin_amdgcn_sched_barrier(0);
#pragma unroll
                for (int ks = 0; ks < 4; ++ks) y = __builtin_amdgcn_mfma_f32_16x16x32_bf16(xa[ks], cfr[ks], y, 0, 0, 0);
                y = __builtin_amdgcn_mfma_f32_16x16x32_bf16(ufr, dfr, y, 0, 0, 0);
                asm volatile("" :: "v"(xa[0]), "v"(xa[1]), "v"(xa[2]), "v"(xa[3]), "v"(ufr));
#pragma unroll
                for (int q = 0; q < 4; ++q) zb[(size_t)(blk * 16 + 4 * kq + q) * SSM_W + n16] = (bf16_t)f2bf(gelu_tanh(y[q]));
            }
            WAVE_SYNC();
            uw = un;
        }
        if (PASS == 1) Sst[((size_t)(b * 32 + g) * 64 + c) * 64 + lane] = make_float2(xr, xi);
    }
}

__device__ __forceinline__ void phase_s5_carry(const Ctx& X, int i) {
    const float2* Abar = (const float2*)(X.ws + WS_S5A); const float2* Sst = (const float2*)(X.ws + WS_S5S); float2* Xin = (float2*)(X.ws + WS_S5X);
    const int gw = X.bid * NWAVES + X.wave, NGW = X.G * NWAVES, lane = X.lane;
    for (int bg = gw; bg < BATCH * SSM_G; bg += NGW) {
        const float2 A = Abar[(i * 32 + (bg & 31)) * 64 + lane];
        float pr_ = A.x, pi_ = A.y;
#pragma unroll
        for (int q = 0; q < 7; ++q) { const float nr = pr_ * pr_ - pi_ * pi_, ni = 2.f * pr_ * pi_; pr_ = nr; pi_ = ni; }
        float xr = 0.f, xi = 0.f;
        const size_t base = (size_t)bg * 64 * 64 + lane;
#pragma unroll 8
        for (int c = 0; c < 64; ++c) {
            Xin[base + (size_t)c * 64] = make_float2(xr, xi);
            const float2 s = Sst[base + (size_t)c * 64];
            const float nr = pr_ * xr - pi_ * xi + s.x, ni = pr_ * xi + pi_ * xr + s.y; xr = nr; xi = ni;
        }
    }
}

typedef short v4i16_t __attribute__((ext_vector_type(4)));
typedef float f32x16 __attribute__((ext_vector_type(16)));
__device__ __forceinline__ v4i16_t vtr16(const LAS unsigned char* p) { return __builtin_amdgcn_ds_read_tr16_b64_v4i16((LAS v4i16_t*)p); }
template <int PASS>
__device__ __forceinline__ void phase_attn(const Ctx& X, const bf16_t* proj, bf16_t* att, bf16_t* ost, float2* ml) {
    using pg8::bf16x8;
    const int lane = X.lane, i32 = lane & 31, hi = lane >> 5;
    LAS unsigned char* vbuf = X.lds + X.wave * 16384;
    LAS unsigned char* kbuf = vbuf + 8192;
    const int gw = X.bid * NWAVES + X.wave, NGW = X.G * NWAVES;
    const float NEG = opaque_f(-3.0e38f); const int seqmax = opaque_i(SEQ - 1);
    const int vrd = ((lane >> 4) & 1) * 32 + (lane & 3) * 8 + (4 * hi + ((lane & 15) >> 2)) * 64;
    const bool xdeal = (X.G == 256);
    constexpr int NT = PASS == 0 ? 13 : 5, PD = 2, NR = 3;
    const int lrow = lane >> 3, lpc = lane & 7;
#pragma nounroll
    for (int it = 0; it < (xdeal ? 8 : (BATCH * NH * 256 + NGW - 1) / NGW); ++it) {
        const int task = xdeal ? (((it * 8 + (X.bid & 7)) << 8) | ((X.bid >> 3) * 8 + X.wave)) : (gw + it * NGW);
        if (task >= BATCH * NH * 256) break;
        const int QST = PASS == 0 ? 4 : 16;
        const int r = PASS == 0 ? (task & 3) : (task & 15), blk = PASS == 0 ? ((task >> 2) & 63) : ((task >> 4) & 15), hh = (task >> 8) & 15, b = task >> 12;
        const bf16_t* base = proj + (size_t)b * SEQ * 3072 + hh * 64;
        const int t0 = (PASS == 0 ? 128 : 512) * blk + r;
        bf16x8 qf[4];
        { const bf16_t* qp = base + (size_t)(t0 + QST * i32) * 3072 + 8 * hi;
#pragma unroll
          for (int d0 = 0; d0 < 4; ++d0) qf[d0] = *(const bf16x8*)(qp + 16 * d0); }
        float m_run = NEG, l_run = 0.f;
        f32x16 o0, o1;
#pragma unroll
        for (int q = 0; q < 16; ++q) { o0[q] = 0.f; o1[q] = 0.f; }
        const size_t srow = (size_t)(b * SEQ + t0 + QST * i32);
        if (PASS == 1) {
            const float2 mlv = ml[srow * NH + hh]; m_run = mlv.x; l_run = hi == 0 ? mlv.y : 0.f;
            const bf16_t* sp = ost + srow * D + hh * 64 + 4 * hi;
#pragma unroll
            for (int gq = 0; gq < 4; ++gq) { const u32x2 w0 = *(const u32x2*)(sp + 8 * gq), w1 = *(const u32x2*)(sp + 32 + 8 * gq);
                o0[4 * gq] = bf_lo(w0.x); o0[4 * gq + 1] = bf_hi(w0.x); o0[4 * gq + 2] = bf_lo(w0.y); o0[4 * gq + 3] = bf_hi(w0.y);
                o1[4 * gq] = bf_lo(w1.x); o1[4 * gq + 1] = bf_hi(w1.x); o1[4 * gq + 2] = bf_lo(w1.y); o1[4 * gq + 3] = bf_hi(w1.y); }
        }
#define AT_PAT(j) (PASS == 1 ? 0 : ((j) < 5 ? 0 : 1))
#define AT_KT(j) (PASS == 1 ? (j) : ((j) < 5 ? (j) : (j) - 5))
#define AT_DIL(j) (PASS == 1 ? 16 : (AT_PAT(j) == 0 ? 4 : 1))
#define AT_QS(j) (PASS == 1 ? 1 : (AT_PAT(j) == 0 ? 1 : 4))
#define AT_RR(j) (PASS == 1 ? r : (AT_PAT(j) == 0 ? r : 0))
        u32x4 kr[NR][4], vr[NR][4];
        auto issue = [&](int j, u32x4 (&kk)[4], u32x4 (&vv)[4]) {
            const int dil = AT_DIL(j), rr = AT_RR(j), Mt = (t0 - rr) / dil - 128 + 32 * AT_KT(j);
            auto keypos = [&](int M) { int p = dil * M + rr; p = p < 0 ? 0 : p; p = p > seqmax ? seqmax : p; return p; };
#pragma unroll
            for (int q = 0; q < 4; ++q) {
                const bf16_t* rp = base + (size_t)keypos(Mt + 8 * q + lrow) * 3072;
                kk[q] = *(const u32x4*)(rp + 1024 + 8 * (lpc ^ lrow));
                vv[q] = *(const u32x4*)(rp + 2048 + 8 * lpc);
            }
        };
#pragma unroll
        for (int j = 0; j < PD; ++j) issue(j, kr[j], vr[j]);
#pragma unroll
        for (int j = 0; j < NT; ++j) {
            if (j + PD < NT) issue(j + PD, kr[(j + PD) % NR], vr[(j + PD) % NR]);
            const int kt = AT_KT(j), dil = AT_DIL(j), rr = AT_RR(j), Mstart = (t0 - rr) / dil - 128, qi = AT_QS(j) * i32;
            f32x16 s;
#pragma unroll
            for (int q = 0; q < 16; ++q) s[q] = 0.f;
#pragma unroll
            for (int q = 0; q < 4; ++q) *(LAS u32x4*)(kbuf + (j & 1) * 4096 + q * 1024 + lane * 16) = kr[j % NR][q];
            bf16x8 kf[4];
#pragma unroll
            for (int d0 = 0; d0 < 4; ++d0) kf[d0] = *(const LAS bf16x8*)(kbuf + (j & 1) * 4096 + (i32 >> 3) * 1024 + (i32 & 7) * 128 + (((2 * d0 + hi) ^ (i32 & 7)) << 4));
#pragma unroll
            for (int d0 = 0; d0 < 4; ++d0) s = __builtin_amdgcn_mfma_f32_32x32x16_bf16(kf[d0], qf[d0], s, 0, 0, 0);
            const int hi_ = qi + 128 - 32 * kt; int lo = hi_ - 128; { const int nk = -(Mstart + 32 * kt); lo = lo > nk ? lo : nk; }
            const int rb = 4 * hi - lo; const unsigned span = (unsigned)(hi_ - lo);
            const bool any = hi_ >= lo;
            float tmax = NEG;
#pragma unroll
            for (int q = 0; q < 16; ++q) { const int rowc = (q & 3) + 8 * (q >> 2); const bool ok = any && ((unsigned)(rowc + rb) <= span) && (rowc + rb >= 0); s[q] = ok ? s[q] : NEG; tmax = fmaxf(tmax, s[q]); }
            tmax = fmaxf(tmax, __shfl_xor(tmax, 32));
            const float m_new = fmaxf(m_run, tmax), sc = __builtin_amdgcn_exp2f(m_run - m_new);
            m_run = m_new;
            float ps = 0.f;
#pragma unroll
            for (int q = 0; q < 16; ++q) { s[q] = __builtin_amdgcn_exp2f(s[q] - m_new); ps += s[q]; }
            l_run = l_run * sc + ps;
#pragma unroll
            for (int q = 0; q < 16; ++q) { o0[q] *= sc; o1[q] *= sc; }
            u32x4 pw0, pw1;
            pw0.x = cvt_pk_bf16(s[0], s[1]); pw0.y = cvt_pk_bf16(s[2], s[3]); pw0.z = cvt_pk_bf16(s[4], s[5]); pw0.w = cvt_pk_bf16(s[6], s[7]);
            pw1.x = cvt_pk_bf16(s[8], s[9]); pw1.y = cvt_pk_bf16(s[10], s[11]); pw1.z = cvt_pk_bf16(s[12], s[13]); pw1.w = cvt_pk_bf16(s[14], s[15]);
            const bf16x8 pf0 = __builtin_bit_cast(bf16x8, pw0), pf1 = __builtin_bit_cast(bf16x8, pw1);
#pragma unroll
            for (int q = 0; q < 4; ++q) *(LAS u32x4*)(vbuf + (j & 1) * 4096 + ((lpc >> 2) * 2 + (q >> 1)) * 1024 + ((q & 1) * 8 + lrow) * 64 + (lpc & 3) * 16) = vr[j % NR][q];
            const LAS unsigned char* vb = vbuf + (j & 1) * 4096 + vrd;
#pragma unroll
            for (int dh = 0; dh < 2; ++dh) {
#pragma unroll
                for (int kg = 0; kg < 2; ++kg) {
                    const v4i16_t vlo = vtr16(vb + (dh * 2 + kg) * 1024), vhi = vtr16(vb + (dh * 2 + kg) * 1024 + 512);
                    const bf16x8 vf = (bf16x8){vlo[0], vlo[1], vlo[2], vlo[3], vhi[0], vhi[1], vhi[2], vhi[3]};
                    if (dh == 0) o0 = __builtin_amdgcn_mfma_f32_32x32x16_bf16(vf, kg == 0 ? pf0 : pf1, o0, 0, 0, 0);
                    else o1 = __builtin_amdgcn_mfma_f32_32x32x16_bf16(vf, kg == 0 ? pf0 : pf1, o1, 0, 0, 0);
                }
            }
        }
#undef AT_PAT
#undef AT_KT
#undef AT_DIL
#undef AT_QS
#undef AT_RR
        const float lt = l_run + __shfl_xor(l_run, 32), rl = PASS == 1 ? 1.0f / lt : 1.0f;
        if (PASS == 0 && hi == 0) ml[srow * NH + hh] = make_float2(m_run, lt);
        bf16_t* op = (PASS == 1 ? att : ost) + srow * D + hh * 64 + 4 * hi;
#pragma unroll
        for (int gq = 0; gq < 4; ++gq) {
            u32x2 w0, w1;
            w0.x = cvt_pk_bf16(o0[4 * gq] * rl, o0[4 * gq + 1] * rl); w0.y = cvt_pk_bf16(o0[4 * gq + 2] * rl, o0[4 * gq + 3] * rl);
            w1.x = cvt_pk_bf16(o1[4 * gq] * rl, o1[4 * gq + 1] * rl); w1.y = cvt_pk_bf16(o1[4 * gq + 2] * rl, o1[4 * gq + 3] * rl);
            *(u32x2*)(op + 8 * gq) = w0; *(u32x2*)(op + 32 + 8 * gq) = w1;
        }
    }
}

__device__ __forceinline__ void phase_ln_router(const Ctx& X, int layer, const bf16_t* hin, const bf16_t* mixo, const float* g, const float* bta, const float* rb, bf16_t* h1) {
    using pg8::bf16x8;
    LAS unsigned char* Ah = X.lds;
    LAS unsigned char* Al = X.lds + 65536;
    LAS float* P = (LAS float*)X.lds;
    LAS int* s_cnt = (LAS int*)(X.lds + TAB_OFF);
    LAS int* s_gb = s_cnt + 32;
    const int lane = X.lane, w = X.wave, tok = lane & 31, hi = lane >> 5;
    int* tok_e = (int*)(X.ws + WS_TOKE); int* tok_r = (int*)(X.ws + WS_TOKR); float* glist = (float*)(X.ws + WS_GLIST); unsigned char* XG8 = (unsigned char*)(X.ws + WS_XG);
    unsigned* cnt = X.ctl + CW_CNT + layer * 32 * 64;
    const float rbe = rb[tok]; const float ninf = opaque_f(-INFINITY);
    const auto rs_h = __builtin_amdgcn_make_buffer_rsrc((void*)hin, 0, -1, 0x00020000), rs_m = __builtin_amdgcn_make_buffer_rsrc((void*)mixo, 0, -1, 0x00020000);
#define LNA_LD(rs_, tokidx_, j_) __builtin_bit_cast(u32x4, __builtin_amdgcn_raw_buffer_load_b128(rs_, lane * 16, (tokidx_) * (D * 2) + (j_) * 1024, 0))
    const int tb = X.bid * 128;
    if (tb < T) {
        u32x4 raw[4][4];
#pragma unroll
        for (int tl = 0; tl < 4; ++tl) { const int ti_ = __builtin_amdgcn_readfirstlane(tb + w * 4 + tl);
#pragma unroll
            for (int j = 0; j < 2; ++j) { raw[tl][2 * j] = LNA_LD(rs_h, ti_, j); raw[tl][2 * j + 1] = LNA_LD(rs_m, ti_, j); } }
#pragma nounroll
        for (int rnd = 0; rnd < 4; ++rnd) {
            __syncthreads();
            if (X.tid < 32) s_cnt[X.tid] = 0;
            const int t0 = tb + rnd * 32 + w * 4;
            int lane_o = lane; asm volatile("" : "+v"(lane_o));
            const int tok_o = lane_o & 31, hi_o = lane_o >> 5;
            float v[4][16]; u32x2 xo[4][2];
            const float* g2 = g; const float* b2 = bta; asm volatile("" : "+s"(g2), "+s"(b2));
#pragma unroll
            for (int tl = 0; tl < 4; ++tl) {
                const size_t rowo = (size_t)(t0 + tl) * D;
                float s = 0.f;
#pragma unroll
                for (int j = 0; j < 2; ++j) { float a[8], m[8]; unpack8(raw[tl][2 * j], a); unpack8(raw[tl][2 * j + 1], m);
#pragma unroll
                    for (int q = 0; q < 8; ++q) { v[tl][j * 8 + q] = DN_ALPHA * a[q] + m[q]; s += v[tl][j * 8 + q]; } }
                const float mean = wave_sum(s) * (1.f / D); float s2 = 0.f;
#pragma unroll
                for (int q = 0; q < 16; ++q) { v[tl][q] -= mean; s2 += v[tl][q] * v[tl][q]; }
                const float rstd = rsqrtf(wave_sum(s2) * (1.f / D) + opaque_f(LN_EPS));
#pragma unroll
                for (int j = 0; j < 2; ++j) { const f32x4 g0 = *(const f32x4*)(g2 + j * 512 + lane * 8), g1 = *(const f32x4*)(g2 + j * 512 + lane * 8 + 4), b0 = *(const f32x4*)(b2 + j * 512 + lane * 8), b1 = *(const f32x4*)(b2 + j * 512 + lane * 8 + 4);
#pragma unroll
                    for (int q = 0; q < 4; ++q) { v[tl][j * 8 + q] = v[tl][j * 8 + q] * rstd * g0[q] + b0[q]; v[tl][j * 8 + 4 + q] = v[tl][j * 8 + 4 + q] * rstd * g1[q] + b1[q]; } }
                xo[tl][0].x = pk4_fp8(v[tl][0], v[tl][1], v[tl][2], v[tl][3]); xo[tl][0].y = pk4_fp8(v[tl][4], v[tl][5], v[tl][6], v[tl][7]);
                xo[tl][1].x = pk4_fp8(v[tl][8], v[tl][9], v[tl][10], v[tl][11]); xo[tl][1].y = pk4_fp8(v[tl][12], v[tl][13], v[tl][14], v[tl][15]);
                const int tr = w * 4 + tl;
#pragma unroll
                for (int j = 0; j < 2; ++j) {
                    u32x4 oh, ol; float lo[8];
                    oh.x = cvt_pk_bf16(v[tl][j * 8 + 0], v[tl][j * 8 + 1]); oh.y = cvt_pk_bf16(v[tl][j * 8 + 2], v[tl][j * 8 + 3]); oh.z = cvt_pk_bf16(v[tl][j * 8 + 4], v[tl][j * 8 + 5]); oh.w = cvt_pk_bf16(v[tl][j * 8 + 6], v[tl][j * 8 + 7]);
                    float hf[8]; unpack8(oh, hf);
#pragma unroll
                    for (int q = 0; q < 8; ++q) lo[q] = v[tl][j * 8 + q] - hf[q];
                    ol = pack8(lo);
                    *(u32x4*)(h1 + rowo + j * 512 + lane * 8) = oh;
                    const int ch = ((lane_o + 64 * j) ^ (tr & 7)) << 4;
                    *(LAS u32x4*)(Ah + tr * 2048 + ch) = oh; *(LAS u32x4*)(Al + tr * 2048 + ch) = ol;
                }

            }
            if (rnd < 3) {
#pragma unroll
                for (int tl = 0; tl < 4; ++tl) { const int ti_ = __builtin_amdgcn_readfirstlane(t0 + 32 + tl);
#pragma unroll
                    for (int j = 0; j < 2; ++j) { raw[tl][2 * j] = LNA_LD(rs_h, ti_, j); raw[tl][2 * j + 1] = LNA_LD(rs_m, ti_, j); } } }
            bf16x8 wfh[8], wfl[8];
            { const bf16_t* rwh = (const bf16_t*)(X.ws + WS_RWH) + ((size_t)layer * NE + tok) * D + 128 * w + 8 * hi; const bf16_t* rwl = (const bf16_t*)(X.ws + WS_RWL) + ((size_t)layer * NE + tok) * D + 128 * w + 8 * hi;
#pragma unroll
              for (int i = 0; i < 8; ++i) { wfh[i] = *(const bf16x8*)(rwh + 16 * i); wfl[i] = *(const bf16x8*)(rwl + 16 * i); } }
            __syncthreads();
            f32x16 acc;
#pragma unroll
            for (int q = 0; q < 16; ++q) acc[q] = 0.f;
#pragma unroll
            for (int i = 0; i < 8; ++i) {
                const int ch = ((2 * (8 * w + i) + hi_o) ^ (tok_o & 7)) << 4;
                const bf16x8 bh = *(const LAS bf16x8*)(Ah + tok_o * 2048 + ch), bl = *(const LAS bf16x8*)(Al + tok_o * 2048 + ch);
                acc = __builtin_amdgcn_mfma_f32_32x32x16_bf16(wfh[i], bh, acc, 0, 0, 0);
                acc = __builtin_amdgcn_mfma_f32_32x32x16_bf16(wfl[i], bh, acc, 0, 0, 0);
                acc = __builtin_amdgcn_mfma_f32_32x32x16_bf16(wfh[i], bl, acc, 0, 0, 0);
            }
            __syncthreads();
#pragma unroll
            for (int q = 0; q < 16; ++q) P[(w * 32 + tok) * 33 + (q & 3) + 8 * (q >> 2) + 4 * hi] = acc[q];
            __syncthreads();
            float lg[4];
#pragma unroll
            for (int tl = 0; tl < 4; ++tl) { float a = 0.f;
#pragma unroll
                for (int ww = 0; ww < 4; ++ww) a += P[((hi * 4 + ww) * 32 + (w * 4 + tl)) * 33 + tok];
                a += __shfl_xor(a, 32); lg[tl] = a + rbe; }
            const int e = tok;
            int my_e = 0; float my_g = 0.f;
#pragma unroll
            for (int tl = 0; tl < 4; ++tl) {
                float cur = lg[tl];
                float sv0 = 0.f, sv1 = 0.f, sv2 = 0.f, sv3 = 0.f; int si0 = 0, si1 = 0, si2 = 0, si3 = 0;
#pragma unroll
                for (int k = 0; k < 4; ++k) {
                    float bv = cur; int bi = e;
#pragma unroll
                    for (int o = 1; o < 32; o <<= 1) { const float ov = __shfl_xor(bv, o); const int oi = __shfl_xor(bi, o); if (ov > bv || (ov == bv && oi < bi)) { bv = ov; bi = oi; } }
                    if (k == 0) { sv0 = bv; si0 = bi; } else if (k == 1) { sv1 = bv; si1 = bi; } else if (k == 2) { sv2 = bv; si2 = bi; } else { sv3 = bv; si3 = bi; }
                    if (e == bi) cur = ninf;
                }
                const float e1 = __expf(sv1 - sv0), e2 = __expf(sv2 - sv0), e3 = __expf(sv3 - sv0), inv = 1.f / (1.f + e1 + e2 + e3);
                if ((lane >> 2) == tl) { const int k = lane & 3; my_e = k == 0 ? si0 : k == 1 ? si1 : k == 2 ? si2 : si3; my_g = (k == 0 ? 1.f : k == 1 ? e1 : k == 2 ? e2 : e3) * inv; }
            }
            int my_lr = 0;
            if (lane < 16) my_lr = __hip_atomic_fetch_add(&s_cnt[my_e], 1, __ATOMIC_RELAXED, __HIP_MEMORY_SCOPE_WORKGROUP);
            __syncthreads();
            { int tid_o = X.tid; asm volatile("" : "+v"(tid_o));
              if (tid_o < 32) { const int c = s_cnt[tid_o]; s_gb[tid_o] = c ? (int)atomicAdd(cnt + tid_o * 64, (unsigned)c) : 0; } }
            __syncthreads();
            int my_r = 0;
            if (lane < 16) { my_r = s_gb[my_e] + my_lr; const int t = t0 + (lane >> 2); tok_e[t * 4 + (lane & 3)] = my_e; tok_r[t * 4 + (lane & 3)] = my_r; glist[(size_t)my_e * T + my_r] = my_g; }
#pragma unroll
            for (int tl = 0; tl < 4; ++tl) {
#pragma unroll
                for (int k = 0; k < 4; ++k) { const int ee = __shfl(my_e, tl * 4 + k), rr = __shfl(my_r, tl * 4 + k);
                    unsigned char* dst = XG8 + ((size_t)ee * T + rr) * D + lane * 8;
                    *(u32x2*)(dst) = xo[tl][0]; *(u32x2*)(dst + 512) = xo[tl][1]; }
            }
        }
    }
}
#undef LNA_LD

__device__ __forceinline__ void load_tile_table(const Ctx& X, int layer, LAS int* tb) {
    __syncthreads();
    if (X.tid < 64) {
        const int c = X.tid < 32 ? (int)__hip_atomic_load(X.ctl + CW_CNT + (layer * 32 + X.tid) * 64, RLX_AGENT) : 0;
        const int tl = (c + 255) >> 8; int incl = tl;
#pragma unroll
        for (int o = 1; o < 32; o <<= 1) { const int t = __shfl_up(incl, o); if ((X.tid & 31) >= o) incl += t; }
        if (X.tid < 32) { tb[X.tid] = incl - tl; if (X.tid == 31) tb[32] = incl; }
    }
    __syncthreads();
}

template <bool OUT_F32>
__device__ __forceinline__ void phase_combine_ln(const Ctx& X, int layer, const bf16_t* h1, const bf16_t* Y, const float* g, const float* bta, void* outp) {
    const int lane = X.lane;
    const int gw = X.bid * NWAVES + X.wave, NGW = X.G * NWAVES;
    const int* tok_e = (const int*)(X.ws + WS_TOKE); const int* tok_r = (const int*)(X.ws + WS_TOKR);
    int basev = 0;
    { const int c = lane < 32 ? (int)__hip_atomic_load(X.ctl + CW_CNT + (layer * 32 + lane) * 64, RLX_AGENT) : 0; const int pc = ((c + 255) >> 8) << 8; int incl = pc;
#pragma unroll
      for (int o = 1; o < 32; o <<= 1) { const int t = __shfl_up(incl, o); if ((lane & 31) >= o) incl += t; }
      basev = incl - pc; }
    float gg[16], bb[16];
#pragma unroll
    for (int j = 0; j < 2; ++j) {
        const f32x4 g0 = *(const f32x4*)(g + j * 512 + lane * 8), g1 = *(const f32x4*)(g + j * 512 + lane * 8 + 4), b0 = *(const f32x4*)(bta + j * 512 + lane * 8), b1 = *(const f32x4*)(bta + j * 512 + lane * 8 + 4);
#pragma unroll
        for (int q = 0; q < 4; ++q) { gg[j * 8 + q] = g0[q]; gg[j * 8 + 4 + q] = g1[q]; bb[j * 8 + q] = b0[q]; bb[j * 8 + 4 + q] = b1[q]; }
    }
    for (int bt = gw; bt < T; bt += NGW) {
        int myslot = 0;
        if (lane < 4) myslot = tok_r[bt * 4 + lane];
        const int mye = lane < 4 ? tok_e[bt * 4 + lane] : 0;
        myslot += __shfl(basev, mye);
        const int s0 = __shfl(myslot, 0), s1 = __shfl(myslot, 1), s2 = __shfl(myslot, 2), s3 = __shfl(myslot, 3);
        float v[16]; float s = 0.f;
#pragma unroll
        for (int j = 0; j < 2; ++j) {
            const int off = j * 512 + lane * 8;
            float a[8], y0[8], y1[8], y2[8], y3[8];
            unpack8(*(const u32x4*)(h1 + (size_t)bt * D + off), a);
            const unsigned char* Y8 = (const unsigned char*)Y;
            unpack8_fp8(*(const u32x2*)(Y8 + (size_t)s0 * D + off), y0); unpack8_fp8(*(const u32x2*)(Y8 + (size_t)s1 * D + off), y1); unpack8_fp8(*(const u32x2*)(Y8 + (size_t)s2 * D + off), y2); unpack8_fp8(*(const u32x2*)(Y8 + (size_t)s3 * D + off), y3);
#pragma unroll
            for (int q = 0; q < 8; ++q) { v[j * 8 + q] = DN_ALPHA * a[q] + (((y0[q] + y1[q]) + y2[q]) + y3[q]) * (1.0f / Y8_SCALE); s += v[j * 8 + q]; }
        }
        const float mean = wave_sum(s) * (1.f / D); float s2q = 0.f;
#pragma unroll
        for (int q = 0; q < 16; ++q) { v[q] -= mean; s2q += v[q] * v[q]; }
        const float rstd = rsqrtf(wave_sum(s2q) * (1.f / D) + opaque_f(LN_EPS));
#pragma unroll
        for (int q = 0; q < 16; ++q) v[q] = v[q] * rstd * gg[q] + bb[q];
#pragma unroll
        for (int j = 0; j < 2; ++j) {
            const size_t o = (size_t)bt * D + j * 512 + lane * 8;
            if (OUT_F32) { float* op = (float*)outp + o; *(f32x4*)(op) = (f32x4){v[j * 8 + 0], v[j * 8 + 1], v[j * 8 + 2], v[j * 8 + 3]}; *(f32x4*)(op + 4) = (f32x4){v[j * 8 + 4], v[j * 8 + 5], v[j * 8 + 6], v[j * 8 + 7]}; }
            else { u32x4 w; w.x = cvt_pk_bf16(v[j * 8 + 0], v[j * 8 + 1]); w.y = cvt_pk_bf16(v[j * 8 + 2], v[j * 8 + 3]); w.z = cvt_pk_bf16(v[j * 8 + 4], v[j * 8 + 5]); w.w = cvt_pk_bf16(v[j * 8 + 6], v[j * 8 + 7]); *(u32x4*)((bf16_t*)outp + o) = w; }
        }
    }
}


__device__ __forceinline__ Ctx refresh_ctx(const Ctx& X0) {
    Ctx X = X0; int wv = X0.wave; asm volatile("" : "+s"(wv)); int t = wv * 64 + lane_id(); asm volatile("" : "+v"(t)); X.tid = t; X.lane = t & 63; X.wave = wv;
    asm volatile("" : "+s"(X.ws), "+s"(X.ctl), "+s"(X.G), "+s"(X.bid));
    return X;
}
struct Args { const float* in[26]; float* out; unsigned char* ws; int ph_lo, ph_hi; };
constexpr int N_PHASES = 1 + 2 * (6 + 4) + 2 * (4 + 4);
#define GP_ALIGN true
#define GP_SP2 true

__global__ void __launch_bounds__(NTHR, 2) mk_fwd(Args args) {
    extern __shared__ __attribute__((aligned(16))) unsigned char lds_raw[];
    Ctx X0;
    X0.lds = (LAS unsigned char*)lds_raw;
    X0.tid = threadIdx.x; X0.lane = X0.tid & 63; X0.wave = __builtin_amdgcn_readfirstlane(X0.tid >> 6);
    X0.G = gridDim.x; X0.bid = blockIdx.x;
    X0.ws = (GAS unsigned char*)args.ws; X0.ctl = (unsigned*)(args.ws + WS_CTL);
    volatile LAS unsigned* MISC = (volatile LAS unsigned*)(X0.lds + MISC_OFF);
    if (X0.tid < 32) MISC[X0.tid] = 0u;
    __syncthreads();
    XcdBarrier bar; bar.bar = X0.ctl + CW_BAR; bar.x = 0; bar.st = nullptr;
    if (MK_ONE_LAUNCH) bar = xcd_barrier_post(X0.ctl + CW_BAR, MISC + 8);
    volatile LAS unsigned long long* ptab = (volatile LAS unsigned long long*)(X0.lds + TAB_OFF + 1024);
    if (X0.tid < 26) ptab[X0.tid] = (unsigned long long)args.in[X0.tid];
    __syncthreads();
#define INP(k) ld_ptr(ptab, k)
    const int lo = args.ph_lo, hi = args.ph_hi;
    int ph = 0;
#define IN() (lo <= ph && ph < hi)
#define SEAM() do { if (MK_ONE_LAUNCH && lo <= ph && ph + 1 < hi) xcd_barrier(bar); ++ph; } while (0)

#define H0 ((bf16_t*)(X.ws + WS_H0))
#define H1 ((bf16_t*)(X.ws + WS_H1))
#define PROJ ((bf16_t*)(X.ws + WS_PROJ))
#define MIX ((bf16_t*)(X.ws + WS_MIX))
#define MIXO ((bf16_t*)(X.ws + WS_MIXO))
#define Z ((bf16_t*)(X.ws + WS_Z))
#define ACT ((bf16_t*)(X.ws + WS_ACT))
#define Y ((bf16_t*)(X.ws + WS_Y))
#define tb ((LAS int*)(X.lds + TAB_OFF + 512))

#ifndef DUP_MASK
#define DUP_MASK 0
#endif
    enum { P_PRO, P_E1, P_S5A, P_S5C, P_S5B, P_E3, P_E4, P_O1, P_ATT, P_O3, P_LNA, P_M1, P_M2, P_LNB };
#define PHASE_BEGIN(k) _Pragma("nounroll") for (int _r = 0; _r < ((((DUP_MASK) >> (k)) & 1) + 1); ++_r) { if (IN()) { const Ctx X = refresh_ctx(X0);
#define PHASE_END } SEAM(); }
    PHASE_BEGIN(P_PRO)  phase_prologue(X, ptab);  PHASE_END

#pragma nounroll
    for (int layer = 0; layer < DEPTH; ++layer) {
        const int i = layer >> 1;
        if ((layer & 1) == 0) {
            PHASE_BEGIN(P_E1)  pg8::Gemm gm{H0, (const bf16_t*)(X.ws + WS_WIN) + (size_t)i * 2048 * D, T, 2048, D}; pg8::StaticOrder S; S.init(T, 2048, D, X.G, X.bid);
                pg8::EpiStore E{PROJ, 2048};
                pg8::gemm_phase<pg8::EpiStore, pg8::StaticOrder, GP_ALIGN, GP_SP2>(X.lds, gm, S, E, X.wave);  PHASE_END
            PHASE_BEGIN(P_S5A)  phase_s5<1>(X, i, PROJ, INP(2), INP(8), INP(9), INP(10), MIX, Z);  PHASE_END
            PHASE_BEGIN(P_S5C)  phase_s5_carry(X, i);  PHASE_END
            PHASE_BEGIN(P_S5B)  phase_s5<2>(X, i, PROJ, INP(2), INP(8), INP(9), INP(10), MIX, Z);  PHASE_END
            PHASE_BEGIN(P_E3)  pg8::Gemm gm{Z, (const bf16_t*)(X.ws + WS_WGLU) + (size_t)i * 512 * 512, T, 512, 512}; pg8::StaticOrder S; S.init(T, 512, 512, X.G, X.bid);
                pg8::EpiGlu E{Z, MIX, INP(12) + (size_t)i * SSM_W};
                pg8::gemm_phase<pg8::EpiGlu, pg8::StaticOrder, GP_ALIGN, GP_SP2>(X.lds, gm, S, E, X.wave);  PHASE_END
            PHASE_BEGIN(P_E4)  pg8::Gemm gm{MIX, (const bf16_t*)(X.ws + WS_WOUT) + (size_t)i * D * D, T, D, D}; pg8::StaticOrder S; S.init(T, D, D, X.G, X.bid);
                pg8::EpiStore E{MIXO, D};
                pg8::gemm_phase<pg8::EpiStore, pg8::StaticOrder, GP_ALIGN, GP_SP2>(X.lds, gm, S, E, X.wave);  PHASE_END
        } else {
            PHASE_BEGIN(P_O1)  pg8::Gemm gm{H0, (const bf16_t*)(X.ws + WS_WQKV) + (size_t)i * 3072 * D, T, 3072, D}; pg8::StaticOrder S; S.init(T, 3072, D, X.G, X.bid);
                pg8::EpiRope E{PROJ, (const f32x2*)(X.ws + WS_ROPE)};
                pg8::gemm_phase<pg8::EpiRope, pg8::StaticOrder, GP_ALIGN, GP_SP2>(X.lds, gm, S, E, X.wave);  PHASE_END
            PHASE_BEGIN(P_ATT)  phase_attn<0>(X, PROJ, MIX, MIXO, (float2*)(X.ws + WS_S5X));  PHASE_END
            PHASE_BEGIN(P_ATT)  phase_attn<1>(X, PROJ, MIX, MIXO, (float2*)(X.ws + WS_S5X));  PHASE_END
            PHASE_BEGIN(P_O3)  pg8::Gemm gm{MIX, (const bf16_t*)(X.ws + WS_WO) + (size_t)i * D * D, T, D, D}; pg8::StaticOrder S; S.init(T, D, D, X.G, X.bid);
                pg8::EpiStore E{MIXO, D};
                pg8::gemm_phase<pg8::EpiStore, pg8::StaticOrder, GP_ALIGN, GP_SP2>(X.lds, gm, S, E, X.wave);  PHASE_END
        }
        PHASE_BEGIN(P_LNA)  phase_ln_router(X, layer, H0, MIXO, INP(16) + layer * D, INP(17) + layer * D, INP(21) + layer * NE, H1);  PHASE_END
        PHASE_BEGIN(P_M1)  load_tile_table(X, layer, tb);
            pg8::Gemm gm{(const bf16_t*)(X.ws + WS_XG), (const bf16_t*)(X.ws + WS_WGU + (size_t)layer * NE * 2048 * D), 0, 2048, D / 2};
            pg8::MoeOrder<8, true> S; S.init(tb, X.G, X.bid, 2048, D / 2);
#ifdef PROBE_NOSTORE
            pg8::EpiSwiglu E{opaque_i(((DUP_MASK >> P_M1) & 1) && _r == 0) != 0, ACT, INP(23) + (size_t)layer * NE * 2048};
#else
            pg8::EpiSwiglu E{ACT, INP(23) + (size_t)layer * NE * 2048};
#endif
#if defined(PROBE_M1)
            if (_r == 0) pg8::gemm_phase<pg8::EpiSwiglu, pg8::MoeOrder<8, true>, GP_ALIGN, GP_SP2, true, PROBE_M1>(X.lds, gm, S, E, X.wave, opaque_i(127 - W8_SHIFT_GU), opaque_i(127)); else
#endif
            pg8::gemm_phase<pg8::EpiSwiglu, pg8::MoeOrder<8, true>, GP_ALIGN, GP_SP2, true>(X.lds, gm, S, E, X.wave, opaque_i(127 - W8_SHIFT_GU), opaque_i(127));  PHASE_END
        PHASE_BEGIN(P_M2)  load_tile_table(X, layer, tb);
            pg8::Gemm gm{ACT, (const bf16_t*)(X.ws + WS_WDN + (size_t)layer * NE * D * D), 0, D, D / 2};
            pg8::MoeOrder<4, false> S; S.init(tb, X.G, X.bid, D, D / 2);
#ifdef PROBE_NOSTORE
            pg8::EpiDown E{opaque_i(((DUP_MASK >> P_M2) & 1) && _r == 0) != 0, Y, INP(25) + (size_t)layer * NE * D, (const float*)(X.ws + WS_GLIST)};
#else
            pg8::EpiDown E{Y, INP(25) + (size_t)layer * NE * D, (const float*)(X.ws + WS_GLIST)};
#endif
#if defined(PROBE_M2)
            if (_r == 0) pg8::gemm_phase<pg8::EpiDown, pg8::MoeOrder<4, false>, GP_ALIGN, GP_SP2, true, PROBE_M2>(X.lds, gm, S, E, X.wave, opaque_i(127 - W8_SHIFT_DN), opaque_i(127)); else
#endif
            pg8::gemm_phase<pg8::EpiDown, pg8::MoeOrder<4, false>, GP_ALIGN, GP_SP2, true>(X.lds, gm, S, E, X.wave, opaque_i(127 - W8_SHIFT_DN), opaque_i(127));  PHASE_END
        PHASE_BEGIN(P_LNB)
            if (layer == DEPTH - 1) phase_combine_ln<true>(X, layer, H1, Y, INP(18) + layer * D, INP(19) + layer * D, (void*)args.out);
            else phase_combine_ln<false>(X, layer, H1, Y, INP(18) + layer * D, INP(19) + layer * D, (void*)H0);
         PHASE_END
    }
#undef IN
#undef SEAM
#undef PHASE_BEGIN
#undef PHASE_END
#undef H0
#undef H1
#undef PROJ
#undef MIX
#undef MIXO
#undef Z
#undef ACT
#undef Y
#undef tb
}

extern "C" void kernel_launch(void* const* d_in, const int* in_sizes, int n_in, void* d_out, int out_size, void* d_ws, size_t ws_size, hipStream_t stream) {
    static int grid = 0;
    if (grid == 0) {
        if (n_in != 26 || out_size != T * D || ws_size < WS_END) { fprintf(stderr, "kernel_launch: unexpected shapes n_in %d out %d ws %zu (need %zu)\n", n_in, out_size, ws_size, (size_t)WS_END); grid = -1; return; }
        int dev = 0, cus = 0, per_cu = 0;
        if (hipGetDevice(&dev) != hipSuccess || hipDeviceGetAttribute(&cus, hipDeviceAttributeMultiprocessorCount, dev) != hipSuccess) { grid = -1; return; }
        if (hipFuncSetAttribute((const void*)mk_fwd, hipFuncAttributeMaxDynamicSharedMemorySize, LDS_BYTES) != hipSuccess) { fprintf(stderr, "kernel_launch: hipFuncSetAttribute failed\n"); grid = -1; return; }
        if (hipOccupancyMaxActiveBlocksPerMultiprocessor(&per_cu, (const void*)mk_fwd, NTHR, LDS_BYTES) != hipSuccess || per_cu < 1) fprintf(stderr, "kernel_launch: occupancy query says %d\n", per_cu);
        (void)hipGetLastError();
        grid = cus;
        if (grid < 256) { fprintf(stderr, "kernel_launch: %d CUs; the LN+router phase deals one 128-token slab per workgroup and needs 256\n", cus); grid = -1; return; }
        if (grid > 256) grid = 256;
    }
    if (grid < 0) return;
    if (hipMemsetAsync((char*)d_ws + WS_CTL, 0, CTL_ZERO_BYTES, stream) != hipSuccess) return;
    Args a{};
    for (int i = 0; i < 26; ++i) a.in[i] = (const float*)d_in[i];
    a.out = (float*)d_out; a.ws = (unsigned char*)d_ws;
#if MK_ONE_LAUNCH
    a.ph_lo = 0; a.ph_hi = DUP_MASK ? 100000 : N_PHASES;
    hipLaunchKernelGGL(mk_fwd, dim3(grid), dim3(NTHR), LDS_BYTES, stream, a);
#else
    for (int p = 0; p < N_PHASES; ++p) { a.ph_lo = p; a.ph_hi = p + 1; hipLaunchKernelGGL(mk_fwd, dim3(grid), dim3(NTHR), LDS_BYTES, stream, a); }
#endif
}
```

```cpp
#include <hip/hip_runtime.h>
#include <cstdio>
#include <cstdint>

#ifndef MK_ONE_LAUNCH
#define MK_ONE_LAUNCH 1
#endif

#define GAS __attribute__((address_space(1)))
#define LAS __attribute__((address_space(3)))
#define RLX_AGENT __ATOMIC_RELAXED, __HIP_MEMORY_SCOPE_AGENT
#define WAVE_SYNC() asm volatile("s_waitcnt lgkmcnt(0)" ::: "memory")
typedef float f32x4 __attribute__((ext_vector_type(4)));
typedef float f32x2 __attribute__((ext_vector_type(2)));
typedef unsigned u32x4 __attribute__((ext_vector_type(4)));
typedef unsigned u32x2 __attribute__((ext_vector_type(2)));
typedef unsigned short bf16_t;

constexpr int BATCH = 4, SEQ = 8192, D = 1024, T = BATCH * SEQ, DEPTH = 4;
constexpr int CONV_CH = 512, SSM_W = 512, SSM_G = 32, SSM_H = 16, SSM_P = 64;
constexpr int NH = 16, HD = 64;
constexpr int NE = 32, TOPK = 4, NA = T * TOPK;
constexpr float SW_LIMIT = 7.0f, SW_ALPHA = 1.702f;
constexpr float LN_EPS = 1e-5f;
constexpr float DN_ALPHA = 1.6817928305074290860622509524664f;
constexpr int NWAVES = 8, NTHR = 512;

constexpr size_t MiB = 1u << 20;
constexpr size_t WS_CTL = 0, CTL_ZERO_BYTES = 1 * MiB;
constexpr size_t WS_S5A = 1 * MiB;
constexpr size_t WS_S5B = 1 * MiB + 65536;
constexpr size_t WS_ROPE = 2 * MiB;
constexpr size_t WS_S5X = 48 * MiB;
constexpr size_t WS_TOKE = 4 * MiB;
constexpr size_t WS_TOKR = 4 * MiB + 524288;
constexpr size_t WS_RWH = 5 * MiB;
constexpr size_t WS_RWL = 5 * MiB + 262144;
constexpr size_t WS_GLIST = 8 * MiB;
constexpr size_t WS_S5S = 12 * MiB;
constexpr size_t WS_WIN = 16 * MiB;
constexpr size_t WS_WGLU = 24 * MiB;
constexpr size_t WS_WOUT = 26 * MiB;
constexpr size_t WS_WQKV = 32 * MiB;
constexpr size_t WS_WO = 44 * MiB;
constexpr size_t WS_WGU = 64 * MiB;
constexpr size_t WS_WDN = 576 * MiB;
constexpr size_t WS_H0 = 832 * MiB;
constexpr size_t WS_H1 = 896 * MiB;
constexpr size_t WS_PROJ = 960 * MiB;
constexpr size_t WS_MIX = 1152 * MiB;
constexpr size_t WS_MIXO = 1216 * MiB;
constexpr size_t WS_Z = 1280 * MiB;
constexpr size_t WS_ACT = 1312 * MiB;
constexpr size_t WS_Y = 1584 * MiB;
constexpr size_t WS_XG = 1856 * MiB;
constexpr size_t WS_END = 3904 * MiB;
constexpr int CW_BAR = 4096;
constexpr int CW_CNT = 16384;

constexpr int LDS_BYTES = 147456;
constexpr int MISC_OFF = 131072 + 320;
constexpr int TAB_OFF = 131072 + 1024;

#define XB_TMO      128
#define XB_XCNT(j)  (256  + 64 * (j))
#define XB_XSUB(j)  (1280 + 64 * (j))
#define XB_XGEN(j)  (2304 + 64 * (j))
#define XB_TOP      3328
#define XB_TOPGEN   3392
#define XCD_BAR_WORDS 3456
#define XB_SPIN_CAP (1u << 22)

__device__ __forceinline__ unsigned xb_ld(unsigned* p)              { return __hip_atomic_load(p, __ATOMIC_RELAXED, __HIP_MEMORY_SCOPE_AGENT); }
__device__ __forceinline__ unsigned xb_add(unsigned* p, unsigned v) { return __hip_atomic_fetch_add(p, v, __ATOMIC_RELAXED, __HIP_MEMORY_SCOPE_AGENT); }
__device__ __forceinline__ unsigned xb_xcc_id() { return (unsigned)__builtin_amdgcn_s_getreg((3 << 11) | 20) & 0xFu; }
#define XB_SPIN(cond, bar) do { unsigned _sp = 0; while (cond) { __builtin_amdgcn_s_sleep(1); \
    if ((++_sp & 255u) == 0u) { if (xb_ld(&(bar)[XB_TMO])) break; if (_sp > XB_SPIN_CAP) { atomicAdd(&(bar)[XB_TMO], 1u); break; } } } } while (0)

struct XcdBarrier { unsigned* bar; unsigned x; volatile LAS unsigned* st; int wave; };
__device__ __forceinline__ int xb_lane() { int l; asm volatile("v_mbcnt_lo_u32_b32 %0, -1, 0\n\tv_mbcnt_hi_u32_b32 %0, -1, %0" : "=v"(l)); return l; }

__device__ __forceinline__ XcdBarrier xcd_barrier_post(unsigned* bar, volatile LAS unsigned* st, int wave) {
    XcdBarrier b; b.bar = bar; b.x = xb_xcc_id(); b.st = st; b.wave = wave;
    if (wave == 0 && xb_lane() == 0) (void)xb_add(&bar[XB_XCNT(b.x)], 1u);
    return b;
}
__device__ __forceinline__ void xcd_barrier_complete(unsigned* bar, unsigned x, unsigned& nloc, unsigned& nx) {
    const unsigned G = gridDim.x * gridDim.y * gridDim.z;
    unsigned sum, cnt, mine, sp = 0u;
    for (;;) {
        sum = 0u; cnt = 0u; mine = 0u;
#pragma unroll
        for (unsigned j = 0; j < 16; ++j) { const unsigned c = xb_ld(&bar[XB_XCNT(j)]); sum += c; cnt += (c > 0u) ? 1u : 0u; mine = (j == x) ? c : mine; }
        if (sum == G) break;
        __builtin_amdgcn_s_sleep(1);
        if ((++sp & 255u) == 0u) { if (xb_ld(&bar[XB_TMO])) break; if (sp > XB_SPIN_CAP) { atomicAdd(&bar[XB_TMO], 1u); break; } }
    }
    nloc = mine > 0u ? mine : 1u; nx = cnt > 0u ? cnt : 1u;
}
__device__ __forceinline__ void xcd_barrier(const XcdBarrier& b) {
    asm volatile("s_waitcnt vmcnt(0)" ::: "memory");
    __syncthreads();
    if (b.wave == 0 && xb_lane() == 0) {
        unsigned* bar = b.bar;
        __builtin_amdgcn_s_waitcnt(0);
        unsigned nloc = b.st[0], nx = b.st[1];
        if (nloc == 0u) { xcd_barrier_complete(bar, b.x, nloc, nx); b.st[0] = nloc; b.st[1] = nx; }
        const unsigned old = xb_add(&bar[XB_XSUB(b.x)], 1u);
        const unsigned gen = old / nloc;
        if (old + 1u == (gen + 1u) * nloc) {
            __builtin_amdgcn_fence(__ATOMIC_RELEASE, "agent");
            asm volatile("s_waitcnt vmcnt(0)" ::: "memory");
            const unsigned og = xb_add(&bar[XB_TOP], 1u);
            const unsigned tg = og / nx;
            if (og + 1u == (tg + 1u) * nx) xb_add(&bar[XB_TOPGEN], 1u);
            else XB_SPIN(xb_ld(&bar[XB_TOPGEN]) == tg, bar);
            __builtin_amdgcn_fence(__ATOMIC_ACQUIRE, "agent");
            xb_add(&bar[XB_XGEN(b.x)], 1u);
            asm volatile("s_waitcnt vmcnt(0)" ::: "memory");
        } else {
            XB_SPIN(xb_ld(&bar[XB_XGEN(b.x)]) == gen, bar);
            __builtin_amdgcn_fence(__ATOMIC_ACQUIRE, "agent");
            asm volatile("s_waitcnt vmcnt(0)" ::: "memory");
        }
    }
    __syncthreads();
}

template <int M> __device__ __forceinline__ int swz_i(int v) { static_assert(M > 0 && M < 32, "ds_swizzle bit mode"); return __builtin_amdgcn_ds_swizzle(v, (M << 10) | 0x1f); }
template <int M> __device__ __forceinline__ float swz_f(float v) { return __builtin_bit_cast(float, swz_i<M>(__builtin_bit_cast(int, v))); }
__device__ __forceinline__ int bperm_i(int srclane, int v) { return __builtin_amdgcn_ds_bpermute(srclane << 2, v); }
__device__ __forceinline__ float bperm_f(int srclane, float v) { return __builtin_bit_cast(float, __builtin_amdgcn_ds_bpermute(srclane << 2, __builtin_bit_cast(int, v))); }
__device__ __forceinline__ float rdlane_f(float v, int l) { return __builtin_bit_cast(float, __builtin_amdgcn_readlane(__builtin_bit_cast(int, v), l)); }
__device__ __forceinline__ float wave_sum(float v) {
    v += swz_f<1>(v); v += swz_f<2>(v); v += swz_f<4>(v); v += swz_f<8>(v); v += swz_f<16>(v);
    return rdlane_f(v, 0) + rdlane_f(v, 32);
}
__device__ __forceinline__ float wave_max(float v) {
    v = fmaxf(v, swz_f<1>(v)); v = fmaxf(v, swz_f<2>(v)); v = fmaxf(v, swz_f<4>(v)); v = fmaxf(v, swz_f<8>(v)); v = fmaxf(v, swz_f<16>(v));
    return fmaxf(rdlane_f(v, 0), rdlane_f(v, 32));
}
__device__ __forceinline__ float sigmoidf_(float x) { return __builtin_amdgcn_rcpf(1.0f + __builtin_amdgcn_exp2f(-1.4426950408889634f * x)); }
__device__ __forceinline__ float gelu_tanh(float y) { return y * sigmoidf_(1.5957691216057308f * (y + 0.044715f * y * y * y)); }
__device__ __forceinline__ float opaque_f(float v) { asm volatile("" : "+s"(v)); return v; }
__device__ __forceinline__ int opaque_i(int v) { asm volatile("" : "+s"(v)); return v; }
__device__ __forceinline__ int seqpos(int bt) { return bt - ((bt >> 13) << 13); }
__device__ __forceinline__ unsigned f2bf(float f) { unsigned u = __builtin_bit_cast(unsigned, f); return (u + 0x7fffu + ((u >> 16) & 1u)) >> 16; }
__device__ __forceinline__ unsigned pk2(float lo, float hi) { return f2bf(lo) | (f2bf(hi) << 16); }
typedef float f32x2_t_ __attribute__((ext_vector_type(2))); typedef __bf16 bf16x2_t_ __attribute__((ext_vector_type(2)));
__device__ __forceinline__ unsigned cvt_pk_bf16(float lo, float hi) { const f32x2_t_ v = {lo, hi}; const bf16x2_t_ b = __builtin_convertvector(v, bf16x2_t_); return __builtin_bit_cast(unsigned, b); }
__device__ __forceinline__ float bf_lo(unsigned w) { return __builtin_bit_cast(float, w << 16); }
__device__ __forceinline__ float bf_hi(unsigned w) { return __builtin_bit_cast(float, w & 0xffff0000u); }
__device__ __forceinline__ float bf2f(bf16_t b) { return __builtin_bit_cast(float, ((unsigned)b) << 16); }
__device__ __forceinline__ void unpack8(const u32x4 w, float (&f)[8]) { f[0] = bf_lo(w.x); f[1] = bf_hi(w.x); f[2] = bf_lo(w.y); f[3] = bf_hi(w.y); f[4] = bf_lo(w.z); f[5] = bf_hi(w.z); f[6] = bf_lo(w.w); f[7] = bf_hi(w.w); }
__device__ __forceinline__ u32x4 pack8(const float (&f)[8]) { u32x4 w; w.x = cvt_pk_bf16(f[0], f[1]); w.y = cvt_pk_bf16(f[2], f[3]); w.z = cvt_pk_bf16(f[4], f[5]); w.w = cvt_pk_bf16(f[6], f[7]); return w; }

__device__ __forceinline__ unsigned pk4_fp8(float a, float b, float c, float d) {
    int w = __builtin_amdgcn_cvt_pk_fp8_f32(a, b, 0, false); w = __builtin_amdgcn_cvt_pk_fp8_f32(c, d, w, true); return (unsigned)w; }
__device__ __forceinline__ u32x2 pack8_fp8(const float (&f)[8]) { u32x2 w; w.x = pk4_fp8(f[0], f[1], f[2], f[3]); w.y = pk4_fp8(f[4], f[5], f[6], f[7]); return w; }
typedef float f32x2v_ __attribute__((ext_vector_type(2)));
__device__ __forceinline__ void unpack8_fp8(const u32x2 w, float (&f)[8]) {
    const f32x2v_ a = __builtin_amdgcn_cvt_pk_f32_fp8((int)w.x, false), b = __builtin_amdgcn_cvt_pk_f32_fp8((int)w.x, true), c = __builtin_amdgcn_cvt_pk_f32_fp8((int)w.y, false), d = __builtin_amdgcn_cvt_pk_f32_fp8((int)w.y, true);
    f[0] = a.x; f[1] = a.y; f[2] = b.x; f[3] = b.y; f[4] = c.x; f[5] = c.y; f[6] = d.x; f[7] = d.y; }
constexpr float Y8_SCALE = 16.0f;
constexpr int W8_SHIFT_GU = 5, W8_SHIFT_DN = 6;

__device__ __forceinline__ int lane_id() { int l; asm volatile("v_mbcnt_lo_u32_b32 %0, -1, 0\n\tv_mbcnt_hi_u32_b32 %0, -1, %0" : "=v"(l)); return l; }

struct Ctx {
    LAS unsigned char* lds;
    int tid, lane, wave, G, bid;
    unsigned* ctl;
    GAS unsigned char* ws;
};

namespace pg8 {
#define PG8_LAS __attribute__((address_space(3)))
typedef short bf16x8 __attribute__((ext_vector_type(8)));
constexpr int BM = 256, BK = 64, HALF = 128, HTB = HALF * BK * 2  , STAGE_BYTES = 8 * HTB, NXCD = 8, WGM = 8;

__host__ __device__ __forceinline__ int lds_byte(int r, int c) { const int st = (r >> 4) * 2 + (c >> 5), rr = r & 15, cc = c & 31, ob = rr * 64 + cc * 2; return st * 1024 + (ob ^ (((ob >> 9) & 1) << 5)); }
__host__ __device__ __forceinline__ void stage_rc(int b, int& R, int& C) { const int st = b / 1024, sb = b % 1024, swz = sb ^ (((sb >> 9) & 1) << 5); R = (st >> 1) * 16 + swz / 64; C = (st & 1) * 32 + (swz % 64) / 2; }
__host__ __device__ __forceinline__ int perm32(int rho) { const int n = rho >> 4, i = rho & 15; return 8 * (i >> 2) + 4 * n + (i & 3); }

struct Unit { int pm, pn, e, mt; };
struct Gemm { const bf16_t* A; const bf16_t* Bt; int M, N, K; };

struct StaticOrder {
    int nM, nN, nwg, G, c; size_t tstep;
    __device__ void init(int M, int N, int K, int G_, int c_) { nM = M / BM; nN = N / BM; nwg = nM * nN; G = G_; c = c_; tstep = (size_t)BM * K * 2; }
    __device__ bool next(int i, Unit& u) const {
        const long L = (long)i * G + c; if (L >= nwg) return false;
        int wgid = (int)L; { const int q = nwg / NXCD, r = nwg % NXCD, xcd = wgid % NXCD, off = wgid / NXCD; wgid = (xcd < r ? xcd * (q + 1) : r * (q + 1) + (xcd - r) * q) + off; }
        const int nig = WGM * nN, gid = wgid / nig, fm = gid * WGM, gsz = (nM - fm) < WGM ? (nM - fm) : WGM;
        u.pm = fm + ((wgid % nig) % gsz); u.pn = (wgid % nig) / gsz; u.e = 0; u.mt = 0; return true;
    }
    __device__ __forceinline__ size_t a_off(const Unit& u) const { return (size_t)u.pm * tstep; }
    __device__ __forceinline__ size_t b_off(const Unit& u) const { return (size_t)u.pn * tstep; }
    __device__ __forceinline__ void a_ready(const Unit&) const {}
    __device__ __forceinline__ void done(const Unit&) const {}
};
template <int NPN, bool A_IS_XG> struct MoeOrder {
    const PG8_LAS int* tb; int G, c, ntile; size_t bexp, rowb;
    __device__ void init(const PG8_LAS int* tb_, int G_, int c_, int Nexp, int K) { tb = tb_; G = G_; c = c_; ntile = tb_[32]; rowb = (size_t)K * 2; bexp = (size_t)Nexp * rowb; }
    __device__ bool next(int i, Unit& u) const {
        int mtg, pn;
        if (G == 256) { constexpr int MPR = 256 / NPN, MPX = MPR / 8; mtg = MPR * i + MPX * (c & 7) + (c >> 3) / NPN; pn = (c >> 3) % NPN; }
        else { const long L = (long)i * G + c; mtg = (int)(L / NPN); pn = (int)(L % NPN); }
        if (mtg >= ntile) return false;
        int e = 0;
#pragma unroll
        for (int st = 16; st >= 1; st >>= 1) { const int tv = __builtin_amdgcn_readfirstlane(tb[e + st]); if (tv <= mtg) e += st; }
        u.pm = mtg; u.pn = pn; u.e = e; u.mt = mtg - tb[e]; return true;
    }
    __device__ __forceinline__ size_t a_off(const Unit& u) const { return A_IS_XG ? ((size_t)u.e * T + (size_t)u.mt * BM) * rowb : (size_t)u.pm * BM * rowb; }
    __device__ __forceinline__ size_t b_off(const Unit& u) const { return (size_t)u.e * bexp + (size_t)u.pn * BM * rowb; }
    __device__ __forceinline__ void a_ready(const Unit&) const {}
    __device__ __forceinline__ void done(const Unit&) const {}
};

__device__ __forceinline__ u32x4 pack_v(const f32x4 v0, const f32x4 v1) { u32x4 w; w.x = cvt_pk_bf16(v0[0], v0[1]); w.y = cvt_pk_bf16(v0[2], v0[3]); w.z = cvt_pk_bf16(v1[0], v1[1]); w.w = cvt_pk_bf16(v1[2], v1[3]); return w; }

struct EpiStore {
    static constexpr bool PERM = true, AFTER_DRAIN = false, BIAS_INIT = false;
    bf16_t* O; int ldc;
    __device__ __forceinline__ void operator()(const f32x4 (&acc)[2][2][4][2], const Unit& u, int wr, int wc, int fr, int fq) const {
        const int row0 = u.pm * BM + wr * 64 + fr, col0 = u.pn * BM + wc * 32 + 8 * fq;
#pragma unroll
        for (int ai = 0; ai < 2; ++ai)
#pragma unroll
            for (int m = 0; m < 4; ++m) { bf16_t* rowp = O + (size_t)(row0 + ai * HALF + m * 16) * ldc + col0;
#pragma unroll
                for (int bj = 0; bj < 2; ++bj) *(u32x4*)(rowp + bj * HALF) = pack_v(acc[ai][bj][m][0], acc[ai][bj][m][1]); }
    }
};
struct EpiGlu {
    static constexpr bool PERM = true, AFTER_DRAIN = false, BIAS_INIT = false;
    const bf16_t* Z; bf16_t* MIX; const float* bias;
    __device__ __forceinline__ void operator()(const f32x4 (&acc)[2][2][4][2], const Unit& u, int wr, int wc, int fr, int fq) const {
        const int row0 = u.pm * BM + wr * 64 + fr, col0 = u.pn * BM + wc * 32 + 8 * fq;
        f32x4 bv[2][2];
#pragma unroll
        for (int bj = 0; bj < 2; ++bj)
#pragma unroll
            for (int n = 0; n < 2; ++n) bv[bj][n] = *(const f32x4*)(bias + col0 + bj * HALF + 4 * n);
#pragma unroll
        for (int ai = 0; ai < 2; ++ai)
#pragma unroll
            for (int m = 0; m < 4; ++m) { const size_t row = (size_t)(row0 + ai * HALF + m * 16);
#pragma unroll
                for (int bj = 0; bj < 2; ++bj) {
                    const u32x4 zw = *(const u32x4*)(Z + row * SSM_W + col0 + bj * HALF); float z[8]; unpack8(zw, z);
                    const f32x4 a0 = acc[ai][bj][m][0] + bv[bj][0], a1 = acc[ai][bj][m][1] + bv[bj][1];
                    float o[8];
#pragma unroll
                    for (int j = 0; j < 4; ++j) { o[j] = z[j] * sigmoidf_(a0[j]); o[4 + j] = z[4 + j] * sigmoidf_(a1[j]); }
                    *(u32x4*)(MIX + row * D + 512 + col0 + bj * HALF) = pack8(o); } }
    }
};
struct EpiRope {
    static constexpr bool PERM = true, AFTER_DRAIN = false, BIAS_INIT = false;
    bf16_t* O; const f32x2* rope;
    __device__ __forceinline__ void operator()(const f32x4 (&acc)[2][2][4][2], const Unit& u, int wr, int wc, int fr, int fq) const {
        const int part = u.pn >> 2, tp = u.pn & 3;
        const int row0 = u.pm * BM + wr * 64 + fr, colb = part * 1024 + (4 * tp + wc) * 64 + 8 * fq;
        const float qs = part == 0 ? 0.125f * 1.4426950408889634f : 1.0f;
#pragma unroll
        for (int ai = 0; ai < 2; ++ai)
#pragma unroll
            for (int m = 0; m < 4; ++m) { const int row = row0 + ai * HALF + m * 16; bf16_t* rowp = O + (size_t)row * 3072 + colb;
                const f32x4 x1a = acc[ai][0][m][0], x1b = acc[ai][0][m][1], x2a = acc[ai][1][m][0], x2b = acc[ai][1][m][1];
                if (part < 2) {
                    const f32x4* rp = (const f32x4*)(rope + (size_t)seqpos(row) * 32 + 8 * fq);
                    const f32x4 c01 = rp[0], c23 = rp[1], c45 = rp[2], c67 = rp[3];
                    float o1[8], o2[8];
                    const float cs[8] = {c01[0], c01[2], c23[0], c23[2], c45[0], c45[2], c67[0], c67[2]}, sn[8] = {c01[1], c01[3], c23[1], c23[3], c45[1], c45[3], c67[1], c67[3]};
                    const float x1[8] = {x1a[0], x1a[1], x1a[2], x1a[3], x1b[0], x1b[1], x1b[2], x1b[3]}, x2[8] = {x2a[0], x2a[1], x2a[2], x2a[3], x2b[0], x2b[1], x2b[2], x2b[3]};
#pragma unroll
                    for (int j = 0; j < 8; ++j) { o1[j] = (x1[j] * cs[j] - x2[j] * sn[j]) * qs; o2[j] = (x2[j] * cs[j] + x1[j] * sn[j]) * qs; }
                    *(u32x4*)(rowp) = pack8(o1); *(u32x4*)(rowp + 32) = pack8(o2);
                } else { *(u32x4*)(rowp) = pack_v(x1a, x1b); *(u32x4*)(rowp + 32) = pack_v(x2a, x2b); } }
    }
};
struct EpiSwiglu {
    static constexpr bool PERM = true, AFTER_DRAIN = false, BIAS_INIT = true;
#ifdef PROBE_NOSTORE
    bool nostore = false;
#endif
    bf16_t* ACT; const float* bgu;
    __device__ __forceinline__ void init(f32x4 (&acc)[2][2][4][2], const Unit& u, int wc, int fq) const {
        const float* bb = bgu + (size_t)u.e * 2048 + u.pn * 128 + wc * 32 + 8 * fq;
        const f32x4 bg0 = *(const f32x4*)(bb), bg1 = *(const f32x4*)(bb + 4), bl0 = *(const f32x4*)(bb + 1024), bl1 = *(const f32x4*)(bb + 1028);
#pragma unroll
        for (int ai = 0; ai < 2; ++ai)
#pragma unroll
            for (int m = 0; m < 4; ++m) { acc[ai][0][m][0] = bg0; acc[ai][0][m][1] = bg1; acc[ai][1][m][0] = bl0; acc[ai][1][m][1] = bl1; }
    }
    __device__ __forceinline__ void operator()(const f32x4 (&acc)[2][2][4][2], const Unit& u, int wr, int wc, int fr, int fq) const {
        const int row0 = u.pm * BM + wr * 64 + fr, j0 = u.pn * 128 + wc * 32 + 8 * fq;
        unsigned char* ab = (unsigned char*)ACT + (size_t)row0 * D + j0;
#pragma unroll
        for (int ai = 0; ai < 2; ++ai)
#pragma unroll
            for (int m = 0; m < 4; ++m) {
                const f32x4 g0 = acc[ai][0][m][0], g1 = acc[ai][0][m][1], l0 = acc[ai][1][m][0], l1 = acc[ai][1][m][1];
                float o[8];
#pragma unroll
                for (int j = 0; j < 4; ++j) {
                    const float ga = __builtin_amdgcn_fmed3f(g0[j], -3.0e38f, SW_LIMIT), gb = __builtin_amdgcn_fmed3f(g1[j], -3.0e38f, SW_LIMIT);
                    const float la = __builtin_amdgcn_fmed3f(l0[j], -SW_LIMIT, SW_LIMIT), lb = __builtin_amdgcn_fmed3f(l1[j], -SW_LIMIT, SW_LIMIT);
                    const float sa = ga * __builtin_amdgcn_rcpf(1.0f + __builtin_amdgcn_exp2f((-SW_ALPHA * 1.4426950408889634f) * ga)), sb = gb * __builtin_amdgcn_rcpf(1.0f + __builtin_amdgcn_exp2f((-SW_ALPHA * 1.4426950408889634f) * gb));
                    o[j] = fmaf(la, sa, sa); o[4 + j] = fmaf(lb, sb, sb); }
#ifdef PROBE_NOSTORE
                { const u32x2 w_ = pack8_fp8(o); if (!nostore) *(u32x2*)(ab + (size_t)(ai * HALF + m * 16) * D) = w_; else asm volatile("" :: "v"(w_)); } }
#else
                *(u32x2*)(ab + (size_t)(ai * HALF + m * 16) * D) = pack8_fp8(o); }
#endif
    }
};
struct EpiDown {
    static constexpr bool PERM = true, AFTER_DRAIN = false, BIAS_INIT = true;
#ifdef PROBE_NOSTORE
    bool nostore = false;
#endif
    bf16_t* Y; const float* bd; const float* glist;
    __device__ __forceinline__ void init(f32x4 (&acc)[2][2][4][2], const Unit& u, int wc, int fq) const {
        const float* bb = bd + (size_t)u.e * D + u.pn * BM + wc * 32 + 8 * fq;
        const f32x4 b00 = *(const f32x4*)(bb), b01 = *(const f32x4*)(bb + 4), b10 = *(const f32x4*)(bb + HALF), b11 = *(const f32x4*)(bb + HALF + 4);
#pragma unroll
        for (int ai = 0; ai < 2; ++ai)
#pragma unroll
            for (int m = 0; m < 4; ++m) { acc[ai][0][m][0] = b00; acc[ai][0][m][1] = b01; acc[ai][1][m][0] = b10; acc[ai][1][m][1] = b11; }
    }
    __device__ __forceinline__ void operator()(const f32x4 (&acc)[2][2][4][2], const Unit& u, int wr, int wc, int fr, int fq) const {
        const int rl0 = wr * 64 + fr, col0 = u.pn * BM + wc * 32 + 8 * fq;
        const float* gl = glist + (size_t)u.e * T + (size_t)u.mt * BM + rl0;
        unsigned char* yb = (unsigned char*)Y + ((size_t)u.pm * BM + rl0) * D + col0;
#pragma unroll
        for (int ai = 0; ai < 2; ++ai)
#pragma unroll
            for (int m = 0; m < 4; ++m) { const int rl = ai * HALF + m * 16; const float gt = gl[rl] * Y8_SCALE;
#pragma unroll
                for (int bj = 0; bj < 2; ++bj) { const f32x4 v0 = acc[ai][bj][m][0] * gt, v1 = acc[ai][bj][m][1] * gt; u32x2 w; w.x = pk4_fp8(v0[0], v0[1], v0[2], v0[3]); w.y = pk4_fp8(v1[0], v1[1], v1[2], v1[3]);
#ifdef PROBE_NOSTORE
                    if (nostore) asm volatile("" :: "v"(w)); else
#endif
                    *(u32x2*)(yb + (size_t)rl * D + bj * HALF) = w; } }
    }
};

template <class Epi, class Sched, bool ALIGN_EPI = false, bool SP2 = false, bool FP8 = false, int PROBE = 0>
__device__ __forceinline__ void gemm_phase(PG8_LAS unsigned char* lds, const Gemm g, const Sched& S, const Epi& E, int wave_, int scale_w = 127, int scale_x = 127) {
    int tid = wave_ * 64 + lane_id(); asm volatile("" : "+v"(tid)); const int wid = wave_, lane = tid & 63, wr = wid >> 2, wc = wid & 3, fr = lane & 15, fq = lane >> 4;
    const int K = g.K, nt = K / BK;
    unsigned voffA[2], voffB[2];
#pragma unroll
    for (int i = 0; i < 2; ++i) { int R, C; stage_rc(tid * 16 + i * 8192, R, C); const int Rb = Epi::PERM ? ((R & ~31) + perm32(R & 31)) : R;
        voffA[i] = (unsigned)(R * K + C) * 2u; voffB[i] = (unsigned)(Rb * K + C) * 2u; }
    const unsigned kstep = (unsigned)(BK * 2);
    const unsigned hstep = (unsigned)HALF * (unsigned)K * 2u;
    const unsigned ldsw = (unsigned)wid * 1024u;
    const int aoff = lds_byte(wr * 64 + fr, fq * 8), boff = lds_byte(wc * 32 + fr, fq * 8);
#define PG8_SA(b, h) (((b) * 2 + (h)) * HTB)
#define PG8_SB(b, h) ((4 + (b) * 2 + (h)) * HTB)
#define PG8_STAGE(bufoff, gbase, voff) do { if constexpr (!(PROBE & 2)) _Pragma("unroll") for (int _i = 0; _i < 2; ++_i) \
        __builtin_amdgcn_raw_ptr_buffer_load_lds(rsrc_##voff, (PG8_LAS unsigned*)(lds + (bufoff) + ldsw + _i * 8192), 16, (voff)[_i], (gbase), 0, 0); } while (0)
#define PG8_LDA(dst, b, h) do { if constexpr ((PROBE & 16) != 0) { if constexpr (FP8) { asm volatile("" : "+v"(dst##8[0]), "+v"(dst##8[1]), "+v"(dst##8[2]), "+v"(dst##8[3])); } } else if constexpr (FP8) { _Pragma("unroll") for (int m = 0; m < 4; ++m) { const v4i_ lo_ = *(const PG8_LAS v4i_*)(lds + PG8_SA(b, h) + aoff + m * 2048), hi_ = *(const PG8_LAS v4i_*)(lds + PG8_SA(b, h) + aoff + m * 2048 + 1024); dst##8[m] = __builtin_shufflevector(lo_, hi_, 0, 1, 2, 3, 4, 5, 6, 7); } } \
        else { _Pragma("unroll") for (int m = 0; m < 4; ++m) _Pragma("unroll") for (int k = 0; k < 2; ++k) dst[m][k] = *(const PG8_LAS bf16x8*)(lds + PG8_SA(b, h) + aoff + m * 2048 + k * 1024); } } while (0)
#define PG8_LDB(dst, b, h) do { if constexpr ((PROBE & 8) != 0) { if constexpr (FP8) { asm volatile("" : "+v"(dst##8[0]), "+v"(dst##8[1])); } } else if constexpr (FP8) { _Pragma("unroll") for (int n = 0; n < 2; ++n) { const v4i_ lo_ = *(const PG8_LAS v4i_*)(lds + PG8_SB(b, h) + boff + n * 2048), hi_ = *(const PG8_LAS v4i_*)(lds + PG8_SB(b, h) + boff + n * 2048 + 1024); dst##8[n] = __builtin_shufflevector(lo_, hi_, 0, 1, 2, 3, 4, 5, 6, 7); } } \
        else { _Pragma("unroll") for (int n = 0; n < 2; ++n) _Pragma("unroll") for (int k = 0; k < 2; ++k) dst[n][k] = *(const PG8_LAS bf16x8*)(lds + PG8_SB(b, h) + boff + n * 2048 + k * 1024); } } while (0)
#define PG8_MMA(ai, bj, At, Bt) do { __builtin_amdgcn_s_setprio(1); _Pragma("unroll") for (int m = 0; m < 4; ++m) _Pragma("unroll") for (int n = 0; n < 2; ++n) { \
        if constexpr ((PROBE & 4) != 0) { if constexpr (FP8) asm volatile("" :: "v"(Bt##8[n]), "v"(At##8[m])); else asm volatile("" :: "v"(Bt[n][0]), "v"(At[m][0]), "v"(Bt[n][1]), "v"(At[m][1])); } else \
        if constexpr (FP8) acc[ai][bj][m][n] = __builtin_amdgcn_mfma_scale_f32_16x16x128_f8f6f4(Bt##8[n], At##8[m], acc[ai][bj][m][n], 0, 0, 0, scale_w, 0, scale_x); \
        else { _Pragma("unroll") for (int k = 0; k < 2; ++k) acc[ai][bj][m][n] = __builtin_amdgcn_mfma_f32_16x16x32_bf16(Bt[n][k], At[m][k], acc[ai][bj][m][n], 0, 0, 0); } } \
        __builtin_amdgcn_s_setprio(0); } while (0)
#define PG8_WAIT_V(n) asm volatile("s_waitcnt vmcnt(" #n ")" ::: "memory")
#define PG8_WAIT_L(n) asm volatile("s_waitcnt lgkmcnt(" #n ")" ::: "memory")
#define PG8_BAR __builtin_amdgcn_s_barrier()
#define PG8_SCHED __builtin_amdgcn_sched_barrier(0)
#define PG8_ACC_INIT(u_) do { if constexpr (Epi::BIAS_INIT && !(PROBE & 64)) { int tz_ = lane_id(); asm volatile("" : "+v"(tz_)); E.init(acc, u_, wc, (tz_ & 63) >> 4); } else { \
        _Pragma("unroll") for (int a = 0; a < 2; ++a) _Pragma("unroll") for (int b = 0; b < 2; ++b) _Pragma("unroll") for (int m = 0; m < 4; ++m) _Pragma("unroll") for (int n = 0; n < 2; ++n) acc[a][b][m][n] = (f32x4){0.f, 0.f, 0.f, 0.f}; } } while (0)
    Unit cur, nxt; int ui = 0;
    if (!S.next(0, cur)) return;
    f32x4 acc[2][2][4][2];
    PG8_ACC_INIT(cur);
    typedef int v4i_ __attribute__((ext_vector_type(4))); typedef int v8i_ __attribute__((ext_vector_type(8)));
    bf16x8 At[4][2], B0[2][2], B1[2][2]; v8i_ At8[4], B08[2], B18[2];
    const auto rsrc_voffA = __builtin_amdgcn_make_buffer_rsrc((void*)g.A, 0, -1, 0x00020000), rsrc_voffB = __builtin_amdgcn_make_buffer_rsrc((void*)g.Bt, 0, -1, 0x00020000);
    unsigned cA = (unsigned)__builtin_amdgcn_readfirstlane((int)(unsigned)S.a_off(cur)), cB = (unsigned)__builtin_amdgcn_readfirstlane((int)(unsigned)S.b_off(cur));
    S.a_ready(cur);
    if constexpr (SP2) {
        PG8_STAGE(PG8_SB(0, 0), cB, voffB); PG8_STAGE(PG8_SB(0, 1), cB + hstep, voffB); PG8_STAGE(PG8_SA(0, 0), cA, voffA); PG8_STAGE(PG8_SA(0, 1), cA + hstep, voffA);
        if (wr == 1) PG8_BAR;
        PG8_WAIT_V(2); PG8_BAR;
        PG8_STAGE(PG8_SB(1, 0), cB + kstep, voffB); PG8_STAGE(PG8_SA(1, 0), cA + kstep, voffA); PG8_STAGE(PG8_SB(1, 1), cB + hstep + kstep, voffB);
        PG8_WAIT_V(6); PG8_BAR;
    } else {
        PG8_STAGE(PG8_SB(0, 0), cB, voffB); PG8_STAGE(PG8_SA(0, 0), cA, voffA); PG8_STAGE(PG8_SB(0, 1), cB + hstep, voffB); PG8_STAGE(PG8_SA(0, 1), cA + hstep, voffA);
        if (wr == 1) PG8_BAR;
        PG8_WAIT_V(4); PG8_BAR;
        PG8_STAGE(PG8_SB(1, 0), cB + kstep, voffB); PG8_STAGE(PG8_SA(1, 0), cA + kstep, voffA); PG8_STAGE(PG8_SB(1, 1), cB + hstep + kstep, voffB);
        PG8_WAIT_V(6); PG8_BAR;
    }
    for (;;) {
        const bool has_next = S.next(ui + 1, nxt);
        const unsigned nA = has_next ? (unsigned)__builtin_amdgcn_readfirstlane((int)(unsigned)S.a_off(nxt)) : cA, nB = has_next ? (unsigned)__builtin_amdgcn_readfirstlane((int)(unsigned)S.b_off(nxt)) : cB;
#pragma nounroll
        for (int t = 0; t < nt; t += 2) {
            const bool last = (t == nt - 2);
            const unsigned a1 = cA + (unsigned)(t + 1) * kstep;
            const unsigned a2 = last ? nA : cA + (unsigned)(t + 2) * kstep, b2 = last ? nB : cB + (unsigned)(t + 2) * kstep;
            const unsigned a3 = a2 + kstep, b3 = b2 + kstep;
            if (last && has_next) S.a_ready(nxt);
            if constexpr (SP2) {
            PG8_LDB(B0, 0, 0); PG8_LDB(B1, 0, 1); PG8_SCHED; PG8_LDA(At, 0, 0); PG8_STAGE(PG8_SA(1, 1), a1 + hstep, voffA);
            PG8_WAIT_V(8); PG8_WAIT_L(0); PG8_BAR; PG8_MMA(0, 0, At, B0); PG8_MMA(0, 1, At, B1); PG8_BAR; PG8_SCHED;
            PG8_LDA(At, 0, 1); PG8_STAGE(PG8_SB(0, 0), b2, voffB); PG8_STAGE(PG8_SB(0, 1), b2 + hstep, voffB); PG8_STAGE(PG8_SA(0, 0), a2, voffA);
            PG8_WAIT_V(8); PG8_WAIT_L(0); PG8_BAR; PG8_MMA(1, 0, At, B0); PG8_MMA(1, 1, At, B1); PG8_BAR; PG8_SCHED;
            PG8_LDB(B0, 1, 0); PG8_LDB(B1, 1, 1); PG8_SCHED; PG8_LDA(At, 1, 0); PG8_STAGE(PG8_SA(0, 1), a2 + hstep, voffA);
            PG8_WAIT_V(8); PG8_WAIT_L(0); PG8_BAR; PG8_MMA(0, 0, At, B0); PG8_MMA(0, 1, At, B1); PG8_BAR; PG8_SCHED;
            PG8_LDA(At, 1, 1); PG8_STAGE(PG8_SB(1, 0), b3, voffB); PG8_STAGE(PG8_SB(1, 1), b3 + hstep, voffB); PG8_STAGE(PG8_SA(1, 0), a3, voffA);
            PG8_WAIT_V(8); PG8_WAIT_L(0); PG8_BAR; PG8_MMA(1, 0, At, B0); PG8_MMA(1, 1, At, B1); PG8_BAR; PG8_SCHED;
            } else {
            PG8_LDB(B0, 0, 0); PG8_SCHED; PG8_LDA(At, 0, 0); PG8_STAGE(PG8_SA(1, 1), a1 + hstep, voffA);
            PG8_WAIT_L(8); PG8_BAR; PG8_WAIT_L(0); PG8_MMA(0, 0, At, B0); PG8_BAR; PG8_SCHED;
            PG8_LDB(B1, 0, 1); PG8_STAGE(PG8_SB(0, 0), b2, voffB);
            PG8_BAR; PG8_WAIT_L(0); PG8_MMA(0, 1, At, B1); PG8_BAR;
            PG8_LDA(At, 0, 1); PG8_STAGE(PG8_SA(0, 0), a2, voffA);
            PG8_BAR; PG8_WAIT_L(0); PG8_MMA(1, 0, At, B0); PG8_BAR; PG8_SCHED;
            PG8_STAGE(PG8_SB(0, 1), b2 + hstep, voffB);
            PG8_WAIT_V(6); PG8_BAR; PG8_MMA(1, 1, At, B1); PG8_BAR;
            PG8_LDB(B0, 1, 0); PG8_SCHED; PG8_LDA(At, 1, 0); PG8_STAGE(PG8_SA(0, 1), a2 + hstep, voffA);
            PG8_WAIT_L(8); PG8_BAR; PG8_WAIT_L(0); PG8_MMA(0, 0, At, B0); PG8_BAR; PG8_SCHED;
            PG8_LDB(B1, 1, 1); PG8_STAGE(PG8_SB(1, 0), b3, voffB);
            PG8_BAR; PG8_WAIT_L(0); PG8_MMA(0, 1, At, B1); PG8_BAR;
            PG8_LDA(At, 1, 1); PG8_STAGE(PG8_SA(1, 0), a3, voffA);
            PG8_BAR; PG8_WAIT_L(0); PG8_MMA(1, 0, At, B0); PG8_BAR; PG8_SCHED;
            PG8_STAGE(PG8_SB(1, 1), b3 + hstep, voffB);
            PG8_WAIT_V(6); PG8_BAR; PG8_MMA(1, 1, At, B1); PG8_BAR;
            }
        }
        if constexpr (ALIGN_EPI) { if (wr == 0) PG8_BAR; }
        if constexpr (!Epi::AFTER_DRAIN) { int tz = lane_id(); asm volatile("" : "+v"(tz));
            if constexpr ((PROBE & 1) != 0) { _Pragma("unroll") for (int a = 0; a < 2; ++a) _Pragma("unroll") for (int b = 0; b < 2; ++b) _Pragma("unroll") for (int m = 0; m < 4; ++m) _Pragma("unroll") for (int n = 0; n < 2; ++n) asm volatile("" :: "v"(acc[a][b][m][n])); }
            else E(acc, cur, wr, wc, tz & 15, (tz & 63) >> 4); S.done(cur); }
        if (!has_next) break;
        PG8_ACC_INIT(nxt);
        cur = nxt; cA = nA; cB = nB; ++ui;
        if constexpr (ALIGN_EPI) { if (wr == 1) PG8_BAR; }
    }
    PG8_WAIT_V(0);
    if constexpr (!ALIGN_EPI) { if (wr == 0) PG8_BAR; }
    PG8_BAR;
    if constexpr (Epi::AFTER_DRAIN) { E.fused(acc, cur, wr, wc, fr, fq, lds, wid, lane); S.done(cur); }
#undef PG8_SA
#undef PG8_SB
#undef PG8_ACC_INIT
#undef PG8_STAGE
#undef PG8_LDA
#undef PG8_LDB
#undef PG8_MMA
#undef PG8_WAIT_V
#undef PG8_WAIT_L
#undef PG8_BAR
#undef PG8_SCHED
}
}

template <int MODE>
__device__ __forceinline__ void transpose_item(const float* W, int K, int N, bf16_t* WT, LAS float* scr, int item, int lane) {
    const int nblk = N / 32, kb = item / nblk, nb = item % nblk, k0 = 64 * kb, n0 = 32 * nb;
    int dr = n0;
    if (MODE == 1) { const int j = n0 & 1023, half = n0 >> 10; dr = 256 * (j >> 7) + 128 * half + (j & 127); }
    if (MODE == 2) { const int part = n0 >> 10, c = n0 & 1023, head = c >> 6, half = (c >> 5) & 1; dr = part * 1024 + (head >> 2) * 256 + half * 128 + (head & 3) * 32; }
#pragma unroll 8
    for (int i = 0; i < 32; ++i) { const int kk = 2 * i + (lane >> 5); scr[kk * 33 + (lane & 31)] = W[(size_t)(k0 + kk) * N + n0 + (lane & 31)]; }
    WAVE_SYNC();
    const int c = lane & 7;
#pragma unroll
    for (int j = 0; j < 4; ++j) { const int n = (lane >> 3) + 8 * j; const LAS float* s = scr + (8 * c) * 33 + n;
        u32x4 o; o.x = pk2(s[0 * 33], s[1 * 33]); o.y = pk2(s[2 * 33], s[3 * 33]); o.z = pk2(s[4 * 33], s[5 * 33]); o.w = pk2(s[6 * 33], s[7 * 33]);
        *(u32x4*)(WT + (size_t)(dr + n) * K + k0 + 8 * c) = o; }
    WAVE_SYNC();
}

template <int MODE>
__device__ __forceinline__ void transpose_item_fp8(const float* W, int K, int N, unsigned char* WT, LAS float* scr, int item, int lane, float scale) {
    const int nblk = N / 32, kb = item / nblk, nb = item % nblk, k0 = 64 * kb, n0 = 32 * nb;
    int dr = n0;
    if (MODE == 1) { const int j = n0 & 1023, half = n0 >> 10; dr = 256 * (j >> 7) + 128 * half + (j & 127); }
#pragma unroll 8
    for (int i = 0; i < 32; ++i) { const int kk = 2 * i + (lane >> 5); scr[kk * 33 + (lane & 31)] = W[(size_t)(k0 + kk) * N + n0 + (lane & 31)] * scale; }
    WAVE_SYNC();
#pragma unroll
    for (int j = 0; j < 2; ++j) { const int n = lane & 31, c = (lane >> 5) + 2 * j; const LAS float* s = scr + (16 * c) * 33 + n;
        u32x4 o; o.x = pk4_fp8(s[0 * 33], s[1 * 33], s[2 * 33], s[3 * 33]); o.y = pk4_fp8(s[4 * 33], s[5 * 33], s[6 * 33], s[7 * 33]);
        o.z = pk4_fp8(s[8 * 33], s[9 * 33], s[10 * 33], s[11 * 33]); o.w = pk4_fp8(s[12 * 33], s[13 * 33], s[14 * 33], s[15 * 33]);
        *(u32x4*)(WT + (size_t)(dr + n) * K + k0 + 16 * c) = o; }
    WAVE_SYNC();
}

__device__ __forceinline__ const float* ld_ptr(volatile LAS unsigned long long* t, int k) {
    const unsigned long long v = t[k]; const unsigned lo = __builtin_amdgcn_readfirstlane((unsigned)v), hi = __builtin_amdgcn_readfirstlane((unsigned)(v >> 32));
    return (const float*)(const GAS float*)(((unsigned long long)hi << 32) | lo);
}
__device__ __forceinline__ void phase_prologue(const Ctx& X, volatile LAS unsigned long long* ptab) {
#define in_(k) ld_ptr(ptab, k)
    const float* a_re = in_(3); const float* a_im = in_(4); const float* log_dt = in_(5); const float* b_re = in_(6); const float* b_im = in_(7);
    float2* Abar = (float2*)(X.ws + WS_S5A); float2* Bbar = (float2*)(X.ws + WS_S5B); float2* rope = (float2*)(X.ws + WS_ROPE);
    const int gt = X.bid * NTHR + X.tid, NT = X.G * NTHR;
    for (int it = gt; it < 2 * SSM_G * SSM_P; it += NT) {
        const int ig = it >> 6;
        const double lam_re = fmin((double)a_re[it], -1e-4), lam_im = (double)a_im[it];
        const double dt = exp((double)log_dt[ig]);
        const double mag = exp(lam_re * dt), ang = lam_im * dt;
        const double abr = mag * cos(ang), abi = mag * sin(ang);
        const double nr = abr - 1.0, ni = abi, den = lam_re * lam_re + lam_im * lam_im;
        const double cr = (nr * lam_re + ni * lam_im) / den, ci = (ni * lam_re - nr * lam_im) / den;
        Abar[it] = make_float2((float)abr, (float)abi);
        for (int h = 0; h < SSM_H; ++h) {
            const double br = (double)b_re[it * 16 + h], bi = (double)b_im[it * 16 + h];
            Bbar[it * 16 + h] = make_float2((float)(cr * br - ci * bi), (float)(cr * bi + ci * br));
        }
    }
    for (int it = gt; it < SEQ * 32; it += NT) {
        const int pos = it >> 5, i = it & 31;
        const float inv = powf(10000.0f, -(float)i / 32.0f);
        const float ang = (float)pos * inv;
        rope[it] = make_float2((float)cos((double)ang), (float)sin((double)ang));
    }
    { const float* rw = in_(20); bf16_t* RWh = (bf16_t*)(X.ws + WS_RWH); bf16_t* RWl = (bf16_t*)(X.ws + WS_RWL);
      for (int it = gt; it < DEPTH * NE * D; it += NT) { const int k = it & 1023, e = (it >> 10) & 31, l = it >> 15;
          const float w = rw[((size_t)l * D + k) * NE + e]; const unsigned hb = f2bf(w); RWh[it] = (bf16_t)hb; RWl[it] = (bf16_t)f2bf(w - bf2f((bf16_t)hb)); } }
    { const float* x = in_(0); bf16_t* H0 = (bf16_t*)(X.ws + WS_H0);
      const size_t n8 = (size_t)T * D / 8;
      for (size_t i8 = (size_t)gt; i8 < n8; i8 += (size_t)NT) {
          const f32x4 a = *(const f32x4*)(x + i8 * 8), b = *(const f32x4*)(x + i8 * 8 + 4);
          u32x4 o; o.x = pk2(a[0], a[1]); o.y = pk2(a[2], a[3]); o.z = pk2(b[0], b[1]); o.w = pk2(b[2], b[3]);
          *(u32x4*)(H0 + i8 * 8) = o; } }
    LAS float* scr = (LAS float*)(X.lds + X.wave * 16384);
    const int gw = X.bid * NWAVES + X.wave, NGW = X.G * NWAVES;
    constexpr int I_GU = 16 * 64, I_DN = 16 * 32, I_IN = 16 * 64, I_GLU = 8 * 16, I_OUT = 16 * 32, I_QKV = 16 * 96, I_O = 16 * 32;
    constexpr int N_GU = 128 * I_GU, N_DN = 128 * I_DN, N_IN = 2 * I_IN, N_GLU = 2 * I_GLU, N_OUT = 2 * I_OUT, N_QKV = 2 * I_QKV, N_O = 2 * I_O;
    constexpr int NITEMS = N_GU + N_DN + N_IN + N_GLU + N_OUT + N_QKV + N_O;
    for (int it = gw; it < NITEMS; it += NGW) {
        int r = it;
        if (r < N_GU) { const int m = r / I_GU; transpose_item_fp8<1>(in_(22) + (size_t)m * D * 2048, D, 2048, (unsigned char*)(X.ws + WS_WGU + (size_t)m * 2048 * D), scr, r % I_GU, X.lane, (float)(1 << W8_SHIFT_GU)); continue; } r -= N_GU;
        if (r < N_DN) { const int m = r / I_DN; transpose_item_fp8<0>(in_(24) + (size_t)m * D * D, D, D, (unsigned char*)(X.ws + WS_WDN + (size_t)m * D * D), scr, r % I_DN, X.lane, (float)(1 << W8_SHIFT_DN)); continue; } r -= N_DN;
        if (r < N_IN) { const int m = r / I_IN; transpose_item<0>(in_(1) + (size_t)m * D * 2048, D, 2048, (bf16_t*)(X.ws + WS_WIN) + (size_t)m * 2048 * D, scr, r % I_IN, X.lane); continue; } r -= N_IN;
        if (r < N_GLU) { const int m = r / I_GLU; transpose_item<0>(in_(11) + (size_t)m * 512 * 512, 512, 512, (bf16_t*)(X.ws + WS_WGLU) + (size_t)m * 512 * 512, scr, r % I_GLU, X.lane); continue; } r -= N_GLU;
        if (r < N_OUT) { const int m = r / I_OUT; transpose_item<0>(in_(13) + (size_t)m * D * D, D, D, (bf16_t*)(X.ws + WS_WOUT) + (size_t)m * D * D, scr, r % I_OUT, X.lane); continue; } r -= N_OUT;
        if (r < N_QKV) { const int m = r / I_QKV; transpose_item<2>(in_(14) + (size_t)m * D * 3072, D, 3072, (bf16_t*)(X.ws + WS_WQKV) + (size_t)m * 3072 * D, scr, r % I_QKV, X.lane); continue; } r -= N_QKV;
        { const int m = r / I_O; transpose_item<0>(in_(15) + (size_t)m * D * D, D, D, (bf16_t*)(X.ws + WS_WO) + (size_t)m * D * D, scr, r % I_O, X.lane); }
    }
}

#undef in_
typedef float f32x4v __attribute__((ext_vector_type(4)));
template <int PASS>
__device__ __forceinline__ void phase_s5(const Ctx& X, int i, const bf16_t* proj, const float* conv_w, const float* c_re, const float* c_im, const float* d_skip, bf16_t* mix, bf16_t* Z) {
    using pg8::bf16x8;
    if (PASS == 2) {
        const float* w = conv_w + (size_t)i * 3 * CONV_CH;
        const size_t n = (size_t)T * (CONV_CH / 8);
        for (size_t idx = (size_t)X.bid * NTHR + X.tid; idx < n; idx += (size_t)X.G * NTHR) {
            const int bt = (int)(idx >> 6), c = (int)(idx & 63) * 8, pos = seqpos(bt);
            const bf16_t* pr = proj + (size_t)bt * 2048;
            float gb[8], a2[8], b2[8], a1[8], b1[8], a0[8], b0[8];
            unpack8(*(const u32x4*)(pr + c), gb); unpack8(*(const u32x4*)(pr + 512 + c), a2); unpack8(*(const u32x4*)(pr + 1024 + c), b2);
            if (pos >= 1) { unpack8(*(const u32x4*)(pr + 512 + c - 2048), a1); unpack8(*(const u32x4*)(pr + 1024 + c - 2048), b1); }
            if (pos >= 2) { unpack8(*(const u32x4*)(pr + 512 + c - 4096), a0); unpack8(*(const u32x4*)(pr + 1024 + c - 4096), b0); }
            float o[8];
#pragma unroll
            for (int j = 0; j < 8; ++j) {
                float s = w[2 * CONV_CH + c + j] * (a2[j] * b2[j]);
                if (pos >= 1) s += w[1 * CONV_CH + c + j] * (a1[j] * b1[j]);
                if (pos >= 2) s += w[0 * CONV_CH + c + j] * (a0[j] * b0[j]);
                o[j] = gb[j] * s; }
            *(u32x4*)(mix + (size_t)bt * D + c) = pack8(o);
        }
    }
    const int lane = X.lane, n16 = lane & 15, kq = lane >> 4;
    LAS float* BuT = (LAS float*)(X.lds + X.wave * 15360);
    LAS unsigned char* xsb = X.lds + X.wave * 15360 + 10240;
    const float2* Abar = (const float2*)(X.ws + WS_S5A); const float2* Bbar = (const float2*)(X.ws + WS_S5B);
    float2* Sst = (float2*)(X.ws + WS_S5S);
    const int gw = X.bid * NWAVES + X.wave, NGW = X.G * NWAVES;
    const int g = gw & 31, ig = i * 32 + g;
        const float2 A = Abar[ig * 64 + lane];
    bf16x8 bfr[8];
#pragma unroll
    for (int cb = 0; cb < 8; ++cb) {
        u32x4 w = (u32x4){0u, 0u, 0u, 0u};
        if (kq < 2) { const float2* bp = Bbar + ((size_t)(ig * 64 + 16 * (cb & 3) + n16)) * 16 + 8 * kq; float v[8];
#pragma unroll
            for (int j = 0; j < 8; ++j) { const float2 t2 = bp[j]; v[j] = cb < 4 ? t2.x : t2.y; }
            w = pack8(v); }
        bfr[cb] = __builtin_bit_cast(bf16x8, w);
    }
    bf16x8 cfr[4]; bf16x8 dfr;
    if (PASS == 2) {
#pragma unroll
        for (int ks = 0; ks < 4; ++ks) { const int p0 = 16 * ks + 4 * kq; const f32x4 cr = *(const f32x4*)(c_re + (size_t)(ig * 16 + n16) * 64 + p0), ci = *(const f32x4*)(c_im + (size_t)(ig * 16 + n16) * 64 + p0);
            u32x4 w; w.x = cvt_pk_bf16(cr[0], -ci[0]); w.y = cvt_pk_bf16(cr[1], -ci[1]); w.z = cvt_pk_bf16(cr[2], -ci[2]); w.w = cvt_pk_bf16(cr[3], -ci[3]); cfr[ks] = __builtin_bit_cast(bf16x8, w); }
        { const float dv = d_skip[ig * 16 + n16]; float v[8];
#pragma unroll
          for (int j = 0; j < 8; ++j) v[j] = (kq < 2 && 8 * kq + j == n16) ? dv : 0.f;
          dfr = __builtin_bit_cast(bf16x8, pack8(v)); }
    }
    for (int task = gw; task < BATCH * 64 * SSM_G; task += NGW) {
        const int c = (task >> 5) & 63, b = task >> 11;
        float xr = 0.f, xi = 0.f;
        if (PASS == 2) { const float2 xin = ((const float2*)(X.ws + WS_S5X))[((size_t)(b * 32 + g) * 64 + c) * 64 + lane]; xr = xin.x; xi = xin.y; }
        const bf16_t* ub = proj + ((size_t)b * SEQ + (size_t)c * 128) * 2048 + 1536 + g * 16;
        bf16_t* zb = Z + ((size_t)b * SEQ + (size_t)c * 128) * SSM_W + g * 16;
        u32x4 uw = (u32x4){0u, 0u, 0u, 0u};
        if (kq < 2) uw = *(const u32x4*)(ub + (size_t)n16 * 2048 + 8 * kq);
#pragma nounroll
        for (int blk = 0; blk < 8; ++blk) {
            const bf16x8 ufr = __builtin_bit_cast(bf16x8, uw);
            u32x4 un = (u32x4){0u, 0u, 0u, 0u};
            if (kq < 2 && blk < 7) un = *(const u32x4*)(ub + (size_t)((blk + 1) * 16 + n16) * 2048 + 8 * kq);
#pragma unroll
            for (int cb = 0; cb < 8; ++cb) {
                f32x4v acc = (f32x4v){0.f, 0.f, 0.f, 0.f};
                acc = __builtin_amdgcn_mfma_f32_16x16x32_bf16(ufr, bfr[cb], acc, 0, 0, 0);
                *(LAS f32x4v*)(BuT + (16 * cb + n16) * 20 + 4 * kq) = acc;
            }
            WAVE_SYNC();
#pragma unroll
            for (int k4 = 0; k4 < 4; ++k4) {
                const f32x4v br = *(const LAS f32x4v*)(BuT + lane * 20 + 4 * k4), bi = *(const LAS f32x4v*)(BuT + (64 + lane) * 20 + 4 * k4);
#pragma unroll
                for (int s = 0; s < 4; ++s) {
                    float nr = fmaf(-A.y, xi, fmaf(A.x, xr, br[s])); asm volatile("" : "+v"(nr));
                    float ni = fmaf(A.y, xr, fmaf(A.x, xi, bi[s])); asm volatile("" : "+v"(ni));
                    xr = nr; xi = ni;
                    if (PASS == 2) *(LAS unsigned*)(xsb + (4 * k4 + s) * 272 + lane * 4) = cvt_pk_bf16(xr, xi);
                }
            }
            if (PASS == 2) {
                WAVE_SYNC();
                f32x4v y = (f32x4v){0.f, 0.f, 0.f, 0.f};
                bf16x8 xa[4];
#pragma unroll
                for (int ks = 0; ks < 4; ++ks) xa[ks] = *(const LAS bf16x8*)(xsb + n16 * 272 + ks * 64 + kq * 16);
                WAVE_SYNC(); __builtin_amdgcn_sched_barrier(0);
#pragma unroll
                for (int ks = 0; ks < 4; ++ks) y = __builtin_amdgcn_mfma_f32_16x16x32_bf16(xa[ks], cfr[ks], y, 0, 0, 0);
                y = __builtin_amdgcn_mfma_f32_16x16x32_bf16(ufr, dfr, y, 0, 0, 0);
                asm volatile("" :: "v"(xa[0]), "v"(xa[1]), "v"(xa[2]), "v"(xa[3]), "v"(ufr));
#pragma unroll
                for (int q = 0; q < 4; ++q) zb[(size_t)(blk * 16 + 4 * kq + q) * SSM_W + n16] = (bf16_t)f2bf(gelu_tanh(y[q]));
            }
            WAVE_SYNC();
            uw = un;
        }
        if (PASS == 1) Sst[((size_t)(b * 32 + g) * 64 + c) * 64 + lane] = make_float2(xr, xi);
    }
}

__device__ __forceinline__ void phase_s5_carry(const Ctx& X, int i) {
    const float2* Abar = (const float2*)(X.ws + WS_S5A); const float2* Sst = (const float2*)(X.ws + WS_S5S); float2* Xin = (float2*)(X.ws + WS_S5X);
    const int gw = X.bid * NWAVES + X.wave, NGW = X.G * NWAVES, lane = X.lane;
    for (int bg = gw; bg < BATCH * SSM_G; bg += NGW) {
        const float2 A = Abar[(i * 32 + (bg & 31)) * 64 + lane];
        float pr_ = A.x, pi_ = A.y;
#pragma unroll
        for (int q = 0; q < 7; ++q) { const float nr = pr_ * pr_ - pi_ * pi_, ni = 2.f * pr_ * pi_; pr_ = nr; pi_ = ni; }
        float xr = 0.f, xi = 0.f;
        const size_t base = (size_t)bg * 64 * 64 + lane;
#pragma unroll 8
        for (int c = 0; c < 64; ++c) {
            Xin[base + (size_t)c * 64] = make_float2(xr, xi);
            const float2 s = Sst[base + (size_t)c * 64];
            const float nr = pr_ * xr - pi_ * xi + s.x, ni = pr_ * xi + pi_ * xr + s.y; xr = nr; xi = ni;
        }
    }
}

typedef short v4i16_t __attribute__((ext_vector_type(4)));
typedef float f32x16 __attribute__((ext_vector_type(16)));
__device__ __forceinline__ v4i16_t vtr16(const LAS unsigned char* p) { return __builtin_amdgcn_ds_read_tr16_b64_v4i16((LAS v4i16_t*)p); }
template <int PASS>
__device__ __forceinline__ void phase_attn(const Ctx& X, const bf16_t* proj, bf16_t* att, bf16_t* ost, float2* ml) {
    using pg8::bf16x8;
    const int lane = X.lane, i32 = lane & 31, hi = lane >> 5;
    LAS unsigned char* vbuf = X.lds + X.wave * 16384;
    LAS unsigned char* kbuf = vbuf + 8192;
    const int gw = X.bid * NWAVES + X.wave, NGW = X.G * NWAVES;
    const float NEG = opaque_f(-3.0e38f); const int seqmax = opaque_i(SEQ - 1);
    const int vrd = ((lane >> 4) & 1) * 32 + (lane & 3) * 8 + (4 * hi + ((lane & 15) >> 2)) * 64;
    const bool xdeal = (X.G == 256);
    constexpr int NT = PASS == 0 ? 13 : 5, PD = 2, NR = 3;
    const int lrow = lane >> 3, lpc = lane & 7;
#pragma nounroll
    for (int it = 0; it < (xdeal ? 8 : (BATCH * NH * 256 + NGW - 1) / NGW); ++it) {
        const int task = xdeal ? (((it * 8 + (X.bid & 7)) << 8) | ((X.bid >> 3) * 8 + X.wave)) : (gw + it * NGW);
        if (task >= BATCH * NH * 256) break;
        const int QST = PASS == 0 ? 4 : 16;
        const int r = PASS == 0 ? (task & 3) : (task & 15), blk = PASS == 0 ? ((task >> 2) & 63) : ((task >> 4) & 15), hh = (task >> 8) & 15, b = task >> 12;
        const bf16_t* base = proj + (size_t)b * SEQ * 3072 + hh * 64;
        const int t0 = (PASS == 0 ? 128 : 512) * blk + r;
        bf16x8 qf[4];
        { const bf16_t* qp = base + (size_t)(t0 + QST * i32) * 3072 + 8 * hi;
#pragma unroll
          for (int d0 = 0; d0 < 4; ++d0) qf[d0] = *(const bf16x8*)(qp + 16 * d0); }
        float m_run = NEG, l_run = 0.f;
        f32x16 o0, o1;
#pragma unroll
        for (int q = 0; q < 16; ++q) { o0[q] = 0.f; o1[q] = 0.f; }
        const size_t srow = (size_t)(b * SEQ + t0 + QST * i32);
        if (PASS == 1) {
            const float2 mlv = ml[srow * NH + hh]; m_run = mlv.x; l_run = hi == 0 ? mlv.y : 0.f;
            const bf16_t* sp = ost + srow * D + hh * 64 + 4 * hi;
#pragma unroll
            for (int gq = 0; gq < 4; ++gq) { const u32x2 w0 = *(const u32x2*)(sp + 8 * gq), w1 = *(const u32x2*)(sp + 32 + 8 * gq);
                o0[4 * gq] = bf_lo(w0.x); o0[4 * gq + 1] = bf_hi(w0.x); o0[4 * gq + 2] = bf_lo(w0.y); o0[4 * gq + 3] = bf_hi(w0.y);
                o1[4 * gq] = bf_lo(w1.x); o1[4 * gq + 1] = bf_hi(w1.x); o1[4 * gq + 2] = bf_lo(w1.y); o1[4 * gq + 3] = bf_hi(w1.y); }
        }
#define AT_PAT(j) (PASS == 1 ? 0 : ((j) < 5 ? 0 : 1))
#define AT_KT(j) (PASS == 1 ? (j) : ((j) < 5 ? (j) : (j) - 5))
#define AT_DIL(j) (PASS == 1 ? 16 : (AT_PAT(j) == 0 ? 4 : 1))
#define AT_QS(j) (PASS == 1 ? 1 : (AT_PAT(j) == 0 ? 1 : 4))
#define AT_RR(j) (PASS == 1 ? r : (AT_PAT(j) == 0 ? r : 0))
        u32x4 kr[NR][4], vr[NR][4];
        auto issue = [&](int j, u32x4 (&kk)[4], u32x4 (&vv)[4]) {
            const int dil = AT_DIL(j), rr = AT_RR(j), Mt = (t0 - rr) / dil - 128 + 32 * AT_KT(j);
            auto keypos = [&](int M) { int p = dil * M + rr; p = p < 0 ? 0 : p; p = p > seqmax ? seqmax : p; return p; };
#pragma unroll
            for (int q = 0; q < 4; ++q) {
                const bf16_t* rp = base + (size_t)keypos(Mt + 8 * q + lrow) * 3072;
                kk[q] = *(const u32x4*)(rp + 1024 + 8 * (lpc ^ lrow));
                vv[q] = *(const u32x4*)(rp + 2048 + 8 * lpc);
            }
        };
#pragma unroll
        for (int j = 0; j < PD; ++j) issue(j, kr[j], vr[j]);
#pragma unroll
        for (int j = 0; j < NT; ++j) {
            if (j + PD < NT) issue(j + PD, kr[(j + PD) % NR], vr[(j + PD) % NR]);
            const int kt = AT_KT(j), dil = AT_DIL(j), rr = AT_RR(j), Mstart = (t0 - rr) / dil - 128, qi = AT_QS(j) * i32;
            f32x16 s;
#pragma unroll
            for (int q = 0; q < 16; ++q) s[q] = 0.f;
#pragma unroll
            for (int q = 0; q < 4; ++q) *(LAS u32x4*)(kbuf + (j & 1) * 4096 + q * 1024 + lane * 16) = kr[j % NR][q];
            bf16x8 kf[4];
#pragma unroll
            for (int d0 = 0; d0 < 4; ++d0) kf[d0] = *(const LAS bf16x8*)(kbuf + (j & 1) * 4096 + (i32 >> 3) * 1024 + (i32 & 7) * 128 + (((2 * d0 + hi) ^ (i32 & 7)) << 4));
#pragma unroll
            for (int d0 = 0; d0 < 4; ++d0) s = __builtin_amdgcn_mfma_f32_32x32x16_bf16(kf[d0], qf[d0], s, 0, 0, 0);
            const int hi_ = qi + 128 - 32 * kt; int lo = hi_ - 128; { const int nk = -(Mstart + 32 * kt); lo = lo > nk ? lo : nk; }
            const int rb = 4 * hi - lo; const unsigned span = (unsigned)(hi_ - lo);
            const bool any = hi_ >= lo;
            float tmax = NEG;
#pragma unroll
            for (int q = 0; q < 16; ++q) { const int rowc = (q & 3) + 8 * (q >> 2); const bool ok = any && ((unsigned)(rowc + rb) <= span) && (rowc + rb >= 0); s[q] = ok ? s[q] : NEG; tmax = fmaxf(tmax, s[q]); }
            tmax = fmaxf(tmax, bperm_f(lane ^ 32, tmax));
            const float m_new = fmaxf(m_run, tmax), sc = __builtin_amdgcn_exp2f(m_run - m_new);
            m_run = m_new;
            float ps = 0.f;
#pragma unroll
            for (int q = 0; q < 16; ++q) { s[q] = __builtin_amdgcn_exp2f(s[q] - m_new); ps += s[q]; }
            l_run = l_run * sc + ps;
#pragma unroll
            for (int q = 0; q < 16; ++q) { o0[q] *= sc; o1[q] *= sc; }
            u32x4 pw0, pw1;
            pw0.x = cvt_pk_bf16(s[0], s[1]); pw0.y = cvt_pk_bf16(s[2], s[3]); pw0.z = cvt_pk_bf16(s[4], s[5]); pw0.w = cvt_pk_bf16(s[6], s[7]);
            pw1.x = cvt_pk_bf16(s[8], s[9]); pw1.y = cvt_pk_bf16(s[10], s[11]); pw1.z = cvt_pk_bf16(s[12], s[13]); pw1.w = cvt_pk_bf16(s[14], s[15]);
            const bf16x8 pf0 = __builtin_bit_cast(bf16x8, pw0), pf1 = __builtin_bit_cast(bf16x8, pw1);
#pragma unroll
            for (int q = 0; q < 4; ++q) *(LAS u32x4*)(vbuf + (j & 1) * 4096 + ((lpc >> 2) * 2 + (q >> 1)) * 1024 + ((q & 1) * 8 + lrow) * 64 + (lpc & 3) * 16) = vr[j % NR][q];
            const LAS unsigned char* vb = vbuf + (j & 1) * 4096 + vrd;
#pragma unroll
            for (int dh = 0; dh < 2; ++dh) {
#pragma unroll
                for (int kg = 0; kg < 2; ++kg) {
                    const v4i16_t vlo = vtr16(vb + (dh * 2 + kg) * 1024), vhi = vtr16(vb + (dh * 2 + kg) * 1024 + 512);
                    const bf16x8 vf = (bf16x8){vlo[0], vlo[1], vlo[2], vlo[3], vhi[0], vhi[1], vhi[2], vhi[3]};
                    if (dh == 0) o0 = __builtin_amdgcn_mfma_f32_32x32x16_bf16(vf, kg == 0 ? pf0 : pf1, o0, 0, 0, 0);
                    else o1 = __builtin_amdgcn_mfma_f32_32x32x16_bf16(vf, kg == 0 ? pf0 : pf1, o1, 0, 0, 0);
                }
            }
        }
#undef AT_PAT
#undef AT_KT
#undef AT_DIL
#undef AT_QS
#undef AT_RR
        const float lt = l_run + bperm_f(lane ^ 32, l_run), rl = PASS == 1 ? 1.0f / lt : 1.0f;
        if (PASS == 0 && hi == 0) ml[srow * NH + hh] = make_float2(m_run, lt);
        bf16_t* op = (PASS == 1 ? att : ost) + srow * D + hh * 64 + 4 * hi;
#pragma unroll
        for (int gq = 0; gq < 4; ++gq) {
            u32x2 w0, w1;
            w0.x = cvt_pk_bf16(o0[4 * gq] * rl, o0[4 * gq + 1] * rl); w0.y = cvt_pk_bf16(o0[4 * gq + 2] * rl, o0[4 * gq + 3] * rl);
            w1.x = cvt_pk_bf16(o1[4 * gq] * rl, o1[4 * gq + 1] * rl); w1.y = cvt_pk_bf16(o1[4 * gq + 2] * rl, o1[4 * gq + 3] * rl);
            *(u32x2*)(op + 8 * gq) = w0; *(u32x2*)(op + 32 + 8 * gq) = w1;
        }
    }
}

__device__ __forceinline__ void phase_attn_coop1(const Ctx& X, const bf16_t* proj, bf16_t* att, const bf16_t* ost, const float2* ml) {
    using pg8::bf16x8;
    const int lane = X.lane, i32 = lane & 31, hi = lane >> 5, w = X.wave;
    LAS unsigned char* kimg = X.lds;
    LAS unsigned char* vimg = X.lds + 49152;
    const float NEG = opaque_f(-3.0e38f); const int seqmax = opaque_i(SEQ - 1);
    const int vrd = ((lane >> 4) & 1) * 32 + (lane & 3) * 8 + (4 * hi + ((lane & 15) >> 2)) * 64;
    const int lrow = X.tid >> 3, lpc = X.tid & 7;
    constexpr int NGRP = BATCH * NH * 32;
    const bool xdeal = (X.G == 256);
    const int ngi = xdeal ? 8 : (NGRP + X.G - 1) / X.G;
    auto group_of = [&](int it) { return xdeal ? (((it * 8 + (X.bid & 7)) << 5) | (X.bid >> 3)) : (X.bid + it * X.G); };
    u32x4 pk[6], pv[6];
    auto prefetch = [&](int grp) {
        const int half = grp & 1, r = (grp >> 1) & 15, hh = (grp >> 5) & 15, b = grp >> 9;
        const bf16_t* base = proj + (size_t)b * SEQ * 3072 + hh * 64;
#pragma unroll
        for (int i = 0; i < 6; ++i) {
            const int ridx = lrow + 64 * i, M = 32 * (8 * half - 4) + ridx;
            int p = 16 * M + r; p = p < 0 ? 0 : p; p = p > seqmax ? seqmax : p;
            const bf16_t* rp = base + (size_t)p * 3072;
            pk[i] = *(const u32x4*)(rp + 1024 + 8 * lpc); pv[i] = *(const u32x4*)(rp + 2048 + 8 * lpc);
        }
    };
    if (group_of(0) < NGRP) prefetch(group_of(0));
#pragma nounroll
    for (int it = 0; it < ngi; ++it) {
        const int grp = group_of(it);
        if (grp >= NGRP) break;
        const int half = grp & 1, r = (grp >> 1) & 15, hh = (grp >> 5) & 15, b = grp >> 9;
        __syncthreads();
#pragma unroll
        for (int i = 0; i < 6; ++i) {
            const int ridx = lrow + 64 * i, tl = ridx >> 5, row = ridx & 31;
            *(LAS u32x4*)(kimg + tl * 4096 + row * 128 + ((lpc ^ (row & 7)) << 4)) = pk[i];
            *(LAS u32x4*)(vimg + tl * 4096 + ((lpc >> 2) * 2 + (row >> 4)) * 1024 + (row & 15) * 64 + (lpc & 3) * 16) = pv[i];
        }
        __syncthreads();
        const int blk = 8 * half + w, t0 = 512 * blk + r;
        const bf16_t* base = proj + (size_t)b * SEQ * 3072 + hh * 64;
        bf16x8 qf[4];
        { const bf16_t* qp = base + (size_t)(t0 + 16 * i32) * 3072 + 8 * hi;
#pragma unroll
          for (int d0 = 0; d0 < 4; ++d0) qf[d0] = *(const bf16x8*)(qp + 16 * d0); }
        const size_t srow = (size_t)(b * SEQ + t0 + 16 * i32);
        float m_run, l_run; f32x16 o0, o1;
        { const float2 mlv = ml[srow * NH + hh]; m_run = mlv.x; l_run = hi == 0 ? mlv.y : 0.f;
          const bf16_t* sp = ost + srow * D + hh * 64 + 4 * hi;
#pragma unroll
          for (int gq = 0; gq < 4; ++gq) { const u32x2 w0 = *(const u32x2*)(sp + 8 * gq), w1 = *(const u32x2*)(sp + 32 + 8 * gq);
              o0[4 * gq] = bf_lo(w0.x); o0[4 * gq + 1] = bf_hi(w0.x); o0[4 * gq + 2] = bf_lo(w0.y); o0[4 * gq + 3] = bf_hi(w0.y);
              o1[4 * gq] = bf_lo(w1.x); o1[4 * gq + 1] = bf_hi(w1.x); o1[4 * gq + 2] = bf_lo(w1.y); o1[4 * gq + 3] = bf_hi(w1.y); } }
        { const int gn = it + 1 < ngi ? group_of(it + 1) : NGRP; if (gn < NGRP) prefetch(gn); }
        const int Mstart = 32 * blk - 128;
#pragma unroll
        for (int kt = 0; kt < 5; ++kt) {
            const LAS unsigned char* kt_ = kimg + (w + kt) * 4096; const LAS unsigned char* vt_ = vimg + (w + kt) * 4096 + vrd;
            bf16x8 kf[4];
#pragma unroll
            for (int d0 = 0; d0 < 4; ++d0) kf[d0] = *(const LAS bf16x8*)(kt_ + i32 * 128 + (((2 * d0 + hi) ^ (i32 & 7)) << 4));
            f32x16 s;
#pragma unroll
            for (int q = 0; q < 16; ++q) s[q] = 0.f;
#pragma unroll
            for (int d0 = 0; d0 < 4; ++d0) s = __builtin_amdgcn_mfma_f32_32x32x16_bf16(kf[d0], qf[d0], s, 0, 0, 0);
            const int hi_ = i32 + 128 - 32 * kt; int lo = hi_ - 128; { const int nk = -(Mstart + 32 * kt); lo = lo > nk ? lo : nk; }
            const int rb = 4 * hi - lo; const unsigned span = (unsigned)(hi_ - lo);
            const bool any = hi_ >= lo;
            float tmax = NEG;
#pragma unroll
            for (int q = 0; q < 16; ++q) { const int rowc = (q & 3) + 8 * (q >> 2); const bool ok = any && ((unsigned)(rowc + rb) <= span) && (rowc + rb >= 0); s[q] = ok ? s[q] : NEG; tmax = fmaxf(tmax, s[q]); }
            tmax = fmaxf(tmax, bperm_f(lane ^ 32, tmax));
            const float m_new = fmaxf(m_run, tmax), sc = __builtin_amdgcn_exp2f(m_run - m_new);
            m_run = m_new;
            float ps = 0.f;
#pragma unroll
            for (int q = 0; q < 16; ++q) { s[q] = __builtin_amdgcn_exp2f(s[q] - m_new); ps += s[q]; }
            l_run = l_run * sc + ps;
#pragma unroll
            for (int q = 0; q < 16; ++q) { o0[q] *= sc; o1[q] *= sc; }
            u32x4 pw0, pw1;
            pw0.x = cvt_pk_bf16(s[0], s[1]); pw0.y = cvt_pk_bf16(s[2], s[3]); pw0.z = cvt_pk_bf16(s[4], s[5]); pw0.w = cvt_pk_bf16(s[6], s[7]);
            pw1.x = cvt_pk_bf16(s[8], s[9]); pw1.y = cvt_pk_bf16(s[10], s[11]); pw1.z = cvt_pk_bf16(s[12], s[13]); pw1.w = cvt_pk_bf16(s[14], s[15]);
            const bf16x8 pf0 = __builtin_bit_cast(bf16x8, pw0), pf1 = __builtin_bit_cast(bf16x8, pw1);
#pragma unroll
            for (int dh = 0; dh < 2; ++dh) {
#pragma unroll
                for (int kg = 0; kg < 2; ++kg) {
                    const v4i16_t vlo = vtr16(vt_ + (dh * 2 + kg) * 1024), vhi = vtr16(vt_ + (dh * 2 + kg) * 1024 + 512);
                    const bf16x8 vf = (bf16x8){vlo[0], vlo[1], vlo[2], vlo[3], vhi[0], vhi[1], vhi[2], vhi[3]};
                    if (dh == 0) o0 = __builtin_amdgcn_mfma_f32_32x32x16_bf16(vf, kg == 0 ? pf0 : pf1, o0, 0, 0, 0);
                    else o1 = __builtin_amdgcn_mfma_f32_32x32x16_bf16(vf, kg == 0 ? pf0 : pf1, o1, 0, 0, 0);
                }
            }
        }
        const float lt = l_run + bperm_f(lane ^ 32, l_run), rl = 1.0f / lt;
        bf16_t* op = att + srow * D + hh * 64 + 4 * hi;
#pragma unroll
        for (int gq = 0; gq < 4; ++gq) {
            u32x2 w0, w1;
            w0.x = cvt_pk_bf16(o0[4 * gq] * rl, o0[4 * gq + 1] * rl); w0.y = cvt_pk_bf16(o0[4 * gq + 2] * rl, o0[4 * gq + 3] * rl);
            w1.x = cvt_pk_bf16(o1[4 * gq] * rl, o1[4 * gq + 1] * rl); w1.y = cvt_pk_bf16(o1[4 * gq + 2] * rl, o1[4 * gq + 3] * rl);
            *(u32x2*)(op + 8 * gq) = w0; *(u32x2*)(op + 32 + 8 * gq) = w1;
        }
    }
    __syncthreads();
}

__device__ __forceinline__ void phase_ln_router(const Ctx& X, int layer, const bf16_t* hin, const bf16_t* mixo, const float* g, const float* bta, const float* rb, bf16_t* h1) {
    using pg8::bf16x8;
    LAS unsigned char* Ah = X.lds;
    LAS unsigned char* Al = X.lds + 65536;
    LAS float* P = (LAS float*)X.lds;
    LAS int* s_cnt = (LAS int*)(X.lds + TAB_OFF);
    LAS int* s_gb = s_cnt + 32;
    const int lane = X.lane, w = X.wave, tok = lane & 31, hi = lane >> 5;
    int* tok_e = (int*)(X.ws + WS_TOKE); int* tok_r = (int*)(X.ws + WS_TOKR); float* glist = (float*)(X.ws + WS_GLIST); unsigned char* XG8 = (unsigned char*)(X.ws + WS_XG);
    unsigned* cnt = X.ctl + CW_CNT + layer * 32 * 64;
    const float rbe = rb[tok]; const float ninf = opaque_f(-INFINITY);
    const auto rs_h = __builtin_amdgcn_make_buffer_rsrc((void*)hin, 0, -1, 0x00020000), rs_m = __builtin_amdgcn_make_buffer_rsrc((void*)mixo, 0, -1, 0x00020000);
#define LNA_LD(rs_, tokidx_, j_) __builtin_bit_cast(u32x4, __builtin_amdgcn_raw_buffer_load_b128(rs_, lane * 16, (tokidx_) * (D * 2) + (j_) * 1024, 0))
    const int tb = X.bid * 128;
    if (tb < T) {
        u32x4 raw[4][4];
#pragma unroll
        for (int tl = 0; tl < 4; ++tl) { const int ti_ = __builtin_amdgcn_readfirstlane(tb + w * 4 + tl);
#pragma unroll
            for (int j = 0; j < 2; ++j) { raw[tl][2 * j] = LNA_LD(rs_h, ti_, j); raw[tl][2 * j + 1] = LNA_LD(rs_m, ti_, j); } }
#pragma nounroll
        for (int rnd = 0; rnd < 4; ++rnd) {
            __syncthreads();
            if (X.tid < 32) s_cnt[X.tid] = 0;
            const int t0 = tb + rnd * 32 + w * 4;
            int lane_o = lane; asm volatile("" : "+v"(lane_o));
            const int tok_o = lane_o & 31, hi_o = lane_o >> 5;
            float v[4][16]; u32x2 xo[4][2];
            const float* g2 = g; const float* b2 = bta; asm volatile("" : "+s"(g2), "+s"(b2));
#pragma unroll
            for (int tl = 0; tl < 4; ++tl) {
                const size_t rowo = (size_t)(t0 + tl) * D;
                float s = 0.f;
#pragma unroll
                for (int j = 0; j < 2; ++j) { float a[8], m[8]; unpack8(raw[tl][2 * j], a); unpack8(raw[tl][2 * j + 1], m);
#pragma unroll
                    for (int q = 0; q < 8; ++q) { v[tl][j * 8 + q] = DN_ALPHA * a[q] + m[q]; s += v[tl][j * 8 + q]; } }
                const float mean = wave_sum(s) * (1.f / D); float s2 = 0.f;
#pragma unroll
                for (int q = 0; q < 16; ++q) { v[tl][q] -= mean; s2 += v[tl][q] * v[tl][q]; }
                const float rstd = rsqrtf(wave_sum(s2) * (1.f / D) + opaque_f(LN_EPS));
#pragma unroll
                for (int j = 0; j < 2; ++j) { const f32x4 g0 = *(const f32x4*)(g2 + j * 512 + lane * 8), g1 = *(const f32x4*)(g2 + j * 512 + lane * 8 + 4), b0 = *(const f32x4*)(b2 + j * 512 + lane * 8), b1 = *(const f32x4*)(b2 + j * 512 + lane * 8 + 4);
#pragma unroll
                    for (int q = 0; q < 4; ++q) { v[tl][j * 8 + q] = v[tl][j * 8 + q] * rstd * g0[q] + b0[q]; v[tl][j * 8 + 4 + q] = v[tl][j * 8 + 4 + q] * rstd * g1[q] + b1[q]; } }
                xo[tl][0].x = pk4_fp8(v[tl][0], v[tl][1], v[tl][2], v[tl][3]); xo[tl][0].y = pk4_fp8(v[tl][4], v[tl][5], v[tl][6], v[tl][7]);
                xo[tl][1].x = pk4_fp8(v[tl][8], v[tl][9], v[tl][10], v[tl][11]); xo[tl][1].y = pk4_fp8(v[tl][12], v[tl][13], v[tl][14], v[tl][15]);
                const int tr = w * 4 + tl;
#pragma unroll
                for (int j = 0; j < 2; ++j) {
                    u32x4 oh, ol; float lo[8];
                    oh.x = cvt_pk_bf16(v[tl][j * 8 + 0], v[tl][j * 8 + 1]); oh.y = cvt_pk_bf16(v[tl][j * 8 + 2], v[tl][j * 8 + 3]); oh.z = cvt_pk_bf16(v[tl][j * 8 + 4], v[tl][j * 8 + 5]); oh.w = cvt_pk_bf16(v[tl][j * 8 + 6], v[tl][j * 8 + 7]);
                    float hf[8]; unpack8(oh, hf);
#pragma unroll
                    for (int q = 0; q < 8; ++q) lo[q] = v[tl][j * 8 + q] - hf[q];
                    ol = pack8(lo);
                    *(u32x4*)(h1 + rowo + j * 512 + lane * 8) = oh;
                    const int ch = ((lane_o + 64 * j) ^ (tr & 7)) << 4;
                    *(LAS u32x4*)(Ah + tr * 2048 + ch) = oh; *(LAS u32x4*)(Al + tr * 2048 + ch) = ol;
                }

            }
            if (rnd < 3) {
#pragma unroll
                for (int tl = 0; tl < 4; ++tl) { const int ti_ = __builtin_amdgcn_readfirstlane(t0 + 32 + tl);
#pragma unroll
                    for (int j = 0; j < 2; ++j) { raw[tl][2 * j] = LNA_LD(rs_h, ti_, j); raw[tl][2 * j + 1] = LNA_LD(rs_m, ti_, j); } } }
            bf16x8 wfh[8], wfl[8];
            { const bf16_t* rwh = (const bf16_t*)(X.ws + WS_RWH) + ((size_t)layer * NE + tok) * D + 128 * w + 8 * hi; const bf16_t* rwl = (const bf16_t*)(X.ws + WS_RWL) + ((size_t)layer * NE + tok) * D + 128 * w + 8 * hi;
#pragma unroll
              for (int i = 0; i < 8; ++i) { wfh[i] = *(const bf16x8*)(rwh + 16 * i); wfl[i] = *(const bf16x8*)(rwl + 16 * i); } }
            __syncthreads();
            f32x16 acc;
#pragma unroll
            for (int q = 0; q < 16; ++q) acc[q] = 0.f;
#pragma unroll
            for (int i = 0; i < 8; ++i) {
                const int ch = ((2 * (8 * w + i) + hi_o) ^ (tok_o & 7)) << 4;
                const bf16x8 bh = *(const LAS bf16x8*)(Ah + tok_o * 2048 + ch), bl = *(const LAS bf16x8*)(Al + tok_o * 2048 + ch);
                acc = __builtin_amdgcn_mfma_f32_32x32x16_bf16(wfh[i], bh, acc, 0, 0, 0);
                acc = __builtin_amdgcn_mfma_f32_32x32x16_bf16(wfl[i], bh, acc, 0, 0, 0);
                acc = __builtin_amdgcn_mfma_f32_32x32x16_bf16(wfh[i], bl, acc, 0, 0, 0);
            }
            __syncthreads();
#pragma unroll
            for (int q = 0; q < 16; ++q) P[(w * 32 + tok) * 33 + (q & 3) + 8 * (q >> 2) + 4 * hi] = acc[q];
            __syncthreads();
            float lg[4];
#pragma unroll
            for (int tl = 0; tl < 4; ++tl) { float a = 0.f;
#pragma unroll
                for (int ww = 0; ww < 4; ++ww) a += P[((hi * 4 + ww) * 32 + (w * 4 + tl)) * 33 + tok];
                a += bperm_f(lane_o ^ 32, a); lg[tl] = a + rbe; }
            const int e = tok;
            int my_e = 0; float my_g = 0.f;
#pragma unroll
            for (int tl = 0; tl < 4; ++tl) {
                float cur = lg[tl];
                float sv0 = 0.f, sv1 = 0.f, sv2 = 0.f, sv3 = 0.f; int si0 = 0, si1 = 0, si2 = 0, si3 = 0;
#pragma unroll
                for (int k = 0; k < 4; ++k) {
                    float bv = cur; int bi = e;
#define LNA_XS(o) { const float ov = swz_f<o>(bv); const int oi = swz_i<o>(bi); if (ov > bv || (ov == bv && oi < bi)) { bv = ov; bi = oi; } }
                    LNA_XS(1) LNA_XS(2) LNA_XS(4) LNA_XS(8) LNA_XS(16)
#undef LNA_XS
                    if (k == 0) { sv0 = bv; si0 = bi; } else if (k == 1) { sv1 = bv; si1 = bi; } else if (k == 2) { sv2 = bv; si2 = bi; } else { sv3 = bv; si3 = bi; }
                    if (e == bi) cur = ninf;
                }
                const float e1 = __expf(sv1 - sv0), e2 = __expf(sv2 - sv0), e3 = __expf(sv3 - sv0), inv = 1.f / (1.f + e1 + e2 + e3);
                if ((lane >> 2) == tl) { const int k = lane & 3; my_e = k == 0 ? si0 : k == 1 ? si1 : k == 2 ? si2 : si3; my_g = (k == 0 ? 1.f : k == 1 ? e1 : k == 2 ? e2 : e3) * inv; }
            }
            int my_lr = 0;
            if (lane < 16) my_lr = __hip_atomic_fetch_add(&s_cnt[my_e], 1, __ATOMIC_RELAXED, __HIP_MEMORY_SCOPE_WORKGROUP);
            __syncthreads();
            { int tid_o = X.tid; asm volatile("" : "+v"(tid_o));
              if (tid_o < 32) { const int c = s_cnt[tid_o]; s_gb[tid_o] = c ? (int)atomicAdd(cnt + tid_o * 64, (unsigned)c) : 0; } }
            __syncthreads();
            int my_r = 0;
            if (lane < 16) { my_r = s_gb[my_e] + my_lr; const int t = t0 + (lane >> 2); tok_e[t * 4 + (lane & 3)] = my_e; tok_r[t * 4 + (lane & 3)] = my_r; glist[(size_t)my_e * T + my_r] = my_g; }
#pragma unroll
            for (int tl = 0; tl < 4; ++tl) {
#pragma unroll
                for (int k = 0; k < 4; ++k) { const int ee = bperm_i(tl * 4 + k, my_e), rr = bperm_i(tl * 4 + k, my_r);
                    unsigned char* dst = XG8 + ((size_t)ee * T + rr) * D + lane * 8;
                    *(u32x2*)(dst) = xo[tl][0]; *(u32x2*)(dst + 512) = xo[tl][1]; }
            }
        }
    }
}
#undef LNA_LD

__device__ __forceinline__ void load_tile_table(const Ctx& X, int layer, LAS int* tb) {
    __syncthreads();
    if (X.tid < 64) {
        const int c = X.tid < 32 ? (int)__hip_atomic_load(X.ctl + CW_CNT + (layer * 32 + X.tid) * 64, RLX_AGENT) : 0;
        const int tl = (c + 255) >> 8; int incl = tl;
#pragma unroll
        for (int o = 1; o < 32; o <<= 1) { const int t = bperm_i(X.lane - o, incl); if ((X.tid & 31) >= o) incl += t; }
        if (X.tid < 32) { tb[X.tid] = incl - tl; if (X.tid == 31) tb[32] = incl; }
    }
    __syncthreads();
}

template <bool OUT_F32>
__device__ __forceinline__ void phase_combine_ln(const Ctx& X, int layer, const bf16_t* h1, const bf16_t* Y, const float* g, const float* bta, void* outp) {
    const int lane = X.lane;
    const int gw = X.bid * NWAVES + X.wave, NGW = X.G * NWAVES;
    const int* tok_e = (const int*)(X.ws + WS_TOKE); const int* tok_r = (const int*)(X.ws + WS_TOKR);
    int basev = 0;
    { const int c = lane < 32 ? (int)__hip_atomic_load(X.ctl + CW_CNT + (layer * 32 + lane) * 64, RLX_AGENT) : 0; const int pc = ((c + 255) >> 8) << 8; int incl = pc;
#pragma unroll
      for (int o = 1; o < 32; o <<= 1) { const int t = bperm_i(lane - o, incl); if ((lane & 31) >= o) incl += t; }
      basev = incl - pc; }
    float gg[16], bb[16];
#pragma unroll
    for (int j = 0; j < 2; ++j) {
        const f32x4 g0 = *(const f32x4*)(g + j * 512 + lane * 8), g1 = *(const f32x4*)(g + j * 512 + lane * 8 + 4), b0 = *(const f32x4*)(bta + j * 512 + lane * 8), b1 = *(const f32x4*)(bta + j * 512 + lane * 8 + 4);
#pragma unroll
        for (int q = 0; q < 4; ++q) { gg[j * 8 + q] = g0[q]; gg[j * 8 + 4 + q] = g1[q]; bb[j * 8 + q] = b0[q]; bb[j * 8 + 4 + q] = b1[q]; }
    }
    for (int bt = gw; bt < T; bt += NGW) {
        int myslot = 0;
        if (lane < 4) myslot = tok_r[bt * 4 + lane];
        const int mye = lane < 4 ? tok_e[bt * 4 + lane] : 0;
        myslot += bperm_i(mye, basev);
        const int s0 = bperm_i(0, myslot), s1 = bperm_i(1, myslot), s2 = bperm_i(2, myslot), s3 = bperm_i(3, myslot);
        float v[16]; float s = 0.f;
#pragma unroll
        for (int j = 0; j < 2; ++j) {
            const int off = j * 512 + lane * 8;
            float a[8], y0[8], y1[8], y2[8], y3[8];
            unpack8(*(const u32x4*)(h1 + (size_t)bt * D + off), a);
            const unsigned char* Y8 = (const unsigned char*)Y;
            unpack8_fp8(*(const u32x2*)(Y8 + (size_t)s0 * D + off), y0); unpack8_fp8(*(const u32x2*)(Y8 + (size_t)s1 * D + off), y1); unpack8_fp8(*(const u32x2*)(Y8 + (size_t)s2 * D + off), y2); unpack8_fp8(*(const u32x2*)(Y8 + (size_t)s3 * D + off), y3);
#pragma unroll
            for (int q = 0; q < 8; ++q) { v[j * 8 + q] = DN_ALPHA * a[q] + (((y0[q] + y1[q]) + y2[q]) + y3[q]) * (1.0f / Y8_SCALE); s += v[j * 8 + q]; }
        }
        const float mean = wave_sum(s) * (1.f / D); float s2q = 0.f;
#pragma unroll
        for (int q = 0; q < 16; ++q) { v[q] -= mean; s2q += v[q] * v[q]; }
        const float rstd = rsqrtf(wave_sum(s2q) * (1.f / D) + opaque_f(LN_EPS));
#pragma unroll
        for (int q = 0; q < 16; ++q) v[q] = v[q] * rstd * gg[q] + bb[q];
#pragma unroll
        for (int j = 0; j < 2; ++j) {
            const size_t o = (size_t)bt * D + j * 512 + lane * 8;
            if (OUT_F32) { float* op = (float*)outp + o; *(f32x4*)(op) = (f32x4){v[j * 8 + 0], v[j * 8 + 1], v[j * 8 + 2], v[j * 8 + 3]}; *(f32x4*)(op + 4) = (f32x4){v[j * 8 + 4], v[j * 8 + 5], v[j * 8 + 6], v[j * 8 + 7]}; }
            else { u32x4 w; w.x = cvt_pk_bf16(v[j * 8 + 0], v[j * 8 + 1]); w.y = cvt_pk_bf16(v[j * 8 + 2], v[j * 8 + 3]); w.z = cvt_pk_bf16(v[j * 8 + 4], v[j * 8 + 5]); w.w = cvt_pk_bf16(v[j * 8 + 6], v[j * 8 + 7]); *(u32x4*)((bf16_t*)outp + o) = w; }
        }
    }
}


__device__ __forceinline__ Ctx refresh_ctx(const Ctx& X0) {
    Ctx X = X0; int wv = X0.wave; asm volatile("" : "+s"(wv)); int t = wv * 64 + lane_id(); asm volatile("" : "+v"(t)); X.tid = t; X.lane = t & 63; X.wave = wv;
    asm volatile("" : "+s"(X.ws), "+s"(X.ctl), "+s"(X.G), "+s"(X.bid));
    return X;
}
struct Args { const float* in[26]; float* out; unsigned char* ws; int ph_lo, ph_hi; };
constexpr int N_PHASES = 1 + 2 * (6 + 4) + 2 * (4 + 4);
#define GP_ALIGN true
#define GP_SP2 true

__global__ void __launch_bounds__(NTHR, 2) mk_fwd(Args args) {
    extern __shared__ __attribute__((aligned(16))) unsigned char lds_raw[];
    Ctx X0;
    X0.lds = (LAS unsigned char*)lds_raw;
    X0.tid = threadIdx.x; X0.lane = X0.tid & 63; X0.wave = __builtin_amdgcn_readfirstlane(X0.tid >> 6);
    X0.G = gridDim.x; X0.bid = blockIdx.x;
    X0.ws = (GAS unsigned char*)args.ws; X0.ctl = (unsigned*)(args.ws + WS_CTL);
    volatile LAS unsigned* MISC = (volatile LAS unsigned*)(X0.lds + MISC_OFF);
    if (X0.tid < 32) MISC[X0.tid] = 0u;
    __syncthreads();
    XcdBarrier bar; bar.bar = X0.ctl + CW_BAR; bar.x = 0; bar.st = nullptr; bar.wave = X0.wave;
    if (MK_ONE_LAUNCH) bar = xcd_barrier_post(X0.ctl + CW_BAR, MISC + 8, X0.wave);
    volatile LAS unsigned long long* ptab = (volatile LAS unsigned long long*)(X0.lds + TAB_OFF + 1024);
    if (X0.tid < 26) ptab[X0.tid] = (unsigned long long)args.in[X0.tid];
    __syncthreads();
#define INP(k) ld_ptr(ptab, k)
    const int lo = args.ph_lo, hi = args.ph_hi;
    int ph = 0;
#define IN() (lo <= ph && ph < hi)
#define SEAM() do { if (MK_ONE_LAUNCH && lo <= ph && ph + 1 < hi) xcd_barrier(bar); ++ph; } while (0)

#define H0 ((bf16_t*)(X.ws + WS_H0))
#define H1 ((bf16_t*)(X.ws + WS_H1))
#define PROJ ((bf16_t*)(X.ws + WS_PROJ))
#define MIX ((bf16_t*)(X.ws + WS_MIX))
#define MIXO ((bf16_t*)(X.ws + WS_MIXO))
#define Z ((bf16_t*)(X.ws + WS_Z))
#define ACT ((bf16_t*)(X.ws + WS_ACT))
#define Y ((bf16_t*)(X.ws + WS_Y))
#define tb ((LAS int*)(X.lds + TAB_OFF + 512))

#ifndef DUP_MASK
#define DUP_MASK 0
#endif
    enum { P_PRO, P_E1, P_S5A, P_S5C, P_S5B, P_E3, P_E4, P_O1, P_ATT, P_O3, P_LNA, P_M1, P_M2, P_LNB };
#define PHASE_BEGIN(k) _Pragma("nounroll") for (int _r = 0; _r < ((((DUP_MASK) >> (k)) & 1) + 1); ++_r) { if (IN()) { const Ctx X = refresh_ctx(X0);
#define PHASE_END } SEAM(); }
    PHASE_BEGIN(P_PRO)  phase_prologue(X, ptab);  PHASE_END

#pragma nounroll
    for (int layer = 0; layer < DEPTH; ++layer) {
        const int i = layer >> 1;
        if ((layer & 1) == 0) {
            PHASE_BEGIN(P_E1)  pg8::Gemm gm{H0, (const bf16_t*)(X.ws + WS_WIN) + (size_t)i * 2048 * D, T, 2048, D}; pg8::StaticOrder S; S.init(T, 2048, D, X.G, X.bid);
                pg8::EpiStore E{PROJ, 2048};
                pg8::gemm_phase<pg8::EpiStore, pg8::StaticOrder, GP_ALIGN, GP_SP2>(X.lds, gm, S, E, X.wave);  PHASE_END
            PHASE_BEGIN(P_S5A)  phase_s5<1>(X, i, PROJ, INP(2), INP(8), INP(9), INP(10), MIX, Z);  PHASE_END
            PHASE_BEGIN(P_S5C)  phase_s5_carry(X, i);  PHASE_END
            PHASE_BEGIN(P_S5B)  phase_s5<2>(X, i, PROJ, INP(2), INP(8), INP(9), INP(10), MIX, Z);  PHASE_END
            PHASE_BEGIN(P_E3)  pg8::Gemm gm{Z, (const bf16_t*)(X.ws + WS_WGLU) + (size_t)i * 512 * 512, T, 512, 512}; pg8::StaticOrder S; S.init(T, 512, 512, X.G, X.bid);
                pg8::EpiGlu E{Z, MIX, INP(12) + (size_t)i * SSM_W};
                pg8::gemm_phase<pg8::EpiGlu, pg8::StaticOrder, GP_ALIGN, GP_SP2>(X.lds, gm, S, E, X.wave);  PHASE_END
            PHASE_BEGIN(P_E4)  pg8::Gemm gm{MIX, (const bf16_t*)(X.ws + WS_WOUT) + (size_t)i * D * D, T, D, D}; pg8::StaticOrder S; S.init(T, D, D, X.G, X.bid);
                pg8::EpiStore E{MIXO, D};
                pg8::gemm_phase<pg8::EpiStore, pg8::StaticOrder, GP_ALIGN, GP_SP2>(X.lds, gm, S, E, X.wave);  PHASE_END
        } else {
            PHASE_BEGIN(P_O1)  pg8::Gemm gm{H0, (const bf16_t*)(X.ws + WS_WQKV) + (size_t)i * 3072 * D, T, 3072, D}; pg8::StaticOrder S; S.init(T, 3072, D, X.G, X.bid);
                pg8::EpiRope E{PROJ, (const f32x2*)(X.ws + WS_ROPE)};
                pg8::gemm_phase<pg8::EpiRope, pg8::StaticOrder, GP_ALIGN, GP_SP2>(X.lds, gm, S, E, X.wave);  PHASE_END
            PHASE_BEGIN(P_ATT)  phase_attn<0>(X, PROJ, MIX, MIXO, (float2*)(X.ws + WS_S5X));  PHASE_END
            PHASE_BEGIN(P_ATT)  phase_attn_coop1(X, PROJ, MIX, MIXO, (const float2*)(X.ws + WS_S5X));  PHASE_END
            PHASE_BEGIN(P_O3)  pg8::Gemm gm{MIX, (const bf16_t*)(X.ws + WS_WO) + (size_t)i * D * D, T, D, D}; pg8::StaticOrder S; S.init(T, D, D, X.G, X.bid);
                pg8::EpiStore E{MIXO, D};
                pg8::gemm_phase<pg8::EpiStore, pg8::StaticOrder, GP_ALIGN, GP_SP2>(X.lds, gm, S, E, X.wave);  PHASE_END
        }
        PHASE_BEGIN(P_LNA)  phase_ln_router(X, layer, H0, MIXO, INP(16) + layer * D, INP(17) + layer * D, INP(21) + layer * NE, H1);  PHASE_END
        PHASE_BEGIN(P_M1)  load_tile_table(X, layer, tb);
            pg8::Gemm gm{(const bf16_t*)(X.ws + WS_XG), (const bf16_t*)(X.ws + WS_WGU + (size_t)layer * NE * 2048 * D), 0, 2048, D / 2};
            pg8::MoeOrder<8, true> S; S.init(tb, X.G, X.bid, 2048, D / 2);
#ifdef PROBE_NOSTORE
            pg8::EpiSwiglu E{opaque_i(((DUP_MASK >> P_M1) & 1) && _r == 0) != 0, ACT, INP(23) + (size_t)layer * NE * 2048};
#else
            pg8::EpiSwiglu E{ACT, INP(23) + (size_t)layer * NE * 2048};
#endif
#if defined(PROBE_M1)
            if (_r == 0) pg8::gemm_phase<pg8::EpiSwiglu, pg8::MoeOrder<8, true>, GP_ALIGN, GP_SP2, true, PROBE_M1>(X.lds, gm, S, E, X.wave, opaque_i(127 - W8_SHIFT_GU), opaque_i(127)); else
#endif
            pg8::gemm_phase<pg8::EpiSwiglu, pg8::MoeOrder<8, true>, GP_ALIGN, GP_SP2, true>(X.lds, gm, S, E, X.wave, opaque_i(127 - W8_SHIFT_GU), opaque_i(127));  PHASE_END
        PHASE_BEGIN(P_M2)  load_tile_table(X, layer, tb);
            pg8::Gemm gm{ACT, (const bf16_t*)(X.ws + WS_WDN + (size_t)layer * NE * D * D), 0, D, D / 2};
            pg8::MoeOrder<4, false> S; S.init(tb, X.G, X.bid, D, D / 2);
#ifdef PROBE_NOSTORE
            pg8::EpiDown E{opaque_i(((DUP_MASK >> P_M2) & 1) && _r == 0) != 0, Y, INP(25) + (size_t)layer * NE * D, (const float*)(X.ws + WS_GLIST)};
#else
            pg8::EpiDown E{Y, INP(25) + (size_t)layer * NE * D, (const float*)(X.ws + WS_GLIST)};
#endif
#if defined(PROBE_M2)
            if (_r == 0) pg8::gemm_phase<pg8::EpiDown, pg8::MoeOrder<4, false>, GP_ALIGN, GP_SP2, true, PROBE_M2>(X.lds, gm, S, E, X.wave, opaque_i(127 - W8_SHIFT_DN), opaque_i(127)); else
#endif
            pg8::gemm_phase<pg8::EpiDown, pg8::MoeOrder<4, false>, GP_ALIGN, GP_SP2, true>(X.lds, gm, S, E, X.wave, opaque_i(127 - W8_SHIFT_DN), opaque_i(127));  PHASE_END
        PHASE_BEGIN(P_LNB)
            if (layer == DEPTH - 1) phase_combine_ln<true>(X, layer, H1, Y, INP(18) + layer * D, INP(19) + layer * D, (void*)args.out);
            else phase_combine_ln<false>(X, layer, H1, Y, INP(18) + layer * D, INP(19) + layer * D, (void*)H0);
         PHASE_END
    }
#undef IN
#undef SEAM
#undef PHASE_BEGIN
#undef PHASE_END
#undef H0
#undef H1
#undef PROJ
#undef MIX
#undef MIXO
#undef Z
#undef ACT
#undef Y
#undef tb
}

extern "C" void kernel_launch(void* const* d_in, const int* in_sizes, int n_in, void* d_out, int out_size, void* d_ws, size_t ws_size, hipStream_t stream) {
    static int grid = 0;
    if (grid == 0) {
        if (n_in != 26 || out_size != T * D || ws_size < WS_END) { fprintf(stderr, "kernel_launch: unexpected shapes n_in %d out %d ws %zu (need %zu)\n", n_in, out_size, ws_size, (size_t)WS_END); grid = -1; return; }
        int dev = 0, cus = 0, per_cu = 0;
        if (hipGetDevice(&dev) != hipSuccess || hipDeviceGetAttribute(&cus, hipDeviceAttributeMultiprocessorCount, dev) != hipSuccess) { grid = -1; return; }
        if (hipFuncSetAttribute((const void*)mk_fwd, hipFuncAttributeMaxDynamicSharedMemorySize, LDS_BYTES) != hipSuccess) { fprintf(stderr, "kernel_launch: hipFuncSetAttribute failed\n"); grid = -1; return; }
        if (hipOccupancyMaxActiveBlocksPerMultiprocessor(&per_cu, (const void*)mk_fwd, NTHR, LDS_BYTES) != hipSuccess || per_cu < 1) fprintf(stderr, "kernel_launch: occupancy query says %d\n", per_cu);
        (void)hipGetLastError();
        grid = cus;
        if (grid < 256) { fprintf(stderr, "kernel_launch: %d CUs; the LN+router phase deals one 128-token slab per workgroup and needs 256\n", cus); grid = -1; return; }
        if (grid > 256) grid = 256;
    }
    if (grid < 0) return;
    if (hipMemsetAsync((char*)d_ws + WS_CTL, 0, CTL_ZERO_BYTES, stream) != hipSuccess) return;
    Args a{};
    for (int i = 0; i < 26; ++i) a.in[i] = (const float*)d_in[i];
    a.out = (float*)d_out; a.ws = (unsigned char*)d_ws;
#if MK_ONE_LAUNCH
    a.ph_lo = 0; a.ph_hi = DUP_MASK ? 100000 : N_PHASES;
    hipLaunchKernelGGL(mk_fwd, dim3(grid), dim3(NTHR), LDS_BYTES, stream, a);
#else
    for (int p = 0; p < N_PHASES; ++p) { a.ph_lo = p; a.ph_hi = p + 1; hipLaunchKernelGGL(mk_fwd, dim3(grid), dim3(NTHR), LDS_BYTES, stream, a); }
#endif
}
```

```cpp
#include <hip/hip_runtime.h>
#include <cstdio>
#include <cstdint>

#ifndef MK_ONE_LAUNCH
#define MK_ONE_LAUNCH 1
#endif

#define GAS __attribute__((address_space(1)))
#define LAS __attribute__((address_space(3)))
#define RLX_AGENT __ATOMIC_RELAXED, __HIP_MEMORY_SCOPE_AGENT
#define WAVE_SYNC() asm volatile("s_waitcnt lgkmcnt(0)" ::: "memory")
typedef float f32x4 __attribute__((ext_vector_type(4)));
typedef float f32x2 __attribute__((ext_vector_type(2)));
typedef unsigned u32x4 __attribute__((ext_vector_type(4)));
typedef unsigned u32x2 __attribute__((ext_vector_type(2)));
typedef unsigned short bf16_t;

constexpr int BATCH = 4, SEQ = 8192, D = 1024, T = BATCH * SEQ, DEPTH = 4;
constexpr int CONV_CH = 512, SSM_W = 512, SSM_G = 32, SSM_H = 16, SSM_P = 64;
constexpr int NH = 16, HD = 64;
constexpr int NE = 32, TOPK = 4, NA = T * TOPK;
constexpr float SW_LIMIT = 7.0f, SW_ALPHA = 1.702f;
constexpr float LN_EPS = 1e-5f;
constexpr float DN_ALPHA = 1.6817928305074290860622509524664f;
constexpr int NWAVES = 8, NTHR = 512;

constexpr size_t MiB = 1u << 20;
constexpr size_t WS_CTL = 0, CTL_ZERO_BYTES = 1 * MiB;
constexpr size_t WS_S5A = 1 * MiB;
constexpr size_t WS_S5B = 1 * MiB + 65536;
constexpr size_t WS_ROPE = 2 * MiB;
constexpr size_t WS_S5X = 48 * MiB;
constexpr size_t WS_TOKE = 4 * MiB;
constexpr size_t WS_TOKR = 4 * MiB + 524288;
constexpr size_t WS_RWH = 5 * MiB;
constexpr size_t WS_RWL = 5 * MiB + 262144;
constexpr size_t WS_GLIST = 8 * MiB;
constexpr size_t WS_S5S = 12 * MiB;
constexpr size_t WS_WIN = 16 * MiB;
constexpr size_t WS_WGLU = 24 * MiB;
constexpr size_t WS_WOUT = 26 * MiB;
constexpr size_t WS_WQKV = 32 * MiB;
constexpr size_t WS_WO = 44 * MiB;
constexpr size_t WS_WGU = 64 * MiB;
constexpr size_t WS_WDN = 576 * MiB;
constexpr size_t WS_H0 = 832 * MiB;
constexpr size_t WS_H1 = 896 * MiB;
constexpr size_t WS_PROJ = 960 * MiB;
constexpr size_t WS_MIX = 1152 * MiB;
constexpr size_t WS_MIXO = 1216 * MiB;
constexpr size_t WS_Z = 1280 * MiB;
constexpr size_t WS_ACT = 1312 * MiB;
constexpr size_t WS_Y = 1584 * MiB;
constexpr size_t WS_XG = 1856 * MiB;
constexpr size_t WS_STOK = 1920 * MiB;
constexpr size_t WS_END = 3904 * MiB;
constexpr int CW_BAR = 4096;
constexpr int CW_CNT = 16384;

constexpr int LDS_BYTES = 147456;
constexpr int MISC_OFF = 131072 + 320;
constexpr int TAB_OFF = 131072 + 1024;

#define XB_TMO      128
#define XB_XCNT(j)  (256  + 64 * (j))
#define XB_XSUB(j)  (1280 + 64 * (j))
#define XB_XGEN(j)  (2304 + 64 * (j))
#define XB_TOP      3328
#define XB_TOPGEN   3392
#define XCD_BAR_WORDS 3456
#define XB_SPIN_CAP (1u << 22)

__device__ __forceinline__ unsigned xb_ld(unsigned* p)              { return __hip_atomic_load(p, __ATOMIC_RELAXED, __HIP_MEMORY_SCOPE_AGENT); }
__device__ __forceinline__ unsigned xb_add(unsigned* p, unsigned v) { return __hip_atomic_fetch_add(p, v, __ATOMIC_RELAXED, __HIP_MEMORY_SCOPE_AGENT); }
__device__ __forceinline__ unsigned xb_xcc_id() { return (unsigned)__builtin_amdgcn_s_getreg((3 << 11) | 20) & 0xFu; }
#define XB_SPIN(cond, bar) do { unsigned _sp = 0; while (cond) { __builtin_amdgcn_s_sleep(1); \
    if ((++_sp & 255u) == 0u) { if (xb_ld(&(bar)[XB_TMO])) break; if (_sp > XB_SPIN_CAP) { atomicAdd(&(bar)[XB_TMO], 1u); break; } } } } while (0)

struct XcdBarrier { unsigned* bar; unsigned x; volatile LAS unsigned* st; int wave; };
__device__ __forceinline__ int xb_lane() { int l; asm volatile("v_mbcnt_lo_u32_b32 %0, -1, 0\n\tv_mbcnt_hi_u32_b32 %0, -1, %0" : "=v"(l)); return l; }

__device__ __forceinline__ XcdBarrier xcd_barrier_post(unsigned* bar, volatile LAS unsigned* st, int wave) {
    XcdBarrier b; b.bar = bar; b.x = xb_xcc_id(); b.st = st; b.wave = wave;
    if (wave == 0 && xb_lane() == 0) (void)xb_add(&bar[XB_XCNT(b.x)], 1u);
    return b;
}
__device__ __forceinline__ void xcd_barrier_complete(unsigned* bar, unsigned x, unsigned& nloc, unsigned& nx) {
    const unsigned G = gridDim.x * gridDim.y * gridDim.z;
    unsigned sum, cnt, mine, sp = 0u;
    for (;;) {
        sum = 0u; cnt = 0u; mine = 0u;
#pragma unroll
        for (unsigned j = 0; j < 16; ++j) { const unsigned c = xb_ld(&bar[XB_XCNT(j)]); sum += c; cnt += (c > 0u) ? 1u : 0u; mine = (j == x) ? c : mine; }
        if (sum == G) break;
        __builtin_amdgcn_s_sleep(1);
        if ((++sp & 255u) == 0u) { if (xb_ld(&bar[XB_TMO])) break; if (sp > XB_SPIN_CAP) { atomicAdd(&bar[XB_TMO], 1u); break; } }
    }
    nloc = mine > 0u ? mine : 1u; nx = cnt > 0u ? cnt : 1u;
}
__device__ __forceinline__ void xcd_barrier(const XcdBarrier& b) {
    asm volatile("s_waitcnt vmcnt(0)" ::: "memory");
    __syncthreads();
    if (b.wave == 0 && xb_lane() == 0) {
        unsigned* bar = b.bar;
        __builtin_amdgcn_s_waitcnt(0);
        unsigned nloc = b.st[0], nx = b.st[1];
        if (nloc == 0u) { xcd_barrier_complete(bar, b.x, nloc, nx); b.st[0] = nloc; b.st[1] = nx; }
        const unsigned old = xb_add(&bar[XB_XSUB(b.x)], 1u);
        const unsigned gen = old / nloc;
        if (old + 1u == (gen + 1u) * nloc) {
            __builtin_amdgcn_fence(__ATOMIC_RELEASE, "agent");
            asm volatile("s_waitcnt vmcnt(0)" ::: "memory");
            const unsigned og = xb_add(&bar[XB_TOP], 1u);
            const unsigned tg = og / nx;
            if (og + 1u == (tg + 1u) * nx) xb_add(&bar[XB_TOPGEN], 1u);
            else XB_SPIN(xb_ld(&bar[XB_TOPGEN]) == tg, bar);
            __builtin_amdgcn_fence(__ATOMIC_ACQUIRE, "agent");
            xb_add(&bar[XB_XGEN(b.x)], 1u);
            asm volatile("s_waitcnt vmcnt(0)" ::: "memory");
        } else {
            XB_SPIN(xb_ld(&bar[XB_XGEN(b.x)]) == gen, bar);
            __builtin_amdgcn_fence(__ATOMIC_ACQUIRE, "agent");
            asm volatile("s_waitcnt vmcnt(0)" ::: "memory");
        }
    }
    __syncthreads();
}

template <int M> __device__ __forceinline__ int swz_i(int v) { static_assert(M > 0 && M < 32, "ds_swizzle bit mode"); return __builtin_amdgcn_ds_swizzle(v, (M << 10) | 0x1f); }
template <int M> __device__ __forceinline__ float swz_f(float v) { return __builtin_bit_cast(float, swz_i<M>(__builtin_bit_cast(int, v))); }
__device__ __forceinline__ int bperm_i(int srclane, int v) { return __builtin_amdgcn_ds_bpermute(srclane << 2, v); }
__device__ __forceinline__ float bperm_f(int srclane, float v) { return __builtin_bit_cast(float, __builtin_amdgcn_ds_bpermute(srclane << 2, __builtin_bit_cast(int, v))); }
__device__ __forceinline__ float rdlane_f(float v, int l) { return __builtin_bit_cast(float, __builtin_amdgcn_readlane(__builtin_bit_cast(int, v), l)); }
__device__ __forceinline__ float wave_sum(float v) {
    v += swz_f<1>(v); v += swz_f<2>(v); v += swz_f<4>(v); v += swz_f<8>(v); v += swz_f<16>(v);
    return rdlane_f(v, 0) + rdlane_f(v, 32);
}
__device__ __forceinline__ float wave_max(float v) {
    v = fmaxf(v, swz_f<1>(v)); v = fmaxf(v, swz_f<2>(v)); v = fmaxf(v, swz_f<4>(v)); v = fmaxf(v, swz_f<8>(v)); v = fmaxf(v, swz_f<16>(v));
    return fmaxf(rdlane_f(v, 0), rdlane_f(v, 32));
}
__device__ __forceinline__ float sigmoidf_(float x) { return __builtin_amdgcn_rcpf(1.0f + __builtin_amdgcn_exp2f(-1.4426950408889634f * x)); }
__device__ __forceinline__ float gelu_tanh(float y) { return y * sigmoidf_(1.5957691216057308f * (y + 0.044715f * y * y * y)); }
__device__ __forceinline__ float opaque_f(float v) { asm volatile("" : "+s"(v)); return v; }
__device__ __forceinline__ int opaque_i(int v) { asm volatile("" : "+s"(v)); return v; }
__device__ __forceinline__ int seqpos(int bt) { return bt - ((bt >> 13) << 13); }
__device__ __forceinline__ unsigned f2bf(float f) { unsigned u = __builtin_bit_cast(unsigned, f); return (u + 0x7fffu + ((u >> 16) & 1u)) >> 16; }
__device__ __forceinline__ unsigned pk2(float lo, float hi) { return f2bf(lo) | (f2bf(hi) << 16); }
typedef float f32x2_t_ __attribute__((ext_vector_type(2))); typedef __bf16 bf16x2_t_ __attribute__((ext_vector_type(2)));
__device__ __forceinline__ unsigned cvt_pk_bf16(float lo, float hi) { const f32x2_t_ v = {lo, hi}; const bf16x2_t_ b = __builtin_convertvector(v, bf16x2_t_); return __builtin_bit_cast(unsigned, b); }
__device__ __forceinline__ float bf_lo(unsigned w) { return __builtin_bit_cast(float, w << 16); }
__device__ __forceinline__ float bf_hi(unsigned w) { return __builtin_bit_cast(float, w & 0xffff0000u); }
__device__ __forceinline__ float bf2f(bf16_t b) { return __builtin_bit_cast(float, ((unsigned)b) << 16); }
__device__ __forceinline__ void unpack8(const u32x4 w, float (&f)[8]) { f[0] = bf_lo(w.x); f[1] = bf_hi(w.x); f[2] = bf_lo(w.y); f[3] = bf_hi(w.y); f[4] = bf_lo(w.z); f[5] = bf_hi(w.z); f[6] = bf_lo(w.w); f[7] = bf_hi(w.w); }
__device__ __forceinline__ u32x4 pack8(const float (&f)[8]) { u32x4 w; w.x = cvt_pk_bf16(f[0], f[1]); w.y = cvt_pk_bf16(f[2], f[3]); w.z = cvt_pk_bf16(f[4], f[5]); w.w = cvt_pk_bf16(f[6], f[7]); return w; }

__device__ __forceinline__ unsigned pk4_fp8(float a, float b, float c, float d) {
    int w = __builtin_amdgcn_cvt_pk_fp8_f32(a, b, 0, false); w = __builtin_amdgcn_cvt_pk_fp8_f32(c, d, w, true); return (unsigned)w; }
__device__ __forceinline__ u32x2 pack8_fp8(const float (&f)[8]) { u32x2 w; w.x = pk4_fp8(f[0], f[1], f[2], f[3]); w.y = pk4_fp8(f[4], f[5], f[6], f[7]); return w; }
typedef float f32x2v_ __attribute__((ext_vector_type(2)));
__device__ __forceinline__ void unpack8_fp8(const u32x2 w, float (&f)[8]) {
    const f32x2v_ a = __builtin_amdgcn_cvt_pk_f32_fp8((int)w.x, false), b = __builtin_amdgcn_cvt_pk_f32_fp8((int)w.x, true), c = __builtin_amdgcn_cvt_pk_f32_fp8((int)w.y, false), d = __builtin_amdgcn_cvt_pk_f32_fp8((int)w.y, true);
    f[0] = a.x; f[1] = a.y; f[2] = b.x; f[3] = b.y; f[4] = c.x; f[5] = c.y; f[6] = d.x; f[7] = d.y; }
constexpr float Y8_SCALE = 16.0f;
constexpr int W8_SHIFT_GU = 5, W8_SHIFT_DN = 6;

__device__ __forceinline__ int lane_id() { int l; asm volatile("v_mbcnt_lo_u32_b32 %0, -1, 0\n\tv_mbcnt_hi_u32_b32 %0, -1, %0" : "=v"(l)); return l; }

struct Ctx {
    LAS unsigned char* lds;
    int tid, lane, wave, G, bid;
    unsigned* ctl;
    GAS unsigned char* ws;
};

namespace pg8 {
#define PG8_LAS __attribute__((address_space(3)))
typedef short bf16x8 __attribute__((ext_vector_type(8)));
constexpr int BM = 256, BK = 64, HALF = 128, HTB = HALF * BK * 2  , STAGE_BYTES = 8 * HTB, NXCD = 8, WGM = 8;

__host__ __device__ __forceinline__ int lds_byte(int r, int c) { const int st = (r >> 4) * 2 + (c >> 5), rr = r & 15, cc = c & 31, ob = rr * 64 + cc * 2; return st * 1024 + (ob ^ (((ob >> 9) & 1) << 5)); }
__host__ __device__ __forceinline__ void stage_rc(int b, int& R, int& C) { const int st = b / 1024, sb = b % 1024, swz = sb ^ (((sb >> 9) & 1) << 5); R = (st >> 1) * 16 + swz / 64; C = (st & 1) * 32 + (swz % 64) / 2; }
__host__ __device__ __forceinline__ int perm32(int rho) { const int n = rho >> 4, i = rho & 15; return 8 * (i >> 2) + 4 * n + (i & 3); }

struct Unit { int pm, pn, e, mt; };
struct Gemm { const bf16_t* A; const bf16_t* Bt; int M, N, K; };

struct StaticOrder {
    int nM, nN, nwg, G, c; size_t tstep;
    __device__ void init(int M, int N, int K, int G_, int c_) { nM = M / BM; nN = N / BM; nwg = nM * nN; G = G_; c = c_; tstep = (size_t)BM * K * 2; }
    __device__ bool next(int i, Unit& u) const {
        const long L = (long)i * G + c; if (L >= nwg) return false;
        int wgid = (int)L; { const int q = nwg / NXCD, r = nwg % NXCD, xcd = wgid % NXCD, off = wgid / NXCD; wgid = (xcd < r ? xcd * (q + 1) : r * (q + 1) + (xcd - r) * q) + off; }
        const int nig = WGM * nN, gid = wgid / nig, fm = gid * WGM, gsz = (nM - fm) < WGM ? (nM - fm) : WGM;
        u.pm = fm + ((wgid % nig) % gsz); u.pn = (wgid % nig) / gsz; u.e = 0; u.mt = 0; return true;
    }
    __device__ __forceinline__ size_t a_off(const Unit& u) const { return (size_t)u.pm * tstep; }
    __device__ __forceinline__ size_t b_off(const Unit& u) const { return (size_t)u.pn * tstep; }
    __device__ __forceinline__ void a_ready(const Unit&) const {}
    __device__ __forceinline__ void done(const Unit&) const {}
    static constexpr bool GATHER = false;
};
template <int NPN, bool A_IS_XG> struct MoeOrder {
    static constexpr bool GATHER = A_IS_XG;
    const int* stok; const unsigned* cnt;
    const PG8_LAS unsigned short* idl;
    __device__ __forceinline__ unsigned list_id(int ui, int row) const { return (unsigned)idl[ui * BM + row]; }
    __device__ __forceinline__ void preload_ids(PG8_LAS unsigned short* dst, int tid, int wave) {
        idl = dst;
        const auto rs = __builtin_amdgcn_make_buffer_rsrc((void*)stok, 0, -1, 0x00020000);
        int tk[9], cn[9], sl[9];
#pragma unroll
        for (int j = 0; j < 9; ++j) { Unit u; tk[j] = 0; cn[j] = 0; sl[j] = 0;
            if (next(2 * j + (wave >> 2), u)) { sl[j] = u.mt * BM + (tid & 255); cn[j] = (int)__hip_atomic_load(cnt + u.e * 64, __ATOMIC_RELAXED, __HIP_MEMORY_SCOPE_AGENT);
                tk[j] = __builtin_amdgcn_raw_buffer_load_b32(rs, sl[j] * 4, (u.e * T) * 4, 0); } }
#pragma unroll
        for (int j = 0; j < 9; ++j) dst[(2 * j + (wave >> 2)) * BM + (tid & 255)] = (unsigned short)(sl[j] < cn[j] ? tk[j] : 0);
        __syncthreads();
    }
    const PG8_LAS int* tb; int G, c, ntile; size_t bexp, rowb;
    __device__ void init(const PG8_LAS int* tb_, int G_, int c_, int Nexp, int K) { tb = tb_; G = G_; c = c_; ntile = __builtin_amdgcn_readfirstlane(tb_[32]); rowb = (size_t)K * 2; bexp = (size_t)Nexp * rowb; }
    __device__ bool next(int i, Unit& u) const {
        int mtg, pn;
        if (G == 256) { constexpr int MPR = 256 / NPN, MPX = MPR / 8; mtg = MPR * i + MPX * (c & 7) + (c >> 3) / NPN; pn = (c >> 3) % NPN; }
        else { const long L = (long)i * G + c; mtg = (int)(L / NPN); pn = (int)(L % NPN); }
        if (mtg >= ntile) return false;
        int e = 0;
#pragma unroll
        for (int st = 16; st >= 1; st >>= 1) { const int tv = __builtin_amdgcn_readfirstlane(tb[e + st]); if (tv <= mtg) e += st; }
        u.pm = mtg; u.pn = pn; u.e = e; u.mt = mtg - __builtin_amdgcn_readfirstlane(tb[e]); return true;
    }
    __device__ __forceinline__ size_t a_off(const Unit& u) const { return A_IS_XG ? (size_t)0 : (size_t)u.pm * BM * rowb; }
    __device__ __forceinline__ size_t b_off(const Unit& u) const { return (size_t)u.e * bexp + (size_t)u.pn * BM * rowb; }
    __device__ __forceinline__ void a_ready(const Unit&) const {}
    __device__ __forceinline__ void done(const Unit&) const {}
};

__device__ __forceinline__ u32x4 pack_v(const f32x4 v0, const f32x4 v1) { u32x4 w; w.x = cvt_pk_bf16(v0[0], v0[1]); w.y = cvt_pk_bf16(v0[2], v0[3]); w.z = cvt_pk_bf16(v1[0], v1[1]); w.w = cvt_pk_bf16(v1[2], v1[3]); return w; }

struct EpiStore {
    static constexpr bool PERM = true, AFTER_DRAIN = false, BIAS_INIT = false;
    bf16_t* O; int ldc;
    __device__ __forceinline__ void operator()(const f32x4 (&acc)[2][2][4][2], const Unit& u, int wr, int wc, int fr, int fq) const {
        const int row0 = u.pm * BM + wr * 64 + fr, col0 = u.pn * BM + wc * 32 + 8 * fq;
#pragma unroll
        for (int ai = 0; ai < 2; ++ai)
#pragma unroll
            for (int m = 0; m < 4; ++m) { bf16_t* rowp = O + (size_t)(row0 + ai * HALF + m * 16) * ldc + col0;
#pragma unroll
                for (int bj = 0; bj < 2; ++bj) *(u32x4*)(rowp + bj * HALF) = pack_v(acc[ai][bj][m][0], acc[ai][bj][m][1]); }
    }
};
struct EpiGlu {
    static constexpr bool PERM = true, AFTER_DRAIN = false, BIAS_INIT = false;
    const bf16_t* Z; bf16_t* MIX; const float* bias;
    __device__ __forceinline__ void operator()(const f32x4 (&acc)[2][2][4][2], const Unit& u, int wr, int wc, int fr, int fq) const {
        const int row0 = u.pm * BM + wr * 64 + fr, col0 = u.pn * BM + wc * 32 + 8 * fq;
        f32x4 bv[2][2];
#pragma unroll
        for (int bj = 0; bj < 2; ++bj)
#pragma unroll
            for (int n = 0; n < 2; ++n) bv[bj][n] = *(const f32x4*)(bias + col0 + bj * HALF + 4 * n);
#pragma unroll
        for (int ai = 0; ai < 2; ++ai)
#pragma unroll
            for (int m = 0; m < 4; ++m) { const size_t row = (size_t)(row0 + ai * HALF + m * 16);
#pragma unroll
                for (int bj = 0; bj < 2; ++bj) {
                    const u32x4 zw = *(const u32x4*)(Z + row * SSM_W + col0 + bj * HALF); float z[8]; unpack8(zw, z);
                    const f32x4 a0 = acc[ai][bj][m][0] + bv[bj][0], a1 = acc[ai][bj][m][1] + bv[bj][1];
                    float o[8];
#pragma unroll
                    for (int j = 0; j < 4; ++j) { o[j] = z[j] * sigmoidf_(a0[j]); o[4 + j] = z[4 + j] * sigmoidf_(a1[j]); }
                    *(u32x4*)(MIX + row * D + 512 + col0 + bj * HALF) = pack8(o); } }
    }
};
struct EpiRope {
    static constexpr bool PERM = true, AFTER_DRAIN = false, BIAS_INIT = false;
    bf16_t* O; const f32x2* rope;
    __device__ __forceinline__ void operator()(const f32x4 (&acc)[2][2][4][2], const Unit& u, int wr, int wc, int fr, int fq) const {
        const int part = u.pn >> 2, tp = u.pn & 3;
        const int row0 = u.pm * BM + wr * 64 + fr, colb = part * 1024 + (4 * tp + wc) * 64 + 8 * fq;
        const float qs = part == 0 ? 0.125f * 1.4426950408889634f : 1.0f;
#pragma unroll
        for (int ai = 0; ai < 2; ++ai)
#pragma unroll
            for (int m = 0; m < 4; ++m) { const int row = row0 + ai * HALF + m * 16; bf16_t* rowp = O + (size_t)row * 3072 + colb;
                const f32x4 x1a = acc[ai][0][m][0], x1b = acc[ai][0][m][1], x2a = acc[ai][1][m][0], x2b = acc[ai][1][m][1];
                if (part < 2) {
                    const f32x4* rp = (const f32x4*)(rope + (size_t)seqpos(row) * 32 + 8 * fq);
                    const f32x4 c01 = rp[0], c23 = rp[1], c45 = rp[2], c67 = rp[3];
                    float o1[8], o2[8];
                    const float cs[8] = {c01[0], c01[2], c23[0], c23[2], c45[0], c45[2], c67[0], c67[2]}, sn[8] = {c01[1], c01[3], c23[1], c23[3], c45[1], c45[3], c67[1], c67[3]};
                    const float x1[8] = {x1a[0], x1a[1], x1a[2], x1a[3], x1b[0], x1b[1], x1b[2], x1b[3]}, x2[8] = {x2a[0], x2a[1], x2a[2], x2a[3], x2b[0], x2b[1], x2b[2], x2b[3]};
#pragma unroll
                    for (int j = 0; j < 8; ++j) { o1[j] = (x1[j] * cs[j] - x2[j] * sn[j]) * qs; o2[j] = (x2[j] * cs[j] + x1[j] * sn[j]) * qs; }
                    *(u32x4*)(rowp) = pack8(o1); *(u32x4*)(rowp + 32) = pack8(o2);
                } else { *(u32x4*)(rowp) = pack_v(x1a, x1b); *(u32x4*)(rowp + 32) = pack_v(x2a, x2b); } }
    }
};
struct EpiSwiglu {
    static constexpr bool PERM = true, AFTER_DRAIN = false, BIAS_INIT = true;
#ifdef PROBE_NOSTORE
    bool nostore = false;
#endif
    bf16_t* ACT; const float* bgu;
    __device__ __forceinline__ void init_load(const Unit& u, int wc, int fq, f32x4 (&b)[4]) const {
        const auto rsb = __builtin_amdgcn_make_buffer_rsrc((void*)bgu, 0, -1, 0x00020000);
        const int so = (u.e * 2048 + u.pn * 128 + wc * 32) * 4, vo = fq * 32;
        b[0] = __builtin_bit_cast(f32x4, __builtin_amdgcn_raw_buffer_load_b128(rsb, vo, so, 0)); b[1] = __builtin_bit_cast(f32x4, __builtin_amdgcn_raw_buffer_load_b128(rsb, vo + 16, so, 0));
        b[2] = __builtin_bit_cast(f32x4, __builtin_amdgcn_raw_buffer_load_b128(rsb, vo, so + 4096, 0)); b[3] = __builtin_bit_cast(f32x4, __builtin_amdgcn_raw_buffer_load_b128(rsb, vo + 16, so + 4096, 0));
    }
    static __device__ __forceinline__ void init_fill(f32x4 (&acc)[2][2][4][2], const f32x4 (&b)[4]) {
#pragma unroll
        for (int ai = 0; ai < 2; ++ai)
#pragma unroll
            for (int m = 0; m < 4; ++m) { acc[ai][0][m][0] = b[0]; acc[ai][0][m][1] = b[1]; acc[ai][1][m][0] = b[2]; acc[ai][1][m][1] = b[3]; }
    }
    __device__ __forceinline__ void init(f32x4 (&acc)[2][2][4][2], const Unit& u, int wc, int fq) const { f32x4 b[4]; init_load(u, wc, fq, b); init_fill(acc, b); }
    __device__ __forceinline__ void operator()(const f32x4 (&acc)[2][2][4][2], const Unit& u, int wr, int wc, int fr, int fq) const {
        const int row0 = u.pm * BM + wr * 64 + fr, j0 = u.pn * 128 + wc * 32 + 8 * fq;
        unsigned char* ab = (unsigned char*)ACT + (size_t)row0 * D + j0;
#pragma unroll
        for (int ai = 0; ai < 2; ++ai)
#pragma unroll
            for (int m = 0; m < 4; ++m) {
                const f32x4 g0 = acc[ai][0][m][0], g1 = acc[ai][0][m][1], l0 = acc[ai][1][m][0], l1 = acc[ai][1][m][1];
                float o[8];
#pragma unroll
                for (int j = 0; j < 4; ++j) {
                    const float ga = __builtin_amdgcn_fmed3f(g0[j], -3.0e38f, SW_LIMIT), gb = __builtin_amdgcn_fmed3f(g1[j], -3.0e38f, SW_LIMIT);
                    const float la = __builtin_amdgcn_fmed3f(l0[j], -SW_LIMIT, SW_LIMIT), lb = __builtin_amdgcn_fmed3f(l1[j], -SW_LIMIT, SW_LIMIT);
                    const float sa = ga * __builtin_amdgcn_rcpf(1.0f + __builtin_amdgcn_exp2f((-SW_ALPHA * 1.4426950408889634f) * ga)), sb = gb * __builtin_amdgcn_rcpf(1.0f + __builtin_amdgcn_exp2f((-SW_ALPHA * 1.4426950408889634f) * gb));
                    o[j] = fmaf(la, sa, sa); o[4 + j] = fmaf(lb, sb, sb); }
#ifdef PROBE_NOSTORE
                { const u32x2 w_ = pack8_fp8(o); if (!nostore) *(u32x2*)(ab + (size_t)(ai * HALF + m * 16) * D) = w_; else asm volatile("" :: "v"(w_)); } }
#else
                *(u32x2*)(ab + (size_t)(ai * HALF + m * 16) * D) = pack8_fp8(o); }
#endif
    }
};
struct EpiDown {
    static constexpr bool PERM = true, AFTER_DRAIN = false, BIAS_INIT = true;
#ifdef PROBE_NOSTORE
    bool nostore = false;
#endif
    bf16_t* Y; const float* bd; const float* glist;
    __device__ __forceinline__ void init_load(const Unit& u, int wc, int fq, f32x4 (&b)[4]) const {
        const auto rsb = __builtin_amdgcn_make_buffer_rsrc((void*)bd, 0, -1, 0x00020000);
        const int so = (u.e * D + u.pn * BM + wc * 32) * 4, vo = fq * 32;
        b[0] = __builtin_bit_cast(f32x4, __builtin_amdgcn_raw_buffer_load_b128(rsb, vo, so, 0)); b[1] = __builtin_bit_cast(f32x4, __builtin_amdgcn_raw_buffer_load_b128(rsb, vo + 16, so, 0));
        b[2] = __builtin_bit_cast(f32x4, __builtin_amdgcn_raw_buffer_load_b128(rsb, vo, so + HALF * 4, 0)); b[3] = __builtin_bit_cast(f32x4, __builtin_amdgcn_raw_buffer_load_b128(rsb, vo + 16, so + HALF * 4, 0));
    }
    static __device__ __forceinline__ void init_fill(f32x4 (&acc)[2][2][4][2], const f32x4 (&b)[4]) {
#pragma unroll
        for (int ai = 0; ai < 2; ++ai)
#pragma unroll
            for (int m = 0; m < 4; ++m) { acc[ai][0][m][0] = b[0]; acc[ai][0][m][1] = b[1]; acc[ai][1][m][0] = b[2]; acc[ai][1][m][1] = b[3]; }
    }
    __device__ __forceinline__ void init(f32x4 (&acc)[2][2][4][2], const Unit& u, int wc, int fq) const { f32x4 b[4]; init_load(u, wc, fq, b); init_fill(acc, b); }
    __device__ __forceinline__ void operator()(const f32x4 (&acc)[2][2][4][2], const Unit& u, int wr, int wc, int fr, int fq) const {
        const int rl0 = wr * 64 + fr, col0 = u.pn * BM + wc * 32 + 8 * fq;
        const float* gl = glist + (size_t)u.e * T + (size_t)u.mt * BM + rl0;
        unsigned char* yb = (unsigned char*)Y + ((size_t)u.pm * BM + rl0) * D + col0;
#pragma unroll
        for (int ai = 0; ai < 2; ++ai)
#pragma unroll
            for (int m = 0; m < 4; ++m) { const int rl = ai * HALF + m * 16; const float gt = gl[rl] * Y8_SCALE;
#pragma unroll
                for (int bj = 0; bj < 2; ++bj) { const f32x4 v0 = acc[ai][bj][m][0] * gt, v1 = acc[ai][bj][m][1] * gt; u32x2 w; w.x = pk4_fp8(v0[0], v0[1], v0[2], v0[3]); w.y = pk4_fp8(v1[0], v1[1], v1[2], v1[3]);
#ifdef PROBE_NOSTORE
                    if (nostore) { *(u32x2*)((unsigned char*)Y + (size_t)(u.pm * 4 + u.pn) * 65536 + (size_t)(wr * 4 + wc) * 8192 + ((ai * 4 + m) * 2 + bj) * 512 + (fr + 16 * fq) * 8) = w; } else
#endif
                    *(u32x2*)(yb + (size_t)rl * D + bj * HALF) = w; } }
    }
};

template <class Epi, class Sched, bool ALIGN_EPI = false, bool SP2 = false, bool FP8 = false, int PROBE = 0>
__device__ __forceinline__ void gemm_phase(PG8_LAS unsigned char* lds, const Gemm g, const Sched& S, const Epi& E, int wave_, int scale_w = 127, int scale_x = 127) {
    int tid = wave_ * 64 + lane_id(); asm volatile("" : "+v"(tid)); const int wid = wave_, lane = tid & 63, wr = wid >> 2, wc = wid & 3, fr = lane & 15, fq = lane >> 4;
    const int K = g.K, nt = K / BK;
    unsigned voffA[2], voffB[2];
#pragma unroll
    for (int i = 0; i < 2; ++i) { int R, C; stage_rc(tid * 16 + i * 8192, R, C); const int Rb = Epi::PERM ? ((R & ~31) + perm32(R & 31)) : R;
        voffA[i] = (unsigned)(R * K + C) * 2u; voffB[i] = (unsigned)(Rb * K + C) * 2u; }
    unsigned gv[2] = {0u, 0u}, gn[2] = {0u, 0u}, gc2 = 0u;
    auto gather_unit = [&](int ui_, unsigned (&o)[2]) {
        if constexpr (Sched::GATHER) {
            int t_ = lane_id(); asm volatile("" : "+v"(t_)); t_ += wid * 64;
            int R, C; stage_rc(t_ * 16, R, C);
#pragma unroll
            for (int h = 0; h < 2; ++h) o[h] = S.list_id(ui_, h * HALF + R) | (S.list_id(ui_, h * HALF + R + 64) << 16);
        }
    };
    if constexpr (Sched::GATHER) { int R, C; stage_rc(tid * 16, R, C); gc2 = (unsigned)(C * 2); }
    const unsigned kstep = (unsigned)(BK * 2);
    const unsigned hstep = (unsigned)HALF * (unsigned)K * 2u;
    const unsigned ldsw = (unsigned)wid * 1024u;
    const int aoff = lds_byte(wr * 64 + fr, fq * 8), boff = lds_byte(wc * 32 + fr, fq * 8);
#define PG8_SA(b, h) (((b) * 2 + (h)) * HTB)
#define PG8_SB(b, h) ((4 + (b) * 2 + (h)) * HTB)
#define PG8_STAGE(bufoff, gbase, voff) do { if constexpr (!(PROBE & 2)) _Pragma("unroll") for (int _i = 0; _i < 2; ++_i) \
        __builtin_amdgcn_raw_ptr_buffer_load_lds(rsrc_##voff, (PG8_LAS unsigned*)(lds + (bufoff) + ldsw + _i * 8192), 16, (voff)[_i], (gbase), 0, 0); } while (0)
#define PG8_STAGE_A(b, h, soff, NEXT) do { if constexpr (Sched::GATHER) { _Pragma("unroll") for (int _i = 0; _i < 2; ++_i) \
        { unsigned pk_ = (NEXT) ? gn[h] : gv[h]; asm volatile("" : "+v"(pk_)); const unsigned tk_ = _i ? (pk_ >> 16) : (pk_ & 0xffffu);     \
        __builtin_amdgcn_raw_ptr_buffer_load_lds(rsrc_voffA, (PG8_LAS unsigned*)(lds + PG8_SA(b, h) + ldsw + _i * 8192), 16, (tk_ << 10) | gc2, (soff), 0, 0); } } \
        else PG8_STAGE(PG8_SA(b, h), (soff) + (h) * hstep, voffA); } while (0)
#define PG8_LDA(dst, b, h) do { if constexpr ((PROBE & 16) != 0) { if constexpr (FP8) { asm volatile("" : "+v"(dst##8[0]), "+v"(dst##8[1]), "+v"(dst##8[2]), "+v"(dst##8[3])); } } else if constexpr (FP8) { _Pragma("unroll") for (int m = 0; m < 4; ++m) { const v4i_ lo_ = *(const PG8_LAS v4i_*)(lds + PG8_SA(b, h) + aoff + m * 2048), hi_ = *(const PG8_LAS v4i_*)(lds + PG8_SA(b, h) + aoff + m * 2048 + 1024); dst##8[m] = __builtin_shufflevector(lo_, hi_, 0, 1, 2, 3, 4, 5, 6, 7); } } \
        else { _Pragma("unroll") for (int m = 0; m < 4; ++m) _Pragma("unroll") for (int k = 0; k < 2; ++k) dst[m][k] = *(const PG8_LAS bf16x8*)(lds + PG8_SA(b, h) + aoff + m * 2048 + k * 1024); } } while (0)
#define PG8_LDB(dst, b, h) do { if constexpr ((PROBE & 8) != 0) { if constexpr (FP8) { asm volatile("" : "+v"(dst##8[0]), "+v"(dst##8[1])); } } else if constexpr (FP8) { _Pragma("unroll") for (int n = 0; n < 2; ++n) { const v4i_ lo_ = *(const PG8_LAS v4i_*)(lds + PG8_SB(b, h) + boff + n * 2048), hi_ = *(const PG8_LAS v4i_*)(lds + PG8_SB(b, h) + boff + n * 2048 + 1024); dst##8[n] = __builtin_shufflevector(lo_, hi_, 0, 1, 2, 3, 4, 5, 6, 7); } } \
        else { _Pragma("unroll") for (int n = 0; n < 2; ++n) _Pragma("unroll") for (int k = 0; k < 2; ++k) dst[n][k] = *(const PG8_LAS bf16x8*)(lds + PG8_SB(b, h) + boff + n * 2048 + k * 1024); } } while (0)
#define PG8_MMA(ai, bj, At, Bt) do { __builtin_amdgcn_s_setprio(1); _Pragma("unroll") for (int m = 0; m < 4; ++m) _Pragma("unroll") for (int n = 0; n < 2; ++n) { \
        if constexpr ((PROBE & 4) != 0) { if constexpr (FP8) asm volatile("" :: "v"(Bt##8[n]), "v"(At##8[m])); else asm volatile("" :: "v"(Bt[n][0]), "v"(At[m][0]), "v"(Bt[n][1]), "v"(At[m][1])); } else \
        if constexpr (FP8) acc[ai][bj][m][n] = __builtin_amdgcn_mfma_scale_f32_16x16x128_f8f6f4(Bt##8[n], At##8[m], acc[ai][bj][m][n], 0, 0, 0, scale_w, 0, scale_x); \
        else { _Pragma("unroll") for (int k = 0; k < 2; ++k) acc[ai][bj][m][n] = __builtin_amdgcn_mfma_f32_16x16x32_bf16(Bt[n][k], At[m][k], acc[ai][bj][m][n], 0, 0, 0); } } \
        __builtin_amdgcn_s_setprio(0); } while (0)
#define PG8_WAIT_V(n) asm volatile("s_waitcnt vmcnt(" #n ")" ::: "memory")
#define PG8_WAIT_L(n) asm volatile("s_waitcnt lgkmcnt(" #n ")" ::: "memory")
#define PG8_BAR __builtin_amdgcn_s_barrier()
#define PG8_SCHED __builtin_amdgcn_sched_barrier(0)
#define PG8_ACC_INIT(u_) do { if constexpr (Epi::BIAS_INIT && !(PROBE & 64)) { int tz_ = lane_id(); asm volatile("" : "+v"(tz_)); E.init(acc, u_, wc, (tz_ & 63) >> 4); } else { \
        _Pragma("unroll") for (int a = 0; a < 2; ++a) _Pragma("unroll") for (int b = 0; b < 2; ++b) _Pragma("unroll") for (int m = 0; m < 4; ++m) _Pragma("unroll") for (int n = 0; n < 2; ++n) acc[a][b][m][n] = (f32x4){0.f, 0.f, 0.f, 0.f}; } } while (0)
    Unit cur, nxt; int ui = 0;
    if (!S.next(0, cur)) return;
    f32x4 acc[2][2][4][2];
    typedef int v4i_ __attribute__((ext_vector_type(4))); typedef int v8i_ __attribute__((ext_vector_type(8)));
    bf16x8 At[4][2], B0[2][2], B1[2][2]; v8i_ At8[4], B08[2], B18[2];
    const auto rsrc_voffA = __builtin_amdgcn_make_buffer_rsrc((void*)g.A, 0, -1, 0x00020000), rsrc_voffB = __builtin_amdgcn_make_buffer_rsrc((void*)g.Bt, 0, -1, 0x00020000);
    unsigned cA = (unsigned)__builtin_amdgcn_readfirstlane((int)(unsigned)S.a_off(cur)), cB = (unsigned)__builtin_amdgcn_readfirstlane((int)(unsigned)S.b_off(cur));
    S.a_ready(cur);
    if constexpr (Sched::GATHER) { static_assert(BK * 2 == 128, "row offset 1 KiB = K * 2 bytes assumed below");
        gather_unit(0, gv); Unit n1_; if (S.next(1, n1_)) gather_unit(1, gn); else { gn[0] = gv[0]; gn[1] = gv[1]; }
        asm volatile("" : "+v"(gv[0]), "+v"(gv[1]), "+v"(gn[0]), "+v"(gn[1])); }
    PG8_ACC_INIT(cur);
    if constexpr (SP2) {
        PG8_STAGE(PG8_SB(0, 0), cB, voffB); PG8_STAGE(PG8_SB(0, 1), cB + hstep, voffB); PG8_STAGE_A(0, 0, cA, false); PG8_STAGE_A(0, 1, cA, false);
        if (wr == 1) PG8_BAR;
        PG8_WAIT_V(2); PG8_BAR;
        PG8_STAGE(PG8_SB(1, 0), cB + kstep, voffB); PG8_STAGE_A(1, 0, cA + kstep, false); PG8_STAGE(PG8_SB(1, 1), cB + hstep + kstep, voffB);
        PG8_WAIT_V(6); PG8_BAR;
    } else {
        PG8_STAGE(PG8_SB(0, 0), cB, voffB); PG8_STAGE_A(0, 0, cA, false); PG8_STAGE(PG8_SB(0, 1), cB + hstep, voffB); PG8_STAGE_A(0, 1, cA, false);
        if (wr == 1) PG8_BAR;
        PG8_WAIT_V(4); PG8_BAR;
        PG8_STAGE(PG8_SB(1, 0), cB + kstep, voffB); PG8_STAGE_A(1, 0, cA + kstep, false); PG8_STAGE(PG8_SB(1, 1), cB + hstep + kstep, voffB);
        PG8_WAIT_V(6); PG8_BAR;
    }
    for (;;) {
        const bool has_next = S.next(ui + 1, nxt);
        const unsigned nA = has_next ? (unsigned)__builtin_amdgcn_readfirstlane((int)(unsigned)S.a_off(nxt)) : cA, nB = has_next ? (unsigned)__builtin_amdgcn_readfirstlane((int)(unsigned)S.b_off(nxt)) : cB;
#pragma nounroll
        for (int t = 0; t < nt; t += 2) {
            const bool last = (t == nt - 2);
            const unsigned a1 = cA + (unsigned)(t + 1) * kstep;
            const unsigned a2 = last ? nA : cA + (unsigned)(t + 2) * kstep, b2 = last ? nB : cB + (unsigned)(t + 2) * kstep;
            const unsigned a3 = a2 + kstep, b3 = b2 + kstep;
            if (last && has_next) S.a_ready(nxt);
            if constexpr (SP2) {
            PG8_LDB(B0, 0, 0); PG8_LDB(B1, 0, 1); PG8_SCHED; PG8_LDA(At, 0, 0); PG8_STAGE_A(1, 1, a1, false);
            PG8_WAIT_V(8); PG8_WAIT_L(0); PG8_BAR; PG8_MMA(0, 0, At, B0); PG8_MMA(0, 1, At, B1); PG8_BAR; PG8_SCHED;
            PG8_LDA(At, 0, 1); PG8_STAGE(PG8_SB(0, 0), b2, voffB); PG8_STAGE(PG8_SB(0, 1), b2 + hstep, voffB); PG8_STAGE_A(0, 0, a2, last);
            PG8_WAIT_V(8); PG8_WAIT_L(0); PG8_BAR; PG8_MMA(1, 0, At, B0); PG8_MMA(1, 1, At, B1); PG8_BAR; PG8_SCHED;
            PG8_LDB(B0, 1, 0); PG8_LDB(B1, 1, 1); PG8_SCHED; PG8_LDA(At, 1, 0); PG8_STAGE_A(0, 1, a2, last);
            PG8_WAIT_V(8); PG8_WAIT_L(0); PG8_BAR; PG8_MMA(0, 0, At, B0); PG8_MMA(0, 1, At, B1); PG8_BAR; PG8_SCHED;
            PG8_LDA(At, 1, 1); PG8_STAGE(PG8_SB(1, 0), b3, voffB); PG8_STAGE(PG8_SB(1, 1), b3 + hstep, voffB); PG8_STAGE_A(1, 0, a3, last);
            PG8_WAIT_V(8); PG8_WAIT_L(0); PG8_BAR; PG8_MMA(1, 0, At, B0); PG8_MMA(1, 1, At, B1); PG8_BAR; PG8_SCHED;
            } else {
            PG8_LDB(B0, 0, 0); PG8_SCHED; PG8_LDA(At, 0, 0); PG8_STAGE_A(1, 1, a1, false);
            PG8_WAIT_L(8); PG8_BAR; PG8_WAIT_L(0); PG8_MMA(0, 0, At, B0); PG8_BAR; PG8_SCHED;
            PG8_LDB(B1, 0, 1); PG8_STAGE(PG8_SB(0, 0), b2, voffB);
            PG8_BAR; PG8_WAIT_L(0); PG8_MMA(0, 1, At, B1); PG8_BAR;
            PG8_LDA(At, 0, 1); PG8_STAGE_A(0, 0, a2, last);
            PG8_BAR; PG8_WAIT_L(0); PG8_MMA(1, 0, At, B0); PG8_BAR; PG8_SCHED;
            PG8_STAGE(PG8_SB(0, 1), b2 + hstep, voffB);
            PG8_WAIT_V(6); PG8_BAR; PG8_MMA(1, 1, At, B1); PG8_BAR;
            PG8_LDB(B0, 1, 0); PG8_SCHED; PG8_LDA(At, 1, 0); PG8_STAGE_A(0, 1, a2, last);
            PG8_WAIT_L(8); PG8_BAR; PG8_WAIT_L(0); PG8_MMA(0, 0, At, B0); PG8_BAR; PG8_SCHED;
            PG8_LDB(B1, 1, 1); PG8_STAGE(PG8_SB(1, 0), b3, voffB);
            PG8_BAR; PG8_WAIT_L(0); PG8_MMA(0, 1, At, B1); PG8_BAR;
            PG8_LDA(At, 1, 1); PG8_STAGE_A(1, 0, a3, last);
            PG8_BAR; PG8_WAIT_L(0); PG8_MMA(1, 0, At, B0); PG8_BAR; PG8_SCHED;
            PG8_STAGE(PG8_SB(1, 1), b3 + hstep, voffB);
            PG8_WAIT_V(6); PG8_BAR; PG8_MMA(1, 1, At, B1); PG8_BAR;
            }
        }
        if constexpr (ALIGN_EPI) { if (wr == 0) PG8_BAR; }
        if constexpr (!Epi::AFTER_DRAIN) { int tz = lane_id(); asm volatile("" : "+v"(tz));
            if constexpr ((PROBE & 1) != 0) { _Pragma("unroll") for (int a = 0; a < 2; ++a) _Pragma("unroll") for (int b = 0; b < 2; ++b) _Pragma("unroll") for (int m = 0; m < 4; ++m) _Pragma("unroll") for (int n = 0; n < 2; ++n) asm volatile("" :: "v"(acc[a][b][m][n])); }
            else E(acc, cur, wr, wc, tz & 15, (tz & 63) >> 4); S.done(cur); }
        if (!has_next) break;
        if constexpr (Sched::GATHER) {
            gv[0] = gn[0]; gv[1] = gn[1]; }
        if constexpr (Sched::GATHER) { Unit n2_; if (S.next(ui + 2, n2_)) gather_unit(ui + 2, gn); asm volatile("" : "+v"(gn[0]), "+v"(gn[1])); }
        PG8_ACC_INIT(nxt);
        cur = nxt; cA = nA; cB = nB; ++ui;
        if constexpr (ALIGN_EPI) { if (wr == 1) PG8_BAR; }
    }
    PG8_WAIT_V(0);
    if constexpr (!ALIGN_EPI) { if (wr == 0) PG8_BAR; }
    PG8_BAR;
    if constexpr (Epi::AFTER_DRAIN) { E.fused(acc, cur, wr, wc, fr, fq, lds, wid, lane); S.done(cur); }
#undef PG8_SA
#undef PG8_SB
#undef PG8_ACC_INIT
#undef PG8_STAGE
#undef PG8_STAGE_A
#undef PG8_LDA
#undef PG8_LDB
#undef PG8_MMA
#undef PG8_WAIT_V
#undef PG8_WAIT_L
#undef PG8_BAR
#undef PG8_SCHED
}
}

template <int MODE>
__device__ __forceinline__ void transpose_item(const float* W, int K, int N, bf16_t* WT, LAS float* scr, int item, int lane) {
    const int nblk = N / 32, kb = item / nblk, nb = item % nblk, k0 = 64 * kb, n0 = 32 * nb;
    int dr = n0;
    if (MODE == 1) { const int j = n0 & 1023, half = n0 >> 10; dr = 256 * (j >> 7) + 128 * half + (j & 127); }
    if (MODE == 2) { const int part = n0 >> 10, c = n0 & 1023, head = c >> 6, half = (c >> 5) & 1; dr = part * 1024 + (head >> 2) * 256 + half * 128 + (head & 3) * 32; }
    float wv[32];
#pragma unroll
    for (int i = 0; i < 32; ++i) wv[i] = W[(size_t)(k0 + 2 * i + (lane >> 5)) * N + n0 + (lane & 31)];
#pragma unroll
    for (int i = 0; i < 32; ++i) scr[(2 * i + (lane >> 5)) * 33 + (lane & 31)] = wv[i];
    WAVE_SYNC();
    const int c = lane & 7;
#pragma unroll
    for (int j = 0; j < 4; ++j) { const int n = (lane >> 3) + 8 * j; const LAS float* s = scr + (8 * c) * 33 + n;
        u32x4 o; o.x = pk2(s[0 * 33], s[1 * 33]); o.y = pk2(s[2 * 33], s[3 * 33]); o.z = pk2(s[4 * 33], s[5 * 33]); o.w = pk2(s[6 * 33], s[7 * 33]);
        *(u32x4*)(WT + (size_t)(dr + n) * K + k0 + 8 * c) = o; }
    WAVE_SYNC();
}

template <int MODE>
__device__ __forceinline__ void transpose_item_fp8(const float* W, int K, int N, unsigned char* WT, LAS float* scr, int item, int lane, float scale) {
    const int nblk = N / 32, kb = item / nblk, nb = item % nblk, k0 = 64 * kb, n0 = 32 * nb;
    int dr = n0;
    if (MODE == 1) { const int j = n0 & 1023, half = n0 >> 10; dr = 256 * (j >> 7) + 128 * half + (j & 127); }
    float wv[32];
#pragma unroll
    for (int i = 0; i < 32; ++i) wv[i] = W[(size_t)(k0 + 2 * i + (lane >> 5)) * N + n0 + (lane & 31)];
#pragma unroll
    for (int i = 0; i < 32; ++i) scr[(2 * i + (lane >> 5)) * 33 + (lane & 31)] = wv[i] * scale;
    WAVE_SYNC();
#pragma unroll
    for (int j = 0; j < 2; ++j) { const int n = lane & 31, c = (lane >> 5) + 2 * j; const LAS float* s = scr + (16 * c) * 33 + n;
        u32x4 o; o.x = pk4_fp8(s[0 * 33], s[1 * 33], s[2 * 33], s[3 * 33]); o.y = pk4_fp8(s[4 * 33], s[5 * 33], s[6 * 33], s[7 * 33]);
        o.z = pk4_fp8(s[8 * 33], s[9 * 33], s[10 * 33], s[11 * 33]); o.w = pk4_fp8(s[12 * 33], s[13 * 33], s[14 * 33], s[15 * 33]);
        *(u32x4*)(WT + (size_t)(dr + n) * K + k0 + 16 * c) = o; }
    WAVE_SYNC();
}

__device__ __forceinline__ const float* ld_ptr(volatile LAS unsigned long long* t, int k) {
    const unsigned long long v = t[k]; const unsigned lo = __builtin_amdgcn_readfirstlane((unsigned)v), hi = __builtin_amdgcn_readfirstlane((unsigned)(v >> 32));
    return (const float*)(const GAS float*)(((unsigned long long)hi << 32) | lo);
}
__device__ __forceinline__ void phase_prologue(const Ctx& X, volatile LAS unsigned long long* ptab) {
#define in_(k) ld_ptr(ptab, k)
    const float* a_re = in_(3); const float* a_im = in_(4); const float* log_dt = in_(5); const float* b_re = in_(6); const float* b_im = in_(7);
    float2* Abar = (float2*)(X.ws + WS_S5A); float2* Bbar = (float2*)(X.ws + WS_S5B); float2* rope = (float2*)(X.ws + WS_ROPE);
    const int gt = X.bid * NTHR + X.tid, NT = X.G * NTHR;
    for (int it = gt; it < 2 * SSM_G * SSM_P; it += NT) {
        const int ig = it >> 6;
        const double lam_re = fmin((double)a_re[it], -1e-4), lam_im = (double)a_im[it];
        const double dt = exp((double)log_dt[ig]);
        const double mag = exp(lam_re * dt), ang = lam_im * dt;
        const double abr = mag * cos(ang), abi = mag * sin(ang);
        const double nr = abr - 1.0, ni = abi, den = lam_re * lam_re + lam_im * lam_im;
        const double cr = (nr * lam_re + ni * lam_im) / den, ci = (ni * lam_re - nr * lam_im) / den;
        Abar[it] = make_float2((float)abr, (float)abi);
        for (int h = 0; h < SSM_H; ++h) {
            const double br = (double)b_re[it * 16 + h], bi = (double)b_im[it * 16 + h];
            Bbar[it * 16 + h] = make_float2((float)(cr * br - ci * bi), (float)(cr * bi + ci * br));
        }
    }
    for (int it = gt; it < SEQ * 32; it += NT) {
        const int pos = it >> 5, i = it & 31;
        const float inv = powf(10000.0f, -(float)i / 32.0f);
        const float ang = (float)pos * inv;
        rope[it] = make_float2((float)cos((double)ang), (float)sin((double)ang));
    }
    { const float* rw = in_(20); bf16_t* RWh = (bf16_t*)(X.ws + WS_RWH); bf16_t* RWl = (bf16_t*)(X.ws + WS_RWL);
      for (int it = gt; it < DEPTH * NE * D; it += NT) { const int k = it & 1023, e = (it >> 10) & 31, l = it >> 15;
          const float w = rw[((size_t)l * D + k) * NE + e]; const unsigned hb = f2bf(w); RWh[it] = (bf16_t)hb; RWl[it] = (bf16_t)f2bf(w - bf2f((bf16_t)hb)); } }
    { const float* x = in_(0); bf16_t* H0 = (bf16_t*)(X.ws + WS_H0);
      const size_t n8 = (size_t)T * D / 8;
      for (size_t i8 = (size_t)gt; i8 < n8; i8 += (size_t)NT) {
          const f32x4 a = *(const f32x4*)(x + i8 * 8), b = *(const f32x4*)(x + i8 * 8 + 4);
          u32x4 o; o.x = pk2(a[0], a[1]); o.y = pk2(a[2], a[3]); o.z = pk2(b[0], b[1]); o.w = pk2(b[2], b[3]);
          *(u32x4*)(H0 + i8 * 8) = o; } }
    LAS float* scr = (LAS float*)(X.lds + X.wave * 16384);
    const int gw = X.bid * NWAVES + X.wave, NGW = X.G * NWAVES;
    constexpr int I_GU = 16 * 64, I_DN = 16 * 32, I_IN = 16 * 64, I_GLU = 8 * 16, I_OUT = 16 * 32, I_QKV = 16 * 96, I_O = 16 * 32;
    constexpr int N_GU = 128 * I_GU, N_DN = 128 * I_DN, N_IN = 2 * I_IN, N_GLU = 2 * I_GLU, N_OUT = 2 * I_OUT, N_QKV = 2 * I_QKV, N_O = 2 * I_O;
    constexpr int NITEMS = N_GU + N_DN + N_IN + N_GLU + N_OUT + N_QKV + N_O;
    for (int it = gw; it < NITEMS; it += NGW) {
        int r = it;
        if (r < N_GU) { const int m = r / I_GU; transpose_item_fp8<1>(in_(22) + (size_t)m * D * 2048, D, 2048, (unsigned char*)(X.ws + WS_WGU + (size_t)m * 2048 * D), scr, r % I_GU, X.lane, (float)(1 << W8_SHIFT_GU)); continue; } r -= N_GU;
        if (r < N_DN) { const int m = r / I_DN; transpose_item_fp8<0>(in_(24) + (size_t)m * D * D, D, D, (unsigned char*)(X.ws + WS_WDN + (size_t)m * D * D), scr, r % I_DN, X.lane, (float)(1 << W8_SHIFT_DN)); continue; } r -= N_DN;
        if (r < N_IN) { const int m = r / I_IN; transpose_item<0>(in_(1) + (size_t)m * D * 2048, D, 2048, (bf16_t*)(X.ws + WS_WIN) + (size_t)m * 2048 * D, scr, r % I_IN, X.lane); continue; } r -= N_IN;
        if (r < N_GLU) { const int m = r / I_GLU; transpose_item<0>(in_(11) + (size_t)m * 512 * 512, 512, 512, (bf16_t*)(X.ws + WS_WGLU) + (size_t)m * 512 * 512, scr, r % I_GLU, X.lane); continue; } r -= N_GLU;
        if (r < N_OUT) { const int m = r / I_OUT; transpose_item<0>(in_(13) + (size_t)m * D * D, D, D, (bf16_t*)(X.ws + WS_WOUT) + (size_t)m * D * D, scr, r % I_OUT, X.lane); continue; } r -= N_OUT;
        if (r < N_QKV) { const int m = r / I_QKV; transpose_item<2>(in_(14) + (size_t)m * D * 3072, D, 3072, (bf16_t*)(X.ws + WS_WQKV) + (size_t)m * 3072 * D, scr, r % I_QKV, X.lane); continue; } r -= N_QKV;
        { const int m = r / I_O; transpose_item<0>(in_(15) + (size_t)m * D * D, D, D, (bf16_t*)(X.ws + WS_WO) + (size_t)m * D * D, scr, r % I_O, X.lane); }
    }
}

#undef in_
typedef float f32x4v __attribute__((ext_vector_type(4)));
template <int PASS>
__device__ __forceinline__ void phase_s5(const Ctx& X, int i, const bf16_t* proj, const float* conv_w, const float* c_re, const float* c_im, const float* d_skip, bf16_t* mix, bf16_t* Z) {
    using pg8::bf16x8;
    if (PASS == 2) {
        const float* w = conv_w + (size_t)i * 3 * CONV_CH;
        const size_t n = (size_t)T * (CONV_CH / 8);
        for (size_t idx = (size_t)X.bid * NTHR + X.tid; idx < n; idx += (size_t)X.G * NTHR) {
            const int bt = (int)(idx >> 6), c = (int)(idx & 63) * 8, pos = seqpos(bt);
            const bf16_t* pr = proj + (size_t)bt * 2048;
            float gb[8], a2[8], b2[8], a1[8], b1[8], a0[8], b0[8];
            unpack8(*(const u32x4*)(pr + c), gb); unpack8(*(const u32x4*)(pr + 512 + c), a2); unpack8(*(const u32x4*)(pr + 1024 + c), b2);
            if (pos >= 1) { unpack8(*(const u32x4*)(pr + 512 + c - 2048), a1); unpack8(*(const u32x4*)(pr + 1024 + c - 2048), b1); }
            if (pos >= 2) { unpack8(*(const u32x4*)(pr + 512 + c - 4096), a0); unpack8(*(const u32x4*)(pr + 1024 + c - 4096), b0); }
            float o[8];
#pragma unroll
            for (int j = 0; j < 8; ++j) {
                float s = w[2 * CONV_CH + c + j] * (a2[j] * b2[j]);
                if (pos >= 1) s += w[1 * CONV_CH + c + j] * (a1[j] * b1[j]);
                if (pos >= 2) s += w[0 * CONV_CH + c + j] * (a0[j] * b0[j]);
                o[j] = gb[j] * s; }
            *(u32x4*)(mix + (size_t)bt * D + c) = pack8(o);
        }
    }
    const int lane = X.lane, n16 = lane & 15, kq = lane >> 4;
    LAS float* BuT = (LAS float*)(X.lds + X.wave * 15360);
    LAS unsigned char* xsb = X.lds + X.wave * 15360 + 10240;
    const float2* Abar = (const float2*)(X.ws + WS_S5A); const float2* Bbar = (const float2*)(X.ws + WS_S5B);
    float2* Sst = (float2*)(X.ws + WS_S5S);
    const int gw = X.bid * NWAVES + X.wave, NGW = X.G * NWAVES;
    const int g = gw & 31, ig = i * 32 + g;
        const float2 A = Abar[ig * 64 + lane];
    bf16x8 bfr[8];
#pragma unroll
    for (int cb = 0; cb < 8; ++cb) {
        u32x4 w = (u32x4){0u, 0u, 0u, 0u};
        if (kq < 2) { const float2* bp = Bbar + ((size_t)(ig * 64 + 16 * (cb & 3) + n16)) * 16 + 8 * kq; float v[8];
#pragma unroll
            for (int j = 0; j < 8; ++j) { const float2 t2 = bp[j]; v[j] = cb < 4 ? t2.x : t2.y; }
            w = pack8(v); }
        bfr[cb] = __builtin_bit_cast(bf16x8, w);
    }
    bf16x8 cfr[4]; bf16x8 dfr;
    if (PASS == 2) {
#pragma unroll
        for (int ks = 0; ks < 4; ++ks) { const int p0 = 16 * ks + 4 * kq; const f32x4 cr = *(const f32x4*)(c_re + (size_t)(ig * 16 + n16) * 64 + p0), ci = *(const f32x4*)(c_im + (size_t)(ig * 16 + n16) * 64 + p0);
            u32x4 w; w.x = cvt_pk_bf16(cr[0], -ci[0]); w.y = cvt_pk_bf16(cr[1], -ci[1]); w.z = cvt_pk_bf16(cr[2], -ci[2]); w.w = cvt_pk_bf16(cr[3], -ci[3]); cfr[ks] = __builtin_bit_cast(bf16x8, w); }
        { const float dv = d_skip[ig * 16 + n16]; float v[8];
#pragma unroll
          for (int j = 0; j < 8; ++j) v[j] = (kq < 2 && 8 * kq + j == n16) ? dv : 0.f;
          dfr = __builtin_bit_cast(bf16x8, pack8(v)); }
    }
    for (int task = gw; task < BATCH * 64 * SSM_G; task += NGW) {
        const int c = (task >> 5) & 63, b = task >> 11;
        float xr = 0.f, xi = 0.f;
        if (PASS == 2) { const float2 xin = ((const float2*)(X.ws + WS_S5X))[((size_t)(b * 32 + g) * 64 + c) * 64 + lane]; xr = xin.x; xi = xin.y; }
        const bf16_t* ub = proj + ((size_t)b * SEQ + (size_t)c * 128) * 2048 + 1536 + g * 16;
        bf16_t* zb = Z + ((size_t)b * SEQ + (size_t)c * 128) * SSM_W + g * 16;
        u32x4 uw = (u32x4){0u, 0u, 0u, 0u};
        if (kq < 2) uw = *(const u32x4*)(ub + (size_t)n16 * 2048 + 8 * kq);
#pragma nounroll
        for (int blk = 0; blk < 8; ++blk) {
            const bf16x8 ufr = __builtin_bit_cast(bf16x8, uw);
            u32x4 un = (u32x4){0u, 0u, 0u, 0u};
            if (kq < 2 && blk < 7) un = *(const u32x4*)(ub + (size_t)((blk + 1) * 16 + n16) * 2048 + 8 * kq);
#pragma unroll
            for (int cb = 0; cb < 8; ++cb) {
                f32x4v acc = (f32x4v){0.f, 0.f, 0.f, 0.f};
                acc = __builtin_amdgcn_mfma_f32_16x16x32_bf16(ufr, bfr[cb], acc, 0, 0, 0);
                *(LAS f32x4v*)(BuT + (16 * cb + n16) * 20 + 4 * kq) = acc;
            }
            WAVE_SYNC();
#pragma unroll
            for (int k4 = 0; k4 < 4; ++k4) {
                const f32x4v br = *(const LAS f32x4v*)(BuT + lane * 20 + 4 * k4), bi = *(const LAS f32x4v*)(BuT + (64 + lane) * 20 + 4 * k4);
#pragma unroll
                for (int s = 0; s < 4; ++s) {
                    float nr = fmaf(-A.y, xi, fmaf(A.x, xr, br[s])); asm volatile("" : "+v"(nr));
                    float ni = fmaf(A.y, xr, fmaf(A.x, xi, bi[s])); asm volatile("" : "+v"(ni));
                    xr = nr; xi = ni;
                    if (PASS == 2) *(LAS unsigned*)(xsb + (4 * k4 + s) * 272 + lane * 4) = cvt_pk_bf16(xr, xi);
                }
            }
            if (PASS == 2) {
                WAVE_SYNC();
                f32x4v y = (f32x4v){0.f, 0.f, 0.f, 0.f};
                bf16x8 xa[4];
#pragma unroll
                for (int ks = 0; ks < 4; ++ks) xa[ks] = *(const LAS bf16x8*)(xsb + n16 * 272 + ks * 64 + kq * 16);
                WAVE_SYNC(); __builtin_amdgcn_sched_barrier(0);
#pragma unroll
                for (int ks = 0; ks < 4; ++ks) y = __builtin_amdgcn_mfma_f32_16x16x32_bf16(xa[ks], cfr[ks], y, 0, 0, 0);
                y = __builtin_amdgcn_mfma_f32_16x16x32_bf16(ufr, dfr, y, 0, 0, 0);
                asm volatile("" :: "v"(xa[0]), "v"(xa[1]), "v"(xa[2]), "v"(xa[3]), "v"(ufr));
#pragma unroll
                for (int q = 0; q < 4; ++q) zb[(size_t)(blk * 16 + 4 * kq + q) * SSM_W + n16] = (bf16_t)f2bf(gelu_tanh(y[q]));
            }
            WAVE_SYNC();
            uw = un;
        }
        if (PASS == 1) Sst[((size_t)(b * 32 + g) * 64 + c) * 64 + lane] = make_float2(xr, xi);
    }
}

__device__ __forceinline__ void phase_s5_carry(const Ctx& X, int i) {
    const float2* Abar = (const float2*)(X.ws + WS_S5A); const float2* Sst = (const float2*)(X.ws + WS_S5S); float2* Xin = (float2*)(X.ws + WS_S5X);
    const int gw = X.bid * NWAVES + X.wave, NGW = X.G * NWAVES, lane = X.lane;
    for (int bg = gw; bg < BATCH * SSM_G; bg += NGW) {
        const float2 A = Abar[(i * 32 + (bg & 31)) * 64 + lane];
        float pr_ = A.x, pi_ = A.y;
#pragma unroll
        for (int q = 0; q < 7; ++q) { const float nr = pr_ * pr_ - pi_ * pi_, ni = 2.f * pr_ * pi_; pr_ = nr; pi_ = ni; }
        float xr = 0.f, xi = 0.f;
        const size_t base = (size_t)bg * 64 * 64 + lane;
#pragma unroll 8
        for (int c = 0; c < 64; ++c) {
            Xin[base + (size_t)c * 64] = make_float2(xr, xi);
            const float2 s = Sst[base + (size_t)c * 64];
            const float nr = pr_ * xr - pi_ * xi + s.x, ni = pr_ * xi + pi_ * xr + s.y; xr = nr; xi = ni;
        }
    }
}

typedef short v4i16_t __attribute__((ext_vector_type(4)));
typedef float f32x16 __attribute__((ext_vector_type(16)));
__device__ __forceinline__ v4i16_t vtr16(const LAS unsigned char* p) { return __builtin_amdgcn_ds_read_tr16_b64_v4i16((LAS v4i16_t*)p); }
template <int PASS>
__device__ __forceinline__ void phase_attn(const Ctx& X, const bf16_t* proj, bf16_t* att, bf16_t* ost, float2* ml) {
    using pg8::bf16x8;
    const int lane = X.lane, i32 = lane & 31, hi = lane >> 5;
    LAS unsigned char* vbuf = X.lds + X.wave * 16384;
    LAS unsigned char* kbuf = vbuf + 8192;
    const int gw = X.bid * NWAVES + X.wave, NGW = X.G * NWAVES;
    const float NEG = opaque_f(-3.0e38f); const int seqmax = opaque_i(SEQ - 1);
    const int vrd = ((lane >> 4) & 1) * 32 + (lane & 3) * 8 + (4 * hi + ((lane & 15) >> 2)) * 64;
    const bool xdeal = (X.G == 256);
    constexpr int NT = PASS == 0 ? 13 : 5, PD = 2, NR = 3;
    const int lrow = lane >> 3, lpc = lane & 7;
#pragma nounroll
    for (int it = 0; it < (xdeal ? 8 : (BATCH * NH * 256 + NGW - 1) / NGW); ++it) {
        const int task = xdeal ? (((it * 8 + (X.bid & 7)) << 8) | ((X.bid >> 3) * 8 + X.wave)) : (gw + it * NGW);
        if (task >= BATCH * NH * 256) break;
        const int QST = PASS == 0 ? 4 : 16;
        const int r = PASS == 0 ? (task & 3) : (task & 15), blk = PASS == 0 ? ((task >> 2) & 63) : ((task >> 4) & 15), hh = (task >> 8) & 15, b = task >> 12;
        const bf16_t* base = proj + (size_t)b * SEQ * 3072 + hh * 64;
        const int t0 = (PASS == 0 ? 128 : 512) * blk + r;
        bf16x8 qf[4];
        { const bf16_t* qp = base + (size_t)(t0 + QST * i32) * 3072 + 8 * hi;
#pragma unroll
          for (int d0 = 0; d0 < 4; ++d0) qf[d0] = *(const bf16x8*)(qp + 16 * d0); }
        float m_run = NEG, l_run = 0.f;
        f32x16 o0, o1;
#pragma unroll
        for (int q = 0; q < 16; ++q) { o0[q] = 0.f; o1[q] = 0.f; }
        const size_t srow = (size_t)(b * SEQ + t0 + QST * i32);
        if (PASS == 1) {
            const float2 mlv = ml[srow * NH + hh]; m_run = mlv.x; l_run = hi == 0 ? mlv.y : 0.f;
            const bf16_t* sp = ost + srow * D + hh * 64 + 4 * hi;
#pragma unroll
            for (int gq = 0; gq < 4; ++gq) { const u32x2 w0 = *(const u32x2*)(sp + 8 * gq), w1 = *(const u32x2*)(sp + 32 + 8 * gq);
                o0[4 * gq] = bf_lo(w0.x); o0[4 * gq + 1] = bf_hi(w0.x); o0[4 * gq + 2] = bf_lo(w0.y); o0[4 * gq + 3] = bf_hi(w0.y);
                o1[4 * gq] = bf_lo(w1.x); o1[4 * gq + 1] = bf_hi(w1.x); o1[4 * gq + 2] = bf_lo(w1.y); o1[4 * gq + 3] = bf_hi(w1.y); }
        }
#define AT_PAT(j) (PASS == 1 ? 0 : ((j) < 5 ? 0 : 1))
#define AT_KT(j) (PASS == 1 ? (j) : ((j) < 5 ? (j) : (j) - 5))
#define AT_DIL(j) (PASS == 1 ? 16 : (AT_PAT(j) == 0 ? 4 : 1))
#define AT_QS(j) (PASS == 1 ? 1 : (AT_PAT(j) == 0 ? 1 : 4))
#define AT_RR(j) (PASS == 1 ? r : (AT_PAT(j) == 0 ? r : 0))
        u32x4 kr[NR][4], vr[NR][4];
        auto issue = [&](int j, u32x4 (&kk)[4], u32x4 (&vv)[4]) {
            const int dil = AT_DIL(j), rr = AT_RR(j), Mt = (t0 - rr) / dil - 128 + 32 * AT_KT(j);
            auto keypos = [&](int M) { int p = dil * M + rr; p = p < 0 ? 0 : p; p = p > seqmax ? seqmax : p; return p; };
#pragma unroll
            for (int q = 0; q < 4; ++q) {
                const bf16_t* rp = base + (size_t)keypos(Mt + 8 * q + lrow) * 3072;
                kk[q] = *(const u32x4*)(rp + 1024 + 8 * (lpc ^ lrow));
                vv[q] = *(const u32x4*)(rp + 2048 + 8 * lpc);
            }
        };
#pragma unroll
        for (int j = 0; j < PD; ++j) issue(j, kr[j], vr[j]);
#pragma unroll
        for (int j = 0; j < NT; ++j) {
            if (j + PD < NT) issue(j + PD, kr[(j + PD) % NR], vr[(j + PD) % NR]);
            const int kt = AT_KT(j), dil = AT_DIL(j), rr = AT_RR(j), Mstart = (t0 - rr) / dil - 128, qi = AT_QS(j) * i32;
            f32x16 s;
#pragma unroll
            for (int q = 0; q < 16; ++q) s[q] = 0.f;
#pragma unroll
            for (int q = 0; q < 4; ++q) *(LAS u32x4*)(kbuf + (j & 1) * 4096 + q * 1024 + lane * 16) = kr[j % NR][q];
            bf16x8 kf[4];
#pragma unroll
            for (int d0 = 0; d0 < 4; ++d0) kf[d0] = *(const LAS bf16x8*)(kbuf + (j & 1) * 4096 + (i32 >> 3) * 1024 + (i32 & 7) * 128 + (((2 * d0 + hi) ^ (i32 & 7)) << 4));
#pragma unroll
            for (int d0 = 0; d0 < 4; ++d0) s = __builtin_amdgcn_mfma_f32_32x32x16_bf16(kf[d0], qf[d0], s, 0, 0, 0);
            const int hi_ = qi + 128 - 32 * kt; int lo = hi_ - 128; { const int nk = -(Mstart + 32 * kt); lo = lo > nk ? lo : nk; }
            const int rb = 4 * hi - lo; const unsigned span = (unsigned)(hi_ - lo);
            const bool any = hi_ >= lo;
            float tmax = NEG;
#pragma unroll
            for (int q = 0; q < 16; ++q) { const int rowc = (q & 3) + 8 * (q >> 2); const bool ok = any && ((unsigned)(rowc + rb) <= span) && (rowc + rb >= 0); s[q] = ok ? s[q] : NEG; tmax = fmaxf(tmax, s[q]); }
            tmax = fmaxf(tmax, bperm_f(lane ^ 32, tmax));
            const float m_new = fmaxf(m_run, tmax), sc = __builtin_amdgcn_exp2f(m_run - m_new);
            m_run = m_new;
            float ps = 0.f;
#pragma unroll
            for (int q = 0; q < 16; ++q) { s[q] = __builtin_amdgcn_exp2f(s[q] - m_new); ps += s[q]; }
            l_run = l_run * sc + ps;
#pragma unroll
            for (int q = 0; q < 16; ++q) { o0[q] *= sc; o1[q] *= sc; }
            u32x4 pw0, pw1;
            pw0.x = cvt_pk_bf16(s[0], s[1]); pw0.y = cvt_pk_bf16(s[2], s[3]); pw0.z = cvt_pk_bf16(s[4], s[5]); pw0.w = cvt_pk_bf16(s[6], s[7]);
            pw1.x = cvt_pk_bf16(s[8], s[9]); pw1.y = cvt_pk_bf16(s[10], s[11]); pw1.z = cvt_pk_bf16(s[12], s[13]); pw1.w = cvt_pk_bf16(s[14], s[15]);
            const bf16x8 pf0 = __builtin_bit_cast(bf16x8, pw0), pf1 = __builtin_bit_cast(bf16x8, pw1);
#pragma unroll
            for (int q = 0; q < 4; ++q) *(LAS u32x4*)(vbuf + (j & 1) * 4096 + ((lpc >> 2) * 2 + (q >> 1)) * 1024 + ((q & 1) * 8 + lrow) * 64 + (lpc & 3) * 16) = vr[j % NR][q];
            const LAS unsigned char* vb = vbuf + (j & 1) * 4096 + vrd;
#pragma unroll
            for (int dh = 0; dh < 2; ++dh) {
#pragma unroll
                for (int kg = 0; kg < 2; ++kg) {
                    const v4i16_t vlo = vtr16(vb + (dh * 2 + kg) * 1024), vhi = vtr16(vb + (dh * 2 + kg) * 1024 + 512);
                    const bf16x8 vf = (bf16x8){vlo[0], vlo[1], vlo[2], vlo[3], vhi[0], vhi[1], vhi[2], vhi[3]};
                    if (dh == 0) o0 = __builtin_amdgcn_mfma_f32_32x32x16_bf16(vf, kg == 0 ? pf0 : pf1, o0, 0, 0, 0);
                    else o1 = __builtin_amdgcn_mfma_f32_32x32x16_bf16(vf, kg == 0 ? pf0 : pf1, o1, 0, 0, 0);
                }
            }
        }
#undef AT_PAT
#undef AT_KT
#undef AT_DIL
#undef AT_QS
#undef AT_RR
        const float lt = l_run + bperm_f(lane ^ 32, l_run), rl = PASS == 1 ? 1.0f / lt : 1.0f;
        if (PASS == 0 && hi == 0) ml[srow * NH + hh] = make_float2(m_run, lt);
        bf16_t* op = (PASS == 1 ? att : ost) + srow * D + hh * 64 + 4 * hi;
#pragma unroll
        for (int gq = 0; gq < 4; ++gq) {
            u32x2 w0, w1;
            w0.x = cvt_pk_bf16(o0[4 * gq] * rl, o0[4 * gq + 1] * rl); w0.y = cvt_pk_bf16(o0[4 * gq + 2] * rl, o0[4 * gq + 3] * rl);
            w1.x = cvt_pk_bf16(o1[4 * gq] * rl, o1[4 * gq + 1] * rl); w1.y = cvt_pk_bf16(o1[4 * gq + 2] * rl, o1[4 * gq + 3] * rl);
            *(u32x2*)(op + 8 * gq) = w0; *(u32x2*)(op + 32 + 8 * gq) = w1;
        }
    }
}

__device__ __forceinline__ void phase_attn_coop1(const Ctx& X, const bf16_t* proj, bf16_t* att, const bf16_t* ost, const float2* ml) {
    using pg8::bf16x8;
    const int lane = X.lane, i32 = lane & 31, hi = lane >> 5, w = X.wave;
    LAS unsigned char* kimg = X.lds;
    LAS unsigned char* vimg = X.lds + 49152;
    const float NEG = opaque_f(-3.0e38f); const int seqmax = opaque_i(SEQ - 1);
    const int vrd = ((lane >> 4) & 1) * 32 + (lane & 3) * 8 + (4 * hi + ((lane & 15) >> 2)) * 64;
    const int lrow = X.tid >> 3, lpc = X.tid & 7;
    constexpr int NGRP = BATCH * NH * 32;
    const bool xdeal = (X.G == 256);
    const int ngi = xdeal ? 8 : (NGRP + X.G - 1) / X.G;
    auto group_of = [&](int it) { return xdeal ? (((it * 8 + (X.bid & 7)) << 5) | (X.bid >> 3)) : (X.bid + it * X.G); };
    u32x4 pk[6], pv[6];
    auto prefetch = [&](int grp) {
        const int half = grp & 1, r = (grp >> 1) & 15, hh = (grp >> 5) & 15, b = grp >> 9;
        const bf16_t* base = proj + (size_t)b * SEQ * 3072 + hh * 64;
#pragma unroll
        for (int i = 0; i < 6; ++i) {
            const int ridx = lrow + 64 * i, M = 32 * (8 * half - 4) + ridx;
            int p = 16 * M + r; p = p < 0 ? 0 : p; p = p > seqmax ? seqmax : p;
            const bf16_t* rp = base + (size_t)p * 3072;
            pk[i] = *(const u32x4*)(rp + 1024 + 8 * lpc); pv[i] = *(const u32x4*)(rp + 2048 + 8 * lpc);
        }
    };
    if (group_of(0) < NGRP) prefetch(group_of(0));
#pragma nounroll
    for (int it = 0; it < ngi; ++it) {
        const int grp = group_of(it);
        if (grp >= NGRP) break;
        const int half = grp & 1, r = (grp >> 1) & 15, hh = (grp >> 5) & 15, b = grp >> 9;
        __syncthreads();
#pragma unroll
        for (int i = 0; i < 6; ++i) {
            const int ridx = lrow + 64 * i, tl = ridx >> 5, row = ridx & 31;
            *(LAS u32x4*)(kimg + tl * 4096 + row * 128 + ((lpc ^ (row & 7)) << 4)) = pk[i];
            *(LAS u32x4*)(vimg + tl * 4096 + ((lpc >> 2) * 2 + (row >> 4)) * 1024 + (row & 15) * 64 + (lpc & 3) * 16) = pv[i];
        }
        __syncthreads();
        const int blk = 8 * half + w, t0 = 512 * blk + r;
        const bf16_t* base = proj + (size_t)b * SEQ * 3072 + hh * 64;
        bf16x8 qf[4];
        { const bf16_t* qp = base + (size_t)(t0 + 16 * i32) * 3072 + 8 * hi;
#pragma unroll
          for (int d0 = 0; d0 < 4; ++d0) qf[d0] = *(const bf16x8*)(qp + 16 * d0); }
        const size_t srow = (size_t)(b * SEQ + t0 + 16 * i32);
        float m_run, l_run; f32x16 o0, o1;
        { const float2 mlv = ml[srow * NH + hh]; m_run = mlv.x; l_run = hi == 0 ? mlv.y : 0.f;
          const bf16_t* sp = ost + srow * D + hh * 64 + 4 * hi;
#pragma unroll
          for (int gq = 0; gq < 4; ++gq) { const u32x2 w0 = *(const u32x2*)(sp + 8 * gq), w1 = *(const u32x2*)(sp + 32 + 8 * gq);
              o0[4 * gq] = bf_lo(w0.x); o0[4 * gq + 1] = bf_hi(w0.x); o0[4 * gq + 2] = bf_lo(w0.y); o0[4 * gq + 3] = bf_hi(w0.y);
              o1[4 * gq] = bf_lo(w1.x); o1[4 * gq + 1] = bf_hi(w1.x); o1[4 * gq + 2] = bf_lo(w1.y); o1[4 * gq + 3] = bf_hi(w1.y); } }
        { const int gn = it + 1 < ngi ? group_of(it + 1) : NGRP; if (gn < NGRP) prefetch(gn); }
        const int Mstart = 32 * blk - 128;
#pragma unroll
        for (int kt = 0; kt < 5; ++kt) {
            const LAS unsigned char* kt_ = kimg + (w + kt) * 4096; const LAS unsigned char* vt_ = vimg + (w + kt) * 4096 + vrd;
            bf16x8 kf[4];
#pragma unroll
            for (int d0 = 0; d0 < 4; ++d0) kf[d0] = *(const LAS bf16x8*)(kt_ + i32 * 128 + (((2 * d0 + hi) ^ (i32 & 7)) << 4));
            f32x16 s;
#pragma unroll
            for (int q = 0; q < 16; ++q) s[q] = 0.f;
#pragma unroll
            for (int d0 = 0; d0 < 4; ++d0) s = __builtin_amdgcn_mfma_f32_32x32x16_bf16(kf[d0], qf[d0], s, 0, 0, 0);
            const int hi_ = i32 + 128 - 32 * kt; int lo = hi_ - 128; { const int nk = -(Mstart + 32 * kt); lo = lo > nk ? lo : nk; }
            const int rb = 4 * hi - lo; const unsigned span = (unsigned)(hi_ - lo);
            const bool any = hi_ >= lo;
            float tmax = NEG;
#pragma unroll
            for (int q = 0; q < 16; ++q) { const int rowc = (q & 3) + 8 * (q >> 2); const bool ok = any && ((unsigned)(rowc + rb) <= span) && (rowc + rb >= 0); s[q] = ok ? s[q] : NEG; tmax = fmaxf(tmax, s[q]); }
            tmax = fmaxf(tmax, bperm_f(lane ^ 32, tmax));
            const float m_new = fmaxf(m_run, tmax), sc = __builtin_amdgcn_exp2f(m_run - m_new);
            m_run = m_new;
            float ps = 0.f;
#pragma unroll
            for (int q = 0; q < 16; ++q) { s[q] = __builtin_amdgcn_exp2f(s[q] - m_new); ps += s[q]; }
            l_run = l_run * sc + ps;
#pragma unroll
            for (int q = 0; q < 16; ++q) { o0[q] *= sc; o1[q] *= sc; }
            u32x4 pw0, pw1;
            pw0.x = cvt_pk_bf16(s[0], s[1]); pw0.y = cvt_pk_bf16(s[2], s[3]); pw0.z = cvt_pk_bf16(s[4], s[5]); pw0.w = cvt_pk_bf16(s[6], s[7]);
            pw1.x = cvt_pk_bf16(s[8], s[9]); pw1.y = cvt_pk_bf16(s[10], s[11]); pw1.z = cvt_pk_bf16(s[12], s[13]); pw1.w = cvt_pk_bf16(s[14], s[15]);
            const bf16x8 pf0 = __builtin_bit_cast(bf16x8, pw0), pf1 = __builtin_bit_cast(bf16x8, pw1);
#pragma unroll
            for (int dh = 0; dh < 2; ++dh) {
#pragma unroll
                for (int kg = 0; kg < 2; ++kg) {
                    const v4i16_t vlo = vtr16(vt_ + (dh * 2 + kg) * 1024), vhi = vtr16(vt_ + (dh * 2 + kg) * 1024 + 512);
                    const bf16x8 vf = (bf16x8){vlo[0], vlo[1], vlo[2], vlo[3], vhi[0], vhi[1], vhi[2], vhi[3]};
                    if (dh == 0) o0 = __builtin_amdgcn_mfma_f32_32x32x16_bf16(vf, kg == 0 ? pf0 : pf1, o0, 0, 0, 0);
                    else o1 = __builtin_amdgcn_mfma_f32_32x32x16_bf16(vf, kg == 0 ? pf0 : pf1, o1, 0, 0, 0);
                }
            }
        }
        const float lt = l_run + bperm_f(lane ^ 32, l_run), rl = 1.0f / lt;
        bf16_t* op = att + srow * D + hh * 64 + 4 * hi;
#pragma unroll
        for (int gq = 0; gq < 4; ++gq) {
            u32x2 w0, w1;
            w0.x = cvt_pk_bf16(o0[4 * gq] * rl, o0[4 * gq + 1] * rl); w0.y = cvt_pk_bf16(o0[4 * gq + 2] * rl, o0[4 * gq + 3] * rl);
            w1.x = cvt_pk_bf16(o1[4 * gq] * rl, o1[4 * gq + 1] * rl); w1.y = cvt_pk_bf16(o1[4 * gq + 2] * rl, o1[4 * gq + 3] * rl);
            *(u32x2*)(op + 8 * gq) = w0; *(u32x2*)(op + 32 + 8 * gq) = w1;
        }
    }
    __syncthreads();
}

__device__ __forceinline__ void phase_attn_coop0(const Ctx& X, const bf16_t* proj, bf16_t* ost, float2* ml) {
    using pg8::bf16x8;
    const int lane = X.lane, i32 = lane & 31, hi = lane >> 5, w = X.wave;
    LAS unsigned char* vbuf = X.lds + w * 16384;
    LAS unsigned char* kbuf = vbuf + 8192;
    LAS unsigned char* kimg = X.lds;
    LAS unsigned char* vimg = X.lds + 53248;
    const float NEG = opaque_f(-3.0e38f); const int seqmax = opaque_i(SEQ - 1);
    const int vrd = ((lane >> 4) & 1) * 32 + (lane & 3) * 8 + (4 * hi + ((lane & 15) >> 2)) * 64;
    const int lrow = lane >> 3, lpc = lane & 7;
    constexpr int NGRP = BATCH * NH * 32;
    const bool xdeal = (X.G == 256);
    const int ngi = xdeal ? 8 : (NGRP + X.G - 1) / X.G;
    constexpr int PD = 2, NR = 3;
#pragma nounroll
    for (int it = 0; it < ngi; ++it) {
        const int grp = xdeal ? (((it * 8 + (X.bid & 7)) << 5) | (X.bid >> 3)) : (X.bid + it * X.G);
        if (grp >= NGRP) break;
        const int n0 = 2 * (grp & 31), hh = (grp >> 5) & 15, b = grp >> 9;
        const int r = w & 3, bq = w >> 2, blk = n0 + bq, t0 = 128 * blk + r;
        const bf16_t* base = proj + (size_t)b * SEQ * 3072 + hh * 64;
        __syncthreads();
        bf16x8 qf[4];
        { const bf16_t* qp = base + (size_t)(t0 + 4 * i32) * 3072 + 8 * hi;
#pragma unroll
          for (int d0 = 0; d0 < 4; ++d0) qf[d0] = *(const bf16x8*)(qp + 16 * d0); }
        float m_run = NEG, l_run = 0.f;
        f32x16 o0, o1;
#pragma unroll
        for (int q = 0; q < 16; ++q) { o0[q] = 0.f; o1[q] = 0.f; }
        const size_t srow = (size_t)(b * SEQ + t0 + 4 * i32);
#define AT_TILE(kf, Mstart_, kt_, qi_, VADDR) do { \
            f32x16 s; _Pragma("unroll") for (int q = 0; q < 16; ++q) s[q] = 0.f; \
            _Pragma("unroll") for (int d0 = 0; d0 < 4; ++d0) s = __builtin_amdgcn_mfma_f32_32x32x16_bf16(kf[d0], qf[d0], s, 0, 0, 0); \
            const int hi_ = (qi_) + 128 - 32 * (kt_); int lo = hi_ - 128; { const int nk = -((Mstart_) + 32 * (kt_)); lo = lo > nk ? lo : nk; } \
            const int rb = 4 * hi - lo; const unsigned span = (unsigned)(hi_ - lo); const bool any = hi_ >= lo; \
            float tmax = NEG; \
            _Pragma("unroll") for (int q = 0; q < 16; ++q) { const int rowc = (q & 3) + 8 * (q >> 2); const bool ok = any && ((unsigned)(rowc + rb) <= span) && (rowc + rb >= 0); s[q] = ok ? s[q] : NEG; tmax = fmaxf(tmax, s[q]); } \
            tmax = fmaxf(tmax, bperm_f(lane ^ 32, tmax)); \
            const float m_new = fmaxf(m_run, tmax), sc = __builtin_amdgcn_exp2f(m_run - m_new); m_run = m_new; \
            float ps = 0.f; \
            _Pragma("unroll") for (int q = 0; q < 16; ++q) { s[q] = __builtin_amdgcn_exp2f(s[q] - m_new); ps += s[q]; } \
            l_run = l_run * sc + ps; \
            _Pragma("unroll") for (int q = 0; q < 16; ++q) { o0[q] *= sc; o1[q] *= sc; } \
            u32x4 pw0, pw1; \
            pw0.x = cvt_pk_bf16(s[0], s[1]); pw0.y = cvt_pk_bf16(s[2], s[3]); pw0.z = cvt_pk_bf16(s[4], s[5]); pw0.w = cvt_pk_bf16(s[6], s[7]); \
            pw1.x = cvt_pk_bf16(s[8], s[9]); pw1.y = cvt_pk_bf16(s[10], s[11]); pw1.z = cvt_pk_bf16(s[12], s[13]); pw1.w = cvt_pk_bf16(s[14], s[15]); \
            const bf16x8 pf0 = __builtin_bit_cast(bf16x8, pw0), pf1 = __builtin_bit_cast(bf16x8, pw1); \
            _Pragma("unroll") for (int dh = 0; dh < 2; ++dh) { _Pragma("unroll") for (int kg = 0; kg < 2; ++kg) { \
                const LAS unsigned char* va_ = VADDR(dh, kg); \
                const v4i16_t vlo = vtr16(va_), vhi = vtr16(va_ + 512); \
                const bf16x8 vf = (bf16x8){vlo[0], vlo[1], vlo[2], vlo[3], vhi[0], vhi[1], vhi[2], vhi[3]}; \
                if (dh == 0) o0 = __builtin_amdgcn_mfma_f32_32x32x16_bf16(vf, kg == 0 ? pf0 : pf1, o0, 0, 0, 0); \
                else o1 = __builtin_amdgcn_mfma_f32_32x32x16_bf16(vf, kg == 0 ? pf0 : pf1, o1, 0, 0, 0); } } \
        } while (0)
        {
            const int Mstart = (t0 - r) / 4 - 128;
            u32x4 kr[NR][4], vr[NR][4];
            auto issue = [&](int j, u32x4 (&kk)[4], u32x4 (&vv)[4]) {
                const int Mt = Mstart + 32 * j;
#pragma unroll
                for (int q = 0; q < 4; ++q) {
                    int p = 4 * (Mt + 8 * q + lrow) + r; p = p < 0 ? 0 : p; p = p > seqmax ? seqmax : p;
                    const bf16_t* rp = base + (size_t)p * 3072;
                    kk[q] = *(const u32x4*)(rp + 1024 + 8 * (lpc ^ lrow)); vv[q] = *(const u32x4*)(rp + 2048 + 8 * lpc);
                }
            };
#pragma unroll
            for (int j = 0; j < PD; ++j) issue(j, kr[j], vr[j]);
#pragma unroll
            for (int j = 0; j < 5; ++j) {
                if (j + PD < 5) issue(j + PD, kr[(j + PD) % NR], vr[(j + PD) % NR]);
#pragma unroll
                for (int q = 0; q < 4; ++q) *(LAS u32x4*)(kbuf + (j & 1) * 4096 + q * 1024 + lane * 16) = kr[j % NR][q];
                bf16x8 kf[4];
#pragma unroll
                for (int d0 = 0; d0 < 4; ++d0) kf[d0] = *(const LAS bf16x8*)(kbuf + (j & 1) * 4096 + (i32 >> 3) * 1024 + (i32 & 7) * 128 + (((2 * d0 + hi) ^ (i32 & 7)) << 4));
#pragma unroll
                for (int q = 0; q < 4; ++q) *(LAS u32x4*)(vbuf + (j & 1) * 4096 + ((lpc >> 2) * 2 + (q >> 1)) * 1024 + ((q & 1) * 8 + lrow) * 64 + (lpc & 3) * 16) = vr[j % NR][q];
#define AT_VP(dh, kg) (vbuf + (j & 1) * 4096 + vrd + ((dh) * 2 + (kg)) * 1024)
                AT_TILE(kf, Mstart, j, i32, AT_VP);
#undef AT_VP
            }
        }
        {
            __builtin_amdgcn_sched_barrier(0);
            u32x4 sh[13];
            const int p0 = 128 * (n0 - 1);
#pragma unroll
            for (int i = 0; i < 13; ++i) {
                const int e_ = X.tid + 512 * i; const bool isv = e_ >= 3328; const int ee = isv ? e_ - 3328 : e_;
                int p = p0 + (ee >> 3); p = p < 0 ? 0 : p; p = p > seqmax ? seqmax : p;
                sh[i] = *(const u32x4*)(base + (size_t)p * 3072 + (isv ? 2048 : 1024) + 8 * (ee & 7));
            }
            __syncthreads();
#pragma unroll
            for (int i = 0; i < 13; ++i) {
                const int e_ = X.tid + 512 * i; const bool isv = e_ >= 3328; const int ee = isv ? e_ - 3328 : e_, row = ee >> 3, pc = ee & 7;
                if (isv) *(LAS u32x4*)(vimg + (pc >> 2) * 26624 + row * 64 + (pc & 3) * 16) = sh[i];
                else *(LAS u32x4*)(kimg + row * 128 + ((pc ^ (row & 7)) << 4)) = sh[i];
            }
            __syncthreads();
            const int Mstart = t0 - 128, s0 = 128 * bq + r;
#pragma nounroll
            for (int kt = 0; kt < 8; ++kt) {
                const int R = s0 + 32 * kt + i32;
                bf16x8 kf[4];
#pragma unroll
                for (int d0 = 0; d0 < 4; ++d0) kf[d0] = *(const LAS bf16x8*)(kimg + R * 128 + (((2 * d0 + hi) ^ (R & 7)) << 4));
#define AT_VP(dh, kg) (vimg + (dh) * 26624 + (s0 + 32 * kt + 16 * (kg)) * 64 + vrd)
                AT_TILE(kf, Mstart, kt, 4 * i32, AT_VP);
#undef AT_VP
            }
        }
#undef AT_TILE
        const float lt = l_run + bperm_f(lane ^ 32, l_run);
        if (hi == 0) ml[srow * NH + hh] = make_float2(m_run, lt);
        bf16_t* op = ost + srow * D + hh * 64 + 4 * hi;
#pragma unroll
        for (int gq = 0; gq < 4; ++gq) {
            u32x2 w0, w1;
            w0.x = cvt_pk_bf16(o0[4 * gq], o0[4 * gq + 1]); w0.y = cvt_pk_bf16(o0[4 * gq + 2], o0[4 * gq + 3]);
            w1.x = cvt_pk_bf16(o1[4 * gq], o1[4 * gq + 1]); w1.y = cvt_pk_bf16(o1[4 * gq + 2], o1[4 * gq + 3]);
            *(u32x2*)(op + 8 * gq) = w0; *(u32x2*)(op + 32 + 8 * gq) = w1;
        }
    }
    __syncthreads();
}

__device__ __forceinline__ void phase_ln_router(const Ctx& X, int layer, const bf16_t* hin, const bf16_t* mixo, const float* g, const float* bta, const float* rb, bf16_t* h1, int cnt_layer, int probe = 0) {
    using pg8::bf16x8;
    LAS unsigned char* Ah = X.lds;
    LAS unsigned char* Al = X.lds + 65536;
    LAS float* P = (LAS float*)X.lds;
    LAS int* s_cnt = (LAS int*)(X.lds + TAB_OFF);
    LAS int* s_gb = s_cnt + 32;
    const int lane = X.lane, w = X.wave, tok = lane & 31, hi = lane >> 5;
    int* tok_e = (int*)(X.ws + WS_TOKE); int* tok_r = (int*)(X.ws + WS_TOKR); float* glist = (float*)(X.ws + WS_GLIST); unsigned char* XG8 = (unsigned char*)(X.ws + WS_XG); int* stok = (int*)(X.ws + WS_STOK);
    unsigned* cnt = X.ctl + CW_CNT + cnt_layer * 32 * 64;
    const float rbe = rb[tok]; const float ninf = opaque_f(-INFINITY);
    const auto rs_h = __builtin_amdgcn_make_buffer_rsrc((void*)hin, 0, -1, 0x00020000), rs_m = __builtin_amdgcn_make_buffer_rsrc((void*)mixo, 0, -1, 0x00020000);
#define LNA_LD(rs_, tokidx_, j_) __builtin_bit_cast(u32x4, __builtin_amdgcn_raw_buffer_load_b128(rs_, lane * 16, (tokidx_) * (D * 2) + (j_) * 1024, 0))
    const int tb = X.bid * 128;
    if (tb < T) {
        u32x4 raw[4][4];
#pragma unroll
        for (int tl = 0; tl < 4; ++tl) { const int ti_ = __builtin_amdgcn_readfirstlane(tb + w * 4 + tl);
#pragma unroll
            for (int j = 0; j < 2; ++j) { raw[tl][2 * j] = LNA_LD(rs_h, ti_, j); raw[tl][2 * j + 1] = LNA_LD(rs_m, ti_, j); } }
#pragma nounroll
        for (int rnd = 0; rnd < 4; ++rnd) {
            __syncthreads();
            if (X.tid < 32) s_cnt[X.tid] = 0;
            const int t0 = tb + rnd * 32 + w * 4;
            int lane_o = lane; asm volatile("" : "+v"(lane_o));
            const int tok_o = lane_o & 31, hi_o = lane_o >> 5;
            float v[4][16]; u32x2 xo[4][2];
            const float* g2 = g; const float* b2 = bta; asm volatile("" : "+s"(g2), "+s"(b2));
#pragma unroll
            for (int tl = 0; tl < 4; ++tl) {
                const size_t rowo = (size_t)(t0 + tl) * D;
                float s = 0.f;
#pragma unroll
                for (int j = 0; j < 2; ++j) { float a[8], m[8]; unpack8(raw[tl][2 * j], a); unpack8(raw[tl][2 * j + 1], m);
#pragma unroll
                    for (int q = 0; q < 8; ++q) { v[tl][j * 8 + q] = DN_ALPHA * a[q] + m[q]; s += v[tl][j * 8 + q]; } }
                const float mean = wave_sum(s) * (1.f / D); float s2 = 0.f;
#pragma unroll
                for (int q = 0; q < 16; ++q) { v[tl][q] -= mean; s2 += v[tl][q] * v[tl][q]; }
                const float rstd = rsqrtf(wave_sum(s2) * (1.f / D) + opaque_f(LN_EPS));
#pragma unroll
                for (int j = 0; j < 2; ++j) { const f32x4 g0 = *(const f32x4*)(g2 + j * 512 + lane * 8), g1 = *(const f32x4*)(g2 + j * 512 + lane * 8 + 4), b0 = *(const f32x4*)(b2 + j * 512 + lane * 8), b1 = *(const f32x4*)(b2 + j * 512 + lane * 8 + 4);
#pragma unroll
                    for (int q = 0; q < 4; ++q) { v[tl][j * 8 + q] = v[tl][j * 8 + q] * rstd * g0[q] + b0[q]; v[tl][j * 8 + 4 + q] = v[tl][j * 8 + 4 + q] * rstd * g1[q] + b1[q]; } }
                xo[tl][0].x = pk4_fp8(v[tl][0], v[tl][1], v[tl][2], v[tl][3]); xo[tl][0].y = pk4_fp8(v[tl][4], v[tl][5], v[tl][6], v[tl][7]);
                xo[tl][1].x = pk4_fp8(v[tl][8], v[tl][9], v[tl][10], v[tl][11]); xo[tl][1].y = pk4_fp8(v[tl][12], v[tl][13], v[tl][14], v[tl][15]);
                const int tr = w * 4 + tl;
#pragma unroll
                for (int j = 0; j < 2; ++j) {
                    u32x4 oh, ol; float lo[8];
                    oh.x = cvt_pk_bf16(v[tl][j * 8 + 0], v[tl][j * 8 + 1]); oh.y = cvt_pk_bf16(v[tl][j * 8 + 2], v[tl][j * 8 + 3]); oh.z = cvt_pk_bf16(v[tl][j * 8 + 4], v[tl][j * 8 + 5]); oh.w = cvt_pk_bf16(v[tl][j * 8 + 6], v[tl][j * 8 + 7]);
                    float hf[8]; unpack8(oh, hf);
#pragma unroll
                    for (int q = 0; q < 8; ++q) lo[q] = v[tl][j * 8 + q] - hf[q];
                    ol = pack8(lo);
                    *(u32x4*)(h1 + rowo + j * 512 + lane * 8) = oh;
                    const int ch = ((lane_o + 64 * j) ^ (tr & 7)) << 4;
                    *(LAS u32x4*)(Ah + tr * 2048 + ch) = oh; *(LAS u32x4*)(Al + tr * 2048 + ch) = ol;
                }

            }
            if (rnd < 3) {
#pragma unroll
                for (int tl = 0; tl < 4; ++tl) { const int ti_ = __builtin_amdgcn_readfirstlane(t0 + 32 + tl);
#pragma unroll
                    for (int j = 0; j < 2; ++j) { raw[tl][2 * j] = LNA_LD(rs_h, ti_, j); raw[tl][2 * j + 1] = LNA_LD(rs_m, ti_, j); } } }
            bf16x8 wfh[8], wfl[8];
            { const bf16_t* rwh = (const bf16_t*)(X.ws + WS_RWH) + ((size_t)layer * NE + tok) * D + 128 * w + 8 * hi; const bf16_t* rwl = (const bf16_t*)(X.ws + WS_RWL) + ((size_t)layer * NE + tok) * D + 128 * w + 8 * hi;
#pragma unroll
              for (int i = 0; i < 8; ++i) { wfh[i] = *(const bf16x8*)(rwh + 16 * i); wfl[i] = *(const bf16x8*)(rwl + 16 * i); } }
            __syncthreads();
            f32x16 acc;
#pragma unroll
            for (int q = 0; q < 16; ++q) acc[q] = 0.f;
#pragma unroll
            for (int i = 0; i < 8; ++i) {
                const int ch = ((2 * (8 * w + i) + hi_o) ^ (tok_o & 7)) << 4;
                const bf16x8 bh = *(const LAS bf16x8*)(Ah + tok_o * 2048 + ch), bl = *(const LAS bf16x8*)(Al + tok_o * 2048 + ch);
                acc = __builtin_amdgcn_mfma_f32_32x32x16_bf16(wfh[i], bh, acc, 0, 0, 0);
                acc = __builtin_amdgcn_mfma_f32_32x32x16_bf16(wfl[i], bh, acc, 0, 0, 0);
                acc = __builtin_amdgcn_mfma_f32_32x32x16_bf16(wfh[i], bl, acc, 0, 0, 0);
            }
            __syncthreads();
#pragma unroll
            for (int q = 0; q < 16; ++q) P[(w * 32 + tok) * 33 + (q & 3) + 8 * (q >> 2) + 4 * hi] = acc[q];
            __syncthreads();
            float lg[4];
#pragma unroll
            for (int tl = 0; tl < 4; ++tl) { float a = 0.f;
#pragma unroll
                for (int ww = 0; ww < 4; ++ww) a += P[((hi * 4 + ww) * 32 + (w * 4 + tl)) * 33 + tok];
                a += bperm_f(lane_o ^ 32, a); lg[tl] = a + rbe; }
            const int e = tok;
            int my_e = 0; float my_g = 0.f;
#pragma unroll
            for (int tl = 0; tl < 4; ++tl) {
                float cur = lg[tl];
                float sv0 = 0.f, sv1 = 0.f, sv2 = 0.f, sv3 = 0.f; int si0 = 0, si1 = 0, si2 = 0, si3 = 0;
#pragma unroll
                for (int k = 0; k < 4; ++k) {
                    float bv = cur; int bi = e;
#define LNA_XS(o) { const float ov = swz_f<o>(bv); const int oi = swz_i<o>(bi); if (ov > bv || (ov == bv && oi < bi)) { bv = ov; bi = oi; } }
                    LNA_XS(1) LNA_XS(2) LNA_XS(4) LNA_XS(8) LNA_XS(16)
#undef LNA_XS
                    if (k == 0) { sv0 = bv; si0 = bi; } else if (k == 1) { sv1 = bv; si1 = bi; } else if (k == 2) { sv2 = bv; si2 = bi; } else { sv3 = bv; si3 = bi; }
                    if (e == bi) cur = ninf;
                }
                const float e1 = __expf(sv1 - sv0), e2 = __expf(sv2 - sv0), e3 = __expf(sv3 - sv0), inv = 1.f / (1.f + e1 + e2 + e3);
                if ((lane >> 2) == tl) { const int k = lane & 3; my_e = k == 0 ? si0 : k == 1 ? si1 : k == 2 ? si2 : si3; my_g = (k == 0 ? 1.f : k == 1 ? e1 : k == 2 ? e2 : e3) * inv; }
            }
            int my_lr = 0;
            if (lane < 16) my_lr = __hip_atomic_fetch_add(&s_cnt[my_e], 1, __ATOMIC_RELAXED, __HIP_MEMORY_SCOPE_WORKGROUP);
            __syncthreads();
            { int tid_o = X.tid; asm volatile("" : "+v"(tid_o));
#ifdef PROBE_LNA
              if (probe & 4) { if (tid_o < 32) s_gb[tid_o] = tb + rnd * 32; } else
#endif
              if (tid_o < 32) { const int c = s_cnt[tid_o]; s_gb[tid_o] = c ? (int)atomicAdd(cnt + tid_o * 64, (unsigned)c) : 0; } }
            __syncthreads();
            int my_r = 0;
            if (lane < 16) { my_r = s_gb[my_e] + my_lr; const int t = t0 + (lane >> 2); tok_e[t * 4 + (lane & 3)] = my_e; tok_r[t * 4 + (lane & 3)] = my_r; glist[(size_t)my_e * T + my_r] = my_g; stok[(size_t)my_e * T + my_r] = t; }
#ifdef PROBE_LNA
            if (!(probe & 1))
#endif
#pragma unroll
            for (int tl = 0; tl < 4; ++tl) {
                unsigned char* dst = XG8 + (size_t)(t0 + tl) * D + lane * 8;
                *(u32x2*)(dst) = xo[tl][0]; *(u32x2*)(dst + 512) = xo[tl][1]; }
        }
    }
}
#undef LNA_LD

__device__ __forceinline__ void load_tile_table(const Ctx& X, int layer, LAS int* tb) {
    __syncthreads();
    if (X.tid < 64) {
        const int c = X.tid < 32 ? (int)__hip_atomic_load(X.ctl + CW_CNT + (layer * 32 + X.tid) * 64, RLX_AGENT) : 0;
        const int tl = (c + 255) >> 8; int incl = tl;
#pragma unroll
        for (int o = 1; o < 32; o <<= 1) { const int t = bperm_i(X.lane - o, incl); if ((X.tid & 31) >= o) incl += t; }
        if (X.tid < 32) { tb[X.tid] = incl - tl; if (X.tid == 31) tb[32] = incl; }
    }
    __syncthreads();
}

template <bool OUT_F32>
__device__ __forceinline__ void phase_combine_ln(const Ctx& X, int layer, const bf16_t* h1, const bf16_t* Y, const float* g, const float* bta, void* outp) {
    const int lane = X.lane;
    const int gw = X.bid * NWAVES + X.wave, NGW = X.G * NWAVES;
    const int* tok_e = (const int*)(X.ws + WS_TOKE); const int* tok_r = (const int*)(X.ws + WS_TOKR);
    int basev = 0;
    { const int c = lane < 32 ? (int)__hip_atomic_load(X.ctl + CW_CNT + (layer * 32 + lane) * 64, RLX_AGENT) : 0; const int pc = ((c + 255) >> 8) << 8; int incl = pc;
#pragma unroll
      for (int o = 1; o < 32; o <<= 1) { const int t = bperm_i(lane - o, incl); if ((lane & 31) >= o) incl += t; }
      basev = incl - pc; }
    float gg[16], bb[16];
#pragma unroll
    for (int j = 0; j < 2; ++j) {
        const f32x4 g0 = *(const f32x4*)(g + j * 512 + lane * 8), g1 = *(const f32x4*)(g + j * 512 + lane * 8 + 4), b0 = *(const f32x4*)(bta + j * 512 + lane * 8), b1 = *(const f32x4*)(bta + j * 512 + lane * 8 + 4);
#pragma unroll
        for (int q = 0; q < 4; ++q) { gg[j * 8 + q] = g0[q]; gg[j * 8 + 4 + q] = g1[q]; bb[j * 8 + q] = b0[q]; bb[j * 8 + 4 + q] = b1[q]; }
    }
    for (int bt = gw; bt < T; bt += NGW) {
        int myslot = 0;
        if (lane < 4) myslot = tok_r[bt * 4 + lane];
        const int mye = lane < 4 ? tok_e[bt * 4 + lane] : 0;
        myslot += bperm_i(mye, basev);
        const int s0 = bperm_i(0, myslot), s1 = bperm_i(1, myslot), s2 = bperm_i(2, myslot), s3 = bperm_i(3, myslot);
        float v[16]; float s = 0.f;
#pragma unroll
        for (int j = 0; j < 2; ++j) {
            const int off = j * 512 + lane * 8;
            float a[8], y0[8], y1[8], y2[8], y3[8];
            unpack8(*(const u32x4*)(h1 + (size_t)bt * D + off), a);
            const unsigned char* Y8 = (const unsigned char*)Y;
            unpack8_fp8(*(const u32x2*)(Y8 + (size_t)s0 * D + off), y0); unpack8_fp8(*(const u32x2*)(Y8 + (size_t)s1 * D + off), y1); unpack8_fp8(*(const u32x2*)(Y8 + (size_t)s2 * D + off), y2); unpack8_fp8(*(const u32x2*)(Y8 + (size_t)s3 * D + off), y3);
#pragma unroll
            for (int q = 0; q < 8; ++q) { v[j * 8 + q] = DN_ALPHA * a[q] + (((y0[q] + y1[q]) + y2[q]) + y3[q]) * (1.0f / Y8_SCALE); s += v[j * 8 + q]; }
        }
        const float mean = wave_sum(s) * (1.f / D); float s2q = 0.f;
#pragma unroll
        for (int q = 0; q < 16; ++q) { v[q] -= mean; s2q += v[q] * v[q]; }
        const float rstd = rsqrtf(wave_sum(s2q) * (1.f / D) + opaque_f(LN_EPS));
#pragma unroll
        for (int q = 0; q < 16; ++q) v[q] = v[q] * rstd * gg[q] + bb[q];
#pragma unroll
        for (int j = 0; j < 2; ++j) {
            const size_t o = (size_t)bt * D + j * 512 + lane * 8;
            if (OUT_F32) { float* op = (float*)outp + o; *(f32x4*)(op) = (f32x4){v[j * 8 + 0], v[j * 8 + 1], v[j * 8 + 2], v[j * 8 + 3]}; *(f32x4*)(op + 4) = (f32x4){v[j * 8 + 4], v[j * 8 + 5], v[j * 8 + 6], v[j * 8 + 7]}; }
            else { u32x4 w; w.x = cvt_pk_bf16(v[j * 8 + 0], v[j * 8 + 1]); w.y = cvt_pk_bf16(v[j * 8 + 2], v[j * 8 + 3]); w.z = cvt_pk_bf16(v[j * 8 + 4], v[j * 8 + 5]); w.w = cvt_pk_bf16(v[j * 8 + 6], v[j * 8 + 7]); *(u32x4*)((bf16_t*)outp + o) = w; }
        }
    }
}


__device__ __forceinline__ Ctx refresh_ctx(const Ctx& X0) {
    Ctx X = X0; int wv = X0.wave; asm volatile("" : "+s"(wv)); int t = wv * 64 + lane_id(); asm volatile("" : "+v"(t)); X.tid = t; X.lane = t & 63; X.wave = wv;
    asm volatile("" : "+s"(X.ws), "+s"(X.ctl), "+s"(X.G), "+s"(X.bid));
    return X;
}
#ifndef STAG
#define STAG 0
#endif
__device__ __forceinline__ void stagger(const Ctx& X) { const int n = ((X.bid >> 3) & 31) * STAG;
#pragma nounroll
    for (int i = 0; i < n; ++i) __builtin_amdgcn_s_sleep(1); }
struct Args { const float* in[26]; float* out; unsigned char* ws; int ph_lo, ph_hi; };
constexpr int N_PHASES = 1 + 2 * (6 + 4) + 2 * (4 + 4);
#define GP_ALIGN true
#define GP_SP2 true

__global__ void __launch_bounds__(NTHR, 2) mk_fwd(Args args) {
    extern __shared__ __attribute__((aligned(16))) unsigned char lds_raw[];
    Ctx X0;
    X0.lds = (LAS unsigned char*)lds_raw;
    X0.tid = threadIdx.x; X0.lane = X0.tid & 63; X0.wave = __builtin_amdgcn_readfirstlane(X0.tid >> 6);
    X0.G = gridDim.x; X0.bid = blockIdx.x;
    X0.ws = (GAS unsigned char*)args.ws; X0.ctl = (unsigned*)(args.ws + WS_CTL);
    volatile LAS unsigned* MISC = (volatile LAS unsigned*)(X0.lds + MISC_OFF);
    if (X0.tid < 32) MISC[X0.tid] = 0u;
    __syncthreads();
    XcdBarrier bar; bar.bar = X0.ctl + CW_BAR; bar.x = 0; bar.st = nullptr; bar.wave = X0.wave;
    if (MK_ONE_LAUNCH) bar = xcd_barrier_post(X0.ctl + CW_BAR, MISC + 8, X0.wave);
    volatile LAS unsigned long long* ptab = (volatile LAS unsigned long long*)(X0.lds + TAB_OFF + 1024);
    if (X0.tid < 26) ptab[X0.tid] = (unsigned long long)args.in[X0.tid];
    __syncthreads();
#define INP(k) ld_ptr(ptab, k)
    const int lo = args.ph_lo, hi = args.ph_hi;
    int ph = 0;
#define IN() (lo <= ph && ph < hi)
#define SEAM() do { if (MK_ONE_LAUNCH && lo <= ph && ph + 1 < hi) xcd_barrier(bar); ++ph; } while (0)

#define H0 ((bf16_t*)(X.ws + WS_H0))
#define H1 ((bf16_t*)(X.ws + WS_H1))
#define PROJ ((bf16_t*)(X.ws + WS_PROJ))
#define MIX ((bf16_t*)(X.ws + WS_MIX))
#define MIXO ((bf16_t*)(X.ws + WS_MIXO))
#define Z ((bf16_t*)(X.ws + WS_Z))
#define ACT ((bf16_t*)(X.ws + WS_ACT))
#define Y ((bf16_t*)(X.ws + WS_Y))
#define tb ((LAS int*)(X.lds + TAB_OFF + 512))

#ifndef DUP_MASK
#define DUP_MASK 0
#endif
    enum { P_PRO, P_E1, P_S5A, P_S5C, P_S5B, P_E3, P_E4, P_O1, P_ATT, P_O3, P_LNA, P_M1, P_M2, P_LNB, P_ATT1 };
#define PHASE_BEGIN(k) _Pragma("nounroll") for (int _r = 0; _r < ((((DUP_MASK) >> (k)) & 1) + 1); ++_r) { if (IN()) { const Ctx X = refresh_ctx(X0);
#define PHASE_END } SEAM(); }
    PHASE_BEGIN(P_PRO)  phase_prologue(X, ptab);  PHASE_END

#pragma nounroll
    for (int layer = 0; layer < DEPTH; ++layer) {
        const int i = layer >> 1;
        if ((layer & 1) == 0) {
            PHASE_BEGIN(P_E1)  pg8::Gemm gm{H0, (const bf16_t*)(X.ws + WS_WIN) + (size_t)i * 2048 * D, T, 2048, D}; pg8::StaticOrder S; S.init(T, 2048, D, X.G, X.bid);
                pg8::EpiStore E{PROJ, 2048};
                pg8::gemm_phase<pg8::EpiStore, pg8::StaticOrder, GP_ALIGN, GP_SP2>(X.lds, gm, S, E, X.wave);  PHASE_END
            PHASE_BEGIN(P_S5A)  phase_s5<1>(X, i, PROJ, INP(2), INP(8), INP(9), INP(10), MIX, Z);  PHASE_END
            PHASE_BEGIN(P_S5C)  phase_s5_carry(X, i);  PHASE_END
            PHASE_BEGIN(P_S5B)  phase_s5<2>(X, i, PROJ, INP(2), INP(8), INP(9), INP(10), MIX, Z);  PHASE_END
            PHASE_BEGIN(P_E3)  pg8::Gemm gm{Z, (const bf16_t*)(X.ws + WS_WGLU) + (size_t)i * 512 * 512, T, 512, 512}; pg8::StaticOrder S; S.init(T, 512, 512, X.G, X.bid);
                pg8::EpiGlu E{Z, MIX, INP(12) + (size_t)i * SSM_W};
                pg8::gemm_phase<pg8::EpiGlu, pg8::StaticOrder, GP_ALIGN, GP_SP2>(X.lds, gm, S, E, X.wave);  PHASE_END
            PHASE_BEGIN(P_E4)  pg8::Gemm gm{MIX, (const bf16_t*)(X.ws + WS_WOUT) + (size_t)i * D * D, T, D, D}; pg8::StaticOrder S; S.init(T, D, D, X.G, X.bid);
                pg8::EpiStore E{MIXO, D};
                pg8::gemm_phase<pg8::EpiStore, pg8::StaticOrder, GP_ALIGN, GP_SP2>(X.lds, gm, S, E, X.wave);  PHASE_END
        } else {
            PHASE_BEGIN(P_O1)  pg8::Gemm gm{H0, (const bf16_t*)(X.ws + WS_WQKV) + (size_t)i * 3072 * D, T, 3072, D}; pg8::StaticOrder S; S.init(T, 3072, D, X.G, X.bid);
                pg8::EpiRope E{PROJ, (const f32x2*)(X.ws + WS_ROPE)};
                pg8::gemm_phase<pg8::EpiRope, pg8::StaticOrder, GP_ALIGN, GP_SP2>(X.lds, gm, S, E, X.wave);  PHASE_END
            PHASE_BEGIN(P_ATT)  phase_attn_coop0(X, PROJ, MIXO, (float2*)(X.ws + WS_S5X));  PHASE_END
            PHASE_BEGIN(P_ATT1)  phase_attn_coop1(X, PROJ, MIX, MIXO, (const float2*)(X.ws + WS_S5X));  PHASE_END
            PHASE_BEGIN(P_O3)  pg8::Gemm gm{MIX, (const bf16_t*)(X.ws + WS_WO) + (size_t)i * D * D, T, D, D}; pg8::StaticOrder S; S.init(T, D, D, X.G, X.bid);
                pg8::EpiStore E{MIXO, D};
                pg8::gemm_phase<pg8::EpiStore, pg8::StaticOrder, GP_ALIGN, GP_SP2>(X.lds, gm, S, E, X.wave);  PHASE_END
        }
#ifdef PROBE_LNA
        PHASE_BEGIN(P_LNA)  phase_ln_router(X, layer, H0, MIXO, INP(16) + layer * D, INP(17) + layer * D, INP(21) + layer * NE, H1, _r == 0 ? layer + 4 : layer, _r == 0 ? opaque_i(PROBE_LNA) : 0);  PHASE_END
#else
        PHASE_BEGIN(P_LNA)  phase_ln_router(X, layer, H0, MIXO, INP(16) + layer * D, INP(17) + layer * D, INP(21) + layer * NE, H1, layer);  PHASE_END
#endif
        PHASE_BEGIN(P_M1)  load_tile_table(X, layer, tb);
            pg8::Gemm gm{(const bf16_t*)(X.ws + WS_XG), (const bf16_t*)(X.ws + WS_WGU + (size_t)layer * NE * 2048 * D), 0, 2048, D / 2};
            pg8::MoeOrder<8, true> S; S.init(tb, X.G, X.bid, 2048, D / 2); S.stok = (const int*)(X.ws + WS_STOK); S.cnt = X.ctl + CW_CNT + layer * 32 * 64; S.preload_ids((LAS unsigned short*)(X.lds + 131072 + 3072), X.tid, X.wave);
            stagger(X);
#ifdef PROBE_NOSTORE
            pg8::EpiSwiglu E{opaque_i(((DUP_MASK >> P_M1) & 1) && _r == 0) != 0, ACT, INP(23) + (size_t)layer * NE * 2048};
#else
            pg8::EpiSwiglu E{ACT, INP(23) + (size_t)layer * NE * 2048};
#endif
#if defined(PROBE_M1)
            if (_r == 0) pg8::gemm_phase<pg8::EpiSwiglu, pg8::MoeOrder<8, true>, GP_ALIGN, GP_SP2, true, PROBE_M1>(X.lds, gm, S, E, X.wave, opaque_i(127 - W8_SHIFT_GU), opaque_i(127)); else
#endif
            pg8::gemm_phase<pg8::EpiSwiglu, pg8::MoeOrder<8, true>, GP_ALIGN, GP_SP2, true>(X.lds, gm, S, E, X.wave, opaque_i(127 - W8_SHIFT_GU), opaque_i(127));  PHASE_END
        PHASE_BEGIN(P_M2)  load_tile_table(X, layer, tb);
            pg8::Gemm gm{ACT, (const bf16_t*)(X.ws + WS_WDN + (size_t)layer * NE * D * D), 0, D, D / 2};
            pg8::MoeOrder<4, false> S; S.init(tb, X.G, X.bid, D, D / 2); S.stok = nullptr; S.cnt = nullptr; S.idl = nullptr;
            stagger(X);
#ifdef PROBE_NOSTORE
            pg8::EpiDown E{opaque_i(((DUP_MASK >> P_M2) & 1) && _r == 0) != 0, Y, INP(25) + (size_t)layer * NE * D, (const float*)(X.ws + WS_GLIST)};
#else
            pg8::EpiDown E{Y, INP(25) + (size_t)layer * NE * D, (const float*)(X.ws + WS_GLIST)};
#endif
#if defined(PROBE_M2)
            if (_r == 0) pg8::gemm_phase<pg8::EpiDown, pg8::MoeOrder<4, false>, GP_ALIGN, GP_SP2, true, PROBE_M2>(X.lds, gm, S, E, X.wave, opaque_i(127 - W8_SHIFT_DN), opaque_i(127)); else
#endif
            pg8::gemm_phase<pg8::EpiDown, pg8::MoeOrder<4, false>, GP_ALIGN, GP_SP2, true>(X.lds, gm, S, E, X.wave, opaque_i(127 - W8_SHIFT_DN), opaque_i(127));  PHASE_END
        PHASE_BEGIN(P_LNB)
            if (layer == DEPTH - 1) phase_combine_ln<true>(X, layer, H1, Y, INP(18) + layer * D, INP(19) + layer * D, (void*)args.out);
            else phase_combine_ln<false>(X, layer, H1, Y, INP(18) + layer * D, INP(19) + layer * D, (void*)H0);
         PHASE_END
    }
#undef IN
#undef SEAM
#undef PHASE_BEGIN
#undef PHASE_END
#undef H0
#undef H1
#undef PROJ
#undef MIX
#undef MIXO
#undef Z
#undef ACT
#undef Y
#undef tb
}

extern "C" void kernel_launch(void* const* d_in, const int* in_sizes, int n_in, void* d_out, int out_size, void* d_ws, size_t ws_size, hipStream_t stream) {
    static int grid = 0;
    if (grid == 0) {
        if (n_in != 26 || out_size != T * D || ws_size < WS_END) { fprintf(stderr, "kernel_launch: unexpected shapes n_in %d out %d ws %zu (need %zu)\n", n_in, out_size, ws_size, (size_t)WS_END); grid = -1; return; }
        int dev = 0, cus = 0, per_cu = 0;
        if (hipGetDevice(&dev) != hipSuccess || hipDeviceGetAttribute(&cus, hipDeviceAttributeMultiprocessorCount, dev) != hipSuccess) { grid = -1; return; }
        if (hipFuncSetAttribute((const void*)mk_fwd, hipFuncAttributeMaxDynamicSharedMemorySize, LDS_BYTES) != hipSuccess) { fprintf(stderr, "kernel_launch: hipFuncSetAttribute failed\n"); grid = -1; return; }
        if (hipOccupancyMaxActiveBlocksPerMultiprocessor(&per_cu, (const void*)mk_fwd, NTHR, LDS_BYTES) != hipSuccess || per_cu < 1) fprintf(stderr, "kernel_launch: occupancy query says %d\n", per_cu);
        (void)hipGetLastError();
        grid = cus;
        if (grid < 256) { fprintf(stderr, "kernel_launch: %d CUs; the LN+router phase deals one 128-token slab per workgroup and needs 256\n", cus); grid = -1; return; }
        if (grid > 256) grid = 256;
    }
    if (grid < 0) return;
    if (hipMemsetAsync((char*)d_ws + WS_CTL, 0, CTL_ZERO_BYTES, stream) != hipSuccess) return;
    Args a{};
    for (int i = 0; i < 26; ++i) a.in[i] = (const float*)d_in[i];
    a.out = (float*)d_out; a.ws = (unsigned char*)d_ws;
#if MK_ONE_LAUNCH
    a.ph_lo = 0; a.ph_hi = DUP_MASK ? 100000 : N_PHASES;
    hipLaunchKernelGGL(mk_fwd, dim3(grid), dim3(NTHR), LDS_BYTES, stream, a);
#else
    for (int p = 0; p < N_PHASES; ++p) { a.ph_lo = p; a.ph_hi = p + 1; hipLaunchKernelGGL(mk_fwd, dim3(grid), dim3(NTHR), LDS_BYTES, stream, a); }
#endif
}
```

```cpp
#include <hip/hip_runtime.h>
#include <cstdio>
#include <cstdint>

#ifndef MK_ONE_LAUNCH
#define MK_ONE_LAUNCH 1
#endif

#define GAS __attribute__((address_space(1)))
#define LAS __attribute__((address_space(3)))
#define RLX_AGENT __ATOMIC_RELAXED, __HIP_MEMORY_SCOPE_AGENT
#define WAVE_SYNC() asm volatile("s_waitcnt lgkmcnt(0)" ::: "memory")
typedef float f32x4 __attribute__((ext_vector_type(4)));
typedef float f32x2 __attribute__((ext_vector_type(2)));
typedef unsigned u32x4 __attribute__((ext_vector_type(4)));
typedef unsigned u32x2 __attribute__((ext_vector_type(2)));
typedef unsigned short bf16_t;

constexpr int BATCH = 4, SEQ = 8192, D = 1024, T = BATCH * SEQ, DEPTH = 4;
constexpr int CONV_CH = 512, SSM_W = 512, SSM_G = 32, SSM_H = 16, SSM_P = 64;
constexpr int NH = 16, HD = 64;
constexpr int NE = 32, TOPK = 4, NA = T * TOPK;
constexpr float SW_LIMIT = 7.0f, SW_ALPHA = 1.702f;
constexpr float LN_EPS = 1e-5f;
constexpr float DN_ALPHA = 1.6817928305074290860622509524664f;
constexpr int NWAVES = 8, NTHR = 512;

constexpr size_t MiB = 1u << 20;
constexpr size_t WS_CTL = 0, CTL_ZERO_BYTES = 1 * MiB;
constexpr size_t WS_S5A = 1 * MiB;
constexpr size_t WS_S5B = 1 * MiB + 65536;
constexpr size_t WS_ROPE = 2 * MiB;
constexpr size_t WS_S5X = 48 * MiB;
constexpr size_t WS_TOKE = 4 * MiB;
constexpr size_t WS_TOKR = 4 * MiB + 524288;
constexpr size_t WS_RWH = 5 * MiB;
constexpr size_t WS_RWL = 5 * MiB + 262144;
constexpr size_t WS_GLIST = 8 * MiB;
constexpr size_t WS_S5S = 12 * MiB;
constexpr size_t WS_WIN = 16 * MiB;
constexpr size_t WS_WGLU = 24 * MiB;
constexpr size_t WS_WOUT = 26 * MiB;
constexpr size_t WS_WQKV = 32 * MiB;
constexpr size_t WS_WO = 44 * MiB;
constexpr size_t WS_WGU = 64 * MiB;
constexpr size_t WS_WDN = 576 * MiB;
constexpr size_t WS_H0 = 832 * MiB;
constexpr size_t WS_H1 = 896 * MiB;
constexpr size_t WS_PROJ = 960 * MiB;
constexpr size_t WS_MIX = 1152 * MiB;
constexpr size_t WS_MIXO = 1216 * MiB;
constexpr size_t WS_Z = 1280 * MiB;
constexpr size_t WS_ACT = 1312 * MiB;
constexpr size_t WS_Y = 1584 * MiB;
constexpr size_t WS_XG = 1856 * MiB;
constexpr size_t WS_STOK = 1920 * MiB;
constexpr size_t WS_END = 3904 * MiB;
constexpr int CW_BAR = 4096;
constexpr int CW_CNT = 16384;

constexpr int LDS_BYTES = 147456;
constexpr int MISC_OFF = 131072 + 320;
constexpr int TAB_OFF = 131072 + 1024;

#define XB_TMO      128
#define XB_XCNT(j)  (256  + 64 * (j))
#define XB_XSUB(j)  (1280 + 64 * (j))
#define XB_XGEN(j)  (2304 + 64 * (j))
#define XB_TOP      3328
#define XB_TOPGEN   3392
#define XCD_BAR_WORDS 3456
#define XB_SPIN_CAP (1u << 22)

__device__ __forceinline__ unsigned xb_ld(unsigned* p)              { return __hip_atomic_load(p, __ATOMIC_RELAXED, __HIP_MEMORY_SCOPE_AGENT); }
__device__ __forceinline__ unsigned xb_add(unsigned* p, unsigned v) { return __hip_atomic_fetch_add(p, v, __ATOMIC_RELAXED, __HIP_MEMORY_SCOPE_AGENT); }
__device__ __forceinline__ unsigned xb_xcc_id() { return (unsigned)__builtin_amdgcn_s_getreg((3 << 11) | 20) & 0xFu; }
#define XB_SPIN(cond, bar) do { unsigned _sp = 0; while (cond) { __builtin_amdgcn_s_sleep(1); \
    if ((++_sp & 255u) == 0u) { if (xb_ld(&(bar)[XB_TMO])) break; if (_sp > XB_SPIN_CAP) { atomicAdd(&(bar)[XB_TMO], 1u); break; } } } } while (0)

struct XcdBarrier { unsigned* bar; unsigned x; volatile LAS unsigned* st; int wave; };
__device__ __forceinline__ int xb_lane() { int l; asm volatile("v_mbcnt_lo_u32_b32 %0, -1, 0\n\tv_mbcnt_hi_u32_b32 %0, -1, %0" : "=v"(l)); return l; }

__device__ __forceinline__ XcdBarrier xcd_barrier_post(unsigned* bar, volatile LAS unsigned* st, int wave) {
    XcdBarrier b; b.bar = bar; b.x = xb_xcc_id(); b.st = st; b.wave = wave;
    if (wave == 0 && xb_lane() == 0) (void)xb_add(&bar[XB_XCNT(b.x)], 1u);
    return b;
}
__device__ __forceinline__ void xcd_barrier_complete(unsigned* bar, unsigned x, unsigned& nloc, unsigned& nx) {
    const unsigned G = gridDim.x * gridDim.y * gridDim.z;
    unsigned sum, cnt, mine, sp = 0u;
    for (;;) {
        sum = 0u; cnt = 0u; mine = 0u;
#pragma unroll
        for (unsigned j = 0; j < 16; ++j) { const unsigned c = xb_ld(&bar[XB_XCNT(j)]); sum += c; cnt += (c > 0u) ? 1u : 0u; mine = (j == x) ? c : mine; }
        if (sum == G) break;
        __builtin_amdgcn_s_sleep(1);
        if ((++sp & 255u) == 0u) { if (xb_ld(&bar[XB_TMO])) break; if (sp > XB_SPIN_CAP) { atomicAdd(&bar[XB_TMO], 1u); break; } }
    }
    nloc = mine > 0u ? mine : 1u; nx = cnt > 0u ? cnt : 1u;
}
__device__ __forceinline__ void xcd_barrier(const XcdBarrier& b) {
    asm volatile("s_waitcnt vmcnt(0)" ::: "memory");
    __syncthreads();
    if (b.wave == 0 && xb_lane() == 0) {
        unsigned* bar = b.bar;
        __builtin_amdgcn_s_waitcnt(0);
        unsigned nloc = b.st[0], nx = b.st[1];
        if (nloc == 0u) { xcd_barrier_complete(bar, b.x, nloc, nx); b.st[0] = nloc; b.st[1] = nx; }
        const unsigned old = xb_add(&bar[XB_XSUB(b.x)], 1u);
        const unsigned gen = old / nloc;
        if (old + 1u == (gen + 1u) * nloc) {
            __builtin_amdgcn_fence(__ATOMIC_RELEASE, "agent");
            asm volatile("s_waitcnt vmcnt(0)" ::: "memory");
            const unsigned og = xb_add(&bar[XB_TOP], 1u);
            const unsigned tg = og / nx;
            if (og + 1u == (tg + 1u) * nx) xb_add(&bar[XB_TOPGEN], 1u);
            else XB_SPIN(xb_ld(&bar[XB_TOPGEN]) == tg, bar);
            __builtin_amdgcn_fence(__ATOMIC_ACQUIRE, "agent");
            xb_add(&bar[XB_XGEN(b.x)], 1u);
            asm volatile("s_waitcnt vmcnt(0)" ::: "memory");
        } else {
            XB_SPIN(xb_ld(&bar[XB_XGEN(b.x)]) == gen, bar);
            __builtin_amdgcn_fence(__ATOMIC_ACQUIRE, "agent");
            asm volatile("s_waitcnt vmcnt(0)" ::: "memory");
        }
    }
    __syncthreads();
}

template <int M> __device__ __forceinline__ int swz_i(int v) { static_assert(M > 0 && M < 32, "ds_swizzle bit mode"); return __builtin_amdgcn_ds_swizzle(v, (M << 10) | 0x1f); }
template <int M> __device__ __forceinline__ float swz_f(float v) { return __builtin_bit_cast(float, swz_i<M>(__builtin_bit_cast(int, v))); }
__device__ __forceinline__ int bperm_i(int srclane, int v) { return __builtin_amdgcn_ds_bpermute(srclane << 2, v); }
__device__ __forceinline__ float bperm_f(int srclane, float v) { return __builtin_bit_cast(float, __builtin_amdgcn_ds_bpermute(srclane << 2, __builtin_bit_cast(int, v))); }
__device__ __forceinline__ float rdlane_f(float v, int l) { return __builtin_bit_cast(float, __builtin_amdgcn_readlane(__builtin_bit_cast(int, v), l)); }
__device__ __forceinline__ float wave_sum(float v) {
    v += swz_f<1>(v); v += swz_f<2>(v); v += swz_f<4>(v); v += swz_f<8>(v); v += swz_f<16>(v);
    return rdlane_f(v, 0) + rdlane_f(v, 32);
}
__device__ __forceinline__ float wave_max(float v) {
    v = fmaxf(v, swz_f<1>(v)); v = fmaxf(v, swz_f<2>(v)); v = fmaxf(v, swz_f<4>(v)); v = fmaxf(v, swz_f<8>(v)); v = fmaxf(v, swz_f<16>(v));
    return fmaxf(rdlane_f(v, 0), rdlane_f(v, 32));
}
__device__ __forceinline__ float sigmoidf_(float x) { return __builtin_amdgcn_rcpf(1.0f + __builtin_amdgcn_exp2f(-1.4426950408889634f * x)); }
__device__ __forceinline__ float gelu_tanh(float y) { return y * sigmoidf_(1.5957691216057308f * (y + 0.044715f * y * y * y)); }
__device__ __forceinline__ float opaque_f(float v) { asm volatile("" : "+s"(v)); return v; }
__device__ __forceinline__ int opaque_i(int v) { asm volatile("" : "+s"(v)); return v; }
__device__ __forceinline__ int seqpos(int bt) { return bt - ((bt >> 13) << 13); }
__device__ __forceinline__ unsigned f2bf(float f) { unsigned u = __builtin_bit_cast(unsigned, f); return (u + 0x7fffu + ((u >> 16) & 1u)) >> 16; }
__device__ __forceinline__ unsigned pk2(float lo, float hi) { return f2bf(lo) | (f2bf(hi) << 16); }
typedef float f32x2_t_ __attribute__((ext_vector_type(2))); typedef __bf16 bf16x2_t_ __attribute__((ext_vector_type(2)));
__device__ __forceinline__ unsigned cvt_pk_bf16(float lo, float hi) { const f32x2_t_ v = {lo, hi}; const bf16x2_t_ b = __builtin_convertvector(v, bf16x2_t_); return __builtin_bit_cast(unsigned, b); }
__device__ __forceinline__ float bf_lo(unsigned w) { return __builtin_bit_cast(float, w << 16); }
__device__ __forceinline__ float bf_hi(unsigned w) { return __builtin_bit_cast(float, w & 0xffff0000u); }
__device__ __forceinline__ float bf2f(bf16_t b) { return __builtin_bit_cast(float, ((unsigned)b) << 16); }
__device__ __forceinline__ void unpack8(const u32x4 w, float (&f)[8]) { f[0] = bf_lo(w.x); f[1] = bf_hi(w.x); f[2] = bf_lo(w.y); f[3] = bf_hi(w.y); f[4] = bf_lo(w.z); f[5] = bf_hi(w.z); f[6] = bf_lo(w.w); f[7] = bf_hi(w.w); }
__device__ __forceinline__ u32x4 pack8(const float (&f)[8]) { u32x4 w; w.x = cvt_pk_bf16(f[0], f[1]); w.y = cvt_pk_bf16(f[2], f[3]); w.z = cvt_pk_bf16(f[4], f[5]); w.w = cvt_pk_bf16(f[6], f[7]); return w; }

__device__ __forceinline__ unsigned pk4_fp8(float a, float b, float c, float d) {
    int w = __builtin_amdgcn_cvt_pk_fp8_f32(a, b, 0, false); w = __builtin_amdgcn_cvt_pk_fp8_f32(c, d, w, true); return (unsigned)w; }
__device__ __forceinline__ u32x2 pack8_fp8(const float (&f)[8]) { u32x2 w; w.x = pk4_fp8(f[0], f[1], f[2], f[3]); w.y = pk4_fp8(f[4], f[5], f[6], f[7]); return w; }
typedef float f32x2v_ __attribute__((ext_vector_type(2)));
__device__ __forceinline__ void unpack8_fp8(const u32x2 w, float (&f)[8]) {
    const f32x2v_ a = __builtin_amdgcn_cvt_pk_f32_fp8((int)w.x, false), b = __builtin_amdgcn_cvt_pk_f32_fp8((int)w.x, true), c = __builtin_amdgcn_cvt_pk_f32_fp8((int)w.y, false), d = __builtin_amdgcn_cvt_pk_f32_fp8((int)w.y, true);
    f[0] = a.x; f[1] = a.y; f[2] = b.x; f[3] = b.y; f[4] = c.x; f[5] = c.y; f[6] = d.x; f[7] = d.y; }
constexpr float Y8_SCALE = 16.0f;
constexpr int W8_SHIFT_GU = 5, W8_SHIFT_DN = 6;

__device__ __forceinline__ int lane_id() { int l; asm volatile("v_mbcnt_lo_u32_b32 %0, -1, 0\n\tv_mbcnt_hi_u32_b32 %0, -1, %0" : "=v"(l)); return l; }

struct Ctx {
    LAS unsigned char* lds;
    int tid, lane, wave, G, bid;
    unsigned* ctl;
    GAS unsigned char* ws;
};

namespace pg8 {
#define PG8_LAS __attribute__((address_space(3)))
typedef short bf16x8 __attribute__((ext_vector_type(8)));
constexpr int BM = 256, BK = 64, HALF = 128, HTB = HALF * BK * 2  , STAGE_BYTES = 8 * HTB, NXCD = 8, WGM = 8;

__host__ __device__ __forceinline__ int lds_byte(int r, int c) { const int st = (r >> 4) * 2 + (c >> 5), rr = r & 15, cc = c & 31, ob = rr * 64 + cc * 2; return st * 1024 + (ob ^ (((ob >> 9) & 1) << 5)); }
__host__ __device__ __forceinline__ void stage_rc(int b, int& R, int& C) { const int st = b / 1024, sb = b % 1024, swz = sb ^ (((sb >> 9) & 1) << 5); R = (st >> 1) * 16 + swz / 64; C = (st & 1) * 32 + (swz % 64) / 2; }
__host__ __device__ __forceinline__ int perm32(int rho) { const int n = rho >> 4, i = rho & 15; return 8 * (i >> 2) + 4 * n + (i & 3); }

struct Unit { int pm, pn, e, mt; };
struct Gemm { const bf16_t* A; const bf16_t* Bt; int M, N, K; };

struct StaticOrder {
    int nM, nN, nwg, G, c; size_t tstep;
    __device__ void init(int M, int N, int K, int G_, int c_) { nM = M / BM; nN = N / BM; nwg = nM * nN; G = G_; c = c_; tstep = (size_t)BM * K * 2; }
    __device__ bool next(int i, Unit& u) const {
        const long L = (long)i * G + c; if (L >= nwg) return false;
        int wgid = (int)L; { const int q = nwg / NXCD, r = nwg % NXCD, xcd = wgid % NXCD, off = wgid / NXCD; wgid = (xcd < r ? xcd * (q + 1) : r * (q + 1) + (xcd - r) * q) + off; }
        const int nig = WGM * nN, gid = wgid / nig, fm = gid * WGM, gsz = (nM - fm) < WGM ? (nM - fm) : WGM;
        u.pm = fm + ((wgid % nig) % gsz); u.pn = (wgid % nig) / gsz; u.e = 0; u.mt = 0; return true;
    }
    __device__ __forceinline__ size_t a_off(const Unit& u) const { return (size_t)u.pm * tstep; }
    __device__ __forceinline__ size_t b_off(const Unit& u) const { return (size_t)u.pn * tstep; }
    __device__ __forceinline__ void a_ready(const Unit&) const {}
    __device__ __forceinline__ void done(const Unit&) const {}
    static constexpr bool GATHER = false;
};
template <int NPN, bool A_IS_XG> struct MoeOrder {
    static constexpr bool GATHER = A_IS_XG;
    const int* stok; const unsigned* cnt;
    const PG8_LAS unsigned short* idl;
    __device__ __forceinline__ unsigned list_id(int ui, int row) const { return (unsigned)idl[ui * BM + row]; }
    __device__ __forceinline__ void preload_ids(PG8_LAS unsigned short* dst, int tid, int wave) {
        idl = dst;
        const auto rs = __builtin_amdgcn_make_buffer_rsrc((void*)stok, 0, -1, 0x00020000);
        int tk[9], cn[9], sl[9];
#pragma unroll
        for (int j = 0; j < 9; ++j) { Unit u; tk[j] = 0; cn[j] = 0; sl[j] = 0;
            if (next(2 * j + (wave >> 2), u)) { sl[j] = u.mt * BM + (tid & 255); cn[j] = (int)__hip_atomic_load(cnt + u.e * 64, __ATOMIC_RELAXED, __HIP_MEMORY_SCOPE_AGENT);
                tk[j] = __builtin_amdgcn_raw_buffer_load_b32(rs, sl[j] * 4, (u.e * T) * 4, 0); } }
#pragma unroll
        for (int j = 0; j < 9; ++j) dst[(2 * j + (wave >> 2)) * BM + (tid & 255)] = (unsigned short)(sl[j] < cn[j] ? tk[j] : 0);
        __syncthreads();
    }
    const PG8_LAS int* tb; int G, c, ntile; size_t bexp, rowb;
    __device__ void init(const PG8_LAS int* tb_, int G_, int c_, int Nexp, int K) { tb = tb_; G = G_; c = c_; ntile = __builtin_amdgcn_readfirstlane(tb_[32]); rowb = (size_t)K * 2; bexp = (size_t)Nexp * rowb; }
    __device__ bool next(int i, Unit& u) const {
        int mtg, pn;
        if (G == 256) { constexpr int MPR = 256 / NPN, MPX = MPR / 8; mtg = MPR * i + MPX * (c & 7) + (c >> 3) / NPN; pn = (c >> 3) % NPN; }
        else { const long L = (long)i * G + c; mtg = (int)(L / NPN); pn = (int)(L % NPN); }
        if (mtg >= ntile) return false;
        int e = 0;
#pragma unroll
        for (int st = 16; st >= 1; st >>= 1) { const int tv = __builtin_amdgcn_readfirstlane(tb[e + st]); if (tv <= mtg) e += st; }
        u.pm = mtg; u.pn = pn; u.e = e; u.mt = mtg - __builtin_amdgcn_readfirstlane(tb[e]); return true;
    }
    __device__ __forceinline__ size_t a_off(const Unit& u) const { return A_IS_XG ? (size_t)0 : (size_t)u.pm * BM * rowb; }
    __device__ __forceinline__ size_t b_off(const Unit& u) const { return (size_t)u.e * bexp + (size_t)u.pn * BM * rowb; }
    __device__ __forceinline__ void a_ready(const Unit&) const {}
    __device__ __forceinline__ void done(const Unit&) const {}
};

__device__ __forceinline__ u32x4 pack_v(const f32x4 v0, const f32x4 v1) { u32x4 w; w.x = cvt_pk_bf16(v0[0], v0[1]); w.y = cvt_pk_bf16(v0[2], v0[3]); w.z = cvt_pk_bf16(v1[0], v1[1]); w.w = cvt_pk_bf16(v1[2], v1[3]); return w; }

struct EpiStore {
    static constexpr bool PERM = true, AFTER_DRAIN = false, BIAS_INIT = false;
    bf16_t* O; int ldc;
    __device__ __forceinline__ void operator()(const f32x4 (&acc)[2][2][4][2], const Unit& u, int wr, int wc, int fr, int fq) const {
        const int row0 = u.pm * BM + wr * 64 + fr, col0 = u.pn * BM + wc * 32 + 8 * fq;
#pragma unroll
        for (int ai = 0; ai < 2; ++ai)
#pragma unroll
            for (int m = 0; m < 4; ++m) { bf16_t* rowp = O + (size_t)(row0 + ai * HALF + m * 16) * ldc + col0;
#pragma unroll
                for (int bj = 0; bj < 2; ++bj) *(u32x4*)(rowp + bj * HALF) = pack_v(acc[ai][bj][m][0], acc[ai][bj][m][1]); }
    }
};
struct EpiGlu {
    static constexpr bool PERM = true, AFTER_DRAIN = false, BIAS_INIT = false;
    const bf16_t* Z; bf16_t* MIX; const float* bias;
    __device__ __forceinline__ void operator()(const f32x4 (&acc)[2][2][4][2], const Unit& u, int wr, int wc, int fr, int fq) const {
        const int row0 = u.pm * BM + wr * 64 + fr, col0 = u.pn * BM + wc * 32 + 8 * fq;
        f32x4 bv[2][2];
#pragma unroll
        for (int bj = 0; bj < 2; ++bj)
#pragma unroll
            for (int n = 0; n < 2; ++n) bv[bj][n] = *(const f32x4*)(bias + col0 + bj * HALF + 4 * n);
#pragma unroll
        for (int ai = 0; ai < 2; ++ai)
#pragma unroll
            for (int m = 0; m < 4; ++m) { const size_t row = (size_t)(row0 + ai * HALF + m * 16);
#pragma unroll
                for (int bj = 0; bj < 2; ++bj) {
                    const u32x4 zw = *(const u32x4*)(Z + row * SSM_W + col0 + bj * HALF); float z[8]; unpack8(zw, z);
                    const f32x4 a0 = acc[ai][bj][m][0] + bv[bj][0], a1 = acc[ai][bj][m][1] + bv[bj][1];
                    float o[8];
#pragma unroll
                    for (int j = 0; j < 4; ++j) { o[j] = z[j] * sigmoidf_(a0[j]); o[4 + j] = z[4 + j] * sigmoidf_(a1[j]); }
                    *(u32x4*)(MIX + row * D + 512 + col0 + bj * HALF) = pack8(o); } }
    }
};
struct EpiRope {
    static constexpr bool PERM = true, AFTER_DRAIN = false, BIAS_INIT = false;
    bf16_t* O; const f32x2* rope;
    __device__ __forceinline__ void operator()(const f32x4 (&acc)[2][2][4][2], const Unit& u, int wr, int wc, int fr, int fq) const {
        const int part = u.pn >> 2, tp = u.pn & 3;
        const int row0 = u.pm * BM + wr * 64 + fr, colb = part * 1024 + (4 * tp + wc) * 64 + 8 * fq;
        const float qs = part == 0 ? 0.125f * 1.4426950408889634f : 1.0f;
#pragma unroll
        for (int ai = 0; ai < 2; ++ai)
#pragma unroll
            for (int m = 0; m < 4; ++m) { const int row = row0 + ai * HALF + m * 16; bf16_t* rowp = O + (size_t)row * 3072 + colb;
                const f32x4 x1a = acc[ai][0][m][0], x1b = acc[ai][0][m][1], x2a = acc[ai][1][m][0], x2b = acc[ai][1][m][1];
                if (part < 2) {
                    const f32x4* rp = (const f32x4*)(rope + (size_t)seqpos(row) * 32 + 8 * fq);
                    const f32x4 c01 = rp[0], c23 = rp[1], c45 = rp[2], c67 = rp[3];
                    float o1[8], o2[8];
                    const float cs[8] = {c01[0], c01[2], c23[0], c23[2], c45[0], c45[2], c67[0], c67[2]}, sn[8] = {c01[1], c01[3], c23[1], c23[3], c45[1], c45[3], c67[1], c67[3]};
                    const float x1[8] = {x1a[0], x1a[1], x1a[2], x1a[3], x1b[0], x1b[1], x1b[2], x1b[3]}, x2[8] = {x2a[0], x2a[1], x2a[2], x2a[3], x2b[0], x2b[1], x2b[2], x2b[3]};
#pragma unroll
                    for (int j = 0; j < 8; ++j) { o1[j] = (x1[j] * cs[j] - x2[j] * sn[j]) * qs; o2[j] = (x2[j] * cs[j] + x1[j] * sn[j]) * qs; }
                    *(u32x4*)(rowp) = pack8(o1); *(u32x4*)(rowp + 32) = pack8(o2);
                } else { *(u32x4*)(rowp) = pack_v(x1a, x1b); *(u32x4*)(rowp + 32) = pack_v(x2a, x2b); } }
    }
};
struct EpiSwiglu {
    static constexpr bool PERM = true, AFTER_DRAIN = false, BIAS_INIT = true;
#ifdef PROBE_NOSTORE
    bool nostore = false;
#endif
    bf16_t* ACT; const float* bgu;
    __device__ __forceinline__ void init_load(const Unit& u, int wc, int fq, f32x4 (&b)[4]) const {
        const auto rsb = __builtin_amdgcn_make_buffer_rsrc((void*)bgu, 0, -1, 0x00020000);
        const int so = (u.e * 2048 + u.pn * 128 + wc * 32) * 4, vo = fq * 32;
        b[0] = __builtin_bit_cast(f32x4, __builtin_amdgcn_raw_buffer_load_b128(rsb, vo, so, 0)); b[1] = __builtin_bit_cast(f32x4, __builtin_amdgcn_raw_buffer_load_b128(rsb, vo + 16, so, 0));
        b[2] = __builtin_bit_cast(f32x4, __builtin_amdgcn_raw_buffer_load_b128(rsb, vo, so + 4096, 0)); b[3] = __builtin_bit_cast(f32x4, __builtin_amdgcn_raw_buffer_load_b128(rsb, vo + 16, so + 4096, 0));
    }
    static __device__ __forceinline__ void init_fill(f32x4 (&acc)[2][2][4][2], const f32x4 (&b)[4]) {
#pragma unroll
        for (int ai = 0; ai < 2; ++ai)
#pragma unroll
            for (int m = 0; m < 4; ++m) { acc[ai][0][m][0] = b[0]; acc[ai][0][m][1] = b[1]; acc[ai][1][m][0] = b[2]; acc[ai][1][m][1] = b[3]; }
    }
    __device__ __forceinline__ void init(f32x4 (&acc)[2][2][4][2], const Unit& u, int wc, int fq) const { f32x4 b[4]; init_load(u, wc, fq, b); init_fill(acc, b); }
    __device__ __forceinline__ void operator()(const f32x4 (&acc)[2][2][4][2], const Unit& u, int wr, int wc, int fr, int fq) const {
        const int row0 = u.pm * BM + wr * 64 + fr, j0 = u.pn * 128 + wc * 32 + 8 * fq;
        unsigned char* ab = (unsigned char*)ACT + (size_t)row0 * D + j0;
#pragma unroll
        for (int ai = 0; ai < 2; ++ai)
#pragma unroll
            for (int m = 0; m < 4; ++m) {
                const f32x4 g0 = acc[ai][0][m][0], g1 = acc[ai][0][m][1], l0 = acc[ai][1][m][0], l1 = acc[ai][1][m][1];
                float o[8];
#pragma unroll
                for (int j = 0; j < 4; ++j) {
                    const float ga = __builtin_amdgcn_fmed3f(g0[j], -3.0e38f, SW_LIMIT), gb = __builtin_amdgcn_fmed3f(g1[j], -3.0e38f, SW_LIMIT);
                    const float la = __builtin_amdgcn_fmed3f(l0[j], -SW_LIMIT, SW_LIMIT), lb = __builtin_amdgcn_fmed3f(l1[j], -SW_LIMIT, SW_LIMIT);
                    const float sa = ga * __builtin_amdgcn_rcpf(1.0f + __builtin_amdgcn_exp2f((-SW_ALPHA * 1.4426950408889634f) * ga)), sb = gb * __builtin_amdgcn_rcpf(1.0f + __builtin_amdgcn_exp2f((-SW_ALPHA * 1.4426950408889634f) * gb));
                    o[j] = fmaf(la, sa, sa); o[4 + j] = fmaf(lb, sb, sb); }
#ifdef PROBE_NOSTORE
                { const u32x2 w_ = pack8_fp8(o); if (!nostore) *(u32x2*)(ab + (size_t)(ai * HALF + m * 16) * D) = w_; else asm volatile("" :: "v"(w_)); } }
#else
                *(u32x2*)(ab + (size_t)(ai * HALF + m * 16) * D) = pack8_fp8(o); }
#endif
    }
};
struct EpiDown {
    static constexpr bool PERM = true, AFTER_DRAIN = false, BIAS_INIT = true;
#ifdef PROBE_NOSTORE
    bool nostore = false;
#endif
    bf16_t* Y; const float* bd; const float* glist;
    __device__ __forceinline__ void init_load(const Unit& u, int wc, int fq, f32x4 (&b)[4]) const {
        const auto rsb = __builtin_amdgcn_make_buffer_rsrc((void*)bd, 0, -1, 0x00020000);
        const int so = (u.e * D + u.pn * BM + wc * 32) * 4, vo = fq * 32;
        b[0] = __builtin_bit_cast(f32x4, __builtin_amdgcn_raw_buffer_load_b128(rsb, vo, so, 0)); b[1] = __builtin_bit_cast(f32x4, __builtin_amdgcn_raw_buffer_load_b128(rsb, vo + 16, so, 0));
        b[2] = __builtin_bit_cast(f32x4, __builtin_amdgcn_raw_buffer_load_b128(rsb, vo, so + HALF * 4, 0)); b[3] = __builtin_bit_cast(f32x4, __builtin_amdgcn_raw_buffer_load_b128(rsb, vo + 16, so + HALF * 4, 0));
    }
    static __device__ __forceinline__ void init_fill(f32x4 (&acc)[2][2][4][2], const f32x4 (&b)[4]) {
#pragma unroll
        for (int ai = 0; ai < 2; ++ai)
#pragma unroll
            for (int m = 0; m < 4; ++m) { acc[ai][0][m][0] = b[0]; acc[ai][0][m][1] = b[1]; acc[ai][1][m][0] = b[2]; acc[ai][1][m][1] = b[3]; }
    }
    __device__ __forceinline__ void init(f32x4 (&acc)[2][2][4][2], const Unit& u, int wc, int fq) const { f32x4 b[4]; init_load(u, wc, fq, b); init_fill(acc, b); }
    __device__ __forceinline__ void operator()(const f32x4 (&acc)[2][2][4][2], const Unit& u, int wr, int wc, int fr, int fq) const {
        const int rl0 = wr * 64 + fr, col0 = u.pn * BM + wc * 32 + 8 * fq;
        const float* gl = glist + (size_t)u.e * T + (size_t)u.mt * BM + rl0;
        unsigned char* yb = (unsigned char*)Y + ((size_t)u.pm * BM + rl0) * D + col0;
#pragma unroll
        for (int ai = 0; ai < 2; ++ai)
#pragma unroll
            for (int m = 0; m < 4; ++m) { const int rl = ai * HALF + m * 16; const float gt = gl[rl] * Y8_SCALE;
#pragma unroll
                for (int bj = 0; bj < 2; ++bj) { const f32x4 v0 = acc[ai][bj][m][0] * gt, v1 = acc[ai][bj][m][1] * gt; u32x2 w; w.x = pk4_fp8(v0[0], v0[1], v0[2], v0[3]); w.y = pk4_fp8(v1[0], v1[1], v1[2], v1[3]);
#ifdef PROBE_NOSTORE
                    if (nostore) { *(u32x2*)((unsigned char*)Y + (size_t)(u.pm * 4 + u.pn) * 65536 + (size_t)(wr * 4 + wc) * 8192 + ((ai * 4 + m) * 2 + bj) * 512 + (fr + 16 * fq) * 8) = w; } else
#endif
                    *(u32x2*)(yb + (size_t)rl * D + bj * HALF) = w; } }
    }
};

template <class Epi, class Sched, bool ALIGN_EPI = false, bool SP2 = false, bool FP8 = false, int PROBE = 0>
__device__ __forceinline__ void gemm_phase(PG8_LAS unsigned char* lds, const Gemm g, const Sched& S, const Epi& E, int wave_, int scale_w = 127, int scale_x = 127) {
    int tid = wave_ * 64 + lane_id(); asm volatile("" : "+v"(tid)); const int wid = wave_, lane = tid & 63, wr = wid >> 2, wc = wid & 3, fr = lane & 15, fq = lane >> 4;
    const int K = g.K, nt = K / BK;
    unsigned voffA[2], voffB[2];
#pragma unroll
    for (int i = 0; i < 2; ++i) { int R, C; stage_rc(tid * 16 + i * 8192, R, C); const int Rb = Epi::PERM ? ((R & ~31) + perm32(R & 31)) : R;
        voffA[i] = (unsigned)(R * K + C) * 2u; voffB[i] = (unsigned)(Rb * K + C) * 2u; }
    unsigned gv[2] = {0u, 0u}, gn[2] = {0u, 0u}, gc2 = 0u;
    auto gather_unit = [&](int ui_, unsigned (&o)[2]) {
        if constexpr (Sched::GATHER) {
            int t_ = lane_id(); asm volatile("" : "+v"(t_)); t_ += wid * 64;
            int R, C; stage_rc(t_ * 16, R, C);
#pragma unroll
            for (int h = 0; h < 2; ++h) o[h] = S.list_id(ui_, h * HALF + R) | (S.list_id(ui_, h * HALF + R + 64) << 16);
        }
    };
    if constexpr (Sched::GATHER) { int R, C; stage_rc(tid * 16, R, C); gc2 = (unsigned)(C * 2); }
    const unsigned kstep = (unsigned)(BK * 2);
    const unsigned hstep = (unsigned)HALF * (unsigned)K * 2u;
    const unsigned ldsw = (unsigned)wid * 1024u;
    const int aoff = lds_byte(wr * 64 + fr, fq * 8), boff = lds_byte(wc * 32 + fr, fq * 8);
#define PG8_SA(b, h) (((b) * 2 + (h)) * HTB)
#define PG8_SB(b, h) ((4 + (b) * 2 + (h)) * HTB)
#define PG8_STAGE(bufoff, gbase, voff) do { if constexpr (!(PROBE & 2)) _Pragma("unroll") for (int _i = 0; _i < 2; ++_i) \
        __builtin_amdgcn_raw_ptr_buffer_load_lds(rsrc_##voff, (PG8_LAS unsigned*)(lds + (bufoff) + ldsw + _i * 8192), 16, (voff)[_i], (gbase), 0, 0); } while (0)
#define PG8_STAGE_A(b, h, soff, NEXT) do { if constexpr (Sched::GATHER) { _Pragma("unroll") for (int _i = 0; _i < 2; ++_i) \
        { unsigned pk_ = (NEXT) ? gn[h] : gv[h]; asm volatile("" : "+v"(pk_)); const unsigned tk_ = _i ? (pk_ >> 16) : (pk_ & 0xffffu);     \
        __builtin_amdgcn_raw_ptr_buffer_load_lds(rsrc_voffA, (PG8_LAS unsigned*)(lds + PG8_SA(b, h) + ldsw + _i * 8192), 16, (tk_ << 10) | gc2, (soff), 0, 0); } } \
        else PG8_STAGE(PG8_SA(b, h), (soff) + (h) * hstep, voffA); } while (0)
#define PG8_LDA(dst, b, h) do { if constexpr ((PROBE & 16) != 0) { if constexpr (FP8) { asm volatile("" : "+v"(dst##8[0]), "+v"(dst##8[1]), "+v"(dst##8[2]), "+v"(dst##8[3])); } } else if constexpr (FP8) { _Pragma("unroll") for (int m = 0; m < 4; ++m) { const v4i_ lo_ = *(const PG8_LAS v4i_*)(lds + PG8_SA(b, h) + aoff + m * 2048), hi_ = *(const PG8_LAS v4i_*)(lds + PG8_SA(b, h) + aoff + m * 2048 + 1024); dst##8[m] = __builtin_shufflevector(lo_, hi_, 0, 1, 2, 3, 4, 5, 6, 7); } } \
        else { _Pragma("unroll") for (int m = 0; m < 4; ++m) _Pragma("unroll") for (int k = 0; k < 2; ++k) dst[m][k] = *(const PG8_LAS bf16x8*)(lds + PG8_SA(b, h) + aoff + m * 2048 + k * 1024); } } while (0)
#define PG8_LDB(dst, b, h) do { if constexpr ((PROBE & 8) != 0) { if constexpr (FP8) { asm volatile("" : "+v"(dst##8[0]), "+v"(dst##8[1])); } } else if constexpr (FP8) { _Pragma("unroll") for (int n = 0; n < 2; ++n) { const v4i_ lo_ = *(const PG8_LAS v4i_*)(lds + PG8_SB(b, h) + boff + n * 2048), hi_ = *(const PG8_LAS v4i_*)(lds + PG8_SB(b, h) + boff + n * 2048 + 1024); dst##8[n] = __builtin_shufflevector(lo_, hi_, 0, 1, 2, 3, 4, 5, 6, 7); } } \
        else { _Pragma("unroll") for (int n = 0; n < 2; ++n) _Pragma("unroll") for (int k = 0; k < 2; ++k) dst[n][k] = *(const PG8_LAS bf16x8*)(lds + PG8_SB(b, h) + boff + n * 2048 + k * 1024); } } while (0)
#define PG8_MMA(ai, bj, At, Bt) do { __builtin_amdgcn_s_setprio(1); _Pragma("unroll") for (int m = 0; m < 4; ++m) _Pragma("unroll") for (int n = 0; n < 2; ++n) { \
        if constexpr ((PROBE & 4) != 0) { if constexpr (FP8) asm volatile("" :: "v"(Bt##8[n]), "v"(At##8[m])); else asm volatile("" :: "v"(Bt[n][0]), "v"(At[m][0]), "v"(Bt[n][1]), "v"(At[m][1])); } else \
        if constexpr (FP8) acc[ai][bj][m][n] = __builtin_amdgcn_mfma_scale_f32_16x16x128_f8f6f4(Bt##8[n], At##8[m], acc[ai][bj][m][n], 0, 0, 0, scale_w, 0, scale_x); \
        else { _Pragma("unroll") for (int k = 0; k < 2; ++k) acc[ai][bj][m][n] = __builtin_amdgcn_mfma_f32_16x16x32_bf16(Bt[n][k], At[m][k], acc[ai][bj][m][n], 0, 0, 0); } } \
        __builtin_amdgcn_s_setprio(0); } while (0)
#define PG8_WAIT_V(n) asm volatile("s_waitcnt vmcnt(" #n ")" ::: "memory")
#define PG8_WAIT_L(n) asm volatile("s_waitcnt lgkmcnt(" #n ")" ::: "memory")
#define PG8_BAR __builtin_amdgcn_s_barrier()
#define PG8_SCHED __builtin_amdgcn_sched_barrier(0)
#define PG8_ACC_INIT(u_) do { if constexpr (Epi::BIAS_INIT && !(PROBE & 64)) { int tz_ = lane_id(); asm volatile("" : "+v"(tz_)); E.init(acc, u_, wc, (tz_ & 63) >> 4); } else { \
        _Pragma("unroll") for (int a = 0; a < 2; ++a) _Pragma("unroll") for (int b = 0; b < 2; ++b) _Pragma("unroll") for (int m = 0; m < 4; ++m) _Pragma("unroll") for (int n = 0; n < 2; ++n) acc[a][b][m][n] = (f32x4){0.f, 0.f, 0.f, 0.f}; } } while (0)
    Unit cur, nxt; int ui = 0;
    if (!S.next(0, cur)) return;
    f32x4 acc[2][2][4][2];
    typedef int v4i_ __attribute__((ext_vector_type(4))); typedef int v8i_ __attribute__((ext_vector_type(8)));
    bf16x8 At[4][2], B0[2][2], B1[2][2]; v8i_ At8[4], B08[2], B18[2];
    const auto rsrc_voffA = __builtin_amdgcn_make_buffer_rsrc((void*)g.A, 0, -1, 0x00020000), rsrc_voffB = __builtin_amdgcn_make_buffer_rsrc((void*)g.Bt, 0, -1, 0x00020000);
    unsigned cA = (unsigned)__builtin_amdgcn_readfirstlane((int)(unsigned)S.a_off(cur)), cB = (unsigned)__builtin_amdgcn_readfirstlane((int)(unsigned)S.b_off(cur));
    S.a_ready(cur);
    if constexpr (Sched::GATHER) { static_assert(BK * 2 == 128, "row offset 1 KiB = K * 2 bytes assumed below");
        gather_unit(0, gv); Unit n1_; if (S.next(1, n1_)) gather_unit(1, gn); else { gn[0] = gv[0]; gn[1] = gv[1]; }
        asm volatile("" : "+v"(gv[0]), "+v"(gv[1]), "+v"(gn[0]), "+v"(gn[1])); }
    PG8_ACC_INIT(cur);
    if constexpr (SP2) {
        PG8_STAGE(PG8_SB(0, 0), cB, voffB); PG8_STAGE(PG8_SB(0, 1), cB + hstep, voffB); PG8_STAGE_A(0, 0, cA, false); PG8_STAGE_A(0, 1, cA, false);
        if (wr == 1) PG8_BAR;
        PG8_WAIT_V(2); PG8_BAR;
        PG8_STAGE(PG8_SB(1, 0), cB + kstep, voffB); PG8_STAGE_A(1, 0, cA + kstep, false); PG8_STAGE(PG8_SB(1, 1), cB + hstep + kstep, voffB);
        PG8_WAIT_V(6); PG8_BAR;
    } else {
        PG8_STAGE(PG8_SB(0, 0), cB, voffB); PG8_STAGE_A(0, 0, cA, false); PG8_STAGE(PG8_SB(0, 1), cB + hstep, voffB); PG8_STAGE_A(0, 1, cA, false);
        if (wr == 1) PG8_BAR;
        PG8_WAIT_V(4); PG8_BAR;
        PG8_STAGE(PG8_SB(1, 0), cB + kstep, voffB); PG8_STAGE_A(1, 0, cA + kstep, false); PG8_STAGE(PG8_SB(1, 1), cB + hstep + kstep, voffB);
        PG8_WAIT_V(6); PG8_BAR;
    }
    for (;;) {
        const bool has_next = S.next(ui + 1, nxt);
        const unsigned nA = has_next ? (unsigned)__builtin_amdgcn_readfirstlane((int)(unsigned)S.a_off(nxt)) : cA, nB = has_next ? (unsigned)__builtin_amdgcn_readfirstlane((int)(unsigned)S.b_off(nxt)) : cB;
#pragma nounroll
        for (int t = 0; t < nt; t += 2) {
            const bool last = (t == nt - 2);
            const unsigned a1 = cA + (unsigned)(t + 1) * kstep;
            const unsigned a2 = last ? nA : cA + (unsigned)(t + 2) * kstep, b2 = last ? nB : cB + (unsigned)(t + 2) * kstep;
            const unsigned a3 = a2 + kstep, b3 = b2 + kstep;
            if (last && has_next) S.a_ready(nxt);
            if constexpr (SP2) {
            PG8_LDB(B0, 0, 0); PG8_LDB(B1, 0, 1); PG8_SCHED; PG8_LDA(At, 0, 0); PG8_STAGE_A(1, 1, a1, false);
            PG8_WAIT_V(8); PG8_WAIT_L(0); PG8_BAR; PG8_MMA(0, 0, At, B0); PG8_MMA(0, 1, At, B1); PG8_BAR; PG8_SCHED;
            PG8_LDA(At, 0, 1); PG8_STAGE(PG8_SB(0, 0), b2, voffB); PG8_STAGE(PG8_SB(0, 1), b2 + hstep, voffB); PG8_STAGE_A(0, 0, a2, last);
            PG8_WAIT_V(8); PG8_WAIT_L(0); PG8_BAR; PG8_MMA(1, 0, At, B0); PG8_MMA(1, 1, At, B1); PG8_BAR; PG8_SCHED;
            PG8_LDB(B0, 1, 0); PG8_LDB(B1, 1, 1); PG8_SCHED; PG8_LDA(At, 1, 0); PG8_STAGE_A(0, 1, a2, last);
            PG8_WAIT_V(8); PG8_WAIT_L(0); PG8_BAR; PG8_MMA(0, 0, At, B0); PG8_MMA(0, 1, At, B1); PG8_BAR; PG8_SCHED;
            PG8_LDA(At, 1, 1); PG8_STAGE(PG8_SB(1, 0), b3, voffB); PG8_STAGE(PG8_SB(1, 1), b3 + hstep, voffB); PG8_STAGE_A(1, 0, a3, last);
            PG8_WAIT_V(8); PG8_WAIT_L(0); PG8_BAR; PG8_MMA(1, 0, At, B0); PG8_MMA(1, 1, At, B1); PG8_BAR; PG8_SCHED;
            } else {
            PG8_LDB(B0, 0, 0); PG8_SCHED; PG8_LDA(At, 0, 0); PG8_STAGE_A(1, 1, a1, false);
            PG8_WAIT_L(8); PG8_BAR; PG8_WAIT_L(0); PG8_MMA(0, 0, At, B0); PG8_BAR; PG8_SCHED;
            PG8_LDB(B1, 0, 1); PG8_STAGE(PG8_SB(0, 0), b2, voffB);
            PG8_BAR; PG8_WAIT_L(0); PG8_MMA(0, 1, At, B1); PG8_BAR;
            PG8_LDA(At, 0, 1); PG8_STAGE_A(0, 0, a2, last);
            PG8_BAR; PG8_WAIT_L(0); PG8_MMA(1, 0, At, B0); PG8_BAR; PG8_SCHED;
            PG8_STAGE(PG8_SB(0, 1), b2 + hstep, voffB);
            PG8_WAIT_V(6); PG8_BAR; PG8_MMA(1, 1, At, B1); PG8_BAR;
            PG8_LDB(B0, 1, 0); PG8_SCHED; PG8_LDA(At, 1, 0); PG8_STAGE_A(0, 1, a2, last);
            PG8_WAIT_L(8); PG8_BAR; PG8_WAIT_L(0); PG8_MMA(0, 0, At, B0); PG8_BAR; PG8_SCHED;
            PG8_LDB(B1, 1, 1); PG8_STAGE(PG8_SB(1, 0), b3, voffB);
            PG8_BAR; PG8_WAIT_L(0); PG8_MMA(0, 1, At, B1); PG8_BAR;
            PG8_LDA(At, 1, 1); PG8_STAGE_A(1, 0, a3, last);
            PG8_BAR; PG8_WAIT_L(0); PG8_MMA(1, 0, At, B0); PG8_BAR; PG8_SCHED;
            PG8_STAGE(PG8_SB(1, 1), b3 + hstep, voffB);
            PG8_WAIT_V(6); PG8_BAR; PG8_MMA(1, 1, At, B1); PG8_BAR;
            }
        }
        if constexpr (ALIGN_EPI) { if (wr == 0) PG8_BAR; }
        if constexpr (!Epi::AFTER_DRAIN) { int tz = lane_id(); asm volatile("" : "+v"(tz));
            if constexpr ((PROBE & 1) != 0) { _Pragma("unroll") for (int a = 0; a < 2; ++a) _Pragma("unroll") for (int b = 0; b < 2; ++b) _Pragma("unroll") for (int m = 0; m < 4; ++m) _Pragma("unroll") for (int n = 0; n < 2; ++n) asm volatile("" :: "v"(acc[a][b][m][n])); }
            else E(acc, cur, wr, wc, tz & 15, (tz & 63) >> 4); S.done(cur); }
        if (!has_next) break;
        if constexpr (Sched::GATHER) {
            gv[0] = gn[0]; gv[1] = gn[1]; }
        if constexpr (Sched::GATHER) { Unit n2_; if (S.next(ui + 2, n2_)) gather_unit(ui + 2, gn); asm volatile("" : "+v"(gn[0]), "+v"(gn[1])); }
        PG8_ACC_INIT(nxt);
        cur = nxt; cA = nA; cB = nB; ++ui;
        if constexpr (ALIGN_EPI) { if (wr == 1) PG8_BAR; }
    }
    PG8_WAIT_V(0);
    if constexpr (!ALIGN_EPI) { if (wr == 0) PG8_BAR; }
    PG8_BAR;
    if constexpr (Epi::AFTER_DRAIN) { E.fused(acc, cur, wr, wc, fr, fq, lds, wid, lane); S.done(cur); }
#undef PG8_SA
#undef PG8_SB
#undef PG8_ACC_INIT
#undef PG8_STAGE
#undef PG8_STAGE_A
#undef PG8_LDA
#undef PG8_LDB
#undef PG8_MMA
#undef PG8_WAIT_V
#undef PG8_WAIT_L
#undef PG8_BAR
#undef PG8_SCHED
}
}

template <int MODE>
__device__ __forceinline__ void transpose_item(const float* W, int K, int N, bf16_t* WT, LAS float* scr, int item, int lane) {
    const int nblk = N / 32, kb = item / nblk, nb = item % nblk, k0 = 64 * kb, n0 = 32 * nb;
    int dr = n0;
    if (MODE == 1) { const int j = n0 & 1023, half = n0 >> 10; dr = 256 * (j >> 7) + 128 * half + (j & 127); }
    if (MODE == 2) { const int part = n0 >> 10, c = n0 & 1023, head = c >> 6, half = (c >> 5) & 1; dr = part * 1024 + (head >> 2) * 256 + half * 128 + (head & 3) * 32; }
    float wv[32];
#pragma unroll
    for (int i = 0; i < 32; ++i) wv[i] = __builtin_nontemporal_load(W + (size_t)(k0 + 2 * i + (lane >> 5)) * N + n0 + (lane & 31));
#pragma unroll
    for (int i = 0; i < 32; ++i) scr[(2 * i + (lane >> 5)) * 33 + (lane & 31)] = wv[i];
    WAVE_SYNC();
    const int c = lane & 7;
#pragma unroll
    for (int j = 0; j < 4; ++j) { const int n = (lane >> 3) + 8 * j; const LAS float* s = scr + (8 * c) * 33 + n;
        u32x4 o; o.x = pk2(s[0 * 33], s[1 * 33]); o.y = pk2(s[2 * 33], s[3 * 33]); o.z = pk2(s[4 * 33], s[5 * 33]); o.w = pk2(s[6 * 33], s[7 * 33]);
        *(u32x4*)(WT + (size_t)(dr + n) * K + k0 + 8 * c) = o; }
    WAVE_SYNC();
}

template <int MODE>
__device__ __forceinline__ void transpose_item_fp8(const float* W, int K, int N, unsigned char* WT, LAS float* scr, int item, int lane, float scale) {
    const int nblk = N / 32, kb = item / nblk, nb = item % nblk, k0 = 64 * kb, n0 = 32 * nb;
    int dr = n0;
    if (MODE == 1) { const int j = n0 & 1023, half = n0 >> 10; dr = 256 * (j >> 7) + 128 * half + (j & 127); }
    float wv[32];
#pragma unroll
    for (int i = 0; i < 32; ++i) wv[i] = __builtin_nontemporal_load(W + (size_t)(k0 + 2 * i + (lane >> 5)) * N + n0 + (lane & 31));
#pragma unroll
    for (int i = 0; i < 32; ++i) scr[(2 * i + (lane >> 5)) * 33 + (lane & 31)] = wv[i] * scale;
    WAVE_SYNC();
#pragma unroll
    for (int j = 0; j < 2; ++j) { const int n = lane & 31, c = (lane >> 5) + 2 * j; const LAS float* s = scr + (16 * c) * 33 + n;
        u32x4 o; o.x = pk4_fp8(s[0 * 33], s[1 * 33], s[2 * 33], s[3 * 33]); o.y = pk4_fp8(s[4 * 33], s[5 * 33], s[6 * 33], s[7 * 33]);
        o.z = pk4_fp8(s[8 * 33], s[9 * 33], s[10 * 33], s[11 * 33]); o.w = pk4_fp8(s[12 * 33], s[13 * 33], s[14 * 33], s[15 * 33]);
        *(u32x4*)(WT + (size_t)(dr + n) * K + k0 + 16 * c) = o; }
    WAVE_SYNC();
}

__device__ __forceinline__ const float* ld_ptr(volatile LAS unsigned long long* t, int k) {
    const unsigned long long v = t[k]; const unsigned lo = __builtin_amdgcn_readfirstlane((unsigned)v), hi = __builtin_amdgcn_readfirstlane((unsigned)(v >> 32));
    return (const float*)(const GAS float*)(((unsigned long long)hi << 32) | lo);
}
__device__ __forceinline__ void phase_prologue(const Ctx& X, volatile LAS unsigned long long* ptab) {
#define in_(k) ld_ptr(ptab, k)
    const float* a_re = in_(3); const float* a_im = in_(4); const float* log_dt = in_(5); const float* b_re = in_(6); const float* b_im = in_(7);
    float2* Abar = (float2*)(X.ws + WS_S5A); float2* Bbar = (float2*)(X.ws + WS_S5B); float2* rope = (float2*)(X.ws + WS_ROPE);
    const int gt = X.bid * NTHR + X.tid, NT = X.G * NTHR;
    for (int it = gt; it < 2 * SSM_G * SSM_P; it += NT) {
        const int ig = it >> 6;
        const double lam_re = fmin((double)a_re[it], -1e-4), lam_im = (double)a_im[it];
        const double dt = exp((double)log_dt[ig]);
        const double mag = exp(lam_re * dt), ang = lam_im * dt;
        const double abr = mag * cos(ang), abi = mag * sin(ang);
        const double nr = abr - 1.0, ni = abi, den = lam_re * lam_re + lam_im * lam_im;
        const double cr = (nr * lam_re + ni * lam_im) / den, ci = (ni * lam_re - nr * lam_im) / den;
        Abar[it] = make_float2((float)abr, (float)abi);
        for (int h = 0; h < SSM_H; ++h) {
            const double br = (double)b_re[it * 16 + h], bi = (double)b_im[it * 16 + h];
            Bbar[it * 16 + h] = make_float2((float)(cr * br - ci * bi), (float)(cr * bi + ci * br));
        }
    }
    for (int it = gt; it < SEQ * 32; it += NT) {
        const int pos = it >> 5, i = it & 31;
        const float inv = powf(10000.0f, -(float)i / 32.0f);
        const float ang = (float)pos * inv;
        rope[it] = make_float2((float)cos((double)ang), (float)sin((double)ang));
    }
    { const float* rw = in_(20); bf16_t* RWh = (bf16_t*)(X.ws + WS_RWH); bf16_t* RWl = (bf16_t*)(X.ws + WS_RWL);
      for (int it = gt; it < DEPTH * NE * D; it += NT) { const int k = it & 1023, e = (it >> 10) & 31, l = it >> 15;
          const float w = rw[((size_t)l * D + k) * NE + e]; const unsigned hb = f2bf(w); RWh[it] = (bf16_t)hb; RWl[it] = (bf16_t)f2bf(w - bf2f((bf16_t)hb)); } }
    { const float* x = in_(0); bf16_t* H0 = (bf16_t*)(X.ws + WS_H0);
      const size_t n8 = (size_t)T * D / 8;
      for (size_t i8 = (size_t)gt; i8 < n8; i8 += (size_t)NT) {
          const f32x4 a = *(const f32x4*)(x + i8 * 8), b = *(const f32x4*)(x + i8 * 8 + 4);
          u32x4 o; o.x = pk2(a[0], a[1]); o.y = pk2(a[2], a[3]); o.z = pk2(b[0], b[1]); o.w = pk2(b[2], b[3]);
          *(u32x4*)(H0 + i8 * 8) = o; } }
    LAS float* scr = (LAS float*)(X.lds + X.wave * 16384);
    const int gw = X.bid * NWAVES + X.wave, NGW = X.G * NWAVES;
    constexpr int I_GU = 16 * 64, I_DN = 16 * 32, I_IN = 16 * 64, I_GLU = 8 * 16, I_OUT = 16 * 32, I_QKV = 16 * 96, I_O = 16 * 32;
    constexpr int N_GU = 128 * I_GU, N_DN = 128 * I_DN, N_IN = 2 * I_IN, N_GLU = 2 * I_GLU, N_OUT = 2 * I_OUT, N_QKV = 2 * I_QKV, N_O = 2 * I_O;
    constexpr int NITEMS = N_GU + N_DN + N_IN + N_GLU + N_OUT + N_QKV + N_O;
    for (int it = gw; it < NITEMS; it += NGW) {
        int r = it;
        if (r < N_GU) { const int m = r / I_GU; transpose_item_fp8<1>(in_(22) + (size_t)m * D * 2048, D, 2048, (unsigned char*)(X.ws + WS_WGU + (size_t)m * 2048 * D), scr, r % I_GU, X.lane, (float)(1 << W8_SHIFT_GU)); continue; } r -= N_GU;
        if (r < N_DN) { const int m = r / I_DN; transpose_item_fp8<0>(in_(24) + (size_t)m * D * D, D, D, (unsigned char*)(X.ws + WS_WDN + (size_t)m * D * D), scr, r % I_DN, X.lane, (float)(1 << W8_SHIFT_DN)); continue; } r -= N_DN;
        if (r < N_IN) { const int m = r / I_IN; transpose_item<0>(in_(1) + (size_t)m * D * 2048, D, 2048, (bf16_t*)(X.ws + WS_WIN) + (size_t)m * 2048 * D, scr, r % I_IN, X.lane); continue; } r -= N_IN;
        if (r < N_GLU) { const int m = r / I_GLU; transpose_item<0>(in_(11) + (size_t)m * 512 * 512, 512, 512, (bf16_t*)(X.ws + WS_WGLU) + (size_t)m * 512 * 512, scr, r % I_GLU, X.lane); continue; } r -= N_GLU;
        if (r < N_OUT) { const int m = r / I_OUT; transpose_item<0>(in_(13) + (size_t)m * D * D, D, D, (bf16_t*)(X.ws + WS_WOUT) + (size_t)m * D * D, scr, r % I_OUT, X.lane); continue; } r -= N_OUT;
        if (r < N_QKV) { const int m = r / I_QKV; transpose_item<2>(in_(14) + (size_t)m * D * 3072, D, 3072, (bf16_t*)(X.ws + WS_WQKV) + (size_t)m * 3072 * D, scr, r % I_QKV, X.lane); continue; } r -= N_QKV;
        { const int m = r / I_O; transpose_item<0>(in_(15) + (size_t)m * D * D, D, D, (bf16_t*)(X.ws + WS_WO) + (size_t)m * D * D, scr, r % I_O, X.lane); }
    }
}

#undef in_
typedef float f32x4v __attribute__((ext_vector_type(4)));
template <int PASS>
__device__ __forceinline__ void phase_s5(const Ctx& X, int i, const bf16_t* proj, const float* conv_w, const float* c_re, const float* c_im, const float* d_skip, bf16_t* mix, bf16_t* Z) {
    using pg8::bf16x8;
    if (PASS == 2) {
        const float* w = conv_w + (size_t)i * 3 * CONV_CH;
        const size_t n = (size_t)T * (CONV_CH / 8);
        for (size_t idx = (size_t)X.bid * NTHR + X.tid; idx < n; idx += (size_t)X.G * NTHR) {
            const int bt = (int)(idx >> 6), c = (int)(idx & 63) * 8, pos = seqpos(bt);
            const bf16_t* pr = proj + (size_t)bt * 2048;
            float gb[8], a2[8], b2[8], a1[8], b1[8], a0[8], b0[8];
            unpack8(*(const u32x4*)(pr + c), gb); unpack8(*(const u32x4*)(pr + 512 + c), a2); unpack8(*(const u32x4*)(pr + 1024 + c), b2);
            if (pos >= 1) { unpack8(*(const u32x4*)(pr + 512 + c - 2048), a1); unpack8(*(const u32x4*)(pr + 1024 + c - 2048), b1); }
            if (pos >= 2) { unpack8(*(const u32x4*)(pr + 512 + c - 4096), a0); unpack8(*(const u32x4*)(pr + 1024 + c - 4096), b0); }
            float o[8];
#pragma unroll
            for (int j = 0; j < 8; ++j) {
                float s = w[2 * CONV_CH + c + j] * (a2[j] * b2[j]);
                if (pos >= 1) s += w[1 * CONV_CH + c + j] * (a1[j] * b1[j]);
                if (pos >= 2) s += w[0 * CONV_CH + c + j] * (a0[j] * b0[j]);
                o[j] = gb[j] * s; }
            *(u32x4*)(mix + (size_t)bt * D + c) = pack8(o);
        }
    }
    const int lane = X.lane, n16 = lane & 15, kq = lane >> 4;
    LAS float* BuT = (LAS float*)(X.lds + X.wave * 15360);
    LAS unsigned char* xsb = X.lds + X.wave * 15360 + 10240;
    const float2* Abar = (const float2*)(X.ws + WS_S5A); const float2* Bbar = (const float2*)(X.ws + WS_S5B);
    float2* Sst = (float2*)(X.ws + WS_S5S);
    const int gw = X.bid * NWAVES + X.wave, NGW = X.G * NWAVES;
    const int g = gw & 31, ig = i * 32 + g;
        const float2 A = Abar[ig * 64 + lane];
    bf16x8 bfr[8];
#pragma unroll
    for (int cb = 0; cb < 8; ++cb) {
        u32x4 w = (u32x4){0u, 0u, 0u, 0u};
        if (kq < 2) { const float2* bp = Bbar + ((size_t)(ig * 64 + 16 * (cb & 3) + n16)) * 16 + 8 * kq; float v[8];
#pragma unroll
            for (int j = 0; j < 8; ++j) { const float2 t2 = bp[j]; v[j] = cb < 4 ? t2.x : t2.y; }
            w = pack8(v); }
        bfr[cb] = __builtin_bit_cast(bf16x8, w);
    }
    bf16x8 cfr[4]; bf16x8 dfr;
    if (PASS == 2) {
#pragma unroll
        for (int ks = 0; ks < 4; ++ks) { const int p0 = 16 * ks + 4 * kq; const f32x4 cr = *(const f32x4*)(c_re + (size_t)(ig * 16 + n16) * 64 + p0), ci = *(const f32x4*)(c_im + (size_t)(ig * 16 + n16) * 64 + p0);
            u32x4 w; w.x = cvt_pk_bf16(cr[0], -ci[0]); w.y = cvt_pk_bf16(cr[1], -ci[1]); w.z = cvt_pk_bf16(cr[2], -ci[2]); w.w = cvt_pk_bf16(cr[3], -ci[3]); cfr[ks] = __builtin_bit_cast(bf16x8, w); }
        { const float dv = d_skip[ig * 16 + n16]; float v[8];
#pragma unroll
          for (int j = 0; j < 8; ++j) v[j] = (kq < 2 && 8 * kq + j == n16) ? dv : 0.f;
          dfr = __builtin_bit_cast(bf16x8, pack8(v)); }
    }
    for (int task = gw; task < BATCH * 64 * SSM_G; task += NGW) {
        const int c = (task >> 5) & 63, b = task >> 11;
        float xr = 0.f, xi = 0.f;
        if (PASS == 2) { const float2 xin = ((const float2*)(X.ws + WS_S5X))[((size_t)(b * 32 + g) * 64 + c) * 64 + lane]; xr = xin.x; xi = xin.y; }
        const bf16_t* ub = proj + ((size_t)b * SEQ + (size_t)c * 128) * 2048 + 1536 + g * 16;
        bf16_t* zb = Z + ((size_t)b * SEQ + (size_t)c * 128) * SSM_W + g * 16;
        u32x4 uw = (u32x4){0u, 0u, 0u, 0u};
        if (kq < 2) uw = *(const u32x4*)(ub + (size_t)n16 * 2048 + 8 * kq);
#pragma nounroll
        for (int blk = 0; blk < 8; ++blk) {
            const bf16x8 ufr = __builtin_bit_cast(bf16x8, uw);
            u32x4 un = (u32x4){0u, 0u, 0u, 0u};
            if (kq < 2 && blk < 7) un = *(const u32x4*)(ub + (size_t)((blk + 1) * 16 + n16) * 2048 + 8 * kq);
#pragma unroll
            for (int cb = 0; cb < 8; ++cb) {
                f32x4v acc = (f32x4v){0.f, 0.f, 0.f, 0.f};
                acc = __builtin_amdgcn_mfma_f32_16x16x32_bf16(ufr, bfr[cb], acc, 0, 0, 0);
                *(LAS f32x4v*)(BuT + (16 * cb + n16) * 20 + 4 * kq) = acc;
            }
            WAVE_SYNC();
#pragma unroll
            for (int k4 = 0; k4 < 4; ++k4) {
                const f32x4v br = *(const LAS f32x4v*)(BuT + lane * 20 + 4 * k4), bi = *(const LAS f32x4v*)(BuT + (64 + lane) * 20 + 4 * k4);
#pragma unroll
                for (int s = 0; s < 4; ++s) {
                    float nr = fmaf(-A.y, xi, fmaf(A.x, xr, br[s])); asm volatile("" : "+v"(nr));
                    float ni = fmaf(A.y, xr, fmaf(A.x, xi, bi[s])); asm volatile("" : "+v"(ni));
                    xr = nr; xi = ni;
                    if (PASS == 2) *(LAS unsigned*)(xsb + (4 * k4 + s) * 272 + lane * 4) = cvt_pk_bf16(xr, xi);
                }
            }
            if (PASS == 2) {
                WAVE_SYNC();
                f32x4v y = (f32x4v){0.f, 0.f, 0.f, 0.f};
                bf16x8 xa[4];
#pragma unroll
                for (int ks = 0; ks < 4; ++ks) xa[ks] = *(const LAS bf16x8*)(xsb + n16 * 272 + ks * 64 + kq * 16);
                WAVE_SYNC(); __builtin_amdgcn_sched_barrier(0);
#pragma unroll
                for (int ks = 0; ks < 4; ++ks) y = __builtin_amdgcn_mfma_f32_16x16x32_bf16(xa[ks], cfr[ks], y, 0, 0, 0);
                y = __builtin_amdgcn_mfma_f32_16x16x32_bf16(ufr, dfr, y, 0, 0, 0);
                asm volatile("" :: "v"(xa[0]), "v"(xa[1]), "v"(xa[2]), "v"(xa[3]), "v"(ufr));
#pragma unroll
                for (int q = 0; q < 4; ++q) zb[(size_t)(blk * 16 + 4 * kq + q) * SSM_W + n16] = (bf16_t)f2bf(gelu_tanh(y[q]));
            }
            WAVE_SYNC();
            uw = un;
        }
        if (PASS == 1) Sst[((size_t)(b * 32 + g) * 64 + c) * 64 + lane] = make_float2(xr, xi);
    }
}

__device__ __forceinline__ void phase_s5_carry(const Ctx& X, int i) {
    const float2* Abar = (const float2*)(X.ws + WS_S5A); const float2* Sst = (const float2*)(X.ws + WS_S5S); float2* Xin = (float2*)(X.ws + WS_S5X);
    const int gw = X.bid * NWAVES + X.wave, NGW = X.G * NWAVES, lane = X.lane;
    for (int bg = gw; bg < BATCH * SSM_G; bg += NGW) {
        const float2 A = Abar[(i * 32 + (bg & 31)) * 64 + lane];
        float pr_ = A.x, pi_ = A.y;
#pragma unroll
        for (int q = 0; q < 7; ++q) { const float nr = pr_ * pr_ - pi_ * pi_, ni = 2.f * pr_ * pi_; pr_ = nr; pi_ = ni; }
        float xr = 0.f, xi = 0.f;
        const size_t base = (size_t)bg * 64 * 64 + lane;
#pragma unroll 8
        for (int c = 0; c < 64; ++c) {
            Xin[base + (size_t)c * 64] = make_float2(xr, xi);
            const float2 s = Sst[base + (size_t)c * 64];
            const float nr = pr_ * xr - pi_ * xi + s.x, ni = pr_ * xi + pi_ * xr + s.y; xr = nr; xi = ni;
        }
    }
}

typedef short v4i16_t __attribute__((ext_vector_type(4)));
typedef float f32x16 __attribute__((ext_vector_type(16)));
__device__ __forceinline__ v4i16_t vtr16(const LAS unsigned char* p) { return __builtin_amdgcn_ds_read_tr16_b64_v4i16((LAS v4i16_t*)p); }
template <int PASS>
__device__ __forceinline__ void phase_attn(const Ctx& X, const bf16_t* proj, bf16_t* att, bf16_t* ost, float2* ml) {
    using pg8::bf16x8;
    const int lane = X.lane, i32 = lane & 31, hi = lane >> 5;
    LAS unsigned char* vbuf = X.lds + X.wave * 16384;
    LAS unsigned char* kbuf = vbuf + 8192;
    const int gw = X.bid * NWAVES + X.wave, NGW = X.G * NWAVES;
    const float NEG = opaque_f(-3.0e38f); const int seqmax = opaque_i(SEQ - 1);
    const int vrd = ((lane >> 4) & 1) * 32 + (lane & 3) * 8 + (4 * hi + ((lane & 15) >> 2)) * 64;
    const bool xdeal = (X.G == 256);
    constexpr int NT = PASS == 0 ? 13 : 5, PD = 2, NR = 3;
    const int lrow = lane >> 3, lpc = lane & 7;
#pragma nounroll
    for (int it = 0; it < (xdeal ? 8 : (BATCH * NH * 256 + NGW - 1) / NGW); ++it) {
        const int task = xdeal ? (((it * 8 + (X.bid & 7)) << 8) | ((X.bid >> 3) * 8 + X.wave)) : (gw + it * NGW);
        if (task >= BATCH * NH * 256) break;
        const int QST = PASS == 0 ? 4 : 16;
        const int r = PASS == 0 ? (task & 3) : (task & 15), blk = PASS == 0 ? ((task >> 2) & 63) : ((task >> 4) & 15), hh = (task >> 8) & 15, b = task >> 12;
        const bf16_t* base = proj + (size_t)b * SEQ * 3072 + hh * 64;
        const int t0 = (PASS == 0 ? 128 : 512) * blk + r;
        bf16x8 qf[4];
        { const bf16_t* qp = base + (size_t)(t0 + QST * i32) * 3072 + 8 * hi;
#pragma unroll
          for (int d0 = 0; d0 < 4; ++d0) qf[d0] = *(const bf16x8*)(qp + 16 * d0); }
        float m_run = NEG, l_run = 0.f;
        f32x16 o0, o1;
#pragma unroll
        for (int q = 0; q < 16; ++q) { o0[q] = 0.f; o1[q] = 0.f; }
        const size_t srow = (size_t)(b * SEQ + t0 + QST * i32);
        if (PASS == 1) {
            const float2 mlv = ml[srow * NH + hh]; m_run = mlv.x; l_run = hi == 0 ? mlv.y : 0.f;
            const bf16_t* sp = ost + srow * D + hh * 64 + 4 * hi;
#pragma unroll
            for (int gq = 0; gq < 4; ++gq) { const u32x2 w0 = *(const u32x2*)(sp + 8 * gq), w1 = *(const u32x2*)(sp + 32 + 8 * gq);
                o0[4 * gq] = bf_lo(w0.x); o0[4 * gq + 1] = bf_hi(w0.x); o0[4 * gq + 2] = bf_lo(w0.y); o0[4 * gq + 3] = bf_hi(w0.y);
                o1[4 * gq] = bf_lo(w1.x); o1[4 * gq + 1] = bf_hi(w1.x); o1[4 * gq + 2] = bf_lo(w1.y); o1[4 * gq + 3] = bf_hi(w1.y); }
        }
#define AT_PAT(j) (PASS == 1 ? 0 : ((j) < 5 ? 0 : 1))
#define AT_KT(j) (PASS == 1 ? (j) : ((j) < 5 ? (j) : (j) - 5))
#define AT_DIL(j) (PASS == 1 ? 16 : (AT_PAT(j) == 0 ? 4 : 1))
#define AT_QS(j) (PASS == 1 ? 1 : (AT_PAT(j) == 0 ? 1 : 4))
#define AT_RR(j) (PASS == 1 ? r : (AT_PAT(j) == 0 ? r : 0))
        u32x4 kr[NR][4], vr[NR][4];
        auto issue = [&](int j, u32x4 (&kk)[4], u32x4 (&vv)[4]) {
            const int dil = AT_DIL(j), rr = AT_RR(j), Mt = (t0 - rr) / dil - 128 + 32 * AT_KT(j);
            auto keypos = [&](int M) { int p = dil * M + rr; p = p < 0 ? 0 : p; p = p > seqmax ? seqmax : p; return p; };
#pragma unroll
            for (int q = 0; q < 4; ++q) {
                const bf16_t* rp = base + (size_t)keypos(Mt + 8 * q + lrow) * 3072;
                kk[q] = *(const u32x4*)(rp + 1024 + 8 * (lpc ^ lrow));
                vv[q] = *(const u32x4*)(rp + 2048 + 8 * lpc);
            }
        };
#pragma unroll
        for (int j = 0; j < PD; ++j) issue(j, kr[j], vr[j]);
#pragma unroll
        for (int j = 0; j < NT; ++j) {
            if (j + PD < NT) issue(j + PD, kr[(j + PD) % NR], vr[(j + PD) % NR]);
            const int kt = AT_KT(j), dil = AT_DIL(j), rr = AT_RR(j), Mstart = (t0 - rr) / dil - 128, qi = AT_QS(j) * i32;
            f32x16 s;
#pragma unroll
            for (int q = 0; q < 16; ++q) s[q] = 0.f;
#pragma unroll
            for (int q = 0; q < 4; ++q) *(LAS u32x4*)(kbuf + (j & 1) * 4096 + q * 1024 + lane * 16) = kr[j % NR][q];
            bf16x8 kf[4];
#pragma unroll
            for (int d0 = 0; d0 < 4; ++d0) kf[d0] = *(const LAS bf16x8*)(kbuf + (j & 1) * 4096 + (i32 >> 3) * 1024 + (i32 & 7) * 128 + (((2 * d0 + hi) ^ (i32 & 7)) << 4));
#pragma unroll
            for (int d0 = 0; d0 < 4; ++d0) s = __builtin_amdgcn_mfma_f32_32x32x16_bf16(kf[d0], qf[d0], s, 0, 0, 0);
            const int hi_ = qi + 128 - 32 * kt; int lo = hi_ - 128; { const int nk = -(Mstart + 32 * kt); lo = lo > nk ? lo : nk; }
            const int rb = 4 * hi - lo; const unsigned span = (unsigned)(hi_ - lo);
            const bool any = hi_ >= lo;
            float tmax = NEG;
#pragma unroll
            for (int q = 0; q < 16; ++q) { const int rowc = (q & 3) + 8 * (q >> 2); const bool ok = any && ((unsigned)(rowc + rb) <= span) && (rowc + rb >= 0); s[q] = ok ? s[q] : NEG; tmax = fmaxf(tmax, s[q]); }
            tmax = fmaxf(tmax, bperm_f(lane ^ 32, tmax));
            const float m_new = fmaxf(m_run, tmax), sc = __builtin_amdgcn_exp2f(m_run - m_new);
            m_run = m_new;
            float ps = 0.f;
#pragma unroll
            for (int q = 0; q < 16; ++q) { s[q] = __builtin_amdgcn_exp2f(s[q] - m_new); ps += s[q]; }
            l_run = l_run * sc + ps;
#pragma unroll
            for (int q = 0; q < 16; ++q) { o0[q] *= sc; o1[q] *= sc; }
            u32x4 pw0, pw1;
            pw0.x = cvt_pk_bf16(s[0], s[1]); pw0.y = cvt_pk_bf16(s[2], s[3]); pw0.z = cvt_pk_bf16(s[4], s[5]); pw0.w = cvt_pk_bf16(s[6], s[7]);
            pw1.x = cvt_pk_bf16(s[8], s[9]); pw1.y = cvt_pk_bf16(s[10], s[11]); pw1.z = cvt_pk_bf16(s[12], s[13]); pw1.w = cvt_pk_bf16(s[14], s[15]);
            const bf16x8 pf0 = __builtin_bit_cast(bf16x8, pw0), pf1 = __builtin_bit_cast(bf16x8, pw1);
#pragma unroll
            for (int q = 0; q < 4; ++q) *(LAS u32x4*)(vbuf + (j & 1) * 4096 + ((lpc >> 2) * 2 + (q >> 1)) * 1024 + ((q & 1) * 8 + lrow) * 64 + (lpc & 3) * 16) = vr[j % NR][q];
            const LAS unsigned char* vb = vbuf + (j & 1) * 4096 + vrd;
#pragma unroll
            for (int dh = 0; dh < 2; ++dh) {
#pragma unroll
                for (int kg = 0; kg < 2; ++kg) {
                    const v4i16_t vlo = vtr16(vb + (dh * 2 + kg) * 1024), vhi = vtr16(vb + (dh * 2 + kg) * 1024 + 512);
                    const bf16x8 vf = (bf16x8){vlo[0], vlo[1], vlo[2], vlo[3], vhi[0], vhi[1], vhi[2], vhi[3]};
                    if (dh == 0) o0 = __builtin_amdgcn_mfma_f32_32x32x16_bf16(vf, kg == 0 ? pf0 : pf1, o0, 0, 0, 0);
                    else o1 = __builtin_amdgcn_mfma_f32_32x32x16_bf16(vf, kg == 0 ? pf0 : pf1, o1, 0, 0, 0);
                }
            }
        }
#undef AT_PAT
#undef AT_KT
#undef AT_DIL
#undef AT_QS
#undef AT_RR
        const float lt = l_run + bperm_f(lane ^ 32, l_run), rl = PASS == 1 ? 1.0f / lt : 1.0f;
        if (PASS == 0 && hi == 0) ml[srow * NH + hh] = make_float2(m_run, lt);
        bf16_t* op = (PASS == 1 ? att : ost) + srow * D + hh * 64 + 4 * hi;
#pragma unroll
        for (int gq = 0; gq < 4; ++gq) {
            u32x2 w0, w1;
            w0.x = cvt_pk_bf16(o0[4 * gq] * rl, o0[4 * gq + 1] * rl); w0.y = cvt_pk_bf16(o0[4 * gq + 2] * rl, o0[4 * gq + 3] * rl);
            w1.x = cvt_pk_bf16(o1[4 * gq] * rl, o1[4 * gq + 1] * rl); w1.y = cvt_pk_bf16(o1[4 * gq + 2] * rl, o1[4 * gq + 3] * rl);
            *(u32x2*)(op + 8 * gq) = w0; *(u32x2*)(op + 32 + 8 * gq) = w1;
        }
    }
}

__device__ __forceinline__ void phase_attn_coop1(const Ctx& X, const bf16_t* proj, bf16_t* att, const bf16_t* ost, const float2* ml) {
    using pg8::bf16x8;
    const int lane = X.lane, i32 = lane & 31, hi = lane >> 5, w = X.wave;
    LAS unsigned char* kimg = X.lds;
    LAS unsigned char* vimg = X.lds + 49152;
    const float NEG = opaque_f(-3.0e38f); const int seqmax = opaque_i(SEQ - 1);
    const int vrd = ((lane >> 4) & 1) * 32 + (lane & 3) * 8 + (4 * hi + ((lane & 15) >> 2)) * 64;
    const int lrow = X.tid >> 3, lpc = X.tid & 7;
    constexpr int NGRP = BATCH * NH * 32;
    const bool xdeal = (X.G == 256);
    const int ngi = xdeal ? 8 : (NGRP + X.G - 1) / X.G;
    auto group_of = [&](int it) { return xdeal ? (((it * 8 + (X.bid & 7)) << 5) | (X.bid >> 3)) : (X.bid + it * X.G); };
    u32x4 pk[6], pv[6];
    auto prefetch = [&](int grp) {
        const int half = grp & 1, r = (grp >> 1) & 15, hh = (grp >> 5) & 15, b = grp >> 9;
        const bf16_t* base = proj + (size_t)b * SEQ * 3072 + hh * 64;
#pragma unroll
        for (int i = 0; i < 6; ++i) {
            const int ridx = lrow + 64 * i, M = 32 * (8 * half - 4) + ridx;
            int p = 16 * M + r; p = p < 0 ? 0 : p; p = p > seqmax ? seqmax : p;
            const bf16_t* rp = base + (size_t)p * 3072;
            pk[i] = *(const u32x4*)(rp + 1024 + 8 * lpc); pv[i] = *(const u32x4*)(rp + 2048 + 8 * lpc);
        }
    };
    if (group_of(0) < NGRP) prefetch(group_of(0));
#pragma nounroll
    for (int it = 0; it < ngi; ++it) {
        const int grp = group_of(it);
        if (grp >= NGRP) break;
        const int half = grp & 1, r = (grp >> 1) & 15, hh = (grp >> 5) & 15, b = grp >> 9;
        __syncthreads();
#pragma unroll
        for (int i = 0; i < 6; ++i) {
            const int ridx = lrow + 64 * i, tl = ridx >> 5, row = ridx & 31;
            *(LAS u32x4*)(kimg + tl * 4096 + row * 128 + ((lpc ^ (row & 7)) << 4)) = pk[i];
            *(LAS u32x4*)(vimg + tl * 4096 + ((lpc >> 2) * 2 + (row >> 4)) * 1024 + (row & 15) * 64 + (lpc & 3) * 16) = pv[i];
        }
        __syncthreads();
        const int blk = 8 * half + w, t0 = 512 * blk + r;
        const bf16_t* base = proj + (size_t)b * SEQ * 3072 + hh * 64;
        bf16x8 qf[4];
        { const bf16_t* qp = base + (size_t)(t0 + 16 * i32) * 3072 + 8 * hi;
#pragma unroll
          for (int d0 = 0; d0 < 4; ++d0) qf[d0] = *(const bf16x8*)(qp + 16 * d0); }
        const size_t srow = (size_t)(b * SEQ + t0 + 16 * i32);
        float m_run, l_run; f32x16 o0, o1;
        { const float2 mlv = ml[srow * NH + hh]; m_run = mlv.x; l_run = hi == 0 ? mlv.y : 0.f;
          const bf16_t* sp = ost + srow * D + hh * 64 + 4 * hi;
#pragma unroll
          for (int gq = 0; gq < 4; ++gq) { const u32x2 w0 = *(const u32x2*)(sp + 8 * gq), w1 = *(const u32x2*)(sp + 32 + 8 * gq);
              o0[4 * gq] = bf_lo(w0.x); o0[4 * gq + 1] = bf_hi(w0.x); o0[4 * gq + 2] = bf_lo(w0.y); o0[4 * gq + 3] = bf_hi(w0.y);
              o1[4 * gq] = bf_lo(w1.x); o1[4 * gq + 1] = bf_hi(w1.x); o1[4 * gq + 2] = bf_lo(w1.y); o1[4 * gq + 3] = bf_hi(w1.y); } }
        { const int gn = it + 1 < ngi ? group_of(it + 1) : NGRP; if (gn < NGRP) prefetch(gn); }
        const int Mstart = 32 * blk - 128;
#pragma unroll
        for (int kt = 0; kt < 5; ++kt) {
            const LAS unsigned char* kt_ = kimg + (w + kt) * 4096; const LAS unsigned char* vt_ = vimg + (w + kt) * 4096 + vrd;
            bf16x8 kf[4];
#pragma unroll
            for (int d0 = 0; d0 < 4; ++d0) kf[d0] = *(const LAS bf16x8*)(kt_ + i32 * 128 + (((2 * d0 + hi) ^ (i32 & 7)) << 4));
            f32x16 s;
#pragma unroll
            for (int q = 0; q < 16; ++q) s[q] = 0.f;
#pragma unroll
            for (int d0 = 0; d0 < 4; ++d0) s = __builtin_amdgcn_mfma_f32_32x32x16_bf16(kf[d0], qf[d0], s, 0, 0, 0);
            const int hi_ = i32 + 128 - 32 * kt; int lo = hi_ - 128; { const int nk = -(Mstart + 32 * kt); lo = lo > nk ? lo : nk; }
            const int rb = 4 * hi - lo; const unsigned span = (unsigned)(hi_ - lo);
            const bool any = hi_ >= lo;
            float tmax = NEG;
#pragma unroll
            for (int q = 0; q < 16; ++q) { const int rowc = (q & 3) + 8 * (q >> 2); const bool ok = any && ((unsigned)(rowc + rb) <= span) && (rowc + rb >= 0); s[q] = ok ? s[q] : NEG; tmax = fmaxf(tmax, s[q]); }
            tmax = fmaxf(tmax, bperm_f(lane ^ 32, tmax));
            const float m_new = fmaxf(m_run, tmax), sc = __builtin_amdgcn_exp2f(m_run - m_new);
            m_run = m_new;
            float ps = 0.f;
#pragma unroll
            for (int q = 0; q < 16; ++q) { s[q] = __builtin_amdgcn_exp2f(s[q] - m_new); ps += s[q]; }
            l_run = l_run * sc + ps;
#pragma unroll
            for (int q = 0; q < 16; ++q) { o0[q] *= sc; o1[q] *= sc; }
            u32x4 pw0, pw1;
            pw0.x = cvt_pk_bf16(s[0], s[1]); pw0.y = cvt_pk_bf16(s[2], s[3]); pw0.z = cvt_pk_bf16(s[4], s[5]); pw0.w = cvt_pk_bf16(s[6], s[7]);
            pw1.x = cvt_pk_bf16(s[8], s[9]); pw1.y = cvt_pk_bf16(s[10], s[11]); pw1.z = cvt_pk_bf16(s[12], s[13]); pw1.w = cvt_pk_bf16(s[14], s[15]);
            const bf16x8 pf0 = __builtin_bit_cast(bf16x8, pw0), pf1 = __builtin_bit_cast(bf16x8, pw1);
#pragma unroll
            for (int dh = 0; dh < 2; ++dh) {
#pragma unroll
                for (int kg = 0; kg < 2; ++kg) {
                    const v4i16_t vlo = vtr16(vt_ + (dh * 2 + kg) * 1024), vhi = vtr16(vt_ + (dh * 2 + kg) * 1024 + 512);
                    const bf16x8 vf = (bf16x8){vlo[0], vlo[1], vlo[2], vlo[3], vhi[0], vhi[1], vhi[2], vhi[3]};
                    if (dh == 0) o0 = __builtin_amdgcn_mfma_f32_32x32x16_bf16(vf, kg == 0 ? pf0 : pf1, o0, 0, 0, 0);
                    else o1 = __builtin_amdgcn_mfma_f32_32x32x16_bf16(vf, kg == 0 ? pf0 : pf1, o1, 0, 0, 0);
                }
            }
        }
        const float lt = l_run + bperm_f(lane ^ 32, l_run), rl = 1.0f / lt;
        bf16_t* op = att + srow * D + hh * 64 + 4 * hi;
#pragma unroll
        for (int gq = 0; gq < 4; ++gq) {
            u32x2 w0, w1;
            w0.x = cvt_pk_bf16(o0[4 * gq] * rl, o0[4 * gq + 1] * rl); w0.y = cvt_pk_bf16(o0[4 * gq + 2] * rl, o0[4 * gq + 3] * rl);
            w1.x = cvt_pk_bf16(o1[4 * gq] * rl, o1[4 * gq + 1] * rl); w1.y = cvt_pk_bf16(o1[4 * gq + 2] * rl, o1[4 * gq + 3] * rl);
            *(u32x2*)(op + 8 * gq) = w0; *(u32x2*)(op + 32 + 8 * gq) = w1;
        }
    }
    __syncthreads();
}

__device__ __forceinline__ void phase_attn_coop0(const Ctx& X, const bf16_t* proj, bf16_t* ost, float2* ml) {
    using pg8::bf16x8;
    const int lane = X.lane, i32 = lane & 31, hi = lane >> 5, w = X.wave;
    LAS unsigned char* vbuf = X.lds + w * 16384;
    LAS unsigned char* kbuf = vbuf + 8192;
    LAS unsigned char* kimg = X.lds;
    LAS unsigned char* vimg = X.lds + 53248;
    const float NEG = opaque_f(-3.0e38f); const int seqmax = opaque_i(SEQ - 1);
    const int vrd = ((lane >> 4) & 1) * 32 + (lane & 3) * 8 + (4 * hi + ((lane & 15) >> 2)) * 64;
    const int lrow = lane >> 3, lpc = lane & 7;
    constexpr int NGRP = BATCH * NH * 32;
    const bool xdeal = (X.G == 256);
    const int ngi = xdeal ? 8 : (NGRP + X.G - 1) / X.G;
    constexpr int PD = 2, NR = 3;
#pragma nounroll
    for (int it = 0; it < ngi; ++it) {
        const int grp = xdeal ? (((it * 8 + (X.bid & 7)) << 5) | (X.bid >> 3)) : (X.bid + it * X.G);
        if (grp >= NGRP) break;
        const int n0 = 2 * (grp & 31), hh = (grp >> 5) & 15, b = grp >> 9;
        const int r = w & 3, bq = w >> 2, blk = n0 + bq, t0 = 128 * blk + r;
        const bf16_t* base = proj + (size_t)b * SEQ * 3072 + hh * 64;
        __syncthreads();
        bf16x8 qf[4];
        { const bf16_t* qp = base + (size_t)(t0 + 4 * i32) * 3072 + 8 * hi;
#pragma unroll
          for (int d0 = 0; d0 < 4; ++d0) qf[d0] = *(const bf16x8*)(qp + 16 * d0); }
        float m_run = NEG, l_run = 0.f;
        f32x16 o0, o1;
#pragma unroll
        for (int q = 0; q < 16; ++q) { o0[q] = 0.f; o1[q] = 0.f; }
        const size_t srow = (size_t)(b * SEQ + t0 + 4 * i32);
#define AT_TILE(kf, Mstart_, kt_, qi_, VADDR) do { \
            f32x16 s; _Pragma("unroll") for (int q = 0; q < 16; ++q) s[q] = 0.f; \
            _Pragma("unroll") for (int d0 = 0; d0 < 4; ++d0) s = __builtin_amdgcn_mfma_f32_32x32x16_bf16(kf[d0], qf[d0], s, 0, 0, 0); \
            const int hi_ = (qi_) + 128 - 32 * (kt_); int lo = hi_ - 128; { const int nk = -((Mstart_) + 32 * (kt_)); lo = lo > nk ? lo : nk; } \
            const int rb = 4 * hi - lo; const unsigned span = (unsigned)(hi_ - lo); const bool any = hi_ >= lo; \
            float tmax = NEG; \
            _Pragma("unroll") for (int q = 0; q < 16; ++q) { const int rowc = (q & 3) + 8 * (q >> 2); const bool ok = any && ((unsigned)(rowc + rb) <= span) && (rowc + rb >= 0); s[q] = ok ? s[q] : NEG; tmax = fmaxf(tmax, s[q]); } \
            tmax = fmaxf(tmax, bperm_f(lane ^ 32, tmax)); \
            const float m_new = fmaxf(m_run, tmax), sc = __builtin_amdgcn_exp2f(m_run - m_new); m_run = m_new; \
            float ps = 0.f; \
            _Pragma("unroll") for (int q = 0; q < 16; ++q) { s[q] = __builtin_amdgcn_exp2f(s[q] - m_new); ps += s[q]; } \
            l_run = l_run * sc + ps; \
            _Pragma("unroll") for (int q = 0; q < 16; ++q) { o0[q] *= sc; o1[q] *= sc; } \
            u32x4 pw0, pw1; \
            pw0.x = cvt_pk_bf16(s[0], s[1]); pw0.y = cvt_pk_bf16(s[2], s[3]); pw0.z = cvt_pk_bf16(s[4], s[5]); pw0.w = cvt_pk_bf16(s[6], s[7]); \
            pw1.x = cvt_pk_bf16(s[8], s[9]); pw1.y = cvt_pk_bf16(s[10], s[11]); pw1.z = cvt_pk_bf16(s[12], s[13]); pw1.w = cvt_pk_bf16(s[14], s[15]); \
            const bf16x8 pf0 = __builtin_bit_cast(bf16x8, pw0), pf1 = __builtin_bit_cast(bf16x8, pw1); \
            _Pragma("unroll") for (int dh = 0; dh < 2; ++dh) { _Pragma("unroll") for (int kg = 0; kg < 2; ++kg) { \
                const LAS unsigned char* va_ = VADDR(dh, kg); \
                const v4i16_t vlo = vtr16(va_), vhi = vtr16(va_ + 512); \
                const bf16x8 vf = (bf16x8){vlo[0], vlo[1], vlo[2], vlo[3], vhi[0], vhi[1], vhi[2], vhi[3]}; \
                if (dh == 0) o0 = __builtin_amdgcn_mfma_f32_32x32x16_bf16(vf, kg == 0 ? pf0 : pf1, o0, 0, 0, 0); \
                else o1 = __builtin_amdgcn_mfma_f32_32x32x16_bf16(vf, kg == 0 ? pf0 : pf1, o1, 0, 0, 0); } } \
        } while (0)
        {
            const int Mstart = (t0 - r) / 4 - 128;
            u32x4 kr[NR][4], vr[NR][4];
            auto issue = [&](int j, u32x4 (&kk)[4], u32x4 (&vv)[4]) {
                const int Mt = Mstart + 32 * j;
#pragma unroll
                for (int q = 0; q < 4; ++q) {
                    int p = 4 * (Mt + 8 * q + lrow) + r; p = p < 0 ? 0 : p; p = p > seqmax ? seqmax : p;
                    const bf16_t* rp = base + (size_t)p * 3072;
                    kk[q] = *(const u32x4*)(rp + 1024 + 8 * (lpc ^ lrow)); vv[q] = *(const u32x4*)(rp + 2048 + 8 * lpc);
                }
            };
#pragma unroll
            for (int j = 0; j < PD; ++j) issue(j, kr[j], vr[j]);
#pragma unroll
            for (int j = 0; j < 5; ++j) {
                if (j + PD < 5) issue(j + PD, kr[(j + PD) % NR], vr[(j + PD) % NR]);
#pragma unroll
                for (int q = 0; q < 4; ++q) *(LAS u32x4*)(kbuf + (j & 1) * 4096 + q * 1024 + lane * 16) = kr[j % NR][q];
                bf16x8 kf[4];
#pragma unroll
                for (int d0 = 0; d0 < 4; ++d0) kf[d0] = *(const LAS bf16x8*)(kbuf + (j & 1) * 4096 + (i32 >> 3) * 1024 + (i32 & 7) * 128 + (((2 * d0 + hi) ^ (i32 & 7)) << 4));
#pragma unroll
                for (int q = 0; q < 4; ++q) *(LAS u32x4*)(vbuf + (j & 1) * 4096 + ((lpc >> 2) * 2 + (q >> 1)) * 1024 + ((q & 1) * 8 + lrow) * 64 + (lpc & 3) * 16) = vr[j % NR][q];
#define AT_VP(dh, kg) (vbuf + (j & 1) * 4096 + vrd + ((dh) * 2 + (kg)) * 1024)
                AT_TILE(kf, Mstart, j, i32, AT_VP);
#undef AT_VP
            }
        }
        {
            __builtin_amdgcn_sched_barrier(0);
            u32x4 sh[13];
            const int p0 = 128 * (n0 - 1);
#pragma unroll
            for (int i = 0; i < 13; ++i) {
                const int e_ = X.tid + 512 * i; const bool isv = e_ >= 3328; const int ee = isv ? e_ - 3328 : e_;
                int p = p0 + (ee >> 3); p = p < 0 ? 0 : p; p = p > seqmax ? seqmax : p;
                sh[i] = *(const u32x4*)(base + (size_t)p * 3072 + (isv ? 2048 : 1024) + 8 * (ee & 7));
            }
            __syncthreads();
#pragma unroll
            for (int i = 0; i < 13; ++i) {
                const int e_ = X.tid + 512 * i; const bool isv = e_ >= 3328; const int ee = isv ? e_ - 3328 : e_, row = ee >> 3, pc = ee & 7;
                if (isv) *(LAS u32x4*)(vimg + (pc >> 2) * 26624 + row * 64 + (pc & 3) * 16) = sh[i];
                else *(LAS u32x4*)(kimg + row * 128 + ((pc ^ (row & 7)) << 4)) = sh[i];
            }
            __syncthreads();
            const int Mstart = t0 - 128, s0 = 128 * bq + r;
#pragma nounroll
            for (int kt = 0; kt < 8; ++kt) {
                const int R = s0 + 32 * kt + i32;
                bf16x8 kf[4];
#pragma unroll
                for (int d0 = 0; d0 < 4; ++d0) kf[d0] = *(const LAS bf16x8*)(kimg + R * 128 + (((2 * d0 + hi) ^ (R & 7)) << 4));
#define AT_VP(dh, kg) (vimg + (dh) * 26624 + (s0 + 32 * kt + 16 * (kg)) * 64 + vrd)
                AT_TILE(kf, Mstart, kt, 4 * i32, AT_VP);
#undef AT_VP
            }
        }
#undef AT_TILE
        const float lt = l_run + bperm_f(lane ^ 32, l_run);
        if (hi == 0) ml[srow * NH + hh] = make_float2(m_run, lt);
        bf16_t* op = ost + srow * D + hh * 64 + 4 * hi;
#pragma unroll
        for (int gq = 0; gq < 4; ++gq) {
            u32x2 w0, w1;
            w0.x = cvt_pk_bf16(o0[4 * gq], o0[4 * gq + 1]); w0.y = cvt_pk_bf16(o0[4 * gq + 2], o0[4 * gq + 3]);
            w1.x = cvt_pk_bf16(o1[4 * gq], o1[4 * gq + 1]); w1.y = cvt_pk_bf16(o1[4 * gq + 2], o1[4 * gq + 3]);
            *(u32x2*)(op + 8 * gq) = w0; *(u32x2*)(op + 32 + 8 * gq) = w1;
        }
    }
    __syncthreads();
}

__device__ __forceinline__ void phase_ln_router(const Ctx& X, int layer, const bf16_t* hin, const bf16_t* mixo, const float* g, const float* bta, const float* rb, bf16_t* h1, int cnt_layer, int probe = 0) {
    using pg8::bf16x8;
    LAS unsigned char* Ah = X.lds;
    LAS unsigned char* Al = X.lds + 65536;
    LAS float* P = (LAS float*)X.lds;
    LAS int* s_cnt = (LAS int*)(X.lds + TAB_OFF);
    LAS int* s_gb = s_cnt + 32;
    const int lane = X.lane, w = X.wave, tok = lane & 31, hi = lane >> 5;
    int* tok_e = (int*)(X.ws + WS_TOKE); int* tok_r = (int*)(X.ws + WS_TOKR); float* glist = (float*)(X.ws + WS_GLIST); unsigned char* XG8 = (unsigned char*)(X.ws + WS_XG); int* stok = (int*)(X.ws + WS_STOK);
    unsigned* cnt = X.ctl + CW_CNT + cnt_layer * 32 * 64;
    const float rbe = rb[tok]; const float ninf = opaque_f(-INFINITY);
    const auto rs_h = __builtin_amdgcn_make_buffer_rsrc((void*)hin, 0, -1, 0x00020000), rs_m = __builtin_amdgcn_make_buffer_rsrc((void*)mixo, 0, -1, 0x00020000);
#define LNA_LD(rs_, tokidx_, j_) __builtin_bit_cast(u32x4, __builtin_amdgcn_raw_buffer_load_b128(rs_, lane * 16, (tokidx_) * (D * 2) + (j_) * 1024, 0))
    const int tb = X.bid * 128;
    if (tb < T) {
        u32x4 raw[4][4];
#pragma unroll
        for (int tl = 0; tl < 4; ++tl) { const int ti_ = __builtin_amdgcn_readfirstlane(tb + w * 4 + tl);
#pragma unroll
            for (int j = 0; j < 2; ++j) { raw[tl][2 * j] = LNA_LD(rs_h, ti_, j); raw[tl][2 * j + 1] = LNA_LD(rs_m, ti_, j); } }
#pragma nounroll
        for (int rnd = 0; rnd < 4; ++rnd) {
            __syncthreads();
            if (X.tid < 32) s_cnt[X.tid] = 0;
            const int t0 = tb + rnd * 32 + w * 4;
            int lane_o = lane; asm volatile("" : "+v"(lane_o));
            const int tok_o = lane_o & 31, hi_o = lane_o >> 5;
            float v[4][16]; u32x2 xo[4][2];
            const float* g2 = g; const float* b2 = bta; asm volatile("" : "+s"(g2), "+s"(b2));
#pragma unroll
            for (int tl = 0; tl < 4; ++tl) {
                const size_t rowo = (size_t)(t0 + tl) * D;
                float s = 0.f;
#pragma unroll
                for (int j = 0; j < 2; ++j) { float a[8], m[8]; unpack8(raw[tl][2 * j], a); unpack8(raw[tl][2 * j + 1], m);
#pragma unroll
                    for (int q = 0; q < 8; ++q) { v[tl][j * 8 + q] = DN_ALPHA * a[q] + m[q]; s += v[tl][j * 8 + q]; } }
                const float mean = wave_sum(s) * (1.f / D); float s2 = 0.f;
#pragma unroll
                for (int q = 0; q < 16; ++q) { v[tl][q] -= mean; s2 += v[tl][q] * v[tl][q]; }
                const float rstd = rsqrtf(wave_sum(s2) * (1.f / D) + opaque_f(LN_EPS));
#pragma unroll
                for (int j = 0; j < 2; ++j) { const f32x4 g0 = *(const f32x4*)(g2 + j * 512 + lane * 8), g1 = *(const f32x4*)(g2 + j * 512 + lane * 8 + 4), b0 = *(const f32x4*)(b2 + j * 512 + lane * 8), b1 = *(const f32x4*)(b2 + j * 512 + lane * 8 + 4);
#pragma unroll
                    for (int q = 0; q < 4; ++q) { v[tl][j * 8 + q] = v[tl][j * 8 + q] * rstd * g0[q] + b0[q]; v[tl][j * 8 + 4 + q] = v[tl][j * 8 + 4 + q] * rstd * g1[q] + b1[q]; } }
                xo[tl][0].x = pk4_fp8(v[tl][0], v[tl][1], v[tl][2], v[tl][3]); xo[tl][0].y = pk4_fp8(v[tl][4], v[tl][5], v[tl][6], v[tl][7]);
                xo[tl][1].x = pk4_fp8(v[tl][8], v[tl][9], v[tl][10], v[tl][11]); xo[tl][1].y = pk4_fp8(v[tl][12], v[tl][13], v[tl][14], v[tl][15]);
                const int tr = w * 4 + tl;
#pragma unroll
                for (int j = 0; j < 2; ++j) {
                    u32x4 oh, ol; float lo[8];
                    oh.x = cvt_pk_bf16(v[tl][j * 8 + 0], v[tl][j * 8 + 1]); oh.y = cvt_pk_bf16(v[tl][j * 8 + 2], v[tl][j * 8 + 3]); oh.z = cvt_pk_bf16(v[tl][j * 8 + 4], v[tl][j * 8 + 5]); oh.w = cvt_pk_bf16(v[tl][j * 8 + 6], v[tl][j * 8 + 7]);
                    float hf[8]; unpack8(oh, hf);
#pragma unroll
                    for (int q = 0; q < 8; ++q) lo[q] = v[tl][j * 8 + q] - hf[q];
                    ol = pack8(lo);
                    *(u32x4*)(h1 + rowo + j * 512 + lane * 8) = oh;
                    const int ch = ((lane_o + 64 * j) ^ (tr & 7)) << 4;
                    *(LAS u32x4*)(Ah + tr * 2048 + ch) = oh; *(LAS u32x4*)(Al + tr * 2048 + ch) = ol;
                }

            }
            if (rnd < 3) {
#pragma unroll
                for (int tl = 0; tl < 4; ++tl) { const int ti_ = __builtin_amdgcn_readfirstlane(t0 + 32 + tl);
#pragma unroll
                    for (int j = 0; j < 2; ++j) { raw[tl][2 * j] = LNA_LD(rs_h, ti_, j); raw[tl][2 * j + 1] = LNA_LD(rs_m, ti_, j); } } }
            bf16x8 wfh[8], wfl[8];
            { const bf16_t* rwh = (const bf16_t*)(X.ws + WS_RWH) + ((size_t)layer * NE + tok) * D + 128 * w + 8 * hi; const bf16_t* rwl = (const bf16_t*)(X.ws + WS_RWL) + ((size_t)layer * NE + tok) * D + 128 * w + 8 * hi;
#pragma unroll
              for (int i = 0; i < 8; ++i) { wfh[i] = *(const bf16x8*)(rwh + 16 * i); wfl[i] = *(const bf16x8*)(rwl + 16 * i); } }
            __syncthreads();
            f32x16 acc;
#pragma unroll
            for (int q = 0; q < 16; ++q) acc[q] = 0.f;
#pragma unroll
            for (int i = 0; i < 8; ++i) {
                const int ch = ((2 * (8 * w + i) + hi_o) ^ (tok_o & 7)) << 4;
                const bf16x8 bh = *(const LAS bf16x8*)(Ah + tok_o * 2048 + ch), bl = *(const LAS bf16x8*)(Al + tok_o * 2048 + ch);
                acc = __builtin_amdgcn_mfma_f32_32x32x16_bf16(wfh[i], bh, acc, 0, 0, 0);
                acc = __builtin_amdgcn_mfma_f32_32x32x16_bf16(wfl[i], bh, acc, 0, 0, 0);
                acc = __builtin_amdgcn_mfma_f32_32x32x16_bf16(wfh[i], bl, acc, 0, 0, 0);
            }
            __syncthreads();
#pragma unroll
            for (int q = 0; q < 16; ++q) P[(w * 32 + tok) * 33 + (q & 3) + 8 * (q >> 2) + 4 * hi] = acc[q];
            __syncthreads();
            float lg[4];
#pragma unroll
            for (int tl = 0; tl < 4; ++tl) { float a = 0.f;
#pragma unroll
                for (int ww = 0; ww < 4; ++ww) a += P[((hi * 4 + ww) * 32 + (w * 4 + tl)) * 33 + tok];
                a += bperm_f(lane_o ^ 32, a); lg[tl] = a + rbe; }
            const int e = tok;
            int my_e = 0; float my_g = 0.f;
#pragma unroll
            for (int tl = 0; tl < 4; ++tl) {
                float cur = lg[tl];
                float sv0 = 0.f, sv1 = 0.f, sv2 = 0.f, sv3 = 0.f; int si0 = 0, si1 = 0, si2 = 0, si3 = 0;
#pragma unroll
                for (int k = 0; k < 4; ++k) {
                    float bv = cur; int bi = e;
#define LNA_XS(o) { const float ov = swz_f<o>(bv); const int oi = swz_i<o>(bi); if (ov > bv || (ov == bv && oi < bi)) { bv = ov; bi = oi; } }
                    LNA_XS(1) LNA_XS(2) LNA_XS(4) LNA_XS(8) LNA_XS(16)
#undef LNA_XS
                    if (k == 0) { sv0 = bv; si0 = bi; } else if (k == 1) { sv1 = bv; si1 = bi; } else if (k == 2) { sv2 = bv; si2 = bi; } else { sv3 = bv; si3 = bi; }
                    if (e == bi) cur = ninf;
                }
                const float e1 = __expf(sv1 - sv0), e2 = __expf(sv2 - sv0), e3 = __expf(sv3 - sv0), inv = 1.f / (1.f + e1 + e2 + e3);
                if ((lane >> 2) == tl) { const int k = lane & 3; my_e = k == 0 ? si0 : k == 1 ? si1 : k == 2 ? si2 : si3; my_g = (k == 0 ? 1.f : k == 1 ? e1 : k == 2 ? e2 : e3) * inv; }
            }
            int my_lr = 0;
            if (lane < 16) my_lr = __hip_atomic_fetch_add(&s_cnt[my_e], 1, __ATOMIC_RELAXED, __HIP_MEMORY_SCOPE_WORKGROUP);
            __syncthreads();
            { int tid_o = X.tid; asm volatile("" : "+v"(tid_o));
#ifdef PROBE_LNA
              if (probe & 4) { if (tid_o < 32) s_gb[tid_o] = tb + rnd * 32; } else
#endif
              if (tid_o < 32) { const int c = s_cnt[tid_o]; s_gb[tid_o] = c ? (int)atomicAdd(cnt + tid_o * 64, (unsigned)c) : 0; } }
            __syncthreads();
            int my_r = 0;
            if (lane < 16) { my_r = s_gb[my_e] + my_lr; const int t = t0 + (lane >> 2); tok_e[t * 4 + (lane & 3)] = my_e; tok_r[t * 4 + (lane & 3)] = my_r; glist[(size_t)my_e * T + my_r] = my_g; stok[(size_t)my_e * T + my_r] = t; }
#ifdef PROBE_LNA
            if (!(probe & 1))
#endif
#pragma unroll
            for (int tl = 0; tl < 4; ++tl) {
                unsigned char* dst = XG8 + (size_t)(t0 + tl) * D + lane * 8;
                *(u32x2*)(dst) = xo[tl][0]; *(u32x2*)(dst + 512) = xo[tl][1]; }
        }
    }
}
#undef LNA_LD

__device__ __forceinline__ void load_tile_table(const Ctx& X, int layer, LAS int* tb) {
    __syncthreads();
    if (X.tid < 64) {
        const int c = X.tid < 32 ? (int)__hip_atomic_load(X.ctl + CW_CNT + (layer * 32 + X.tid) * 64, RLX_AGENT) : 0;
        const int tl = (c + 255) >> 8; int incl = tl;
#pragma unroll
        for (int o = 1; o < 32; o <<= 1) { const int t = bperm_i(X.lane - o, incl); if ((X.tid & 31) >= o) incl += t; }
        if (X.tid < 32) { tb[X.tid] = incl - tl; if (X.tid == 31) tb[32] = incl; }
    }
    __syncthreads();
}

template <bool OUT_F32>
__device__ __forceinline__ void phase_combine_ln(const Ctx& X, int layer, const bf16_t* h1, const bf16_t* Y, const float* g, const float* bta, void* outp) {
    const int lane = X.lane;
    const int gw = X.bid * NWAVES + X.wave, NGW = X.G * NWAVES;
    const int* tok_e = (const int*)(X.ws + WS_TOKE); const int* tok_r = (const int*)(X.ws + WS_TOKR);
    int basev = 0;
    { const int c = lane < 32 ? (int)__hip_atomic_load(X.ctl + CW_CNT + (layer * 32 + lane) * 64, RLX_AGENT) : 0; const int pc = ((c + 255) >> 8) << 8; int incl = pc;
#pragma unroll
      for (int o = 1; o < 32; o <<= 1) { const int t = bperm_i(lane - o, incl); if ((lane & 31) >= o) incl += t; }
      basev = incl - pc; }
    float gg[16], bb[16];
#pragma unroll
    for (int j = 0; j < 2; ++j) {
        const f32x4 g0 = *(const f32x4*)(g + j * 512 + lane * 8), g1 = *(const f32x4*)(g + j * 512 + lane * 8 + 4), b0 = *(const f32x4*)(bta + j * 512 + lane * 8), b1 = *(const f32x4*)(bta + j * 512 + lane * 8 + 4);
#pragma unroll
        for (int q = 0; q < 4; ++q) { gg[j * 8 + q] = g0[q]; gg[j * 8 + 4 + q] = g1[q]; bb[j * 8 + q] = b0[q]; bb[j * 8 + 4 + q] = b1[q]; }
    }
    for (int bt = gw; bt < T; bt += NGW) {
        int myslot = 0;
        if (lane < 4) myslot = tok_r[bt * 4 + lane];
        const int mye = lane < 4 ? tok_e[bt * 4 + lane] : 0;
        myslot += bperm_i(mye, basev);
        const int s0 = bperm_i(0, myslot), s1 = bperm_i(1, myslot), s2 = bperm_i(2, myslot), s3 = bperm_i(3, myslot);
        float v[16]; float s = 0.f;
#pragma unroll
        for (int j = 0; j < 2; ++j) {
            const int off = j * 512 + lane * 8;
            float a[8], y0[8], y1[8], y2[8], y3[8];
            unpack8(*(const u32x4*)(h1 + (size_t)bt * D + off), a);
            const unsigned char* Y8 = (const unsigned char*)Y;
            unpack8_fp8(*(const u32x2*)(Y8 + (size_t)s0 * D + off), y0); unpack8_fp8(*(const u32x2*)(Y8 + (size_t)s1 * D + off), y1); unpack8_fp8(*(const u32x2*)(Y8 + (size_t)s2 * D + off), y2); unpack8_fp8(*(const u32x2*)(Y8 + (size_t)s3 * D + off), y3);
#pragma unroll
            for (int q = 0; q < 8; ++q) { v[j * 8 + q] = DN_ALPHA * a[q] + (((y0[q] + y1[q]) + y2[q]) + y3[q]) * (1.0f / Y8_SCALE); s += v[j * 8 + q]; }
        }
        const float mean = wave_sum(s) * (1.f / D); float s2q = 0.f;
#pragma unroll
        for (int q = 0; q < 16; ++q) { v[q] -= mean; s2q += v[q] * v[q]; }
        const float rstd = rsqrtf(wave_sum(s2q) * (1.f / D) + opaque_f(LN_EPS));
#pragma unroll
        for (int q = 0; q < 16; ++q) v[q] = v[q] * rstd * gg[q] + bb[q];
#pragma unroll
        for (int j = 0; j < 2; ++j) {
            const size_t o = (size_t)bt * D + j * 512 + lane * 8;
            if (OUT_F32) { float* op = (float*)outp + o; *(f32x4*)(op) = (f32x4){v[j * 8 + 0], v[j * 8 + 1], v[j * 8 + 2], v[j * 8 + 3]}; *(f32x4*)(op + 4) = (f32x4){v[j * 8 + 4], v[j * 8 + 5], v[j * 8 + 6], v[j * 8 + 7]}; }
            else { u32x4 w; w.x = cvt_pk_bf16(v[j * 8 + 0], v[j * 8 + 1]); w.y = cvt_pk_bf16(v[j * 8 + 2], v[j * 8 + 3]); w.z = cvt_pk_bf16(v[j * 8 + 4], v[j * 8 + 5]); w.w = cvt_pk_bf16(v[j * 8 + 6], v[j * 8 + 7]); *(u32x4*)((bf16_t*)outp + o) = w; }
        }
    }
}


__device__ __forceinline__ Ctx refresh_ctx(const Ctx& X0) {
    Ctx X = X0; int wv = X0.wave; asm volatile("" : "+s"(wv)); int t = wv * 64 + lane_id(); asm volatile("" : "+v"(t)); X.tid = t; X.lane = t & 63; X.wave = wv;
    asm volatile("" : "+s"(X.ws), "+s"(X.ctl), "+s"(X.G), "+s"(X.bid));
    return X;
}
#ifndef STAG
#define STAG 0
#endif
__device__ __forceinline__ void stagger(const Ctx& X) { const int n = ((X.bid >> 3) & 31) * STAG;
#pragma nounroll
    for (int i = 0; i < n; ++i) __builtin_amdgcn_s_sleep(1); }
struct Args { const float* in[26]; float* out; unsigned char* ws; int ph_lo, ph_hi; };
constexpr int N_PHASES = 1 + 2 * (6 + 4) + 2 * (4 + 4);
#define GP_ALIGN true
#define GP_SP2 true

__global__ void __launch_bounds__(NTHR, 2) mk_fwd(Args args) {
    extern __shared__ __attribute__((aligned(16))) unsigned char lds_raw[];
    Ctx X0;
    X0.lds = (LAS unsigned char*)lds_raw;
    X0.tid = threadIdx.x; X0.lane = X0.tid & 63; X0.wave = __builtin_amdgcn_readfirstlane(X0.tid >> 6);
    X0.G = gridDim.x; X0.bid = blockIdx.x;
    X0.ws = (GAS unsigned char*)args.ws; X0.ctl = (unsigned*)(args.ws + WS_CTL);
    volatile LAS unsigned* MISC = (volatile LAS unsigned*)(X0.lds + MISC_OFF);
    if (X0.tid < 32) MISC[X0.tid] = 0u;
    __syncthreads();
    XcdBarrier bar; bar.bar = X0.ctl + CW_BAR; bar.x = 0; bar.st = nullptr; bar.wave = X0.wave;
    if (MK_ONE_LAUNCH) bar = xcd_barrier_post(X0.ctl + CW_BAR, MISC + 8, X0.wave);
    volatile LAS unsigned long long* ptab = (volatile LAS unsigned long long*)(X0.lds + TAB_OFF + 1024);
    if (X0.tid < 26) ptab[X0.tid] = (unsigned long long)args.in[X0.tid];
    __syncthreads();
#define INP(k) ld_ptr(ptab, k)
    const int lo = args.ph_lo, hi = args.ph_hi;
    int ph = 0;
#define IN() (lo <= ph && ph < hi)
#define SEAM() do { if (MK_ONE_LAUNCH && lo <= ph && ph + 1 < hi) xcd_barrier(bar); ++ph; } while (0)

#define H0 ((bf16_t*)(X.ws + WS_H0))
#define H1 ((bf16_t*)(X.ws + WS_H1))
#define PROJ ((bf16_t*)(X.ws + WS_PROJ))
#define MIX ((bf16_t*)(X.ws + WS_MIX))
#define MIXO ((bf16_t*)(X.ws + WS_MIXO))
#define Z ((bf16_t*)(X.ws + WS_Z))
#define ACT ((bf16_t*)(X.ws + WS_ACT))
#define Y ((bf16_t*)(X.ws + WS_Y))
#define tb ((LAS int*)(X.lds + TAB_OFF + 512))

#ifndef DUP_MASK
#define DUP_MASK 0
#endif
    enum { P_PRO, P_E1, P_S5A, P_S5C, P_S5B, P_E3, P_E4, P_O1, P_ATT, P_O3, P_LNA, P_M1, P_M2, P_LNB, P_ATT1 };
#define PHASE_BEGIN(k) _Pragma("nounroll") for (int _r = 0; _r < ((((DUP_MASK) >> (k)) & 1) + 1); ++_r) { if (IN()) { const Ctx X = refresh_ctx(X0);
#define PHASE_END } SEAM(); }
    PHASE_BEGIN(P_PRO)  phase_prologue(X, ptab);  PHASE_END

#pragma nounroll
    for (int layer = 0; layer < DEPTH; ++layer) {
        const int i = layer >> 1;
        if ((layer & 1) == 0) {
            PHASE_BEGIN(P_E1)  pg8::Gemm gm{H0, (const bf16_t*)(X.ws + WS_WIN) + (size_t)i * 2048 * D, T, 2048, D}; pg8::StaticOrder S; S.init(T, 2048, D, X.G, X.bid);
                pg8::EpiStore E{PROJ, 2048};
                pg8::gemm_phase<pg8::EpiStore, pg8::StaticOrder, GP_ALIGN, GP_SP2>(X.lds, gm, S, E, X.wave);  PHASE_END
            PHASE_BEGIN(P_S5A)  phase_s5<1>(X, i, PROJ, INP(2), INP(8), INP(9), INP(10), MIX, Z);  PHASE_END
            PHASE_BEGIN(P_S5C)  phase_s5_carry(X, i);  PHASE_END
            PHASE_BEGIN(P_S5B)  phase_s5<2>(X, i, PROJ, INP(2), INP(8), INP(9), INP(10), MIX, Z);  PHASE_END
            PHASE_BEGIN(P_E3)  pg8::Gemm gm{Z, (const bf16_t*)(X.ws + WS_WGLU) + (size_t)i * 512 * 512, T, 512, 512}; pg8::StaticOrder S; S.init(T, 512, 512, X.G, X.bid);
                pg8::EpiGlu E{Z, MIX, INP(12) + (size_t)i * SSM_W};
                pg8::gemm_phase<pg8::EpiGlu, pg8::StaticOrder, GP_ALIGN, GP_SP2>(X.lds, gm, S, E, X.wave);  PHASE_END
            PHASE_BEGIN(P_E4)  pg8::Gemm gm{MIX, (const bf16_t*)(X.ws + WS_WOUT) + (size_t)i * D * D, T, D, D}; pg8::StaticOrder S; S.init(T, D, D, X.G, X.bid);
                pg8::EpiStore E{MIXO, D};
                pg8::gemm_phase<pg8::EpiStore, pg8::StaticOrder, GP_ALIGN, GP_SP2>(X.lds, gm, S, E, X.wave);  PHASE_END
        } else {
            PHASE_BEGIN(P_O1)  pg8::Gemm gm{H0, (const bf16_t*)(X.ws + WS_WQKV) + (size_t)i * 3072 * D, T, 3072, D}; pg8::StaticOrder S; S.init(T, 3072, D, X.G, X.bid);
                pg8::EpiRope E{PROJ, (const f32x2*)(X.ws + WS_ROPE)};
                pg8::gemm_phase<pg8::EpiRope, pg8::StaticOrder, GP_ALIGN, GP_SP2>(X.lds, gm, S, E, X.wave);  PHASE_END
            PHASE_BEGIN(P_ATT)  phase_attn_coop0(X, PROJ, MIXO, (float2*)(X.ws + WS_S5X));  PHASE_END
            PHASE_BEGIN(P_ATT1)  phase_attn_coop1(X, PROJ, MIX, MIXO, (const float2*)(X.ws + WS_S5X));  PHASE_END
            PHASE_BEGIN(P_O3)  pg8::Gemm gm{MIX, (const bf16_t*)(X.ws + WS_WO) + (size_t)i * D * D, T, D, D}; pg8::StaticOrder S; S.init(T, D, D, X.G, X.bid);
                pg8::EpiStore E{MIXO, D};
                pg8::gemm_phase<pg8::EpiStore, pg8::StaticOrder, GP_ALIGN, GP_SP2>(X.lds, gm, S, E, X.wave);  PHASE_END
        }
#ifdef PROBE_LNA
        PHASE_BEGIN(P_LNA)  phase_ln_router(X, layer, H0, MIXO, INP(16) + layer * D, INP(17) + layer * D, INP(21) + layer * NE, H1, _r == 0 ? layer + 4 : layer, _r == 0 ? opaque_i(PROBE_LNA) : 0);  PHASE_END
#else
        PHASE_BEGIN(P_LNA)  phase_ln_router(X, layer, H0, MIXO, INP(16) + layer * D, INP(17) + layer * D, INP(21) + layer * NE, H1, layer);  PHASE_END
#endif
        PHASE_BEGIN(P_M1)  load_tile_table(X, layer, tb);
            pg8::Gemm gm{(const bf16_t*)(X.ws + WS_XG), (const bf16_t*)(X.ws + WS_WGU + (size_t)layer * NE * 2048 * D), 0, 2048, D / 2};
            pg8::MoeOrder<8, true> S; S.init(tb, X.G, X.bid, 2048, D / 2); S.stok = (const int*)(X.ws + WS_STOK); S.cnt = X.ctl + CW_CNT + layer * 32 * 64; S.preload_ids((LAS unsigned short*)(X.lds + 131072 + 3072), X.tid, X.wave);
            stagger(X);
#ifdef PROBE_NOSTORE
            pg8::EpiSwiglu E{opaque_i(((DUP_MASK >> P_M1) & 1) && _r == 0) != 0, ACT, INP(23) + (size_t)layer * NE * 2048};
#else
            pg8::EpiSwiglu E{ACT, INP(23) + (size_t)layer * NE * 2048};
#endif
#if defined(PROBE_M1)
            if (_r == 0) pg8::gemm_phase<pg8::EpiSwiglu, pg8::MoeOrder<8, true>, GP_ALIGN, GP_SP2, true, PROBE_M1>(X.lds, gm, S, E, X.wave, opaque_i(127 - W8_SHIFT_GU), opaque_i(127)); else
#endif
            pg8::gemm_phase<pg8::EpiSwiglu, pg8::MoeOrder<8, true>, GP_ALIGN, GP_SP2, true>(X.lds, gm, S, E, X.wave, opaque_i(127 - W8_SHIFT_GU), opaque_i(127));  PHASE_END
        PHASE_BEGIN(P_M2)  load_tile_table(X, layer, tb);
            pg8::Gemm gm{ACT, (const bf16_t*)(X.ws + WS_WDN + (size_t)layer * NE * D * D), 0, D, D / 2};
            pg8::MoeOrder<4, false> S; S.init(tb, X.G, X.bid, D, D / 2); S.stok = nullptr; S.cnt = nullptr; S.idl = nullptr;
            stagger(X);
#ifdef PROBE_NOSTORE
            pg8::EpiDown E{opaque_i(((DUP_MASK >> P_M2) & 1) && _r == 0) != 0, Y, INP(25) + (size_t)layer * NE * D, (const float*)(X.ws + WS_GLIST)};
#else
            pg8::EpiDown E{Y, INP(25) + (size_t)layer * NE * D, (const float*)(X.ws + WS_GLIST)};
#endif
#if defined(PROBE_M2)
            if (_r == 0) pg8::gemm_phase<pg8::EpiDown, pg8::MoeOrder<4, false>, GP_ALIGN, GP_SP2, true, PROBE_M2>(X.lds, gm, S, E, X.wave, opaque_i(127 - W8_SHIFT_DN), opaque_i(127)); else
#endif
            pg8::gemm_phase<pg8::EpiDown, pg8::MoeOrder<4, false>, GP_ALIGN, GP_SP2, true>(X.lds, gm, S, E, X.wave, opaque_i(127 - W8_SHIFT_DN), opaque_i(127));  PHASE_END
        PHASE_BEGIN(P_LNB)
            if (layer == DEPTH - 1) phase_combine_ln<true>(X, layer, H1, Y, INP(18) + layer * D, INP(19) + layer * D, (void*)args.out);
            else phase_combine_ln<false>(X, layer, H1, Y, INP(18) + layer * D, INP(19) + layer * D, (void*)H0);
         PHASE_END
    }
#undef IN
#undef SEAM
#undef PHASE_BEGIN
#undef PHASE_END
#undef H0
#undef H1
#undef PROJ
#undef MIX
#undef MIXO
#undef Z
#undef ACT
#undef Y
#undef tb
}

extern "C" void kernel_launch(void* const* d_in, const int* in_sizes, int n_in, void* d_out, int out_size, void* d_ws, size_t ws_size, hipStream_t stream) {
    static int grid = 0;
    if (grid == 0) {
        if (n_in != 26 || out_size != T * D || ws_size < WS_END) { fprintf(stderr, "kernel_launch: unexpected shapes n_in %d out %d ws %zu (need %zu)\n", n_in, out_size, ws_size, (size_t)WS_END); grid = -1; return; }
        int dev = 0, cus = 0, per_cu = 0;
        if (hipGetDevice(&dev) != hipSuccess || hipDeviceGetAttribute(&cus, hipDeviceAttributeMultiprocessorCount, dev) != hipSuccess) { grid = -1; return; }
        if (hipFuncSetAttribute((const void*)mk_fwd, hipFuncAttributeMaxDynamicSharedMemorySize, LDS_BYTES) != hipSuccess) { fprintf(stderr, "kernel_launch: hipFuncSetAttribute failed\n"); grid = -1; return; }
        if (hipOccupancyMaxActiveBlocksPerMultiprocessor(&per_cu, (const void*)mk_fwd, NTHR, LDS_BYTES) != hipSuccess || per_cu < 1) fprintf(stderr, "kernel_launch: occupancy query says %d\n", per_cu);
        (void)hipGetLastError();
        grid = cus;
        if (grid < 256) { fprintf(stderr, "kernel_launch: %d CUs; the LN+router phase deals one 128-token slab per workgroup and needs 256\n", cus); grid = -1; return; }
        if (grid > 256) grid = 256;
    }
    if (grid < 0) return;
    if (hipMemsetAsync((char*)d_ws + WS_CTL, 0, CTL_ZERO_BYTES, stream) != hipSuccess) return;
    Args a{};
    for (int i = 0; i < 26; ++i) a.in[i] = (const float*)d_in[i];
    a.out = (float*)d_out; a.ws = (unsigned char*)d_ws;
#if MK_ONE_LAUNCH
    a.ph_lo = 0; a.ph_hi = DUP_MASK ? 100000 : N_PHASES;
    hipLaunchKernelGGL(mk_fwd, dim3(grid), dim3(NTHR), LDS_BYTES, stream, a);
#else
    for (int p = 0; p < N_PHASES; ++p) { a.ph_lo = p; a.ph_hi = p + 1; hipLaunchKernelGGL(mk_fwd, dim3(grid), dim3(NTHR), LDS_BYTES, stream, a); }
#endif
}
```

```cpp
#include <hip/hip_runtime.h>
#include <cstdio>
#include <cstdint>

#ifndef MK_ONE_LAUNCH
#define MK_ONE_LAUNCH 1
#endif

#define GAS __attribute__((address_space(1)))
#define LAS __attribute__((address_space(3)))
#define RLX_AGENT __ATOMIC_RELAXED, __HIP_MEMORY_SCOPE_AGENT
#define WAVE_SYNC() asm volatile("s_waitcnt lgkmcnt(0)" ::: "memory")
typedef float f32x4 __attribute__((ext_vector_type(4)));
typedef float f32x2 __attribute__((ext_vector_type(2)));
typedef unsigned u32x4 __attribute__((ext_vector_type(4)));
typedef unsigned u32x2 __attribute__((ext_vector_type(2)));
typedef unsigned short bf16_t;

constexpr int BATCH = 4, SEQ = 8192, D = 1024, T = BATCH * SEQ, DEPTH = 4;
constexpr int CONV_CH = 512, SSM_W = 512, SSM_G = 32, SSM_H = 16, SSM_P = 64;
constexpr int NH = 16, HD = 64;
constexpr int NE = 32, TOPK = 4, NA = T * TOPK;
constexpr float SW_LIMIT = 7.0f, SW_ALPHA = 1.702f;
constexpr float LN_EPS = 1e-5f;
constexpr float DN_ALPHA = 1.6817928305074290860622509524664f;
constexpr int NWAVES = 8, NTHR = 512;

constexpr size_t MiB = 1u << 20;
constexpr size_t WS_CTL = 0, CTL_ZERO_BYTES = 1 * MiB;
constexpr size_t WS_S5A = 1 * MiB;
constexpr size_t WS_S5B = 1 * MiB + 65536;
constexpr size_t WS_ROPE = 2 * MiB;
constexpr size_t WS_S5X = 48 * MiB;
constexpr size_t WS_TOKE = 4 * MiB;
constexpr size_t WS_TOKR = 4 * MiB + 524288;
constexpr size_t WS_RWH = 5 * MiB;
constexpr size_t WS_RWL = 5 * MiB + 262144;
constexpr size_t WS_GLIST = 8 * MiB;
constexpr size_t WS_S5S = 12 * MiB;
constexpr size_t WS_WIN = 16 * MiB;
constexpr size_t WS_WGLU = 24 * MiB;
constexpr size_t WS_WOUT = 26 * MiB;
constexpr size_t WS_WQKV = 32 * MiB;
constexpr size_t WS_WO = 44 * MiB;
constexpr size_t WS_WGU = 64 * MiB;
constexpr size_t WS_WDN = 576 * MiB;
constexpr size_t WS_H0 = 832 * MiB;
constexpr size_t WS_H1 = 896 * MiB;
constexpr size_t WS_PROJ = 960 * MiB;
constexpr size_t WS_MIX = 1152 * MiB;
constexpr size_t WS_MIXO = 1216 * MiB;
constexpr size_t WS_Z = 1280 * MiB;
constexpr size_t WS_ACT = 1312 * MiB;
constexpr size_t WS_Y = 1584 * MiB;
constexpr size_t WS_XG = 1856 * MiB;
constexpr size_t WS_STOK = 1920 * MiB;
constexpr size_t WS_END = 3904 * MiB;
constexpr int CW_BAR = 4096;
constexpr int CW_CNT = 16384;

constexpr int LDS_BYTES = 163840;
constexpr int MISC_OFF = 131072 + 320;
constexpr int TAB_OFF = 131072 + 1024;

#define XB_TMO      128
#define XB_XCNT(j)  (256  + 64 * (j))
#define XB_XSUB(j)  (1280 + 64 * (j))
#define XB_XGEN(j)  (2304 + 64 * (j))
#define XB_TOP      3328
#define XB_TOPGEN   3392
#define XCD_BAR_WORDS 3456
#define XB_SPIN_CAP (1u << 22)

__device__ __forceinline__ unsigned xb_ld(unsigned* p)              { return __hip_atomic_load(p, __ATOMIC_RELAXED, __HIP_MEMORY_SCOPE_AGENT); }
__device__ __forceinline__ unsigned xb_add(unsigned* p, unsigned v) { return __hip_atomic_fetch_add(p, v, __ATOMIC_RELAXED, __HIP_MEMORY_SCOPE_AGENT); }
__device__ __forceinline__ unsigned xb_xcc_id() { return (unsigned)__builtin_amdgcn_s_getreg((3 << 11) | 20) & 0xFu; }
#define XB_SPIN(cond, bar) do { unsigned _sp = 0; while (cond) { __builtin_amdgcn_s_sleep(1); \
    if ((++_sp & 255u) == 0u) { if (xb_ld(&(bar)[XB_TMO])) break; if (_sp > XB_SPIN_CAP) { atomicAdd(&(bar)[XB_TMO], 1u); break; } } } } while (0)

struct XcdBarrier { unsigned* bar; unsigned x; volatile LAS unsigned* st; int wave; };
__device__ __forceinline__ int xb_lane() { int l; asm volatile("v_mbcnt_lo_u32_b32 %0, -1, 0\n\tv_mbcnt_hi_u32_b32 %0, -1, %0" : "=v"(l)); return l; }

__device__ __forceinline__ XcdBarrier xcd_barrier_post(unsigned* bar, volatile LAS unsigned* st, int wave) {
    XcdBarrier b; b.bar = bar; b.x = xb_xcc_id(); b.st = st; b.wave = wave;
    if (wave == 0 && xb_lane() == 0) (void)xb_add(&bar[XB_XCNT(b.x)], 1u);
    return b;
}
__device__ __forceinline__ void xcd_barrier_complete(unsigned* bar, unsigned x, unsigned& nloc, unsigned& nx) {
    const unsigned G = gridDim.x * gridDim.y * gridDim.z;
    unsigned sum, cnt, mine, sp = 0u;
    for (;;) {
        sum = 0u; cnt = 0u; mine = 0u;
#pragma unroll
        for (unsigned j = 0; j < 16; ++j) { const unsigned c = xb_ld(&bar[XB_XCNT(j)]); sum += c; cnt += (c > 0u) ? 1u : 0u; mine = (j == x) ? c : mine; }
        if (sum == G) break;
        __builtin_amdgcn_s_sleep(1);
        if ((++sp & 255u) == 0u) { if (xb_ld(&bar[XB_TMO])) break; if (sp > XB_SPIN_CAP) { atomicAdd(&bar[XB_TMO], 1u); break; } }
    }
    nloc = mine > 0u ? mine : 1u; nx = cnt > 0u ? cnt : 1u;
}
__device__ __forceinline__ void xcd_barrier(const XcdBarrier& b) {
    asm volatile("s_waitcnt vmcnt(0)" ::: "memory");
    __syncthreads();
    if (b.wave == 0 && xb_lane() == 0) {
        unsigned* bar = b.bar;
        __builtin_amdgcn_s_waitcnt(0);
        unsigned nloc = b.st[0], nx = b.st[1];
        if (nloc == 0u) { xcd_barrier_complete(bar, b.x, nloc, nx); b.st[0] = nloc; b.st[1] = nx; }
        const unsigned old = xb_add(&bar[XB_XSUB(b.x)], 1u);
        const unsigned gen = old / nloc;
        if (old + 1u == (gen + 1u) * nloc) {
            __builtin_amdgcn_fence(__ATOMIC_RELEASE, "agent");
            asm volatile("s_waitcnt vmcnt(0)" ::: "memory");
            const unsigned og = xb_add(&bar[XB_TOP], 1u);
            const unsigned tg = og / nx;
            if (og + 1u == (tg + 1u) * nx) xb_add(&bar[XB_TOPGEN], 1u);
            else XB_SPIN(xb_ld(&bar[XB_TOPGEN]) == tg, bar);
            __builtin_amdgcn_fence(__ATOMIC_ACQUIRE, "agent");
            xb_add(&bar[XB_XGEN(b.x)], 1u);
            asm volatile("s_waitcnt vmcnt(0)" ::: "memory");
        } else {
            XB_SPIN(xb_ld(&bar[XB_XGEN(b.x)]) == gen, bar);
            __builtin_amdgcn_fence(__ATOMIC_ACQUIRE, "agent");
            asm volatile("s_waitcnt vmcnt(0)" ::: "memory");
        }
    }
    __syncthreads();
}

template <int M> __device__ __forceinline__ int swz_i(int v) { static_assert(M > 0 && M < 32, "ds_swizzle bit mode"); return __builtin_amdgcn_ds_swizzle(v, (M << 10) | 0x1f); }
template <int M> __device__ __forceinline__ float swz_f(float v) { return __builtin_bit_cast(float, swz_i<M>(__builtin_bit_cast(int, v))); }
__device__ __forceinline__ int bperm_i(int srclane, int v) { return __builtin_amdgcn_ds_bpermute(srclane << 2, v); }
__device__ __forceinline__ float bperm_f(int srclane, float v) { return __builtin_bit_cast(float, __builtin_amdgcn_ds_bpermute(srclane << 2, __builtin_bit_cast(int, v))); }
__device__ __forceinline__ float rdlane_f(float v, int l) { return __builtin_bit_cast(float, __builtin_amdgcn_readlane(__builtin_bit_cast(int, v), l)); }
__device__ __forceinline__ float wave_sum(float v) {
    v += swz_f<1>(v); v += swz_f<2>(v); v += swz_f<4>(v); v += swz_f<8>(v); v += swz_f<16>(v);
    return rdlane_f(v, 0) + rdlane_f(v, 32);
}
__device__ __forceinline__ float wave_max(float v) {
    v = fmaxf(v, swz_f<1>(v)); v = fmaxf(v, swz_f<2>(v)); v = fmaxf(v, swz_f<4>(v)); v = fmaxf(v, swz_f<8>(v)); v = fmaxf(v, swz_f<16>(v));
    return fmaxf(rdlane_f(v, 0), rdlane_f(v, 32));
}
__device__ __forceinline__ float sigmoidf_(float x) { return __builtin_amdgcn_rcpf(1.0f + __builtin_amdgcn_exp2f(-1.4426950408889634f * x)); }
__device__ __forceinline__ float gelu_tanh(float y) { return y * sigmoidf_(1.5957691216057308f * (y + 0.044715f * y * y * y)); }
__device__ __forceinline__ float opaque_f(float v) { asm volatile("" : "+s"(v)); return v; }
__device__ __forceinline__ int opaque_i(int v) { asm volatile("" : "+s"(v)); return v; }
__device__ __forceinline__ int seqpos(int bt) { return bt - ((bt >> 13) << 13); }
__device__ __forceinline__ unsigned f2bf(float f) { unsigned u = __builtin_bit_cast(unsigned, f); return (u + 0x7fffu + ((u >> 16) & 1u)) >> 16; }
__device__ __forceinline__ unsigned pk2(float lo, float hi) { return f2bf(lo) | (f2bf(hi) << 16); }
typedef float f32x2_t_ __attribute__((ext_vector_type(2))); typedef __bf16 bf16x2_t_ __attribute__((ext_vector_type(2)));
__device__ __forceinline__ unsigned cvt_pk_bf16(float lo, float hi) { const f32x2_t_ v = {lo, hi}; const bf16x2_t_ b = __builtin_convertvector(v, bf16x2_t_); return __builtin_bit_cast(unsigned, b); }
__device__ __forceinline__ float bf_lo(unsigned w) { return __builtin_bit_cast(float, w << 16); }
__device__ __forceinline__ float bf_hi(unsigned w) { return __builtin_bit_cast(float, w & 0xffff0000u); }
__device__ __forceinline__ float bf2f(bf16_t b) { return __builtin_bit_cast(float, ((unsigned)b) << 16); }
__device__ __forceinline__ void unpack8(const u32x4 w, float (&f)[8]) { f[0] = bf_lo(w.x); f[1] = bf_hi(w.x); f[2] = bf_lo(w.y); f[3] = bf_hi(w.y); f[4] = bf_lo(w.z); f[5] = bf_hi(w.z); f[6] = bf_lo(w.w); f[7] = bf_hi(w.w); }
__device__ __forceinline__ u32x4 pack8(const float (&f)[8]) { u32x4 w; w.x = cvt_pk_bf16(f[0], f[1]); w.y = cvt_pk_bf16(f[2], f[3]); w.z = cvt_pk_bf16(f[4], f[5]); w.w = cvt_pk_bf16(f[6], f[7]); return w; }

__device__ __forceinline__ unsigned pk4_fp8(float a, float b, float c, float d) {
    int w = __builtin_amdgcn_cvt_pk_fp8_f32(a, b, 0, false); w = __builtin_amdgcn_cvt_pk_fp8_f32(c, d, w, true); return (unsigned)w; }
__device__ __forceinline__ u32x2 pack8_fp8(const float (&f)[8]) { u32x2 w; w.x = pk4_fp8(f[0], f[1], f[2], f[3]); w.y = pk4_fp8(f[4], f[5], f[6], f[7]); return w; }
typedef float f32x2v_ __attribute__((ext_vector_type(2)));
__device__ __forceinline__ void unpack8_fp8(const u32x2 w, float (&f)[8]) {
    const f32x2v_ a = __builtin_amdgcn_cvt_pk_f32_fp8((int)w.x, false), b = __builtin_amdgcn_cvt_pk_f32_fp8((int)w.x, true), c = __builtin_amdgcn_cvt_pk_f32_fp8((int)w.y, false), d = __builtin_amdgcn_cvt_pk_f32_fp8((int)w.y, true);
    f[0] = a.x; f[1] = a.y; f[2] = b.x; f[3] = b.y; f[4] = c.x; f[5] = c.y; f[6] = d.x; f[7] = d.y; }
constexpr float Y8_SCALE = 16.0f;
constexpr int W8_SHIFT_GU = 5, W8_SHIFT_DN = 6;

__device__ __forceinline__ int lane_id() { int l; asm volatile("v_mbcnt_lo_u32_b32 %0, -1, 0\n\tv_mbcnt_hi_u32_b32 %0, -1, %0" : "=v"(l)); return l; }

struct Ctx {
    LAS unsigned char* lds;
    int tid, lane, wave, G, bid;
    unsigned* ctl;
    GAS unsigned char* ws;
};

namespace pg8 {
#define PG8_LAS __attribute__((address_space(3)))
typedef short bf16x8 __attribute__((ext_vector_type(8)));
constexpr int BM = 256, BK = 64, HALF = 128, HTB = HALF * BK * 2  , STAGE_BYTES = 8 * HTB, NXCD = 8, WGM = 8;

__host__ __device__ __forceinline__ int lds_byte(int r, int c) { const int st = (r >> 4) * 2 + (c >> 5), rr = r & 15, cc = c & 31, ob = rr * 64 + cc * 2; return st * 1024 + (ob ^ (((ob >> 9) & 1) << 5)); }
__host__ __device__ __forceinline__ void stage_rc(int b, int& R, int& C) { const int st = b / 1024, sb = b % 1024, swz = sb ^ (((sb >> 9) & 1) << 5); R = (st >> 1) * 16 + swz / 64; C = (st & 1) * 32 + (swz % 64) / 2; }
__host__ __device__ __forceinline__ int perm32(int rho) { const int n = rho >> 4, i = rho & 15; return 8 * (i >> 2) + 4 * n + (i & 3); }

struct Unit { int pm, pn, e, mt, ix; };
struct Gemm { const bf16_t* A; const bf16_t* Bt; int M, N, K; };

struct StaticOrder {
    int nM, nN, nwg, G, c; size_t tstep;
    __device__ void init(int M, int N, int K, int G_, int c_) { nM = M / BM; nN = N / BM; nwg = nM * nN; G = G_; c = c_; tstep = (size_t)BM * K * 2; }
    __device__ bool next(int i, Unit& u) const {
        const long L = (long)i * G + c; if (L >= nwg) return false;
        int wgid = (int)L; { const int q = nwg / NXCD, r = nwg % NXCD, xcd = wgid % NXCD, off = wgid / NXCD; wgid = (xcd < r ? xcd * (q + 1) : r * (q + 1) + (xcd - r) * q) + off; }
        const int nig = WGM * nN, gid = wgid / nig, fm = gid * WGM, gsz = (nM - fm) < WGM ? (nM - fm) : WGM;
        u.pm = fm + ((wgid % nig) % gsz); u.pn = (wgid % nig) / gsz; u.e = 0; u.mt = 0; u.ix = i; return true;
    }
    __device__ __forceinline__ size_t a_off(const Unit& u) const { return (size_t)u.pm * tstep; }
    __device__ __forceinline__ size_t b_off(const Unit& u) const { return (size_t)u.pn * tstep; }
    __device__ __forceinline__ void a_ready(const Unit&) const {}
    __device__ __forceinline__ void done(const Unit&) const {}
    static constexpr bool GATHER = false, A_PAIR2 = false;
};
template <int NPN, bool A_IS_XG> struct MoeOrder {
    static constexpr bool GATHER = A_IS_XG, A_PAIR2 = !A_IS_XG;
    const int* stok; const unsigned* cnt;
    const PG8_LAS unsigned short* idl;
    __device__ __forceinline__ unsigned list_id(int ui, int row) const { return (unsigned)idl[ui * BM + row]; }
    __device__ __forceinline__ void preload_ids(PG8_LAS unsigned short* dst, int tid, int wave) {
        idl = dst;
        const auto rs = __builtin_amdgcn_make_buffer_rsrc((void*)stok, 0, -1, 0x00020000);
        int tk[9], cn[9], sl[9];
#pragma unroll
        for (int j = 0; j < 9; ++j) { Unit u; tk[j] = 0; cn[j] = 0; sl[j] = 0;
            if (next(2 * j + (wave >> 2), u)) { sl[j] = u.mt * BM + (tid & 255); cn[j] = (int)__hip_atomic_load(cnt + u.e * 64, __ATOMIC_RELAXED, __HIP_MEMORY_SCOPE_AGENT);
                tk[j] = __builtin_amdgcn_raw_buffer_load_b32(rs, sl[j] * 4, (u.e * T) * 4, 0); } }
#pragma unroll
        for (int j = 0; j < 9; ++j) dst[(2 * j + (wave >> 2)) * BM + (tid & 255)] = (unsigned short)(sl[j] < cn[j] ? tk[j] : 0);
        __syncthreads();
    }
    template <int NPAIR, bool GU> __device__ __forceinline__ void preload_bias(PG8_LAS float* dst, const float* bias, int tid, int wave) const {
        const auto rs = __builtin_amdgcn_make_buffer_rsrc((void*)bias, 0, -1, 0x00020000);
        float bv_[NPAIR]; const int t = tid & 255;
#pragma unroll
        for (int j = 0; j < NPAIR; ++j) { Unit u; bv_[j] = 0.f;
            if (next(2 * j + (wave >> 2), u)) { const int col = GU ? (u.e * 2048 + u.pn * 128 + (t < 128 ? t : 1024 - 128 + t)) : (u.e * D + u.pn * BM + t);
                bv_[j] = __builtin_bit_cast(float, __builtin_amdgcn_raw_buffer_load_b32(rs, col * 4, 0, 0)); } }
#pragma unroll
        for (int j = 0; j < NPAIR; ++j) dst[(2 * j + (wave >> 2)) * BM + t] = bv_[j];
        __syncthreads();
    }
    __device__ __forceinline__ void preload_gates(PG8_LAS float* dst, const float* glist, int tid, int wave) const {
        const auto rs = __builtin_amdgcn_make_buffer_rsrc((void*)glist, 0, -1, 0x00020000);
        float gv_[5];
#pragma unroll
        for (int j = 0; j < 5; ++j) { Unit u; gv_[j] = 0.f; if (next(2 * j + (wave >> 2), u)) gv_[j] = __builtin_bit_cast(float, __builtin_amdgcn_raw_buffer_load_b32(rs, (u.mt * BM + (tid & 255)) * 4, (u.e * T) * 4, 0)); }
#pragma unroll
        for (int j = 0; j < 5; ++j) dst[(2 * j + (wave >> 2)) * BM + (tid & 255)] = gv_[j];
        __syncthreads();
    }
    const PG8_LAS int* tb; int G, c, ntile; size_t bexp, rowb;
    __device__ void init(const PG8_LAS int* tb_, int G_, int c_, int Nexp, int K) { tb = tb_; G = G_; c = c_; ntile = __builtin_amdgcn_readfirstlane(tb_[32]); rowb = (size_t)K * 2; bexp = (size_t)Nexp * rowb; }
    __device__ bool next(int i, Unit& u) const {
        int mtg, pn;
        if (G == 256) {
            constexpr int MPR = 256 / NPN, MPX = MPR / 8; const int nx = (ntile + 7) >> 3, l = MPX * i + (c >> 3) / NPN;
            if (l >= nx) return false;
            mtg = nx * (c & 7) + l; pn = (c >> 3) % NPN; }
        else { const long L = (long)i * G + c; mtg = (int)(L / NPN); pn = (int)(L % NPN); }
        if (mtg >= ntile) return false;
        int e = 0;
#pragma unroll
        for (int st = 16; st >= 1; st >>= 1) { const int tv = __builtin_amdgcn_readfirstlane(tb[e + st]); if (tv <= mtg) e += st; }
        u.pm = mtg; u.pn = pn; u.e = e; u.mt = mtg - __builtin_amdgcn_readfirstlane(tb[e]); u.ix = i; return true;
    }
    __device__ __forceinline__ size_t a_off(const Unit& u) const { return A_IS_XG ? (size_t)0 : (size_t)u.pm * BM * rowb; }
    __device__ __forceinline__ size_t b_off(const Unit& u) const { return (size_t)u.e * bexp + (size_t)u.pn * BM * rowb; }
    __device__ __forceinline__ void a_ready(const Unit&) const {}
    __device__ __forceinline__ void done(const Unit&) const {}
};

__device__ __forceinline__ u32x4 pack_v(const f32x4 v0, const f32x4 v1) { u32x4 w; w.x = cvt_pk_bf16(v0[0], v0[1]); w.y = cvt_pk_bf16(v0[2], v0[3]); w.z = cvt_pk_bf16(v1[0], v1[1]); w.w = cvt_pk_bf16(v1[2], v1[3]); return w; }

struct EpiStore {
    static constexpr bool PERM = true, PERM2 = true, AFTER_DRAIN = false, BIAS_INIT = false;
    bf16_t* O; int ldc;
    static __device__ __forceinline__ unsigned swp(unsigned v) { return (unsigned)__builtin_amdgcn_mov_dpp((int)v, 0xB1, 0xF, 0xF, true); }
    __device__ __forceinline__ void operator()(const f32x4 (&acc)[2][2][4][2], const Unit& u, int wr, int wc, int fr, int fq) const {
        const bool odd = (fr & 1) != 0;
        const int row0 = u.pm * BM + wr * 64, col0 = u.pn * BM + wc * 64 + 16 * fq + (odd ? 8 : 0);
        bf16_t* pa = O + (size_t)(row0 + (fr & ~1)) * ldc + col0;
#pragma unroll
        for (int ai = 0; ai < 2; ++ai)
#pragma unroll
            for (int m = 0; m < 4; ++m) {
                const u32x4 h0 = pack_v(acc[ai][0][m][0], acc[ai][0][m][1]), h1 = pack_v(acc[ai][1][m][0], acc[ai][1][m][1]);
                u32x4 snd, rcv, da, db;
                snd.x = odd ? h0.x : h1.x; snd.y = odd ? h0.y : h1.y; snd.z = odd ? h0.z : h1.z; snd.w = odd ? h0.w : h1.w;
                rcv.x = swp(snd.x); rcv.y = swp(snd.y); rcv.z = swp(snd.z); rcv.w = swp(snd.w);
                da.x = odd ? rcv.x : h0.x; da.y = odd ? rcv.y : h0.y; da.z = odd ? rcv.z : h0.z; da.w = odd ? rcv.w : h0.w;
                db.x = odd ? h1.x : rcv.x; db.y = odd ? h1.y : rcv.y; db.z = odd ? h1.z : rcv.z; db.w = odd ? h1.w : rcv.w;
                bf16_t* rp = pa + (size_t)(ai * HALF + m * 16) * ldc;
                *(u32x4*)(rp) = da; *(u32x4*)(rp + ldc) = db; }
    }
};
struct EpiGlu {
    static constexpr bool PERM = true, PERM2 = false, AFTER_DRAIN = false, BIAS_INIT = false;
    const bf16_t* Z; bf16_t* MIX; const float* bias;
    __device__ __forceinline__ void operator()(const f32x4 (&acc)[2][2][4][2], const Unit& u, int wr, int wc, int fr, int fq) const {
        const int row0 = u.pm * BM + wr * 64 + fr, col0 = u.pn * BM + wc * 32 + 8 * fq;
        f32x4 bv[2][2];
#pragma unroll
        for (int bj = 0; bj < 2; ++bj)
#pragma unroll
            for (int n = 0; n < 2; ++n) bv[bj][n] = *(const f32x4*)(bias + col0 + bj * HALF + 4 * n);
#pragma unroll
        for (int ai = 0; ai < 2; ++ai)
#pragma unroll
            for (int m = 0; m < 4; ++m) { const size_t row = (size_t)(row0 + ai * HALF + m * 16);
#pragma unroll
                for (int bj = 0; bj < 2; ++bj) {
                    const u32x4 zw = *(const u32x4*)(Z + row * SSM_W + col0 + bj * HALF); float z[8]; unpack8(zw, z);
                    const f32x4 a0 = acc[ai][bj][m][0] + bv[bj][0], a1 = acc[ai][bj][m][1] + bv[bj][1];
                    float o[8];
#pragma unroll
                    for (int j = 0; j < 4; ++j) { o[j] = z[j] * sigmoidf_(a0[j]); o[4 + j] = z[4 + j] * sigmoidf_(a1[j]); }
                    *(u32x4*)(MIX + row * D + 512 + col0 + bj * HALF) = pack8(o); } }
    }
};
struct EpiRope {
    static constexpr bool PERM = true, PERM2 = false, AFTER_DRAIN = false, BIAS_INIT = false;
    bf16_t* O; const f32x2* rope;
    __device__ __forceinline__ void operator()(const f32x4 (&acc)[2][2][4][2], const Unit& u, int wr, int wc, int fr, int fq) const {
        const int part = u.pn >> 2, tp = u.pn & 3;
        const int row0 = u.pm * BM + wr * 64 + fr, colb = part * 1024 + (4 * tp + wc) * 64 + 8 * fq;
        const float qs = part == 0 ? 0.125f * 1.4426950408889634f : 1.0f;
#pragma unroll
        for (int ai = 0; ai < 2; ++ai)
#pragma unroll
            for (int m = 0; m < 4; ++m) { const int row = row0 + ai * HALF + m * 16; bf16_t* rowp = O + (size_t)row * 3072 + colb;
                const f32x4 x1a = acc[ai][0][m][0], x1b = acc[ai][0][m][1], x2a = acc[ai][1][m][0], x2b = acc[ai][1][m][1];
                if (part < 2) {
                    const f32x4* rp = (const f32x4*)(rope + (size_t)seqpos(row) * 32 + 8 * fq);
                    const f32x4 c01 = rp[0], c23 = rp[1], c45 = rp[2], c67 = rp[3];
                    float o1[8], o2[8];
                    const float cs[8] = {c01[0], c01[2], c23[0], c23[2], c45[0], c45[2], c67[0], c67[2]}, sn[8] = {c01[1], c01[3], c23[1], c23[3], c45[1], c45[3], c67[1], c67[3]};
                    const float x1[8] = {x1a[0], x1a[1], x1a[2], x1a[3], x1b[0], x1b[1], x1b[2], x1b[3]}, x2[8] = {x2a[0], x2a[1], x2a[2], x2a[3], x2b[0], x2b[1], x2b[2], x2b[3]};
#pragma unroll
                    for (int j = 0; j < 8; ++j) { o1[j] = (x1[j] * cs[j] - x2[j] * sn[j]) * qs; o2[j] = (x2[j] * cs[j] + x1[j] * sn[j]) * qs; }
                    *(u32x4*)(rowp) = pack8(o1); *(u32x4*)(rowp + 32) = pack8(o2);
                } else { *(u32x4*)(rowp) = pack_v(x1a, x1b); *(u32x4*)(rowp + 32) = pack_v(x2a, x2b); } }
    }
};
struct EpiSwiglu {
    static constexpr bool PERM = true, PERM2 = false, AFTER_DRAIN = false, BIAS_INIT = true;
#ifdef PROBE_NOSTORE
    bool nostore = false;
#endif
    bf16_t* ACT; const PG8_LAS float* bias_lds;
    __device__ __forceinline__ void init_load(const Unit& u, int wc, int fq, f32x4 (&b)[4]) const {
        const PG8_LAS float* bb = bias_lds + u.ix * BM + wc * 32 + 8 * fq;
        b[0] = *(const PG8_LAS f32x4*)(bb); b[1] = *(const PG8_LAS f32x4*)(bb + 4); b[2] = *(const PG8_LAS f32x4*)(bb + 128); b[3] = *(const PG8_LAS f32x4*)(bb + 132);
    }
    static __device__ __forceinline__ void init_fill(f32x4 (&acc)[2][2][4][2], const f32x4 (&b)[4]) {
#pragma unroll
        for (int ai = 0; ai < 2; ++ai)
#pragma unroll
            for (int m = 0; m < 4; ++m) { acc[ai][0][m][0] = b[0]; acc[ai][0][m][1] = b[1]; acc[ai][1][m][0] = b[2]; acc[ai][1][m][1] = b[3]; }
    }
    __device__ __forceinline__ void init(f32x4 (&acc)[2][2][4][2], const Unit& u, int wc, int fq) const { f32x4 b[4]; init_load(u, wc, fq, b); init_fill(acc, b); }
    __device__ __forceinline__ void operator()(const f32x4 (&acc)[2][2][4][2], const Unit& u, int wr, int wc, int fr, int fq) const {
        const bool oq = (fq & 1) != 0;
        const int row0 = u.pm * BM + wr * 64 + fr, j0 = u.pn * 128 + wc * 32;
        unsigned char* ab = (unsigned char*)ACT + (size_t)(row0 >> 1) * (2 * D) + (j0 >> 5) * 64 + (fr & 1) * 32 + 16 * (fq >> 1);
#pragma unroll
        for (int ai = 0; ai < 2; ++ai)
#pragma unroll
            for (int mp = 0; mp < 2; ++mp) {
                u32x2 dd[2];
#pragma unroll
                for (int mm = 0; mm < 2; ++mm) { const int m = 2 * mp + mm;
                    const f32x4 g0 = acc[ai][0][m][0], g1 = acc[ai][0][m][1], l0 = acc[ai][1][m][0], l1 = acc[ai][1][m][1];
                    float o[8];
#pragma unroll
                    for (int j = 0; j < 4; ++j) {
                        const float ga = __builtin_amdgcn_fmed3f(g0[j], -3.0e38f, SW_LIMIT), gb = __builtin_amdgcn_fmed3f(g1[j], -3.0e38f, SW_LIMIT);
                        const float la = __builtin_amdgcn_fmed3f(l0[j], -SW_LIMIT, SW_LIMIT), lb = __builtin_amdgcn_fmed3f(l1[j], -SW_LIMIT, SW_LIMIT);
                        const float sa = ga * __builtin_amdgcn_rcpf(1.0f + __builtin_amdgcn_exp2f((-SW_ALPHA * 1.4426950408889634f) * ga)), sb = gb * __builtin_amdgcn_rcpf(1.0f + __builtin_amdgcn_exp2f((-SW_ALPHA * 1.4426950408889634f) * gb));
                        o[j] = fmaf(la, sa, sa); o[4 + j] = fmaf(lb, sb, sb); }
                    dd[mm] = pack8_fp8(o); }
                const unsigned sx = oq ? dd[0].x : dd[1].x, sy = oq ? dd[0].y : dd[1].y;
                const unsigned rx = (unsigned)swz_i<16>((int)sx), ry = (unsigned)swz_i<16>((int)sy);
                u32x4 w;
                if (!oq) { w.x = dd[0].x; w.y = dd[0].y; w.z = rx; w.w = ry; } else { w.x = rx; w.y = ry; w.z = dd[1].x; w.w = dd[1].y; }
                *(u32x4*)(ab + (size_t)(ai * (HALF / 2) + (2 * mp + (oq ? 1 : 0)) * 8) * (2 * D)) = w; }
    }
};
struct EpiDown {
    static constexpr bool PERM = true, PERM2 = true, AFTER_DRAIN = false, BIAS_INIT = true;
#ifdef PROBE_NOSTORE
    bool nostore = false;
#endif
    bf16_t* Y; const PG8_LAS float* bias_lds; const PG8_LAS float* gl_lds;
    __device__ __forceinline__ void init_load(const Unit& u, int wc, int fq, f32x4 (&b)[4]) const {
        const PG8_LAS float* bb = bias_lds + u.ix * BM + wc * 64 + 16 * fq;
        b[0] = *(const PG8_LAS f32x4*)(bb); b[1] = *(const PG8_LAS f32x4*)(bb + 4); b[2] = *(const PG8_LAS f32x4*)(bb + 8); b[3] = *(const PG8_LAS f32x4*)(bb + 12);
    }
    static __device__ __forceinline__ void init_fill(f32x4 (&acc)[2][2][4][2], const f32x4 (&b)[4]) {
#pragma unroll
        for (int ai = 0; ai < 2; ++ai)
#pragma unroll
            for (int m = 0; m < 4; ++m) { acc[ai][0][m][0] = b[0]; acc[ai][0][m][1] = b[1]; acc[ai][1][m][0] = b[2]; acc[ai][1][m][1] = b[3]; }
    }
    __device__ __forceinline__ void init(f32x4 (&acc)[2][2][4][2], const Unit& u, int wc, int fq) const { f32x4 b[4]; init_load(u, wc, fq, b); init_fill(acc, b); }
    __device__ __forceinline__ void operator()(const f32x4 (&acc)[2][2][4][2], const Unit& u, int wr, int wc, int fr, int fq) const {
        const int rl0 = wr * 64 + fr, col0 = u.pn * BM + wc * 64 + 16 * fq;
        const PG8_LAS float* gl = gl_lds + u.ix * BM + rl0;
        unsigned char* yb = (unsigned char*)Y + ((size_t)u.pm * BM + rl0) * D + col0;
#pragma unroll
        for (int ai = 0; ai < 2; ++ai)
#pragma unroll
            for (int m = 0; m < 4; ++m) { const int rl = ai * HALF + m * 16; const float gt = gl[rl] * Y8_SCALE;
                u32x4 w;
#pragma unroll
                for (int bj = 0; bj < 2; ++bj) { const f32x4 v0 = acc[ai][bj][m][0] * gt, v1 = acc[ai][bj][m][1] * gt;
                    const unsigned lo_ = pk4_fp8(v0[0], v0[1], v0[2], v0[3]), hi_ = pk4_fp8(v1[0], v1[1], v1[2], v1[3]);
                    if (bj == 0) { w.x = lo_; w.y = hi_; } else { w.z = lo_; w.w = hi_; } }
                *(u32x4*)(yb + (size_t)rl * D) = w; }
    }
};

template <class Epi, class Sched, bool ALIGN_EPI = false, bool SP2 = false, bool FP8 = false, int PROBE = 0>
__device__ __forceinline__ void gemm_phase(PG8_LAS unsigned char* lds, const Gemm g, const Sched& S, const Epi& E, int wave_, int scale_w = 127, int scale_x = 127) {
    int tid = wave_ * 64 + lane_id(); asm volatile("" : "+v"(tid)); const int wid = wave_, lane = tid & 63, wr = wid >> 2, wc = wid & 3, fr = lane & 15, fq = lane >> 4;
    const int K = g.K, nt = K / BK;
    unsigned voffA[2], voffB[2];
#pragma unroll
    for (int i = 0; i < 2; ++i) { int R, C; stage_rc(tid * 16 + i * 8192, R, C);
        const int Rb = Epi::PERM2 ? (64 * (R >> 5) + 16 * ((R & 15) >> 2) + 4 * ((R >> 4) & 1) + (R & 3)) : Epi::PERM ? ((R & ~31) + perm32(R & 31)) : R;
        if constexpr (Sched::A_PAIR2) voffA[i] = (unsigned)((R >> 1) * (4 * K) + ((2 * C) >> 5) * 64 + (R & 1) * 32 + ((2 * C) & 31)); else voffA[i] = (unsigned)(R * K + C) * 2u;
        voffB[i] = (unsigned)(Rb * K + C) * 2u; }
    unsigned gv[2] = {0u, 0u}, gn[2] = {0u, 0u}, gc2 = 0u;
    auto gather_unit = [&](int ui_, unsigned (&o)[2]) {
        if constexpr (Sched::GATHER) {
            int t_ = lane_id(); asm volatile("" : "+v"(t_)); t_ += wid * 64;
            int R, C; stage_rc(t_ * 16, R, C);
#pragma unroll
            for (int h = 0; h < 2; ++h) o[h] = S.list_id(ui_, h * HALF + R) | (S.list_id(ui_, h * HALF + R + 64) << 16);
        }
    };
    if constexpr (Sched::GATHER) { int R, C; stage_rc(tid * 16, R, C); gc2 = (unsigned)(C * 2); }
    const unsigned kstep = (unsigned)(BK * 2);
    const unsigned kstepA = Sched::A_PAIR2 ? 2u * kstep : kstep;
    const unsigned hstep = (unsigned)HALF * (unsigned)K * 2u;
    const unsigned hstepB = Epi::PERM2 ? 8u * (unsigned)K * 2u : hstep;
    const unsigned ldsw = (unsigned)wid * 1024u;
    const int aoff = lds_byte(wr * 64 + fr, fq * 8), boff = lds_byte(wc * 32 + fr, fq * 8);
#define PG8_SA(b, h) (((b) * 2 + (h)) * HTB)
#define PG8_SB(b, h) ((4 + (b) * 2 + (h)) * HTB)
#define PG8_STAGE(bufoff, gbase, voff) do { if constexpr (!(PROBE & 2)) _Pragma("unroll") for (int _i = 0; _i < 2; ++_i) \
        __builtin_amdgcn_raw_ptr_buffer_load_lds(rsrc_##voff, (PG8_LAS unsigned*)(lds + (bufoff) + ldsw + _i * 8192), 16, (voff)[_i], (gbase), 0, 0); } while (0)
#define PG8_STAGE_A(b, h, soff, NEXT) do { if constexpr (Sched::GATHER) { _Pragma("unroll") for (int _i = 0; _i < 2; ++_i) \
        { unsigned pk_ = (NEXT) ? gn[h] : gv[h]; asm volatile("" : "+v"(pk_)); const unsigned tk_ = _i ? (pk_ >> 16) : (pk_ & 0xffffu);     \
        __builtin_amdgcn_raw_ptr_buffer_load_lds(rsrc_voffA, (PG8_LAS unsigned*)(lds + PG8_SA(b, h) + ldsw + _i * 8192), 16, (tk_ << 10) | gc2, (soff), 0, 0); } } \
        else PG8_STAGE(PG8_SA(b, h), (soff) + (h) * hstep, voffA); } while (0)
#define PG8_LDA(dst, b, h) do { if constexpr ((PROBE & 16) != 0) { if constexpr (FP8) { asm volatile("" : "+v"(dst##8[0]), "+v"(dst##8[1]), "+v"(dst##8[2]), "+v"(dst##8[3])); } } else if constexpr (FP8) { _Pragma("unroll") for (int m = 0; m < 4; ++m) { const v4i_ lo_ = *(const PG8_LAS v4i_*)(lds + PG8_SA(b, h) + aoff + m * 2048), hi_ = *(const PG8_LAS v4i_*)(lds + PG8_SA(b, h) + aoff + m * 2048 + 1024); dst##8[m] = __builtin_shufflevector(lo_, hi_, 0, 1, 2, 3, 4, 5, 6, 7); } } \
        else { _Pragma("unroll") for (int m = 0; m < 4; ++m) _Pragma("unroll") for (int k = 0; k < 2; ++k) dst[m][k] = *(const PG8_LAS bf16x8*)(lds + PG8_SA(b, h) + aoff + m * 2048 + k * 1024); } } while (0)
#define PG8_LDB(dst, b, h) do { if constexpr ((PROBE & 8) != 0) { if constexpr (FP8) { asm volatile("" : "+v"(dst##8[0]), "+v"(dst##8[1])); } } else if constexpr (FP8) { _Pragma("unroll") for (int n = 0; n < 2; ++n) { const v4i_ lo_ = *(const PG8_LAS v4i_*)(lds + PG8_SB(b, h) + boff + n * 2048), hi_ = *(const PG8_LAS v4i_*)(lds + PG8_SB(b, h) + boff + n * 2048 + 1024); dst##8[n] = __builtin_shufflevector(lo_, hi_, 0, 1, 2, 3, 4, 5, 6, 7); } } \
        else { _Pragma("unroll") for (int n = 0; n < 2; ++n) _Pragma("unroll") for (int k = 0; k < 2; ++k) dst[n][k] = *(const PG8_LAS bf16x8*)(lds + PG8_SB(b, h) + boff + n * 2048 + k * 1024); } } while (0)
#define PG8_MMA(ai, bj, At, Bt) do { __builtin_amdgcn_s_setprio(1); _Pragma("unroll") for (int m = 0; m < 4; ++m) _Pragma("unroll") for (int n = 0; n < 2; ++n) { \
        if constexpr ((PROBE & 4) != 0) { if constexpr (FP8) asm volatile("" :: "v"(Bt##8[n]), "v"(At##8[m])); else asm volatile("" :: "v"(Bt[n][0]), "v"(At[m][0]), "v"(Bt[n][1]), "v"(At[m][1])); } else \
        if constexpr (FP8) acc[ai][bj][m][n] = __builtin_amdgcn_mfma_scale_f32_16x16x128_f8f6f4(Bt##8[n], At##8[m], acc[ai][bj][m][n], 0, 0, 0, scale_w, 0, scale_x); \
        else { _Pragma("unroll") for (int k = 0; k < 2; ++k) acc[ai][bj][m][n] = __builtin_amdgcn_mfma_f32_16x16x32_bf16(Bt[n][k], At[m][k], acc[ai][bj][m][n], 0, 0, 0); } } \
        __builtin_amdgcn_s_setprio(0); } while (0)
#define PG8_WAIT_V(n) asm volatile("s_waitcnt vmcnt(" #n ")" ::: "memory")
#define PG8_WAIT_L(n) asm volatile("s_waitcnt lgkmcnt(" #n ")" ::: "memory")
#define PG8_BAR __builtin_amdgcn_s_barrier()
#define PG8_SCHED __builtin_amdgcn_sched_barrier(0)
#define PG8_ACC_INIT(u_) do { if constexpr (Epi::BIAS_INIT && !(PROBE & 64)) { int tz_ = lane_id(); asm volatile("" : "+v"(tz_)); E.init(acc, u_, wc, (tz_ & 63) >> 4); } else { \
        _Pragma("unroll") for (int a = 0; a < 2; ++a) _Pragma("unroll") for (int b = 0; b < 2; ++b) _Pragma("unroll") for (int m = 0; m < 4; ++m) _Pragma("unroll") for (int n = 0; n < 2; ++n) acc[a][b][m][n] = (f32x4){0.f, 0.f, 0.f, 0.f}; } } while (0)
    Unit cur, nxt; int ui = 0;
    if (!S.next(0, cur)) return;
    f32x4 acc[2][2][4][2];
    typedef int v4i_ __attribute__((ext_vector_type(4))); typedef int v8i_ __attribute__((ext_vector_type(8)));
    bf16x8 At[4][2], B0[2][2], B1[2][2]; v8i_ At8[4], B08[2], B18[2];
    const auto rsrc_voffA = __builtin_amdgcn_make_buffer_rsrc((void*)g.A, 0, -1, 0x00020000), rsrc_voffB = __builtin_amdgcn_make_buffer_rsrc((void*)g.Bt, 0, -1, 0x00020000);
    unsigned cA = (unsigned)__builtin_amdgcn_readfirstlane((int)(unsigned)S.a_off(cur)), cB = (unsigned)__builtin_amdgcn_readfirstlane((int)(unsigned)S.b_off(cur));
    S.a_ready(cur);
    if constexpr (Sched::GATHER) { static_assert(BK * 2 == 128, "row offset 1 KiB = K * 2 bytes assumed below");
        gather_unit(0, gv); Unit n1_; if (S.next(1, n1_)) gather_unit(1, gn); else { gn[0] = gv[0]; gn[1] = gv[1]; }
        asm volatile("" : "+v"(gv[0]), "+v"(gv[1]), "+v"(gn[0]), "+v"(gn[1])); }
    PG8_ACC_INIT(cur);
    if constexpr (SP2) {
        PG8_STAGE(PG8_SB(0, 0), cB, voffB); PG8_STAGE(PG8_SB(0, 1), cB + hstepB, voffB); PG8_STAGE_A(0, 0, cA, false); PG8_STAGE_A(0, 1, cA, false);
        if (wr == 1) PG8_BAR;
        PG8_WAIT_V(2); PG8_BAR;
        PG8_STAGE(PG8_SB(1, 0), cB + kstep, voffB); PG8_STAGE_A(1, 0, cA + kstepA, false); PG8_STAGE(PG8_SB(1, 1), cB + hstepB + kstep, voffB);
        PG8_WAIT_V(6); PG8_BAR;
    } else {
        PG8_STAGE(PG8_SB(0, 0), cB, voffB); PG8_STAGE_A(0, 0, cA, false); PG8_STAGE(PG8_SB(0, 1), cB + hstepB, voffB); PG8_STAGE_A(0, 1, cA, false);
        if (wr == 1) PG8_BAR;
        PG8_WAIT_V(4); PG8_BAR;
        PG8_STAGE(PG8_SB(1, 0), cB + kstep, voffB); PG8_STAGE_A(1, 0, cA + kstepA, false); PG8_STAGE(PG8_SB(1, 1), cB + hstepB + kstep, voffB);
        PG8_WAIT_V(6); PG8_BAR;
    }
    for (;;) {
        const bool has_next = S.next(ui + 1, nxt);
        const unsigned nA = has_next ? (unsigned)__builtin_amdgcn_readfirstlane((int)(unsigned)S.a_off(nxt)) : cA, nB = has_next ? (unsigned)__builtin_amdgcn_readfirstlane((int)(unsigned)S.b_off(nxt)) : cB;
#pragma nounroll
        for (int t = 0; t < nt; t += 2) {
            const bool last = (t == nt - 2);
            const unsigned a1 = cA + (unsigned)(t + 1) * kstepA;
            const unsigned a2 = last ? nA : cA + (unsigned)(t + 2) * kstepA, b2 = last ? nB : cB + (unsigned)(t + 2) * kstep;
            const unsigned a3 = a2 + kstepA, b3 = b2 + kstep;
            if (last && has_next) S.a_ready(nxt);
            if constexpr (SP2) {
            PG8_LDB(B0, 0, 0); PG8_LDB(B1, 0, 1); PG8_SCHED; PG8_LDA(At, 0, 0); PG8_STAGE_A(1, 1, a1, false);
            PG8_WAIT_V(8); PG8_WAIT_L(0); PG8_BAR; PG8_MMA(0, 0, At, B0); PG8_MMA(0, 1, At, B1); PG8_BAR; PG8_SCHED;
            PG8_LDA(At, 0, 1); PG8_STAGE(PG8_SB(0, 0), b2, voffB); PG8_STAGE(PG8_SB(0, 1), b2 + hstepB, voffB); PG8_STAGE_A(0, 0, a2, last);
            PG8_WAIT_V(8); PG8_WAIT_L(0); PG8_BAR; PG8_MMA(1, 0, At, B0); PG8_MMA(1, 1, At, B1); PG8_BAR; PG8_SCHED;
            PG8_LDB(B0, 1, 0); PG8_LDB(B1, 1, 1); PG8_SCHED; PG8_LDA(At, 1, 0); PG8_STAGE_A(0, 1, a2, last);
            PG8_WAIT_V(8); PG8_WAIT_L(0); PG8_BAR; PG8_MMA(0, 0, At, B0); PG8_MMA(0, 1, At, B1); PG8_BAR; PG8_SCHED;
            PG8_LDA(At, 1, 1); PG8_STAGE(PG8_SB(1, 0), b3, voffB); PG8_STAGE(PG8_SB(1, 1), b3 + hstepB, voffB); PG8_STAGE_A(1, 0, a3, last);
            PG8_WAIT_V(8); PG8_WAIT_L(0); PG8_BAR; PG8_MMA(1, 0, At, B0); PG8_MMA(1, 1, At, B1); PG8_BAR; PG8_SCHED;
            } else {
            PG8_LDB(B0, 0, 0); PG8_SCHED; PG8_LDA(At, 0, 0); PG8_STAGE_A(1, 1, a1, false);
            PG8_WAIT_L(8); PG8_BAR; PG8_WAIT_L(0); PG8_MMA(0, 0, At, B0); PG8_BAR; PG8_SCHED;
            PG8_LDB(B1, 0, 1); PG8_STAGE(PG8_SB(0, 0), b2, voffB);
            PG8_BAR; PG8_WAIT_L(0); PG8_MMA(0, 1, At, B1); PG8_BAR;
            PG8_LDA(At, 0, 1); PG8_STAGE_A(0, 0, a2, last);
            PG8_BAR; PG8_WAIT_L(0); PG8_MMA(1, 0, At, B0); PG8_BAR; PG8_SCHED;
            PG8_STAGE(PG8_SB(0, 1), b2 + hstepB, voffB);
            PG8_WAIT_V(6); PG8_BAR; PG8_MMA(1, 1, At, B1); PG8_BAR;
            PG8_LDB(B0, 1, 0); PG8_SCHED; PG8_LDA(At, 1, 0); PG8_STAGE_A(0, 1, a2, last);
            PG8_WAIT_L(8); PG8_BAR; PG8_WAIT_L(0); PG8_MMA(0, 0, At, B0); PG8_BAR; PG8_SCHED;
            PG8_LDB(B1, 1, 1); PG8_STAGE(PG8_SB(1, 0), b3, voffB);
            PG8_BAR; PG8_WAIT_L(0); PG8_MMA(0, 1, At, B1); PG8_BAR;
            PG8_LDA(At, 1, 1); PG8_STAGE_A(1, 0, a3, last);
            PG8_BAR; PG8_WAIT_L(0); PG8_MMA(1, 0, At, B0); PG8_BAR; PG8_SCHED;
            PG8_STAGE(PG8_SB(1, 1), b3 + hstepB, voffB);
            PG8_WAIT_V(6); PG8_BAR; PG8_MMA(1, 1, At, B1); PG8_BAR;
            }
        }
        if constexpr (ALIGN_EPI) { if (wr == 0) PG8_BAR; }
        if constexpr (!Epi::AFTER_DRAIN) { int tz = lane_id(); asm volatile("" : "+v"(tz));
            if constexpr ((PROBE & 1) != 0) { _Pragma("unroll") for (int a = 0; a < 2; ++a) _Pragma("unroll") for (int b = 0; b < 2; ++b) _Pragma("unroll") for (int m = 0; m < 4; ++m) _Pragma("unroll") for (int n = 0; n < 2; ++n) asm volatile("" :: "v"(acc[a][b][m][n])); }
            else E(acc, cur, wr, wc, tz & 15, (tz & 63) >> 4); S.done(cur); }
        if (!has_next) break;
        if constexpr (Sched::GATHER) {
            gv[0] = gn[0]; gv[1] = gn[1]; }
        if constexpr (Sched::GATHER) { Unit n2_; if (S.next(ui + 2, n2_)) gather_unit(ui + 2, gn); asm volatile("" : "+v"(gn[0]), "+v"(gn[1])); }
        PG8_ACC_INIT(nxt);
        cur = nxt; cA = nA; cB = nB; ++ui;
        if constexpr (ALIGN_EPI) { if (wr == 1) PG8_BAR; }
    }
    PG8_WAIT_V(0);
    if constexpr (!ALIGN_EPI) { if (wr == 0) PG8_BAR; }
    PG8_BAR;
    if constexpr (Epi::AFTER_DRAIN) { E.fused(acc, cur, wr, wc, fr, fq, lds, wid, lane); S.done(cur); }
#undef PG8_SA
#undef PG8_SB
#undef PG8_ACC_INIT
#undef PG8_STAGE
#undef PG8_STAGE_A
#undef PG8_LDA
#undef PG8_LDB
#undef PG8_MMA
#undef PG8_WAIT_V
#undef PG8_WAIT_L
#undef PG8_BAR
#undef PG8_SCHED
}
}

template <int MODE>
__device__ __forceinline__ void transpose_item(const float* W, int K, int N, bf16_t* WT, LAS float* scr, int item, int lane) {
    const int nblk = N / 32, kb = item / nblk, nb = item % nblk, k0 = 64 * kb, n0 = 32 * nb;
    int dr = n0;
    if (MODE == 1) { const int j = n0 & 1023, half = n0 >> 10; dr = 256 * (j >> 7) + 128 * half + (j & 127); }
    if (MODE == 2) { const int part = n0 >> 10, c = n0 & 1023, head = c >> 6, half = (c >> 5) & 1; dr = part * 1024 + (head >> 2) * 256 + half * 128 + (head & 3) * 32; }
    float wv[32];
#pragma unroll
    for (int i = 0; i < 32; ++i) wv[i] = __builtin_nontemporal_load(W + (size_t)(k0 + 2 * i + (lane >> 5)) * N + n0 + (lane & 31));
#pragma unroll
    for (int i = 0; i < 32; ++i) scr[(2 * i + (lane >> 5)) * 33 + (lane & 31)] = wv[i];
    WAVE_SYNC();
    const int c = lane & 7;
#pragma unroll
    for (int j = 0; j < 4; ++j) { const int n = (lane >> 3) + 8 * j; const LAS float* s = scr + (8 * c) * 33 + n;
        u32x4 o; o.x = pk2(s[0 * 33], s[1 * 33]); o.y = pk2(s[2 * 33], s[3 * 33]); o.z = pk2(s[4 * 33], s[5 * 33]); o.w = pk2(s[6 * 33], s[7 * 33]);
        *(u32x4*)(WT + (size_t)(dr + n) * K + k0 + 8 * c) = o; }
    WAVE_SYNC();
}

template <int MODE>
__device__ __forceinline__ void transpose_item_fp8(const float* W, int K, int N, unsigned char* WT, LAS float* scr, int item, int lane, float scale) {
    const int nblk = N / 32, kb = item / nblk, nb = item % nblk, k0 = 64 * kb, n0 = 32 * nb;
    int dr = n0;
    if (MODE == 1) { const int j = n0 & 1023, half = n0 >> 10; dr = 256 * (j >> 7) + 128 * half + (j & 127); }
    const int rg = lane >> 3, c4 = lane & 7;
    f32x4 wv[8];
#pragma unroll
    for (int i = 0; i < 8; ++i) wv[i] = __builtin_nontemporal_load((const f32x4*)(W + (size_t)(k0 + 8 * i + rg) * N + n0 + 4 * c4));
#pragma unroll
    for (int i = 0; i < 8; ++i) *(LAS f32x4*)(scr + (8 * i + rg) * 36 + 4 * c4) = wv[i] * scale;
    WAVE_SYNC();
#pragma unroll
    for (int j = 0; j < 2; ++j) { const int n = lane & 31, c = (lane >> 5) + 2 * j; const LAS float* s = scr + (16 * c) * 36 + n;
        u32x4 o; o.x = pk4_fp8(s[0 * 36], s[1 * 36], s[2 * 36], s[3 * 36]); o.y = pk4_fp8(s[4 * 36], s[5 * 36], s[6 * 36], s[7 * 36]);
        o.z = pk4_fp8(s[8 * 36], s[9 * 36], s[10 * 36], s[11 * 36]); o.w = pk4_fp8(s[12 * 36], s[13 * 36], s[14 * 36], s[15 * 36]);
        *(u32x4*)(WT + (size_t)(dr + n) * K + k0 + 16 * c) = o; }
    WAVE_SYNC();
}

__device__ __forceinline__ const float* ld_ptr(volatile LAS unsigned long long* t, int k) {
    const unsigned long long v = t[k]; const unsigned lo = __builtin_amdgcn_readfirstlane((unsigned)v), hi = __builtin_amdgcn_readfirstlane((unsigned)(v >> 32));
    return (const float*)(const GAS float*)(((unsigned long long)hi << 32) | lo);
}
__device__ __forceinline__ void phase_prologue(const Ctx& X, volatile LAS unsigned long long* ptab) {
#define in_(k) ld_ptr(ptab, k)
    const float* a_re = in_(3); const float* a_im = in_(4); const float* log_dt = in_(5); const float* b_re = in_(6); const float* b_im = in_(7);
    float2* Abar = (float2*)(X.ws + WS_S5A); float2* Bbar = (float2*)(X.ws + WS_S5B); float2* rope = (float2*)(X.ws + WS_ROPE);
    const int gt = X.bid * NTHR + X.tid, NT = X.G * NTHR;
    for (int it = gt; it < 2 * SSM_G * SSM_P; it += NT) {
        const int ig = it >> 6;
        const double lam_re = fmin((double)a_re[it], -1e-4), lam_im = (double)a_im[it];
        const double dt = exp((double)log_dt[ig]);
        const double mag = exp(lam_re * dt), ang = lam_im * dt;
        const double abr = mag * cos(ang), abi = mag * sin(ang);
        const double nr = abr - 1.0, ni = abi, den = lam_re * lam_re + lam_im * lam_im;
        const double cr = (nr * lam_re + ni * lam_im) / den, ci = (ni * lam_re - nr * lam_im) / den;
        Abar[it] = make_float2((float)abr, (float)abi);
        for (int h = 0; h < SSM_H; ++h) {
            const double br = (double)b_re[it * 16 + h], bi = (double)b_im[it * 16 + h];
            Bbar[it * 16 + h] = make_float2((float)(cr * br - ci * bi), (float)(cr * bi + ci * br));
        }
    }
    for (int it = gt; it < SEQ * 32; it += NT) {
        const int pos = it >> 5, i = it & 31;
        const float inv = powf(10000.0f, -(float)i / 32.0f);
        const float ang = (float)pos * inv;
        rope[it] = make_float2((float)cos((double)ang), (float)sin((double)ang));
    }
    { const float* rw = in_(20); bf16_t* RWh = (bf16_t*)(X.ws + WS_RWH); bf16_t* RWl = (bf16_t*)(X.ws + WS_RWL);
      for (int it = gt; it < DEPTH * NE * D; it += NT) { const int k = it & 1023, e = (it >> 10) & 31, l = it >> 15;
          const float w = rw[((size_t)l * D + k) * NE + e]; const unsigned hb = f2bf(w); RWh[it] = (bf16_t)hb; RWl[it] = (bf16_t)f2bf(w - bf2f((bf16_t)hb)); } }
    { const float* x = in_(0); bf16_t* H0 = (bf16_t*)(X.ws + WS_H0);
      const size_t n8 = (size_t)T * D / 8;
      for (size_t i8 = (size_t)gt; i8 < n8; i8 += (size_t)NT) {
          const f32x4 a = *(const f32x4*)(x + i8 * 8), b = *(const f32x4*)(x + i8 * 8 + 4);
          u32x4 o; o.x = pk2(a[0], a[1]); o.y = pk2(a[2], a[3]); o.z = pk2(b[0], b[1]); o.w = pk2(b[2], b[3]);
          *(u32x4*)(H0 + i8 * 8) = o; } }
    LAS float* scr = (LAS float*)(X.lds + X.wave * 16384);
    const int gw = X.bid * NWAVES + X.wave, NGW = X.G * NWAVES;
    constexpr int I_GU = 16 * 64, I_DN = 16 * 32, I_IN = 16 * 64, I_GLU = 8 * 16, I_OUT = 16 * 32, I_QKV = 16 * 96, I_O = 16 * 32;
    constexpr int N_GU = 128 * I_GU, N_DN = 128 * I_DN, N_IN = 2 * I_IN, N_GLU = 2 * I_GLU, N_OUT = 2 * I_OUT, N_QKV = 2 * I_QKV, N_O = 2 * I_O;
    constexpr int NITEMS = N_GU + N_DN + N_IN + N_GLU + N_OUT + N_QKV + N_O;
    for (int it = gw; it < NITEMS; it += NGW) {
        int r = it;
        if (r < N_GU) { const int m = r / I_GU; transpose_item_fp8<1>(in_(22) + (size_t)m * D * 2048, D, 2048, (unsigned char*)(X.ws + WS_WGU + (size_t)m * 2048 * D), scr, r % I_GU, X.lane, (float)(1 << W8_SHIFT_GU)); continue; } r -= N_GU;
        if (r < N_DN) { const int m = r / I_DN; transpose_item_fp8<0>(in_(24) + (size_t)m * D * D, D, D, (unsigned char*)(X.ws + WS_WDN + (size_t)m * D * D), scr, r % I_DN, X.lane, (float)(1 << W8_SHIFT_DN)); continue; } r -= N_DN;
        if (r < N_IN) { const int m = r / I_IN; transpose_item<0>(in_(1) + (size_t)m * D * 2048, D, 2048, (bf16_t*)(X.ws + WS_WIN) + (size_t)m * 2048 * D, scr, r % I_IN, X.lane); continue; } r -= N_IN;
        if (r < N_GLU) { const int m = r / I_GLU; transpose_item<0>(in_(11) + (size_t)m * 512 * 512, 512, 512, (bf16_t*)(X.ws + WS_WGLU) + (size_t)m * 512 * 512, scr, r % I_GLU, X.lane); continue; } r -= N_GLU;
        if (r < N_OUT) { const int m = r / I_OUT; transpose_item<0>(in_(13) + (size_t)m * D * D, D, D, (bf16_t*)(X.ws + WS_WOUT) + (size_t)m * D * D, scr, r % I_OUT, X.lane); continue; } r -= N_OUT;
        if (r < N_QKV) { const int m = r / I_QKV; transpose_item<2>(in_(14) + (size_t)m * D * 3072, D, 3072, (bf16_t*)(X.ws + WS_WQKV) + (size_t)m * 3072 * D, scr, r % I_QKV, X.lane); continue; } r -= N_QKV;
        { const int m = r / I_O; transpose_item<0>(in_(15) + (size_t)m * D * D, D, D, (bf16_t*)(X.ws + WS_WO) + (size_t)m * D * D, scr, r % I_O, X.lane); }
    }
}

#undef in_
typedef float f32x4v __attribute__((ext_vector_type(4)));
template <int PASS>
__device__ __forceinline__ void phase_s5(const Ctx& X, int i, const bf16_t* proj, const float* conv_w, const float* c_re, const float* c_im, const float* d_skip, bf16_t* mix, bf16_t* Z, int probe = 0) {
    using pg8::bf16x8;
    if (PASS == 2 && !(probe & 1)) {
        const float* w = conv_w + (size_t)i * 3 * CONV_CH;
        const int c = X.lane * 8;
        float w0[8], w1[8], w2[8];
#pragma unroll
        for (int j = 0; j < 8; ++j) { w0[j] = w[0 * CONV_CH + c + j]; w1[j] = w[1 * CONV_CH + c + j]; w2[j] = w[2 * CONV_CH + c + j]; }
        const int gwv = X.bid * NWAVES + X.wave, NGWV = X.G * NWAVES;
        for (int run = gwv; run < T / 16; run += NGWV) {
            const int bt0 = run * 16, pos0 = seqpos(bt0);
            const bf16_t* pr = proj + (size_t)bt0 * 2048 + c;
            float p0[8], p1[8];
#pragma unroll
            for (int j = 0; j < 8; ++j) { p0[j] = 0.f; p1[j] = 0.f; }
            if (pos0 >= 2) {
                float a[8], b[8];
                unpack8(*(const u32x4*)(pr + 512 - 4096), a); unpack8(*(const u32x4*)(pr + 1024 - 4096), b);
#pragma unroll
                for (int j = 0; j < 8; ++j) p0[j] = a[j] * b[j];
                unpack8(*(const u32x4*)(pr + 512 - 2048), a); unpack8(*(const u32x4*)(pr + 1024 - 2048), b);
#pragma unroll
                for (int j = 0; j < 8; ++j) p1[j] = a[j] * b[j];
            }
#pragma unroll 4
            for (int k = 0; k < 16; ++k) {
                float gb[8], a[8], b[8], o[8];
                unpack8(*(const u32x4*)(pr + (size_t)k * 2048), gb); unpack8(*(const u32x4*)(pr + (size_t)k * 2048 + 512), a); unpack8(*(const u32x4*)(pr + (size_t)k * 2048 + 1024), b);
#pragma unroll
                for (int j = 0; j < 8; ++j) { const float p2 = a[j] * b[j];
                    float s = w2[j] * p2; s += w1[j] * p1[j]; s += w0[j] * p0[j];
                    o[j] = gb[j] * s; p0[j] = p1[j]; p1[j] = p2; }
                *(u32x4*)(mix + (size_t)(bt0 + k) * D + c) = pack8(o);
            }
        }
    }
    const int lane = X.lane, n16 = lane & 15, kq = lane >> 4;
    LAS float* BuT = (LAS float*)(X.lds + X.wave * 15360);
    LAS unsigned char* xsb = X.lds + X.wave * 15360 + 10240;
    const float2* Abar = (const float2*)(X.ws + WS_S5A); const float2* Bbar = (const float2*)(X.ws + WS_S5B);
    float2* Sst = (float2*)(X.ws + WS_S5S);
    const int gw = X.bid * NWAVES + X.wave, NGW = X.G * NWAVES;
    const int g = gw & 31, ig = i * 32 + g;
        const float2 A = Abar[ig * 64 + lane];
    bf16x8 bfr[8];
#pragma unroll
    for (int cb = 0; cb < 8; ++cb) {
        u32x4 w = (u32x4){0u, 0u, 0u, 0u};
        if (kq < 2) { const float2* bp = Bbar + ((size_t)(ig * 64 + 16 * (cb & 3) + n16)) * 16 + 8 * kq; float v[8];
#pragma unroll
            for (int j = 0; j < 8; ++j) { const float2 t2 = bp[j]; v[j] = cb < 4 ? t2.x : t2.y; }
            w = pack8(v); }
        bfr[cb] = __builtin_bit_cast(bf16x8, w);
    }
    bf16x8 cfr[4]; bf16x8 dfr;
    if (PASS == 2) {
#pragma unroll
        for (int ks = 0; ks < 4; ++ks) { const int p0 = 16 * ks + 4 * kq; const f32x4 cr = *(const f32x4*)(c_re + (size_t)(ig * 16 + n16) * 64 + p0), ci = *(const f32x4*)(c_im + (size_t)(ig * 16 + n16) * 64 + p0);
            u32x4 w; w.x = cvt_pk_bf16(cr[0], -ci[0]); w.y = cvt_pk_bf16(cr[1], -ci[1]); w.z = cvt_pk_bf16(cr[2], -ci[2]); w.w = cvt_pk_bf16(cr[3], -ci[3]); cfr[ks] = __builtin_bit_cast(bf16x8, w); }
        { const float dv = d_skip[ig * 16 + n16]; float v[8];
#pragma unroll
          for (int j = 0; j < 8; ++j) v[j] = (kq < 2 && 8 * kq + j == n16) ? dv : 0.f;
          dfr = __builtin_bit_cast(bf16x8, pack8(v)); }
    }
    u32x4 un8[8]; float2 xin_n = make_float2(0.f, 0.f);
#pragma unroll
    for (int q = 0; q < 8; ++q) un8[q] = (u32x4){0u, 0u, 0u, 0u};
    auto task_head = [&](int task_, float2& xin_) { const int c_ = (task_ >> 5) & 63, b_ = task_ >> 11;
        if (PASS == 2) xin_ = ((const float2*)(X.ws + WS_S5X))[((size_t)(b_ * 32 + g) * 64 + c_) * 64 + lane];
        if (kq < 2) { const bf16_t* up_ = proj + ((size_t)b_ * SEQ + (size_t)c_ * 128) * 2048 + 1536 + g * 16 + (size_t)n16 * 2048 + 8 * kq;
#pragma unroll
            for (int q = 0; q < 8; ++q) un8[q] = *(const u32x4*)(up_ + (size_t)q * 16 * 2048); } };
    if (!(probe & 2) && gw < BATCH * 64 * SSM_G) task_head(gw, xin_n);
    if (!(probe & 2))
    for (int task = gw; task < BATCH * 64 * SSM_G; task += NGW) {
        const int c = (task >> 5) & 63, b = task >> 11;
        float xr = 0.f, xi = 0.f;
        if (PASS == 2) { xr = xin_n.x; xi = xin_n.y; }
        const bf16_t* ub = proj + ((size_t)b * SEQ + (size_t)c * 128) * 2048 + 1536 + g * 16;
        bf16_t* zb = Z + ((size_t)b * SEQ + (size_t)c * 128) * SSM_W + g * 16;
        u32x4 uq[8];
#pragma unroll
        for (int q = 0; q < 8; ++q) uq[q] = un8[q];
        if (task + NGW < BATCH * 64 * SSM_G) task_head(task + NGW, xin_n);
#pragma nounroll
        for (int blk = 0; blk < 8; ++blk) {
            const bf16x8 ufr = __builtin_bit_cast(bf16x8, uq[0]);
#pragma unroll
            for (int q = 0; q < 7; ++q) uq[q] = uq[q + 1];
#pragma unroll
            for (int cb = 0; cb < 8; ++cb) {
                f32x4v acc = (f32x4v){0.f, 0.f, 0.f, 0.f};
                acc = __builtin_amdgcn_mfma_f32_16x16x32_bf16(ufr, bfr[cb], acc, 0, 0, 0);
                *(LAS f32x4v*)(BuT + (16 * cb + n16) * 20 + 4 * kq) = acc;
            }
            WAVE_SYNC();
#pragma unroll
            for (int k4 = 0; k4 < 4; ++k4) {
                const f32x4v br = *(const LAS f32x4v*)(BuT + lane * 20 + 4 * k4), bi = *(const LAS f32x4v*)(BuT + (64 + lane) * 20 + 4 * k4);
#pragma unroll
                for (int s = 0; s < 4; ++s) {
                    float nr = fmaf(-A.y, xi, fmaf(A.x, xr, br[s])); asm volatile("" : "+v"(nr));
                    float ni = fmaf(A.y, xr, fmaf(A.x, xi, bi[s])); asm volatile("" : "+v"(ni));
                    xr = nr; xi = ni;
                    if (PASS == 2) *(LAS unsigned*)(xsb + (4 * k4 + s) * 272 + lane * 4) = cvt_pk_bf16(xr, xi);
                }
            }
            if (PASS == 2) {
                WAVE_SYNC();
                f32x4v y = (f32x4v){0.f, 0.f, 0.f, 0.f};
                bf16x8 xa[4];
#pragma unroll
                for (int ks = 0; ks < 4; ++ks) xa[ks] = *(const LAS bf16x8*)(xsb + n16 * 272 + ks * 64 + kq * 16);
                WAVE_SYNC(); __builtin_amdgcn_sched_barrier(0);
#pragma unroll
                for (int ks = 0; ks < 4; ++ks) y = __builtin_amdgcn_mfma_f32_16x16x32_bf16(xa[ks], cfr[ks], y, 0, 0, 0);
                y = __builtin_amdgcn_mfma_f32_16x16x32_bf16(ufr, dfr, y, 0, 0, 0);
                asm volatile("" :: "v"(xa[0]), "v"(xa[1]), "v"(xa[2]), "v"(xa[3]), "v"(ufr));
#pragma unroll
                for (int q = 0; q < 4; ++q) zb[(size_t)(blk * 16 + 4 * kq + q) * SSM_W + n16] = (bf16_t)f2bf(gelu_tanh(y[q]));
            }
            WAVE_SYNC();
        }
        if (PASS == 1) Sst[((size_t)(b * 32 + g) * 64 + c) * 64 + lane] = make_float2(xr, xi);
    }
}

__device__ __forceinline__ void phase_s5_carry(const Ctx& X, int i) {
    const float2* Abar = (const float2*)(X.ws + WS_S5A); const float2* Sst = (const float2*)(X.ws + WS_S5S); float2* Xin = (float2*)(X.ws + WS_S5X);
    const int gw = X.bid * NWAVES + X.wave, NGW = X.G * NWAVES, lane = X.lane;
    for (int bg = gw; bg < BATCH * SSM_G; bg += NGW) {
        const float2 A = Abar[(i * 32 + (bg & 31)) * 64 + lane];
        float pr_ = A.x, pi_ = A.y;
#pragma unroll
        for (int q = 0; q < 7; ++q) { const float nr = pr_ * pr_ - pi_ * pi_, ni = 2.f * pr_ * pi_; pr_ = nr; pi_ = ni; }
        float xr = 0.f, xi = 0.f;
        const size_t base = (size_t)bg * 64 * 64 + lane;
#pragma unroll 8
        for (int c = 0; c < 64; ++c) {
            Xin[base + (size_t)c * 64] = make_float2(xr, xi);
            const float2 s = Sst[base + (size_t)c * 64];
            const float nr = pr_ * xr - pi_ * xi + s.x, ni = pr_ * xi + pi_ * xr + s.y; xr = nr; xi = ni;
        }
    }
}

typedef short v4i16_t __attribute__((ext_vector_type(4)));
typedef float f32x16 __attribute__((ext_vector_type(16)));
__device__ __forceinline__ v4i16_t vtr16(const LAS unsigned char* p) { return __builtin_amdgcn_ds_read_tr16_b64_v4i16((LAS v4i16_t*)p); }
template <int PASS>
__device__ __forceinline__ void phase_attn(const Ctx& X, const bf16_t* proj, bf16_t* att, bf16_t* ost, float2* ml) {
    using pg8::bf16x8;
    const int lane = X.lane, i32 = lane & 31, hi = lane >> 5;
    LAS unsigned char* vbuf = X.lds + X.wave * 16384;
    LAS unsigned char* kbuf = vbuf + 8192;
    const int gw = X.bid * NWAVES + X.wave, NGW = X.G * NWAVES;
    const float NEG = opaque_f(-3.0e38f); const int seqmax = opaque_i(SEQ - 1);
    const int vrd = ((lane >> 4) & 1) * 32 + (lane & 3) * 8 + (4 * hi + ((lane & 15) >> 2)) * 64;
    const bool xdeal = (X.G == 256);
    constexpr int NT = PASS == 0 ? 13 : 5, PD = 2, NR = 3;
    const int lrow = lane >> 3, lpc = lane & 7;
#pragma nounroll
    for (int it = 0; it < (xdeal ? 8 : (BATCH * NH * 256 + NGW - 1) / NGW); ++it) {
        const int task = xdeal ? (((it * 8 + (X.bid & 7)) << 8) | ((X.bid >> 3) * 8 + X.wave)) : (gw + it * NGW);
        if (task >= BATCH * NH * 256) break;
        const int QST = PASS == 0 ? 4 : 16;
        const int r = PASS == 0 ? (task & 3) : (task & 15), blk = PASS == 0 ? ((task >> 2) & 63) : ((task >> 4) & 15), hh = (task >> 8) & 15, b = task >> 12;
        const bf16_t* base = proj + (size_t)b * SEQ * 3072 + hh * 64;
        const int t0 = (PASS == 0 ? 128 : 512) * blk + r;
        bf16x8 qf[4];
        { const bf16_t* qp = base + (size_t)(t0 + QST * i32) * 3072 + 8 * hi;
#pragma unroll
          for (int d0 = 0; d0 < 4; ++d0) qf[d0] = *(const bf16x8*)(qp + 16 * d0); }
        float m_run = NEG, l_run = 0.f;
        f32x16 o0, o1;
#pragma unroll
        for (int q = 0; q < 16; ++q) { o0[q] = 0.f; o1[q] = 0.f; }
        const size_t srow = (size_t)(b * SEQ + t0 + QST * i32);
        if (PASS == 1) {
            const float2 mlv = ml[srow * NH + hh]; m_run = mlv.x; l_run = hi == 0 ? mlv.y : 0.f;
            const bf16_t* sp = ost + srow * D + hh * 64 + 4 * hi;
#pragma unroll
            for (int gq = 0; gq < 4; ++gq) { const u32x2 w0 = *(const u32x2*)(sp + 8 * gq), w1 = *(const u32x2*)(sp + 32 + 8 * gq);
                o0[4 * gq] = bf_lo(w0.x); o0[4 * gq + 1] = bf_hi(w0.x); o0[4 * gq + 2] = bf_lo(w0.y); o0[4 * gq + 3] = bf_hi(w0.y);
                o1[4 * gq] = bf_lo(w1.x); o1[4 * gq + 1] = bf_hi(w1.x); o1[4 * gq + 2] = bf_lo(w1.y); o1[4 * gq + 3] = bf_hi(w1.y); }
        }
#define AT_PAT(j) (PASS == 1 ? 0 : ((j) < 5 ? 0 : 1))
#define AT_KT(j) (PASS == 1 ? (j) : ((j) < 5 ? (j) : (j) - 5))
#define AT_DIL(j) (PASS == 1 ? 16 : (AT_PAT(j) == 0 ? 4 : 1))
#define AT_QS(j) (PASS == 1 ? 1 : (AT_PAT(j) == 0 ? 1 : 4))
#define AT_RR(j) (PASS == 1 ? r : (AT_PAT(j) == 0 ? r : 0))
        u32x4 kr[NR][4], vr[NR][4];
        auto issue = [&](int j, u32x4 (&kk)[4], u32x4 (&vv)[4]) {
            const int dil = AT_DIL(j), rr = AT_RR(j), Mt = (t0 - rr) / dil - 128 + 32 * AT_KT(j);
            auto keypos = [&](int M) { int p = dil * M + rr; p = p < 0 ? 0 : p; p = p > seqmax ? seqmax : p; return p; };
#pragma unroll
            for (int q = 0; q < 4; ++q) {
                const bf16_t* rp = base + (size_t)keypos(Mt + 8 * q + lrow) * 3072;
                kk[q] = *(const u32x4*)(rp + 1024 + 8 * (lpc ^ lrow));
                vv[q] = *(const u32x4*)(rp + 2048 + 8 * lpc);
            }
        };
#pragma unroll
        for (int j = 0; j < PD; ++j) issue(j, kr[j], vr[j]);
#pragma unroll
        for (int j = 0; j < NT; ++j) {
            if (j + PD < NT) issue(j + PD, kr[(j + PD) % NR], vr[(j + PD) % NR]);
            const int kt = AT_KT(j), dil = AT_DIL(j), rr = AT_RR(j), Mstart = (t0 - rr) / dil - 128, qi = AT_QS(j) * i32;
            f32x16 s;
#pragma unroll
            for (int q = 0; q < 16; ++q) s[q] = 0.f;
#pragma unroll
            for (int q = 0; q < 4; ++q) *(LAS u32x4*)(kbuf + (j & 1) * 4096 + q * 1024 + lane * 16) = kr[j % NR][q];
            bf16x8 kf[4];
#pragma unroll
            for (int d0 = 0; d0 < 4; ++d0) kf[d0] = *(const LAS bf16x8*)(kbuf + (j & 1) * 4096 + (i32 >> 3) * 1024 + (i32 & 7) * 128 + (((2 * d0 + hi) ^ (i32 & 7)) << 4));
#pragma unroll
            for (int d0 = 0; d0 < 4; ++d0) s = __builtin_amdgcn_mfma_f32_32x32x16_bf16(kf[d0], qf[d0], s, 0, 0, 0);
            const int hi_ = qi + 128 - 32 * kt; int lo = hi_ - 128; { const int nk = -(Mstart + 32 * kt); lo = lo > nk ? lo : nk; }
            const int rb = 4 * hi - lo; const unsigned span = (unsigned)(hi_ - lo);
            const bool any = hi_ >= lo;
            float tmax = NEG;
#pragma unroll
            for (int q = 0; q < 16; ++q) { const int rowc = (q & 3) + 8 * (q >> 2); const bool ok = any && ((unsigned)(rowc + rb) <= span) && (rowc + rb >= 0); s[q] = ok ? s[q] : NEG; tmax = fmaxf(tmax, s[q]); }
            tmax = fmaxf(tmax, bperm_f(lane ^ 32, tmax));
            const float m_new = fmaxf(m_run, tmax), sc = __builtin_amdgcn_exp2f(m_run - m_new);
            m_run = m_new;
            float ps = 0.f;
#pragma unroll
            for (int q = 0; q < 16; ++q) { s[q] = __builtin_amdgcn_exp2f(s[q] - m_new); ps += s[q]; }
            l_run = l_run * sc + ps;
#pragma unroll
            for (int q = 0; q < 16; ++q) { o0[q] *= sc; o1[q] *= sc; }
            u32x4 pw0, pw1;
            pw0.x = cvt_pk_bf16(s[0], s[1]); pw0.y = cvt_pk_bf16(s[2], s[3]); pw0.z = cvt_pk_bf16(s[4], s[5]); pw0.w = cvt_pk_bf16(s[6], s[7]);
            pw1.x = cvt_pk_bf16(s[8], s[9]); pw1.y = cvt_pk_bf16(s[10], s[11]); pw1.z = cvt_pk_bf16(s[12], s[13]); pw1.w = cvt_pk_bf16(s[14], s[15]);
            const bf16x8 pf0 = __builtin_bit_cast(bf16x8, pw0), pf1 = __builtin_bit_cast(bf16x8, pw1);
#pragma unroll
            for (int q = 0; q < 4; ++q) *(LAS u32x4*)(vbuf + (j & 1) * 4096 + ((lpc >> 2) * 2 + (q >> 1)) * 1024 + ((q & 1) * 8 + lrow) * 64 + (lpc & 3) * 16) = vr[j % NR][q];
            const LAS unsigned char* vb = vbuf + (j & 1) * 4096 + vrd;
#pragma unroll
            for (int dh = 0; dh < 2; ++dh) {
#pragma unroll
                for (int kg = 0; kg < 2; ++kg) {
                    const v4i16_t vlo = vtr16(vb + (dh * 2 + kg) * 1024), vhi = vtr16(vb + (dh * 2 + kg) * 1024 + 512);
                    const bf16x8 vf = (bf16x8){vlo[0], vlo[1], vlo[2], vlo[3], vhi[0], vhi[1], vhi[2], vhi[3]};
                    if (dh == 0) o0 = __builtin_amdgcn_mfma_f32_32x32x16_bf16(vf, kg == 0 ? pf0 : pf1, o0, 0, 0, 0);
                    else o1 = __builtin_amdgcn_mfma_f32_32x32x16_bf16(vf, kg == 0 ? pf0 : pf1, o1, 0, 0, 0);
                }
            }
        }
#undef AT_PAT
#undef AT_KT
#undef AT_DIL
#undef AT_QS
#undef AT_RR
        const float lt = l_run + bperm_f(lane ^ 32, l_run), rl = PASS == 1 ? 1.0f / lt : 1.0f;
        if (PASS == 0 && hi == 0) ml[srow * NH + hh] = make_float2(m_run, lt);
        bf16_t* op = (PASS == 1 ? att : ost) + srow * D + hh * 64 + 4 * hi;
#pragma unroll
        for (int gq = 0; gq < 4; ++gq) {
            u32x2 w0, w1;
            w0.x = cvt_pk_bf16(o0[4 * gq] * rl, o0[4 * gq + 1] * rl); w0.y = cvt_pk_bf16(o0[4 * gq + 2] * rl, o0[4 * gq + 3] * rl);
            w1.x = cvt_pk_bf16(o1[4 * gq] * rl, o1[4 * gq + 1] * rl); w1.y = cvt_pk_bf16(o1[4 * gq + 2] * rl, o1[4 * gq + 3] * rl);
            *(u32x2*)(op + 8 * gq) = w0; *(u32x2*)(op + 32 + 8 * gq) = w1;
        }
    }
}

__device__ __forceinline__ void phase_attn_coop1(const Ctx& X, const bf16_t* proj, bf16_t* att, const bf16_t* ost, const float2* ml) {
    using pg8::bf16x8;
    const int lane = X.lane, i32 = lane & 31, hi = lane >> 5, w = X.wave;
    LAS unsigned char* kimg = X.lds;
    LAS unsigned char* vimg = X.lds + 49152;
    const float NEG = opaque_f(-3.0e38f); const int seqmax = opaque_i(SEQ - 1);
    const int vrd = ((lane >> 4) & 1) * 32 + (lane & 3) * 8 + (4 * hi + ((lane & 15) >> 2)) * 64;
    const int lrow = X.tid >> 3, lpc = X.tid & 7;
    constexpr int NGRP = BATCH * NH * 32;
    const bool xdeal = (X.G == 256);
    const int ngi = xdeal ? 8 : (NGRP + X.G - 1) / X.G;
    auto group_of = [&](int it) { return xdeal ? (((it * 8 + (X.bid & 7)) << 5) | (X.bid >> 3)) : (X.bid + it * X.G); };
    u32x4 pk[6], pv[6];
    auto prefetch = [&](int grp) {
        const int half = grp & 1, r = (grp >> 1) & 15, hh = (grp >> 5) & 15, b = grp >> 9;
        const bf16_t* base = proj + (size_t)b * SEQ * 3072 + hh * 64;
#pragma unroll
        for (int i = 0; i < 6; ++i) {
            const int ridx = lrow + 64 * i, M = 32 * (8 * half - 4) + ridx;
            int p = 16 * M + r; p = p < 0 ? 0 : p; p = p > seqmax ? seqmax : p;
            const bf16_t* rp = base + (size_t)p * 3072;
            pk[i] = *(const u32x4*)(rp + 1024 + 8 * lpc); pv[i] = *(const u32x4*)(rp + 2048 + 8 * lpc);
        }
    };
    if (group_of(0) < NGRP) prefetch(group_of(0));
#pragma nounroll
    for (int it = 0; it < ngi; ++it) {
        const int grp = group_of(it);
        if (grp >= NGRP) break;
        const int half = grp & 1, r = (grp >> 1) & 15, hh = (grp >> 5) & 15, b = grp >> 9;
        __syncthreads();
#pragma unroll
        for (int i = 0; i < 6; ++i) {
            const int ridx = lrow + 64 * i, tl = ridx >> 5, row = ridx & 31;
            *(LAS u32x4*)(kimg + tl * 4096 + row * 128 + ((lpc ^ (row & 7)) << 4)) = pk[i];
            *(LAS u32x4*)(vimg + tl * 4096 + ((lpc >> 2) * 2 + (row >> 4)) * 1024 + (row & 15) * 64 + (lpc & 3) * 16) = pv[i];
        }
        __syncthreads();
        const int blk = 8 * half + w, t0 = 512 * blk + r;
        const bf16_t* base = proj + (size_t)b * SEQ * 3072 + hh * 64;
        bf16x8 qf[4];
        { const bf16_t* qp = base + (size_t)(t0 + 16 * i32) * 3072 + 8 * hi;
#pragma unroll
          for (int d0 = 0; d0 < 4; ++d0) qf[d0] = *(const bf16x8*)(qp + 16 * d0); }
        const size_t srow = (size_t)(b * SEQ + t0 + 16 * i32);
        float m_run, l_run; f32x16 o0, o1;
        { const float2 mlv = ml[srow * NH + hh]; m_run = mlv.x; l_run = hi == 0 ? mlv.y : 0.f;
          const bf16_t* sp = ost + srow * D + hh * 64 + 4 * hi;
#pragma unroll
          for (int gq = 0; gq < 4; ++gq) { const u32x2 w0 = *(const u32x2*)(sp + 8 * gq), w1 = *(const u32x2*)(sp + 32 + 8 * gq);
              o0[4 * gq] = bf_lo(w0.x); o0[4 * gq + 1] = bf_hi(w0.x); o0[4 * gq + 2] = bf_lo(w0.y); o0[4 * gq + 3] = bf_hi(w0.y);
              o1[4 * gq] = bf_lo(w1.x); o1[4 * gq + 1] = bf_hi(w1.x); o1[4 * gq + 2] = bf_lo(w1.y); o1[4 * gq + 3] = bf_hi(w1.y); } }
        { const int gn = it + 1 < ngi ? group_of(it + 1) : NGRP; if (gn < NGRP) prefetch(gn); }
        const int Mstart = 32 * blk - 128;
        auto qk = [&](int kt) { const LAS unsigned char* kt_ = kimg + (w + kt) * 4096; bf16x8 kf[4];
#pragma unroll
            for (int d0 = 0; d0 < 4; ++d0) kf[d0] = *(const LAS bf16x8*)(kt_ + i32 * 128 + (((2 * d0 + hi) ^ (i32 & 7)) << 4));
            f32x16 s;
#pragma unroll
            for (int q = 0; q < 16; ++q) s[q] = 0.f;
#pragma unroll
            for (int d0 = 0; d0 < 4; ++d0) s = __builtin_amdgcn_mfma_f32_32x32x16_bf16(kf[d0], qf[d0], s, 0, 0, 0);
            return s; };
        f32x16 s = qk(0);
#pragma unroll
        for (int kt = 0; kt < 5; ++kt) {
            const LAS unsigned char* vt_ = vimg + (w + kt) * 4096 + vrd;
            f32x16 sn;
            if (kt + 1 < 5) sn = qk(kt + 1);
            const int hi_ = i32 + 128 - 32 * kt; int lo = hi_ - 128; { const int nk = -(Mstart + 32 * kt); lo = lo > nk ? lo : nk; }
            const int rb = 4 * hi - lo; const unsigned span = (unsigned)(hi_ - lo);
            const bool any = hi_ >= lo;
            float tmax = NEG;
            if (kt >= 1 && kt <= 3 && Mstart + 32 * kt >= 0) {
#pragma unroll
                for (int q = 0; q < 16; ++q) tmax = fmaxf(tmax, s[q]);
            } else {
#pragma unroll
                for (int q = 0; q < 16; ++q) { const int rowc = (q & 3) + 8 * (q >> 2); const bool ok = any && ((unsigned)(rowc + rb) <= span) && (rowc + rb >= 0); s[q] = ok ? s[q] : NEG; tmax = fmaxf(tmax, s[q]); }
            }
            tmax = fmaxf(tmax, bperm_f(lane ^ 32, tmax));
            const float m_new = fmaxf(m_run, tmax), sc = __builtin_amdgcn_exp2f(m_run - m_new);
            m_run = m_new;
            float ps = 0.f;
#pragma unroll
            for (int q = 0; q < 16; ++q) { s[q] = __builtin_amdgcn_exp2f(s[q] - m_new); ps += s[q]; }
            l_run = l_run * sc + ps;
#pragma unroll
            for (int q = 0; q < 16; ++q) { o0[q] *= sc; o1[q] *= sc; }
            u32x4 pw0, pw1;
            pw0.x = cvt_pk_bf16(s[0], s[1]); pw0.y = cvt_pk_bf16(s[2], s[3]); pw0.z = cvt_pk_bf16(s[4], s[5]); pw0.w = cvt_pk_bf16(s[6], s[7]);
            pw1.x = cvt_pk_bf16(s[8], s[9]); pw1.y = cvt_pk_bf16(s[10], s[11]); pw1.z = cvt_pk_bf16(s[12], s[13]); pw1.w = cvt_pk_bf16(s[14], s[15]);
            const bf16x8 pf0 = __builtin_bit_cast(bf16x8, pw0), pf1 = __builtin_bit_cast(bf16x8, pw1);
#pragma unroll
            for (int dh = 0; dh < 2; ++dh) {
#pragma unroll
                for (int kg = 0; kg < 2; ++kg) {
                    const v4i16_t vlo = vtr16(vt_ + (dh * 2 + kg) * 1024), vhi = vtr16(vt_ + (dh * 2 + kg) * 1024 + 512);
                    const bf16x8 vf = (bf16x8){vlo[0], vlo[1], vlo[2], vlo[3], vhi[0], vhi[1], vhi[2], vhi[3]};
                    if (dh == 0) o0 = __builtin_amdgcn_mfma_f32_32x32x16_bf16(vf, kg == 0 ? pf0 : pf1, o0, 0, 0, 0);
                    else o1 = __builtin_amdgcn_mfma_f32_32x32x16_bf16(vf, kg == 0 ? pf0 : pf1, o1, 0, 0, 0);
                }
            }
            if (kt + 1 < 5) s = sn;
        }
        const float lt = l_run + bperm_f(lane ^ 32, l_run), rl = 1.0f / lt;
        bf16_t* op = att + srow * D + hh * 64 + 4 * hi;
#pragma unroll
        for (int gq = 0; gq < 4; ++gq) {
            u32x2 w0, w1;
            w0.x = cvt_pk_bf16(o0[4 * gq] * rl, o0[4 * gq + 1] * rl); w0.y = cvt_pk_bf16(o0[4 * gq + 2] * rl, o0[4 * gq + 3] * rl);
            w1.x = cvt_pk_bf16(o1[4 * gq] * rl, o1[4 * gq + 1] * rl); w1.y = cvt_pk_bf16(o1[4 * gq + 2] * rl, o1[4 * gq + 3] * rl);
            *(u32x2*)(op + 8 * gq) = w0; *(u32x2*)(op + 32 + 8 * gq) = w1;
        }
    }
    __syncthreads();
}

__device__ __forceinline__ void phase_attn_coop0(const Ctx& X, const bf16_t* proj, bf16_t* ost, float2* ml) {
    using pg8::bf16x8;
    const int lane = X.lane, i32 = lane & 31, hi = lane >> 5, w = X.wave;
    LAS unsigned char* vbuf = X.lds + w * 16384;
    LAS unsigned char* kbuf = vbuf + 8192;
    LAS unsigned char* kimg = X.lds;
    LAS unsigned char* vimg = X.lds + 53248;
    const float NEG = opaque_f(-3.0e38f); const int seqmax = opaque_i(SEQ - 1);
    const int vrd = ((lane >> 4) & 1) * 32 + (lane & 3) * 8 + (4 * hi + ((lane & 15) >> 2)) * 64;
    const int lrow = lane >> 3, lpc = lane & 7;
    constexpr int NGRP = BATCH * NH * 32;
    const bool xdeal = (X.G == 256);
    const int ngi = xdeal ? 8 : (NGRP + X.G - 1) / X.G;
    constexpr int PD = 2, NR = 3;
#pragma nounroll
    for (int it = 0; it < ngi; ++it) {
        const int grp = xdeal ? (((it * 8 + (X.bid & 7)) << 5) | (X.bid >> 3)) : (X.bid + it * X.G);
        if (grp >= NGRP) break;
        const int n0 = 2 * (grp & 31), hh = (grp >> 5) & 15, b = grp >> 9;
        const int r = w & 3, bq = w >> 2, blk = n0 + bq, t0 = 128 * blk + r;
        const bf16_t* base = proj + (size_t)b * SEQ * 3072 + hh * 64;
        __syncthreads();
        bf16x8 qf[4];
        { const bf16_t* qp = base + (size_t)(t0 + 4 * i32) * 3072 + 8 * hi;
#pragma unroll
          for (int d0 = 0; d0 < 4; ++d0) qf[d0] = *(const bf16x8*)(qp + 16 * d0); }
        float m_run = NEG, l_run = 0.f;
        f32x16 o0, o1;
#pragma unroll
        for (int q = 0; q < 16; ++q) { o0[q] = 0.f; o1[q] = 0.f; }
        const size_t srow = (size_t)(b * SEQ + t0 + 4 * i32);
#define AT_TILE(kf, Mstart_, kt_, qi_, VADDR, FULLOK) do { \
            f32x16 s; _Pragma("unroll") for (int q = 0; q < 16; ++q) s[q] = 0.f; \
            _Pragma("unroll") for (int d0 = 0; d0 < 4; ++d0) s = __builtin_amdgcn_mfma_f32_32x32x16_bf16(kf[d0], qf[d0], s, 0, 0, 0); \
            const int hi_ = (qi_) + 128 - 32 * (kt_); int lo = hi_ - 128; { const int nk = -((Mstart_) + 32 * (kt_)); lo = lo > nk ? lo : nk; } \
            const int rb = 4 * hi - lo; const unsigned span = (unsigned)(hi_ - lo); const bool any = hi_ >= lo; \
            float tmax = NEG; \
            if ((FULLOK) && (Mstart_) + 32 * (kt_) >= 0) { _Pragma("unroll") for (int q = 0; q < 16; ++q) tmax = fmaxf(tmax, s[q]); }     \
            else { _Pragma("unroll") for (int q = 0; q < 16; ++q) { const int rowc = (q & 3) + 8 * (q >> 2); const bool ok = any && ((unsigned)(rowc + rb) <= span) && (rowc + rb >= 0); s[q] = ok ? s[q] : NEG; tmax = fmaxf(tmax, s[q]); } } \
            tmax = fmaxf(tmax, bperm_f(lane ^ 32, tmax)); \
            const float m_new = fmaxf(m_run, tmax), sc = __builtin_amdgcn_exp2f(m_run - m_new); m_run = m_new; \
            float ps = 0.f; \
            _Pragma("unroll") for (int q = 0; q < 16; ++q) { s[q] = __builtin_amdgcn_exp2f(s[q] - m_new); ps += s[q]; } \
            l_run = l_run * sc + ps; \
            _Pragma("unroll") for (int q = 0; q < 16; ++q) { o0[q] *= sc; o1[q] *= sc; } \
            u32x4 pw0, pw1; \
            pw0.x = cvt_pk_bf16(s[0], s[1]); pw0.y = cvt_pk_bf16(s[2], s[3]); pw0.z = cvt_pk_bf16(s[4], s[5]); pw0.w = cvt_pk_bf16(s[6], s[7]); \
            pw1.x = cvt_pk_bf16(s[8], s[9]); pw1.y = cvt_pk_bf16(s[10], s[11]); pw1.z = cvt_pk_bf16(s[12], s[13]); pw1.w = cvt_pk_bf16(s[14], s[15]); \
            const bf16x8 pf0 = __builtin_bit_cast(bf16x8, pw0), pf1 = __builtin_bit_cast(bf16x8, pw1); \
            _Pragma("unroll") for (int dh = 0; dh < 2; ++dh) { _Pragma("unroll") for (int kg = 0; kg < 2; ++kg) { \
                const LAS unsigned char* va_ = VADDR(dh, kg); \
                const v4i16_t vlo = vtr16(va_), vhi = vtr16(va_ + 512); \
                const bf16x8 vf = (bf16x8){vlo[0], vlo[1], vlo[2], vlo[3], vhi[0], vhi[1], vhi[2], vhi[3]}; \
                if (dh == 0) o0 = __builtin_amdgcn_mfma_f32_32x32x16_bf16(vf, kg == 0 ? pf0 : pf1, o0, 0, 0, 0); \
                else o1 = __builtin_amdgcn_mfma_f32_32x32x16_bf16(vf, kg == 0 ? pf0 : pf1, o1, 0, 0, 0); } } \
        } while (0)
        {
            const int Mstart = (t0 - r) / 4 - 128;
            u32x4 kr[NR][4], vr[NR][4];
            auto issue = [&](int j, u32x4 (&kk)[4], u32x4 (&vv)[4]) {
                const int Mt = Mstart + 32 * j;
#pragma unroll
                for (int q = 0; q < 4; ++q) {
                    int p = 4 * (Mt + 8 * q + lrow) + r; p = p < 0 ? 0 : p; p = p > seqmax ? seqmax : p;
                    const bf16_t* rp = base + (size_t)p * 3072;
                    kk[q] = *(const u32x4*)(rp + 1024 + 8 * (lpc ^ lrow)); vv[q] = *(const u32x4*)(rp + 2048 + 8 * lpc);
                }
            };
#pragma unroll
            for (int j = 0; j < PD; ++j) issue(j, kr[j], vr[j]);
#pragma unroll
            for (int j = 0; j < 5; ++j) {
                if (j + PD < 5) issue(j + PD, kr[(j + PD) % NR], vr[(j + PD) % NR]);
#pragma unroll
                for (int q = 0; q < 4; ++q) *(LAS u32x4*)(kbuf + (j & 1) * 4096 + q * 1024 + lane * 16) = kr[j % NR][q];
                bf16x8 kf[4];
#pragma unroll
                for (int d0 = 0; d0 < 4; ++d0) kf[d0] = *(const LAS bf16x8*)(kbuf + (j & 1) * 4096 + (i32 >> 3) * 1024 + (i32 & 7) * 128 + (((2 * d0 + hi) ^ (i32 & 7)) << 4));
#pragma unroll
                for (int q = 0; q < 4; ++q) *(LAS u32x4*)(vbuf + (j & 1) * 4096 + ((lpc >> 2) * 2 + (q >> 1)) * 1024 + ((q & 1) * 8 + lrow) * 64 + (lpc & 3) * 16) = vr[j % NR][q];
#define AT_VP(dh, kg) (vbuf + (j & 1) * 4096 + vrd + ((dh) * 2 + (kg)) * 1024)
                AT_TILE(kf, Mstart, j, i32, AT_VP, false);
#undef AT_VP
            }
        }
        {
            __builtin_amdgcn_sched_barrier(0);
            u32x4 sh[13];
            const int p0 = 128 * (n0 - 1);
#pragma unroll
            for (int i = 0; i < 13; ++i) {
                const int e_ = X.tid + 512 * i; const bool isv = e_ >= 3328; const int ee = isv ? e_ - 3328 : e_;
                int p = p0 + (ee >> 3); p = p < 0 ? 0 : p; p = p > seqmax ? seqmax : p;
                sh[i] = *(const u32x4*)(base + (size_t)p * 3072 + (isv ? 2048 : 1024) + 8 * (ee & 7));
            }
            __syncthreads();
#pragma unroll
            for (int i = 0; i < 13; ++i) {
                const int e_ = X.tid + 512 * i; const bool isv = e_ >= 3328; const int ee = isv ? e_ - 3328 : e_, row = ee >> 3, pc = ee & 7;
                if (isv) *(LAS u32x4*)(vimg + (pc >> 2) * 26624 + row * 64 + (pc & 3) * 16) = sh[i];
                else *(LAS u32x4*)(kimg + row * 128 + ((pc ^ (row & 7)) << 4)) = sh[i];
            }
            __syncthreads();
            const int Mstart = t0 - 128, s0 = 128 * bq + r;
#pragma nounroll
            for (int kt = 0; kt < 8; ++kt) {
                const int R = s0 + 32 * kt + i32;
                bf16x8 kf[4];
#pragma unroll
                for (int d0 = 0; d0 < 4; ++d0) kf[d0] = *(const LAS bf16x8*)(kimg + R * 128 + (((2 * d0 + hi) ^ (R & 7)) << 4));
#define AT_VP(dh, kg) (vimg + (dh) * 26624 + (s0 + 32 * kt + 16 * (kg)) * 64 + vrd)
                AT_TILE(kf, Mstart, kt, 4 * i32, AT_VP, false);
#undef AT_VP
            }
        }
#undef AT_TILE
        const float lt = l_run + bperm_f(lane ^ 32, l_run);
        if (hi == 0) ml[srow * NH + hh] = make_float2(m_run, lt);
        bf16_t* op = ost + srow * D + hh * 64 + 4 * hi;
#pragma unroll
        for (int gq = 0; gq < 4; ++gq) {
            u32x2 w0, w1;
            w0.x = cvt_pk_bf16(o0[4 * gq], o0[4 * gq + 1]); w0.y = cvt_pk_bf16(o0[4 * gq + 2], o0[4 * gq + 3]);
            w1.x = cvt_pk_bf16(o1[4 * gq], o1[4 * gq + 1]); w1.y = cvt_pk_bf16(o1[4 * gq + 2], o1[4 * gq + 3]);
            *(u32x2*)(op + 8 * gq) = w0; *(u32x2*)(op + 32 + 8 * gq) = w1;
        }
    }
    __syncthreads();
}

__device__ __forceinline__ void phase_ln_router(const Ctx& X, int layer, const bf16_t* hin, const bf16_t* mixo, const float* g, const float* bta, const float* rb, bf16_t* h1, int cnt_layer, int probe = 0) {
    using pg8::bf16x8;
    LAS unsigned char* Ah = X.lds;
    LAS unsigned char* Al = X.lds + 65536;
    LAS float* P = (LAS float*)X.lds;
    LAS int* s_cnt = (LAS int*)(X.lds + TAB_OFF);
    LAS int* s_gb = s_cnt + 32;
    const int lane = X.lane, w = X.wave, tok = lane & 31, hi = lane >> 5;
    int* tok_e = (int*)(X.ws + WS_TOKE); int* tok_r = (int*)(X.ws + WS_TOKR); float* glist = (float*)(X.ws + WS_GLIST); unsigned char* XG8 = (unsigned char*)(X.ws + WS_XG); int* stok = (int*)(X.ws + WS_STOK);
    unsigned* cnt = X.ctl + CW_CNT + cnt_layer * 32 * 64;
    const float rbe = rb[tok]; const float ninf = opaque_f(-INFINITY);
    const auto rs_h = __builtin_amdgcn_make_buffer_rsrc((void*)hin, 0, -1, 0x00020000), rs_m = __builtin_amdgcn_make_buffer_rsrc((void*)mixo, 0, -1, 0x00020000);
#define LNA_LD(rs_, tokidx_, j_) __builtin_bit_cast(u32x4, __builtin_amdgcn_raw_buffer_load_b128(rs_, lane * 16, (tokidx_) * (D * 2) + (j_) * 1024, 0))
    { LAS float* gl = (LAS float*)(X.lds + 131072 + 3072); gl[X.tid] = g[X.tid]; gl[512 + X.tid] = g[512 + X.tid]; gl[1024 + X.tid] = bta[X.tid]; gl[1536 + X.tid] = bta[512 + X.tid]; }
    const int tb = X.bid * 128;
    if (tb < T) {
        u32x4 raw[4][4];
#pragma unroll
        for (int tl = 0; tl < 4; ++tl) { const int ti_ = __builtin_amdgcn_readfirstlane(tb + w * 4 + tl);
#pragma unroll
            for (int j = 0; j < 2; ++j) { raw[tl][2 * j] = LNA_LD(rs_h, ti_, j); raw[tl][2 * j + 1] = LNA_LD(rs_m, ti_, j); } }
#pragma nounroll
        for (int rnd = 0; rnd < 4; ++rnd) {
            __syncthreads();
            if (X.tid < 32) s_cnt[X.tid] = 0;
            const int t0 = tb + rnd * 32 + w * 4;
            int lane_o = lane; asm volatile("" : "+v"(lane_o));
            const int tok_o = lane_o & 31, hi_o = lane_o >> 5;
            float v[4][16]; u32x2 xo[4][2];
            int gl_o = 131072 + 3072; asm volatile("" : "+s"(gl_o)); const LAS float* g2 = (const LAS float*)(X.lds + gl_o); const LAS float* b2 = g2 + 1024;
#pragma unroll
            for (int tl = 0; tl < 4; ++tl) {
                const size_t rowo = (size_t)(t0 + tl) * D;
                float s = 0.f;
#pragma unroll
                for (int j = 0; j < 2; ++j) { float a[8], m[8]; unpack8(raw[tl][2 * j], a); unpack8(raw[tl][2 * j + 1], m);
#pragma unroll
                    for (int q = 0; q < 8; ++q) { v[tl][j * 8 + q] = DN_ALPHA * a[q] + m[q]; s += v[tl][j * 8 + q]; } }
                const float mean = wave_sum(s) * (1.f / D); float s2 = 0.f;
#pragma unroll
                for (int q = 0; q < 16; ++q) { v[tl][q] -= mean; s2 += v[tl][q] * v[tl][q]; }
                const float rstd = rsqrtf(wave_sum(s2) * (1.f / D) + opaque_f(LN_EPS));
#pragma unroll
                for (int j = 0; j < 2; ++j) { const f32x4 g0 = *(const LAS f32x4*)(g2 + j * 512 + lane * 8), g1 = *(const LAS f32x4*)(g2 + j * 512 + lane * 8 + 4), b0 = *(const LAS f32x4*)(b2 + j * 512 + lane * 8), b1 = *(const LAS f32x4*)(b2 + j * 512 + lane * 8 + 4);
#pragma unroll
                    for (int q = 0; q < 4; ++q) { v[tl][j * 8 + q] = v[tl][j * 8 + q] * rstd * g0[q] + b0[q]; v[tl][j * 8 + 4 + q] = v[tl][j * 8 + 4 + q] * rstd * g1[q] + b1[q]; } }
                xo[tl][0].x = pk4_fp8(v[tl][0], v[tl][1], v[tl][2], v[tl][3]); xo[tl][0].y = pk4_fp8(v[tl][4], v[tl][5], v[tl][6], v[tl][7]);
                xo[tl][1].x = pk4_fp8(v[tl][8], v[tl][9], v[tl][10], v[tl][11]); xo[tl][1].y = pk4_fp8(v[tl][12], v[tl][13], v[tl][14], v[tl][15]);
                const int tr = w * 4 + tl;
#pragma unroll
                for (int j = 0; j < 2; ++j) {
                    u32x4 oh, ol; float lo[8];
                    oh.x = cvt_pk_bf16(v[tl][j * 8 + 0], v[tl][j * 8 + 1]); oh.y = cvt_pk_bf16(v[tl][j * 8 + 2], v[tl][j * 8 + 3]); oh.z = cvt_pk_bf16(v[tl][j * 8 + 4], v[tl][j * 8 + 5]); oh.w = cvt_pk_bf16(v[tl][j * 8 + 6], v[tl][j * 8 + 7]);
                    float hf[8]; unpack8(oh, hf);
#pragma unroll
                    for (int q = 0; q < 8; ++q) lo[q] = v[tl][j * 8 + q] - hf[q];
                    ol = pack8(lo);
                    *(u32x4*)(h1 + rowo + j * 512 + lane * 8) = oh;
                    const int ch = ((lane_o + 64 * j) ^ (tr & 7)) << 4;
                    *(LAS u32x4*)(Ah + tr * 2048 + ch) = oh; *(LAS u32x4*)(Al + tr * 2048 + ch) = ol;
                }

            }
            if (rnd < 3) {
#pragma unroll
                for (int tl = 0; tl < 4; ++tl) { const int ti_ = __builtin_amdgcn_readfirstlane(t0 + 32 + tl);
#pragma unroll
                    for (int j = 0; j < 2; ++j) { raw[tl][2 * j] = LNA_LD(rs_h, ti_, j); raw[tl][2 * j + 1] = LNA_LD(rs_m, ti_, j); } } }
            bf16x8 wfh[8], wfl[8];
            { const bf16_t* rwh = (const bf16_t*)(X.ws + WS_RWH) + ((size_t)layer * NE + tok) * D + 128 * w + 8 * hi; const bf16_t* rwl = (const bf16_t*)(X.ws + WS_RWL) + ((size_t)layer * NE + tok) * D + 128 * w + 8 * hi;
#pragma unroll
              for (int i = 0; i < 8; ++i) { wfh[i] = *(const bf16x8*)(rwh + 16 * i); wfl[i] = *(const bf16x8*)(rwl + 16 * i); } }
            __syncthreads();
            f32x16 acc;
#pragma unroll
            for (int q = 0; q < 16; ++q) acc[q] = 0.f;
#pragma unroll
            for (int i = 0; i < 8; ++i) {
                const int ch = ((2 * (8 * w + i) + hi_o) ^ (tok_o & 7)) << 4;
                const bf16x8 bh = *(const LAS bf16x8*)(Ah + tok_o * 2048 + ch), bl = *(const LAS bf16x8*)(Al + tok_o * 2048 + ch);
                acc = __builtin_amdgcn_mfma_f32_32x32x16_bf16(wfh[i], bh, acc, 0, 0, 0);
                acc = __builtin_amdgcn_mfma_f32_32x32x16_bf16(wfl[i], bh, acc, 0, 0, 0);
                acc = __builtin_amdgcn_mfma_f32_32x32x16_bf16(wfh[i], bl, acc, 0, 0, 0);
            }
            __syncthreads();
#pragma unroll
            for (int q = 0; q < 16; ++q) P[(w * 32 + tok) * 33 + (q & 3) + 8 * (q >> 2) + 4 * hi] = acc[q];
            __syncthreads();
            float lg[4];
#pragma unroll
            for (int tl = 0; tl < 4; ++tl) { float a = 0.f;
#pragma unroll
                for (int ww = 0; ww < 4; ++ww) a += P[((hi * 4 + ww) * 32 + (w * 4 + tl)) * 33 + tok];
                a += bperm_f(lane_o ^ 32, a); lg[tl] = a + rbe; }
            const int e = tok;
            int my_e = 0; float my_g = 0.f;
#pragma unroll
            for (int tl = 0; tl < 4; ++tl) {
                float cur = lg[tl];
                float sv0 = 0.f, sv1 = 0.f, sv2 = 0.f, sv3 = 0.f; int si0 = 0, si1 = 0, si2 = 0, si3 = 0;
#pragma unroll
                for (int k = 0; k < 4; ++k) {
                    float bv = cur; int bi = e;
#define LNA_XS(o) { const float ov = swz_f<o>(bv); const int oi = swz_i<o>(bi); if (ov > bv || (ov == bv && oi < bi)) { bv = ov; bi = oi; } }
                    LNA_XS(1) LNA_XS(2) LNA_XS(4) LNA_XS(8) LNA_XS(16)
#undef LNA_XS
                    if (k == 0) { sv0 = bv; si0 = bi; } else if (k == 1) { sv1 = bv; si1 = bi; } else if (k == 2) { sv2 = bv; si2 = bi; } else { sv3 = bv; si3 = bi; }
                    if (e == bi) cur = ninf;
                }
                const float e1 = __expf(sv1 - sv0), e2 = __expf(sv2 - sv0), e3 = __expf(sv3 - sv0), inv = 1.f / (1.f + e1 + e2 + e3);
                if ((lane >> 2) == tl) { const int k = lane & 3; my_e = k == 0 ? si0 : k == 1 ? si1 : k == 2 ? si2 : si3; my_g = (k == 0 ? 1.f : k == 1 ? e1 : k == 2 ? e2 : e3) * inv; }
            }
            int my_lr = 0;
            if (lane < 16) my_lr = __hip_atomic_fetch_add(&s_cnt[my_e], 1, __ATOMIC_RELAXED, __HIP_MEMORY_SCOPE_WORKGROUP);
            __syncthreads();
            { int tid_o = X.tid; asm volatile("" : "+v"(tid_o));
#ifdef PROBE_LNA
              if (probe & 4) { if (tid_o < 32) s_gb[tid_o] = tb + rnd * 32; } else
#endif
              if (tid_o < 32) { const int c = s_cnt[tid_o]; s_gb[tid_o] = c ? (int)atomicAdd(cnt + tid_o * 64, (unsigned)c) : 0; } }
            __syncthreads();
            int my_r = 0;
            if (lane < 16) { my_r = s_gb[my_e] + my_lr; const int t = t0 + (lane >> 2); tok_e[t * 4 + (lane & 3)] = my_e; tok_r[t * 4 + (lane & 3)] = my_r; glist[(size_t)my_e * T + my_r] = my_g; stok[(size_t)my_e * T + my_r] = t; }
#ifdef PROBE_LNA
            if (!(probe & 1))
#endif
#pragma unroll
            for (int tl = 0; tl < 4; ++tl) {
                unsigned char* dst = XG8 + (size_t)(t0 + tl) * D + lane * 8;
                *(u32x2*)(dst) = xo[tl][0]; *(u32x2*)(dst + 512) = xo[tl][1]; }
        }
    }
}
#undef LNA_LD

__device__ __forceinline__ void load_tile_table(const Ctx& X, int layer, LAS int* tb) {
    __syncthreads();
    if (X.tid < 64) {
        const int c = X.tid < 32 ? (int)__hip_atomic_load(X.ctl + CW_CNT + (layer * 32 + X.tid) * 64, RLX_AGENT) : 0;
        const int tl = (c + 255) >> 8; int incl = tl;
#pragma unroll
        for (int o = 1; o < 32; o <<= 1) { const int t = bperm_i(X.lane - o, incl); if ((X.tid & 31) >= o) incl += t; }
        if (X.tid < 32) { tb[X.tid] = incl - tl; if (X.tid == 31) tb[32] = incl; }
    }
    __syncthreads();
}

template <bool OUT_F32>
__device__ __forceinline__ void phase_combine_ln(const Ctx& X, int layer, const bf16_t* h1, const bf16_t* Y, const float* g, const float* bta, void* outp) {
    const int lane = X.lane;
    const int gw = X.bid * NWAVES + X.wave, NGW = X.G * NWAVES;
    const int* tok_e = (const int*)(X.ws + WS_TOKE); const int* tok_r = (const int*)(X.ws + WS_TOKR);
    int basev = 0;
    { const int c = lane < 32 ? (int)__hip_atomic_load(X.ctl + CW_CNT + (layer * 32 + lane) * 64, RLX_AGENT) : 0; const int pc = ((c + 255) >> 8) << 8; int incl = pc;
#pragma unroll
      for (int o = 1; o < 32; o <<= 1) { const int t = bperm_i(lane - o, incl); if ((lane & 31) >= o) incl += t; }
      basev = incl - pc; }
    float gg[16], bb[16];
#pragma unroll
    for (int j = 0; j < 2; ++j) {
        const f32x4 g0 = *(const f32x4*)(g + j * 512 + lane * 8), g1 = *(const f32x4*)(g + j * 512 + lane * 8 + 4), b0 = *(const f32x4*)(bta + j * 512 + lane * 8), b1 = *(const f32x4*)(bta + j * 512 + lane * 8 + 4);
#pragma unroll
        for (int q = 0; q < 4; ++q) { gg[j * 8 + q] = g0[q]; gg[j * 8 + 4 + q] = g1[q]; bb[j * 8 + q] = b0[q]; bb[j * 8 + 4 + q] = b1[q]; }
    }
    int nslot = 0, ne_ = 0;
    if (gw < T && lane < 4) { nslot = tok_r[gw * 4 + lane]; ne_ = tok_e[gw * 4 + lane]; }
    for (int bt = gw; bt < T; bt += NGW) {
        int myslot = nslot; const int mye = ne_;
        nslot = 0; ne_ = 0;
        if (bt + NGW < T && lane < 4) { nslot = tok_r[(bt + NGW) * 4 + lane]; ne_ = tok_e[(bt + NGW) * 4 + lane]; }
        myslot += bperm_i(mye, basev);
        const int s0 = bperm_i(0, myslot), s1 = bperm_i(1, myslot), s2 = bperm_i(2, myslot), s3 = bperm_i(3, myslot);
        float v[16]; float s = 0.f;
#pragma unroll
        for (int j = 0; j < 2; ++j) {
            const int off = j * 512 + lane * 8;
            float a[8], y0[8], y1[8], y2[8], y3[8];
            unpack8(*(const u32x4*)(h1 + (size_t)bt * D + off), a);
            const unsigned char* Y8 = (const unsigned char*)Y;
            unpack8_fp8(*(const u32x2*)(Y8 + (size_t)s0 * D + off), y0); unpack8_fp8(*(const u32x2*)(Y8 + (size_t)s1 * D + off), y1); unpack8_fp8(*(const u32x2*)(Y8 + (size_t)s2 * D + off), y2); unpack8_fp8(*(const u32x2*)(Y8 + (size_t)s3 * D + off), y3);
#pragma unroll
            for (int q = 0; q < 8; ++q) { v[j * 8 + q] = DN_ALPHA * a[q] + (((y0[q] + y1[q]) + y2[q]) + y3[q]) * (1.0f / Y8_SCALE); s += v[j * 8 + q]; }
        }
        const float mean = wave_sum(s) * (1.f / D); float s2q = 0.f;
#pragma unroll
        for (int q = 0; q < 16; ++q) { v[q] -= mean; s2q += v[q] * v[q]; }
        const float rstd = rsqrtf(wave_sum(s2q) * (1.f / D) + opaque_f(LN_EPS));
#pragma unroll
        for (int q = 0; q < 16; ++q) v[q] = v[q] * rstd * gg[q] + bb[q];
#pragma unroll
        for (int j = 0; j < 2; ++j) {
            const size_t o = (size_t)bt * D + j * 512 + lane * 8;
            if (OUT_F32) { float* op = (float*)outp + o; *(f32x4*)(op) = (f32x4){v[j * 8 + 0], v[j * 8 + 1], v[j * 8 + 2], v[j * 8 + 3]}; *(f32x4*)(op + 4) = (f32x4){v[j * 8 + 4], v[j * 8 + 5], v[j * 8 + 6], v[j * 8 + 7]}; }
            else { u32x4 w; w.x = cvt_pk_bf16(v[j * 8 + 0], v[j * 8 + 1]); w.y = cvt_pk_bf16(v[j * 8 + 2], v[j * 8 + 3]); w.z = cvt_pk_bf16(v[j * 8 + 4], v[j * 8 + 5]); w.w = cvt_pk_bf16(v[j * 8 + 6], v[j * 8 + 7]); *(u32x4*)((bf16_t*)outp + o) = w; }
        }
    }
}


__device__ __forceinline__ Ctx refresh_ctx(const Ctx& X0) {
    Ctx X = X0; int wv = X0.wave; asm volatile("" : "+s"(wv)); int t = wv * 64 + lane_id(); asm volatile("" : "+v"(t)); X.tid = t; X.lane = t & 63; X.wave = wv;
    asm volatile("" : "+s"(X.ws), "+s"(X.ctl), "+s"(X.G), "+s"(X.bid));
    return X;
}
#ifndef STAG
#define STAG 0
#endif
__device__ __forceinline__ void stagger(const Ctx& X) { const int n = ((X.bid >> 3) & 31) * STAG;
#pragma nounroll
    for (int i = 0; i < n; ++i) __builtin_amdgcn_s_sleep(1); }
struct Args { const float* in[26]; float* out; unsigned char* ws; int ph_lo, ph_hi; };
constexpr int N_PHASES = 1 + 2 * (6 + 4) + 2 * (4 + 4);
#define GP_ALIGN true
#define GP_SP2 true

__global__ void __launch_bounds__(NTHR, 2) mk_fwd(Args args) {
    extern __shared__ __attribute__((aligned(16))) unsigned char lds_raw[];
    Ctx X0;
    X0.lds = (LAS unsigned char*)lds_raw;
    X0.tid = threadIdx.x; X0.lane = X0.tid & 63; X0.wave = __builtin_amdgcn_readfirstlane(X0.tid >> 6);
    X0.G = gridDim.x; X0.bid = blockIdx.x;
    X0.ws = (GAS unsigned char*)args.ws; X0.ctl = (unsigned*)(args.ws + WS_CTL);
    volatile LAS unsigned* MISC = (volatile LAS unsigned*)(X0.lds + MISC_OFF);
    if (X0.tid < 32) MISC[X0.tid] = 0u;
    __syncthreads();
    XcdBarrier bar; bar.bar = X0.ctl + CW_BAR; bar.x = 0; bar.st = nullptr; bar.wave = X0.wave;
    if (MK_ONE_LAUNCH) bar = xcd_barrier_post(X0.ctl + CW_BAR, MISC + 8, X0.wave);
    volatile LAS unsigned long long* ptab = (volatile LAS unsigned long long*)(X0.lds + TAB_OFF + 1024);
    if (X0.tid < 26) ptab[X0.tid] = (unsigned long long)args.in[X0.tid];
    __syncthreads();
#define INP(k) ld_ptr(ptab, k)
    const int lo = args.ph_lo, hi = args.ph_hi;
    int ph = 0;
#define IN() (lo <= ph && ph < hi)
#define SEAM() do { if (MK_ONE_LAUNCH && lo <= ph && ph + 1 < hi) xcd_barrier(bar); ++ph; } while (0)

#define H0 ((bf16_t*)(X.ws + WS_H0))
#define H1 ((bf16_t*)(X.ws + WS_H1))
#define PROJ ((bf16_t*)(X.ws + WS_PROJ))
#define MIX ((bf16_t*)(X.ws + WS_MIX))
#define MIXO ((bf16_t*)(X.ws + WS_MIXO))
#define Z ((bf16_t*)(X.ws + WS_Z))
#define ACT ((bf16_t*)(X.ws + WS_ACT))
#define Y ((bf16_t*)(X.ws + WS_Y))
#define tb ((LAS int*)(X.lds + TAB_OFF + 512))

#ifndef DUP_MASK
#define DUP_MASK 0
#endif
    enum { P_PRO, P_E1, P_S5A, P_S5C, P_S5B, P_E3, P_E4, P_O1, P_ATT, P_O3, P_LNA, P_M1, P_M2, P_LNB, P_ATT1 };
#define PHASE_BEGIN(k) _Pragma("nounroll") for (int _r = 0; _r < ((((DUP_MASK) >> (k)) & 1) + 1); ++_r) { if (IN()) { const Ctx X = refresh_ctx(X0);
#define PHASE_END } SEAM(); }
    PHASE_BEGIN(P_PRO)  phase_prologue(X, ptab);  PHASE_END

#pragma nounroll
    for (int layer = 0; layer < DEPTH; ++layer) {
        const int i = layer >> 1;
        if ((layer & 1) == 0) {
            PHASE_BEGIN(P_E1)  pg8::Gemm gm{H0, (const bf16_t*)(X.ws + WS_WIN) + (size_t)i * 2048 * D, T, 2048, D}; pg8::StaticOrder S; S.init(T, 2048, D, X.G, X.bid);
                pg8::EpiStore E{PROJ, 2048};
                pg8::gemm_phase<pg8::EpiStore, pg8::StaticOrder, GP_ALIGN, GP_SP2>(X.lds, gm, S, E, X.wave);  PHASE_END
            PHASE_BEGIN(P_S5A)  phase_s5<1>(X, i, PROJ, INP(2), INP(8), INP(9), INP(10), MIX, Z);  PHASE_END
            PHASE_BEGIN(P_S5C)  phase_s5_carry(X, i);  PHASE_END
#ifdef PROBE_S5B
            PHASE_BEGIN(P_S5B)  phase_s5<2>(X, i, PROJ, INP(2), INP(8), INP(9), INP(10), MIX, Z, _r == 0 ? opaque_i(PROBE_S5B) : 0);  PHASE_END
#else
            PHASE_BEGIN(P_S5B)  phase_s5<2>(X, i, PROJ, INP(2), INP(8), INP(9), INP(10), MIX, Z);  PHASE_END
#endif
            PHASE_BEGIN(P_E3)  pg8::Gemm gm{Z, (const bf16_t*)(X.ws + WS_WGLU) + (size_t)i * 512 * 512, T, 512, 512}; pg8::StaticOrder S; S.init(T, 512, 512, X.G, X.bid);
                pg8::EpiGlu E{Z, MIX, INP(12) + (size_t)i * SSM_W};
                pg8::gemm_phase<pg8::EpiGlu, pg8::StaticOrder, GP_ALIGN, GP_SP2>(X.lds, gm, S, E, X.wave);  PHASE_END
            PHASE_BEGIN(P_E4)  pg8::Gemm gm{MIX, (const bf16_t*)(X.ws + WS_WOUT) + (size_t)i * D * D, T, D, D}; pg8::StaticOrder S; S.init(T, D, D, X.G, X.bid);
                pg8::EpiStore E{MIXO, D};
                pg8::gemm_phase<pg8::EpiStore, pg8::StaticOrder, GP_ALIGN, GP_SP2>(X.lds, gm, S, E, X.wave);  PHASE_END
        } else {
            PHASE_BEGIN(P_O1)  pg8::Gemm gm{H0, (const bf16_t*)(X.ws + WS_WQKV) + (size_t)i * 3072 * D, T, 3072, D}; pg8::StaticOrder S; S.init(T, 3072, D, X.G, X.bid);
                pg8::EpiRope E{PROJ, (const f32x2*)(X.ws + WS_ROPE)};
#if defined(PROBE_O1)
                if (_r == 0) pg8::gemm_phase<pg8::EpiRope, pg8::StaticOrder, GP_ALIGN, GP_SP2, false, PROBE_O1>(X.lds, gm, S, E, X.wave); else
#endif
                pg8::gemm_phase<pg8::EpiRope, pg8::StaticOrder, GP_ALIGN, GP_SP2>(X.lds, gm, S, E, X.wave);  PHASE_END
            PHASE_BEGIN(P_ATT)  phase_attn_coop0(X, PROJ, MIXO, (float2*)(X.ws + WS_S5X));  PHASE_END
            PHASE_BEGIN(P_ATT1)  phase_attn_coop1(X, PROJ, MIX, MIXO, (const float2*)(X.ws + WS_S5X));  PHASE_END
            PHASE_BEGIN(P_O3)  pg8::Gemm gm{MIX, (const bf16_t*)(X.ws + WS_WO) + (size_t)i * D * D, T, D, D}; pg8::StaticOrder S; S.init(T, D, D, X.G, X.bid);
                pg8::EpiStore E{MIXO, D};
                pg8::gemm_phase<pg8::EpiStore, pg8::StaticOrder, GP_ALIGN, GP_SP2>(X.lds, gm, S, E, X.wave);  PHASE_END
        }
#ifdef PROBE_LNA
        PHASE_BEGIN(P_LNA)  phase_ln_router(X, layer, H0, MIXO, INP(16) + layer * D, INP(17) + layer * D, INP(21) + layer * NE, H1, _r == 0 ? layer + 4 : layer, _r == 0 ? opaque_i(PROBE_LNA) : 0);  PHASE_END
#else
        PHASE_BEGIN(P_LNA)  phase_ln_router(X, layer, H0, MIXO, INP(16) + layer * D, INP(17) + layer * D, INP(21) + layer * NE, H1, layer);  PHASE_END
#endif
        PHASE_BEGIN(P_M1)  load_tile_table(X, layer, tb);
            pg8::Gemm gm{(const bf16_t*)(X.ws + WS_XG), (const bf16_t*)(X.ws + WS_WGU + (size_t)layer * NE * 2048 * D), 0, 2048, D / 2};
            pg8::MoeOrder<8, true> S; S.init(tb, X.G, X.bid, 2048, D / 2); S.stok = (const int*)(X.ws + WS_STOK); S.cnt = X.ctl + CW_CNT + layer * 32 * 64; S.preload_ids((LAS unsigned short*)(X.lds + 131072 + 3072), X.tid, X.wave);
            stagger(X);
#ifdef PROBE_NOSTORE
            pg8::EpiSwiglu E{opaque_i(((DUP_MASK >> P_M1) & 1) && _r == 0) != 0, ACT, INP(23) + (size_t)layer * NE * 2048};
#else
            S.preload_bias<9, true>((LAS float*)(X.lds + 131072 + 3072 + 9216), INP(23) + (size_t)layer * NE * 2048, X.tid, X.wave);
            pg8::EpiSwiglu E{ACT, (const LAS float*)(X.lds + 131072 + 3072 + 9216)};
#endif
#if defined(PROBE_M1)
            if (_r == 0) pg8::gemm_phase<pg8::EpiSwiglu, pg8::MoeOrder<8, true>, GP_ALIGN, GP_SP2, true, PROBE_M1>(X.lds, gm, S, E, X.wave, opaque_i(127 - W8_SHIFT_GU), opaque_i(127)); else
#endif
            pg8::gemm_phase<pg8::EpiSwiglu, pg8::MoeOrder<8, true>, GP_ALIGN, GP_SP2, true>(X.lds, gm, S, E, X.wave, opaque_i(127 - W8_SHIFT_GU), opaque_i(127));  PHASE_END
        PHASE_BEGIN(P_M2)  load_tile_table(X, layer, tb);
            pg8::Gemm gm{ACT, (const bf16_t*)(X.ws + WS_WDN + (size_t)layer * NE * D * D), 0, D, D / 2};
            pg8::MoeOrder<4, false> S; S.init(tb, X.G, X.bid, D, D / 2); S.stok = nullptr; S.cnt = nullptr; S.idl = nullptr;
            stagger(X);
#ifdef PROBE_NOSTORE
            pg8::EpiDown E{opaque_i(((DUP_MASK >> P_M2) & 1) && _r == 0) != 0, Y, INP(25) + (size_t)layer * NE * D, (const float*)(X.ws + WS_GLIST)};
#else
            S.preload_gates((LAS float*)(X.lds + 131072 + 3072), (const float*)(X.ws + WS_GLIST), X.tid, X.wave);
            S.preload_bias<5, false>((LAS float*)(X.lds + 131072 + 3072 + 10240), INP(25) + (size_t)layer * NE * D, X.tid, X.wave);
            pg8::EpiDown E{Y, (const LAS float*)(X.lds + 131072 + 3072 + 10240), (const LAS float*)(X.lds + 131072 + 3072)};
#endif
#if defined(PROBE_M2)
            if (_r == 0) pg8::gemm_phase<pg8::EpiDown, pg8::MoeOrder<4, false>, GP_ALIGN, GP_SP2, true, PROBE_M2>(X.lds, gm, S, E, X.wave, opaque_i(127 - W8_SHIFT_DN), opaque_i(127)); else
#endif
            pg8::gemm_phase<pg8::EpiDown, pg8::MoeOrder<4, false>, GP_ALIGN, GP_SP2, true>(X.lds, gm, S, E, X.wave, opaque_i(127 - W8_SHIFT_DN), opaque_i(127));  PHASE_END
        PHASE_BEGIN(P_LNB)
            if (layer == DEPTH - 1) phase_combine_ln<true>(X, layer, H1, Y, INP(18) + layer * D, INP(19) + layer * D, (void*)args.out);
            else phase_combine_ln<false>(X, layer, H1, Y, INP(18) + layer * D, INP(19) + layer * D, (void*)H0);
         PHASE_END
    }
#undef IN
#undef SEAM
#undef PHASE_BEGIN
#undef PHASE_END
#undef H0
#undef H1
#undef PROJ
#undef MIX
#undef MIXO
#undef Z
#undef ACT
#undef Y
#undef tb
}

extern "C" void kernel_launch(void* const* d_in, const int* in_sizes, int n_in, void* d_out, int out_size, void* d_ws, size_t ws_size, hipStream_t stream) {
    static int grid = 0;
    if (grid == 0) {
        if (n_in != 26 || out_size != T * D || ws_size < WS_END) { fprintf(stderr, "kernel_launch: unexpected shapes n_in %d out %d ws %zu (need %zu)\n", n_in, out_size, ws_size, (size_t)WS_END); grid = -1; return; }
        int dev = 0, cus = 0, per_cu = 0;
        if (hipGetDevice(&dev) != hipSuccess || hipDeviceGetAttribute(&cus, hipDeviceAttributeMultiprocessorCount, dev) != hipSuccess) { grid = -1; return; }
        if (hipFuncSetAttribute((const void*)mk_fwd, hipFuncAttributeMaxDynamicSharedMemorySize, LDS_BYTES) != hipSuccess) { fprintf(stderr, "kernel_launch: hipFuncSetAttribute failed\n"); grid = -1; return; }
        if (hipOccupancyMaxActiveBlocksPerMultiprocessor(&per_cu, (const void*)mk_fwd, NTHR, LDS_BYTES) != hipSuccess || per_cu < 1) fprintf(stderr, "kernel_launch: occupancy query says %d\n", per_cu);
        (void)hipGetLastError();
        grid = cus;
        if (grid < 256) { fprintf(stderr, "kernel_launch: %d CUs; the LN+router phase deals one 128-token slab per workgroup and needs 256\n", cus); grid = -1; return; }
        if (grid > 256) grid = 256;
    }
    if (grid < 0) return;
    if (hipMemsetAsync((char*)d_ws + WS_CTL, 0, CTL_ZERO_BYTES, stream) != hipSuccess) return;
    Args a{};
    for (int i = 0; i < 26; ++i) a.in[i] = (const float*)d_in[i];
    a.out = (float*)d_out; a.ws = (unsigned char*)d_ws;
#if MK_ONE_LAUNCH
    a.ph_lo = 0; a.ph_hi = DUP_MASK ? 100000 : N_PHASES;
    hipLaunchKernelGGL(mk_fwd, dim3(grid), dim3(NTHR), LDS_BYTES, stream, a);
#else
    for (int p = 0; p < N_PHASES; ++p) { a.ph_lo = p; a.ph_hi = p + 1; hipLaunchKernelGGL(mk_fwd, dim3(grid), dim3(NTHR), LDS_BYTES, stream, a); }
#endif
}
```

```cpp
#include <hip/hip_runtime.h>
#include <cstdio>
#include <cstdint>

#ifndef MK_ONE_LAUNCH
#define MK_ONE_LAUNCH 1
#endif

#define GAS __attribute__((address_space(1)))
#define LAS __attribute__((address_space(3)))
#define RLX_AGENT __ATOMIC_RELAXED, __HIP_MEMORY_SCOPE_AGENT
#define WAVE_SYNC() asm volatile("s_waitcnt lgkmcnt(0)" ::: "memory")
typedef float f32x4 __attribute__((ext_vector_type(4)));
typedef float f32x2 __attribute__((ext_vector_type(2)));
typedef unsigned u32x4 __attribute__((ext_vector_type(4)));
typedef unsigned u32x2 __attribute__((ext_vector_type(2)));
typedef unsigned short bf16_t;

constexpr int BATCH = 4, SEQ = 8192, D = 1024, T = BATCH * SEQ, DEPTH = 4;
constexpr int CONV_CH = 512, SSM_W = 512, SSM_G = 32, SSM_H = 16, SSM_P = 64;
constexpr int NH = 16, HD = 64;
constexpr int NE = 32, TOPK = 4, NA = T * TOPK;
constexpr float SW_LIMIT = 7.0f, SW_ALPHA = 1.702f;
constexpr float LN_EPS = 1e-5f;
constexpr float DN_ALPHA = 1.6817928305074290860622509524664f;
constexpr int NWAVES = 8, NTHR = 512;

constexpr size_t MiB = 1u << 20;
constexpr size_t WS_CTL = 0, CTL_ZERO_BYTES = 1 * MiB;
constexpr size_t WS_S5A = 1 * MiB;
constexpr size_t WS_S5B = 1 * MiB + 65536;
constexpr size_t WS_ROPE = 2 * MiB;
constexpr size_t WS_S5X = 48 * MiB;
constexpr size_t WS_TOKE = 4 * MiB;
constexpr size_t WS_TOKR = 4 * MiB + 524288;
constexpr size_t WS_RWH = 5 * MiB;
constexpr size_t WS_RWL = 5 * MiB + 262144;
constexpr size_t WS_GLIST = 8 * MiB;
constexpr size_t WS_S5S = 12 * MiB;
constexpr size_t WS_WIN = 16 * MiB;
constexpr size_t WS_WGLU = 24 * MiB;
constexpr size_t WS_WOUT = 26 * MiB;
constexpr size_t WS_WQKV = 32 * MiB;
constexpr size_t WS_WO = 44 * MiB;
constexpr size_t WS_WGU = 64 * MiB;
constexpr size_t WS_WDN = 576 * MiB;
constexpr size_t WS_H0 = 832 * MiB;
constexpr size_t WS_H1 = 896 * MiB;
constexpr size_t WS_PROJ = 960 * MiB;
constexpr size_t WS_MIX = 1152 * MiB;
constexpr size_t WS_MIXO = 1216 * MiB;
constexpr size_t WS_Z = 1280 * MiB;
constexpr size_t WS_ACT = 1312 * MiB;
constexpr size_t WS_Y = 1584 * MiB;
constexpr size_t WS_XG = 1856 * MiB;
constexpr size_t WS_STOK = 1920 * MiB;
constexpr size_t WS_END = 3904 * MiB;
constexpr int CW_BAR = 4096;
constexpr int CW_CNT = 16384;

constexpr int LDS_BYTES = 163840;
constexpr int MISC_OFF = 131072 + 320;
constexpr int TAB_OFF = 131072 + 1024;

#define XB_TMO      128
#define XB_XCNT(j)  (256  + 64 * (j))
#define XB_XSUB(j)  (1280 + 64 * (j))
#define XB_XGEN(j)  (2304 + 64 * (j))
#define XB_TOP      3328
#define XB_TOPGEN   3392
#define XCD_BAR_WORDS 3456
#define XB_SPIN_CAP (1u << 22)

__device__ __forceinline__ unsigned xb_ld(unsigned* p)              { return __hip_atomic_load(p, __ATOMIC_RELAXED, __HIP_MEMORY_SCOPE_AGENT); }
__device__ __forceinline__ unsigned xb_add(unsigned* p, unsigned v) { return __hip_atomic_fetch_add(p, v, __ATOMIC_RELAXED, __HIP_MEMORY_SCOPE_AGENT); }
__device__ __forceinline__ unsigned xb_xcc_id() { return (unsigned)__builtin_amdgcn_s_getreg((3 << 11) | 20) & 0xFu; }
#define XB_SPIN(cond, bar) do { unsigned _sp = 0; while (cond) { __builtin_amdgcn_s_sleep(1); \
    if ((++_sp & 255u) == 0u) { if (xb_ld(&(bar)[XB_TMO])) break; if (_sp > XB_SPIN_CAP) { atomicAdd(&(bar)[XB_TMO], 1u); break; } } } } while (0)

struct XcdBarrier { unsigned* bar; unsigned x; volatile LAS unsigned* st; int wave; };
__device__ __forceinline__ int xb_lane() { int l; asm volatile("v_mbcnt_lo_u32_b32 %0, -1, 0\n\tv_mbcnt_hi_u32_b32 %0, -1, %0" : "=v"(l)); return l; }

__device__ __forceinline__ XcdBarrier xcd_barrier_post(unsigned* bar, volatile LAS unsigned* st, int wave) {
    XcdBarrier b; b.bar = bar; b.x = xb_xcc_id(); b.st = st; b.wave = wave;
    if (wave == 0 && xb_lane() == 0) (void)xb_add(&bar[XB_XCNT(b.x)], 1u);
    return b;
}
__device__ __forceinline__ void xcd_barrier_complete(unsigned* bar, unsigned x, unsigned& nloc, unsigned& nx) {
    const unsigned G = gridDim.x * gridDim.y * gridDim.z;
    unsigned sum, cnt, mine, sp = 0u;
    for (;;) {
        sum = 0u; cnt = 0u; mine = 0u;
#pragma unroll
        for (unsigned j = 0; j < 16; ++j) { const unsigned c = xb_ld(&bar[XB_XCNT(j)]); sum += c; cnt += (c > 0u) ? 1u : 0u; mine = (j == x) ? c : mine; }
        if (sum == G) break;
        __builtin_amdgcn_s_sleep(1);
        if ((++sp & 255u) == 0u) { if (xb_ld(&bar[XB_TMO])) break; if (sp > XB_SPIN_CAP) { atomicAdd(&bar[XB_TMO], 1u); break; } }
    }
    nloc = mine > 0u ? mine : 1u; nx = cnt > 0u ? cnt : 1u;
}
__device__ __forceinline__ void xcd_barrier(const XcdBarrier& b) {
    asm volatile("s_waitcnt vmcnt(0)" ::: "memory");
    __syncthreads();
    if (b.wave == 0 && xb_lane() == 0) {
        unsigned* bar = b.bar;
        __builtin_amdgcn_s_waitcnt(0);
        unsigned nloc = b.st[0], nx = b.st[1];
        if (nloc == 0u) { xcd_barrier_complete(bar, b.x, nloc, nx); b.st[0] = nloc; b.st[1] = nx; }
        const unsigned old = xb_add(&bar[XB_XSUB(b.x)], 1u);
        const unsigned gen = old / nloc;
        if (old + 1u == (gen + 1u) * nloc) {
            __builtin_amdgcn_fence(__ATOMIC_RELEASE, "agent");
            asm volatile("s_waitcnt vmcnt(0)" ::: "memory");
            const unsigned og = xb_add(&bar[XB_TOP], 1u);
            const unsigned tg = og / nx;
            if (og + 1u == (tg + 1u) * nx) xb_add(&bar[XB_TOPGEN], 1u);
            else XB_SPIN(xb_ld(&bar[XB_TOPGEN]) == tg, bar);
            __builtin_amdgcn_fence(__ATOMIC_ACQUIRE, "agent");
            xb_add(&bar[XB_XGEN(b.x)], 1u);
            asm volatile("s_waitcnt vmcnt(0)" ::: "memory");
        } else {
            XB_SPIN(xb_ld(&bar[XB_XGEN(b.x)]) == gen, bar);
            __builtin_amdgcn_fence(__ATOMIC_ACQUIRE, "agent");
            asm volatile("s_waitcnt vmcnt(0)" ::: "memory");
        }
    }
    __syncthreads();
}

template <int M> __device__ __forceinline__ int swz_i(int v) { static_assert(M > 0 && M < 32, "ds_swizzle bit mode"); return __builtin_amdgcn_ds_swizzle(v, (M << 10) | 0x1f); }
template <int M> __device__ __forceinline__ float swz_f(float v) { return __builtin_bit_cast(float, swz_i<M>(__builtin_bit_cast(int, v))); }
__device__ __forceinline__ int bperm_i(int srclane, int v) { return __builtin_amdgcn_ds_bpermute(srclane << 2, v); }
__device__ __forceinline__ float bperm_f(int srclane, float v) { return __builtin_bit_cast(float, __builtin_amdgcn_ds_bpermute(srclane << 2, __builtin_bit_cast(int, v))); }
__device__ __forceinline__ float rdlane_f(float v, int l) { return __builtin_bit_cast(float, __builtin_amdgcn_readlane(__builtin_bit_cast(int, v), l)); }
__device__ __forceinline__ float wave_sum(float v) {
    v += swz_f<1>(v); v += swz_f<2>(v); v += swz_f<4>(v); v += swz_f<8>(v); v += swz_f<16>(v);
    return rdlane_f(v, 0) + rdlane_f(v, 32);
}
__device__ __forceinline__ float wave_max(float v) {
    v = fmaxf(v, swz_f<1>(v)); v = fmaxf(v, swz_f<2>(v)); v = fmaxf(v, swz_f<4>(v)); v = fmaxf(v, swz_f<8>(v)); v = fmaxf(v, swz_f<16>(v));
    return fmaxf(rdlane_f(v, 0), rdlane_f(v, 32));
}
__device__ __forceinline__ float sigmoidf_(float x) { return __builtin_amdgcn_rcpf(1.0f + __builtin_amdgcn_exp2f(-1.4426950408889634f * x)); }
__device__ __forceinline__ float gelu_tanh(float y) { return y * sigmoidf_(1.5957691216057308f * (y + 0.044715f * y * y * y)); }
__device__ __forceinline__ float opaque_f(float v) { asm volatile("" : "+s"(v)); return v; }
__device__ __forceinline__ int opaque_i(int v) { asm volatile("" : "+s"(v)); return v; }
__device__ __forceinline__ int seqpos(int bt) { return bt - ((bt >> 13) << 13); }
__device__ __forceinline__ unsigned f2bf(float f) { unsigned u = __builtin_bit_cast(unsigned, f); return (u + 0x7fffu + ((u >> 16) & 1u)) >> 16; }
__device__ __forceinline__ unsigned pk2(float lo, float hi) { return f2bf(lo) | (f2bf(hi) << 16); }
typedef float f32x2_t_ __attribute__((ext_vector_type(2))); typedef __bf16 bf16x2_t_ __attribute__((ext_vector_type(2)));
__device__ __forceinline__ unsigned cvt_pk_bf16(float lo, float hi) { const f32x2_t_ v = {lo, hi}; const bf16x2_t_ b = __builtin_convertvector(v, bf16x2_t_); return __builtin_bit_cast(unsigned, b); }
__device__ __forceinline__ float bf_lo(unsigned w) { return __builtin_bit_cast(float, w << 16); }
__device__ __forceinline__ float bf_hi(unsigned w) { return __builtin_bit_cast(float, w & 0xffff0000u); }
__device__ __forceinline__ float bf2f(bf16_t b) { return __builtin_bit_cast(float, ((unsigned)b) << 16); }
__device__ __forceinline__ void unpack8(const u32x4 w, float (&f)[8]) { f[0] = bf_lo(w.x); f[1] = bf_hi(w.x); f[2] = bf_lo(w.y); f[3] = bf_hi(w.y); f[4] = bf_lo(w.z); f[5] = bf_hi(w.z); f[6] = bf_lo(w.w); f[7] = bf_hi(w.w); }
__device__ __forceinline__ u32x4 pack8(const float (&f)[8]) { u32x4 w; w.x = cvt_pk_bf16(f[0], f[1]); w.y = cvt_pk_bf16(f[2], f[3]); w.z = cvt_pk_bf16(f[4], f[5]); w.w = cvt_pk_bf16(f[6], f[7]); return w; }

__device__ __forceinline__ unsigned pk4_fp8(float a, float b, float c, float d) {
    int w = __builtin_amdgcn_cvt_pk_fp8_f32(a, b, 0, false); w = __builtin_amdgcn_cvt_pk_fp8_f32(c, d, w, true); return (unsigned)w; }
__device__ __forceinline__ u32x2 pack8_fp8(const float (&f)[8]) { u32x2 w; w.x = pk4_fp8(f[0], f[1], f[2], f[3]); w.y = pk4_fp8(f[4], f[5], f[6], f[7]); return w; }
typedef float f32x2v_ __attribute__((ext_vector_type(2)));
__device__ __forceinline__ void unpack8_fp8(const u32x2 w, float (&f)[8]) {
    const f32x2v_ a = __builtin_amdgcn_cvt_pk_f32_fp8((int)w.x, false), b = __builtin_amdgcn_cvt_pk_f32_fp8((int)w.x, true), c = __builtin_amdgcn_cvt_pk_f32_fp8((int)w.y, false), d = __builtin_amdgcn_cvt_pk_f32_fp8((int)w.y, true);
    f[0] = a.x; f[1] = a.y; f[2] = b.x; f[3] = b.y; f[4] = c.x; f[5] = c.y; f[6] = d.x; f[7] = d.y; }
constexpr float Y8_SCALE = 16.0f;
constexpr int W8_SHIFT_GU = 5, W8_SHIFT_DN = 6;

__device__ __forceinline__ int lane_id() { int l; asm volatile("v_mbcnt_lo_u32_b32 %0, -1, 0\n\tv_mbcnt_hi_u32_b32 %0, -1, %0" : "=v"(l)); return l; }

struct Ctx {
    LAS unsigned char* lds;
    int tid, lane, wave, G, bid;
    unsigned* ctl;
    GAS unsigned char* ws;
};

namespace pg8 {
#define PG8_LAS __attribute__((address_space(3)))
typedef short bf16x8 __attribute__((ext_vector_type(8)));
constexpr int BM = 256, BK = 64, HALF = 128, HTB = HALF * BK * 2  , STAGE_BYTES = 8 * HTB, NXCD = 8, WGM = 8;

__host__ __device__ __forceinline__ int lds_byte(int r, int c) { const int st = (r >> 4) * 2 + (c >> 5), rr = r & 15, cc = c & 31, ob = rr * 64 + cc * 2; return st * 1024 + (ob ^ (((ob >> 9) & 1) << 5)); }
__host__ __device__ __forceinline__ void stage_rc(int b, int& R, int& C) { const int st = b / 1024, sb = b % 1024, swz = sb ^ (((sb >> 9) & 1) << 5); R = (st >> 1) * 16 + swz / 64; C = (st & 1) * 32 + (swz % 64) / 2; }
__host__ __device__ __forceinline__ int perm32(int rho) { const int n = rho >> 4, i = rho & 15; return 8 * (i >> 2) + 4 * n + (i & 3); }

struct Unit { int pm, pn, e, mt, ix; };
struct Gemm { const bf16_t* A; const bf16_t* Bt; int M, N, K; };

struct StaticOrder {
    int nM, nN, nwg, G, c; size_t tstep;
    __device__ void init(int M, int N, int K, int G_, int c_) { nM = M / BM; nN = N / BM; nwg = nM * nN; G = G_; c = c_; tstep = (size_t)BM * K * 2; }
    __device__ bool next(int i, Unit& u) const {
        const long L = (long)i * G + c; if (L >= nwg) return false;
        int wgid = (int)L; { const int q = nwg / NXCD, r = nwg % NXCD, xcd = wgid % NXCD, off = wgid / NXCD; wgid = (xcd < r ? xcd * (q + 1) : r * (q + 1) + (xcd - r) * q) + off; }
        const int nig = WGM * nN, gid = wgid / nig, fm = gid * WGM, gsz = (nM - fm) < WGM ? (nM - fm) : WGM;
        u.pm = fm + ((wgid % nig) % gsz); u.pn = (wgid % nig) / gsz; u.e = 0; u.mt = 0; u.ix = i; return true;
    }
    __device__ __forceinline__ size_t a_off(const Unit& u) const { return (size_t)u.pm * tstep; }
    __device__ __forceinline__ size_t b_off(const Unit& u) const { return (size_t)u.pn * tstep; }
    __device__ __forceinline__ void a_ready(const Unit&) const {}
    __device__ __forceinline__ void done(const Unit&) const {}
    static constexpr bool GATHER = false, A_PAIR2 = false;
};
template <int NPN, bool A_IS_XG> struct MoeOrder {
    static constexpr bool GATHER = A_IS_XG, A_PAIR2 = !A_IS_XG;
    const int* stok; const unsigned* cnt;
    const PG8_LAS unsigned short* idl;
    __device__ __forceinline__ unsigned list_id(int ui, int row) const { return (unsigned)idl[ui * BM + row]; }
    __device__ __forceinline__ void preload_ids(PG8_LAS unsigned short* dst, int tid, int wave) {
        idl = dst;
        const auto rs = __builtin_amdgcn_make_buffer_rsrc((void*)stok, 0, -1, 0x00020000);
        int tk[9], cn[9], sl[9];
#pragma unroll
        for (int j = 0; j < 9; ++j) { Unit u; tk[j] = 0; cn[j] = 0; sl[j] = 0;
            if (next(2 * j + (wave >> 2), u)) { sl[j] = u.mt * BM + (tid & 255); cn[j] = (int)__hip_atomic_load(cnt + u.e * 64, __ATOMIC_RELAXED, __HIP_MEMORY_SCOPE_AGENT);
                tk[j] = __builtin_amdgcn_raw_buffer_load_b32(rs, sl[j] * 4, (u.e * T) * 4, 0); } }
#pragma unroll
        for (int j = 0; j < 9; ++j) dst[(2 * j + (wave >> 2)) * BM + (tid & 255)] = (unsigned short)(sl[j] < cn[j] ? tk[j] : 0);
        __syncthreads();
    }
    template <int NPAIR, bool GU> __device__ __forceinline__ void preload_bias(PG8_LAS float* dst, const float* bias, int tid, int wave) const {
        const auto rs = __builtin_amdgcn_make_buffer_rsrc((void*)bias, 0, -1, 0x00020000);
        float bv_[NPAIR]; const int t = tid & 255;
#pragma unroll
        for (int j = 0; j < NPAIR; ++j) { Unit u; bv_[j] = 0.f;
            if (next(2 * j + (wave >> 2), u)) { const int col = GU ? (u.e * 2048 + u.pn * 128 + (t < 128 ? t : 1024 - 128 + t)) : (u.e * D + u.pn * BM + t);
                bv_[j] = __builtin_bit_cast(float, __builtin_amdgcn_raw_buffer_load_b32(rs, col * 4, 0, 0)); } }
#pragma unroll
        for (int j = 0; j < NPAIR; ++j) dst[(2 * j + (wave >> 2)) * BM + t] = bv_[j];
        __syncthreads();
    }
    __device__ __forceinline__ void preload_gates(PG8_LAS float* dst, const float* glist, int tid, int wave) const {
        const auto rs = __builtin_amdgcn_make_buffer_rsrc((void*)glist, 0, -1, 0x00020000);
        float gv_[5];
#pragma unroll
        for (int j = 0; j < 5; ++j) { Unit u; gv_[j] = 0.f; if (next(2 * j + (wave >> 2), u)) gv_[j] = __builtin_bit_cast(float, __builtin_amdgcn_raw_buffer_load_b32(rs, (u.mt * BM + (tid & 255)) * 4, (u.e * T) * 4, 0)); }
#pragma unroll
        for (int j = 0; j < 5; ++j) dst[(2 * j + (wave >> 2)) * BM + (tid & 255)] = gv_[j];
        __syncthreads();
    }
    const PG8_LAS int* tb; int G, c, ntile; size_t bexp, rowb;
    __device__ void init(const PG8_LAS int* tb_, int G_, int c_, int Nexp, int K) { tb = tb_; G = G_; c = c_; ntile = __builtin_amdgcn_readfirstlane(tb_[32]); rowb = (size_t)K * 2; bexp = (size_t)Nexp * rowb; }
    __device__ bool next(int i, Unit& u) const {
        int mtg, pn;
        if (G == 256) {
            constexpr int MPR = 256 / NPN, MPX = MPR / 8; const int nx = (ntile + 7) >> 3, l = MPX * i + (c >> 3) / NPN;
            if (l >= nx) return false;
            mtg = nx * (c & 7) + l; pn = (c >> 3) % NPN; }
        else { const long L = (long)i * G + c; mtg = (int)(L / NPN); pn = (int)(L % NPN); }
        if (mtg >= ntile) return false;
        int e = 0;
#pragma unroll
        for (int st = 16; st >= 1; st >>= 1) { const int tv = __builtin_amdgcn_readfirstlane(tb[e + st]); if (tv <= mtg) e += st; }
        u.pm = mtg; u.pn = pn; u.e = e; u.mt = mtg - __builtin_amdgcn_readfirstlane(tb[e]); u.ix = i; return true;
    }
    __device__ __forceinline__ size_t a_off(const Unit& u) const { return A_IS_XG ? (size_t)0 : (size_t)u.pm * BM * rowb; }
    __device__ __forceinline__ size_t b_off(const Unit& u) const { return (size_t)u.e * bexp + (size_t)u.pn * BM * rowb; }
    __device__ __forceinline__ void a_ready(const Unit&) const {}
    __device__ __forceinline__ void done(const Unit&) const {}
};

__device__ __forceinline__ u32x4 pack_v(const f32x4 v0, const f32x4 v1) { u32x4 w; w.x = cvt_pk_bf16(v0[0], v0[1]); w.y = cvt_pk_bf16(v0[2], v0[3]); w.z = cvt_pk_bf16(v1[0], v1[1]); w.w = cvt_pk_bf16(v1[2], v1[3]); return w; }

struct EpiStore {
    static constexpr bool PERM = true, PERM2 = true, AFTER_DRAIN = false, BIAS_INIT = false;
    bf16_t* O; int ldc;
    static __device__ __forceinline__ unsigned swp(unsigned v) { return (unsigned)__builtin_amdgcn_mov_dpp((int)v, 0xB1, 0xF, 0xF, true); }
    __device__ __forceinline__ void operator()(const f32x4 (&acc)[2][2][4][2], const Unit& u, int wr, int wc, int fr, int fq) const {
        const bool odd = (fr & 1) != 0;
        const int row0 = u.pm * BM + wr * 64, col0 = u.pn * BM + wc * 64 + 16 * fq + (odd ? 8 : 0);
        bf16_t* pa = O + (size_t)(row0 + (fr & ~1)) * ldc + col0;
#pragma unroll
        for (int ai = 0; ai < 2; ++ai)
#pragma unroll
            for (int m = 0; m < 4; ++m) {
                const u32x4 h0 = pack_v(acc[ai][0][m][0], acc[ai][0][m][1]), h1 = pack_v(acc[ai][1][m][0], acc[ai][1][m][1]);
                u32x4 snd, rcv, da, db;
                snd.x = odd ? h0.x : h1.x; snd.y = odd ? h0.y : h1.y; snd.z = odd ? h0.z : h1.z; snd.w = odd ? h0.w : h1.w;
                rcv.x = swp(snd.x); rcv.y = swp(snd.y); rcv.z = swp(snd.z); rcv.w = swp(snd.w);
                da.x = odd ? rcv.x : h0.x; da.y = odd ? rcv.y : h0.y; da.z = odd ? rcv.z : h0.z; da.w = odd ? rcv.w : h0.w;
                db.x = odd ? h1.x : rcv.x; db.y = odd ? h1.y : rcv.y; db.z = odd ? h1.z : rcv.z; db.w = odd ? h1.w : rcv.w;
                bf16_t* rp = pa + (size_t)(ai * HALF + m * 16) * ldc;
                *(u32x4*)(rp) = da; *(u32x4*)(rp + ldc) = db; }
    }
};
struct EpiGlu {
    static constexpr bool PERM = true, PERM2 = false, AFTER_DRAIN = false, BIAS_INIT = false;
    const bf16_t* Z; bf16_t* MIX; const float* bias;
    __device__ __forceinline__ void operator()(const f32x4 (&acc)[2][2][4][2], const Unit& u, int wr, int wc, int fr, int fq) const {
        const int row0 = u.pm * BM + wr * 64 + fr, col0 = u.pn * BM + wc * 32 + 8 * fq;
        f32x4 bv[2][2];
#pragma unroll
        for (int bj = 0; bj < 2; ++bj)
#pragma unroll
            for (int n = 0; n < 2; ++n) bv[bj][n] = *(const f32x4*)(bias + col0 + bj * HALF + 4 * n);
#pragma unroll
        for (int ai = 0; ai < 2; ++ai)
#pragma unroll
            for (int m = 0; m < 4; ++m) { const size_t row = (size_t)(row0 + ai * HALF + m * 16);
#pragma unroll
                for (int bj = 0; bj < 2; ++bj) {
                    const u32x4 zw = *(const u32x4*)(Z + row * SSM_W + col0 + bj * HALF); float z[8]; unpack8(zw, z);
                    const f32x4 a0 = acc[ai][bj][m][0] + bv[bj][0], a1 = acc[ai][bj][m][1] + bv[bj][1];
                    float o[8];
#pragma unroll
                    for (int j = 0; j < 4; ++j) { o[j] = z[j] * sigmoidf_(a0[j]); o[4 + j] = z[4 + j] * sigmoidf_(a1[j]); }
                    *(u32x4*)(MIX + row * D + 512 + col0 + bj * HALF) = pack8(o); } }
    }
};
struct EpiRope {
    static constexpr bool PERM = true, PERM2 = false, AFTER_DRAIN = false, BIAS_INIT = false;
    bf16_t* O; const f32x2* rope;
    __device__ __forceinline__ void operator()(const f32x4 (&acc)[2][2][4][2], const Unit& u, int wr, int wc, int fr, int fq) const {
        const int part = u.pn >> 2, tp = u.pn & 3;
        const int row0 = u.pm * BM + wr * 64 + fr, colb = part * 1024 + (4 * tp + wc) * 64 + 8 * fq;
        const float qs = part == 0 ? 0.125f * 1.4426950408889634f : 1.0f;
#pragma unroll
        for (int ai = 0; ai < 2; ++ai)
#pragma unroll
            for (int m = 0; m < 4; ++m) { const int row = row0 + ai * HALF + m * 16; bf16_t* rowp = O + (size_t)row * 3072 + colb;
                const f32x4 x1a = acc[ai][0][m][0], x1b = acc[ai][0][m][1], x2a = acc[ai][1][m][0], x2b = acc[ai][1][m][1];
                if (part < 2) {
                    const f32x4* rp = (const f32x4*)(rope + (size_t)seqpos(row) * 32 + 8 * fq);
                    const f32x4 c01 = rp[0], c23 = rp[1], c45 = rp[2], c67 = rp[3];
                    float o1[8], o2[8];
                    const float cs[8] = {c01[0], c01[2], c23[0], c23[2], c45[0], c45[2], c67[0], c67[2]}, sn[8] = {c01[1], c01[3], c23[1], c23[3], c45[1], c45[3], c67[1], c67[3]};
                    const float x1[8] = {x1a[0], x1a[1], x1a[2], x1a[3], x1b[0], x1b[1], x1b[2], x1b[3]}, x2[8] = {x2a[0], x2a[1], x2a[2], x2a[3], x2b[0], x2b[1], x2b[2], x2b[3]};
#pragma unroll
                    for (int j = 0; j < 8; ++j) { o1[j] = (x1[j] * cs[j] - x2[j] * sn[j]) * qs; o2[j] = (x2[j] * cs[j] + x1[j] * sn[j]) * qs; }
                    *(u32x4*)(rowp) = pack8(o1); *(u32x4*)(rowp + 32) = pack8(o2);
                } else { *(u32x4*)(rowp) = pack_v(x1a, x1b); *(u32x4*)(rowp + 32) = pack_v(x2a, x2b); } }
    }
};
struct EpiSwiglu {
    static constexpr bool PERM = true, PERM2 = false, AFTER_DRAIN = false, BIAS_INIT = true;
#ifdef PROBE_NOSTORE
    bool nostore = false;
#endif
    bf16_t* ACT; const PG8_LAS float* bias_lds;
    __device__ __forceinline__ void init_load(const Unit& u, int wc, int fq, f32x4 (&b)[4]) const {
        const PG8_LAS float* bb = bias_lds + u.ix * BM + wc * 32 + 8 * fq;
        b[0] = *(const PG8_LAS f32x4*)(bb); b[1] = *(const PG8_LAS f32x4*)(bb + 4); b[2] = *(const PG8_LAS f32x4*)(bb + 128); b[3] = *(const PG8_LAS f32x4*)(bb + 132);
    }
    static __device__ __forceinline__ void init_fill(f32x4 (&acc)[2][2][4][2], const f32x4 (&b)[4]) {
#pragma unroll
        for (int ai = 0; ai < 2; ++ai)
#pragma unroll
            for (int m = 0; m < 4; ++m) { acc[ai][0][m][0] = b[0]; acc[ai][0][m][1] = b[1]; acc[ai][1][m][0] = b[2]; acc[ai][1][m][1] = b[3]; }
    }
    __device__ __forceinline__ void init(f32x4 (&acc)[2][2][4][2], const Unit& u, int wc, int fq) const { f32x4 b[4]; init_load(u, wc, fq, b); init_fill(acc, b); }
    __device__ __forceinline__ void operator()(const f32x4 (&acc)[2][2][4][2], const Unit& u, int wr, int wc, int fr, int fq) const {
        const bool oq = (fq & 1) != 0;
        const int row0 = u.pm * BM + wr * 64 + fr, j0 = u.pn * 128 + wc * 32;
        unsigned char* ab = (unsigned char*)ACT + (size_t)(row0 >> 1) * (2 * D) + (j0 >> 5) * 64 + (fr & 1) * 32 + 16 * (fq >> 1);
#pragma unroll
        for (int ai = 0; ai < 2; ++ai)
#pragma unroll
            for (int mp = 0; mp < 2; ++mp) {
                u32x2 dd[2];
#pragma unroll
                for (int mm = 0; mm < 2; ++mm) { const int m = 2 * mp + mm;
                    const f32x4 g0 = acc[ai][0][m][0], g1 = acc[ai][0][m][1], l0 = acc[ai][1][m][0], l1 = acc[ai][1][m][1];
                    float o[8];
#pragma unroll
                    for (int j = 0; j < 4; ++j) {
                        const float ga = __builtin_amdgcn_fmed3f(g0[j], -3.0e38f, SW_LIMIT), gb = __builtin_amdgcn_fmed3f(g1[j], -3.0e38f, SW_LIMIT);
                        const float la = __builtin_amdgcn_fmed3f(l0[j], -SW_LIMIT, SW_LIMIT), lb = __builtin_amdgcn_fmed3f(l1[j], -SW_LIMIT, SW_LIMIT);
                        const float sa = ga * __builtin_amdgcn_rcpf(1.0f + __builtin_amdgcn_exp2f((-SW_ALPHA * 1.4426950408889634f) * ga)), sb = gb * __builtin_amdgcn_rcpf(1.0f + __builtin_amdgcn_exp2f((-SW_ALPHA * 1.4426950408889634f) * gb));
                        o[j] = fmaf(la, sa, sa); o[4 + j] = fmaf(lb, sb, sb); }
                    dd[mm] = pack8_fp8(o); }
                const unsigned sx = oq ? dd[0].x : dd[1].x, sy = oq ? dd[0].y : dd[1].y;
                const unsigned rx = (unsigned)swz_i<16>((int)sx), ry = (unsigned)swz_i<16>((int)sy);
                u32x4 w;
                if (!oq) { w.x = dd[0].x; w.y = dd[0].y; w.z = rx; w.w = ry; } else { w.x = rx; w.y = ry; w.z = dd[1].x; w.w = dd[1].y; }
                *(u32x4*)(ab + (size_t)(ai * (HALF / 2) + (2 * mp + (oq ? 1 : 0)) * 8) * (2 * D)) = w; }
    }
};
struct EpiDown {
    static constexpr bool PERM = true, PERM2 = true, AFTER_DRAIN = false, BIAS_INIT = true;
#ifdef PROBE_NOSTORE
    bool nostore = false;
#endif
    bf16_t* Y; const PG8_LAS float* bias_lds; const PG8_LAS float* gl_lds;
    __device__ __forceinline__ void init_load(const Unit& u, int wc, int fq, f32x4 (&b)[4]) const {
        const PG8_LAS float* bb = bias_lds + u.ix * BM + wc * 64 + 16 * fq;
        b[0] = *(const PG8_LAS f32x4*)(bb); b[1] = *(const PG8_LAS f32x4*)(bb + 4); b[2] = *(const PG8_LAS f32x4*)(bb + 8); b[3] = *(const PG8_LAS f32x4*)(bb + 12);
    }
    static __device__ __forceinline__ void init_fill(f32x4 (&acc)[2][2][4][2], const f32x4 (&b)[4]) {
#pragma unroll
        for (int ai = 0; ai < 2; ++ai)
#pragma unroll
            for (int m = 0; m < 4; ++m) { acc[ai][0][m][0] = b[0]; acc[ai][0][m][1] = b[1]; acc[ai][1][m][0] = b[2]; acc[ai][1][m][1] = b[3]; }
    }
    __device__ __forceinline__ void init(f32x4 (&acc)[2][2][4][2], const Unit& u, int wc, int fq) const { f32x4 b[4]; init_load(u, wc, fq, b); init_fill(acc, b); }
    __device__ __forceinline__ void operator()(const f32x4 (&acc)[2][2][4][2], const Unit& u, int wr, int wc, int fr, int fq) const {
        const int rl0 = wr * 64 + fr, col0 = u.pn * BM + wc * 64 + 16 * fq;
        const PG8_LAS float* gl = gl_lds + u.ix * BM + rl0;
        unsigned char* yb = (unsigned char*)Y + ((size_t)u.pm * BM + rl0) * D + col0;
#pragma unroll
        for (int ai = 0; ai < 2; ++ai)
#pragma unroll
            for (int m = 0; m < 4; ++m) { const int rl = ai * HALF + m * 16; const float gt = gl[rl] * Y8_SCALE;
                u32x4 w;
#pragma unroll
                for (int bj = 0; bj < 2; ++bj) { const f32x4 v0 = acc[ai][bj][m][0] * gt, v1 = acc[ai][bj][m][1] * gt;
                    const unsigned lo_ = pk4_fp8(v0[0], v0[1], v0[2], v0[3]), hi_ = pk4_fp8(v1[0], v1[1], v1[2], v1[3]);
                    if (bj == 0) { w.x = lo_; w.y = hi_; } else { w.z = lo_; w.w = hi_; } }
                *(u32x4*)(yb + (size_t)rl * D) = w; }
    }
};

template <class Epi, class Sched, bool ALIGN_EPI = false, bool SP2 = false, bool FP8 = false, int PROBE = 0>
__device__ __forceinline__ void gemm_phase(PG8_LAS unsigned char* lds, const Gemm g, const Sched& S, const Epi& E, int wave_, int scale_w = 127, int scale_x = 127) {
    int tid = wave_ * 64 + lane_id(); asm volatile("" : "+v"(tid)); const int wid = wave_, lane = tid & 63, wr = wid >> 2, wc = wid & 3, fr = lane & 15, fq = lane >> 4;
    const int K = g.K, nt = K / BK;
    unsigned voffA[2], voffB[2];
#pragma unroll
    for (int i = 0; i < 2; ++i) { int R, C; stage_rc(tid * 16 + i * 8192, R, C);
        const int Rb = Epi::PERM2 ? (64 * (R >> 5) + 16 * ((R & 15) >> 2) + 4 * ((R >> 4) & 1) + (R & 3)) : Epi::PERM ? ((R & ~31) + perm32(R & 31)) : R;
        if constexpr (Sched::A_PAIR2) voffA[i] = (unsigned)((R >> 1) * (4 * K) + ((2 * C) >> 5) * 64 + (R & 1) * 32 + ((2 * C) & 31)); else voffA[i] = (unsigned)(R * K + C) * 2u;
        voffB[i] = (unsigned)(Rb * K + C) * 2u; }
    unsigned gv[2] = {0u, 0u}, gn[2] = {0u, 0u}, gc2 = 0u;
    auto gather_unit = [&](int ui_, unsigned (&o)[2]) {
        if constexpr (Sched::GATHER) {
            int t_ = lane_id(); asm volatile("" : "+v"(t_)); t_ += wid * 64;
            int R, C; stage_rc(t_ * 16, R, C);
#pragma unroll
            for (int h = 0; h < 2; ++h) o[h] = S.list_id(ui_, h * HALF + R) | (S.list_id(ui_, h * HALF + R + 64) << 16);
        }
    };
    if constexpr (Sched::GATHER) { int R, C; stage_rc(tid * 16, R, C); gc2 = (unsigned)(C * 2); }
    const unsigned kstep = (unsigned)(BK * 2);
    const unsigned kstepA = Sched::A_PAIR2 ? 2u * kstep : kstep;
    const unsigned hstep = (unsigned)HALF * (unsigned)K * 2u;
    const unsigned hstepB = Epi::PERM2 ? 8u * (unsigned)K * 2u : hstep;
    const unsigned ldsw = (unsigned)wid * 1024u;
    const int aoff = lds_byte(wr * 64 + fr, fq * 8), boff = lds_byte(wc * 32 + fr, fq * 8);
#define PG8_SA(b, h) (((b) * 2 + (h)) * HTB)
#define PG8_SB(b, h) ((4 + (b) * 2 + (h)) * HTB)
#define PG8_STAGE(bufoff, gbase, voff) do { if constexpr (!(PROBE & 2)) _Pragma("unroll") for (int _i = 0; _i < 2; ++_i) \
        __builtin_amdgcn_raw_ptr_buffer_load_lds(rsrc_##voff, (PG8_LAS unsigned*)(lds + (bufoff) + ldsw + _i * 8192), 16, (voff)[_i], (gbase), 0, 0); } while (0)
#define PG8_STAGE_A(b, h, soff, NEXT) do { if constexpr (Sched::GATHER) { _Pragma("unroll") for (int _i = 0; _i < 2; ++_i) \
        { unsigned pk_ = (NEXT) ? gn[h] : gv[h]; asm volatile("" : "+v"(pk_)); const unsigned tk_ = _i ? (pk_ >> 16) : (pk_ & 0xffffu);     \
        __builtin_amdgcn_raw_ptr_buffer_load_lds(rsrc_voffA, (PG8_LAS unsigned*)(lds + PG8_SA(b, h) + ldsw + _i * 8192), 16, (tk_ << 10) | gc2, (soff), 0, 0); } } \
        else PG8_STAGE(PG8_SA(b, h), (soff) + (h) * hstep, voffA); } while (0)
#define PG8_LDA(dst, b, h) do { if constexpr ((PROBE & 16) != 0) { if constexpr (FP8) { asm volatile("" : "+v"(dst##8[0]), "+v"(dst##8[1]), "+v"(dst##8[2]), "+v"(dst##8[3])); } } else if constexpr (FP8) { _Pragma("unroll") for (int m = 0; m < 4; ++m) { const v4i_ lo_ = *(const PG8_LAS v4i_*)(lds + PG8_SA(b, h) + aoff + m * 2048), hi_ = *(const PG8_LAS v4i_*)(lds + PG8_SA(b, h) + aoff + m * 2048 + 1024); dst##8[m] = __builtin_shufflevector(lo_, hi_, 0, 1, 2, 3, 4, 5, 6, 7); } } \
        else { _Pragma("unroll") for (int m = 0; m < 4; ++m) _Pragma("unroll") for (int k = 0; k < 2; ++k) dst[m][k] = *(const PG8_LAS bf16x8*)(lds + PG8_SA(b, h) + aoff + m * 2048 + k * 1024); } } while (0)
#define PG8_LDB(dst, b, h) do { if constexpr ((PROBE & 8) != 0) { if constexpr (FP8) { asm volatile("" : "+v"(dst##8[0]), "+v"(dst##8[1])); } } else if constexpr (FP8) { _Pragma("unroll") for (int n = 0; n < 2; ++n) { const v4i_ lo_ = *(const PG8_LAS v4i_*)(lds + PG8_SB(b, h) + boff + n * 2048), hi_ = *(const PG8_LAS v4i_*)(lds + PG8_SB(b, h) + boff + n * 2048 + 1024); dst##8[n] = __builtin_shufflevector(lo_, hi_, 0, 1, 2, 3, 4, 5, 6, 7); } } \
        else { _Pragma("unroll") for (int n = 0; n < 2; ++n) _Pragma("unroll") for (int k = 0; k < 2; ++k) dst[n][k] = *(const PG8_LAS bf16x8*)(lds + PG8_SB(b, h) + boff + n * 2048 + k * 1024); } } while (0)
#define PG8_MMA(ai, bj, At, Bt) do { __builtin_amdgcn_s_setprio(1); _Pragma("unroll") for (int m = 0; m < 4; ++m) _Pragma("unroll") for (int n = 0; n < 2; ++n) { \
        if constexpr ((PROBE & 4) != 0) { if constexpr (FP8) asm volatile("" :: "v"(Bt##8[n]), "v"(At##8[m])); else asm volatile("" :: "v"(Bt[n][0]), "v"(At[m][0]), "v"(Bt[n][1]), "v"(At[m][1])); } else \
        if constexpr (FP8) acc[ai][bj][m][n] = __builtin_amdgcn_mfma_scale_f32_16x16x128_f8f6f4(Bt##8[n], At##8[m], acc[ai][bj][m][n], 0, 0, 0, scale_w, 0, scale_x); \
        else { _Pragma("unroll") for (int k = 0; k < 2; ++k) acc[ai][bj][m][n] = __builtin_amdgcn_mfma_f32_16x16x32_bf16(Bt[n][k], At[m][k], acc[ai][bj][m][n], 0, 0, 0); } } \
        __builtin_amdgcn_s_setprio(0); } while (0)
#define PG8_WAIT_V(n) asm volatile("s_waitcnt vmcnt(" #n ")" ::: "memory")
#define PG8_WAIT_L(n) asm volatile("s_waitcnt lgkmcnt(" #n ")" ::: "memory")
#define PG8_BAR __builtin_amdgcn_s_barrier()
#define PG8_SCHED __builtin_amdgcn_sched_barrier(0)
#define PG8_ACC_INIT(u_) do { if constexpr (Epi::BIAS_INIT && !(PROBE & 64)) { int tz_ = lane_id(); asm volatile("" : "+v"(tz_)); E.init(acc, u_, wc, (tz_ & 63) >> 4); } else { \
        _Pragma("unroll") for (int a = 0; a < 2; ++a) _Pragma("unroll") for (int b = 0; b < 2; ++b) _Pragma("unroll") for (int m = 0; m < 4; ++m) _Pragma("unroll") for (int n = 0; n < 2; ++n) acc[a][b][m][n] = (f32x4){0.f, 0.f, 0.f, 0.f}; } } while (0)
    Unit cur, nxt; int ui = 0;
    if (!S.next(0, cur)) return;
    f32x4 acc[2][2][4][2];
    typedef int v4i_ __attribute__((ext_vector_type(4))); typedef int v8i_ __attribute__((ext_vector_type(8)));
    bf16x8 At[4][2], B0[2][2], B1[2][2]; v8i_ At8[4], B08[2], B18[2];
    const auto rsrc_voffA = __builtin_amdgcn_make_buffer_rsrc((void*)g.A, 0, -1, 0x00020000), rsrc_voffB = __builtin_amdgcn_make_buffer_rsrc((void*)g.Bt, 0, -1, 0x00020000);
    unsigned cA = (unsigned)__builtin_amdgcn_readfirstlane((int)(unsigned)S.a_off(cur)), cB = (unsigned)__builtin_amdgcn_readfirstlane((int)(unsigned)S.b_off(cur));
    S.a_ready(cur);
    if constexpr (Sched::GATHER) { static_assert(BK * 2 == 128, "row offset 1 KiB = K * 2 bytes assumed below");
        gather_unit(0, gv); Unit n1_; if (S.next(1, n1_)) gather_unit(1, gn); else { gn[0] = gv[0]; gn[1] = gv[1]; }
        asm volatile("" : "+v"(gv[0]), "+v"(gv[1]), "+v"(gn[0]), "+v"(gn[1])); }
    PG8_ACC_INIT(cur);
    if constexpr (SP2) {
        PG8_STAGE(PG8_SB(0, 0), cB, voffB); PG8_STAGE(PG8_SB(0, 1), cB + hstepB, voffB); PG8_STAGE_A(0, 0, cA, false); PG8_STAGE_A(0, 1, cA, false);
        if (wr == 1) PG8_BAR;
        PG8_WAIT_V(2); PG8_BAR;
        PG8_STAGE(PG8_SB(1, 0), cB + kstep, voffB); PG8_STAGE_A(1, 0, cA + kstepA, false); PG8_STAGE(PG8_SB(1, 1), cB + hstepB + kstep, voffB);
        PG8_WAIT_V(6); PG8_BAR;
    } else {
        PG8_STAGE(PG8_SB(0, 0), cB, voffB); PG8_STAGE_A(0, 0, cA, false); PG8_STAGE(PG8_SB(0, 1), cB + hstepB, voffB); PG8_STAGE_A(0, 1, cA, false);
        if (wr == 1) PG8_BAR;
        PG8_WAIT_V(4); PG8_BAR;
        PG8_STAGE(PG8_SB(1, 0), cB + kstep, voffB); PG8_STAGE_A(1, 0, cA + kstepA, false); PG8_STAGE(PG8_SB(1, 1), cB + hstepB + kstep, voffB);
        PG8_WAIT_V(6); PG8_BAR;
    }
    for (;;) {
        const bool has_next = S.next(ui + 1, nxt);
        const unsigned nA = has_next ? (unsigned)__builtin_amdgcn_readfirstlane((int)(unsigned)S.a_off(nxt)) : cA, nB = has_next ? (unsigned)__builtin_amdgcn_readfirstlane((int)(unsigned)S.b_off(nxt)) : cB;
#pragma nounroll
        for (int t = 0; t < nt; t += 2) {
            const bool last = (t == nt - 2);
            const unsigned a1 = cA + (unsigned)(t + 1) * kstepA;
            const unsigned a2 = last ? nA : cA + (unsigned)(t + 2) * kstepA, b2 = last ? nB : cB + (unsigned)(t + 2) * kstep;
            const unsigned a3 = a2 + kstepA, b3 = b2 + kstep;
            if (last && has_next) S.a_ready(nxt);
            if constexpr (SP2) {
            PG8_LDB(B0, 0, 0); PG8_LDB(B1, 0, 1); PG8_SCHED; PG8_LDA(At, 0, 0); PG8_STAGE_A(1, 1, a1, false);
            PG8_WAIT_V(8); PG8_WAIT_L(0); PG8_BAR; PG8_MMA(0, 0, At, B0); PG8_MMA(0, 1, At, B1); PG8_BAR; PG8_SCHED;
            PG8_LDA(At, 0, 1); PG8_STAGE(PG8_SB(0, 0), b2, voffB); PG8_STAGE(PG8_SB(0, 1), b2 + hstepB, voffB); PG8_STAGE_A(0, 0, a2, last);
            PG8_WAIT_V(8); PG8_WAIT_L(0); PG8_BAR; PG8_MMA(1, 0, At, B0); PG8_MMA(1, 1, At, B1); PG8_BAR; PG8_SCHED;
            PG8_LDB(B0, 1, 0); PG8_LDB(B1, 1, 1); PG8_SCHED; PG8_LDA(At, 1, 0); PG8_STAGE_A(0, 1, a2, last);
            PG8_WAIT_V(8); PG8_WAIT_L(0); PG8_BAR; PG8_MMA(0, 0, At, B0); PG8_MMA(0, 1, At, B1); PG8_BAR; PG8_SCHED;
            PG8_LDA(At, 1, 1); PG8_STAGE(PG8_SB(1, 0), b3, voffB); PG8_STAGE(PG8_SB(1, 1), b3 + hstepB, voffB); PG8_STAGE_A(1, 0, a3, last);
            PG8_WAIT_V(8); PG8_WAIT_L(0); PG8_BAR; PG8_MMA(1, 0, At, B0); PG8_MMA(1, 1, At, B1); PG8_BAR; PG8_SCHED;
            } else {
            PG8_LDB(B0, 0, 0); PG8_SCHED; PG8_LDA(At, 0, 0); PG8_STAGE_A(1, 1, a1, false);
            PG8_WAIT_L(8); PG8_BAR; PG8_WAIT_L(0); PG8_MMA(0, 0, At, B0); PG8_BAR; PG8_SCHED;
            PG8_LDB(B1, 0, 1); PG8_STAGE(PG8_SB(0, 0), b2, voffB);
            PG8_BAR; PG8_WAIT_L(0); PG8_MMA(0, 1, At, B1); PG8_BAR;
            PG8_LDA(At, 0, 1); PG8_STAGE_A(0, 0, a2, last);
            PG8_BAR; PG8_WAIT_L(0); PG8_MMA(1, 0, At, B0); PG8_BAR; PG8_SCHED;
            PG8_STAGE(PG8_SB(0, 1), b2 + hstepB, voffB);
            PG8_WAIT_V(6); PG8_BAR; PG8_MMA(1, 1, At, B1); PG8_BAR;
            PG8_LDB(B0, 1, 0); PG8_SCHED; PG8_LDA(At, 1, 0); PG8_STAGE_A(0, 1, a2, last);
            PG8_WAIT_L(8); PG8_BAR; PG8_WAIT_L(0); PG8_MMA(0, 0, At, B0); PG8_BAR; PG8_SCHED;
            PG8_LDB(B1, 1, 1); PG8_STAGE(PG8_SB(1, 0), b3, voffB);
            PG8_BAR; PG8_WAIT_L(0); PG8_MMA(0, 1, At, B1); PG8_BAR;
            PG8_LDA(At, 1, 1); PG8_STAGE_A(1, 0, a3, last);
            PG8_BAR; PG8_WAIT_L(0); PG8_MMA(1, 0, At, B0); PG8_BAR; PG8_SCHED;
            PG8_STAGE(PG8_SB(1, 1), b3 + hstepB, voffB);
            PG8_WAIT_V(6); PG8_BAR; PG8_MMA(1, 1, At, B1); PG8_BAR;
            }
        }
        if constexpr (ALIGN_EPI) { if (wr == 0) PG8_BAR; }
        if constexpr (!Epi::AFTER_DRAIN) { int tz = lane_id(); asm volatile("" : "+v"(tz));
            if constexpr ((PROBE & 1) != 0) { _Pragma("unroll") for (int a = 0; a < 2; ++a) _Pragma("unroll") for (int b = 0; b < 2; ++b) _Pragma("unroll") for (int m = 0; m < 4; ++m) _Pragma("unroll") for (int n = 0; n < 2; ++n) asm volatile("" :: "v"(acc[a][b][m][n])); }
            else E(acc, cur, wr, wc, tz & 15, (tz & 63) >> 4); S.done(cur); }
        if (!has_next) break;
        if constexpr (Sched::GATHER) {
            gv[0] = gn[0]; gv[1] = gn[1]; }
        if constexpr (Sched::GATHER) { Unit n2_; if (S.next(ui + 2, n2_)) gather_unit(ui + 2, gn); asm volatile("" : "+v"(gn[0]), "+v"(gn[1])); }
        PG8_ACC_INIT(nxt);
        cur = nxt; cA = nA; cB = nB; ++ui;
        if constexpr (ALIGN_EPI) { if (wr == 1) PG8_BAR; }
    }
    PG8_WAIT_V(0);
    if constexpr (!ALIGN_EPI) { if (wr == 0) PG8_BAR; }
    PG8_BAR;
    if constexpr (Epi::AFTER_DRAIN) { E.fused(acc, cur, wr, wc, fr, fq, lds, wid, lane); S.done(cur); }
#undef PG8_SA
#undef PG8_SB
#undef PG8_ACC_INIT
#undef PG8_STAGE
#undef PG8_STAGE_A
#undef PG8_LDA
#undef PG8_LDB
#undef PG8_MMA
#undef PG8_WAIT_V
#undef PG8_WAIT_L
#undef PG8_BAR
#undef PG8_SCHED
}
}

template <int MODE>
__device__ __forceinline__ void transpose_item(const float* W, int K, int N, bf16_t* WT, LAS float* scr, int item, int lane) {
    const int nblk = N / 32, kb = item / nblk, nb = item % nblk, k0 = 64 * kb, n0 = 32 * nb;
    int dr = n0;
    if (MODE == 1) { const int j = n0 & 1023, half = n0 >> 10; dr = 256 * (j >> 7) + 128 * half + (j & 127); }
    if (MODE == 2) { const int part = n0 >> 10, c = n0 & 1023, head = c >> 6, half = (c >> 5) & 1; dr = part * 1024 + (head >> 2) * 256 + half * 128 + (head & 3) * 32; }
    float wv[32];
#pragma unroll
    for (int i = 0; i < 32; ++i) wv[i] = __builtin_nontemporal_load(W + (size_t)(k0 + 2 * i + (lane >> 5)) * N + n0 + (lane & 31));
#pragma unroll
    for (int i = 0; i < 32; ++i) scr[(2 * i + (lane >> 5)) * 33 + (lane & 31)] = wv[i];
    WAVE_SYNC();
    const int c = lane & 7;
#pragma unroll
    for (int j = 0; j < 4; ++j) { const int n = (lane >> 3) + 8 * j; const LAS float* s = scr + (8 * c) * 33 + n;
        u32x4 o; o.x = pk2(s[0 * 33], s[1 * 33]); o.y = pk2(s[2 * 33], s[3 * 33]); o.z = pk2(s[4 * 33], s[5 * 33]); o.w = pk2(s[6 * 33], s[7 * 33]);
        *(u32x4*)(WT + (size_t)(dr + n) * K + k0 + 8 * c) = o; }
    WAVE_SYNC();
}

template <int MODE>
__device__ __forceinline__ void transpose_item_fp8(const float* W, int K, int N, unsigned char* WT, LAS float* scr, int item, int lane, float scale) {
    const int nblk = N / 32, kb = item / nblk, nb = item % nblk, k0 = 64 * kb, n0 = 32 * nb;
    int dr = n0;
    if (MODE == 1) { const int j = n0 & 1023, half = n0 >> 10; dr = 256 * (j >> 7) + 128 * half + (j & 127); }
    const int rg = lane >> 3, c4 = lane & 7;
    f32x4 wv[8];
#pragma unroll
    for (int i = 0; i < 8; ++i) wv[i] = __builtin_nontemporal_load((const f32x4*)(W + (size_t)(k0 + 8 * i + rg) * N + n0 + 4 * c4));
#pragma unroll
    for (int i = 0; i < 8; ++i) *(LAS f32x4*)(scr + (8 * i + rg) * 36 + 4 * c4) = wv[i] * scale;
    WAVE_SYNC();
#pragma unroll
    for (int j = 0; j < 2; ++j) { const int n = lane & 31, c = (lane >> 5) + 2 * j; const LAS float* s = scr + (16 * c) * 36 + n;
        u32x4 o; o.x = pk4_fp8(s[0 * 36], s[1 * 36], s[2 * 36], s[3 * 36]); o.y = pk4_fp8(s[4 * 36], s[5 * 36], s[6 * 36], s[7 * 36]);
        o.z = pk4_fp8(s[8 * 36], s[9 * 36], s[10 * 36], s[11 * 36]); o.w = pk4_fp8(s[12 * 36], s[13 * 36], s[14 * 36], s[15 * 36]);
        *(u32x4*)(WT + (size_t)(dr + n) * K + k0 + 16 * c) = o; }
    WAVE_SYNC();
}

__device__ __forceinline__ const float* ld_ptr(volatile LAS unsigned long long* t, int k) {
    const unsigned long long v = t[k]; const unsigned lo = __builtin_amdgcn_readfirstlane((unsigned)v), hi = __builtin_amdgcn_readfirstlane((unsigned)(v >> 32));
    return (const float*)(const GAS float*)(((unsigned long long)hi << 32) | lo);
}
__device__ __forceinline__ void phase_prologue(const Ctx& X, volatile LAS unsigned long long* ptab) {
#define in_(k) ld_ptr(ptab, k)
    const float* a_re = in_(3); const float* a_im = in_(4); const float* log_dt = in_(5); const float* b_re = in_(6); const float* b_im = in_(7);
    float2* Abar = (float2*)(X.ws + WS_S5A); float2* Bbar = (float2*)(X.ws + WS_S5B); float2* rope = (float2*)(X.ws + WS_ROPE);
    const int gt = X.bid * NTHR + X.tid, NT = X.G * NTHR;
    for (int it = gt; it < 2 * SSM_G * SSM_P; it += NT) {
        const int ig = it >> 6;
        const double lam_re = fmin((double)a_re[it], -1e-4), lam_im = (double)a_im[it];
        const double dt = exp((double)log_dt[ig]);
        const double mag = exp(lam_re * dt), ang = lam_im * dt;
        const double abr = mag * cos(ang), abi = mag * sin(ang);
        const double nr = abr - 1.0, ni = abi, den = lam_re * lam_re + lam_im * lam_im;
        const double cr = (nr * lam_re + ni * lam_im) / den, ci = (ni * lam_re - nr * lam_im) / den;
        Abar[it] = make_float2((float)abr, (float)abi);
        for (int h = 0; h < SSM_H; ++h) {
            const double br = (double)b_re[it * 16 + h], bi = (double)b_im[it * 16 + h];
            Bbar[it * 16 + h] = make_float2((float)(cr * br - ci * bi), (float)(cr * bi + ci * br));
        }
    }
    for (int it = gt; it < SEQ * 32; it += NT) {
        const int pos = it >> 5, i = it & 31;
        const float inv = powf(10000.0f, -(float)i / 32.0f);
        const float ang = (float)pos * inv;
        rope[it] = make_float2((float)cos((double)ang), (float)sin((double)ang));
    }
    { const float* rw = in_(20); bf16_t* RWh = (bf16_t*)(X.ws + WS_RWH); bf16_t* RWl = (bf16_t*)(X.ws + WS_RWL);
      for (int it = gt; it < DEPTH * NE * D; it += NT) { const int k = it & 1023, e = (it >> 10) & 31, l = it >> 15;
          const float w = rw[((size_t)l * D + k) * NE + e]; const unsigned hb = f2bf(w); RWh[it] = (bf16_t)hb; RWl[it] = (bf16_t)f2bf(w - bf2f((bf16_t)hb)); } }
    { const float* x = in_(0); bf16_t* H0 = (bf16_t*)(X.ws + WS_H0);
      const size_t n8 = (size_t)T * D / 8;
      for (size_t i8 = (size_t)gt; i8 < n8; i8 += (size_t)NT) {
          const f32x4 a = *(const f32x4*)(x + i8 * 8), b = *(const f32x4*)(x + i8 * 8 + 4);
          u32x4 o; o.x = pk2(a[0], a[1]); o.y = pk2(a[2], a[3]); o.z = pk2(b[0], b[1]); o.w = pk2(b[2], b[3]);
          *(u32x4*)(H0 + i8 * 8) = o; } }
    LAS float* scr = (LAS float*)(X.lds + X.wave * 16384);
    const int gw = X.bid * NWAVES + X.wave, NGW = X.G * NWAVES;
    constexpr int I_GU = 16 * 64, I_DN = 16 * 32, I_IN = 16 * 64, I_GLU = 8 * 16, I_OUT = 16 * 32, I_QKV = 16 * 96, I_O = 16 * 32;
    constexpr int N_GU = 128 * I_GU, N_DN = 128 * I_DN, N_IN = 2 * I_IN, N_GLU = 2 * I_GLU, N_OUT = 2 * I_OUT, N_QKV = 2 * I_QKV, N_O = 2 * I_O;
    constexpr int NITEMS = N_GU + N_DN + N_IN + N_GLU + N_OUT + N_QKV + N_O;
    for (int it = gw; it < NITEMS; it += NGW) {
        int r = it;
        if (r < N_GU) { const int m = r / I_GU; transpose_item_fp8<1>(in_(22) + (size_t)m * D * 2048, D, 2048, (unsigned char*)(X.ws + WS_WGU + (size_t)m * 2048 * D), scr, r % I_GU, X.lane, (float)(1 << W8_SHIFT_GU)); continue; } r -= N_GU;
        if (r < N_DN) { const int m = r / I_DN; transpose_item_fp8<0>(in_(24) + (size_t)m * D * D, D, D, (unsigned char*)(X.ws + WS_WDN + (size_t)m * D * D), scr, r % I_DN, X.lane, (float)(1 << W8_SHIFT_DN)); continue; } r -= N_DN;
        if (r < N_IN) { const int m = r / I_IN; transpose_item<0>(in_(1) + (size_t)m * D * 2048, D, 2048, (bf16_t*)(X.ws + WS_WIN) + (size_t)m * 2048 * D, scr, r % I_IN, X.lane); continue; } r -= N_IN;
        if (r < N_GLU) { const int m = r / I_GLU; transpose_item<0>(in_(11) + (size_t)m * 512 * 512, 512, 512, (bf16_t*)(X.ws + WS_WGLU) + (size_t)m * 512 * 512, scr, r % I_GLU, X.lane); continue; } r -= N_GLU;
        if (r < N_OUT) { const int m = r / I_OUT; transpose_item<0>(in_(13) + (size_t)m * D * D, D, D, (bf16_t*)(X.ws + WS_WOUT) + (size_t)m * D * D, scr, r % I_OUT, X.lane); continue; } r -= N_OUT;
        if (r < N_QKV) { const int m = r / I_QKV; transpose_item<2>(in_(14) + (size_t)m * D * 3072, D, 3072, (bf16_t*)(X.ws + WS_WQKV) + (size_t)m * 3072 * D, scr, r % I_QKV, X.lane); continue; } r -= N_QKV;
        { const int m = r / I_O; transpose_item<0>(in_(15) + (size_t)m * D * D, D, D, (bf16_t*)(X.ws + WS_WO) + (size_t)m * D * D, scr, r % I_O, X.lane); }
    }
}

#undef in_
typedef float f32x4v __attribute__((ext_vector_type(4)));
template <int PASS>
__device__ __forceinline__ void phase_s5(const Ctx& X, int i, const bf16_t* proj, const float* conv_w, const float* c_re, const float* c_im, const float* d_skip, bf16_t* mix, bf16_t* Z, int probe = 0) {
    using pg8::bf16x8;
    if (PASS == 2 && !(probe & 1)) {
        const float* w = conv_w + (size_t)i * 3 * CONV_CH;
        const int c = X.lane * 8;
        float w0[8], w1[8], w2[8];
#pragma unroll
        for (int j = 0; j < 8; ++j) { w0[j] = w[0 * CONV_CH + c + j]; w1[j] = w[1 * CONV_CH + c + j]; w2[j] = w[2 * CONV_CH + c + j]; }
        const int gwv = X.bid * NWAVES + X.wave, NGWV = X.G * NWAVES;
        for (int run = gwv; run < T / 16; run += NGWV) {
            const int bt0 = run * 16, pos0 = seqpos(bt0);
            const bf16_t* pr = proj + (size_t)bt0 * 2048 + c;
            float p0[8], p1[8];
#pragma unroll
            for (int j = 0; j < 8; ++j) { p0[j] = 0.f; p1[j] = 0.f; }
            if (pos0 >= 2) {
                float a[8], b[8];
                unpack8(*(const u32x4*)(pr + 512 - 4096), a); unpack8(*(const u32x4*)(pr + 1024 - 4096), b);
#pragma unroll
                for (int j = 0; j < 8; ++j) p0[j] = a[j] * b[j];
                unpack8(*(const u32x4*)(pr + 512 - 2048), a); unpack8(*(const u32x4*)(pr + 1024 - 2048), b);
#pragma unroll
                for (int j = 0; j < 8; ++j) p1[j] = a[j] * b[j];
            }
#pragma unroll 4
            for (int k = 0; k < 16; ++k) {
                float gb[8], a[8], b[8], o[8];
                unpack8(*(const u32x4*)(pr + (size_t)k * 2048), gb); unpack8(*(const u32x4*)(pr + (size_t)k * 2048 + 512), a); unpack8(*(const u32x4*)(pr + (size_t)k * 2048 + 1024), b);
#pragma unroll
                for (int j = 0; j < 8; ++j) { const float p2 = a[j] * b[j];
                    float s = w2[j] * p2; s += w1[j] * p1[j]; s += w0[j] * p0[j];
                    o[j] = gb[j] * s; p0[j] = p1[j]; p1[j] = p2; }
                *(u32x4*)(mix + (size_t)(bt0 + k) * D + c) = pack8(o);
            }
        }
    }
    const int lane = X.lane, n16 = lane & 15, kq = lane >> 4;
    LAS float* BuT = (LAS float*)(X.lds + X.wave * 15360);
    LAS unsigned char* xsb = X.lds + X.wave * 15360 + 10240;
    const float2* Abar = (const float2*)(X.ws + WS_S5A); const float2* Bbar = (const float2*)(X.ws + WS_S5B);
    float2* Sst = (float2*)(X.ws + WS_S5S);
    const int gw = X.bid * NWAVES + X.wave, NGW = X.G * NWAVES;
    const int g = gw & 31, ig = i * 32 + g;
        const float2 A = Abar[ig * 64 + lane];
    bf16x8 bfr[8];
#pragma unroll
    for (int cb = 0; cb < 8; ++cb) {
        u32x4 w = (u32x4){0u, 0u, 0u, 0u};
        if (kq < 2) { const float2* bp = Bbar + ((size_t)(ig * 64 + 16 * (cb & 3) + n16)) * 16 + 8 * kq; float v[8];
#pragma unroll
            for (int j = 0; j < 8; ++j) { const float2 t2 = bp[j]; v[j] = cb < 4 ? t2.x : t2.y; }
            w = pack8(v); }
        bfr[cb] = __builtin_bit_cast(bf16x8, w);
    }
    bf16x8 cfr[4]; bf16x8 dfr;
    if (PASS == 2) {
#pragma unroll
        for (int ks = 0; ks < 4; ++ks) { const int p0 = 16 * ks + 4 * kq; const f32x4 cr = *(const f32x4*)(c_re + (size_t)(ig * 16 + n16) * 64 + p0), ci = *(const f32x4*)(c_im + (size_t)(ig * 16 + n16) * 64 + p0);
            u32x4 w; w.x = cvt_pk_bf16(cr[0], -ci[0]); w.y = cvt_pk_bf16(cr[1], -ci[1]); w.z = cvt_pk_bf16(cr[2], -ci[2]); w.w = cvt_pk_bf16(cr[3], -ci[3]); cfr[ks] = __builtin_bit_cast(bf16x8, w); }
        { const float dv = d_skip[ig * 16 + n16]; float v[8];
#pragma unroll
          for (int j = 0; j < 8; ++j) v[j] = (kq < 2 && 8 * kq + j == n16) ? dv : 0.f;
          dfr = __builtin_bit_cast(bf16x8, pack8(v)); }
    }
    u32x4 uw_n = (u32x4){0u, 0u, 0u, 0u}; float2 xin_n = make_float2(0.f, 0.f);
    auto task_head = [&](int task_, u32x4& uw_, float2& xin_) { const int c_ = (task_ >> 5) & 63, b_ = task_ >> 11;
        if (PASS == 2) xin_ = ((const float2*)(X.ws + WS_S5X))[((size_t)(b_ * 32 + g) * 64 + c_) * 64 + lane];
        uw_ = (u32x4){0u, 0u, 0u, 0u};
        if (kq < 2) uw_ = *(const u32x4*)(proj + ((size_t)b_ * SEQ + (size_t)c_ * 128) * 2048 + 1536 + g * 16 + (size_t)n16 * 2048 + 8 * kq); };
    if (!(probe & 2) && gw < BATCH * 64 * SSM_G) task_head(gw, uw_n, xin_n);
    if (!(probe & 2))
    for (int task = gw; task < BATCH * 64 * SSM_G; task += NGW) {
        const int c = (task >> 5) & 63, b = task >> 11;
        float xr = 0.f, xi = 0.f;
        if (PASS == 2) { xr = xin_n.x; xi = xin_n.y; }
        const bf16_t* ub = proj + ((size_t)b * SEQ + (size_t)c * 128) * 2048 + 1536 + g * 16;
        bf16_t* zb = Z + ((size_t)b * SEQ + (size_t)c * 128) * SSM_W + g * 16;
        u32x4 uw = uw_n;
        if (task + NGW < BATCH * 64 * SSM_G) task_head(task + NGW, uw_n, xin_n);
#pragma nounroll
        for (int blk = 0; blk < 8; ++blk) {
            const bf16x8 ufr = __builtin_bit_cast(bf16x8, uw);
            u32x4 un = (u32x4){0u, 0u, 0u, 0u};
            if (kq < 2 && blk < 7) un = *(const u32x4*)(ub + (size_t)((blk + 1) * 16 + n16) * 2048 + 8 * kq);
#pragma unroll
            for (int cb = 0; cb < 8; ++cb) {
                f32x4v acc = (f32x4v){0.f, 0.f, 0.f, 0.f};
                acc = __builtin_amdgcn_mfma_f32_16x16x32_bf16(ufr, bfr[cb], acc, 0, 0, 0);
                *(LAS f32x4v*)(BuT + (16 * cb + n16) * 20 + 4 * kq) = acc;
            }
            WAVE_SYNC();
#pragma unroll
            for (int k4 = 0; k4 < 4; ++k4) {
                const f32x4v br = *(const LAS f32x4v*)(BuT + lane * 20 + 4 * k4), bi = *(const LAS f32x4v*)(BuT + (64 + lane) * 20 + 4 * k4);
#pragma unroll
                for (int s = 0; s < 4; ++s) {
                    float nr = fmaf(-A.y, xi, fmaf(A.x, xr, br[s])); asm volatile("" : "+v"(nr));
                    float ni = fmaf(A.y, xr, fmaf(A.x, xi, bi[s])); asm volatile("" : "+v"(ni));
                    xr = nr; xi = ni;
                    if (PASS == 2) *(LAS unsigned*)(xsb + (4 * k4 + s) * 272 + lane * 4) = cvt_pk_bf16(xr, xi);
                }
            }
            if (PASS == 2) {
                WAVE_SYNC();
                f32x4v y = (f32x4v){0.f, 0.f, 0.f, 0.f};
                bf16x8 xa[4];
#pragma unroll
                for (int ks = 0; ks < 4; ++ks) xa[ks] = *(const LAS bf16x8*)(xsb + n16 * 272 + ks * 64 + kq * 16);
                WAVE_SYNC(); __builtin_amdgcn_sched_barrier(0);
#pragma unroll
                for (int ks = 0; ks < 4; ++ks) y = __builtin_amdgcn_mfma_f32_16x16x32_bf16(xa[ks], cfr[ks], y, 0, 0, 0);
                y = __builtin_amdgcn_mfma_f32_16x16x32_bf16(ufr, dfr, y, 0, 0, 0);
                asm volatile("" :: "v"(xa[0]), "v"(xa[1]), "v"(xa[2]), "v"(xa[3]), "v"(ufr));
#pragma unroll
                for (int q = 0; q < 4; ++q) zb[(size_t)(blk * 16 + 4 * kq + q) * SSM_W + n16] = (bf16_t)f2bf(gelu_tanh(y[q]));
            }
            WAVE_SYNC();
            uw = un;
        }
        if (PASS == 1) Sst[((size_t)(b * 32 + g) * 64 + c) * 64 + lane] = make_float2(xr, xi);
    }
}

__device__ __forceinline__ void phase_s5_carry(const Ctx& X, int i) {
    const float2* Abar = (const float2*)(X.ws + WS_S5A); const float2* Sst = (const float2*)(X.ws + WS_S5S); float2* Xin = (float2*)(X.ws + WS_S5X);
    const int gw = X.bid * NWAVES + X.wave, NGW = X.G * NWAVES, lane = X.lane;
    for (int bg = gw; bg < BATCH * SSM_G; bg += NGW) {
        const float2 A = Abar[(i * 32 + (bg & 31)) * 64 + lane];
        float pr_ = A.x, pi_ = A.y;
#pragma unroll
        for (int q = 0; q < 7; ++q) { const float nr = pr_ * pr_ - pi_ * pi_, ni = 2.f * pr_ * pi_; pr_ = nr; pi_ = ni; }
        float xr = 0.f, xi = 0.f;
        const size_t base = (size_t)bg * 64 * 64 + lane;
#pragma unroll 8
        for (int c = 0; c < 64; ++c) {
            Xin[base + (size_t)c * 64] = make_float2(xr, xi);
            const float2 s = Sst[base + (size_t)c * 64];
            const float nr = pr_ * xr - pi_ * xi + s.x, ni = pr_ * xi + pi_ * xr + s.y; xr = nr; xi = ni;
        }
    }
}

typedef short v4i16_t __attribute__((ext_vector_type(4)));
typedef float f32x16 __attribute__((ext_vector_type(16)));
__device__ __forceinline__ v4i16_t vtr16(const LAS unsigned char* p) { return __builtin_amdgcn_ds_read_tr16_b64_v4i16((LAS v4i16_t*)p); }
template <int PASS>
__device__ __forceinline__ void phase_attn(const Ctx& X, const bf16_t* proj, bf16_t* att, bf16_t* ost, float2* ml) {
    using pg8::bf16x8;
    const int lane = X.lane, i32 = lane & 31, hi = lane >> 5;
    LAS unsigned char* vbuf = X.lds + X.wave * 16384;
    LAS unsigned char* kbuf = vbuf + 8192;
    const int gw = X.bid * NWAVES + X.wave, NGW = X.G * NWAVES;
    const float NEG = opaque_f(-3.0e38f); const int seqmax = opaque_i(SEQ - 1);
    const int vrd = ((lane >> 4) & 1) * 32 + (lane & 3) * 8 + (4 * hi + ((lane & 15) >> 2)) * 64;
    const bool xdeal = (X.G == 256);
    constexpr int NT = PASS == 0 ? 13 : 5, PD = 2, NR = 3;
    const int lrow = lane >> 3, lpc = lane & 7;
#pragma nounroll
    for (int it = 0; it < (xdeal ? 8 : (BATCH * NH * 256 + NGW - 1) / NGW); ++it) {
        const int task = xdeal ? (((it * 8 + (X.bid & 7)) << 8) | ((X.bid >> 3) * 8 + X.wave)) : (gw + it * NGW);
        if (task >= BATCH * NH * 256) break;
        const int QST = PASS == 0 ? 4 : 16;
        const int r = PASS == 0 ? (task & 3) : (task & 15), blk = PASS == 0 ? ((task >> 2) & 63) : ((task >> 4) & 15), hh = (task >> 8) & 15, b = task >> 12;
        const bf16_t* base = proj + (size_t)b * SEQ * 3072 + hh * 64;
        const int t0 = (PASS == 0 ? 128 : 512) * blk + r;
        bf16x8 qf[4];
        { const bf16_t* qp = base + (size_t)(t0 + QST * i32) * 3072 + 8 * hi;
#pragma unroll
          for (int d0 = 0; d0 < 4; ++d0) qf[d0] = *(const bf16x8*)(qp + 16 * d0); }
        float m_run = NEG, l_run = 0.f;
        f32x16 o0, o1;
#pragma unroll
        for (int q = 0; q < 16; ++q) { o0[q] = 0.f; o1[q] = 0.f; }
        const size_t srow = (size_t)(b * SEQ + t0 + QST * i32);
        if (PASS == 1) {
            const float2 mlv = ml[srow * NH + hh]; m_run = mlv.x; l_run = hi == 0 ? mlv.y : 0.f;
            const bf16_t* sp = ost + srow * D + hh * 64 + 4 * hi;
#pragma unroll
            for (int gq = 0; gq < 4; ++gq) { const u32x2 w0 = *(const u32x2*)(sp + 8 * gq), w1 = *(const u32x2*)(sp + 32 + 8 * gq);
                o0[4 * gq] = bf_lo(w0.x); o0[4 * gq + 1] = bf_hi(w0.x); o0[4 * gq + 2] = bf_lo(w0.y); o0[4 * gq + 3] = bf_hi(w0.y);
                o1[4 * gq] = bf_lo(w1.x); o1[4 * gq + 1] = bf_hi(w1.x); o1[4 * gq + 2] = bf_lo(w1.y); o1[4 * gq + 3] = bf_hi(w1.y); }
        }
#define AT_PAT(j) (PASS == 1 ? 0 : ((j) < 5 ? 0 : 1))
#define AT_KT(j) (PASS == 1 ? (j) : ((j) < 5 ? (j) : (j) - 5))
#define AT_DIL(j) (PASS == 1 ? 16 : (AT_PAT(j) == 0 ? 4 : 1))
#define AT_QS(j) (PASS == 1 ? 1 : (AT_PAT(j) == 0 ? 1 : 4))
#define AT_RR(j) (PASS == 1 ? r : (AT_PAT(j) == 0 ? r : 0))
        u32x4 kr[NR][4], vr[NR][4];
        auto issue = [&](int j, u32x4 (&kk)[4], u32x4 (&vv)[4]) {
            const int dil = AT_DIL(j), rr = AT_RR(j), Mt = (t0 - rr) / dil - 128 + 32 * AT_KT(j);
            auto keypos = [&](int M) { int p = dil * M + rr; p = p < 0 ? 0 : p; p = p > seqmax ? seqmax : p; return p; };
#pragma unroll
            for (int q = 0; q < 4; ++q) {
                const bf16_t* rp = base + (size_t)keypos(Mt + 8 * q + lrow) * 3072;
                kk[q] = *(const u32x4*)(rp + 1024 + 8 * (lpc ^ lrow));
                vv[q] = *(const u32x4*)(rp + 2048 + 8 * lpc);
            }
        };
#pragma unroll
        for (int j = 0; j < PD; ++j) issue(j, kr[j], vr[j]);
#pragma unroll
        for (int j = 0; j < NT; ++j) {
            if (j + PD < NT) issue(j + PD, kr[(j + PD) % NR], vr[(j + PD) % NR]);
            const int kt = AT_KT(j), dil = AT_DIL(j), rr = AT_RR(j), Mstart = (t0 - rr) / dil - 128, qi = AT_QS(j) * i32;
            f32x16 s;
#pragma unroll
            for (int q = 0; q < 16; ++q) s[q] = 0.f;
#pragma unroll
            for (int q = 0; q < 4; ++q) *(LAS u32x4*)(kbuf + (j & 1) * 4096 + q * 1024 + lane * 16) = kr[j % NR][q];
            bf16x8 kf[4];
#pragma unroll
            for (int d0 = 0; d0 < 4; ++d0) kf[d0] = *(const LAS bf16x8*)(kbuf + (j & 1) * 4096 + (i32 >> 3) * 1024 + (i32 & 7) * 128 + (((2 * d0 + hi) ^ (i32 & 7)) << 4));
#pragma unroll
            for (int d0 = 0; d0 < 4; ++d0) s = __builtin_amdgcn_mfma_f32_32x32x16_bf16(kf[d0], qf[d0], s, 0, 0, 0);
            const int hi_ = qi + 128 - 32 * kt; int lo = hi_ - 128; { const int nk = -(Mstart + 32 * kt); lo = lo > nk ? lo : nk; }
            const int rb = 4 * hi - lo; const unsigned span = (unsigned)(hi_ - lo);
            const bool any = hi_ >= lo;
            float tmax = NEG;
#pragma unroll
            for (int q = 0; q < 16; ++q) { const int rowc = (q & 3) + 8 * (q >> 2); const bool ok = any && ((unsigned)(rowc + rb) <= span) && (rowc + rb >= 0); s[q] = ok ? s[q] : NEG; tmax = fmaxf(tmax, s[q]); }
            tmax = fmaxf(tmax, bperm_f(lane ^ 32, tmax));
            const float m_new = fmaxf(m_run, tmax), sc = __builtin_amdgcn_exp2f(m_run - m_new);
            m_run = m_new;
            float ps = 0.f;
#pragma unroll
            for (int q = 0; q < 16; ++q) { s[q] = __builtin_amdgcn_exp2f(s[q] - m_new); ps += s[q]; }
            l_run = l_run * sc + ps;
#pragma unroll
            for (int q = 0; q < 16; ++q) { o0[q] *= sc; o1[q] *= sc; }
            u32x4 pw0, pw1;
            pw0.x = cvt_pk_bf16(s[0], s[1]); pw0.y = cvt_pk_bf16(s[2], s[3]); pw0.z = cvt_pk_bf16(s[4], s[5]); pw0.w = cvt_pk_bf16(s[6], s[7]);
            pw1.x = cvt_pk_bf16(s[8], s[9]); pw1.y = cvt_pk_bf16(s[10], s[11]); pw1.z = cvt_pk_bf16(s[12], s[13]); pw1.w = cvt_pk_bf16(s[14], s[15]);
            const bf16x8 pf0 = __builtin_bit_cast(bf16x8, pw0), pf1 = __builtin_bit_cast(bf16x8, pw1);
#pragma unroll
            for (int q = 0; q < 4; ++q) *(LAS u32x4*)(vbuf + (j & 1) * 4096 + ((lpc >> 2) * 2 + (q >> 1)) * 1024 + ((q & 1) * 8 + lrow) * 64 + (lpc & 3) * 16) = vr[j % NR][q];
            const LAS unsigned char* vb = vbuf + (j & 1) * 4096 + vrd;
#pragma unroll
            for (int dh = 0; dh < 2; ++dh) {
#pragma unroll
                for (int kg = 0; kg < 2; ++kg) {
                    const v4i16_t vlo = vtr16(vb + (dh * 2 + kg) * 1024), vhi = vtr16(vb + (dh * 2 + kg) * 1024 + 512);
                    const bf16x8 vf = (bf16x8){vlo[0], vlo[1], vlo[2], vlo[3], vhi[0], vhi[1], vhi[2], vhi[3]};
                    if (dh == 0) o0 = __builtin_amdgcn_mfma_f32_32x32x16_bf16(vf, kg == 0 ? pf0 : pf1, o0, 0, 0, 0);
                    else o1 = __builtin_amdgcn_mfma_f32_32x32x16_bf16(vf, kg == 0 ? pf0 : pf1, o1, 0, 0, 0);
                }
            }
        }
#undef AT_PAT
#undef AT_KT
#undef AT_DIL
#undef AT_QS
#undef AT_RR
        const float lt = l_run + bperm_f(lane ^ 32, l_run), rl = PASS == 1 ? 1.0f / lt : 1.0f;
        if (PASS == 0 && hi == 0) ml[srow * NH + hh] = make_float2(m_run, lt);
        bf16_t* op = (PASS == 1 ? att : ost) + srow * D + hh * 64 + 4 * hi;
#pragma unroll
        for (int gq = 0; gq < 4; ++gq) {
            u32x2 w0, w1;
            w0.x = cvt_pk_bf16(o0[4 * gq] * rl, o0[4 * gq + 1] * rl); w0.y = cvt_pk_bf16(o0[4 * gq + 2] * rl, o0[4 * gq + 3] * rl);
            w1.x = cvt_pk_bf16(o1[4 * gq] * rl, o1[4 * gq + 1] * rl); w1.y = cvt_pk_bf16(o1[4 * gq + 2] * rl, o1[4 * gq + 3] * rl);
            *(u32x2*)(op + 8 * gq) = w0; *(u32x2*)(op + 32 + 8 * gq) = w1;
        }
    }
}

__device__ __forceinline__ void phase_attn_coop1(const Ctx& X, const bf16_t* proj, bf16_t* att, const bf16_t* ost, const float2* ml) {
    using pg8::bf16x8;
    const int lane = X.lane, i32 = lane & 31, hi = lane >> 5, w = X.wave;
    LAS unsigned char* kimg = X.lds;
    LAS unsigned char* vimg = X.lds + 49152;
    const float NEG = opaque_f(-3.0e38f); const int seqmax = opaque_i(SEQ - 1);
    const int vrd = ((lane >> 4) & 1) * 32 + (lane & 3) * 8 + (4 * hi + ((lane & 15) >> 2)) * 64;
    const int lrow = X.tid >> 3, lpc = X.tid & 7;
    constexpr int NGRP = BATCH * NH * 32;
    const bool xdeal = (X.G == 256);
    const int ngi = xdeal ? 8 : (NGRP + X.G - 1) / X.G;
    auto group_of = [&](int it) { return xdeal ? (((it * 8 + (X.bid & 7)) << 5) | (X.bid >> 3)) : (X.bid + it * X.G); };
    u32x4 pk[6], pv[6];
    auto prefetch = [&](int grp) {
        const int half = grp & 1, r = (grp >> 1) & 15, hh = (grp >> 5) & 15, b = grp >> 9;
        const bf16_t* base = proj + (size_t)b * SEQ * 3072 + hh * 64;
#pragma unroll
        for (int i = 0; i < 6; ++i) {
            const int ridx = lrow + 64 * i, M = 32 * (8 * half - 4) + ridx;
            int p = 16 * M + r; p = p < 0 ? 0 : p; p = p > seqmax ? seqmax : p;
            const bf16_t* rp = base + (size_t)p * 3072;
            pk[i] = *(const u32x4*)(rp + 1024 + 8 * lpc); pv[i] = *(const u32x4*)(rp + 2048 + 8 * lpc);
        }
    };
    if (group_of(0) < NGRP) prefetch(group_of(0));
#pragma nounroll
    for (int it = 0; it < ngi; ++it) {
        const int grp = group_of(it);
        if (grp >= NGRP) break;
        const int half = grp & 1, r = (grp >> 1) & 15, hh = (grp >> 5) & 15, b = grp >> 9;
        __syncthreads();
#pragma unroll
        for (int i = 0; i < 6; ++i) {
            const int ridx = lrow + 64 * i, tl = ridx >> 5, row = ridx & 31;
            *(LAS u32x4*)(kimg + tl * 4096 + row * 128 + ((lpc ^ (row & 7)) << 4)) = pk[i];
            *(LAS u32x4*)(vimg + tl * 4096 + ((lpc >> 2) * 2 + (row >> 4)) * 1024 + (row & 15) * 64 + (lpc & 3) * 16) = pv[i];
        }
        __syncthreads();
        const int blk = 8 * half + w, t0 = 512 * blk + r;
        const bf16_t* base = proj + (size_t)b * SEQ * 3072 + hh * 64;
        bf16x8 qf[4];
        { const bf16_t* qp = base + (size_t)(t0 + 16 * i32) * 3072 + 8 * hi;
#pragma unroll
          for (int d0 = 0; d0 < 4; ++d0) qf[d0] = *(const bf16x8*)(qp + 16 * d0); }
        const size_t srow = (size_t)(b * SEQ + t0 + 16 * i32);
        float m_run, l_run; f32x16 o0, o1;
        { const float2 mlv = ml[srow * NH + hh]; m_run = mlv.x; l_run = hi == 0 ? mlv.y : 0.f;
          const bf16_t* sp = ost + srow * D + hh * 64 + 4 * hi;
#pragma unroll
          for (int gq = 0; gq < 4; ++gq) { const u32x2 w0 = *(const u32x2*)(sp + 8 * gq), w1 = *(const u32x2*)(sp + 32 + 8 * gq);
              o0[4 * gq] = bf_lo(w0.x); o0[4 * gq + 1] = bf_hi(w0.x); o0[4 * gq + 2] = bf_lo(w0.y); o0[4 * gq + 3] = bf_hi(w0.y);
              o1[4 * gq] = bf_lo(w1.x); o1[4 * gq + 1] = bf_hi(w1.x); o1[4 * gq + 2] = bf_lo(w1.y); o1[4 * gq + 3] = bf_hi(w1.y); } }
        { const int gn = it + 1 < ngi ? group_of(it + 1) : NGRP; if (gn < NGRP) prefetch(gn); }
        const int Mstart = 32 * blk - 128;
        auto qk = [&](int kt) { const LAS unsigned char* kt_ = kimg + (w + kt) * 4096; bf16x8 kf[4];
#pragma unroll
            for (int d0 = 0; d0 < 4; ++d0) kf[d0] = *(const LAS bf16x8*)(kt_ + i32 * 128 + (((2 * d0 + hi) ^ (i32 & 7)) << 4));
            f32x16 s;
#pragma unroll
            for (int q = 0; q < 16; ++q) s[q] = 0.f;
#pragma unroll
            for (int d0 = 0; d0 < 4; ++d0) s = __builtin_amdgcn_mfma_f32_32x32x16_bf16(kf[d0], qf[d0], s, 0, 0, 0);
            return s; };
        f32x16 s = qk(0);
#pragma unroll
        for (int kt = 0; kt < 5; ++kt) {
            const LAS unsigned char* vt_ = vimg + (w + kt) * 4096 + vrd;
            f32x16 sn;
            if (kt + 1 < 5) sn = qk(kt + 1);
            const int hi_ = i32 + 128 - 32 * kt; int lo = hi_ - 128; { const int nk = -(Mstart + 32 * kt); lo = lo > nk ? lo : nk; }
            const int rb = 4 * hi - lo; const unsigned span = (unsigned)(hi_ - lo);
            const bool any = hi_ >= lo;
            float tmax = NEG;
            if (kt >= 1 && kt <= 3 && Mstart + 32 * kt >= 0) {
#pragma unroll
                for (int q = 0; q < 16; ++q) tmax = fmaxf(tmax, s[q]);
            } else {
#pragma unroll
                for (int q = 0; q < 16; ++q) { const int rowc = (q & 3) + 8 * (q >> 2); const bool ok = any && ((unsigned)(rowc + rb) <= span) && (rowc + rb >= 0); s[q] = ok ? s[q] : NEG; tmax = fmaxf(tmax, s[q]); }
            }
            tmax = fmaxf(tmax, bperm_f(lane ^ 32, tmax));
            const float m_new = fmaxf(m_run, tmax), sc = __builtin_amdgcn_exp2f(m_run - m_new);
            m_run = m_new;
            float ps = 0.f;
#pragma unroll
            for (int q = 0; q < 16; ++q) { s[q] = __builtin_amdgcn_exp2f(s[q] - m_new); ps += s[q]; }
            l_run = l_run * sc + ps;
#pragma unroll
            for (int q = 0; q < 16; ++q) { o0[q] *= sc; o1[q] *= sc; }
            u32x4 pw0, pw1;
            pw0.x = cvt_pk_bf16(s[0], s[1]); pw0.y = cvt_pk_bf16(s[2], s[3]); pw0.z = cvt_pk_bf16(s[4], s[5]); pw0.w = cvt_pk_bf16(s[6], s[7]);
            pw1.x = cvt_pk_bf16(s[8], s[9]); pw1.y = cvt_pk_bf16(s[10], s[11]); pw1.z = cvt_pk_bf16(s[12], s[13]); pw1.w = cvt_pk_bf16(s[14], s[15]);
            const bf16x8 pf0 = __builtin_bit_cast(bf16x8, pw0), pf1 = __builtin_bit_cast(bf16x8, pw1);
#pragma unroll
            for (int dh = 0; dh < 2; ++dh) {
#pragma unroll
                for (int kg = 0; kg < 2; ++kg) {
                    const v4i16_t vlo = vtr16(vt_ + (dh * 2 + kg) * 1024), vhi = vtr16(vt_ + (dh * 2 + kg) * 1024 + 512);
                    const bf16x8 vf = (bf16x8){vlo[0], vlo[1], vlo[2], vlo[3], vhi[0], vhi[1], vhi[2], vhi[3]};
                    if (dh == 0) o0 = __builtin_amdgcn_mfma_f32_32x32x16_bf16(vf, kg == 0 ? pf0 : pf1, o0, 0, 0, 0);
                    else o1 = __builtin_amdgcn_mfma_f32_32x32x16_bf16(vf, kg == 0 ? pf0 : pf1, o1, 0, 0, 0);
                }
            }
            if (kt + 1 < 5) s = sn;
        }
        const float lt = l_run + bperm_f(lane ^ 32, l_run), rl = 1.0f / lt;
        bf16_t* op = att + srow * D + hh * 64 + 4 * hi;
#pragma unroll
        for (int gq = 0; gq < 4; ++gq) {
            u32x2 w0, w1;
            w0.x = cvt_pk_bf16(o0[4 * gq] * rl, o0[4 * gq + 1] * rl); w0.y = cvt_pk_bf16(o0[4 * gq + 2] * rl, o0[4 * gq + 3] * rl);
            w1.x = cvt_pk_bf16(o1[4 * gq] * rl, o1[4 * gq + 1] * rl); w1.y = cvt_pk_bf16(o1[4 * gq + 2] * rl, o1[4 * gq + 3] * rl);
            *(u32x2*)(op + 8 * gq) = w0; *(u32x2*)(op + 32 + 8 * gq) = w1;
        }
    }
    __syncthreads();
}

__device__ __forceinline__ void phase_attn_coop0(const Ctx& X, const bf16_t* proj, bf16_t* ost, float2* ml) {
    using pg8::bf16x8;
    const int lane = X.lane, i32 = lane & 31, hi = lane >> 5, w = X.wave;
    LAS unsigned char* vbuf = X.lds + w * 16384;
    LAS unsigned char* kbuf = vbuf + 8192;
    LAS unsigned char* kimg = X.lds;
    LAS unsigned char* vimg = X.lds + 53248;
    const float NEG = opaque_f(-3.0e38f); const int seqmax = opaque_i(SEQ - 1);
    const int vrd = ((lane >> 4) & 1) * 32 + (lane & 3) * 8 + (4 * hi + ((lane & 15) >> 2)) * 64;
    const int lrow = lane >> 3, lpc = lane & 7;
    constexpr int NGRP = BATCH * NH * 32;
    const bool xdeal = (X.G == 256);
    const int ngi = xdeal ? 8 : (NGRP + X.G - 1) / X.G;
    constexpr int PD = 2, NR = 3;
#pragma nounroll
    for (int it = 0; it < ngi; ++it) {
        const int grp = xdeal ? (((it * 8 + (X.bid & 7)) << 5) | (X.bid >> 3)) : (X.bid + it * X.G);
        if (grp >= NGRP) break;
        const int n0 = 2 * (grp & 31), hh = (grp >> 5) & 15, b = grp >> 9;
        const int r = w & 3, bq = w >> 2, blk = n0 + bq, t0 = 128 * blk + r;
        const bf16_t* base = proj + (size_t)b * SEQ * 3072 + hh * 64;
        __syncthreads();
        bf16x8 qf[4];
        { const bf16_t* qp = base + (size_t)(t0 + 4 * i32) * 3072 + 8 * hi;
#pragma unroll
          for (int d0 = 0; d0 < 4; ++d0) qf[d0] = *(const bf16x8*)(qp + 16 * d0); }
        float m_run = NEG, l_run = 0.f;
        f32x16 o0, o1;
#pragma unroll
        for (int q = 0; q < 16; ++q) { o0[q] = 0.f; o1[q] = 0.f; }
        const size_t srow = (size_t)(b * SEQ + t0 + 4 * i32);
#define AT_TILE(kf, Mstart_, kt_, qi_, VADDR, FULLOK) do { \
            f32x16 s; _Pragma("unroll") for (int q = 0; q < 16; ++q) s[q] = 0.f; \
            _Pragma("unroll") for (int d0 = 0; d0 < 4; ++d0) s = __builtin_amdgcn_mfma_f32_32x32x16_bf16(kf[d0], qf[d0], s, 0, 0, 0); \
            const int hi_ = (qi_) + 128 - 32 * (kt_); int lo = hi_ - 128; { const int nk = -((Mstart_) + 32 * (kt_)); lo = lo > nk ? lo : nk; } \
            const int rb = 4 * hi - lo; const unsigned span = (unsigned)(hi_ - lo); const bool any = hi_ >= lo; \
            float tmax = NEG; \
            if ((FULLOK) && (Mstart_) + 32 * (kt_) >= 0) { _Pragma("unroll") for (int q = 0; q < 16; ++q) tmax = fmaxf(tmax, s[q]); }     \
            else { _Pragma("unroll") for (int q = 0; q < 16; ++q) { const int rowc = (q & 3) + 8 * (q >> 2); const bool ok = any && ((unsigned)(rowc + rb) <= span) && (rowc + rb >= 0); s[q] = ok ? s[q] : NEG; tmax = fmaxf(tmax, s[q]); } } \
            tmax = fmaxf(tmax, bperm_f(lane ^ 32, tmax)); \
            const float m_new = fmaxf(m_run, tmax), sc = __builtin_amdgcn_exp2f(m_run - m_new); m_run = m_new; \
            float ps = 0.f; \
            _Pragma("unroll") for (int q = 0; q < 16; ++q) { s[q] = __builtin_amdgcn_exp2f(s[q] - m_new); ps += s[q]; } \
            l_run = l_run * sc + ps; \
            _Pragma("unroll") for (int q = 0; q < 16; ++q) { o0[q] *= sc; o1[q] *= sc; } \
            u32x4 pw0, pw1; \
            pw0.x = cvt_pk_bf16(s[0], s[1]); pw0.y = cvt_pk_bf16(s[2], s[3]); pw0.z = cvt_pk_bf16(s[4], s[5]); pw0.w = cvt_pk_bf16(s[6], s[7]); \
            pw1.x = cvt_pk_bf16(s[8], s[9]); pw1.y = cvt_pk_bf16(s[10], s[11]); pw1.z = cvt_pk_bf16(s[12], s[13]); pw1.w = cvt_pk_bf16(s[14], s[15]); \
            const bf16x8 pf0 = __builtin_bit_cast(bf16x8, pw0), pf1 = __builtin_bit_cast(bf16x8, pw1); \
            _Pragma("unroll") for (int dh = 0; dh < 2; ++dh) { _Pragma("unroll") for (int kg = 0; kg < 2; ++kg) { \
                const LAS unsigned char* va_ = VADDR(dh, kg); \
                const v4i16_t vlo = vtr16(va_), vhi = vtr16(va_ + 512); \
                const bf16x8 vf = (bf16x8){vlo[0], vlo[1], vlo[2], vlo[3], vhi[0], vhi[1], vhi[2], vhi[3]}; \
                if (dh == 0) o0 = __builtin_amdgcn_mfma_f32_32x32x16_bf16(vf, kg == 0 ? pf0 : pf1, o0, 0, 0, 0); \
                else o1 = __builtin_amdgcn_mfma_f32_32x32x16_bf16(vf, kg == 0 ? pf0 : pf1, o1, 0, 0, 0); } } \
        } while (0)
        {
            const int Mstart = (t0 - r) / 4 - 128;
            u32x4 kr[NR][4], vr[NR][4];
            auto issue = [&](int j, u32x4 (&kk)[4], u32x4 (&vv)[4]) {
                const int Mt = Mstart + 32 * j;
#pragma unroll
                for (int q = 0; q < 4; ++q) {
                    int p = 4 * (Mt + 8 * q + lrow) + r; p = p < 0 ? 0 : p; p = p > seqmax ? seqmax : p;
                    const bf16_t* rp = base + (size_t)p * 3072;
                    kk[q] = *(const u32x4*)(rp + 1024 + 8 * (lpc ^ lrow)); vv[q] = *(const u32x4*)(rp + 2048 + 8 * lpc);
                }
            };
#pragma unroll
            for (int j = 0; j < PD; ++j) issue(j, kr[j], vr[j]);
#pragma unroll
            for (int j = 0; j < 5; ++j) {
                if (j + PD < 5) issue(j + PD, kr[(j + PD) % NR], vr[(j + PD) % NR]);
#pragma unroll
                for (int q = 0; q < 4; ++q) *(LAS u32x4*)(kbuf + (j & 1) * 4096 + q * 1024 + lane * 16) = kr[j % NR][q];
                bf16x8 kf[4];
#pragma unroll
                for (int d0 = 0; d0 < 4; ++d0) kf[d0] = *(const LAS bf16x8*)(kbuf + (j & 1) * 4096 + (i32 >> 3) * 1024 + (i32 & 7) * 128 + (((2 * d0 + hi) ^ (i32 & 7)) << 4));
#pragma unroll
                for (int q = 0; q < 4; ++q) *(LAS u32x4*)(vbuf + (j & 1) * 4096 + ((lpc >> 2) * 2 + (q >> 1)) * 1024 + ((q & 1) * 8 + lrow) * 64 + (lpc & 3) * 16) = vr[j % NR][q];
#define AT_VP(dh, kg) (vbuf + (j & 1) * 4096 + vrd + ((dh) * 2 + (kg)) * 1024)
                AT_TILE(kf, Mstart, j, i32, AT_VP, false);
#undef AT_VP
            }
        }
        {
            __builtin_amdgcn_sched_barrier(0);
            u32x4 sh[13];
            const int p0 = 128 * (n0 - 1);
#pragma unroll
            for (int i = 0; i < 13; ++i) {
                const int e_ = X.tid + 512 * i; const bool isv = e_ >= 3328; const int ee = isv ? e_ - 3328 : e_;
                int p = p0 + (ee >> 3); p = p < 0 ? 0 : p; p = p > seqmax ? seqmax : p;
                sh[i] = *(const u32x4*)(base + (size_t)p * 3072 + (isv ? 2048 : 1024) + 8 * (ee & 7));
            }
            __syncthreads();
#pragma unroll
            for (int i = 0; i < 13; ++i) {
                const int e_ = X.tid + 512 * i; const bool isv = e_ >= 3328; const int ee = isv ? e_ - 3328 : e_, row = ee >> 3, pc = ee & 7;
                if (isv) *(LAS u32x4*)(vimg + (pc >> 2) * 26624 + row * 64 + (pc & 3) * 16) = sh[i];
                else *(LAS u32x4*)(kimg + row * 128 + ((pc ^ (row & 7)) << 4)) = sh[i];
            }
            __syncthreads();
            const int Mstart = t0 - 128, s0 = 128 * bq + r;
#pragma nounroll
            for (int kt = 0; kt < 8; ++kt) {
                const int R = s0 + 32 * kt + i32;
                bf16x8 kf[4];
#pragma unroll
                for (int d0 = 0; d0 < 4; ++d0) kf[d0] = *(const LAS bf16x8*)(kimg + R * 128 + (((2 * d0 + hi) ^ (R & 7)) << 4));
#define AT_VP(dh, kg) (vimg + (dh) * 26624 + (s0 + 32 * kt + 16 * (kg)) * 64 + vrd)
                AT_TILE(kf, Mstart, kt, 4 * i32, AT_VP, false);
#undef AT_VP
            }
        }
#undef AT_TILE
        const float lt = l_run + bperm_f(lane ^ 32, l_run);
        if (hi == 0) ml[srow * NH + hh] = make_float2(m_run, lt);
        bf16_t* op = ost + srow * D + hh * 64 + 4 * hi;
#pragma unroll
        for (int gq = 0; gq < 4; ++gq) {
            u32x2 w0, w1;
            w0.x = cvt_pk_bf16(o0[4 * gq], o0[4 * gq + 1]); w0.y = cvt_pk_bf16(o0[4 * gq + 2], o0[4 * gq + 3]);
            w1.x = cvt_pk_bf16(o1[4 * gq], o1[4 * gq + 1]); w1.y = cvt_pk_bf16(o1[4 * gq + 2], o1[4 * gq + 3]);
            *(u32x2*)(op + 8 * gq) = w0; *(u32x2*)(op + 32 + 8 * gq) = w1;
        }
    }
    __syncthreads();
}

__device__ __forceinline__ void phase_ln_router(const Ctx& X, int layer, const bf16_t* hin, const bf16_t* mixo, const float* g, const float* bta, const float* rb, bf16_t* h1, int cnt_layer, int probe = 0) {
    using pg8::bf16x8;
    LAS unsigned char* Ah = X.lds;
    LAS unsigned char* Al = X.lds + 65536;
    LAS float* P = (LAS float*)X.lds;
    LAS int* s_cnt = (LAS int*)(X.lds + TAB_OFF);
    LAS int* s_gb = s_cnt + 32;
    const int lane = X.lane, w = X.wave, tok = lane & 31, hi = lane >> 5;
    int* tok_e = (int*)(X.ws + WS_TOKE); int* tok_r = (int*)(X.ws + WS_TOKR); float* glist = (float*)(X.ws + WS_GLIST); unsigned char* XG8 = (unsigned char*)(X.ws + WS_XG); int* stok = (int*)(X.ws + WS_STOK);
    unsigned* cnt = X.ctl + CW_CNT + cnt_layer * 32 * 64;
    const float rbe = rb[tok]; const float ninf = opaque_f(-INFINITY);
    const auto rs_h = __builtin_amdgcn_make_buffer_rsrc((void*)hin, 0, -1, 0x00020000), rs_m = __builtin_amdgcn_make_buffer_rsrc((void*)mixo, 0, -1, 0x00020000);
#define LNA_LD(rs_, tokidx_, j_) __builtin_bit_cast(u32x4, __builtin_amdgcn_raw_buffer_load_b128(rs_, lane * 16, (tokidx_) * (D * 2) + (j_) * 1024, 0))
    { LAS float* gl = (LAS float*)(X.lds + 131072 + 3072); gl[X.tid] = g[X.tid]; gl[512 + X.tid] = g[512 + X.tid]; gl[1024 + X.tid] = bta[X.tid]; gl[1536 + X.tid] = bta[512 + X.tid]; }
    const int tb = X.bid * 128;
    if (tb < T) {
        u32x4 raw[4][4];
#pragma unroll
        for (int tl = 0; tl < 4; ++tl) { const int ti_ = __builtin_amdgcn_readfirstlane(tb + w * 4 + tl);
#pragma unroll
            for (int j = 0; j < 2; ++j) { raw[tl][2 * j] = LNA_LD(rs_h, ti_, j); raw[tl][2 * j + 1] = LNA_LD(rs_m, ti_, j); } }
        LAS int* rec_e = (LAS int*)(X.lds + 131072 + 3072 + 8192); LAS int* rec_l = rec_e + 512; LAS float* rec_g = (LAS float*)(rec_e + 1024);
        if (X.tid < 32) s_cnt[X.tid] = 0;
#pragma nounroll
        for (int rnd = 0; rnd < 4; ++rnd) {
            __syncthreads();
            const int t0 = tb + rnd * 32 + w * 4;
            int lane_o = lane; asm volatile("" : "+v"(lane_o));
            const int tok_o = lane_o & 31, hi_o = lane_o >> 5;
            float v[4][16]; u32x2 xo[4][2];
            int gl_o = 131072 + 3072; asm volatile("" : "+s"(gl_o)); const LAS float* g2 = (const LAS float*)(X.lds + gl_o); const LAS float* b2 = g2 + 1024;
#pragma unroll
            for (int tl = 0; tl < 4; ++tl) {
                const size_t rowo = (size_t)(t0 + tl) * D;
                float s = 0.f;
#pragma unroll
                for (int j = 0; j < 2; ++j) { float a[8], m[8]; unpack8(raw[tl][2 * j], a); unpack8(raw[tl][2 * j + 1], m);
#pragma unroll
                    for (int q = 0; q < 8; ++q) { v[tl][j * 8 + q] = DN_ALPHA * a[q] + m[q]; s += v[tl][j * 8 + q]; } }
                const float mean = wave_sum(s) * (1.f / D); float s2 = 0.f;
#pragma unroll
                for (int q = 0; q < 16; ++q) { v[tl][q] -= mean; s2 += v[tl][q] * v[tl][q]; }
                const float rstd = rsqrtf(wave_sum(s2) * (1.f / D) + opaque_f(LN_EPS));
#pragma unroll
                for (int j = 0; j < 2; ++j) { const f32x4 g0 = *(const LAS f32x4*)(g2 + j * 512 + lane * 8), g1 = *(const LAS f32x4*)(g2 + j * 512 + lane * 8 + 4), b0 = *(const LAS f32x4*)(b2 + j * 512 + lane * 8), b1 = *(const LAS f32x4*)(b2 + j * 512 + lane * 8 + 4);
#pragma unroll
                    for (int q = 0; q < 4; ++q) { v[tl][j * 8 + q] = v[tl][j * 8 + q] * rstd * g0[q] + b0[q]; v[tl][j * 8 + 4 + q] = v[tl][j * 8 + 4 + q] * rstd * g1[q] + b1[q]; } }
                xo[tl][0].x = pk4_fp8(v[tl][0], v[tl][1], v[tl][2], v[tl][3]); xo[tl][0].y = pk4_fp8(v[tl][4], v[tl][5], v[tl][6], v[tl][7]);
                xo[tl][1].x = pk4_fp8(v[tl][8], v[tl][9], v[tl][10], v[tl][11]); xo[tl][1].y = pk4_fp8(v[tl][12], v[tl][13], v[tl][14], v[tl][15]);
                const int tr = w * 4 + tl;
#pragma unroll
                for (int j = 0; j < 2; ++j) {
                    u32x4 oh, ol; float lo[8];
                    oh.x = cvt_pk_bf16(v[tl][j * 8 + 0], v[tl][j * 8 + 1]); oh.y = cvt_pk_bf16(v[tl][j * 8 + 2], v[tl][j * 8 + 3]); oh.z = cvt_pk_bf16(v[tl][j * 8 + 4], v[tl][j * 8 + 5]); oh.w = cvt_pk_bf16(v[tl][j * 8 + 6], v[tl][j * 8 + 7]);
                    float hf[8]; unpack8(oh, hf);
#pragma unroll
                    for (int q = 0; q < 8; ++q) lo[q] = v[tl][j * 8 + q] - hf[q];
                    ol = pack8(lo);
                    *(u32x4*)(h1 + rowo + j * 512 + lane * 8) = oh;
                    const int ch = ((lane_o + 64 * j) ^ (tr & 7)) << 4;
                    *(LAS u32x4*)(Ah + tr * 2048 + ch) = oh; *(LAS u32x4*)(Al + tr * 2048 + ch) = ol;
                }

            }
            if (rnd < 3) {
#pragma unroll
                for (int tl = 0; tl < 4; ++tl) { const int ti_ = __builtin_amdgcn_readfirstlane(t0 + 32 + tl);
#pragma unroll
                    for (int j = 0; j < 2; ++j) { raw[tl][2 * j] = LNA_LD(rs_h, ti_, j); raw[tl][2 * j + 1] = LNA_LD(rs_m, ti_, j); } } }
            bf16x8 wfh[8], wfl[8];
            { const bf16_t* rwh = (const bf16_t*)(X.ws + WS_RWH) + ((size_t)layer * NE + tok) * D + 128 * w + 8 * hi; const bf16_t* rwl = (const bf16_t*)(X.ws + WS_RWL) + ((size_t)layer * NE + tok) * D + 128 * w + 8 * hi;
#pragma unroll
              for (int i = 0; i < 8; ++i) { wfh[i] = *(const bf16x8*)(rwh + 16 * i); wfl[i] = *(const bf16x8*)(rwl + 16 * i); } }
            __syncthreads();
            f32x16 acc;
#pragma unroll
            for (int q = 0; q < 16; ++q) acc[q] = 0.f;
#pragma unroll
            for (int i = 0; i < 8; ++i) {
                const int ch = ((2 * (8 * w + i) + hi_o) ^ (tok_o & 7)) << 4;
                const bf16x8 bh = *(const LAS bf16x8*)(Ah + tok_o * 2048 + ch), bl = *(const LAS bf16x8*)(Al + tok_o * 2048 + ch);
                acc = __builtin_amdgcn_mfma_f32_32x32x16_bf16(wfh[i], bh, acc, 0, 0, 0);
                acc = __builtin_amdgcn_mfma_f32_32x32x16_bf16(wfl[i], bh, acc, 0, 0, 0);
                acc = __builtin_amdgcn_mfma_f32_32x32x16_bf16(wfh[i], bl, acc, 0, 0, 0);
            }
            __syncthreads();
#pragma unroll
            for (int q = 0; q < 16; ++q) P[(w * 32 + tok) * 33 + (q & 3) + 8 * (q >> 2) + 4 * hi] = acc[q];
            __syncthreads();
            float lg[4];
#pragma unroll
            for (int tl = 0; tl < 4; ++tl) { float a = 0.f;
#pragma unroll
                for (int ww = 0; ww < 4; ++ww) a += P[((hi * 4 + ww) * 32 + (w * 4 + tl)) * 33 + tok];
                a += bperm_f(lane_o ^ 32, a); lg[tl] = a + rbe; }
            const int e = tok;
            int my_e = 0; float my_g = 0.f;
#pragma unroll
            for (int tl = 0; tl < 4; ++tl) {
                float cur = lg[tl];
                float sv0 = 0.f, sv1 = 0.f, sv2 = 0.f, sv3 = 0.f; int si0 = 0, si1 = 0, si2 = 0, si3 = 0;
#pragma unroll
                for (int k = 0; k < 4; ++k) {
                    float bv = cur; int bi = e;
#define LNA_XS(o) { const float ov = swz_f<o>(bv); const int oi = swz_i<o>(bi); if (ov > bv || (ov == bv && oi < bi)) { bv = ov; bi = oi; } }
                    LNA_XS(1) LNA_XS(2) LNA_XS(4) LNA_XS(8) LNA_XS(16)
#undef LNA_XS
                    if (k == 0) { sv0 = bv; si0 = bi; } else if (k == 1) { sv1 = bv; si1 = bi; } else if (k == 2) { sv2 = bv; si2 = bi; } else { sv3 = bv; si3 = bi; }
                    if (e == bi) cur = ninf;
                }
                const float e1 = __expf(sv1 - sv0), e2 = __expf(sv2 - sv0), e3 = __expf(sv3 - sv0), inv = 1.f / (1.f + e1 + e2 + e3);
                if ((lane >> 2) == tl) { const int k = lane & 3; my_e = k == 0 ? si0 : k == 1 ? si1 : k == 2 ? si2 : si3; my_g = (k == 0 ? 1.f : k == 1 ? e1 : k == 2 ? e2 : e3) * inv; }
            }
            if (lane < 16) { const int my_lr = __hip_atomic_fetch_add(&s_cnt[my_e], 1, __ATOMIC_RELAXED, __HIP_MEMORY_SCOPE_WORKGROUP);
                const int ri = (rnd * 32 + w * 4 + (lane >> 2)) * 4 + (lane & 3); rec_e[ri] = my_e; rec_l[ri] = my_lr; rec_g[ri] = my_g; }
#ifdef PROBE_LNA
            if (!(probe & 1))
#endif
#pragma unroll
            for (int tl = 0; tl < 4; ++tl) {
                unsigned char* dst = XG8 + (size_t)(t0 + tl) * D + lane * 8;
                *(u32x2*)(dst) = xo[tl][0]; *(u32x2*)(dst + 512) = xo[tl][1]; }
        }
        __syncthreads();
        { int tid_o = X.tid; asm volatile("" : "+v"(tid_o));
          if (tid_o < 32) { const int c = s_cnt[tid_o]; s_gb[tid_o] = c ? (int)atomicAdd(cnt + tid_o * 64, (unsigned)c) : 0; }
          __syncthreads();
          const int e_ = rec_e[tid_o], r_ = s_gb[e_] + rec_l[tid_o], t_ = tb + (tid_o >> 2); const float g_ = rec_g[tid_o];
          tok_e[t_ * 4 + (tid_o & 3)] = e_; tok_r[t_ * 4 + (tid_o & 3)] = r_; glist[(size_t)e_ * T + r_] = g_; stok[(size_t)e_ * T + r_] = t_; }
    }
}
#undef LNA_LD

__device__ __forceinline__ void load_tile_table(const Ctx& X, int layer, LAS int* tb) {
    __syncthreads();
    if (X.tid < 64) {
        const int c = X.tid < 32 ? (int)__hip_atomic_load(X.ctl + CW_CNT + (layer * 32 + X.tid) * 64, RLX_AGENT) : 0;
        const int tl = (c + 255) >> 8; int incl = tl;
#pragma unroll
        for (int o = 1; o < 32; o <<= 1) { const int t = bperm_i(X.lane - o, incl); if ((X.tid & 31) >= o) incl += t; }
        if (X.tid < 32) { tb[X.tid] = incl - tl; if (X.tid == 31) tb[32] = incl; }
    }
    __syncthreads();
}

template <bool OUT_F32>
__device__ __forceinline__ void phase_combine_ln(const Ctx& X, int layer, const bf16_t* h1, const bf16_t* Y, const float* g, const float* bta, void* outp) {
    const int lane = X.lane;
    const int gw = X.bid * NWAVES + X.wave, NGW = X.G * NWAVES;
    const int* tok_e = (const int*)(X.ws + WS_TOKE); const int* tok_r = (const int*)(X.ws + WS_TOKR);
    int basev = 0;
    { const int c = lane < 32 ? (int)__hip_atomic_load(X.ctl + CW_CNT + (layer * 32 + lane) * 64, RLX_AGENT) : 0; const int pc = ((c + 255) >> 8) << 8; int incl = pc;
#pragma unroll
      for (int o = 1; o < 32; o <<= 1) { const int t = bperm_i(lane - o, incl); if ((lane & 31) >= o) incl += t; }
      basev = incl - pc; }
    float gg[16], bb[16];
#pragma unroll
    for (int j = 0; j < 2; ++j) {
        const f32x4 g0 = *(const f32x4*)(g + j * 512 + lane * 8), g1 = *(const f32x4*)(g + j * 512 + lane * 8 + 4), b0 = *(const f32x4*)(bta + j * 512 + lane * 8), b1 = *(const f32x4*)(bta + j * 512 + lane * 8 + 4);
#pragma unroll
        for (int q = 0; q < 4; ++q) { gg[j * 8 + q] = g0[q]; gg[j * 8 + 4 + q] = g1[q]; bb[j * 8 + q] = b0[q]; bb[j * 8 + 4 + q] = b1[q]; }
    }
    int nslot = 0, ne_ = 0;
    if (gw < T && lane < 4) { nslot = tok_r[gw * 4 + lane]; ne_ = tok_e[gw * 4 + lane]; }
    for (int bt = gw; bt < T; bt += NGW) {
        int myslot = nslot; const int mye = ne_;
        nslot = 0; ne_ = 0;
        if (bt + NGW < T && lane < 4) { nslot = tok_r[(bt + NGW) * 4 + lane]; ne_ = tok_e[(bt + NGW) * 4 + lane]; }
        myslot += bperm_i(mye, basev);
        const int s0 = bperm_i(0, myslot), s1 = bperm_i(1, myslot), s2 = bperm_i(2, myslot), s3 = bperm_i(3, myslot);
        float v[16]; float s = 0.f;
#pragma unroll
        for (int j = 0; j < 2; ++j) {
            const int off = j * 512 + lane * 8;
            float a[8], y0[8], y1[8], y2[8], y3[8];
            unpack8(*(const u32x4*)(h1 + (size_t)bt * D + off), a);
            const unsigned char* Y8 = (const unsigned char*)Y;
            unpack8_fp8(*(const u32x2*)(Y8 + (size_t)s0 * D + off), y0); unpack8_fp8(*(const u32x2*)(Y8 + (size_t)s1 * D + off), y1); unpack8_fp8(*(const u32x2*)(Y8 + (size_t)s2 * D + off), y2); unpack8_fp8(*(const u32x2*)(Y8 + (size_t)s3 * D + off), y3);
#pragma unroll
            for (int q = 0; q < 8; ++q) { v[j * 8 + q] = DN_ALPHA * a[q] + (((y0[q] + y1[q]) + y2[q]) + y3[q]) * (1.0f / Y8_SCALE); s += v[j * 8 + q]; }
        }
        const float mean = wave_sum(s) * (1.f / D); float s2q = 0.f;
#pragma unroll
        for (int q = 0; q < 16; ++q) { v[q] -= mean; s2q += v[q] * v[q]; }
        const float rstd = rsqrtf(wave_sum(s2q) * (1.f / D) + opaque_f(LN_EPS));
#pragma unroll
        for (int q = 0; q < 16; ++q) v[q] = v[q] * rstd * gg[q] + bb[q];
#pragma unroll
        for (int j = 0; j < 2; ++j) {
            const size_t o = (size_t)bt * D + j * 512 + lane * 8;
            if (OUT_F32) { float* op = (float*)outp + o; *(f32x4*)(op) = (f32x4){v[j * 8 + 0], v[j * 8 + 1], v[j * 8 + 2], v[j * 8 + 3]}; *(f32x4*)(op + 4) = (f32x4){v[j * 8 + 4], v[j * 8 + 5], v[j * 8 + 6], v[j * 8 + 7]}; }
            else { u32x4 w; w.x = cvt_pk_bf16(v[j * 8 + 0], v[j * 8 + 1]); w.y = cvt_pk_bf16(v[j * 8 + 2], v[j * 8 + 3]); w.z = cvt_pk_bf16(v[j * 8 + 4], v[j * 8 + 5]); w.w = cvt_pk_bf16(v[j * 8 + 6], v[j * 8 + 7]); *(u32x4*)((bf16_t*)outp + o) = w; }
        }
    }
}


__device__ __forceinline__ Ctx refresh_ctx(const Ctx& X0) {
    Ctx X = X0; int wv = X0.wave; asm volatile("" : "+s"(wv)); int t = wv * 64 + lane_id(); asm volatile("" : "+v"(t)); X.tid = t; X.lane = t & 63; X.wave = wv;
    asm volatile("" : "+s"(X.ws), "+s"(X.ctl), "+s"(X.G), "+s"(X.bid));
    return X;
}
#ifndef STAG
#define STAG 0
#endif
__device__ __forceinline__ void stagger(const Ctx& X) { const int n = ((X.bid >> 3) & 31) * STAG;
#pragma nounroll
    for (int i = 0; i < n; ++i) __builtin_amdgcn_s_sleep(1); }
struct Args { const float* in[26]; float* out; unsigned char* ws; int ph_lo, ph_hi; };
constexpr int N_PHASES = 1 + 2 * (6 + 4) + 2 * (4 + 4);
#define GP_ALIGN true
#define GP_SP2 true

__global__ void __launch_bounds__(NTHR, 2) mk_fwd(Args args) {
    extern __shared__ __attribute__((aligned(16))) unsigned char lds_raw[];
    Ctx X0;
    X0.lds = (LAS unsigned char*)lds_raw;
    X0.tid = threadIdx.x; X0.lane = X0.tid & 63; X0.wave = __builtin_amdgcn_readfirstlane(X0.tid >> 6);
    X0.G = gridDim.x; X0.bid = blockIdx.x;
    X0.ws = (GAS unsigned char*)args.ws; X0.ctl = (unsigned*)(args.ws + WS_CTL);
    volatile LAS unsigned* MISC = (volatile LAS unsigned*)(X0.lds + MISC_OFF);
    if (X0.tid < 32) MISC[X0.tid] = 0u;
    __syncthreads();
    XcdBarrier bar; bar.bar = X0.ctl + CW_BAR; bar.x = 0; bar.st = nullptr; bar.wave = X0.wave;
    if (MK_ONE_LAUNCH) bar = xcd_barrier_post(X0.ctl + CW_BAR, MISC + 8, X0.wave);
    volatile LAS unsigned long long* ptab = (volatile LAS unsigned long long*)(X0.lds + TAB_OFF + 1024);
    if (X0.tid < 26) ptab[X0.tid] = (unsigned long long)args.in[X0.tid];
    __syncthreads();
#define INP(k) ld_ptr(ptab, k)
    const int lo = args.ph_lo, hi = args.ph_hi;
    int ph = 0;
#define IN() (lo <= ph && ph < hi)
#define SEAM() do { if (MK_ONE_LAUNCH && lo <= ph && ph + 1 < hi) xcd_barrier(bar); ++ph; } while (0)

#define H0 ((bf16_t*)(X.ws + WS_H0))
#define H1 ((bf16_t*)(X.ws + WS_H1))
#define PROJ ((bf16_t*)(X.ws + WS_PROJ))
#define MIX ((bf16_t*)(X.ws + WS_MIX))
#define MIXO ((bf16_t*)(X.ws + WS_MIXO))
#define Z ((bf16_t*)(X.ws + WS_Z))
#define ACT ((bf16_t*)(X.ws + WS_ACT))
#define Y ((bf16_t*)(X.ws + WS_Y))
#define tb ((LAS int*)(X.lds + TAB_OFF + 512))

#ifndef DUP_MASK
#define DUP_MASK 0
#endif
    enum { P_PRO, P_E1, P_S5A, P_S5C, P_S5B, P_E3, P_E4, P_O1, P_ATT, P_O3, P_LNA, P_M1, P_M2, P_LNB, P_ATT1 };
#define PHASE_BEGIN(k) _Pragma("nounroll") for (int _r = 0; _r < ((((DUP_MASK) >> (k)) & 1) + 1); ++_r) { if (IN()) { const Ctx X = refresh_ctx(X0);
#define PHASE_END } SEAM(); }
    PHASE_BEGIN(P_PRO)  phase_prologue(X, ptab);  PHASE_END

#pragma nounroll
    for (int layer = 0; layer < DEPTH; ++layer) {
        const int i = layer >> 1;
        if ((layer & 1) == 0) {
            PHASE_BEGIN(P_E1)  pg8::Gemm gm{H0, (const bf16_t*)(X.ws + WS_WIN) + (size_t)i * 2048 * D, T, 2048, D}; pg8::StaticOrder S; S.init(T, 2048, D, X.G, X.bid);
                pg8::EpiStore E{PROJ, 2048};
                pg8::gemm_phase<pg8::EpiStore, pg8::StaticOrder, GP_ALIGN, GP_SP2>(X.lds, gm, S, E, X.wave);  PHASE_END
            PHASE_BEGIN(P_S5A)  phase_s5<1>(X, i, PROJ, INP(2), INP(8), INP(9), INP(10), MIX, Z);  PHASE_END
            PHASE_BEGIN(P_S5C)  phase_s5_carry(X, i);  PHASE_END
#ifdef PROBE_S5B
            PHASE_BEGIN(P_S5B)  phase_s5<2>(X, i, PROJ, INP(2), INP(8), INP(9), INP(10), MIX, Z, _r == 0 ? opaque_i(PROBE_S5B) : 0);  PHASE_END
#else
            PHASE_BEGIN(P_S5B)  phase_s5<2>(X, i, PROJ, INP(2), INP(8), INP(9), INP(10), MIX, Z);  PHASE_END
#endif
            PHASE_BEGIN(P_E3)  pg8::Gemm gm{Z, (const bf16_t*)(X.ws + WS_WGLU) + (size_t)i * 512 * 512, T, 512, 512}; pg8::StaticOrder S; S.init(T, 512, 512, X.G, X.bid);
                pg8::EpiGlu E{Z, MIX, INP(12) + (size_t)i * SSM_W};
                pg8::gemm_phase<pg8::EpiGlu, pg8::StaticOrder, GP_ALIGN, GP_SP2>(X.lds, gm, S, E, X.wave);  PHASE_END
            PHASE_BEGIN(P_E4)  pg8::Gemm gm{MIX, (const bf16_t*)(X.ws + WS_WOUT) + (size_t)i * D * D, T, D, D}; pg8::StaticOrder S; S.init(T, D, D, X.G, X.bid);
                pg8::EpiStore E{MIXO, D};
                pg8::gemm_phase<pg8::EpiStore, pg8::StaticOrder, GP_ALIGN, GP_SP2>(X.lds, gm, S, E, X.wave);  PHASE_END
        } else {
            PHASE_BEGIN(P_O1)  pg8::Gemm gm{H0, (const bf16_t*)(X.ws + WS_WQKV) + (size_t)i * 3072 * D, T, 3072, D}; pg8::StaticOrder S; S.init(T, 3072, D, X.G, X.bid);
                pg8::EpiRope E{PROJ, (const f32x2*)(X.ws + WS_ROPE)};
#if defined(PROBE_O1)
                if (_r == 0) pg8::gemm_phase<pg8::EpiRope, pg8::StaticOrder, GP_ALIGN, GP_SP2, false, PROBE_O1>(X.lds, gm, S, E, X.wave); else
#endif
                pg8::gemm_phase<pg8::EpiRope, pg8::StaticOrder, GP_ALIGN, GP_SP2>(X.lds, gm, S, E, X.wave);  PHASE_END
            PHASE_BEGIN(P_ATT)  phase_attn_coop0(X, PROJ, MIXO, (float2*)(X.ws + WS_S5X));  PHASE_END
            PHASE_BEGIN(P_ATT1)  phase_attn_coop1(X, PROJ, MIX, MIXO, (const float2*)(X.ws + WS_S5X));  PHASE_END
            PHASE_BEGIN(P_O3)  pg8::Gemm gm{MIX, (const bf16_t*)(X.ws + WS_WO) + (size_t)i * D * D, T, D, D}; pg8::StaticOrder S; S.init(T, D, D, X.G, X.bid);
                pg8::EpiStore E{MIXO, D};
                pg8::gemm_phase<pg8::EpiStore, pg8::StaticOrder, GP_ALIGN, GP_SP2>(X.lds, gm, S, E, X.wave);  PHASE_END
        }
#ifdef PROBE_LNA
        PHASE_BEGIN(P_LNA)  phase_ln_router(X, layer, H0, MIXO, INP(16) + layer * D, INP(17) + layer * D, INP(21) + layer * NE, H1, _r == 0 ? layer + 4 : layer, _r == 0 ? opaque_i(PROBE_LNA) : 0);  PHASE_END
#else
        PHASE_BEGIN(P_LNA)  phase_ln_router(X, layer, H0, MIXO, INP(16) + layer * D, INP(17) + layer * D, INP(21) + layer * NE, H1, layer);  PHASE_END
#endif
        PHASE_BEGIN(P_M1)  load_tile_table(X, layer, tb);
            pg8::Gemm gm{(const bf16_t*)(X.ws + WS_XG), (const bf16_t*)(X.ws + WS_WGU + (size_t)layer * NE * 2048 * D), 0, 2048, D / 2};
            pg8::MoeOrder<8, true> S; S.init(tb, X.G, X.bid, 2048, D / 2); S.stok = (const int*)(X.ws + WS_STOK); S.cnt = X.ctl + CW_CNT + layer * 32 * 64; S.preload_ids((LAS unsigned short*)(X.lds + 131072 + 3072), X.tid, X.wave);
            stagger(X);
#ifdef PROBE_NOSTORE
            pg8::EpiSwiglu E{opaque_i(((DUP_MASK >> P_M1) & 1) && _r == 0) != 0, ACT, INP(23) + (size_t)layer * NE * 2048};
#else
            S.preload_bias<9, true>((LAS float*)(X.lds + 131072 + 3072 + 9216), INP(23) + (size_t)layer * NE * 2048, X.tid, X.wave);
            pg8::EpiSwiglu E{ACT, (const LAS float*)(X.lds + 131072 + 3072 + 9216)};
#endif
#if defined(PROBE_M1)
            if (_r == 0) pg8::gemm_phase<pg8::EpiSwiglu, pg8::MoeOrder<8, true>, GP_ALIGN, GP_SP2, true, PROBE_M1>(X.lds, gm, S, E, X.wave, opaque_i(127 - W8_SHIFT_GU), opaque_i(127)); else
#endif
            pg8::gemm_phase<pg8::EpiSwiglu, pg8::MoeOrder<8, true>, GP_ALIGN, GP_SP2, true>(X.lds, gm, S, E, X.wave, opaque_i(127 - W8_SHIFT_GU), opaque_i(127));  PHASE_END
        PHASE_BEGIN(P_M2)  load_tile_table(X, layer, tb);
            pg8::Gemm gm{ACT, (const bf16_t*)(X.ws + WS_WDN + (size_t)layer * NE * D * D), 0, D, D / 2};
            pg8::MoeOrder<4, false> S; S.init(tb, X.G, X.bid, D, D / 2); S.stok = nullptr; S.cnt = nullptr; S.idl = nullptr;
            stagger(X);
#ifdef PROBE_NOSTORE
            pg8::EpiDown E{opaque_i(((DUP_MASK >> P_M2) & 1) && _r == 0) != 0, Y, INP(25) + (size_t)layer * NE * D, (const float*)(X.ws + WS_GLIST)};
#else
            S.preload_gates((LAS float*)(X.lds + 131072 + 3072), (const float*)(X.ws + WS_GLIST), X.tid, X.wave);
            S.preload_bias<5, false>((LAS float*)(X.lds + 131072 + 3072 + 10240), INP(25) + (size_t)layer * NE * D, X.tid, X.wave);
            pg8::EpiDown E{Y, (const LAS float*)(X.lds + 131072 + 3072 + 10240), (const LAS float*)(X.lds + 131072 + 3072)};
#endif
#if defined(PROBE_M2)
            if (_r == 0) pg8::gemm_phase<pg8::EpiDown, pg8::MoeOrder<4, false>, GP_ALIGN, GP_SP2, true, PROBE_M2>(X.lds, gm, S, E, X.wave, opaque_i(127 - W8_SHIFT_DN), opaque_i(127)); else
#endif
            pg8::gemm_phase<pg8::EpiDown, pg8::MoeOrder<4, false>, GP_ALIGN, GP_SP2, true>(X.lds, gm, S, E, X.wave, opaque_i(127 - W8_SHIFT_DN), opaque_i(127));  PHASE_END
        PHASE_BEGIN(P_LNB)
            if (layer == DEPTH - 1) phase_combine_ln<true>(X, layer, H1, Y, INP(18) + layer * D, INP(19) + layer * D, (void*)args.out);
            else phase_combine_ln<false>(X, layer, H1, Y, INP(18) + layer * D, INP(19) + layer * D, (void*)H0);
         PHASE_END
    }
#undef IN
#undef SEAM
#undef PHASE_BEGIN
#undef PHASE_END
#undef H0
#undef H1
#undef PROJ
#undef MIX
#undef MIXO
#undef Z
#undef ACT
#undef Y
#undef tb
}

extern "C" void kernel_launch(void* const* d_in, const int* in_sizes, int n_in, void* d_out, int out_size, void* d_ws, size_t ws_size, hipStream_t stream) {
    static int grid = 0;
    if (grid == 0) {
        if (n_in != 26 || out_size != T * D || ws_size < WS_END) { fprintf(stderr, "kernel_launch: unexpected shapes n_in %d out %d ws %zu (need %zu)\n", n_in, out_size, ws_size, (size_t)WS_END); grid = -1; return; }
        int dev = 0, cus = 0, per_cu = 0;
        if (hipGetDevice(&dev) != hipSuccess || hipDeviceGetAttribute(&cus, hipDeviceAttributeMultiprocessorCount, dev) != hipSuccess) { grid = -1; return; }
        if (hipFuncSetAttribute((const void*)mk_fwd, hipFuncAttributeMaxDynamicSharedMemorySize, LDS_BYTES) != hipSuccess) { fprintf(stderr, "kernel_launch: hipFuncSetAttribute failed\n"); grid = -1; return; }
        if (hipOccupancyMaxActiveBlocksPerMultiprocessor(&per_cu, (const void*)mk_fwd, NTHR, LDS_BYTES) != hipSuccess || per_cu < 1) fprintf(stderr, "kernel_launch: occupancy query says %d\n", per_cu);
        (void)hipGetLastError();
        grid = cus;
        if (grid < 256) { fprintf(stderr, "kernel_launch: %d CUs; the LN+router phase deals one 128-token slab per workgroup and needs 256\n", cus); grid = -1; return; }
        if (grid > 256) grid = 256;
    }
    if (grid < 0) return;
    if (hipMemsetAsync((char*)d_ws + WS_CTL, 0, CTL_ZERO_BYTES, stream) != hipSuccess) return;
    Args a{};
    for (int i = 0; i < 26; ++i) a.in[i] = (const float*)d_in[i];
    a.out = (float*)d_out; a.ws = (unsigned char*)d_ws;
#if MK_ONE_LAUNCH
    a.ph_lo = 0; a.ph_hi = DUP_MASK ? 100000 : N_PHASES;
    hipLaunchKernelGGL(mk_fwd, dim3(grid), dim3(NTHR), LDS_BYTES, stream, a);
#else
    for (int p = 0; p < N_PHASES; ++p) { a.ph_lo = p; a.ph_hi = p + 1; hipLaunchKernelGGL(mk_fwd, dim3(grid), dim3(NTHR), LDS_BYTES, stream, a); }
#endif
}
```

```cpp
#include <hip/hip_runtime.h>
#include <cstdio>
#include <cstdint>

#ifndef MK_ONE_LAUNCH
#define MK_ONE_LAUNCH 1
#endif

#define GAS __attribute__((address_space(1)))
#define LAS __attribute__((address_space(3)))
#define RLX_AGENT __ATOMIC_RELAXED, __HIP_MEMORY_SCOPE_AGENT
#define WAVE_SYNC() asm volatile("s_waitcnt lgkmcnt(0)" ::: "memory")
typedef float f32x4 __attribute__((ext_vector_type(4)));
typedef float f32x2 __attribute__((ext_vector_type(2)));
typedef unsigned u32x4 __attribute__((ext_vector_type(4)));
typedef unsigned u32x2 __attribute__((ext_vector_type(2)));
typedef unsigned short bf16_t;

constexpr int BATCH = 4, SEQ = 8192, D = 1024, T = BATCH * SEQ, DEPTH = 4;
constexpr int CONV_CH = 512, SSM_W = 512, SSM_G = 32, SSM_H = 16, SSM_P = 64;
constexpr int NH = 16, HD = 64;
constexpr int NE = 32, TOPK = 4, NA = T * TOPK;
constexpr float SW_LIMIT = 7.0f, SW_ALPHA = 1.702f;
constexpr float LN_EPS = 1e-5f;
constexpr float DN_ALPHA = 1.6817928305074290860622509524664f;
constexpr int NWAVES = 8, NTHR = 512;

constexpr size_t MiB = 1u << 20;
constexpr size_t WS_CTL = 0, CTL_ZERO_BYTES = 1 * MiB;
constexpr size_t WS_S5A = 1 * MiB;
constexpr size_t WS_S5B = 1 * MiB + 65536;
constexpr size_t WS_ROPE = 2 * MiB;
constexpr size_t WS_S5X = 48 * MiB;
constexpr size_t WS_TOKE = 4 * MiB;
constexpr size_t WS_TOKR = 4 * MiB + 524288;
constexpr size_t WS_RWH = 5 * MiB;
constexpr size_t WS_RWL = 5 * MiB + 262144;
constexpr size_t WS_GLIST = 8 * MiB;
constexpr size_t WS_S5S = 12 * MiB;
constexpr size_t WS_WIN = 16 * MiB;
constexpr size_t WS_WGLU = 24 * MiB;
constexpr size_t WS_WOUT = 26 * MiB;
constexpr size_t WS_WQKV = 32 * MiB;
constexpr size_t WS_WO = 44 * MiB;
constexpr size_t WS_WGU = 64 * MiB;
constexpr size_t WS_WDN = 576 * MiB;
constexpr size_t WS_H0 = 832 * MiB;
constexpr size_t WS_H1 = 896 * MiB;
constexpr size_t WS_PROJ = 960 * MiB;
constexpr size_t WS_MIX = 1152 * MiB;
constexpr size_t WS_MIXO = 1216 * MiB;
constexpr size_t WS_Z = 1280 * MiB;
constexpr size_t WS_ACT = 1312 * MiB;
constexpr size_t WS_Y = 1584 * MiB;
constexpr size_t WS_XG = 1856 * MiB;
constexpr size_t WS_STOK = 1920 * MiB;
constexpr size_t WS_END = 3904 * MiB;
constexpr int CW_BAR = 4096;
constexpr int CW_CNT = 16384;

constexpr int LDS_BYTES = 163840;
constexpr int MISC_OFF = 131072 + 320;
constexpr int TAB_OFF = 131072 + 1024;

#define XB_TMO      128
#define XB_XCNT(j)  (256  + 64 * (j))
#define XB_XSUB(j)  (1280 + 64 * (j))
#define XB_XGEN(j)  (2304 + 64 * (j))
#define XB_TOP      3328
#define XB_TOPGEN   3392
#define XCD_BAR_WORDS 3456
#define XB_SPIN_CAP (1u << 22)

__device__ __forceinline__ unsigned xb_ld(unsigned* p)              { return __hip_atomic_load(p, __ATOMIC_RELAXED, __HIP_MEMORY_SCOPE_AGENT); }
__device__ __forceinline__ unsigned xb_add(unsigned* p, unsigned v) { return __hip_atomic_fetch_add(p, v, __ATOMIC_RELAXED, __HIP_MEMORY_SCOPE_AGENT); }
__device__ __forceinline__ unsigned xb_xcc_id() { return (unsigned)__builtin_amdgcn_s_getreg((3 << 11) | 20) & 0xFu; }
#define XB_SPIN(cond, bar) do { unsigned _sp = 0; while (cond) { __builtin_amdgcn_s_sleep(1); \
    if ((++_sp & 255u) == 0u) { if (xb_ld(&(bar)[XB_TMO])) break; if (_sp > XB_SPIN_CAP) { atomicAdd(&(bar)[XB_TMO], 1u); break; } } } } while (0)

struct XcdBarrier { unsigned* bar; unsigned x; volatile LAS unsigned* st; int wave; };
__device__ __forceinline__ int xb_lane() { int l; asm volatile("v_mbcnt_lo_u32_b32 %0, -1, 0\n\tv_mbcnt_hi_u32_b32 %0, -1, %0" : "=v"(l)); return l; }

__device__ __forceinline__ XcdBarrier xcd_barrier_post(unsigned* bar, volatile LAS unsigned* st, int wave) {
    XcdBarrier b; b.bar = bar; b.x = xb_xcc_id(); b.st = st; b.wave = wave;
    if (wave == 0 && xb_lane() == 0) (void)xb_add(&bar[XB_XCNT(b.x)], 1u);
    return b;
}
__device__ __forceinline__ void xcd_barrier_complete(unsigned* bar, unsigned x, unsigned& nloc, unsigned& nx) {
    const unsigned G = gridDim.x * gridDim.y * gridDim.z;
    unsigned sum, cnt, mine, sp = 0u;
    for (;;) {
        sum = 0u; cnt = 0u; mine = 0u;
#pragma unroll
        for (unsigned j = 0; j < 16; ++j) { const unsigned c = xb_ld(&bar[XB_XCNT(j)]); sum += c; cnt += (c > 0u) ? 1u : 0u; mine = (j == x) ? c : mine; }
        if (sum == G) break;
        __builtin_amdgcn_s_sleep(1);
        if ((++sp & 255u) == 0u) { if (xb_ld(&bar[XB_TMO])) break; if (sp > XB_SPIN_CAP) { atomicAdd(&bar[XB_TMO], 1u); break; } }
    }
    nloc = mine > 0u ? mine : 1u; nx = cnt > 0u ? cnt : 1u;
}
__device__ __forceinline__ void xcd_barrier(const XcdBarrier& b) {
    asm volatile("s_waitcnt vmcnt(0)" ::: "memory");
    __syncthreads();
    if (b.wave == 0 && xb_lane() == 0) {
        unsigned* bar = b.bar;
        __builtin_amdgcn_s_waitcnt(0);
        unsigned nloc = b.st[0], nx = b.st[1];
        if (nloc == 0u) { xcd_barrier_complete(bar, b.x, nloc, nx); b.st[0] = nloc; b.st[1] = nx; }
        const unsigned old = xb_add(&bar[XB_XSUB(b.x)], 1u);
        const unsigned gen = old / nloc;
        if (old + 1u == (gen + 1u) * nloc) {
            __builtin_amdgcn_fence(__ATOMIC_RELEASE, "agent");
            asm volatile("s_waitcnt vmcnt(0)" ::: "memory");
            const unsigned og = xb_add(&bar[XB_TOP], 1u);
            const unsigned tg = og / nx;
            if (og + 1u == (tg + 1u) * nx) xb_add(&bar[XB_TOPGEN], 1u);
            else XB_SPIN(xb_ld(&bar[XB_TOPGEN]) == tg, bar);
            __builtin_amdgcn_fence(__ATOMIC_ACQUIRE, "agent");
            xb_add(&bar[XB_XGEN(b.x)], 1u);
            asm volatile("s_waitcnt vmcnt(0)" ::: "memory");
        } else {
            XB_SPIN(xb_ld(&bar[XB_XGEN(b.x)]) == gen, bar);
            __builtin_amdgcn_fence(__ATOMIC_ACQUIRE, "agent");
            asm volatile("s_waitcnt vmcnt(0)" ::: "memory");
        }
    }
    __syncthreads();
}

template <int M> __device__ __forceinline__ int swz_i(int v) { static_assert(M > 0 && M < 32, "ds_swizzle bit mode"); return __builtin_amdgcn_ds_swizzle(v, (M << 10) | 0x1f); }
template <int M> __device__ __forceinline__ float swz_f(float v) { return __builtin_bit_cast(float, swz_i<M>(__builtin_bit_cast(int, v))); }
__device__ __forceinline__ int bperm_i(int srclane, int v) { return __builtin_amdgcn_ds_bpermute(srclane << 2, v); }
__device__ __forceinline__ float bperm_f(int srclane, float v) { return __builtin_bit_cast(float, __builtin_amdgcn_ds_bpermute(srclane << 2, __builtin_bit_cast(int, v))); }
__device__ __forceinline__ float rdlane_f(float v, int l) { return __builtin_bit_cast(float, __builtin_amdgcn_readlane(__builtin_bit_cast(int, v), l)); }
__device__ __forceinline__ float wave_sum(float v) {
    v += swz_f<1>(v); v += swz_f<2>(v); v += swz_f<4>(v); v += swz_f<8>(v); v += swz_f<16>(v);
    return rdlane_f(v, 0) + rdlane_f(v, 32);
}
__device__ __forceinline__ float wave_max(float v) {
    v = fmaxf(v, swz_f<1>(v)); v = fmaxf(v, swz_f<2>(v)); v = fmaxf(v, swz_f<4>(v)); v = fmaxf(v, swz_f<8>(v)); v = fmaxf(v, swz_f<16>(v));
    return fmaxf(rdlane_f(v, 0), rdlane_f(v, 32));
}
__device__ __forceinline__ float sigmoidf_(float x) { return __builtin_amdgcn_rcpf(1.0f + __builtin_amdgcn_exp2f(-1.4426950408889634f * x)); }
__device__ __forceinline__ float gelu_tanh(float y) { return y * sigmoidf_(1.5957691216057308f * (y + 0.044715f * y * y * y)); }
__device__ __forceinline__ float opaque_f(float v) { asm volatile("" : "+s"(v)); return v; }
__device__ __forceinline__ int opaque_i(int v) { asm volatile("" : "+s"(v)); return v; }
__device__ __forceinline__ int seqpos(int bt) { return bt - ((bt >> 13) << 13); }
__device__ __forceinline__ unsigned f2bf(float f) { unsigned u = __builtin_bit_cast(unsigned, f); return (u + 0x7fffu + ((u >> 16) & 1u)) >> 16; }
__device__ __forceinline__ unsigned pk2(float lo, float hi) { return f2bf(lo) | (f2bf(hi) << 16); }
typedef float f32x2_t_ __attribute__((ext_vector_type(2))); typedef __bf16 bf16x2_t_ __attribute__((ext_vector_type(2)));
__device__ __forceinline__ unsigned cvt_pk_bf16(float lo, float hi) { const f32x2_t_ v = {lo, hi}; const bf16x2_t_ b = __builtin_convertvector(v, bf16x2_t_); return __builtin_bit_cast(unsigned, b); }
__device__ __forceinline__ float bf_lo(unsigned w) { return __builtin_bit_cast(float, w << 16); }
__device__ __forceinline__ float bf_hi(unsigned w) { return __builtin_bit_cast(float, w & 0xffff0000u); }
__device__ __forceinline__ float bf2f(bf16_t b) { return __builtin_bit_cast(float, ((unsigned)b) << 16); }
__device__ __forceinline__ void unpack8(const u32x4 w, float (&f)[8]) { f[0] = bf_lo(w.x); f[1] = bf_hi(w.x); f[2] = bf_lo(w.y); f[3] = bf_hi(w.y); f[4] = bf_lo(w.z); f[5] = bf_hi(w.z); f[6] = bf_lo(w.w); f[7] = bf_hi(w.w); }
__device__ __forceinline__ u32x4 pack8(const float (&f)[8]) { u32x4 w; w.x = cvt_pk_bf16(f[0], f[1]); w.y = cvt_pk_bf16(f[2], f[3]); w.z = cvt_pk_bf16(f[4], f[5]); w.w = cvt_pk_bf16(f[6], f[7]); return w; }

__device__ __forceinline__ unsigned pk4_fp8(float a, float b, float c, float d) {
    int w = __builtin_amdgcn_cvt_pk_fp8_f32(a, b, 0, false); w = __builtin_amdgcn_cvt_pk_fp8_f32(c, d, w, true); return (unsigned)w; }
__device__ __forceinline__ u32x2 pack8_fp8(const float (&f)[8]) { u32x2 w; w.x = pk4_fp8(f[0], f[1], f[2], f[3]); w.y = pk4_fp8(f[4], f[5], f[6], f[7]); return w; }
typedef float f32x2v_ __attribute__((ext_vector_type(2)));
__device__ __forceinline__ void unpack8_fp8(const u32x2 w, float (&f)[8]) {
    const f32x2v_ a = __builtin_amdgcn_cvt_pk_f32_fp8((int)w.x, false), b = __builtin_amdgcn_cvt_pk_f32_fp8((int)w.x, true), c = __builtin_amdgcn_cvt_pk_f32_fp8((int)w.y, false), d = __builtin_amdgcn_cvt_pk_f32_fp8((int)w.y, true);
    f[0] = a.x; f[1] = a.y; f[2] = b.x; f[3] = b.y; f[4] = c.x; f[5] = c.y; f[6] = d.x; f[7] = d.y; }
constexpr float Y8_SCALE = 16.0f;
constexpr int W8_SHIFT_GU = 5, W8_SHIFT_DN = 6;

__device__ __forceinline__ int lane_id() { int l; asm volatile("v_mbcnt_lo_u32_b32 %0, -1, 0\n\tv_mbcnt_hi_u32_b32 %0, -1, %0" : "=v"(l)); return l; }

struct Ctx {
    LAS unsigned char* lds;
    int tid, lane, wave, G, bid;
    unsigned* ctl;
    GAS unsigned char* ws;
};

namespace pg8 {
#define PG8_LAS __attribute__((address_space(3)))
typedef short bf16x8 __attribute__((ext_vector_type(8)));
constexpr int BM = 256, BK = 64, HALF = 128, HTB = HALF * BK * 2  , STAGE_BYTES = 8 * HTB, NXCD = 8, WGM = 8;

__host__ __device__ __forceinline__ int lds_byte(int r, int c) { const int st = (r >> 4) * 2 + (c >> 5), rr = r & 15, cc = c & 31, ob = rr * 64 + cc * 2; return st * 1024 + (ob ^ (((ob >> 9) & 1) << 5)); }
__host__ __device__ __forceinline__ void stage_rc(int b, int& R, int& C) { const int st = b / 1024, sb = b % 1024, swz = sb ^ (((sb >> 9) & 1) << 5); R = (st >> 1) * 16 + swz / 64; C = (st & 1) * 32 + (swz % 64) / 2; }
__host__ __device__ __forceinline__ int perm32(int rho) { const int n = rho >> 4, i = rho & 15; return 8 * (i >> 2) + 4 * n + (i & 3); }

struct Unit { int pm, pn, e, mt, ix; };
struct Gemm { const bf16_t* A; const bf16_t* Bt; int M, N, K; };

struct StaticOrder {
    int nM, nN, nwg, G, c; size_t tstep;
    __device__ void init(int M, int N, int K, int G_, int c_) { nM = M / BM; nN = N / BM; nwg = nM * nN; G = G_; c = c_; tstep = (size_t)BM * K * 2; }
    __device__ bool next(int i, Unit& u) const {
        const long L = (long)i * G + c; if (L >= nwg) return false;
        int wgid = (int)L; { const int q = nwg / NXCD, r = nwg % NXCD, xcd = wgid % NXCD, off = wgid / NXCD; wgid = (xcd < r ? xcd * (q + 1) : r * (q + 1) + (xcd - r) * q) + off; }
        const int nig = WGM * nN, gid = wgid / nig, fm = gid * WGM, gsz = (nM - fm) < WGM ? (nM - fm) : WGM;
        u.pm = fm + ((wgid % nig) % gsz); u.pn = (wgid % nig) / gsz; u.e = 0; u.mt = 0; u.ix = i; return true;
    }
    __device__ __forceinline__ size_t a_off(const Unit& u) const { return (size_t)u.pm * tstep; }
    __device__ __forceinline__ size_t b_off(const Unit& u) const { return (size_t)u.pn * tstep; }
    __device__ __forceinline__ void a_ready(const Unit&) const {}
    __device__ __forceinline__ void done(const Unit&) const {}
    static constexpr bool GATHER = false, A_PAIR2 = false;
};
template <int NPN, bool A_IS_XG> struct MoeOrder {
    static constexpr bool GATHER = A_IS_XG, A_PAIR2 = !A_IS_XG;
    const int* stok; const unsigned* cnt;
    const PG8_LAS unsigned short* idl;
    __device__ __forceinline__ unsigned list_id(int ui, int row) const { return (unsigned)idl[ui * BM + row]; }
    __device__ __forceinline__ void preload_ids(PG8_LAS unsigned short* dst, int tid, int wave) {
        idl = dst;
        const auto rs = __builtin_amdgcn_make_buffer_rsrc((void*)stok, 0, -1, 0x00020000);
        int tk[9], cn[9], sl[9];
#pragma unroll
        for (int j = 0; j < 9; ++j) { Unit u; tk[j] = 0; cn[j] = 0; sl[j] = 0;
            if (next(2 * j + (wave >> 2), u)) { sl[j] = u.mt * BM + (tid & 255); cn[j] = (int)__hip_atomic_load(cnt + u.e * 64, __ATOMIC_RELAXED, __HIP_MEMORY_SCOPE_AGENT);
                tk[j] = __builtin_amdgcn_raw_buffer_load_b32(rs, sl[j] * 4, (u.e * T) * 4, 0); } }
#pragma unroll
        for (int j = 0; j < 9; ++j) dst[(2 * j + (wave >> 2)) * BM + (tid & 255)] = (unsigned short)(sl[j] < cn[j] ? tk[j] : 0);
        __syncthreads();
    }
    template <int NPAIR, bool GU> __device__ __forceinline__ void preload_bias(PG8_LAS float* dst, const float* bias, int tid, int wave) const {
        const auto rs = __builtin_amdgcn_make_buffer_rsrc((void*)bias, 0, -1, 0x00020000);
        float bv_[NPAIR]; const int t = tid & 255;
#pragma unroll
        for (int j = 0; j < NPAIR; ++j) { Unit u; bv_[j] = 0.f;
            if (next(2 * j + (wave >> 2), u)) { const int col = GU ? (u.e * 2048 + u.pn * 128 + (t < 128 ? t : 1024 - 128 + t)) : (u.e * D + u.pn * BM + t);
                bv_[j] = __builtin_bit_cast(float, __builtin_amdgcn_raw_buffer_load_b32(rs, col * 4, 0, 0)); } }
#pragma unroll
        for (int j = 0; j < NPAIR; ++j) dst[(2 * j + (wave >> 2)) * BM + t] = bv_[j];
        __syncthreads();
    }
    __device__ __forceinline__ void preload_gates(PG8_LAS float* dst, const float* glist, int tid, int wave) const {
        const auto rs = __builtin_amdgcn_make_buffer_rsrc((void*)glist, 0, -1, 0x00020000);
        float gv_[5];
#pragma unroll
        for (int j = 0; j < 5; ++j) { Unit u; gv_[j] = 0.f; if (next(2 * j + (wave >> 2), u)) gv_[j] = __builtin_bit_cast(float, __builtin_amdgcn_raw_buffer_load_b32(rs, (u.mt * BM + (tid & 255)) * 4, (u.e * T) * 4, 0)); }
#pragma unroll
        for (int j = 0; j < 5; ++j) dst[(2 * j + (wave >> 2)) * BM + (tid & 255)] = gv_[j];
        __syncthreads();
    }
    const PG8_LAS int* tb; int G, c, ntile; size_t bexp, rowb;
    __device__ void init(const PG8_LAS int* tb_, int G_, int c_, int Nexp, int K) { tb = tb_; G = G_; c = c_; ntile = __builtin_amdgcn_readfirstlane(tb_[32]); rowb = (size_t)K * 2; bexp = (size_t)Nexp * rowb; }
    __device__ bool next(int i, Unit& u) const {
        int mtg, pn;
        if (G == 256) {
            constexpr int MPR = 256 / NPN, MPX = MPR / 8; const int nx = (ntile + 7) >> 3, l = MPX * i + (c >> 3) / NPN;
            const int nv = (ntile - nx * (c & 7)) < nx ? (ntile - nx * (c & 7)) : nx;
            if (l >= nv) return false;
            mtg = nx * (c & 7) + (A_IS_XG ? l : nv - 1 - l); pn = (c >> 3) % NPN; }
        else { const long L = (long)i * G + c; mtg = (int)(L / NPN); pn = (int)(L % NPN); }
        if (mtg >= ntile) return false;
        int e = 0;
#pragma unroll
        for (int st = 16; st >= 1; st >>= 1) { const int tv = __builtin_amdgcn_readfirstlane(tb[e + st]); if (tv <= mtg) e += st; }
        u.pm = mtg; u.pn = pn; u.e = e; u.mt = mtg - __builtin_amdgcn_readfirstlane(tb[e]); u.ix = i; return true;
    }
    __device__ __forceinline__ size_t a_off(const Unit& u) const { return A_IS_XG ? (size_t)0 : (size_t)u.pm * BM * rowb; }
    __device__ __forceinline__ size_t b_off(const Unit& u) const { return (size_t)u.e * bexp + (size_t)u.pn * BM * rowb; }
    __device__ __forceinline__ void a_ready(const Unit&) const {}
    __device__ __forceinline__ void done(const Unit&) const {}
};

__device__ __forceinline__ u32x4 pack_v(const f32x4 v0, const f32x4 v1) { u32x4 w; w.x = cvt_pk_bf16(v0[0], v0[1]); w.y = cvt_pk_bf16(v0[2], v0[3]); w.z = cvt_pk_bf16(v1[0], v1[1]); w.w = cvt_pk_bf16(v1[2], v1[3]); return w; }

struct EpiStore {
    static constexpr bool PERM = true, PERM2 = true, AFTER_DRAIN = false, BIAS_INIT = false;
    bf16_t* O; int ldc;
    static __device__ __forceinline__ unsigned swp(unsigned v) { return (unsigned)__builtin_amdgcn_mov_dpp((int)v, 0xB1, 0xF, 0xF, true); }
    __device__ __forceinline__ void operator()(const f32x4 (&acc)[2][2][4][2], const Unit& u, int wr, int wc, int fr, int fq) const {
        const bool odd = (fr & 1) != 0;
        const int row0 = u.pm * BM + wr * 64, col0 = u.pn * BM + wc * 64 + 16 * fq + (odd ? 8 : 0);
        bf16_t* pa = O + (size_t)(row0 + (fr & ~1)) * ldc + col0;
#pragma unroll
        for (int ai = 0; ai < 2; ++ai)
#pragma unroll
            for (int m = 0; m < 4; ++m) {
                const u32x4 h0 = pack_v(acc[ai][0][m][0], acc[ai][0][m][1]), h1 = pack_v(acc[ai][1][m][0], acc[ai][1][m][1]);
                u32x4 snd, rcv, da, db;
                snd.x = odd ? h0.x : h1.x; snd.y = odd ? h0.y : h1.y; snd.z = odd ? h0.z : h1.z; snd.w = odd ? h0.w : h1.w;
                rcv.x = swp(snd.x); rcv.y = swp(snd.y); rcv.z = swp(snd.z); rcv.w = swp(snd.w);
                da.x = odd ? rcv.x : h0.x; da.y = odd ? rcv.y : h0.y; da.z = odd ? rcv.z : h0.z; da.w = odd ? rcv.w : h0.w;
                db.x = odd ? h1.x : rcv.x; db.y = odd ? h1.y : rcv.y; db.z = odd ? h1.z : rcv.z; db.w = odd ? h1.w : rcv.w;
                bf16_t* rp = pa + (size_t)(ai * HALF + m * 16) * ldc;
                *(u32x4*)(rp) = da; *(u32x4*)(rp + ldc) = db; }
    }
};
struct EpiGlu {
    static constexpr bool PERM = true, PERM2 = false, AFTER_DRAIN = false, BIAS_INIT = false;
    const bf16_t* Z; bf16_t* MIX; const float* bias;
    __device__ __forceinline__ void operator()(const f32x4 (&acc)[2][2][4][2], const Unit& u, int wr, int wc, int fr, int fq) const {
        const int row0 = u.pm * BM + wr * 64 + fr, col0 = u.pn * BM + wc * 32 + 8 * fq;
        f32x4 bv[2][2];
#pragma unroll
        for (int bj = 0; bj < 2; ++bj)
#pragma unroll
            for (int n = 0; n < 2; ++n) bv[bj][n] = *(const f32x4*)(bias + col0 + bj * HALF + 4 * n);
#pragma unroll
        for (int ai = 0; ai < 2; ++ai)
#pragma unroll
            for (int m = 0; m < 4; ++m) { const size_t row = (size_t)(row0 + ai * HALF + m * 16);
#pragma unroll
                for (int bj = 0; bj < 2; ++bj) {
                    const u32x4 zw = *(const u32x4*)(Z + row * SSM_W + col0 + bj * HALF); float z[8]; unpack8(zw, z);
                    const f32x4 a0 = acc[ai][bj][m][0] + bv[bj][0], a1 = acc[ai][bj][m][1] + bv[bj][1];
                    float o[8];
#pragma unroll
                    for (int j = 0; j < 4; ++j) { o[j] = z[j] * sigmoidf_(a0[j]); o[4 + j] = z[4 + j] * sigmoidf_(a1[j]); }
                    *(u32x4*)(MIX + row * D + 512 + col0 + bj * HALF) = pack8(o); } }
    }
};
struct EpiRope {
    static constexpr bool PERM = true, PERM2 = false, AFTER_DRAIN = false, BIAS_INIT = false;
    bf16_t* O; const f32x2* rope;
    __device__ __forceinline__ void operator()(const f32x4 (&acc)[2][2][4][2], const Unit& u, int wr, int wc, int fr, int fq) const {
        const int part = u.pn >> 2, tp = u.pn & 3;
        const int row0 = u.pm * BM + wr * 64 + fr, colb = part * 1024 + (4 * tp + wc) * 64 + 8 * fq;
        const float qs = part == 0 ? 0.125f * 1.4426950408889634f : 1.0f;
#pragma unroll
        for (int ai = 0; ai < 2; ++ai)
#pragma unroll
            for (int m = 0; m < 4; ++m) { const int row = row0 + ai * HALF + m * 16; bf16_t* rowp = O + (size_t)row * 3072 + colb;
                const f32x4 x1a = acc[ai][0][m][0], x1b = acc[ai][0][m][1], x2a = acc[ai][1][m][0], x2b = acc[ai][1][m][1];
                if (part < 2) {
                    const f32x4* rp = (const f32x4*)(rope + (size_t)seqpos(row) * 32 + 8 * fq);
                    const f32x4 c01 = rp[0], c23 = rp[1], c45 = rp[2], c67 = rp[3];
                    float o1[8], o2[8];
                    const float cs[8] = {c01[0], c01[2], c23[0], c23[2], c45[0], c45[2], c67[0], c67[2]}, sn[8] = {c01[1], c01[3], c23[1], c23[3], c45[1], c45[3], c67[1], c67[3]};
                    const float x1[8] = {x1a[0], x1a[1], x1a[2], x1a[3], x1b[0], x1b[1], x1b[2], x1b[3]}, x2[8] = {x2a[0], x2a[1], x2a[2], x2a[3], x2b[0], x2b[1], x2b[2], x2b[3]};
#pragma unroll
                    for (int j = 0; j < 8; ++j) { o1[j] = (x1[j] * cs[j] - x2[j] * sn[j]) * qs; o2[j] = (x2[j] * cs[j] + x1[j] * sn[j]) * qs; }
                    *(u32x4*)(rowp) = pack8(o1); *(u32x4*)(rowp + 32) = pack8(o2);
                } else { *(u32x4*)(rowp) = pack_v(x1a, x1b); *(u32x4*)(rowp + 32) = pack_v(x2a, x2b); } }
    }
};
struct EpiSwiglu {
    static constexpr bool PERM = true, PERM2 = false, AFTER_DRAIN = false, BIAS_INIT = true;
#ifdef PROBE_NOSTORE
    bool nostore = false;
#endif
    bf16_t* ACT; const PG8_LAS float* bias_lds;
    __device__ __forceinline__ void init_load(const Unit& u, int wc, int fq, f32x4 (&b)[4]) const {
        const PG8_LAS float* bb = bias_lds + u.ix * BM + wc * 32 + 8 * fq;
        b[0] = *(const PG8_LAS f32x4*)(bb); b[1] = *(const PG8_LAS f32x4*)(bb + 4); b[2] = *(const PG8_LAS f32x4*)(bb + 128); b[3] = *(const PG8_LAS f32x4*)(bb + 132);
    }
    static __device__ __forceinline__ void init_fill(f32x4 (&acc)[2][2][4][2], const f32x4 (&b)[4]) {
#pragma unroll
        for (int ai = 0; ai < 2; ++ai)
#pragma unroll
            for (int m = 0; m < 4; ++m) { acc[ai][0][m][0] = b[0]; acc[ai][0][m][1] = b[1]; acc[ai][1][m][0] = b[2]; acc[ai][1][m][1] = b[3]; }
    }
    __device__ __forceinline__ void init(f32x4 (&acc)[2][2][4][2], const Unit& u, int wc, int fq) const { f32x4 b[4]; init_load(u, wc, fq, b); init_fill(acc, b); }
    __device__ __forceinline__ void operator()(const f32x4 (&acc)[2][2][4][2], const Unit& u, int wr, int wc, int fr, int fq) const {
        const bool oq = (fq & 1) != 0;
        const int row0 = u.pm * BM + wr * 64 + fr, j0 = u.pn * 128 + wc * 32;
        unsigned char* ab = (unsigned char*)ACT + (size_t)(row0 >> 1) * (2 * D) + (j0 >> 5) * 64 + (fr & 1) * 32 + 16 * (fq >> 1);
#pragma unroll
        for (int ai = 0; ai < 2; ++ai)
#pragma unroll
            for (int mp = 0; mp < 2; ++mp) {
                u32x2 dd[2];
#pragma unroll
                for (int mm = 0; mm < 2; ++mm) { const int m = 2 * mp + mm;
                    const f32x4 g0 = acc[ai][0][m][0], g1 = acc[ai][0][m][1], l0 = acc[ai][1][m][0], l1 = acc[ai][1][m][1];
                    float o[8];
#pragma unroll
                    for (int j = 0; j < 4; ++j) {
                        const float ga = __builtin_amdgcn_fmed3f(g0[j], -3.0e38f, SW_LIMIT), gb = __builtin_amdgcn_fmed3f(g1[j], -3.0e38f, SW_LIMIT);
                        const float la = __builtin_amdgcn_fmed3f(l0[j], -SW_LIMIT, SW_LIMIT), lb = __builtin_amdgcn_fmed3f(l1[j], -SW_LIMIT, SW_LIMIT);
                        const float sa = ga * __builtin_amdgcn_rcpf(1.0f + __builtin_amdgcn_exp2f((-SW_ALPHA * 1.4426950408889634f) * ga)), sb = gb * __builtin_amdgcn_rcpf(1.0f + __builtin_amdgcn_exp2f((-SW_ALPHA * 1.4426950408889634f) * gb));
                        o[j] = fmaf(la, sa, sa); o[4 + j] = fmaf(lb, sb, sb); }
                    dd[mm] = pack8_fp8(o); }
                const unsigned sx = oq ? dd[0].x : dd[1].x, sy = oq ? dd[0].y : dd[1].y;
                const unsigned rx = (unsigned)swz_i<16>((int)sx), ry = (unsigned)swz_i<16>((int)sy);
                u32x4 w;
                if (!oq) { w.x = dd[0].x; w.y = dd[0].y; w.z = rx; w.w = ry; } else { w.x = rx; w.y = ry; w.z = dd[1].x; w.w = dd[1].y; }
                *(u32x4*)(ab + (size_t)(ai * (HALF / 2) + (2 * mp + (oq ? 1 : 0)) * 8) * (2 * D)) = w; }
    }
};
struct EpiDown {
    static constexpr bool PERM = true, PERM2 = true, AFTER_DRAIN = false, BIAS_INIT = true;
#ifdef PROBE_NOSTORE
    bool nostore = false;
#endif
    bf16_t* Y; const PG8_LAS float* bias_lds; const PG8_LAS float* gl_lds;
    __device__ __forceinline__ void init_load(const Unit& u, int wc, int fq, f32x4 (&b)[4]) const {
        const PG8_LAS float* bb = bias_lds + u.ix * BM + wc * 64 + 16 * fq;
        b[0] = *(const PG8_LAS f32x4*)(bb); b[1] = *(const PG8_LAS f32x4*)(bb + 4); b[2] = *(const PG8_LAS f32x4*)(bb + 8); b[3] = *(const PG8_LAS f32x4*)(bb + 12);
    }
    static __device__ __forceinline__ void init_fill(f32x4 (&acc)[2][2][4][2], const f32x4 (&b)[4]) {
#pragma unroll
        for (int ai = 0; ai < 2; ++ai)
#pragma unroll
            for (int m = 0; m < 4; ++m) { acc[ai][0][m][0] = b[0]; acc[ai][0][m][1] = b[1]; acc[ai][1][m][0] = b[2]; acc[ai][1][m][1] = b[3]; }
    }
    __device__ __forceinline__ void init(f32x4 (&acc)[2][2][4][2], const Unit& u, int wc, int fq) const { f32x4 b[4]; init_load(u, wc, fq, b); init_fill(acc, b); }
    __device__ __forceinline__ void operator()(const f32x4 (&acc)[2][2][4][2], const Unit& u, int wr, int wc, int fr, int fq) const {
        const int rl0 = wr * 64 + fr, col0 = u.pn * BM + wc * 64 + 16 * fq;
        const PG8_LAS float* gl = gl_lds + u.ix * BM + rl0;
        unsigned char* yb = (unsigned char*)Y + ((size_t)u.pm * BM + rl0) * D + col0;
#pragma unroll
        for (int ai = 0; ai < 2; ++ai)
#pragma unroll
            for (int m = 0; m < 4; ++m) { const int rl = ai * HALF + m * 16; const float gt = gl[rl] * Y8_SCALE;
                u32x4 w;
#pragma unroll
                for (int bj = 0; bj < 2; ++bj) { const f32x4 v0 = acc[ai][bj][m][0] * gt, v1 = acc[ai][bj][m][1] * gt;
                    const unsigned lo_ = pk4_fp8(v0[0], v0[1], v0[2], v0[3]), hi_ = pk4_fp8(v1[0], v1[1], v1[2], v1[3]);
                    if (bj == 0) { w.x = lo_; w.y = hi_; } else { w.z = lo_; w.w = hi_; } }
                *(u32x4*)(yb + (size_t)rl * D) = w; }
    }
};

template <class Epi, class Sched, bool ALIGN_EPI = false, bool SP2 = false, bool FP8 = false, int PROBE = 0>
__device__ __forceinline__ void gemm_phase(PG8_LAS unsigned char* lds, const Gemm g, const Sched& S, const Epi& E, int wave_, int scale_w = 127, int scale_x = 127) {
    int tid = wave_ * 64 + lane_id(); asm volatile("" : "+v"(tid)); const int wid = wave_, lane = tid & 63, wr = wid >> 2, wc = wid & 3, fr = lane & 15, fq = lane >> 4;
    const int K = g.K, nt = K / BK;
    unsigned voffA[2], voffB[2];
#pragma unroll
    for (int i = 0; i < 2; ++i) { int R, C; stage_rc(tid * 16 + i * 8192, R, C);
        const int Rb = Epi::PERM2 ? (64 * (R >> 5) + 16 * ((R & 15) >> 2) + 4 * ((R >> 4) & 1) + (R & 3)) : Epi::PERM ? ((R & ~31) + perm32(R & 31)) : R;
        if constexpr (Sched::A_PAIR2) voffA[i] = (unsigned)((R >> 1) * (4 * K) + ((2 * C) >> 5) * 64 + (R & 1) * 32 + ((2 * C) & 31)); else voffA[i] = (unsigned)(R * K + C) * 2u;
        voffB[i] = (unsigned)(Rb * K + C) * 2u; }
    unsigned gv[2] = {0u, 0u}, gn[2] = {0u, 0u}, gc2 = 0u;
    auto gather_unit = [&](int ui_, unsigned (&o)[2]) {
        if constexpr (Sched::GATHER) {
            int t_ = lane_id(); asm volatile("" : "+v"(t_)); t_ += wid * 64;
            int R, C; stage_rc(t_ * 16, R, C);
#pragma unroll
            for (int h = 0; h < 2; ++h) o[h] = S.list_id(ui_, h * HALF + R) | (S.list_id(ui_, h * HALF + R + 64) << 16);
        }
    };
    if constexpr (Sched::GATHER) { int R, C; stage_rc(tid * 16, R, C); gc2 = (unsigned)(C * 2); }
    const unsigned kstep = (unsigned)(BK * 2);
    const unsigned kstepA = Sched::A_PAIR2 ? 2u * kstep : kstep;
    const unsigned hstep = (unsigned)HALF * (unsigned)K * 2u;
    const unsigned hstepB = Epi::PERM2 ? 8u * (unsigned)K * 2u : hstep;
    const unsigned ldsw = (unsigned)wid * 1024u;
    const int aoff = lds_byte(wr * 64 + fr, fq * 8), boff = lds_byte(wc * 32 + fr, fq * 8);
#define PG8_SA(b, h) (((b) * 2 + (h)) * HTB)
#define PG8_SB(b, h) ((4 + (b) * 2 + (h)) * HTB)
#define PG8_STAGE(bufoff, gbase, voff) do { if constexpr (!(PROBE & 2)) _Pragma("unroll") for (int _i = 0; _i < 2; ++_i) \
        __builtin_amdgcn_raw_ptr_buffer_load_lds(rsrc_##voff, (PG8_LAS unsigned*)(lds + (bufoff) + ldsw + _i * 8192), 16, (voff)[_i], (gbase), 0, 0); } while (0)
#define PG8_STAGE_A(b, h, soff, NEXT) do { if constexpr (Sched::GATHER) { _Pragma("unroll") for (int _i = 0; _i < 2; ++_i) \
        { unsigned pk_ = (NEXT) ? gn[h] : gv[h]; asm volatile("" : "+v"(pk_)); const unsigned tk_ = _i ? (pk_ >> 16) : (pk_ & 0xffffu);     \
        __builtin_amdgcn_raw_ptr_buffer_load_lds(rsrc_voffA, (PG8_LAS unsigned*)(lds + PG8_SA(b, h) + ldsw + _i * 8192), 16, (tk_ << 10) | gc2, (soff), 0, 0); } } \
        else PG8_STAGE(PG8_SA(b, h), (soff) + (h) * hstep, voffA); } while (0)
#define PG8_LDA(dst, b, h) do { if constexpr ((PROBE & 16) != 0) { if constexpr (FP8) { asm volatile("" : "+v"(dst##8[0]), "+v"(dst##8[1]), "+v"(dst##8[2]), "+v"(dst##8[3])); } } else if constexpr (FP8) { _Pragma("unroll") for (int m = 0; m < 4; ++m) { const v4i_ lo_ = *(const PG8_LAS v4i_*)(lds + PG8_SA(b, h) + aoff + m * 2048), hi_ = *(const PG8_LAS v4i_*)(lds + PG8_SA(b, h) + aoff + m * 2048 + 1024); dst##8[m] = __builtin_shufflevector(lo_, hi_, 0, 1, 2, 3, 4, 5, 6, 7); } } \
        else { _Pragma("unroll") for (int m = 0; m < 4; ++m) _Pragma("unroll") for (int k = 0; k < 2; ++k) dst[m][k] = *(const PG8_LAS bf16x8*)(lds + PG8_SA(b, h) + aoff + m * 2048 + k * 1024); } } while (0)
#define PG8_LDB(dst, b, h) do { if constexpr ((PROBE & 8) != 0) { if constexpr (FP8) { asm volatile("" : "+v"(dst##8[0]), "+v"(dst##8[1])); } } else if constexpr (FP8) { _Pragma("unroll") for (int n = 0; n < 2; ++n) { const v4i_ lo_ = *(const PG8_LAS v4i_*)(lds + PG8_SB(b, h) + boff + n * 2048), hi_ = *(const PG8_LAS v4i_*)(lds + PG8_SB(b, h) + boff + n * 2048 + 1024); dst##8[n] = __builtin_shufflevector(lo_, hi_, 0, 1, 2, 3, 4, 5, 6, 7); } } \
        else { _Pragma("unroll") for (int n = 0; n < 2; ++n) _Pragma("unroll") for (int k = 0; k < 2; ++k) dst[n][k] = *(const PG8_LAS bf16x8*)(lds + PG8_SB(b, h) + boff + n * 2048 + k * 1024); } } while (0)
#define PG8_MMA(ai, bj, At, Bt) do { __builtin_amdgcn_s_setprio(1); _Pragma("unroll") for (int m = 0; m < 4; ++m) _Pragma("unroll") for (int n = 0; n < 2; ++n) { \
        if constexpr ((PROBE & 4) != 0) { if constexpr (FP8) asm volatile("" :: "v"(Bt##8[n]), "v"(At##8[m])); else asm volatile("" :: "v"(Bt[n][0]), "v"(At[m][0]), "v"(Bt[n][1]), "v"(At[m][1])); } else \
        if constexpr (FP8) acc[ai][bj][m][n] = __builtin_amdgcn_mfma_scale_f32_16x16x128_f8f6f4(Bt##8[n], At##8[m], acc[ai][bj][m][n], 0, 0, 0, scale_w, 0, scale_x); \
        else { _Pragma("unroll") for (int k = 0; k < 2; ++k) acc[ai][bj][m][n] = __builtin_amdgcn_mfma_f32_16x16x32_bf16(Bt[n][k], At[m][k], acc[ai][bj][m][n], 0, 0, 0); } } \
        __builtin_amdgcn_s_setprio(0); } while (0)
#define PG8_WAIT_V(n) asm volatile("s_waitcnt vmcnt(" #n ")" ::: "memory")
#define PG8_WAIT_L(n) asm volatile("s_waitcnt lgkmcnt(" #n ")" ::: "memory")
#define PG8_BAR __builtin_amdgcn_s_barrier()
#define PG8_SCHED __builtin_amdgcn_sched_barrier(0)
#define PG8_ACC_INIT(u_) do { if constexpr (Epi::BIAS_INIT && !(PROBE & 64)) { int tz_ = lane_id(); asm volatile("" : "+v"(tz_)); E.init(acc, u_, wc, (tz_ & 63) >> 4); } else { \
        _Pragma("unroll") for (int a = 0; a < 2; ++a) _Pragma("unroll") for (int b = 0; b < 2; ++b) _Pragma("unroll") for (int m = 0; m < 4; ++m) _Pragma("unroll") for (int n = 0; n < 2; ++n) acc[a][b][m][n] = (f32x4){0.f, 0.f, 0.f, 0.f}; } } while (0)
    Unit cur, nxt; int ui = 0;
    if (!S.next(0, cur)) return;
    f32x4 acc[2][2][4][2];
    typedef int v4i_ __attribute__((ext_vector_type(4))); typedef int v8i_ __attribute__((ext_vector_type(8)));
    bf16x8 At[4][2], B0[2][2], B1[2][2]; v8i_ At8[4], B08[2], B18[2];
    const auto rsrc_voffA = __builtin_amdgcn_make_buffer_rsrc((void*)g.A, 0, -1, 0x00020000), rsrc_voffB = __builtin_amdgcn_make_buffer_rsrc((void*)g.Bt, 0, -1, 0x00020000);
    unsigned cA = (unsigned)__builtin_amdgcn_readfirstlane((int)(unsigned)S.a_off(cur)), cB = (unsigned)__builtin_amdgcn_readfirstlane((int)(unsigned)S.b_off(cur));
    S.a_ready(cur);
    if constexpr (Sched::GATHER) { static_assert(BK * 2 == 128, "row offset 1 KiB = K * 2 bytes assumed below");
        gather_unit(0, gv); Unit n1_; if (S.next(1, n1_)) gather_unit(1, gn); else { gn[0] = gv[0]; gn[1] = gv[1]; }
        asm volatile("" : "+v"(gv[0]), "+v"(gv[1]), "+v"(gn[0]), "+v"(gn[1])); }
    PG8_ACC_INIT(cur);
    if constexpr (SP2) {
        PG8_STAGE(PG8_SB(0, 0), cB, voffB); PG8_STAGE(PG8_SB(0, 1), cB + hstepB, voffB); PG8_STAGE_A(0, 0, cA, false); PG8_STAGE_A(0, 1, cA, false);
        if (wr == 1) PG8_BAR;
        PG8_WAIT_V(2); PG8_BAR;
        PG8_STAGE(PG8_SB(1, 0), cB + kstep, voffB); PG8_STAGE_A(1, 0, cA + kstepA, false); PG8_STAGE(PG8_SB(1, 1), cB + hstepB + kstep, voffB);
        PG8_WAIT_V(6); PG8_BAR;
    } else {
        PG8_STAGE(PG8_SB(0, 0), cB, voffB); PG8_STAGE_A(0, 0, cA, false); PG8_STAGE(PG8_SB(0, 1), cB + hstepB, voffB); PG8_STAGE_A(0, 1, cA, false);
        if (wr == 1) PG8_BAR;
        PG8_WAIT_V(4); PG8_BAR;
        PG8_STAGE(PG8_SB(1, 0), cB + kstep, voffB); PG8_STAGE_A(1, 0, cA + kstepA, false); PG8_STAGE(PG8_SB(1, 1), cB + hstepB + kstep, voffB);
        PG8_WAIT_V(6); PG8_BAR;
    }
    for (;;) {
        const bool has_next = S.next(ui + 1, nxt);
        const unsigned nA = has_next ? (unsigned)__builtin_amdgcn_readfirstlane((int)(unsigned)S.a_off(nxt)) : cA, nB = has_next ? (unsigned)__builtin_amdgcn_readfirstlane((int)(unsigned)S.b_off(nxt)) : cB;
#pragma nounroll
        for (int t = 0; t < nt; t += 2) {
            const bool last = (t == nt - 2);
            const unsigned a1 = cA + (unsigned)(t + 1) * kstepA;
            const unsigned a2 = last ? nA : cA + (unsigned)(t + 2) * kstepA, b2 = last ? nB : cB + (unsigned)(t + 2) * kstep;
            const unsigned a3 = a2 + kstepA, b3 = b2 + kstep;
            if (last && has_next) S.a_ready(nxt);
            if constexpr (SP2) {
            PG8_LDB(B0, 0, 0); PG8_LDB(B1, 0, 1); PG8_SCHED; PG8_LDA(At, 0, 0); PG8_STAGE_A(1, 1, a1, false);
            PG8_WAIT_V(8); PG8_WAIT_L(0); PG8_BAR; PG8_MMA(0, 0, At, B0); PG8_MMA(0, 1, At, B1); PG8_BAR; PG8_SCHED;
            PG8_LDA(At, 0, 1); PG8_STAGE(PG8_SB(0, 0), b2, voffB); PG8_STAGE(PG8_SB(0, 1), b2 + hstepB, voffB); PG8_STAGE_A(0, 0, a2, last);
            PG8_WAIT_V(8); PG8_WAIT_L(0); PG8_BAR; PG8_MMA(1, 0, At, B0); PG8_MMA(1, 1, At, B1); PG8_BAR; PG8_SCHED;
            PG8_LDB(B0, 1, 0); PG8_LDB(B1, 1, 1); PG8_SCHED; PG8_LDA(At, 1, 0); PG8_STAGE_A(0, 1, a2, last);
            PG8_WAIT_V(8); PG8_WAIT_L(0); PG8_BAR; PG8_MMA(0, 0, At, B0); PG8_MMA(0, 1, At, B1); PG8_BAR; PG8_SCHED;
            PG8_LDA(At, 1, 1); PG8_STAGE(PG8_SB(1, 0), b3, voffB); PG8_STAGE(PG8_SB(1, 1), b3 + hstepB, voffB); PG8_STAGE_A(1, 0, a3, last);
            PG8_WAIT_V(8); PG8_WAIT_L(0); PG8_BAR; PG8_MMA(1, 0, At, B0); PG8_MMA(1, 1, At, B1); PG8_BAR; PG8_SCHED;
            } else {
            PG8_LDB(B0, 0, 0); PG8_SCHED; PG8_LDA(At, 0, 0); PG8_STAGE_A(1, 1, a1, false);
            PG8_WAIT_L(8); PG8_BAR; PG8_WAIT_L(0); PG8_MMA(0, 0, At, B0); PG8_BAR; PG8_SCHED;
            PG8_LDB(B1, 0, 1); PG8_STAGE(PG8_SB(0, 0), b2, voffB);
            PG8_BAR; PG8_WAIT_L(0); PG8_MMA(0, 1, At, B1); PG8_BAR;
            PG8_LDA(At, 0, 1); PG8_STAGE_A(0, 0, a2, last);
            PG8_BAR; PG8_WAIT_L(0); PG8_MMA(1, 0, At, B0); PG8_BAR; PG8_SCHED;
            PG8_STAGE(PG8_SB(0, 1), b2 + hstepB, voffB);
            PG8_WAIT_V(6); PG8_BAR; PG8_MMA(1, 1, At, B1); PG8_BAR;
            PG8_LDB(B0, 1, 0); PG8_SCHED; PG8_LDA(At, 1, 0); PG8_STAGE_A(0, 1, a2, last);
            PG8_WAIT_L(8); PG8_BAR; PG8_WAIT_L(0); PG8_MMA(0, 0, At, B0); PG8_BAR; PG8_SCHED;
            PG8_LDB(B1, 1, 1); PG8_STAGE(PG8_SB(1, 0), b3, voffB);
            PG8_BAR; PG8_WAIT_L(0); PG8_MMA(0, 1, At, B1); PG8_BAR;
            PG8_LDA(At, 1, 1); PG8_STAGE_A(1, 0, a3, last);
            PG8_BAR; PG8_WAIT_L(0); PG8_MMA(1, 0, At, B0); PG8_BAR; PG8_SCHED;
            PG8_STAGE(PG8_SB(1, 1), b3 + hstepB, voffB);
            PG8_WAIT_V(6); PG8_BAR; PG8_MMA(1, 1, At, B1); PG8_BAR;
            }
        }
        if constexpr (ALIGN_EPI) { if (wr == 0) PG8_BAR; }
        if constexpr (!Epi::AFTER_DRAIN) { int tz = lane_id(); asm volatile("" : "+v"(tz));
            if constexpr ((PROBE & 1) != 0) { _Pragma("unroll") for (int a = 0; a < 2; ++a) _Pragma("unroll") for (int b = 0; b < 2; ++b) _Pragma("unroll") for (int m = 0; m < 4; ++m) _Pragma("unroll") for (int n = 0; n < 2; ++n) asm volatile("" :: "v"(acc[a][b][m][n])); }
            else E(acc, cur, wr, wc, tz & 15, (tz & 63) >> 4); S.done(cur); }
        if (!has_next) break;
        if constexpr (Sched::GATHER) {
            gv[0] = gn[0]; gv[1] = gn[1]; }
        if constexpr (Sched::GATHER) { Unit n2_; if (S.next(ui + 2, n2_)) gather_unit(ui + 2, gn); asm volatile("" : "+v"(gn[0]), "+v"(gn[1])); }
        PG8_ACC_INIT(nxt);
        cur = nxt; cA = nA; cB = nB; ++ui;
        if constexpr (ALIGN_EPI) { if (wr == 1) PG8_BAR; }
    }
    PG8_WAIT_V(0);
    if constexpr (!ALIGN_EPI) { if (wr == 0) PG8_BAR; }
    PG8_BAR;
    if constexpr (Epi::AFTER_DRAIN) { E.fused(acc, cur, wr, wc, fr, fq, lds, wid, lane); S.done(cur); }
#undef PG8_SA
#undef PG8_SB
#undef PG8_ACC_INIT
#undef PG8_STAGE
#undef PG8_STAGE_A
#undef PG8_LDA
#undef PG8_LDB
#undef PG8_MMA
#undef PG8_WAIT_V
#undef PG8_WAIT_L
#undef PG8_BAR
#undef PG8_SCHED
}
}

template <int MODE>
__device__ __forceinline__ void transpose_item(const float* W, int K, int N, bf16_t* WT, LAS float* scr, int item, int lane) {
    const int nblk = N / 32, kb = item / nblk, nb = item % nblk, k0 = 64 * kb, n0 = 32 * nb;
    int dr = n0;
    if (MODE == 1) { const int j = n0 & 1023, half = n0 >> 10; dr = 256 * (j >> 7) + 128 * half + (j & 127); }
    if (MODE == 2) { const int part = n0 >> 10, c = n0 & 1023, head = c >> 6, half = (c >> 5) & 1; dr = part * 1024 + (head >> 2) * 256 + half * 128 + (head & 3) * 32; }
    float wv[32];
#pragma unroll
    for (int i = 0; i < 32; ++i) wv[i] = __builtin_nontemporal_load(W + (size_t)(k0 + 2 * i + (lane >> 5)) * N + n0 + (lane & 31));
#pragma unroll
    for (int i = 0; i < 32; ++i) scr[(2 * i + (lane >> 5)) * 33 + (lane & 31)] = wv[i];
    WAVE_SYNC();
    const int c = lane & 7;
#pragma unroll
    for (int j = 0; j < 4; ++j) { const int n = (lane >> 3) + 8 * j; const LAS float* s = scr + (8 * c) * 33 + n;
        u32x4 o; o.x = pk2(s[0 * 33], s[1 * 33]); o.y = pk2(s[2 * 33], s[3 * 33]); o.z = pk2(s[4 * 33], s[5 * 33]); o.w = pk2(s[6 * 33], s[7 * 33]);
        *(u32x4*)(WT + (size_t)(dr + n) * K + k0 + 8 * c) = o; }
    WAVE_SYNC();
}

template <int MODE>
__device__ __forceinline__ void transpose_item_fp8(const float* W, int K, int N, unsigned char* WT, LAS float* scr, int item, int lane, float scale) {
    const int nblk = N / 32, kb = item / nblk, nb = item % nblk, k0 = 64 * kb, n0 = 32 * nb;
    int dr = n0;
    if (MODE == 1) { const int j = n0 & 1023, half = n0 >> 10; dr = 256 * (j >> 7) + 128 * half + (j & 127); }
    const int rg = lane >> 3, c4 = lane & 7;
    f32x4 wv[8];
#pragma unroll
    for (int i = 0; i < 8; ++i) wv[i] = __builtin_nontemporal_load((const f32x4*)(W + (size_t)(k0 + 8 * i + rg) * N + n0 + 4 * c4));
#pragma unroll
    for (int i = 0; i < 8; ++i) *(LAS f32x4*)(scr + (8 * i + rg) * 36 + 4 * c4) = wv[i] * scale;
    WAVE_SYNC();
#pragma unroll
    for (int j = 0; j < 2; ++j) { const int n = lane & 31, c = (lane >> 5) + 2 * j; const LAS float* s = scr + (16 * c) * 36 + n;
        u32x4 o; o.x = pk4_fp8(s[0 * 36], s[1 * 36], s[2 * 36], s[3 * 36]); o.y = pk4_fp8(s[4 * 36], s[5 * 36], s[6 * 36], s[7 * 36]);
        o.z = pk4_fp8(s[8 * 36], s[9 * 36], s[10 * 36], s[11 * 36]); o.w = pk4_fp8(s[12 * 36], s[13 * 36], s[14 * 36], s[15 * 36]);
        *(u32x4*)(WT + (size_t)(dr + n) * K + k0 + 16 * c) = o; }
    WAVE_SYNC();
}

__device__ __forceinline__ const float* ld_ptr(volatile LAS unsigned long long* t, int k) {
    const unsigned long long v = t[k]; const unsigned lo = __builtin_amdgcn_readfirstlane((unsigned)v), hi = __builtin_amdgcn_readfirstlane((unsigned)(v >> 32));
    return (const float*)(const GAS float*)(((unsigned long long)hi << 32) | lo);
}
__device__ __forceinline__ void phase_prologue(const Ctx& X, volatile LAS unsigned long long* ptab) {
#define in_(k) ld_ptr(ptab, k)
    const float* a_re = in_(3); const float* a_im = in_(4); const float* log_dt = in_(5); const float* b_re = in_(6); const float* b_im = in_(7);
    float2* Abar = (float2*)(X.ws + WS_S5A); float2* Bbar = (float2*)(X.ws + WS_S5B); float2* rope = (float2*)(X.ws + WS_ROPE);
    const int gt = X.bid * NTHR + X.tid, NT = X.G * NTHR;
    for (int it = gt; it < 2 * SSM_G * SSM_P; it += NT) {
        const int ig = it >> 6;
        const double lam_re = fmin((double)a_re[it], -1e-4), lam_im = (double)a_im[it];
        const double dt = exp((double)log_dt[ig]);
        const double mag = exp(lam_re * dt), ang = lam_im * dt;
        const double abr = mag * cos(ang), abi = mag * sin(ang);
        const double nr = abr - 1.0, ni = abi, den = lam_re * lam_re + lam_im * lam_im;
        const double cr = (nr * lam_re + ni * lam_im) / den, ci = (ni * lam_re - nr * lam_im) / den;
        Abar[it] = make_float2((float)abr, (float)abi);
        for (int h = 0; h < SSM_H; ++h) {
            const double br = (double)b_re[it * 16 + h], bi = (double)b_im[it * 16 + h];
            Bbar[it * 16 + h] = make_float2((float)(cr * br - ci * bi), (float)(cr * bi + ci * br));
        }
    }
    for (int it = gt; it < SEQ * 32; it += NT) {
        const int pos = it >> 5, i = it & 31;
        const float inv = powf(10000.0f, -(float)i / 32.0f);
        const float ang = (float)pos * inv;
        rope[it] = make_float2((float)cos((double)ang), (float)sin((double)ang));
    }
    { const float* rw = in_(20); bf16_t* RWh = (bf16_t*)(X.ws + WS_RWH); bf16_t* RWl = (bf16_t*)(X.ws + WS_RWL);
      for (int it = gt; it < DEPTH * NE * D; it += NT) { const int k = it & 1023, e = (it >> 10) & 31, l = it >> 15;
          const float w = rw[((size_t)l * D + k) * NE + e]; const unsigned hb = f2bf(w); RWh[it] = (bf16_t)hb; RWl[it] = (bf16_t)f2bf(w - bf2f((bf16_t)hb)); } }
    { const float* x = in_(0); bf16_t* H0 = (bf16_t*)(X.ws + WS_H0);
      const size_t n8 = (size_t)T * D / 8;
      for (size_t i8 = (size_t)gt; i8 < n8; i8 += (size_t)NT) {
          const f32x4 a = *(const f32x4*)(x + i8 * 8), b = *(const f32x4*)(x + i8 * 8 + 4);
          u32x4 o; o.x = pk2(a[0], a[1]); o.y = pk2(a[2], a[3]); o.z = pk2(b[0], b[1]); o.w = pk2(b[2], b[3]);
          *(u32x4*)(H0 + i8 * 8) = o; } }
    LAS float* scr = (LAS float*)(X.lds + X.wave * 16384);
    const int gw = X.bid * NWAVES + X.wave, NGW = X.G * NWAVES;
    constexpr int I_GU = 16 * 64, I_DN = 16 * 32, I_IN = 16 * 64, I_GLU = 8 * 16, I_OUT = 16 * 32, I_QKV = 16 * 96, I_O = 16 * 32;
    constexpr int N_GU = 128 * I_GU, N_DN = 128 * I_DN, N_IN = 2 * I_IN, N_GLU = 2 * I_GLU, N_OUT = 2 * I_OUT, N_QKV = 2 * I_QKV, N_O = 2 * I_O;
    constexpr int NITEMS = N_GU + N_DN + N_IN + N_GLU + N_OUT + N_QKV + N_O;
    for (int it = gw; it < NITEMS; it += NGW) {
        int r = it;
        if (r < N_GU) { const int m = r / I_GU; transpose_item_fp8<1>(in_(22) + (size_t)m * D * 2048, D, 2048, (unsigned char*)(X.ws + WS_WGU + (size_t)m * 2048 * D), scr, r % I_GU, X.lane, (float)(1 << W8_SHIFT_GU)); continue; } r -= N_GU;
        if (r < N_DN) { const int m = r / I_DN; transpose_item_fp8<0>(in_(24) + (size_t)m * D * D, D, D, (unsigned char*)(X.ws + WS_WDN + (size_t)m * D * D), scr, r % I_DN, X.lane, (float)(1 << W8_SHIFT_DN)); continue; } r -= N_DN;
        if (r < N_IN) { const int m = r / I_IN; transpose_item<0>(in_(1) + (size_t)m * D * 2048, D, 2048, (bf16_t*)(X.ws + WS_WIN) + (size_t)m * 2048 * D, scr, r % I_IN, X.lane); continue; } r -= N_IN;
        if (r < N_GLU) { const int m = r / I_GLU; transpose_item<0>(in_(11) + (size_t)m * 512 * 512, 512, 512, (bf16_t*)(X.ws + WS_WGLU) + (size_t)m * 512 * 512, scr, r % I_GLU, X.lane); continue; } r -= N_GLU;
        if (r < N_OUT) { const int m = r / I_OUT; transpose_item<0>(in_(13) + (size_t)m * D * D, D, D, (bf16_t*)(X.ws + WS_WOUT) + (size_t)m * D * D, scr, r % I_OUT, X.lane); continue; } r -= N_OUT;
        if (r < N_QKV) { const int m = r / I_QKV; transpose_item<2>(in_(14) + (size_t)m * D * 3072, D, 3072, (bf16_t*)(X.ws + WS_WQKV) + (size_t)m * 3072 * D, scr, r % I_QKV, X.lane); continue; } r -= N_QKV;
        { const int m = r / I_O; transpose_item<0>(in_(15) + (size_t)m * D * D, D, D, (bf16_t*)(X.ws + WS_WO) + (size_t)m * D * D, scr, r % I_O, X.lane); }
    }
}

#undef in_
typedef float f32x4v __attribute__((ext_vector_type(4)));
template <int PASS>
__device__ __forceinline__ void phase_s5(const Ctx& X, int i, const bf16_t* proj, const float* conv_w, const float* c_re, const float* c_im, const float* d_skip, bf16_t* mix, bf16_t* Z, int probe = 0) {
    using pg8::bf16x8;
    if (PASS == 2 && !(probe & 1)) {
        const float* w = conv_w + (size_t)i * 3 * CONV_CH;
        const int c = X.lane * 8;
        float w0[8], w1[8], w2[8];
#pragma unroll
        for (int j = 0; j < 8; ++j) { w0[j] = w[0 * CONV_CH + c + j]; w1[j] = w[1 * CONV_CH + c + j]; w2[j] = w[2 * CONV_CH + c + j]; }
        const int gwv = X.bid * NWAVES + X.wave, NGWV = X.G * NWAVES;
        for (int run = gwv; run < T / 16; run += NGWV) {
            const int bt0 = run * 16, pos0 = seqpos(bt0);
            const bf16_t* pr = proj + (size_t)bt0 * 2048 + c;
            float p0[8], p1[8];
#pragma unroll
            for (int j = 0; j < 8; ++j) { p0[j] = 0.f; p1[j] = 0.f; }
            if (pos0 >= 2) {
                float a[8], b[8];
                unpack8(*(const u32x4*)(pr + 512 - 4096), a); unpack8(*(const u32x4*)(pr + 1024 - 4096), b);
#pragma unroll
                for (int j = 0; j < 8; ++j) p0[j] = a[j] * b[j];
                unpack8(*(const u32x4*)(pr + 512 - 2048), a); unpack8(*(const u32x4*)(pr + 1024 - 2048), b);
#pragma unroll
                for (int j = 0; j < 8; ++j) p1[j] = a[j] * b[j];
            }
#pragma unroll 4
            for (int k = 0; k < 16; ++k) {
                float gb[8], a[8], b[8], o[8];
                unpack8(*(const u32x4*)(pr + (size_t)k * 2048), gb); unpack8(*(const u32x4*)(pr + (size_t)k * 2048 + 512), a); unpack8(*(const u32x4*)(pr + (size_t)k * 2048 + 1024), b);
#pragma unroll
                for (int j = 0; j < 8; ++j) { const float p2 = a[j] * b[j];
                    float s = w2[j] * p2; s += w1[j] * p1[j]; s += w0[j] * p0[j];
                    o[j] = gb[j] * s; p0[j] = p1[j]; p1[j] = p2; }
                *(u32x4*)(mix + (size_t)(bt0 + k) * D + c) = pack8(o);
            }
        }
    }
    const int lane = X.lane, n16 = lane & 15, kq = lane >> 4;
    LAS float* BuT = (LAS float*)(X.lds + X.wave * 15360);
    LAS unsigned char* xsb = X.lds + X.wave * 15360 + 10240;
    const float2* Abar = (const float2*)(X.ws + WS_S5A); const float2* Bbar = (const float2*)(X.ws + WS_S5B);
    float2* Sst = (float2*)(X.ws + WS_S5S);
    const int gw = X.bid * NWAVES + X.wave, NGW = X.G * NWAVES;
    const int g = gw & 31, ig = i * 32 + g;
        const float2 A = Abar[ig * 64 + lane];
    bf16x8 bfr[8];
#pragma unroll
    for (int cb = 0; cb < 8; ++cb) {
        u32x4 w = (u32x4){0u, 0u, 0u, 0u};
        if (kq < 2) { const float2* bp = Bbar + ((size_t)(ig * 64 + 16 * (cb & 3) + n16)) * 16 + 8 * kq; float v[8];
#pragma unroll
            for (int j = 0; j < 8; ++j) { const float2 t2 = bp[j]; v[j] = cb < 4 ? t2.x : t2.y; }
            w = pack8(v); }
        bfr[cb] = __builtin_bit_cast(bf16x8, w);
    }
    bf16x8 cfr[4]; bf16x8 dfr;
    if (PASS == 2) {
#pragma unroll
        for (int ks = 0; ks < 4; ++ks) { const int p0 = 16 * ks + 4 * kq; const f32x4 cr = *(const f32x4*)(c_re + (size_t)(ig * 16 + n16) * 64 + p0), ci = *(const f32x4*)(c_im + (size_t)(ig * 16 + n16) * 64 + p0);
            u32x4 w; w.x = cvt_pk_bf16(cr[0], -ci[0]); w.y = cvt_pk_bf16(cr[1], -ci[1]); w.z = cvt_pk_bf16(cr[2], -ci[2]); w.w = cvt_pk_bf16(cr[3], -ci[3]); cfr[ks] = __builtin_bit_cast(bf16x8, w); }
        { const float dv = d_skip[ig * 16 + n16]; float v[8];
#pragma unroll
          for (int j = 0; j < 8; ++j) v[j] = (kq < 2 && 8 * kq + j == n16) ? dv : 0.f;
          dfr = __builtin_bit_cast(bf16x8, pack8(v)); }
    }
    u32x4 uw_n = (u32x4){0u, 0u, 0u, 0u}; float2 xin_n = make_float2(0.f, 0.f);
    auto task_head = [&](int task_, u32x4& uw_, float2& xin_) { const int c_ = (task_ >> 5) & 63, b_ = task_ >> 11;
        if (PASS == 2) xin_ = ((const float2*)(X.ws + WS_S5X))[((size_t)(b_ * 32 + g) * 64 + c_) * 64 + lane];
        uw_ = (u32x4){0u, 0u, 0u, 0u};
        if (kq < 2) uw_ = *(const u32x4*)(proj + ((size_t)b_ * SEQ + (size_t)c_ * 128) * 2048 + 1536 + g * 16 + (size_t)n16 * 2048 + 8 * kq); };
    if (!(probe & 2) && gw < BATCH * 64 * SSM_G) task_head(gw, uw_n, xin_n);
    if (!(probe & 2))
    for (int task = gw; task < BATCH * 64 * SSM_G; task += NGW) {
        const int c = (task >> 5) & 63, b = task >> 11;
        float xr = 0.f, xi = 0.f;
        if (PASS == 2) { xr = xin_n.x; xi = xin_n.y; }
        const bf16_t* ub = proj + ((size_t)b * SEQ + (size_t)c * 128) * 2048 + 1536 + g * 16;
        bf16_t* zb = Z + ((size_t)b * SEQ + (size_t)c * 128) * SSM_W + g * 16;
        u32x4 uw = uw_n;
        if (task + NGW < BATCH * 64 * SSM_G) task_head(task + NGW, uw_n, xin_n);
#pragma nounroll
        for (int blk = 0; blk < 8; ++blk) {
            const bf16x8 ufr = __builtin_bit_cast(bf16x8, uw);
            u32x4 un = (u32x4){0u, 0u, 0u, 0u};
            if (kq < 2 && blk < 7) un = *(const u32x4*)(ub + (size_t)((blk + 1) * 16 + n16) * 2048 + 8 * kq);
#pragma unroll
            for (int cb = 0; cb < 8; ++cb) {
                f32x4v acc = (f32x4v){0.f, 0.f, 0.f, 0.f};
                acc = __builtin_amdgcn_mfma_f32_16x16x32_bf16(ufr, bfr[cb], acc, 0, 0, 0);
                *(LAS f32x4v*)(BuT + (16 * cb + n16) * 20 + 4 * kq) = acc;
            }
            WAVE_SYNC();
#pragma unroll
            for (int k4 = 0; k4 < 4; ++k4) {
                const f32x4v br = *(const LAS f32x4v*)(BuT + lane * 20 + 4 * k4), bi = *(const LAS f32x4v*)(BuT + (64 + lane) * 20 + 4 * k4);
#pragma unroll
                for (int s = 0; s < 4; ++s) {
                    float nr = fmaf(-A.y, xi, fmaf(A.x, xr, br[s])); asm volatile("" : "+v"(nr));
                    float ni = fmaf(A.y, xr, fmaf(A.x, xi, bi[s])); asm volatile("" : "+v"(ni));
                    xr = nr; xi = ni;
                    if (PASS == 2) *(LAS unsigned*)(xsb + (4 * k4 + s) * 272 + lane * 4) = cvt_pk_bf16(xr, xi);
                }
            }
            if (PASS == 2) {
                WAVE_SYNC();
                f32x4v y = (f32x4v){0.f, 0.f, 0.f, 0.f};
                bf16x8 xa[4];
#pragma unroll
                for (int ks = 0; ks < 4; ++ks) xa[ks] = *(const LAS bf16x8*)(xsb + n16 * 272 + ks * 64 + kq * 16);
                WAVE_SYNC(); __builtin_amdgcn_sched_barrier(0);
#pragma unroll
                for (int ks = 0; ks < 4; ++ks) y = __builtin_amdgcn_mfma_f32_16x16x32_bf16(xa[ks], cfr[ks], y, 0, 0, 0);
                y = __builtin_amdgcn_mfma_f32_16x16x32_bf16(ufr, dfr, y, 0, 0, 0);
                asm volatile("" :: "v"(xa[0]), "v"(xa[1]), "v"(xa[2]), "v"(xa[3]), "v"(ufr));
#pragma unroll
                for (int q = 0; q < 4; ++q) zb[(size_t)(blk * 16 + 4 * kq + q) * SSM_W + n16] = (bf16_t)f2bf(gelu_tanh(y[q]));
            }
            WAVE_SYNC();
            uw = un;
        }
        if (PASS == 1) Sst[((size_t)(b * 32 + g) * 64 + c) * 64 + lane] = make_float2(xr, xi);
    }
}

__device__ __forceinline__ void phase_s5_carry(const Ctx& X, int i) {
    const float2* Abar = (const float2*)(X.ws + WS_S5A); const float2* Sst = (const float2*)(X.ws + WS_S5S); float2* Xin = (float2*)(X.ws + WS_S5X);
    const int gw = X.bid * NWAVES + X.wave, NGW = X.G * NWAVES, lane = X.lane;
    for (int bg = gw; bg < BATCH * SSM_G; bg += NGW) {
        const float2 A = Abar[(i * 32 + (bg & 31)) * 64 + lane];
        float pr_ = A.x, pi_ = A.y;
#pragma unroll
        for (int q = 0; q < 7; ++q) { const float nr = pr_ * pr_ - pi_ * pi_, ni = 2.f * pr_ * pi_; pr_ = nr; pi_ = ni; }
        float xr = 0.f, xi = 0.f;
        const size_t base = (size_t)bg * 64 * 64 + lane;
#pragma unroll 8
        for (int c = 0; c < 64; ++c) {
            Xin[base + (size_t)c * 64] = make_float2(xr, xi);
            const float2 s = Sst[base + (size_t)c * 64];
            const float nr = pr_ * xr - pi_ * xi + s.x, ni = pr_ * xi + pi_ * xr + s.y; xr = nr; xi = ni;
        }
    }
}

typedef short v4i16_t __attribute__((ext_vector_type(4)));
typedef float f32x16 __attribute__((ext_vector_type(16)));
__device__ __forceinline__ v4i16_t vtr16(const LAS unsigned char* p) { return __builtin_amdgcn_ds_read_tr16_b64_v4i16((LAS v4i16_t*)p); }
template <int PASS>
__device__ __forceinline__ void phase_attn(const Ctx& X, const bf16_t* proj, bf16_t* att, bf16_t* ost, float2* ml) {
    using pg8::bf16x8;
    const int lane = X.lane, i32 = lane & 31, hi = lane >> 5;
    LAS unsigned char* vbuf = X.lds + X.wave * 16384;
    LAS unsigned char* kbuf = vbuf + 8192;
    const int gw = X.bid * NWAVES + X.wave, NGW = X.G * NWAVES;
    const float NEG = opaque_f(-3.0e38f); const int seqmax = opaque_i(SEQ - 1);
    const int vrd = ((lane >> 4) & 1) * 32 + (lane & 3) * 8 + (4 * hi + ((lane & 15) >> 2)) * 64;
    const bool xdeal = (X.G == 256);
    constexpr int NT = PASS == 0 ? 13 : 5, PD = 2, NR = 3;
    const int lrow = lane >> 3, lpc = lane & 7;
#pragma nounroll
    for (int it = 0; it < (xdeal ? 8 : (BATCH * NH * 256 + NGW - 1) / NGW); ++it) {
        const int task = xdeal ? (((it * 8 + (X.bid & 7)) << 8) | ((X.bid >> 3) * 8 + X.wave)) : (gw + it * NGW);
        if (task >= BATCH * NH * 256) break;
        const int QST = PASS == 0 ? 4 : 16;
        const int r = PASS == 0 ? (task & 3) : (task & 15), blk = PASS == 0 ? ((task >> 2) & 63) : ((task >> 4) & 15), hh = (task >> 8) & 15, b = task >> 12;
        const bf16_t* base = proj + (size_t)b * SEQ * 3072 + hh * 64;
        const int t0 = (PASS == 0 ? 128 : 512) * blk + r;
        bf16x8 qf[4];
        { const bf16_t* qp = base + (size_t)(t0 + QST * i32) * 3072 + 8 * hi;
#pragma unroll
          for (int d0 = 0; d0 < 4; ++d0) qf[d0] = *(const bf16x8*)(qp + 16 * d0); }
        float m_run = NEG, l_run = 0.f;
        f32x16 o0, o1;
#pragma unroll
        for (int q = 0; q < 16; ++q) { o0[q] = 0.f; o1[q] = 0.f; }
        const size_t srow = (size_t)(b * SEQ + t0 + QST * i32);
        if (PASS == 1) {
            const float2 mlv = ml[srow * NH + hh]; m_run = mlv.x; l_run = hi == 0 ? mlv.y : 0.f;
            const bf16_t* sp = ost + srow * D + hh * 64 + 4 * hi;
#pragma unroll
            for (int gq = 0; gq < 4; ++gq) { const u32x2 w0 = *(const u32x2*)(sp + 8 * gq), w1 = *(const u32x2*)(sp + 32 + 8 * gq);
                o0[4 * gq] = bf_lo(w0.x); o0[4 * gq + 1] = bf_hi(w0.x); o0[4 * gq + 2] = bf_lo(w0.y); o0[4 * gq + 3] = bf_hi(w0.y);
                o1[4 * gq] = bf_lo(w1.x); o1[4 * gq + 1] = bf_hi(w1.x); o1[4 * gq + 2] = bf_lo(w1.y); o1[4 * gq + 3] = bf_hi(w1.y); }
        }
#define AT_PAT(j) (PASS == 1 ? 0 : ((j) < 5 ? 0 : 1))
#define AT_KT(j) (PASS == 1 ? (j) : ((j) < 5 ? (j) : (j) - 5))
#define AT_DIL(j) (PASS == 1 ? 16 : (AT_PAT(j) == 0 ? 4 : 1))
#define AT_QS(j) (PASS == 1 ? 1 : (AT_PAT(j) == 0 ? 1 : 4))
#define AT_RR(j) (PASS == 1 ? r : (AT_PAT(j) == 0 ? r : 0))
        u32x4 kr[NR][4], vr[NR][4];
        auto issue = [&](int j, u32x4 (&kk)[4], u32x4 (&vv)[4]) {
            const int dil = AT_DIL(j), rr = AT_RR(j), Mt = (t0 - rr) / dil - 128 + 32 * AT_KT(j);
            auto keypos = [&](int M) { int p = dil * M + rr; p = p < 0 ? 0 : p; p = p > seqmax ? seqmax : p; return p; };
#pragma unroll
            for (int q = 0; q < 4; ++q) {
                const bf16_t* rp = base + (size_t)keypos(Mt + 8 * q + lrow) * 3072;
                kk[q] = *(const u32x4*)(rp + 1024 + 8 * (lpc ^ lrow));
                vv[q] = *(const u32x4*)(rp + 2048 + 8 * lpc);
            }
        };
#pragma unroll
        for (int j = 0; j < PD; ++j) issue(j, kr[j], vr[j]);
#pragma unroll
        for (int j = 0; j < NT; ++j) {
            if (j + PD < NT) issue(j + PD, kr[(j + PD) % NR], vr[(j + PD) % NR]);
            const int kt = AT_KT(j), dil = AT_DIL(j), rr = AT_RR(j), Mstart = (t0 - rr) / dil - 128, qi = AT_QS(j) * i32;
            f32x16 s;
#pragma unroll
            for (int q = 0; q < 16; ++q) s[q] = 0.f;
#pragma unroll
            for (int q = 0; q < 4; ++q) *(LAS u32x4*)(kbuf + (j & 1) * 4096 + q * 1024 + lane * 16) = kr[j % NR][q];
            bf16x8 kf[4];
#pragma unroll
            for (int d0 = 0; d0 < 4; ++d0) kf[d0] = *(const LAS bf16x8*)(kbuf + (j & 1) * 4096 + (i32 >> 3) * 1024 + (i32 & 7) * 128 + (((2 * d0 + hi) ^ (i32 & 7)) << 4));
#pragma unroll
            for (int d0 = 0; d0 < 4; ++d0) s = __builtin_amdgcn_mfma_f32_32x32x16_bf16(kf[d0], qf[d0], s, 0, 0, 0);
            const int hi_ = qi + 128 - 32 * kt; int lo = hi_ - 128; { const int nk = -(Mstart + 32 * kt); lo = lo > nk ? lo : nk; }
            const int rb = 4 * hi - lo; const unsigned span = (unsigned)(hi_ - lo);
            const bool any = hi_ >= lo;
            float tmax = NEG;
#pragma unroll
            for (int q = 0; q < 16; ++q) { const int rowc = (q & 3) + 8 * (q >> 2); const bool ok = any && ((unsigned)(rowc + rb) <= span) && (rowc + rb >= 0); s[q] = ok ? s[q] : NEG; tmax = fmaxf(tmax, s[q]); }
            tmax = fmaxf(tmax, bperm_f(lane ^ 32, tmax));
            const float m_new = fmaxf(m_run, tmax), sc = __builtin_amdgcn_exp2f(m_run - m_new);
            m_run = m_new;
            float ps = 0.f;
#pragma unroll
            for (int q = 0; q < 16; ++q) { s[q] = __builtin_amdgcn_exp2f(s[q] - m_new); ps += s[q]; }
            l_run = l_run * sc + ps;
#pragma unroll
            for (int q = 0; q < 16; ++q) { o0[q] *= sc; o1[q] *= sc; }
            u32x4 pw0, pw1;
            pw0.x = cvt_pk_bf16(s[0], s[1]); pw0.y = cvt_pk_bf16(s[2], s[3]); pw0.z = cvt_pk_bf16(s[4], s[5]); pw0.w = cvt_pk_bf16(s[6], s[7]);
            pw1.x = cvt_pk_bf16(s[8], s[9]); pw1.y = cvt_pk_bf16(s[10], s[11]); pw1.z = cvt_pk_bf16(s[12], s[13]); pw1.w = cvt_pk_bf16(s[14], s[15]);
            const bf16x8 pf0 = __builtin_bit_cast(bf16x8, pw0), pf1 = __builtin_bit_cast(bf16x8, pw1);
#pragma unroll
            for (int q = 0; q < 4; ++q) *(LAS u32x4*)(vbuf + (j & 1) * 4096 + ((lpc >> 2) * 2 + (q >> 1)) * 1024 + ((q & 1) * 8 + lrow) * 64 + (lpc & 3) * 16) = vr[j % NR][q];
            const LAS unsigned char* vb = vbuf + (j & 1) * 4096 + vrd;
#pragma unroll
            for (int dh = 0; dh < 2; ++dh) {
#pragma unroll
                for (int kg = 0; kg < 2; ++kg) {
                    const v4i16_t vlo = vtr16(vb + (dh * 2 + kg) * 1024), vhi = vtr16(vb + (dh * 2 + kg) * 1024 + 512);
                    const bf16x8 vf = (bf16x8){vlo[0], vlo[1], vlo[2], vlo[3], vhi[0], vhi[1], vhi[2], vhi[3]};
                    if (dh == 0) o0 = __builtin_amdgcn_mfma_f32_32x32x16_bf16(vf, kg == 0 ? pf0 : pf1, o0, 0, 0, 0);
                    else o1 = __builtin_amdgcn_mfma_f32_32x32x16_bf16(vf, kg == 0 ? pf0 : pf1, o1, 0, 0, 0);
                }
            }
        }
#undef AT_PAT
#undef AT_KT
#undef AT_DIL
#undef AT_QS
#undef AT_RR
        const float lt = l_run + bperm_f(lane ^ 32, l_run), rl = PASS == 1 ? 1.0f / lt : 1.0f;
        if (PASS == 0 && hi == 0) ml[srow * NH + hh] = make_float2(m_run, lt);
        bf16_t* op = (PASS == 1 ? att : ost) + srow * D + hh * 64 + 4 * hi;
#pragma unroll
        for (int gq = 0; gq < 4; ++gq) {
            u32x2 w0, w1;
            w0.x = cvt_pk_bf16(o0[4 * gq] * rl, o0[4 * gq + 1] * rl); w0.y = cvt_pk_bf16(o0[4 * gq + 2] * rl, o0[4 * gq + 3] * rl);
            w1.x = cvt_pk_bf16(o1[4 * gq] * rl, o1[4 * gq + 1] * rl); w1.y = cvt_pk_bf16(o1[4 * gq + 2] * rl, o1[4 * gq + 3] * rl);
            *(u32x2*)(op + 8 * gq) = w0; *(u32x2*)(op + 32 + 8 * gq) = w1;
        }
    }
}

__device__ __forceinline__ void phase_attn_coop1(const Ctx& X, const bf16_t* proj, bf16_t* att, const bf16_t* ost, const float2* ml) {
    using pg8::bf16x8;
    const int lane = X.lane, i32 = lane & 31, hi = lane >> 5, w = X.wave;
    LAS unsigned char* kimg = X.lds;
    LAS unsigned char* vimg = X.lds + 49152;
    const float NEG = opaque_f(-3.0e38f); const int seqmax = opaque_i(SEQ - 1);
    const int vrd = ((lane >> 4) & 1) * 32 + (lane & 3) * 8 + (4 * hi + ((lane & 15) >> 2)) * 64;
    const int lrow = X.tid >> 3, lpc = X.tid & 7;
    constexpr int NGRP = BATCH * NH * 32;
    const bool xdeal = (X.G == 256);
    const int ngi = xdeal ? 8 : (NGRP + X.G - 1) / X.G;
    auto group_of = [&](int it) { return xdeal ? ((((7 - it) * 8 + (X.bid & 7)) << 5) | (X.bid >> 3)) : (X.bid + it * X.G); };
    u32x4 pk[6], pv[6];
    auto prefetch = [&](int grp) {
        const int half = grp & 1, r = (grp >> 1) & 15, hh = (grp >> 5) & 15, b = grp >> 9;
        const bf16_t* base = proj + (size_t)b * SEQ * 3072 + hh * 64;
#pragma unroll
        for (int i = 0; i < 6; ++i) {
            const int ridx = lrow + 64 * i, M = 32 * (8 * half - 4) + ridx;
            int p = 16 * M + r; p = p < 0 ? 0 : p; p = p > seqmax ? seqmax : p;
            const bf16_t* rp = base + (size_t)p * 3072;
            pk[i] = *(const u32x4*)(rp + 1024 + 8 * lpc); pv[i] = *(const u32x4*)(rp + 2048 + 8 * lpc);
        }
    };
    if (group_of(0) < NGRP) prefetch(group_of(0));
#pragma nounroll
    for (int it = 0; it < ngi; ++it) {
        const int grp = group_of(it);
        if (grp >= NGRP) break;
        const int half = grp & 1, r = (grp >> 1) & 15, hh = (grp >> 5) & 15, b = grp >> 9;
        __syncthreads();
#pragma unroll
        for (int i = 0; i < 6; ++i) {
            const int ridx = lrow + 64 * i, tl = ridx >> 5, row = ridx & 31;
            *(LAS u32x4*)(kimg + tl * 4096 + row * 128 + ((lpc ^ (row & 7)) << 4)) = pk[i];
            *(LAS u32x4*)(vimg + tl * 4096 + ((lpc >> 2) * 2 + (row >> 4)) * 1024 + (row & 15) * 64 + (lpc & 3) * 16) = pv[i];
        }
        __syncthreads();
        const int blk = 8 * half + w, t0 = 512 * blk + r;
        const bf16_t* base = proj + (size_t)b * SEQ * 3072 + hh * 64;
        bf16x8 qf[4];
        { const bf16_t* qp = base + (size_t)(t0 + 16 * i32) * 3072 + 8 * hi;
#pragma unroll
          for (int d0 = 0; d0 < 4; ++d0) qf[d0] = *(const bf16x8*)(qp + 16 * d0); }
        const size_t srow = (size_t)(b * SEQ + t0 + 16 * i32);
        float m_run, l_run; f32x16 o0, o1;
        { const float2 mlv = ml[srow * NH + hh]; m_run = mlv.x; l_run = hi == 0 ? mlv.y : 0.f;
          const bf16_t* sp = ost + srow * D + hh * 64 + 4 * hi;
#pragma unroll
          for (int gq = 0; gq < 4; ++gq) { const u32x2 w0 = *(const u32x2*)(sp + 8 * gq), w1 = *(const u32x2*)(sp + 32 + 8 * gq);
              o0[4 * gq] = bf_lo(w0.x); o0[4 * gq + 1] = bf_hi(w0.x); o0[4 * gq + 2] = bf_lo(w0.y); o0[4 * gq + 3] = bf_hi(w0.y);
              o1[4 * gq] = bf_lo(w1.x); o1[4 * gq + 1] = bf_hi(w1.x); o1[4 * gq + 2] = bf_lo(w1.y); o1[4 * gq + 3] = bf_hi(w1.y); } }
        { const int gn = it + 1 < ngi ? group_of(it + 1) : NGRP; if (gn < NGRP) prefetch(gn); }
        const int Mstart = 32 * blk - 128;
        auto qk = [&](int kt) { const LAS unsigned char* kt_ = kimg + (w + kt) * 4096; bf16x8 kf[4];
#pragma unroll
            for (int d0 = 0; d0 < 4; ++d0) kf[d0] = *(const LAS bf16x8*)(kt_ + i32 * 128 + (((2 * d0 + hi) ^ (i32 & 7)) << 4));
            f32x16 s;
#pragma unroll
            for (int q = 0; q < 16; ++q) s[q] = 0.f;
            __builtin_amdgcn_s_setprio(1);
#pragma unroll
            for (int d0 = 0; d0 < 4; ++d0) s = __builtin_amdgcn_mfma_f32_32x32x16_bf16(kf[d0], qf[d0], s, 0, 0, 0);
            __builtin_amdgcn_s_setprio(0);
            return s; };
        f32x16 s = qk(0);
#pragma unroll
        for (int kt = 0; kt < 5; ++kt) {
            const LAS unsigned char* vt_ = vimg + (w + kt) * 4096 + vrd;
            f32x16 sn;
            if (kt + 1 < 5) sn = qk(kt + 1);
            const int hi_ = i32 + 128 - 32 * kt; int lo = hi_ - 128; { const int nk = -(Mstart + 32 * kt); lo = lo > nk ? lo : nk; }
            const int rb = 4 * hi - lo; const unsigned span = (unsigned)(hi_ - lo);
            const bool any = hi_ >= lo;
            float tmax = NEG;
            if (kt >= 1 && kt <= 3 && Mstart + 32 * kt >= 0) {
#pragma unroll
                for (int q = 0; q < 16; ++q) tmax = fmaxf(tmax, s[q]);
            } else {
#pragma unroll
                for (int q = 0; q < 16; ++q) { const int rowc = (q & 3) + 8 * (q >> 2); const bool ok = any && ((unsigned)(rowc + rb) <= span) && (rowc + rb >= 0); s[q] = ok ? s[q] : NEG; tmax = fmaxf(tmax, s[q]); }
            }
            tmax = fmaxf(tmax, bperm_f(lane ^ 32, tmax));
            const float m_new = fmaxf(m_run, tmax), sc = __builtin_amdgcn_exp2f(m_run - m_new);
            m_run = m_new;
            float ps = 0.f;
#pragma unroll
            for (int q = 0; q < 16; ++q) { s[q] = __builtin_amdgcn_exp2f(s[q] - m_new); ps += s[q]; }
            l_run = l_run * sc + ps;
#pragma unroll
            for (int q = 0; q < 16; ++q) { o0[q] *= sc; o1[q] *= sc; }
            u32x4 pw0, pw1;
            pw0.x = cvt_pk_bf16(s[0], s[1]); pw0.y = cvt_pk_bf16(s[2], s[3]); pw0.z = cvt_pk_bf16(s[4], s[5]); pw0.w = cvt_pk_bf16(s[6], s[7]);
            pw1.x = cvt_pk_bf16(s[8], s[9]); pw1.y = cvt_pk_bf16(s[10], s[11]); pw1.z = cvt_pk_bf16(s[12], s[13]); pw1.w = cvt_pk_bf16(s[14], s[15]);
            const bf16x8 pf0 = __builtin_bit_cast(bf16x8, pw0), pf1 = __builtin_bit_cast(bf16x8, pw1);
            __builtin_amdgcn_s_setprio(1);
#pragma unroll
            for (int dh = 0; dh < 2; ++dh) {
#pragma unroll
                for (int kg = 0; kg < 2; ++kg) {
                    const v4i16_t vlo = vtr16(vt_ + (dh * 2 + kg) * 1024), vhi = vtr16(vt_ + (dh * 2 + kg) * 1024 + 512);
                    const bf16x8 vf = (bf16x8){vlo[0], vlo[1], vlo[2], vlo[3], vhi[0], vhi[1], vhi[2], vhi[3]};
                    if (dh == 0) o0 = __builtin_amdgcn_mfma_f32_32x32x16_bf16(vf, kg == 0 ? pf0 : pf1, o0, 0, 0, 0);
                    else o1 = __builtin_amdgcn_mfma_f32_32x32x16_bf16(vf, kg == 0 ? pf0 : pf1, o1, 0, 0, 0);
                }
            }
            __builtin_amdgcn_s_setprio(0);
            if (kt + 1 < 5) s = sn;
        }
        const float lt = l_run + bperm_f(lane ^ 32, l_run), rl = 1.0f / lt;
        bf16_t* op = att + srow * D + hh * 64 + 4 * hi;
#pragma unroll
        for (int gq = 0; gq < 4; ++gq) {
            u32x2 w0, w1;
            w0.x = cvt_pk_bf16(o0[4 * gq] * rl, o0[4 * gq + 1] * rl); w0.y = cvt_pk_bf16(o0[4 * gq + 2] * rl, o0[4 * gq + 3] * rl);
            w1.x = cvt_pk_bf16(o1[4 * gq] * rl, o1[4 * gq + 1] * rl); w1.y = cvt_pk_bf16(o1[4 * gq + 2] * rl, o1[4 * gq + 3] * rl);
            *(u32x2*)(op + 8 * gq) = w0; *(u32x2*)(op + 32 + 8 * gq) = w1;
        }
    }
    __syncthreads();
}

__device__ __forceinline__ void phase_attn_coop0(const Ctx& X, const bf16_t* proj, bf16_t* ost, float2* ml) {
    using pg8::bf16x8;
    const int lane = X.lane, i32 = lane & 31, hi = lane >> 5, w = X.wave;
    LAS unsigned char* vbuf = X.lds + w * 16384;
    LAS unsigned char* kbuf = vbuf + 8192;
    LAS unsigned char* kimg = X.lds;
    LAS unsigned char* vimg = X.lds + 53248;
    const float NEG = opaque_f(-3.0e38f); const int seqmax = opaque_i(SEQ - 1);
    const int vrd = ((lane >> 4) & 1) * 32 + (lane & 3) * 8 + (4 * hi + ((lane & 15) >> 2)) * 64;
    const int lrow = lane >> 3, lpc = lane & 7;
    constexpr int NGRP = BATCH * NH * 32;
    const bool xdeal = (X.G == 256);
    const int ngi = xdeal ? 8 : (NGRP + X.G - 1) / X.G;
    constexpr int PD = 2, NR = 3;
#pragma nounroll
    for (int it = 0; it < ngi; ++it) {
        const int grp = xdeal ? (((it * 8 + (X.bid & 7)) << 5) | (X.bid >> 3)) : (X.bid + it * X.G);
        if (grp >= NGRP) break;
        const int n0 = 2 * (grp & 31), hh = (grp >> 5) & 15, b = grp >> 9;
        const int r = w & 3, bq = w >> 2, blk = n0 + bq, t0 = 128 * blk + r;
        const bf16_t* base = proj + (size_t)b * SEQ * 3072 + hh * 64;
        __syncthreads();
        bf16x8 qf[4];
        { const bf16_t* qp = base + (size_t)(t0 + 4 * i32) * 3072 + 8 * hi;
#pragma unroll
          for (int d0 = 0; d0 < 4; ++d0) qf[d0] = *(const bf16x8*)(qp + 16 * d0); }
        float m_run = NEG, l_run = 0.f;
        f32x16 o0, o1;
#pragma unroll
        for (int q = 0; q < 16; ++q) { o0[q] = 0.f; o1[q] = 0.f; }
        const size_t srow = (size_t)(b * SEQ + t0 + 4 * i32);
#define AT_TILE(kf, Mstart_, kt_, qi_, VADDR, FULLOK) do { \
            f32x16 s; _Pragma("unroll") for (int q = 0; q < 16; ++q) s[q] = 0.f; \
            _Pragma("unroll") for (int d0 = 0; d0 < 4; ++d0) s = __builtin_amdgcn_mfma_f32_32x32x16_bf16(kf[d0], qf[d0], s, 0, 0, 0); \
            const int hi_ = (qi_) + 128 - 32 * (kt_); int lo = hi_ - 128; { const int nk = -((Mstart_) + 32 * (kt_)); lo = lo > nk ? lo : nk; } \
            const int rb = 4 * hi - lo; const unsigned span = (unsigned)(hi_ - lo); const bool any = hi_ >= lo; \
            float tmax = NEG; \
            if ((FULLOK) && (Mstart_) + 32 * (kt_) >= 0) { _Pragma("unroll") for (int q = 0; q < 16; ++q) tmax = fmaxf(tmax, s[q]); }     \
            else { _Pragma("unroll") for (int q = 0; q < 16; ++q) { const int rowc = (q & 3) + 8 * (q >> 2); const bool ok = any && ((unsigned)(rowc + rb) <= span) && (rowc + rb >= 0); s[q] = ok ? s[q] : NEG; tmax = fmaxf(tmax, s[q]); } } \
            tmax = fmaxf(tmax, bperm_f(lane ^ 32, tmax)); \
            const float m_new = fmaxf(m_run, tmax), sc = __builtin_amdgcn_exp2f(m_run - m_new); m_run = m_new; \
            float ps = 0.f; \
            _Pragma("unroll") for (int q = 0; q < 16; ++q) { s[q] = __builtin_amdgcn_exp2f(s[q] - m_new); ps += s[q]; } \
            l_run = l_run * sc + ps; \
            _Pragma("unroll") for (int q = 0; q < 16; ++q) { o0[q] *= sc; o1[q] *= sc; } \
            u32x4 pw0, pw1; \
            pw0.x = cvt_pk_bf16(s[0], s[1]); pw0.y = cvt_pk_bf16(s[2], s[3]); pw0.z = cvt_pk_bf16(s[4], s[5]); pw0.w = cvt_pk_bf16(s[6], s[7]); \
            pw1.x = cvt_pk_bf16(s[8], s[9]); pw1.y = cvt_pk_bf16(s[10], s[11]); pw1.z = cvt_pk_bf16(s[12], s[13]); pw1.w = cvt_pk_bf16(s[14], s[15]); \
            const bf16x8 pf0 = __builtin_bit_cast(bf16x8, pw0), pf1 = __builtin_bit_cast(bf16x8, pw1); \
            _Pragma("unroll") for (int dh = 0; dh < 2; ++dh) { _Pragma("unroll") for (int kg = 0; kg < 2; ++kg) { \
                const LAS unsigned char* va_ = VADDR(dh, kg); \
                const v4i16_t vlo = vtr16(va_), vhi = vtr16(va_ + 512); \
                const bf16x8 vf = (bf16x8){vlo[0], vlo[1], vlo[2], vlo[3], vhi[0], vhi[1], vhi[2], vhi[3]}; \
                if (dh == 0) o0 = __builtin_amdgcn_mfma_f32_32x32x16_bf16(vf, kg == 0 ? pf0 : pf1, o0, 0, 0, 0); \
                else o1 = __builtin_amdgcn_mfma_f32_32x32x16_bf16(vf, kg == 0 ? pf0 : pf1, o1, 0, 0, 0); } } \
        } while (0)
        {
            const int Mstart = (t0 - r) / 4 - 128;
            u32x4 kr[NR][4], vr[NR][4];
            auto issue = [&](int j, u32x4 (&kk)[4], u32x4 (&vv)[4]) {
                const int Mt = Mstart + 32 * j;
#pragma unroll
                for (int q = 0; q < 4; ++q) {
                    int p = 4 * (Mt + 8 * q + lrow) + r; p = p < 0 ? 0 : p; p = p > seqmax ? seqmax : p;
                    const bf16_t* rp = base + (size_t)p * 3072;
                    kk[q] = *(const u32x4*)(rp + 1024 + 8 * (lpc ^ lrow)); vv[q] = *(const u32x4*)(rp + 2048 + 8 * lpc);
                }
            };
#pragma unroll
            for (int j = 0; j < PD; ++j) issue(j, kr[j], vr[j]);
#pragma unroll
            for (int j = 0; j < 5; ++j) {
                if (j + PD < 5) issue(j + PD, kr[(j + PD) % NR], vr[(j + PD) % NR]);
#pragma unroll
                for (int q = 0; q < 4; ++q) *(LAS u32x4*)(kbuf + (j & 1) * 4096 + q * 1024 + lane * 16) = kr[j % NR][q];
                bf16x8 kf[4];
#pragma unroll
                for (int d0 = 0; d0 < 4; ++d0) kf[d0] = *(const LAS bf16x8*)(kbuf + (j & 1) * 4096 + (i32 >> 3) * 1024 + (i32 & 7) * 128 + (((2 * d0 + hi) ^ (i32 & 7)) << 4));
#pragma unroll
                for (int q = 0; q < 4; ++q) *(LAS u32x4*)(vbuf + (j & 1) * 4096 + ((lpc >> 2) * 2 + (q >> 1)) * 1024 + ((q & 1) * 8 + lrow) * 64 + (lpc & 3) * 16) = vr[j % NR][q];
#define AT_VP(dh, kg) (vbuf + (j & 1) * 4096 + vrd + ((dh) * 2 + (kg)) * 1024)
                AT_TILE(kf, Mstart, j, i32, AT_VP, false);
#undef AT_VP
            }
        }
        {
            __builtin_amdgcn_sched_barrier(0);
            u32x4 sh[13];
            const int p0 = 128 * (n0 - 1);
#pragma unroll
            for (int i = 0; i < 13; ++i) {
                const int e_ = X.tid + 512 * i; const bool isv = e_ >= 3328; const int ee = isv ? e_ - 3328 : e_;
                int p = p0 + (ee >> 3); p = p < 0 ? 0 : p; p = p > seqmax ? seqmax : p;
                sh[i] = *(const u32x4*)(base + (size_t)p * 3072 + (isv ? 2048 : 1024) + 8 * (ee & 7));
            }
            __syncthreads();
#pragma unroll
            for (int i = 0; i < 13; ++i) {
                const int e_ = X.tid + 512 * i; const bool isv = e_ >= 3328; const int ee = isv ? e_ - 3328 : e_, row = ee >> 3, pc = ee & 7;
                if (isv) *(LAS u32x4*)(vimg + (pc >> 2) * 26624 + row * 64 + (pc & 3) * 16) = sh[i];
                else *(LAS u32x4*)(kimg + row * 128 + ((pc ^ (row & 7)) << 4)) = sh[i];
            }
            __syncthreads();
            const int Mstart = t0 - 128, s0 = 128 * bq + r;
#pragma nounroll
            for (int kt = 0; kt < 8; ++kt) {
                const int R = s0 + 32 * kt + i32;
                bf16x8 kf[4];
#pragma unroll
                for (int d0 = 0; d0 < 4; ++d0) kf[d0] = *(const LAS bf16x8*)(kimg + R * 128 + (((2 * d0 + hi) ^ (R & 7)) << 4));
#define AT_VP(dh, kg) (vimg + (dh) * 26624 + (s0 + 32 * kt + 16 * (kg)) * 64 + vrd)
                AT_TILE(kf, Mstart, kt, 4 * i32, AT_VP, false);
#undef AT_VP
            }
        }
#undef AT_TILE
        const float lt = l_run + bperm_f(lane ^ 32, l_run);
        if (hi == 0) ml[srow * NH + hh] = make_float2(m_run, lt);
        bf16_t* op = ost + srow * D + hh * 64 + 4 * hi;
#pragma unroll
        for (int gq = 0; gq < 4; ++gq) {
            u32x2 w0, w1;
            w0.x = cvt_pk_bf16(o0[4 * gq], o0[4 * gq + 1]); w0.y = cvt_pk_bf16(o0[4 * gq + 2], o0[4 * gq + 3]);
            w1.x = cvt_pk_bf16(o1[4 * gq], o1[4 * gq + 1]); w1.y = cvt_pk_bf16(o1[4 * gq + 2], o1[4 * gq + 3]);
            *(u32x2*)(op + 8 * gq) = w0; *(u32x2*)(op + 32 + 8 * gq) = w1;
        }
    }
    __syncthreads();
}

__device__ __forceinline__ void phase_ln_router(const Ctx& X, int layer, const bf16_t* hin, const bf16_t* mixo, const float* g, const float* bta, const float* rb, bf16_t* h1, int cnt_layer, int probe = 0) {
    using pg8::bf16x8;
    LAS unsigned char* Ah = X.lds;
    LAS unsigned char* Al = X.lds + 65536;
    LAS float* P = (LAS float*)X.lds;
    LAS int* s_cnt = (LAS int*)(X.lds + TAB_OFF);
    LAS int* s_gb = s_cnt + 32;
    const int lane = X.lane, w = X.wave, tok = lane & 31, hi = lane >> 5;
    int* tok_e = (int*)(X.ws + WS_TOKE); int* tok_r = (int*)(X.ws + WS_TOKR); float* glist = (float*)(X.ws + WS_GLIST); unsigned char* XG8 = (unsigned char*)(X.ws + WS_XG); int* stok = (int*)(X.ws + WS_STOK);
    unsigned* cnt = X.ctl + CW_CNT + cnt_layer * 32 * 64;
    const float rbe = rb[tok]; const float ninf = opaque_f(-INFINITY);
    const auto rs_h = __builtin_amdgcn_make_buffer_rsrc((void*)hin, 0, -1, 0x00020000), rs_m = __builtin_amdgcn_make_buffer_rsrc((void*)mixo, 0, -1, 0x00020000);
#define LNA_LD(rs_, tokidx_, j_) __builtin_bit_cast(u32x4, __builtin_amdgcn_raw_buffer_load_b128(rs_, lane * 16, (tokidx_) * (D * 2) + (j_) * 1024, 0))
    { LAS float* gl = (LAS float*)(X.lds + 131072 + 3072); gl[X.tid] = g[X.tid]; gl[512 + X.tid] = g[512 + X.tid]; gl[1024 + X.tid] = bta[X.tid]; gl[1536 + X.tid] = bta[512 + X.tid]; }
    const int tb = X.bid * 128;
    if (tb < T) {
        u32x4 raw[4][4];
#pragma unroll
        for (int tl = 0; tl < 4; ++tl) { const int ti_ = __builtin_amdgcn_readfirstlane(tb + w * 4 + tl);
#pragma unroll
            for (int j = 0; j < 2; ++j) { raw[tl][2 * j] = LNA_LD(rs_h, ti_, j); raw[tl][2 * j + 1] = LNA_LD(rs_m, ti_, j); } }
        LAS int* rec_e = (LAS int*)(X.lds + 131072 + 3072 + 8192); LAS int* rec_l = rec_e + 512; LAS float* rec_g = (LAS float*)(rec_e + 1024);
        if (X.tid < 32) s_cnt[X.tid] = 0;
#pragma nounroll
        for (int rnd = 0; rnd < 4; ++rnd) {
            __syncthreads();
            const int t0 = tb + rnd * 32 + w * 4;
            int lane_o = lane; asm volatile("" : "+v"(lane_o));
            const int tok_o = lane_o & 31, hi_o = lane_o >> 5;
            float v[4][16]; u32x2 xo[4][2];
            int gl_o = 131072 + 3072; asm volatile("" : "+s"(gl_o)); const LAS float* g2 = (const LAS float*)(X.lds + gl_o); const LAS float* b2 = g2 + 1024;
#pragma unroll
            for (int tl = 0; tl < 4; ++tl) {
                const size_t rowo = (size_t)(t0 + tl) * D;
                float s = 0.f;
#pragma unroll
                for (int j = 0; j < 2; ++j) { float a[8], m[8]; unpack8(raw[tl][2 * j], a); unpack8(raw[tl][2 * j + 1], m);
#pragma unroll
                    for (int q = 0; q < 8; ++q) { v[tl][j * 8 + q] = DN_ALPHA * a[q] + m[q]; s += v[tl][j * 8 + q]; } }
                const float mean = wave_sum(s) * (1.f / D); float s2 = 0.f;
#pragma unroll
                for (int q = 0; q < 16; ++q) { v[tl][q] -= mean; s2 += v[tl][q] * v[tl][q]; }
                const float rstd = rsqrtf(wave_sum(s2) * (1.f / D) + opaque_f(LN_EPS));
#pragma unroll
                for (int j = 0; j < 2; ++j) { const f32x4 g0 = *(const LAS f32x4*)(g2 + j * 512 + lane * 8), g1 = *(const LAS f32x4*)(g2 + j * 512 + lane * 8 + 4), b0 = *(const LAS f32x4*)(b2 + j * 512 + lane * 8), b1 = *(const LAS f32x4*)(b2 + j * 512 + lane * 8 + 4);
#pragma unroll
                    for (int q = 0; q < 4; ++q) { v[tl][j * 8 + q] = v[tl][j * 8 + q] * rstd * g0[q] + b0[q]; v[tl][j * 8 + 4 + q] = v[tl][j * 8 + 4 + q] * rstd * g1[q] + b1[q]; } }
                xo[tl][0].x = pk4_fp8(v[tl][0], v[tl][1], v[tl][2], v[tl][3]); xo[tl][0].y = pk4_fp8(v[tl][4], v[tl][5], v[tl][6], v[tl][7]);
                xo[tl][1].x = pk4_fp8(v[tl][8], v[tl][9], v[tl][10], v[tl][11]); xo[tl][1].y = pk4_fp8(v[tl][12], v[tl][13], v[tl][14], v[tl][15]);
                const int tr = w * 4 + tl;
#pragma unroll
                for (int j = 0; j < 2; ++j) {
                    u32x4 oh, ol; float lo[8];
                    oh.x = cvt_pk_bf16(v[tl][j * 8 + 0], v[tl][j * 8 + 1]); oh.y = cvt_pk_bf16(v[tl][j * 8 + 2], v[tl][j * 8 + 3]); oh.z = cvt_pk_bf16(v[tl][j * 8 + 4], v[tl][j * 8 + 5]); oh.w = cvt_pk_bf16(v[tl][j * 8 + 6], v[tl][j * 8 + 7]);
                    float hf[8]; unpack8(oh, hf);
#pragma unroll
                    for (int q = 0; q < 8; ++q) lo[q] = v[tl][j * 8 + q] - hf[q];
                    ol = pack8(lo);
                    *(u32x4*)(h1 + rowo + j * 512 + lane * 8) = oh;
                    const int ch = ((lane_o + 64 * j) ^ (tr & 7)) << 4;
                    *(LAS u32x4*)(Ah + tr * 2048 + ch) = oh; *(LAS u32x4*)(Al + tr * 2048 + ch) = ol;
                }

            }
            if (rnd < 3) {
#pragma unroll
                for (int tl = 0; tl < 4; ++tl) { const int ti_ = __builtin_amdgcn_readfirstlane(t0 + 32 + tl);
#pragma unroll
                    for (int j = 0; j < 2; ++j) { raw[tl][2 * j] = LNA_LD(rs_h, ti_, j); raw[tl][2 * j + 1] = LNA_LD(rs_m, ti_, j); } } }
            bf16x8 wfh[8], wfl[8];
            { const bf16_t* rwh = (const bf16_t*)(X.ws + WS_RWH) + ((size_t)layer * NE + tok) * D + 128 * w + 8 * hi; const bf16_t* rwl = (const bf16_t*)(X.ws + WS_RWL) + ((size_t)layer * NE + tok) * D + 128 * w + 8 * hi;
#pragma unroll
              for (int i = 0; i < 8; ++i) { wfh[i] = *(const bf16x8*)(rwh + 16 * i); wfl[i] = *(const bf16x8*)(rwl + 16 * i); } }
            __syncthreads();
            f32x16 acc;
#pragma unroll
            for (int q = 0; q < 16; ++q) acc[q] = 0.f;
#pragma unroll
            for (int i = 0; i < 8; ++i) {
                const int ch = ((2 * (8 * w + i) + hi_o) ^ (tok_o & 7)) << 4;
                const bf16x8 bh = *(const LAS bf16x8*)(Ah + tok_o * 2048 + ch), bl = *(const LAS bf16x8*)(Al + tok_o * 2048 + ch);
                acc = __builtin_amdgcn_mfma_f32_32x32x16_bf16(wfh[i], bh, acc, 0, 0, 0);
                acc = __builtin_amdgcn_mfma_f32_32x32x16_bf16(wfl[i], bh, acc, 0, 0, 0);
                acc = __builtin_amdgcn_mfma_f32_32x32x16_bf16(wfh[i], bl, acc, 0, 0, 0);
            }
            __syncthreads();
#pragma unroll
            for (int q = 0; q < 16; ++q) P[(w * 32 + tok) * 33 + (q & 3) + 8 * (q >> 2) + 4 * hi] = acc[q];
            __syncthreads();
            float lg[4];
#pragma unroll
            for (int tl = 0; tl < 4; ++tl) { float a = 0.f;
#pragma unroll
                for (int ww = 0; ww < 4; ++ww) a += P[((hi * 4 + ww) * 32 + (w * 4 + tl)) * 33 + tok];
                a += bperm_f(lane_o ^ 32, a); lg[tl] = a + rbe; }
            const int e = tok;
            int my_e = 0; float my_g = 0.f;
#pragma unroll
            for (int tl = 0; tl < 4; ++tl) {
                float cur = lg[tl];
                float sv0 = 0.f, sv1 = 0.f, sv2 = 0.f, sv3 = 0.f; int si0 = 0, si1 = 0, si2 = 0, si3 = 0;
#pragma unroll
                for (int k = 0; k < 4; ++k) {
                    float bv = cur; int bi = e;
#define LNA_XS(o) { const float ov = swz_f<o>(bv); const int oi = swz_i<o>(bi); if (ov > bv || (ov == bv && oi < bi)) { bv = ov; bi = oi; } }
                    LNA_XS(1) LNA_XS(2) LNA_XS(4) LNA_XS(8) LNA_XS(16)
#undef LNA_XS
                    if (k == 0) { sv0 = bv; si0 = bi; } else if (k == 1) { sv1 = bv; si1 = bi; } else if (k == 2) { sv2 = bv; si2 = bi; } else { sv3 = bv; si3 = bi; }
                    if (e == bi) cur = ninf;
                }
                const float e1 = __expf(sv1 - sv0), e2 = __expf(sv2 - sv0), e3 = __expf(sv3 - sv0), inv = 1.f / (1.f + e1 + e2 + e3);
                if ((lane >> 2) == tl) { const int k = lane & 3; my_e = k == 0 ? si0 : k == 1 ? si1 : k == 2 ? si2 : si3; my_g = (k == 0 ? 1.f : k == 1 ? e1 : k == 2 ? e2 : e3) * inv; }
            }
            if (lane < 16) { const int my_lr = __hip_atomic_fetch_add(&s_cnt[my_e], 1, __ATOMIC_RELAXED, __HIP_MEMORY_SCOPE_WORKGROUP);
                const int ri = (rnd * 32 + w * 4 + (lane >> 2)) * 4 + (lane & 3); rec_e[ri] = my_e; rec_l[ri] = my_lr; rec_g[ri] = my_g; }
#ifdef PROBE_LNA
            if (!(probe & 1))
#endif
#pragma unroll
            for (int tl = 0; tl < 4; ++tl) {
                unsigned char* dst = XG8 + (size_t)(t0 + tl) * D + lane * 8;
                *(u32x2*)(dst) = xo[tl][0]; *(u32x2*)(dst + 512) = xo[tl][1]; }
        }
        __syncthreads();
        { int tid_o = X.tid; asm volatile("" : "+v"(tid_o));
          if (tid_o < 32) { const int c = s_cnt[tid_o]; s_gb[tid_o] = c ? (int)atomicAdd(cnt + tid_o * 64, (unsigned)c) : 0; }
          __syncthreads();
          const int e_ = rec_e[tid_o], r_ = s_gb[e_] + rec_l[tid_o], t_ = tb + (tid_o >> 2); const float g_ = rec_g[tid_o];
          tok_e[t_ * 4 + (tid_o & 3)] = e_; tok_r[t_ * 4 + (tid_o & 3)] = r_; glist[(size_t)e_ * T + r_] = g_; stok[(size_t)e_ * T + r_] = t_; }
    }
}
#undef LNA_LD

__device__ __forceinline__ void load_tile_table(const Ctx& X, int layer, LAS int* tb) {
    __syncthreads();
    if (X.tid < 64) {
        const int c = X.tid < 32 ? (int)__hip_atomic_load(X.ctl + CW_CNT + (layer * 32 + X.tid) * 64, RLX_AGENT) : 0;
        const int tl = (c + 255) >> 8; int incl = tl;
#pragma unroll
        for (int o = 1; o < 32; o <<= 1) { const int t = bperm_i(X.lane - o, incl); if ((X.tid & 31) >= o) incl += t; }
        if (X.tid < 32) { tb[X.tid] = incl - tl; if (X.tid == 31) tb[32] = incl; }
    }
    __syncthreads();
}

template <bool OUT_F32>
__device__ __forceinline__ void phase_combine_ln(const Ctx& X, int layer, const bf16_t* h1, const bf16_t* Y, const float* g, const float* bta, void* outp) {
    const int lane = X.lane;
    const int gw = X.bid * NWAVES + X.wave, NGW = X.G * NWAVES;
    const int* tok_e = (const int*)(X.ws + WS_TOKE); const int* tok_r = (const int*)(X.ws + WS_TOKR);
    int basev = 0;
    { const int c = lane < 32 ? (int)__hip_atomic_load(X.ctl + CW_CNT + (layer * 32 + lane) * 64, RLX_AGENT) : 0; const int pc = ((c + 255) >> 8) << 8; int incl = pc;
#pragma unroll
      for (int o = 1; o < 32; o <<= 1) { const int t = bperm_i(lane - o, incl); if ((lane & 31) >= o) incl += t; }
      basev = incl - pc; }
    float gg[16], bb[16];
#pragma unroll
    for (int j = 0; j < 2; ++j) {
        const f32x4 g0 = *(const f32x4*)(g + j * 512 + lane * 8), g1 = *(const f32x4*)(g + j * 512 + lane * 8 + 4), b0 = *(const f32x4*)(bta + j * 512 + lane * 8), b1 = *(const f32x4*)(bta + j * 512 + lane * 8 + 4);
#pragma unroll
        for (int q = 0; q < 4; ++q) { gg[j * 8 + q] = g0[q]; gg[j * 8 + 4 + q] = g1[q]; bb[j * 8 + q] = b0[q]; bb[j * 8 + 4 + q] = b1[q]; }
    }
    int nslot = 0, ne_ = 0;
    if (gw < T && lane < 4) { nslot = tok_r[gw * 4 + lane]; ne_ = tok_e[gw * 4 + lane]; }
    for (int bt = gw; bt < T; bt += NGW) {
        int myslot = nslot; const int mye = ne_;
        nslot = 0; ne_ = 0;
        if (bt + NGW < T && lane < 4) { nslot = tok_r[(bt + NGW) * 4 + lane]; ne_ = tok_e[(bt + NGW) * 4 + lane]; }
        myslot += bperm_i(mye, basev);
        const int s0 = bperm_i(0, myslot), s1 = bperm_i(1, myslot), s2 = bperm_i(2, myslot), s3 = bperm_i(3, myslot);
        float v[16]; float s = 0.f;
#pragma unroll
        for (int j = 0; j < 2; ++j) {
            const int off = j * 512 + lane * 8;
            float a[8], y0[8], y1[8], y2[8], y3[8];
            unpack8(*(const u32x4*)(h1 + (size_t)bt * D + off), a);
            const unsigned char* Y8 = (const unsigned char*)Y;
            unpack8_fp8(*(const u32x2*)(Y8 + (size_t)s0 * D + off), y0); unpack8_fp8(*(const u32x2*)(Y8 + (size_t)s1 * D + off), y1); unpack8_fp8(*(const u32x2*)(Y8 + (size_t)s2 * D + off), y2); unpack8_fp8(*(const u32x2*)(Y8 + (size_t)s3 * D + off), y3);
#pragma unroll
            for (int q = 0; q < 8; ++q) { v[j * 8 + q] = DN_ALPHA * a[q] + (((y0[q] + y1[q]) + y2[q]) + y3[q]) * (1.0f / Y8_SCALE); s += v[j * 8 + q]; }
        }
        const float mean = wave_sum(s) * (1.f / D); float s2q = 0.f;
#pragma unroll
        for (int q = 0; q < 16; ++q) { v[q] -= mean; s2q += v[q] * v[q]; }
        const float rstd = rsqrtf(wave_sum(s2q) * (1.f / D) + opaque_f(LN_EPS));
#pragma unroll
        for (int q = 0; q < 16; ++q) v[q] = v[q] * rstd * gg[q] + bb[q];
#pragma unroll
        for (int j = 0; j < 2; ++j) {
            const size_t o = (size_t)bt * D + j * 512 + lane * 8;
            if (OUT_F32) { float* op = (float*)outp + o; *(f32x4*)(op) = (f32x4){v[j * 8 + 0], v[j * 8 + 1], v[j * 8 + 2], v[j * 8 + 3]}; *(f32x4*)(op + 4) = (f32x4){v[j * 8 + 4], v[j * 8 + 5], v[j * 8 + 6], v[j * 8 + 7]}; }
            else { u32x4 w; w.x = cvt_pk_bf16(v[j * 8 + 0], v[j * 8 + 1]); w.y = cvt_pk_bf16(v[j * 8 + 2], v[j * 8 + 3]); w.z = cvt_pk_bf16(v[j * 8 + 4], v[j * 8 + 5]); w.w = cvt_pk_bf16(v[j * 8 + 6], v[j * 8 + 7]); *(u32x4*)((bf16_t*)outp + o) = w; }
        }
    }
}


__device__ __forceinline__ Ctx refresh_ctx(const Ctx& X0) {
    Ctx X = X0; int wv = X0.wave; asm volatile("" : "+s"(wv)); int t = wv * 64 + lane_id(); asm volatile("" : "+v"(t)); X.tid = t; X.lane = t & 63; X.wave = wv;
    asm volatile("" : "+s"(X.ws), "+s"(X.ctl), "+s"(X.G), "+s"(X.bid));
    return X;
}
#ifndef STAG
#define STAG 0
#endif
__device__ __forceinline__ void stagger(const Ctx& X) { const int n = ((X.bid >> 3) & 31) * STAG;
#pragma nounroll
    for (int i = 0; i < n; ++i) __builtin_amdgcn_s_sleep(1); }
struct Args { const float* in[26]; float* out; unsigned char* ws; int ph_lo, ph_hi; };
constexpr int N_PHASES = 1 + 2 * (6 + 4) + 2 * (4 + 4);
#define GP_ALIGN true
#define GP_SP2 true

__global__ void __launch_bounds__(NTHR, 2) mk_fwd(Args args) {
    extern __shared__ __attribute__((aligned(16))) unsigned char lds_raw[];
    Ctx X0;
    X0.lds = (LAS unsigned char*)lds_raw;
    X0.tid = threadIdx.x; X0.lane = X0.tid & 63; X0.wave = __builtin_amdgcn_readfirstlane(X0.tid >> 6);
    X0.G = gridDim.x; X0.bid = blockIdx.x;
    X0.ws = (GAS unsigned char*)args.ws; X0.ctl = (unsigned*)(args.ws + WS_CTL);
    volatile LAS unsigned* MISC = (volatile LAS unsigned*)(X0.lds + MISC_OFF);
    if (X0.tid < 32) MISC[X0.tid] = 0u;
    __syncthreads();
    XcdBarrier bar; bar.bar = X0.ctl + CW_BAR; bar.x = 0; bar.st = nullptr; bar.wave = X0.wave;
    if (MK_ONE_LAUNCH) bar = xcd_barrier_post(X0.ctl + CW_BAR, MISC + 8, X0.wave);
    volatile LAS unsigned long long* ptab = (volatile LAS unsigned long long*)(X0.lds + TAB_OFF + 1024);
    if (X0.tid < 26) ptab[X0.tid] = (unsigned long long)args.in[X0.tid];
    __syncthreads();
#define INP(k) ld_ptr(ptab, k)
    const int lo = args.ph_lo, hi = args.ph_hi;
    int ph = 0;
#define IN() (lo <= ph && ph < hi)
#define SEAM() do { if (MK_ONE_LAUNCH && lo <= ph && ph + 1 < hi) xcd_barrier(bar); ++ph; } while (0)

#define H0 ((bf16_t*)(X.ws + WS_H0))
#define H1 ((bf16_t*)(X.ws + WS_H1))
#define PROJ ((bf16_t*)(X.ws + WS_PROJ))
#define MIX ((bf16_t*)(X.ws + WS_MIX))
#define MIXO ((bf16_t*)(X.ws + WS_MIXO))
#define Z ((bf16_t*)(X.ws + WS_Z))
#define ACT ((bf16_t*)(X.ws + WS_ACT))
#define Y ((bf16_t*)(X.ws + WS_Y))
#define tb ((LAS int*)(X.lds + TAB_OFF + 512))

#ifndef DUP_MASK
#define DUP_MASK 0
#endif
    enum { P_PRO, P_E1, P_S5A, P_S5C, P_S5B, P_E3, P_E4, P_O1, P_ATT, P_O3, P_LNA, P_M1, P_M2, P_LNB, P_ATT1 };
#define PHASE_BEGIN(k) _Pragma("nounroll") for (int _r = 0; _r < ((((DUP_MASK) >> (k)) & 1) + 1); ++_r) { if (IN()) { const Ctx X = refresh_ctx(X0);
#define PHASE_END } SEAM(); }
    PHASE_BEGIN(P_PRO)  phase_prologue(X, ptab);  PHASE_END

#pragma nounroll
    for (int layer = 0; layer < DEPTH; ++layer) {
        const int i = layer >> 1;
        if ((layer & 1) == 0) {
            PHASE_BEGIN(P_E1)  pg8::Gemm gm{H0, (const bf16_t*)(X.ws + WS_WIN) + (size_t)i * 2048 * D, T, 2048, D}; pg8::StaticOrder S; S.init(T, 2048, D, X.G, X.bid);
                pg8::EpiStore E{PROJ, 2048};
                pg8::gemm_phase<pg8::EpiStore, pg8::StaticOrder, GP_ALIGN, GP_SP2>(X.lds, gm, S, E, X.wave);  PHASE_END
            PHASE_BEGIN(P_S5A)  phase_s5<1>(X, i, PROJ, INP(2), INP(8), INP(9), INP(10), MIX, Z);  PHASE_END
            PHASE_BEGIN(P_S5C)  phase_s5_carry(X, i);  PHASE_END
#ifdef PROBE_S5B
            PHASE_BEGIN(P_S5B)  phase_s5<2>(X, i, PROJ, INP(2), INP(8), INP(9), INP(10), MIX, Z, _r == 0 ? opaque_i(PROBE_S5B) : 0);  PHASE_END
#else
            PHASE_BEGIN(P_S5B)  phase_s5<2>(X, i, PROJ, INP(2), INP(8), INP(9), INP(10), MIX, Z);  PHASE_END
#endif
            PHASE_BEGIN(P_E3)  pg8::Gemm gm{Z, (const bf16_t*)(X.ws + WS_WGLU) + (size_t)i * 512 * 512, T, 512, 512}; pg8::StaticOrder S; S.init(T, 512, 512, X.G, X.bid);
                pg8::EpiGlu E{Z, MIX, INP(12) + (size_t)i * SSM_W};
                pg8::gemm_phase<pg8::EpiGlu, pg8::StaticOrder, GP_ALIGN, GP_SP2>(X.lds, gm, S, E, X.wave);  PHASE_END
            PHASE_BEGIN(P_E4)  pg8::Gemm gm{MIX, (const bf16_t*)(X.ws + WS_WOUT) + (size_t)i * D * D, T, D, D}; pg8::StaticOrder S; S.init(T, D, D, X.G, X.bid);
                pg8::EpiStore E{MIXO, D};
                pg8::gemm_phase<pg8::EpiStore, pg8::StaticOrder, GP_ALIGN, GP_SP2>(X.lds, gm, S, E, X.wave);  PHASE_END
        } else {
            PHASE_BEGIN(P_O1)  pg8::Gemm gm{H0, (const bf16_t*)(X.ws + WS_WQKV) + (size_t)i * 3072 * D, T, 3072, D}; pg8::StaticOrder S; S.init(T, 3072, D, X.G, X.bid);
                pg8::EpiRope E{PROJ, (const f32x2*)(X.ws + WS_ROPE)};
#if defined(PROBE_O1)
                if (_r == 0) pg8::gemm_phase<pg8::EpiRope, pg8::StaticOrder, GP_ALIGN, GP_SP2, false, PROBE_O1>(X.lds, gm, S, E, X.wave); else
#endif
                pg8::gemm_phase<pg8::EpiRope, pg8::StaticOrder, GP_ALIGN, GP_SP2>(X.lds, gm, S, E, X.wave);  PHASE_END
            PHASE_BEGIN(P_ATT)  phase_attn_coop0(X, PROJ, MIXO, (float2*)(X.ws + WS_S5X));  PHASE_END
            PHASE_BEGIN(P_ATT1)  phase_attn_coop1(X, PROJ, MIX, MIXO, (const float2*)(X.ws + WS_S5X));  PHASE_END
            PHASE_BEGIN(P_O3)  pg8::Gemm gm{MIX, (const bf16_t*)(X.ws + WS_WO) + (size_t)i * D * D, T, D, D}; pg8::StaticOrder S; S.init(T, D, D, X.G, X.bid);
                pg8::EpiStore E{MIXO, D};
                pg8::gemm_phase<pg8::EpiStore, pg8::StaticOrder, GP_ALIGN, GP_SP2>(X.lds, gm, S, E, X.wave);  PHASE_END
        }
#ifdef PROBE_LNA
        PHASE_BEGIN(P_LNA)  phase_ln_router(X, layer, H0, MIXO, INP(16) + layer * D, INP(17) + layer * D, INP(21) + layer * NE, H1, _r == 0 ? layer + 4 : layer, _r == 0 ? opaque_i(PROBE_LNA) : 0);  PHASE_END
#else
        PHASE_BEGIN(P_LNA)  phase_ln_router(X, layer, H0, MIXO, INP(16) + layer * D, INP(17) + layer * D, INP(21) + layer * NE, H1, layer);  PHASE_END
#endif
        PHASE_BEGIN(P_M1)  load_tile_table(X, layer, tb);
            pg8::Gemm gm{(const bf16_t*)(X.ws + WS_XG), (const bf16_t*)(X.ws + WS_WGU + (size_t)layer * NE * 2048 * D), 0, 2048, D / 2};
            pg8::MoeOrder<8, true> S; S.init(tb, X.G, X.bid, 2048, D / 2); S.stok = (const int*)(X.ws + WS_STOK); S.cnt = X.ctl + CW_CNT + layer * 32 * 64; S.preload_ids((LAS unsigned short*)(X.lds + 131072 + 3072), X.tid, X.wave);
            stagger(X);
#ifdef PROBE_NOSTORE
            pg8::EpiSwiglu E{opaque_i(((DUP_MASK >> P_M1) & 1) && _r == 0) != 0, ACT, INP(23) + (size_t)layer * NE * 2048};
#else
            S.preload_bias<9, true>((LAS float*)(X.lds + 131072 + 3072 + 9216), INP(23) + (size_t)layer * NE * 2048, X.tid, X.wave);
            pg8::EpiSwiglu E{ACT, (const LAS float*)(X.lds + 131072 + 3072 + 9216)};
#endif
#if defined(PROBE_M1)
            if (_r == 0) pg8::gemm_phase<pg8::EpiSwiglu, pg8::MoeOrder<8, true>, GP_ALIGN, GP_SP2, true, PROBE_M1>(X.lds, gm, S, E, X.wave, opaque_i(127 - W8_SHIFT_GU), opaque_i(127)); else
#endif
            pg8::gemm_phase<pg8::EpiSwiglu, pg8::MoeOrder<8, true>, GP_ALIGN, GP_SP2, true>(X.lds, gm, S, E, X.wave, opaque_i(127 - W8_SHIFT_GU), opaque_i(127));  PHASE_END
        PHASE_BEGIN(P_M2)  load_tile_table(X, layer, tb);
            pg8::Gemm gm{ACT, (const bf16_t*)(X.ws + WS_WDN + (size_t)layer * NE * D * D), 0, D, D / 2};
            pg8::MoeOrder<4, false> S; S.init(tb, X.G, X.bid, D, D / 2); S.stok = nullptr; S.cnt = nullptr; S.idl = nullptr;
            stagger(X);
#ifdef PROBE_NOSTORE
            pg8::EpiDown E{opaque_i(((DUP_MASK >> P_M2) & 1) && _r == 0) != 0, Y, INP(25) + (size_t)layer * NE * D, (const float*)(X.ws + WS_GLIST)};
#else
            S.preload_gates((LAS float*)(X.lds + 131072 + 3072), (const float*)(X.ws + WS_GLIST), X.tid, X.wave);
            S.preload_bias<5, false>((LAS float*)(X.lds + 131072 + 3072 + 10240), INP(25) + (size_t)layer * NE * D, X.tid, X.wave);
            pg8::EpiDown E{Y, (const LAS float*)(X.lds + 131072 + 3072 + 10240), (const LAS float*)(X.lds + 131072 + 3072)};
#endif
#if defined(PROBE_M2)
            if (_r == 0) pg8::gemm_phase<pg8::EpiDown, pg8::MoeOrder<4, false>, GP_ALIGN, GP_SP2, true, PROBE_M2>(X.lds, gm, S, E, X.wave, opaque_i(127 - W8_SHIFT_DN), opaque_i(127)); else
#endif
            pg8::gemm_phase<pg8::EpiDown, pg8::MoeOrder<4, false>, GP_ALIGN, GP_SP2, true>(X.lds, gm, S, E, X.wave, opaque_i(127 - W8_SHIFT_DN), opaque_i(127));  PHASE_END
        PHASE_BEGIN(P_LNB)
            if (layer == DEPTH - 1) phase_combine_ln<true>(X, layer, H1, Y, INP(18) + layer * D, INP(19) + layer * D, (void*)args.out);
            else phase_combine_ln<false>(X, layer, H1, Y, INP(18) + layer * D, INP(19) + layer * D, (void*)H0);
         PHASE_END
    }
#undef IN
#undef SEAM
#undef PHASE_BEGIN
#undef PHASE_END
#undef H0
#undef H1
#undef PROJ
#undef MIX
#undef MIXO
#undef Z
#undef ACT
#undef Y
#undef tb
}

extern "C" void kernel_launch(void* const* d_in, const int* in_sizes, int n_in, void* d_out, int out_size, void* d_ws, size_t ws_size, hipStream_t stream) {
    static int grid = 0;
    if (grid == 0) {
        if (n_in != 26 || out_size != T * D || ws_size < WS_END) { fprintf(stderr, "kernel_launch: unexpected shapes n_in %d out %d ws %zu (need %zu)\n", n_in, out_size, ws_size, (size_t)WS_END); grid = -1; return; }
        int dev = 0, cus = 0, per_cu = 0;
        if (hipGetDevice(&dev) != hipSuccess || hipDeviceGetAttribute(&cus, hipDeviceAttributeMultiprocessorCount, dev) != hipSuccess) { grid = -1; return; }
        if (hipFuncSetAttribute((const void*)mk_fwd, hipFuncAttributeMaxDynamicSharedMemorySize, LDS_BYTES) != hipSuccess) { fprintf(stderr, "kernel_launch: hipFuncSetAttribute failed\n"); grid = -1; return; }
        if (hipOccupancyMaxActiveBlocksPerMultiprocessor(&per_cu, (const void*)mk_fwd, NTHR, LDS_BYTES) != hipSuccess || per_cu < 1) fprintf(stderr, "kernel_launch: occupancy query says %d\n", per_cu);
        (void)hipGetLastError();
        grid = cus;
        if (grid < 256) { fprintf(stderr, "kernel_launch: %d CUs; the LN+router phase deals one 128-token slab per workgroup and needs 256\n", cus); grid = -1; return; }
        if (grid > 256) grid = 256;
    }
    if (grid < 0) return;
    if (hipMemsetAsync((char*)d_ws + WS_CTL, 0, CTL_ZERO_BYTES, stream) != hipSuccess) return;
    Args a{};
    for (int i = 0; i < 26; ++i) a.in[i] = (const float*)d_in[i];
    a.out = (float*)d_out; a.ws = (unsigned char*)d_ws;
#if MK_ONE_LAUNCH
    a.ph_lo = 0; a.ph_hi = DUP_MASK ? 100000 : N_PHASES;
    hipLaunchKernelGGL(mk_fwd, dim3(grid), dim3(NTHR), LDS_BYTES, stream, a);
#else
    for (int p = 0; p < N_PHASES; ++p) { a.ph_lo = p; a.ph_hi = p + 1; hipLaunchKernelGGL(mk_fwd, dim3(grid), dim3(NTHR), LDS_BYTES, stream, a); }
#endif
}
```
